# Optimizing an MI355X kernel written in HIP

```python
import numpy as np
import jax
import jax.numpy as jnp
from jax import lax

D_MODEL = 1024
BATCH = 4
SEQ = 8192
DEPTH = 2

GRID_W = 64
CTX_LEN = 256
HEAD_DIM = 64
QBLOCK = 128
ROPE_THETA = 10000.0
EPS = 1e-6
NEG_INF = -1e30

NA_HEADS = 4
NA_KH = 8
NA_KW = 16
GQA_HEADS = 4
GQA_KV_HEADS = 2
SWA_HEADS = 4
SWA_KV_HEADS = 2
SWA_WINDOW = 128
MLA_HEADS = 4
MLA_NOPE = 64
MLA_ROPE = 32
MLA_V = 64
MLA_Q_LORA = 192
MLA_KV_LORA = 128
N_BRANCH = 4
BRANCH_W = 256
N_EXPERTS = 16
EXPERT_FF = 1024
CAPACITY = 2
N_MOD = 6
DEEPNORM_ALPHA = (2 * DEPTH) ** 0.25
DEEPNORM_BETA = (8 * DEPTH) ** -0.25

IN_SPLITS = (
    NA_HEADS * HEAD_DIM, NA_HEADS * HEAD_DIM, NA_HEADS * HEAD_DIM,
    GQA_HEADS * HEAD_DIM, GQA_KV_HEADS * HEAD_DIM, GQA_KV_HEADS * HEAD_DIM,
    SWA_HEADS * HEAD_DIM, SWA_KV_HEADS * HEAD_DIM, SWA_KV_HEADS * HEAD_DIM,
    MLA_Q_LORA, MLA_KV_LORA, MLA_ROPE,
    N_BRANCH * D_MODEL,
)
IN_WIDTH = sum(IN_SPLITS)

kernel_name = 'hybrid_diffusion_parallel_mixers_ec_moe'


def layer_norm(x, g=None, b=None):
    xf = x.astype(jnp.float32)
    mu = jnp.mean(xf, axis=-1, keepdims=True)
    var = jnp.mean(jnp.square(xf - mu), axis=-1, keepdims=True)
    y = (xf - mu) * lax.rsqrt(var + EPS)
    if g is not None:
        y = y * g.astype(jnp.float32) + b.astype(jnp.float32)
    return y.astype(x.dtype)


def rms_norm(x, g):
    xf = x.astype(jnp.float32)
    y = xf * lax.rsqrt(jnp.mean(jnp.square(xf), axis=-1, keepdims=True) + EPS) * g.astype(jnp.float32)
    return y.astype(x.dtype)


def modulate(x, shift, scale):
    return layer_norm(x) * (1.0 + scale) + shift


def rope_1d(x, pos):
    half = x.shape[-1] // 2
    freqs = ROPE_THETA ** (-jnp.arange(half, dtype=jnp.float32) / half)
    ang = pos[:, None] * freqs[None, :]
    cos = jnp.cos(ang)[:, None, :].astype(x.dtype)
    sin = jnp.sin(ang)[:, None, :].astype(x.dtype)
    x1, x2 = x[..., :half], x[..., half:]
    return jnp.concatenate([x1 * cos - x2 * sin, x1 * sin + x2 * cos], axis=-1)


def axial_rope(x, row, col):
    half = x.shape[-1] // 2
    return jnp.concatenate([rope_1d(x[..., :half], row), rope_1d(x[..., half:], col)], axis=-1)


def split_in(z):
    offs = np.cumsum(IN_SPLITS)[:-1].tolist()
    return jnp.split(z, offs, axis=-1)


def heads(t, nh):
    return t.reshape(t.shape[:2] + (nh, -1))


def group(q, nkv):
    return q.reshape(q.shape[:2] + (nkv, q.shape[2] // nkv, q.shape[3]))


def cat(a, b):
    return jnp.concatenate([a, b], axis=1)


def attend(q, k, v, sink=None):
    s = jnp.einsum('bqkgd,bmkd->bkgqm', q, k).astype(jnp.float32) * (q.shape[-1] ** -0.5)
    if sink is not None:
        col = jnp.broadcast_to(sink.astype(jnp.float32)[None, :, :, None, None], s.shape[:-1] + (1,))
        p = jax.nn.softmax(jnp.concatenate([s, col], axis=-1), axis=-1)[..., :-1]
    else:
        p = jax.nn.softmax(s, axis=-1)
    return jnp.einsum('bkgqm,bmkd->bqkgd', p.astype(v.dtype), v)


def dense_blocks(q, k, v):
    B, n = q.shape[:2]
    nb = n // QBLOCK
    qb = jnp.moveaxis(q.reshape((B, nb, QBLOCK) + q.shape[2:]), 1, 0)
    ob = lax.map(lambda qi: attend(qi, k, v), qb)
    return jnp.moveaxis(ob, 0, 1).reshape((B, n) + ob.shape[3:])


def window_attn(q, k, v, kc, vc, sink):
    B, n, K, G, d = q.shape
    nb = n // QBLOCK

    def bands(t):
        tp = jnp.pad(t, ((0, 0), (QBLOCK, QBLOCK), (0, 0), (0, 0)))
        tp = tp.reshape((B, nb + 2, QBLOCK) + t.shape[2:])
        return jnp.concatenate([tp[:, :-2], tp[:, 1:-1], tp[:, 2:]], axis=2)

    kb, vb = bands(k), bands(v)
    qb = q.reshape(B, nb, QBLOCK, K, G, d)
    qpos = jnp.arange(n).reshape(nb, QBLOCK)
    kpos = (jnp.arange(nb)[:, None] - 1) * QBLOCK + jnp.arange(3 * QBLOCK)[None, :]
    ok = ((jnp.abs(qpos[:, :, None] - kpos[:, None, :]) <= SWA_WINDOW)
          & (kpos[:, None, :] >= 0) & (kpos[:, None, :] < n))
    scale = d ** -0.5
    s_lat = jnp.einsum('bnqkgd,bnmkd->bnkgqm', qb, kb).astype(jnp.float32) * scale
    s_lat = jnp.where(ok[None, :, None, None], s_lat, NEG_INF)
    s_ctx = jnp.einsum('bnqkgd,bmkd->bnkgqm', qb, kc).astype(jnp.float32) * scale
    s_snk = jnp.broadcast_to(sink.astype(jnp.float32)[None, None, :, :, None, None], s_lat.shape[:-1] + (1,))
    p = jax.nn.softmax(jnp.concatenate([s_lat, s_ctx, s_snk], axis=-1), axis=-1).astype(v.dtype)
    m = 3 * QBLOCK
    lc = kc.shape[1]
    o = (jnp.einsum('bnkgqm,bnmkd->bnqkgd', p[..., :m], vb)
         + jnp.einsum('bnkgqm,bmkd->bnqkgd', p[..., m:m + lc], vc))
    return o.reshape(B, n, K, G, -1)


def neighborhood_attn(q, k, v, kc, vc, rpb):
    B, n, H, d = q.shape
    rows = n // GRID_W
    kh = min(NA_KH, rows)
    scale = d ** -0.5
    q = q.reshape(B, rows, GRID_W, H, d)
    k = k.reshape(B, rows, GRID_W, H, d)
    v = v.reshape(B, rows, GRID_W, H, d)
    r = jnp.arange(rows)
    key_rows = jnp.clip(r - kh // 2, 0, rows - kh)[:, None] + jnp.arange(kh)[None, :]
    kg = k[:, key_rows]
    vg = v[:, key_rows]
    w = jnp.arange(GRID_W)
    col_start = jnp.clip(w - NA_KW // 2, 0, GRID_W - NA_KW)
    col_ok = (w[None, :] >= col_start[:, None]) & (w[None, :] < col_start[:, None] + NA_KW)
    dr_idx = key_rows - r[:, None] + NA_KH - 1
    dc_idx = jnp.clip(w[None, :] - w[:, None], 1 - NA_KW, NA_KW - 1) + NA_KW - 1
    bias = rpb[:, dr_idx[:, None, :, None], dc_idx[None, :, None, :]].astype(jnp.float32)
    s_lat = jnp.einsum('brqhd,brjmhd->bhrqjm', q, kg).astype(jnp.float32) * scale + bias[None]
    s_lat = jnp.where(col_ok[:, None, :], s_lat, NEG_INF).reshape(B, H, rows, GRID_W, kh * GRID_W)
    s_ctx = jnp.einsum('brqhd,bchd->bhrqc', q, kc).astype(jnp.float32) * scale
    p = jax.nn.softmax(jnp.concatenate([s_lat, s_ctx], axis=-1), axis=-1).astype(v.dtype)
    p_lat = p[..., :kh * GRID_W].reshape(B, H, rows, GRID_W, kh, GRID_W)
    o = (jnp.einsum('bhrqjm,brjmhd->brqhd', p_lat, vg)
         + jnp.einsum('bhrqc,bchd->brqhd', p[..., kh * GRID_W:], vc))
    return o.reshape(B, n, H, d)


def mla_q(cq, p, row=None, col=None):
    B, n = cq.shape[:2]
    q = (rms_norm(cq, p['mla_q_norm']) @ p['mla_w_qb']).reshape(B, n, MLA_HEADS, MLA_NOPE + MLA_ROPE)
    if row is None:
        return q
    return jnp.concatenate([q[..., :MLA_NOPE], axial_rope(q[..., MLA_NOPE:], row, col)], axis=-1)


def mla_kv(ckv, kr, p, row=None, col=None):
    B, n = ckv.shape[:2]
    kv = (rms_norm(ckv, p['mla_kv_norm']) @ p['mla_w_kvb']).reshape(B, n, MLA_HEADS, MLA_NOPE + MLA_V)
    k_rot = kr[:, :, None, :]
    if row is not None:
        k_rot = axial_rope(k_rot, row, col)
    k = jnp.concatenate([kv[..., :MLA_NOPE], jnp.broadcast_to(k_rot, (B, n, MLA_HEADS, MLA_ROPE))], axis=-1)
    return k, kv[..., MLA_NOPE:]


def merge_branches(outs, gates_raw, p):
    B, n = gates_raw.shape[:2]
    g = jax.nn.sigmoid(gates_raw.reshape(B, n, N_BRANCH, D_MODEL))
    merged = g[:, :, 0] * (outs[0].reshape(B, n, BRANCH_W) @ p['w_branch'][0])
    for i in range(1, N_BRANCH):
        merged = merged + g[:, :, i] * (outs[i].reshape(B, n, BRANCH_W) @ p['w_branch'][i])
    return merged @ p['w_out']


def token_mixers(h, hc, row, col, p, need_ctx):
    (na_q, na_k, na_v, gq_q, gq_k, gq_v, sw_q, sw_k, sw_v,
     ml_cq, ml_ckv, ml_kr, gates) = split_in(h @ p['w_in'])
    (nac_q, nac_k, nac_v, gqc_q, gqc_k, gqc_v, swc_q, swc_k, swc_v,
     mlc_cq, mlc_ckv, mlc_kr, gates_c) = split_in(hc @ p['w_in'])
    sink = p['swa_sink'].reshape(SWA_KV_HEADS, SWA_HEADS // SWA_KV_HEADS)

    kac, vac = heads(nac_k, NA_HEADS), heads(nac_v, NA_HEADS)
    kbc = rms_norm(heads(gqc_k, GQA_KV_HEADS), p['gqa_k_norm'])
    vbc = heads(gqc_v, GQA_KV_HEADS)
    kcc, vcc = heads(swc_k, SWA_KV_HEADS), heads(swc_v, SWA_KV_HEADS)
    kdc, vdc = mla_kv(mlc_ckv, mlc_kr, p)

    o_a = neighborhood_attn(heads(na_q, NA_HEADS), heads(na_k, NA_HEADS), heads(na_v, NA_HEADS),
                            kac, vac, p['na_rpb'])
    qb = axial_rope(rms_norm(heads(gq_q, GQA_HEADS), p['gqa_q_norm']), row, col)
    kb = axial_rope(rms_norm(heads(gq_k, GQA_KV_HEADS), p['gqa_k_norm']), row, col)
    o_b = dense_blocks(group(qb, GQA_KV_HEADS), cat(kb, kbc), cat(heads(gq_v, GQA_KV_HEADS), vbc))
    qc = axial_rope(heads(sw_q, SWA_HEADS), row, col)
    kc = axial_rope(heads(sw_k, SWA_KV_HEADS), row, col)
    o_c = window_attn(group(qc, SWA_KV_HEADS), kc, heads(sw_v, SWA_KV_HEADS), kcc, vcc, sink)
    qd = mla_q(ml_cq, p, row, col)
    kd, vd = mla_kv(ml_ckv, ml_kr, p, row, col)
    o_d = dense_blocks(qd[:, :, :, None], cat(kd, kdc), cat(vd, vdc))
    y = merge_branches((o_a, o_b, o_c, o_d), gates, p)
    if not need_ctx:
        return y, None

    oc_a = attend(heads(nac_q, NA_HEADS)[:, :, :, None], kac, vac)
    oc_b = attend(group(rms_norm(heads(gqc_q, GQA_HEADS), p['gqa_q_norm']), GQA_KV_HEADS), kbc, vbc)
    oc_c = attend(group(heads(swc_q, SWA_HEADS), SWA_KV_HEADS), kcc, vcc, sink)
    oc_d = attend(mla_q(mlc_cq, p)[:, :, :, None], kdc, vdc)
    yc = merge_branches((oc_a, oc_b, oc_c, oc_d), gates_c, p)
    return y, yc


def expert_choice_ffn(h, w_router, w_gate, w_up, w_down):
    B, n, D = h.shape
    cap = CAPACITY * n // N_EXPERTS
    aff = jax.nn.softmax((h @ w_router).astype(jnp.float32), axis=-1)
    g, idx = lax.top_k(jnp.swapaxes(aff, 1, 2), cap)
    xg = jax.vmap(lambda hb, ib: hb[ib])(h, idx)
    a = jnp.einsum('becd,edf->becf', xg, w_gate)
    u = jnp.einsum('becd,edf->becf', xg, w_up)
    out = jnp.einsum('becf,efd->becd', jax.nn.silu(a) * u, w_down) * g[..., None].astype(h.dtype)
    return jax.vmap(lambda ob, ib: jnp.zeros((n, D), ob.dtype).at[ib.reshape(-1)].add(ob.reshape(-1, D)))(out, idx)


def hybrid_layer(x, xc, mod, mod_c, row, col, p, need_ctx):
    sh_a, sc_a, g_a, sh_f, sc_f, g_f = jnp.split(mod, N_MOD, axis=-1)
    shc_a, scc_a, gc_a, shc_f, scc_f, gc_f = jnp.split(mod_c, N_MOD, axis=-1)
    h = modulate(x, sh_a[:, None], sc_a[:, None])
    hc = modulate(xc, shc_a, scc_a)
    y, yc = token_mixers(h, hc, row, col, p, need_ctx)
    x = layer_norm(DEEPNORM_ALPHA * x + g_a[:, None] * y, p['ln1_g'], p['ln1_b'])
    h = modulate(x, sh_f[:, None], sc_f[:, None])
    y = expert_choice_ffn(h, p['w_router'], p['w_gate'], p['w_up'], p['w_down'])
    x = layer_norm(DEEPNORM_ALPHA * x + g_f[:, None] * y, p['ln2_g'], p['ln2_b'])
    if need_ctx:
        xc = layer_norm(DEEPNORM_ALPHA * xc + gc_a * yc, p['ln1_g'], p['ln1_b'])
        hc = modulate(xc, shc_f, scc_f)
        yc = expert_choice_ffn(hc, p['w_router'], p['w_gate'], p['w_up'], p['w_down'])
        xc = layer_norm(DEEPNORM_ALPHA * xc + gc_f * yc, p['ln2_g'], p['ln2_b'])
    return x, xc


def setup_inputs(seed: int = 0) -> dict:
    key = jax.random.key(seed)
    ks = jax.random.split(key, 25)

    def nrm(k, shape, scale):
        return jax.random.normal(k, shape, jnp.float32) * scale

    L, D = DEPTH, D_MODEL
    return {
        'x': nrm(ks[0], (BATCH, SEQ, D), 1.0),
        'c': nrm(ks[1], (BATCH, D), 1.0),
        'ctx': nrm(ks[2], (BATCH, CTX_LEN, D), 1.0),
        'c_ctx': nrm(ks[3], (D,), 1.0),
        'w_mod': nrm(ks[4], (L, D, N_MOD * D), 0.5 * D ** -0.5),
        'b_mod': nrm(ks[5], (L, N_MOD * D), 0.02),
        'w_in': nrm(ks[6], (L, D, IN_WIDTH), D ** -0.5),
        'na_rpb': nrm(ks[7], (L, NA_HEADS, 2 * NA_KH - 1, 2 * NA_KW - 1), 0.1),
        'gqa_q_norm': 1.0 + nrm(ks[8], (L, HEAD_DIM), 0.02),
        'gqa_k_norm': 1.0 + nrm(ks[9], (L, HEAD_DIM), 0.02),
        'swa_sink': nrm(ks[10], (L, SWA_HEADS), 0.5),
        'mla_q_norm': 1.0 + nrm(ks[11], (L, MLA_Q_LORA), 0.02),
        'mla_kv_norm': 1.0 + nrm(ks[12], (L, MLA_KV_LORA), 0.02),
        'mla_w_qb': nrm(ks[13], (L, MLA_Q_LORA, MLA_HEADS * (MLA_NOPE + MLA_ROPE)), MLA_Q_LORA ** -0.5),
        'mla_w_kvb': nrm(ks[14], (L, MLA_KV_LORA, MLA_HEADS * (MLA_NOPE + MLA_V)), MLA_KV_LORA ** -0.5),
        'w_branch': nrm(ks[15], (L, N_BRANCH, BRANCH_W, D), BRANCH_W ** -0.5),
        'w_out': nrm(ks[16], (L, D, D), DEEPNORM_BETA * D ** -0.5),
        'ln1_g': 1.0 + nrm(ks[17], (L, D), 0.02),
        'ln1_b': nrm(ks[18], (L, D), 0.02),
        'ln2_g': 1.0 + nrm(ks[19], (L, D), 0.02),
        'ln2_b': nrm(ks[20], (L, D), 0.02),
        'w_router': nrm(ks[21], (L, D, N_EXPERTS), D ** -0.5),
        'w_gate': nrm(ks[22], (L, N_EXPERTS, D, EXPERT_FF), D ** -0.5),
        'w_up': nrm(ks[23], (L, N_EXPERTS, D, EXPERT_FF), D ** -0.5),
        'w_down': nrm(ks[24], (L, N_EXPERTS, EXPERT_FF, D), DEEPNORM_BETA * EXPERT_FF ** -0.5),
    }


def reference(x, c, ctx, c_ctx, w_mod, b_mod, w_in, na_rpb, gqa_q_norm, gqa_k_norm, swa_sink,
              mla_q_norm, mla_kv_norm, mla_w_qb, mla_w_kvb, w_branch, w_out,
              ln1_g, ln1_b, ln2_g, ln2_b, w_router, w_gate, w_up, w_down):
    n = x.shape[1]
    pos = jnp.arange(n, dtype=jnp.int32)
    row = (pos // GRID_W).astype(jnp.float32)
    col = (pos % GRID_W).astype(jnp.float32)
    xc = ctx
    for l in range(DEPTH):
        p = {
            'w_in': w_in[l], 'na_rpb': na_rpb[l],
            'gqa_q_norm': gqa_q_norm[l], 'gqa_k_norm': gqa_k_norm[l], 'swa_sink': swa_sink[l],
            'mla_q_norm': mla_q_norm[l], 'mla_kv_norm': mla_kv_norm[l],
            'mla_w_qb': mla_w_qb[l], 'mla_w_kvb': mla_w_kvb[l],
            'w_branch': w_branch[l], 'w_out': w_out[l],
            'ln1_g': ln1_g[l], 'ln1_b': ln1_b[l], 'ln2_g': ln2_g[l], 'ln2_b': ln2_b[l],
            'w_router': w_router[l], 'w_gate': w_gate[l], 'w_up': w_up[l], 'w_down': w_down[l],
        }
        mod = jax.nn.silu(c) @ w_mod[l] + b_mod[l]
        mod_c = jax.nn.silu(c_ctx) @ w_mod[l] + b_mod[l]
        x, xc = hybrid_layer(x, xc, mod, mod_c, row, col, p, l < DEPTH - 1)
    return x
```

```cpp
#include <hip/hip_runtime.h>
#include <hip/hip_bf16.h>
#include <stdint.h>
#include <stdio.h>

namespace {
constexpr int D = 1024, SEQ = 8192, CTX = 256, NB = 4, NL = 2, HD = 64;
constexpr int GW = 64, GROWS = 128;
constexpr int ZW = 6240;
constexpr int NAQ = 0, NAK = 256, NAV = 512, GQ = 768, GK = 1024, GV = 1152, SQ = 1280, SK = 1536, SV = 1664,
              MCQ = 1792, MCKV = 1984, MKR = 2112, GATE = 2144;
constexpr int NE = 16, FF = 1024, CAP = 1024, CAPC = 32;
constexpr int MODW = 6 * D;
constexpr float EPS = 1e-6f;
constexpr float ALPHA = 1.4142135623730951f;

struct T {
    unsigned short u;
    __device__ __forceinline__ operator float() const { return __uint_as_float((unsigned)u << 16); }
    __device__ __forceinline__ T& operator=(float f) { unsigned b = __float_as_uint(f); b += 0x7fffu + ((b >> 16) & 1u); u = (unsigned short)(b >> 16); return *this; }
};
__device__ __forceinline__ float4 ld4(const float* p) { return *(const float4*)p; }
__device__ __forceinline__ float4 ld4(const T* p) { uint2 r = *(const uint2*)p; return make_float4(__uint_as_float(r.x << 16), __uint_as_float(r.x & 0xffff0000u), __uint_as_float(r.y << 16), __uint_as_float(r.y & 0xffff0000u)); }
__device__ __forceinline__ unsigned pk2(float lo, float hi) { T a, b; a = lo; b = hi; return (unsigned)a.u | ((unsigned)b.u << 16); }
__device__ __forceinline__ void st4(float* p, float4 v) { *(float4*)p = v; }
__device__ __forceinline__ void st4(T* p, float4 v) { *(uint2*)p = make_uint2(pk2(v.x, v.y), pk2(v.z, v.w)); }
__device__ __forceinline__ float ldf(const float* p) { return *p; }
__device__ __forceinline__ float ldf(const T* p) { return (float)*p; }
__device__ __forceinline__ void stf(float* p, float v) { *p = v; }
__device__ __forceinline__ void stf(T* p, float v) { *p = v; }

struct Pass { int nbp, b0, nlat, nctx, nrow; };

__device__ __forceinline__ float wave_sum(float v) {
#pragma unroll
    for (int o = 32; o > 0; o >>= 1) v += __shfl_xor(v, o);
    return v;
}

__global__ void __launch_bounds__(256) k_mod(const float* __restrict__ c, const float* __restrict__ c_ctx, const float* __restrict__ w_mod,
                                             const float* __restrict__ b_mod, float* __restrict__ modv) {
    __shared__ float sc[5][1024];
    __shared__ float red[4][5][64];
    const int l = blockIdx.y, lane = threadIdx.x & 63, kg = threadIdx.x >> 6, j = blockIdx.x * 64 + lane;
    for (int i = threadIdx.x; i < 5 * 1024; i += 256) { int s = i >> 10, k = i & 1023; float v = s < 4 ? c[s * 1024 + k] : c_ctx[k]; sc[s][k] = v / (1.f + expf(-v)); }
    __syncthreads();
    float acc[5] = {0.f, 0.f, 0.f, 0.f, 0.f};
    const float* w = w_mod + (size_t)l * D * MODW + j;
    for (int k = kg * 256; k < kg * 256 + 256; ++k) { float wv = w[(size_t)k * MODW];
#pragma unroll
        for (int s = 0; s < 5; ++s) acc[s] += sc[s][k] * wv; }
#pragma unroll
    for (int s = 0; s < 5; ++s) red[kg][s][lane] = acc[s];
    __syncthreads();
    if (kg == 0) {
#pragma unroll
        for (int s = 0; s < 5; ++s) modv[((size_t)l * 5 + s) * MODW + j] = red[0][s][lane] + red[1][s][lane] + red[2][s][lane] + red[3][s][lane] + b_mod[l * MODW + j];
    }
}

__global__ void k_ropetab(float2* tab64, float2* tab32) {
    int t = blockIdx.x * blockDim.x + threadIdx.x;
    if (t < 128 * 16) { int pos = t / 16, i = t % 16; float f = powf(10000.f, -(float)i / 16.f); float a = (float)pos * f; tab64[t] = make_float2(cosf(a), sinf(a)); }
    if (t < 128 * 8) { int pos = t / 8, i = t % 8; float f = powf(10000.f, -(float)i / 8.f); float a = (float)pos * f; tab32[t] = make_float2(cosf(a), sinf(a)); }
}

__global__ void __launch_bounds__(256) k_lnmod(const float* __restrict__ xlat, const float* __restrict__ xctx, const float* __restrict__ modl,
                                               int sh_off, int sc_off, T* __restrict__ H, Pass P) {
    const int row = blockIdx.x * 4 + (threadIdx.x >> 6), lane = threadIdx.x & 63;
    if (row >= P.nrow) return;
    const float* src = row < P.nlat ? xlat + (size_t)row * D : xctx + (size_t)(row - P.nlat) * D;
    const int s = row < P.nlat ? P.b0 + row / SEQ : 4;
    const float* mv = modl + (size_t)s * MODW;
    float4 v[4]; float sum = 0.f;
#pragma unroll
    for (int i = 0; i < 4; ++i) { v[i] = *(const float4*)(src + i * 256 + lane * 4); sum += v[i].x + v[i].y + v[i].z + v[i].w; }
    const float mean = wave_sum(sum) * (1.f / D);
    float sq = 0.f;
#pragma unroll
    for (int i = 0; i < 4; ++i) { float a = v[i].x - mean, b = v[i].y - mean, c = v[i].z - mean, d = v[i].w - mean; sq += a * a + b * b + c * c + d * d; }
    const float rstd = 1.f / sqrtf(wave_sum(sq) * (1.f / D) + EPS);
#pragma unroll
    for (int i = 0; i < 4; ++i) {
        const int col = i * 256 + lane * 4;
        float4 sh = *(const float4*)(mv + sh_off + col), sc = *(const float4*)(mv + sc_off + col), o;
        o.x = (v[i].x - mean) * rstd * (1.f + sc.x) + sh.x; o.y = (v[i].y - mean) * rstd * (1.f + sc.y) + sh.y;
        o.z = (v[i].z - mean) * rstd * (1.f + sc.z) + sh.z; o.w = (v[i].w - mean) * rstd * (1.f + sc.w) + sh.w;
        st4(H + (size_t)row * D + col, o);
    }
}

struct GemmArgs {
    const T* A; int lda; const int* aidx; long long a_zs, aidx_zs;
    const float* B; int ldb; long long b_zs;
    T* C; int ldc; long long c_zs;
    const void* E; int lde; long long e_zs;
    int M, N, K, accum, zdiv;
};
template <int MODE> __global__ void __launch_bounds__(256) k_sgemm(GemmArgs g) {
    __shared__ float As[8][128 + 4];
    __shared__ float Bs[8][128 + 4];
    const int z = blockIdx.z, tid = threadIdx.x;
    const T* A = g.A + (size_t)z * g.a_zs; const float* B = g.B + (size_t)(z % g.zdiv) * g.b_zs; T* C = g.C + (size_t)z * g.c_zs;
    const int* aidx = g.aidx ? g.aidx + (size_t)z * g.aidx_zs : nullptr;
    const int m0 = blockIdx.y * 128, n0 = blockIdx.x * 128;
    const int tx = tid & 15, ty = tid >> 4;
    float acc[8][8];
#pragma unroll
    for (int i = 0; i < 8; ++i)
#pragma unroll
        for (int j = 0; j < 8; ++j) acc[i][j] = 0.f;
    const int ar = tid >> 1, ak = (tid & 1) * 4, bk = tid >> 5, bn = (tid & 31) * 4;
    const bool arow_ok = (m0 + ar) < g.M;
    size_t arow = 0; if (arow_ok) arow = aidx ? (size_t)aidx[m0 + ar] : (size_t)(m0 + ar);
    const T* ap = A + arow * g.lda + ak;
    for (int k0 = 0; k0 < g.K; k0 += 8) {
        float4 av = arow_ok ? ld4(ap + k0) : make_float4(0.f, 0.f, 0.f, 0.f);
        float4 bv = make_float4(0.f, 0.f, 0.f, 0.f);
        { const float* bp = B + (size_t)(k0 + bk) * g.ldb + n0 + bn;
          if (n0 + bn + 3 < g.N) bv = *(const float4*)bp;
          else { if (n0 + bn < g.N) bv.x = bp[0]; if (n0 + bn + 1 < g.N) bv.y = bp[1]; if (n0 + bn + 2 < g.N) bv.z = bp[2]; } }
        __syncthreads();
        As[ak + 0][ar] = av.x; As[ak + 1][ar] = av.y; As[ak + 2][ar] = av.z; As[ak + 3][ar] = av.w;
        *(float4*)&Bs[bk][bn] = bv;
        __syncthreads();
#pragma unroll
        for (int k = 0; k < 8; ++k) {
            float a[8], b[8];
            *(float4*)&a[0] = *(const float4*)&As[k][ty * 8]; *(float4*)&a[4] = *(const float4*)&As[k][ty * 8 + 4];
            *(float4*)&b[0] = *(const float4*)&Bs[k][tx * 8]; *(float4*)&b[4] = *(const float4*)&Bs[k][tx * 8 + 4];
#pragma unroll
            for (int i = 0; i < 8; ++i)
#pragma unroll
                for (int j = 0; j < 8; ++j) acc[i][j] += a[i] * b[j];
        }
    }
    const T* ET = (const T*)g.E + (size_t)z * g.e_zs; const float* EF = (const float*)g.E + (size_t)z * g.e_zs;
#pragma unroll
    for (int i = 0; i < 8; ++i) {
        const int r = m0 + ty * 8 + i; if (r >= g.M) continue;
#pragma unroll
        for (int j = 0; j < 8; ++j) {
            const int cc = n0 + tx * 8 + j; if (cc >= g.N) continue;
            float v = acc[i][j]; T* cp = C + (size_t)r * g.ldc + cc;
            if (MODE == 2) { float gt = ET[(size_t)r * g.lde + cc]; v *= gt; if (g.accum) v += (float)*cp; }
            if (MODE == 3) { float a = ET[(size_t)r * g.lde + cc]; v *= a / (1.f + expf(-a)); }
            if (MODE == 4) { v *= EF[r]; }
            *cp = v;
        }
    }
}

__global__ void __launch_bounds__(256) k_zpost(T* __restrict__ Z, const float* __restrict__ gqn, const float* __restrict__ gkn,
                                               const float* __restrict__ mqn, const float* __restrict__ mkvn,
                                               const float2* __restrict__ tab64, const float2* __restrict__ tab32, Pass P) {
    const int row = blockIdx.x * 4 + (threadIdx.x >> 6), lane = threadIdx.x & 63;
    if (row >= P.nrow) return;
    const bool lat = row < P.nlat;
    const int t = lat ? row % SEQ : 0, gr = t / GW, gc = t % GW;
    T* z = Z + (size_t)row * ZW;
    float2 cs64 = make_float2(1.f, 0.f);
    if (lat) cs64 = tab64[((lane & 32) ? gc : gr) * 16 + (lane & 15)];
    const bool hi = lane & 16;
    for (int h = 0; h < 6; ++h) {
        T* p = z + (h < 4 ? GQ + h * 64 : GK + (h - 4) * 64);
        float v = p[lane];
        float ms = wave_sum(v * v) * (1.f / 64.f);
        v = v * (1.f / sqrtf(ms + EPS)) * (h < 4 ? gqn[lane] : gkn[lane]);
        float pv = __shfl_xor(v, 16);
        float o = hi ? (pv * cs64.y + v * cs64.x) : (v * cs64.x - pv * cs64.y);
        p[lane] = o;
    }
    if (lat) for (int h = 0; h < 6; ++h) {
        T* p = z + (h < 4 ? SQ + h * 64 : SK + (h - 4) * 64);
        float v = p[lane]; float pv = __shfl_xor(v, 16);
        p[lane] = hi ? (pv * cs64.y + v * cs64.x) : (v * cs64.x - pv * cs64.y);
    }
    if (lat) {
        float v = z[MKR + (lane & 31)]; float pv = __shfl_xor(v, 8);
        float2 cs = tab32[((lane & 16) ? gc : gr) * 8 + (lane & 7)];
        float o = (lane & 8) ? (pv * cs.y + v * cs.x) : (v * cs.x - pv * cs.y);
        if (lane < 32) z[MKR + lane] = o;
    }
    { float a = z[MCQ + lane], b = z[MCQ + 64 + lane], c = z[MCQ + 128 + lane];
      float r = 1.f / sqrtf(wave_sum(a * a + b * b + c * c) * (1.f / 192.f) + EPS);
      z[MCQ + lane] = a * r * mqn[lane]; z[MCQ + 64 + lane] = b * r * mqn[64 + lane]; z[MCQ + 128 + lane] = c * r * mqn[128 + lane]; }
    { float a = z[MCKV + lane], b = z[MCKV + 64 + lane];
      float r = 1.f / sqrtf(wave_sum(a * a + b * b) * (1.f / 128.f) + EPS);
      z[MCKV + lane] = a * r * mkvn[lane]; z[MCKV + 64 + lane] = b * r * mkvn[64 + lane]; }
}
__global__ void __launch_bounds__(256) k_mlaq_rope(T* __restrict__ QM, const float2* __restrict__ tab32, Pass P) {
    const int row = blockIdx.x * 4 + (threadIdx.x >> 6), lane = threadIdx.x & 63;
    if (row >= P.nlat) return;
    const int t = row % SEQ, gr = t / GW, gc = t % GW;
    const int d = lane & 31;
    float2 cs = tab32[((d & 16) ? gc : gr) * 8 + (d & 7)];
#pragma unroll
    for (int j = 0; j < 2; ++j) {
        const int h = (lane >> 5) + 2 * j;
        T* p = QM + (size_t)row * 384 + h * 96 + 64;
        float v = p[d]; float pv = __shfl_xor(v, 8);
        p[d] = (d & 8) ? (pv * cs.y + v * cs.x) : (v * cs.x - pv * cs.y);
    }
}

struct AttnArgs { const T* Z; const T* QM; const T* KVM; T* O; const float* rpb; const float* sink; Pass P; int ctxq; };
template <int BR> __global__ void __launch_bounds__(256) k_attn(AttnArgs a) {
    constexpr int DQ = (BR == 3) ? 96 : 64;
    constexpr int KT = 32;
    __shared__ float Ks[KT][DQ];
    __shared__ float Vs[KT][64];
    const int tid = threadIdx.x, h = blockIdx.y, bl = blockIdx.z;
    const Pass P = a.P;
    const int tq = blockIdx.x * 256 + tid;
    const size_t qrow = a.ctxq ? (size_t)P.nlat + (size_t)bl * CTX + tq : (size_t)bl * SEQ + tq;
    const size_t lat0 = (size_t)bl * SEQ, ctx0 = (size_t)P.nlat + (size_t)bl * CTX;
    const int kvh = (BR == 1 || BR == 2) ? (h >> 1) : h;
    const float scale = (BR == 3) ? 0.10206207261596575f : 0.125f;
    float q[DQ];
    if (BR == 3) { const T* qp = a.QM + qrow * 384 + h * 96;
#pragma unroll
        for (int d = 0; d < 96; ++d) q[d] = qp[d] * scale; }
    else { const int qoff = (BR == 0 ? NAQ : BR == 1 ? GQ : SQ) + h * 64; const T* qp = a.Z + qrow * ZW + qoff;
#pragma unroll
        for (int d = 0; d < 64; ++d) q[d] = qp[d] * scale; }
    float o[64];
#pragma unroll
    for (int d = 0; d < 64; ++d) o[d] = 0.f;
    float m = -INFINITY, l = 0.f;
    int k_lo = 0, k_hi = 0;
    const int q0 = blockIdx.x * 256;
    if (!a.ctxq) {
        if (BR == 0) { int r0 = q0 / GW; int lo = min(max(r0 - 4, 0), GROWS - 8), hi2 = min(max(r0 + 3 - 4, 0), GROWS - 8) + 8; k_lo = lo * GW; k_hi = hi2 * GW; }
        else if (BR == 2) { k_lo = max(q0 - 128, 0); k_hi = min(q0 + 256 + 128, SEQ); }
        else { k_lo = 0; k_hi = SEQ; }
    }
    const int qr = tq / GW, qc = tq % GW;
    const int krow0 = min(max(qr - 4, 0), GROWS - 8), kcol0 = min(max(qc - 8, 0), GW - 16);
    const int nlatk = k_hi - k_lo;
    const int ntile = (nlatk + KT - 1) / KT + CTX / KT;
    for (int it = 0; it < ntile; ++it) {
        const bool isctx = it >= (nlatk + KT - 1) / KT;
        const int kbase = isctx ? (it - (nlatk + KT - 1) / KT) * KT : k_lo + it * KT;
        const int kcnt = isctx ? KT : min(KT, k_hi - kbase);
        __syncthreads();
        for (int i = tid; i < KT * DQ; i += 256) { int kk = i / DQ, d = i % DQ; float v = 0.f;
            if (kk < kcnt) { size_t kr = (isctx ? ctx0 : lat0) + kbase + kk;
                if (BR == 3) v = d < 64 ? a.KVM[kr * 512 + h * 128 + d] : a.Z[kr * ZW + MKR + (d - 64)];
                else v = a.Z[kr * ZW + (BR == 0 ? NAK : BR == 1 ? GK : SK) + kvh * 64 + d]; }
            Ks[kk][d] = v; }
        for (int i = tid; i < KT * 64; i += 256) { int kk = i / 64, d = i % 64; float v = 0.f;
            if (kk < kcnt) { size_t kr = (isctx ? ctx0 : lat0) + kbase + kk;
                if (BR == 3) v = a.KVM[kr * 512 + h * 128 + 64 + d];
                else v = a.Z[kr * ZW + (BR == 0 ? NAV : BR == 1 ? GV : SV) + kvh * 64 + d]; }
            Vs[kk][d] = v; }
        __syncthreads();
        for (int kk = 0; kk < kcnt; ++kk) {
            bool valid = true; float bias = 0.f;
            if (!isctx) {
                const int tk = kbase + kk;
                if (BR == 0) { const int kr = tk / GW, kc = tk % GW;
                    valid = (kr >= krow0) && (kr < krow0 + 8) && (kc >= kcol0) && (kc < kcol0 + 16);
                    if (valid) { int dr = kr - qr + 7; int dc = min(max(kc - qc, -15), 15) + 15; bias = a.rpb[(h * 15 + dr) * 31 + dc]; } }
                if (BR == 2) { int dd = tk - tq; valid = (dd <= 128) && (dd >= -128); }
            }
            if (valid) {
                float s = bias;
#pragma unroll
                for (int d = 0; d < DQ; ++d) s += q[d] * Ks[kk][d];
                if (s > m) { float f = expf(m - s); l *= f;
#pragma unroll
                    for (int d = 0; d < 64; ++d) o[d] *= f;
                    m = s; }
                const float p = expf(s - m); l += p;
#pragma unroll
                for (int d = 0; d < 64; ++d) o[d] += p * Vs[kk][d];
            }
        }
    }
    if (BR == 2) { const float sk = a.sink[h]; const float m2 = fmaxf(m, sk); const float f = expf(m - m2); l = l * f + expf(sk - m2);
#pragma unroll
        for (int d = 0; d < 64; ++d) o[d] *= f; }
    const float inv = 1.f / l;
    T* op = a.O + qrow * D + BR * 256 + h * 64;
#pragma unroll
    for (int d = 0; d < 64; ++d) op[d] = o[d] * inv;
}

struct LnResArgs { const float* xlat; const float* xctx; const T* Y; const float* modl; int g_off, sh_off, sc_off;
                   const float* lg; const float* lb; float* olat; float* octx; T* H2; const float* wr; float* aff; Pass P; int nrows; };
__global__ void __launch_bounds__(256) k_lnres(LnResArgs a) {
    const int row = blockIdx.x * 4 + (threadIdx.x >> 6), lane = threadIdx.x & 63;
    if (row >= a.nrows) return;
    const Pass P = a.P;
    const bool lat = row < P.nlat;
    const float* xs = lat ? a.xlat + (size_t)row * D : a.xctx + (size_t)(row - P.nlat) * D;
    float* xo = lat ? a.olat + (size_t)row * D : a.octx + (size_t)(row - P.nlat) * D;
    const int s = lat ? P.b0 + row / SEQ : 4;
    const float* mv = a.modl + (size_t)s * MODW;
    const T* yp = a.Y + (size_t)row * D;
    float v[16]; float sum = 0.f;
#pragma unroll
    for (int i = 0; i < 4; ++i) {
        const int col = i * 256 + lane * 4;
        float4 x4 = *(const float4*)(xs + col), y4 = ld4(yp + col), g4 = *(const float4*)(mv + a.g_off + col);
        v[i * 4 + 0] = ALPHA * x4.x + g4.x * y4.x; v[i * 4 + 1] = ALPHA * x4.y + g4.y * y4.y; v[i * 4 + 2] = ALPHA * x4.z + g4.z * y4.z; v[i * 4 + 3] = ALPHA * x4.w + g4.w * y4.w;
        sum += v[i * 4] + v[i * 4 + 1] + v[i * 4 + 2] + v[i * 4 + 3];
    }
    const float mean = wave_sum(sum) * (1.f / D);
    float sq = 0.f;
#pragma unroll
    for (int i = 0; i < 16; ++i) { float d = v[i] - mean; sq += d * d; }
    const float rstd = 1.f / sqrtf(wave_sum(sq) * (1.f / D) + EPS);
    float x1[16];
#pragma unroll
    for (int i = 0; i < 4; ++i) {
        const int col = i * 256 + lane * 4;
        float4 lg = *(const float4*)(a.lg + col), lb = *(const float4*)(a.lb + col);
        x1[i * 4 + 0] = (v[i * 4 + 0] - mean) * rstd * lg.x + lb.x; x1[i * 4 + 1] = (v[i * 4 + 1] - mean) * rstd * lg.y + lb.y;
        x1[i * 4 + 2] = (v[i * 4 + 2] - mean) * rstd * lg.z + lb.z; x1[i * 4 + 3] = (v[i * 4 + 3] - mean) * rstd * lg.w + lb.w;
        *(float4*)(xo + col) = make_float4(x1[i * 4], x1[i * 4 + 1], x1[i * 4 + 2], x1[i * 4 + 3]);
    }
    if (!a.H2) return;
    float s2 = 0.f;
#pragma unroll
    for (int i = 0; i < 16; ++i) s2 += x1[i];
    const float mean2 = wave_sum(s2) * (1.f / D);
    float sq2 = 0.f;
#pragma unroll
    for (int i = 0; i < 16; ++i) { float d = x1[i] - mean2; sq2 += d * d; }
    const float rstd2 = 1.f / sqrtf(wave_sum(sq2) * (1.f / D) + EPS);
    float h2[16];
#pragma unroll
    for (int i = 0; i < 4; ++i) {
        const int col = i * 256 + lane * 4;
        float4 sh = *(const float4*)(mv + a.sh_off + col), sc = *(const float4*)(mv + a.sc_off + col);
        h2[i * 4 + 0] = (x1[i * 4 + 0] - mean2) * rstd2 * (1.f + sc.x) + sh.x; h2[i * 4 + 1] = (x1[i * 4 + 1] - mean2) * rstd2 * (1.f + sc.y) + sh.y;
        h2[i * 4 + 2] = (x1[i * 4 + 2] - mean2) * rstd2 * (1.f + sc.z) + sh.z; h2[i * 4 + 3] = (x1[i * 4 + 3] - mean2) * rstd2 * (1.f + sc.w) + sh.w;
        st4(a.H2 + (size_t)row * D + col, make_float4(h2[i * 4], h2[i * 4 + 1], h2[i * 4 + 2], h2[i * 4 + 3]));
    }
    float lg[16];
#pragma unroll
    for (int e = 0; e < 16; ++e) lg[e] = 0.f;
#pragma unroll
    for (int i = 0; i < 4; ++i)
#pragma unroll
        for (int j = 0; j < 4; ++j) {
            const int col = i * 256 + lane * 4 + j; const float hv = h2[i * 4 + j];
            const float4* wp = (const float4*)(a.wr + (size_t)col * NE);
            float4 w0 = wp[0], w1 = wp[1], w2 = wp[2], w3 = wp[3];
            lg[0] += hv * w0.x; lg[1] += hv * w0.y; lg[2] += hv * w0.z; lg[3] += hv * w0.w; lg[4] += hv * w1.x; lg[5] += hv * w1.y; lg[6] += hv * w1.z; lg[7] += hv * w1.w;
            lg[8] += hv * w2.x; lg[9] += hv * w2.y; lg[10] += hv * w2.z; lg[11] += hv * w2.w; lg[12] += hv * w3.x; lg[13] += hv * w3.y; lg[14] += hv * w3.z; lg[15] += hv * w3.w;
        }
    float mx = -INFINITY;
#pragma unroll
    for (int e = 0; e < 16; ++e) { lg[e] = wave_sum(lg[e]); mx = fmaxf(mx, lg[e]); }
    float den = 0.f;
#pragma unroll
    for (int e = 0; e < 16; ++e) { lg[e] = expf(lg[e] - mx); den += lg[e]; }
    if (lane < 16) { float val = 0.f;
#pragma unroll
        for (int e = 0; e < 16; ++e) if (lane == e) val = lg[e];
        a.aff[(size_t)row * NE + lane] = val / den; }
}

struct TopkArgs { const float* aff; int* idx; float* gatev; int* inv; Pass P; };
__global__ void __launch_bounds__(256) k_topk(TopkArgs a) {
    __shared__ unsigned keys[SEQ];
    __shared__ unsigned hist[2048];
    __shared__ unsigned part[256];
    __shared__ unsigned sh_bin, sh_rem;
    __shared__ unsigned wtot[2][4];
    const int tid = threadIdx.x, lane = tid & 63, wv = tid >> 6;
    const int e = blockIdx.x, bl = blockIdx.y, kind = blockIdx.z;
    const Pass P = a.P;
    const int n = kind ? CTX : SEQ, kk = kind ? CAPC : CAP;
    const size_t row0 = kind ? (size_t)P.nlat + (size_t)bl * CTX : (size_t)bl * SEQ;
    const size_t grp = kind ? (size_t)P.nbp * NE * CAP + ((size_t)bl * NE + e) * CAPC : ((size_t)bl * NE + e) * CAP;
    for (int i = tid; i < n; i += 256) keys[i] = __float_as_uint(a.aff[(row0 + i) * NE + e]);
    __syncthreads();
    unsigned prefix = 0, rem = kk;
    for (int pass = 0; pass < 3; ++pass) {
        const int shift = pass == 0 ? 21 : pass == 1 ? 10 : 0;
        const int nb = pass == 2 ? 1024 : 2048;
        const int hshift = pass == 0 ? 32 : pass == 1 ? 21 : 10;
        for (int i = tid; i < 2048; i += 256) hist[i] = 0;
        __syncthreads();
        for (int i = tid; i < n; i += 256) { unsigned k = keys[i]; bool match = (pass == 0) || ((k >> hshift) == prefix); if (match) atomicAdd(&hist[(k >> shift) & (nb - 1)], 1u); }
        __syncthreads();
        unsigned loc = 0;
        for (int j = 0; j < 8; ++j) loc += hist[tid * 8 + j];
        part[tid] = loc;
        __syncthreads();
        unsigned above = 0;
        for (int j = tid + 1; j < 256; ++j) above += part[j];
        if (above < rem && above + loc >= rem) {
            unsigned cum = above; int b = tid * 8 + 7;
            for (; b >= tid * 8; --b) { unsigned hcnt = hist[b]; if (cum + hcnt >= rem) break; cum += hcnt; }
            sh_bin = (unsigned)b; sh_rem = rem - cum;
        }
        __syncthreads();
        prefix = (pass == 0) ? sh_bin : ((prefix << (pass == 1 ? 11 : 10)) | sh_bin);
        rem = sh_rem;
        __syncthreads();
    }
    const unsigned Tkey = prefix;
    unsigned base_gt = 0, base_eq = 0;
    for (int c0 = 0; c0 < n; c0 += 256) {
        const int i = c0 + tid;
        const unsigned k = keys[i];
        const bool gt = k > Tkey, eq = k == Tkey;
        const unsigned long long mg = __ballot(gt), me = __ballot(eq);
        const unsigned long long lt = (1ull << lane) - 1ull;
        if (lane == 0) { wtot[0][wv] = __popcll(mg); wtot[1][wv] = __popcll(me); }
        __syncthreads();
        unsigned pg = base_gt + __popcll(mg & lt), pe = base_eq + __popcll(me & lt);
        for (int w = 0; w < wv; ++w) { pg += wtot[0][w]; pe += wtot[1][w]; }
        const bool sel = gt || (eq && pe < rem);
        const unsigned slot = pg + min(pe, rem);
        if (sel) { a.idx[grp + slot] = (int)(row0 + i); a.gatev[grp + slot] = __uint_as_float(k); }
        a.inv[(row0 + i) * NE + e] = sel ? (int)slot : -1;
        base_gt += wtot[0][0] + wtot[0][1] + wtot[0][2] + wtot[0][3];
        base_eq += wtot[1][0] + wtot[1][1] + wtot[1][2] + wtot[1][3];
        __syncthreads();
    }
}

struct CombArgs { const float* xlat; const float* xctx; const T* OUT; const int* inv; const float* modl; int g_off; const float* lg; const float* lb;
                  float* olat; float* octx; Pass P; int nrows; };
__global__ void __launch_bounds__(256) k_combine(CombArgs a) {
    const int row = blockIdx.x * 4 + (threadIdx.x >> 6), lane = threadIdx.x & 63;
    if (row >= a.nrows) return;
    const Pass P = a.P;
    const bool lat = row < P.nlat;
    const float* xs = lat ? a.xlat + (size_t)row * D : a.xctx + (size_t)(row - P.nlat) * D;
    float* xo = lat ? a.olat + (size_t)row * D : a.octx + (size_t)(row - P.nlat) * D;
    const int bl = lat ? row / SEQ : (row - P.nlat) / CTX;
    const int s = lat ? P.b0 + bl : 4;
    const float* mv = a.modl + (size_t)s * MODW;
    float y[16];
#pragma unroll
    for (int i = 0; i < 16; ++i) y[i] = 0.f;
    for (int e = 0; e < NE; ++e) {
        const int sl = a.inv[(size_t)row * NE + e];
        if (sl < 0) continue;
        const size_t orow = lat ? ((size_t)bl * NE + e) * CAP + sl : (size_t)P.nbp * NE * CAP + ((size_t)bl * NE + e) * CAPC + sl;
        const T* op = a.OUT + orow * D;
#pragma unroll
        for (int i = 0; i < 4; ++i) { float4 o4 = ld4(op + i * 256 + lane * 4); y[i * 4] += o4.x; y[i * 4 + 1] += o4.y; y[i * 4 + 2] += o4.z; y[i * 4 + 3] += o4.w; }
    }
    float v[16]; float sum = 0.f;
#pragma unroll
    for (int i = 0; i < 4; ++i) {
        const int col = i * 256 + lane * 4;
        float4 x4 = *(const float4*)(xs + col), g4 = *(const float4*)(mv + a.g_off + col);
        v[i * 4 + 0] = ALPHA * x4.x + g4.x * y[i * 4 + 0]; v[i * 4 + 1] = ALPHA * x4.y + g4.y * y[i * 4 + 1]; v[i * 4 + 2] = ALPHA * x4.z + g4.z * y[i * 4 + 2]; v[i * 4 + 3] = ALPHA * x4.w + g4.w * y[i * 4 + 3];
        sum += v[i * 4] + v[i * 4 + 1] + v[i * 4 + 2] + v[i * 4 + 3];
    }
    const float mean = wave_sum(sum) * (1.f / D);
    float sq = 0.f;
#pragma unroll
    for (int i = 0; i < 16; ++i) { float d = v[i] - mean; sq += d * d; }
    const float rstd = 1.f / sqrtf(wave_sum(sq) * (1.f / D) + EPS);
#pragma unroll
    for (int i = 0; i < 4; ++i) {
        const int col = i * 256 + lane * 4;
        float4 lg = *(const float4*)(a.lg + col), lb = *(const float4*)(a.lb + col);
        *(float4*)(xo + col) = make_float4((v[i * 4 + 0] - mean) * rstd * lg.x + lb.x, (v[i * 4 + 1] - mean) * rstd * lg.y + lb.y,
                                           (v[i * 4 + 2] - mean) * rstd * lg.z + lb.z, (v[i * 4 + 3] - mean) * rstd * lg.w + lb.w);
    }
}

typedef short bf16x8 __attribute__((ext_vector_type(8)));
typedef float f32x4 __attribute__((ext_vector_type(4)));
#define LAS __attribute__((address_space(3)))
typedef LAS unsigned char* ldsp;
constexpr int ZWP = 6400;

__device__ __forceinline__ float fast_rsqrt(float x) { return __builtin_amdgcn_rsqf(x); }
__device__ __forceinline__ float fast_sigmoid(float x) { return __builtin_amdgcn_rcpf(1.f + __builtin_amdgcn_exp2f(-1.4426950408889634f * x)); }
__device__ __forceinline__ float fast_silu(float x) { return x * fast_sigmoid(x); }
__device__ __forceinline__ uint2 pk4(float a, float b, float c, float d) { return make_uint2(pk2(a, b), pk2(c, d)); }

struct PrepArgs { const float* src; const float* src2; const float* kscale; T* dst; int K, Nsrc, mode; long long src_zs, dst_zs, ks_zs; };
__global__ void __launch_bounds__(256) k_wprep(PrepArgs a) {
    __shared__ float tile[64][65];
    const int z = blockIdx.z, n0 = blockIdx.x * 64, k0 = blockIdx.y * 64, tx = threadIdx.x & 63, ty = threadIdx.x >> 6;
    const float* src = a.src + (size_t)z * a.src_zs; const float* src2 = a.src2 ? a.src2 + (size_t)z * a.src_zs : nullptr;
    const float* ksc = a.kscale ? a.kscale + (size_t)z * a.ks_zs : nullptr;
    T* dst = a.dst + (size_t)z * a.dst_zs;
    const int n = n0 + tx; bool valid = true; int col = n; const float* sp = src;
    if (a.mode == 0) { valid = n < a.Nsrc; }
    else if (a.mode == 1) { if (n < 2144) col = n; else if (n < 2304) valid = false; else col = n - 160; }
    else { const int j = n >> 6, w = n & 63; sp = w < 32 ? src : src2; col = 32 * j + (w & 31); }
    for (int kk = ty; kk < 64; kk += 4) { float v = 0.f; if (valid) { v = sp[(size_t)(k0 + kk) * a.Nsrc + col]; if (ksc) v *= ksc[k0 + kk]; } tile[kk][tx] = v; }
    __syncthreads();
    for (int r = ty; r < 64; r += 4) dst[(size_t)(n0 + r) * a.K + k0 + tx] = tile[tx][r];
}

#define GLDS16(gp, lp) __builtin_amdgcn_global_load_lds((const unsigned*)(gp), (LAS unsigned*)(lp), 16, 0, 0)
template <int BN, bool HAS_SUM, class Prob>
__device__ __forceinline__ void gemm_run(ldsp lds, const Prob& pb, int bid, int nblk) {
    constexpr int NF = BN / 64, GLB = BN / 64, A_BYTES = 32768, B_BYTES = BN * 128, STAGE = A_BYTES + B_BYTES;
    const int tid = threadIdx.x, wid = __builtin_amdgcn_readfirstlane(tid >> 6), lane = tid & 63, wr = wid >> 2, wc = wid & 3, fr = lane & 15, fq = lane >> 4;
    const int NU = pb.nunits();
    if (bid >= NU) return;
    const int sb = lane * 16, swz = sb ^ (((sb >> 9) & 1) << 5);
    const int sR0 = (wid >> 1) * 16 + (swz >> 6), sC = (wid & 1) * 32 + ((swz & 63) >> 1);
    const int ob = fr * 64 + fq * 16, lane_off = ob ^ (((ob >> 9) & 1) << 5);
    const unsigned ldsw = (unsigned)wid * 1024u;
    unsigned aoff[4], boff[GLB];
    int su = bid, st = 0, snt = pb.ntiles(su);
#define G_LOAD_OFFS() do { _Pragma("unroll") for (int i = 0; i < 4; ++i) aoff[i] = pb.a_off(su, sR0 + 64 * i) + sC; \
                           _Pragma("unroll") for (int i = 0; i < GLB; ++i) boff[i] = pb.b_off(su, sR0 + 64 * i) + sC; } while (0)
#define G_STAGE(bufv) do { if (su < NU) { const T* Ab = pb.a_base(su, st); const T* Bb = pb.b_base(su, st); ldsp sbase = lds + (bufv) * STAGE + ldsw; \
        _Pragma("unroll") for (int i = 0; i < 4; ++i) GLDS16(Ab + aoff[i], sbase + i * 8192); \
        _Pragma("unroll") for (int i = 0; i < GLB; ++i) GLDS16(Bb + boff[i], sbase + A_BYTES + i * 8192); \
        if (++st == snt) { su += nblk; st = 0; if (su < NU) { snt = pb.ntiles(su); G_LOAD_OFFS(); } } } } while (0)
    G_LOAD_OFFS();
    G_STAGE(0);
    int buf = 0;
    for (int cu = bid; cu < NU; cu += nblk) {
        f32x4 acc[8][NF]; f32x4 sum[HAS_SUM ? 8 : 1][HAS_SUM ? NF : 1];
#pragma unroll
        for (int m = 0; m < 8; ++m)
#pragma unroll
            for (int n = 0; n < NF; ++n) { acc[m][n] = (f32x4){0.f, 0.f, 0.f, 0.f}; if (HAS_SUM) sum[m][n] = (f32x4){0.f, 0.f, 0.f, 0.f}; }
        const int nt = pb.ntiles(cu);
        for (int t = 0; t < nt; ++t) {
            asm volatile("s_waitcnt vmcnt(0)" ::: "memory");
            __syncthreads();
            G_STAGE(buf ^ 1);
            const ldsp ta = lds + buf * STAGE + wr * 16384 + lane_off, tb = lds + buf * STAGE + A_BYTES + wc * (NF * 2048) + lane_off;
#pragma unroll
            for (int ks = 0; ks < 2; ++ks) {
                bf16x8 At[8], Bf[NF];
#pragma unroll
                for (int m = 0; m < 8; ++m) At[m] = *(const LAS bf16x8*)(ta + m * 2048 + ks * 1024);
#pragma unroll
                for (int n = 0; n < NF; ++n) Bf[n] = *(const LAS bf16x8*)(tb + n * 2048 + ks * 1024);
#pragma unroll
                for (int m = 0; m < 8; ++m)
#pragma unroll
                    for (int n = 0; n < NF; ++n) acc[m][n] = __builtin_amdgcn_mfma_f32_16x16x32_bf16(Bf[n], At[m], acc[m][n], 0, 0, 0);
            }
            if constexpr (HAS_SUM) pb.tile_done(cu, t, acc, sum, wr, wc, fr, fq);
            buf ^= 1;
        }
        if constexpr (HAS_SUM) pb.epilogue(cu, sum, wr, wc, fr, fq); else pb.epilogue(cu, acc, wr, wc, fr, fq);
    }
#undef G_LOAD_OFFS
#undef G_STAGE
}

template <int BN, bool HAS_SUM, class Prob>
__global__ void __launch_bounds__(512, 2) k_gemm(Prob pb) {
    extern __shared__ __attribute__((aligned(16))) unsigned char dynlds[];
    gemm_run<BN, HAS_SUM, Prob>((ldsp)dynlds, pb, blockIdx.x, gridDim.x);
}

struct InProj {
    const T* H; const T* Wt; T* Z; float* SS; const float* gqn; const float* gkn; const float2* tab64; const float2* tab32; int nlat, npm;
    __device__ __forceinline__ int nunits() const { return npm * 25; }
    __device__ __forceinline__ int ntiles(int) const { return 16; }
    __device__ __forceinline__ unsigned a_off(int u, int R) const { return (unsigned)((u / 25) * 256 + R) * 1024u; }
    __device__ __forceinline__ unsigned b_off(int u, int R) const { return (unsigned)((u % 25) * 256 + R) * 1024u; }
    __device__ __forceinline__ const T* a_base(int, int t) const { return H + t * 64; }
    __device__ __forceinline__ const T* b_base(int, int t) const { return Wt + t * 64; }
    __device__ __forceinline__ void epilogue(int u, f32x4 (&acc)[8][4], int wr, int wc, int fr, int fq) const {
        const int pm = u / 25, pn = u % 25, cg = pn * 4 + wc;
        if (cg == 34 || cg == 35) return;
        const int row0 = pm * 256 + wr * 128 + fr;
        const bool lat = pm * 256 < nlat;
        const int zcol = (cg < 36 ? cg * 64 : 2144 + (cg - 36) * 64) + fq * 4;
        const bool t_rms = (cg >= 12 && cg < 18), t_rope = t_rms || (cg >= 20 && cg < 26), t_ssq = (cg >= 28 && cg < 33), t_kr = cg == 33, t_sig = cg >= 36;
        float4 gv[4];
        if (t_rms) { const float* g = cg < 16 ? gqn : gkn;
#pragma unroll
            for (int n = 0; n < 4; ++n) gv[n] = *(const float4*)(g + n * 16 + fq * 4); }
#pragma unroll
        for (int m = 0; m < 8; ++m) {
            const int row = row0 + m * 16;
            const int t = row & (SEQ - 1), gr = t >> 6, gc = t & 63;
            float v[4][4];
#pragma unroll
            for (int n = 0; n < 4; ++n)
#pragma unroll
                for (int j = 0; j < 4; ++j) v[n][j] = acc[m][n][j];
            T* zp = Z + (size_t)row * ZW + zcol;
            if (t_rms || t_ssq) {
                float ss = 0.f;
#pragma unroll
                for (int n = 0; n < 4; ++n)
#pragma unroll
                    for (int j = 0; j < 4; ++j) ss += v[n][j] * v[n][j];
                ss += __shfl_xor(ss, 16); ss += __shfl_xor(ss, 32);
                if (t_ssq) { if (fq == 0) SS[(size_t)row * 8 + (cg - 28)] = ss; }
                else { const float rstd = 1.f / sqrtf(ss * (1.f / 64.f) + EPS);
#pragma unroll
                    for (int n = 0; n < 4; ++n) { v[n][0] *= rstd * gv[n].x; v[n][1] *= rstd * gv[n].y; v[n][2] *= rstd * gv[n].z; v[n][3] *= rstd * gv[n].w; } }
            }
            if (t_rope && lat) {
                const float4* tr = (const float4*)(tab64 + gr * 16 + fq * 4); const float4* tc = (const float4*)(tab64 + gc * 16 + fq * 4);
                const float4 r0 = tr[0], r1 = tr[1], c0 = tc[0], c1 = tc[1];
                const float rc[4] = {r0.x, r0.z, r1.x, r1.z}, rs[4] = {r0.y, r0.w, r1.y, r1.w}, cc[4] = {c0.x, c0.z, c1.x, c1.z}, cs[4] = {c0.y, c0.w, c1.y, c1.w};
#pragma unroll
                for (int j = 0; j < 4; ++j) {
                    const float a0 = v[0][j], a1 = v[1][j], b0 = v[2][j], b1 = v[3][j];
                    v[0][j] = a0 * rc[j] - a1 * rs[j]; v[1][j] = a0 * rs[j] + a1 * rc[j];
                    v[2][j] = b0 * cc[j] - b1 * cs[j]; v[3][j] = b0 * cs[j] + b1 * cc[j];
                }
            }
            if (t_kr) {
#pragma unroll
                for (int n = 0; n < 2; ++n) {
                    const float4* tp = (const float4*)(tab32 + (n == 0 ? gr : gc) * 8 + (fq & 1) * 4);
                    const float4 q0 = tp[0], q1 = tp[1];
                    const float kc[4] = {q0.x, q0.z, q1.x, q1.z}, ks[4] = {q0.y, q0.w, q1.y, q1.w};
#pragma unroll
                    for (int j = 0; j < 4; ++j) { const float x = v[n][j], px = __shfl_xor(x, 32); if (lat) v[n][j] = (fq < 2) ? (x * kc[j] - px * ks[j]) : (px * ks[j] + x * kc[j]); }
                    *(uint2*)(zp + n * 16) = pk4(v[n][0], v[n][1], v[n][2], v[n][3]);
                }
                continue;
            }
            if (t_sig) {
#pragma unroll
                for (int n = 0; n < 4; ++n)
#pragma unroll
                    for (int j = 0; j < 4; ++j) v[n][j] = fast_sigmoid(v[n][j]);
            }
#pragma unroll
            for (int n = 0; n < 4; ++n) *(uint2*)(zp + n * 16) = pk4(v[n][0], v[n][1], v[n][2], v[n][3]);
        }
    }
};

struct MlaProj {
    const T* Z; const T* WqT; const T* WkvT; T* QM; T* KVM; const float* SS; const float2* tab32; int nlat, npm;
    __device__ __forceinline__ int nunits() const { return npm * 7; }
    __device__ __forceinline__ int ntiles(int u) const { return u < npm * 3 ? 3 : 2; }
    __device__ __forceinline__ unsigned a_off(int u, int R) const { const int pm = u < npm * 3 ? u / 3 : (u - npm * 3) / 4; return (unsigned)(pm * 256 + R) * (unsigned)ZW; }
    __device__ __forceinline__ unsigned b_off(int u, int R) const { return u < npm * 3 ? (unsigned)((u % 3) * 128 + R) * 192u : (unsigned)(((u - npm * 3) % 4) * 128 + R) * 128u; }
    __device__ __forceinline__ const T* a_base(int u, int t) const { return Z + (u < npm * 3 ? MCQ : MCKV) + t * 64; }
    __device__ __forceinline__ const T* b_base(int u, int t) const { return (u < npm * 3 ? WqT : WkvT) + t * 64; }
    __device__ __forceinline__ void epilogue(int u, f32x4 (&acc)[8][2], int wr, int wc, int fr, int fq) const {
        const bool isq = u < npm * 3;
        const int pm = isq ? u / 3 : (u - npm * 3) / 4, pn = isq ? u % 3 : (u - npm * 3) % 4;
        const int row0 = pm * 256 + wr * 128 + fr;
        const bool lat = pm * 256 < nlat;
#pragma unroll
        for (int m = 0; m < 8; ++m) {
            const int row = row0 + m * 16;
            const float* ss = SS + (size_t)row * 8;
            const float rstd = isq ? 1.f / sqrtf((ss[0] + ss[1] + ss[2]) * (1.f / 192.f) + EPS) : 1.f / sqrtf((ss[3] + ss[4]) * (1.f / 128.f) + EPS);
            const int t = row & (SEQ - 1), gr = t >> 6, gc = t & 63;
#pragma unroll
            for (int n = 0; n < 2; ++n) {
                float v[4];
#pragma unroll
                for (int j = 0; j < 4; ++j) v[j] = acc[m][n][j] * rstd;
                const int f = pn * 8 + wc * 2 + n;
                if (isq) {
                    const int part = f % 6;
                    if (part >= 4) {
                        const float4* tp = (const float4*)(tab32 + (part == 4 ? gr : gc) * 8 + (fq & 1) * 4);
                        const float4 q0 = tp[0], q1 = tp[1];
                        const float kc[4] = {q0.x, q0.z, q1.x, q1.z}, ks[4] = {q0.y, q0.w, q1.y, q1.w};
#pragma unroll
                        for (int j = 0; j < 4; ++j) { const float x = v[j], px = __shfl_xor(x, 32); if (lat) v[j] = (fq < 2) ? (x * kc[j] - px * ks[j]) : (px * ks[j] + x * kc[j]); }
                    }
                    *(uint2*)(QM + (size_t)row * 384 + f * 16 + fq * 4) = pk4(v[0], v[1], v[2], v[3]);
                } else {
                    *(uint2*)(KVM + (size_t)row * 512 + f * 16 + fq * 4) = pk4(v[0], v[1], v[2], v[3]);
                }
            }
        }
    }
};

struct MergeProb {
    const T* O; const T* WbT; const T* Z; T* MERGED; int npm;
    __device__ __forceinline__ int nunits() const { return npm * 8; }
    __device__ __forceinline__ int ntiles(int) const { return 16; }
    __device__ __forceinline__ unsigned a_off(int u, int R) const { return (unsigned)((u >> 3) * 256 + R) * 1024u; }
    __device__ __forceinline__ unsigned b_off(int u, int R) const { return (unsigned)((u & 7) * 128 + R) * 256u; }
    __device__ __forceinline__ const T* a_base(int, int t) const { return O + (t >> 2) * 256 + (t & 3) * 64; }
    __device__ __forceinline__ const T* b_base(int, int t) const { return WbT + (size_t)(t >> 2) * 1024 * 256 + (t & 3) * 64; }
    __device__ __forceinline__ void tile_done(int u, int t, f32x4 (&acc)[8][2], f32x4 (&sum)[8][2], int wr, int wc, int fr, int fq) const {
        if ((t & 3) != 3) return;
        const int i = t >> 2, pm = u >> 3, pn = u & 7;
        const T* gp = Z + (size_t)(pm * 256 + wr * 128 + fr) * ZW + GATE + i * 1024 + pn * 128 + wc * 32 + fq * 4;
#pragma unroll
        for (int m = 0; m < 8; ++m)
#pragma unroll
            for (int n = 0; n < 2; ++n) {
                const float4 g = ld4(gp + (size_t)m * 16 * ZW + n * 16);
                sum[m][n][0] += g.x * acc[m][n][0]; sum[m][n][1] += g.y * acc[m][n][1]; sum[m][n][2] += g.z * acc[m][n][2]; sum[m][n][3] += g.w * acc[m][n][3];
                acc[m][n] = (f32x4){0.f, 0.f, 0.f, 0.f};
            }
    }
    __device__ __forceinline__ void epilogue(int u, f32x4 (&sum)[8][2], int wr, int wc, int fr, int fq) const {
        const int pm = u >> 3, pn = u & 7;
        T* op = MERGED + (size_t)(pm * 256 + wr * 128 + fr) * 1024 + pn * 128 + wc * 32 + fq * 4;
#pragma unroll
        for (int m = 0; m < 8; ++m)
#pragma unroll
            for (int n = 0; n < 2; ++n) *(uint2*)(op + (size_t)m * 16 * 1024 + n * 16) = pk4(sum[m][n][0], sum[m][n][1], sum[m][n][2], sum[m][n][3]);
    }
};

struct PlainProb {
    const T* A; const T* Bt; T* C; int npm, npn, K, lda, ldc;
    __device__ __forceinline__ int nunits() const { return npm * npn; }
    __device__ __forceinline__ int ntiles(int) const { return K / 64; }
    __device__ __forceinline__ unsigned a_off(int u, int R) const { return (unsigned)((u / npn) * 256 + R) * (unsigned)lda; }
    __device__ __forceinline__ unsigned b_off(int u, int R) const { return (unsigned)((u % npn) * 128 + R) * (unsigned)K; }
    __device__ __forceinline__ const T* a_base(int, int t) const { return A + t * 64; }
    __device__ __forceinline__ const T* b_base(int, int t) const { return Bt + t * 64; }
    __device__ __forceinline__ void epilogue(int u, f32x4 (&acc)[8][2], int wr, int wc, int fr, int fq) const {
        const int pm = u / npn, pn = u % npn;
        T* op = C + (size_t)(pm * 256 + wr * 128 + fr) * ldc + pn * 128 + wc * 32 + fq * 4;
#pragma unroll
        for (int m = 0; m < 8; ++m)
#pragma unroll
            for (int n = 0; n < 2; ++n) *(uint2*)(op + (size_t)m * 16 * ldc + n * 16) = pk4(acc[m][n][0], acc[m][n][1], acc[m][n][2], acc[m][n][3]);
    }
};

constexpr int CTXB = NB * NE * CAP;
struct FfnUp {
    const T* H2; const T* WguT; const int* IDX; T* ACT; int nun;
    __device__ __forceinline__ int nunits() const { return nun; }
    __device__ __forceinline__ int ntiles(int) const { return 16; }
    __device__ __forceinline__ void decode(int u, int& e, int& pn, int& sbase, bool& isctx) const {
        if (u < 2048) { e = u >> 7; const int rem = u & 127; pn = rem & 7; sbase = ((rem >> 5) * NE + e) * CAP + ((rem >> 3) & 3) * 256; isctx = false; }
        else { const int uc = u - 2048; e = uc >> 3; pn = uc & 7; sbase = CTXB + e * CAPC; isctx = true; }
    }
    __device__ __forceinline__ int slot_of(int sbase, bool isctx, int R) const { return isctx ? (R < 128 ? sbase + (R >> 5) * (NE * CAPC) + (R & 31) : -1) : sbase + R; }
    __device__ __forceinline__ unsigned a_off(int u, int R) const { int e, pn, sb; bool ic; decode(u, e, pn, sb, ic); const int s = slot_of(sb, ic, R); return s < 0 ? 0u : (unsigned)IDX[s] * 1024u; }
    __device__ __forceinline__ unsigned b_off(int u, int R) const { int e, pn, sb; bool ic; decode(u, e, pn, sb, ic); return (unsigned)(e * 2048 + pn * 256 + R) * 1024u; }
    __device__ __forceinline__ const T* a_base(int, int t) const { return H2 + t * 64; }
    __device__ __forceinline__ const T* b_base(int, int t) const { return WguT + t * 64; }
    __device__ __forceinline__ void epilogue(int u, f32x4 (&acc)[8][4], int wr, int wc, int fr, int fq) const {
        int e, pn, sb; bool ic; decode(u, e, pn, sb, ic);
        const int col = (pn * 4 + wc) * 32 + fq * 4;
#pragma unroll
        for (int m = 0; m < 8; ++m) {
            const int s = slot_of(sb, ic, wr * 128 + m * 16 + fr);
            if (s < 0) continue;
            T* op = ACT + (size_t)s * FF + col;
#pragma unroll
            for (int n = 0; n < 2; ++n)
                *(uint2*)(op + n * 16) = pk4(fast_silu(acc[m][n][0]) * acc[m][n + 2][0], fast_silu(acc[m][n][1]) * acc[m][n + 2][1],
                                             fast_silu(acc[m][n][2]) * acc[m][n + 2][2], fast_silu(acc[m][n][3]) * acc[m][n + 2][3]);
        }
    }
};
struct FfnDown {
    const T* ACT; const T* WdT; const float* GATEV; T* OUT; int nun;
    __device__ __forceinline__ int nunits() const { return nun; }
    __device__ __forceinline__ int ntiles(int) const { return 16; }
    __device__ __forceinline__ void decode(int u, int& e, int& pn, int& sbase, bool& isctx) const {
        if (u < 1024) { e = u >> 6; const int rem = u & 63; pn = rem & 3; sbase = ((rem >> 4) * NE + e) * CAP + ((rem >> 2) & 3) * 256; isctx = false; }
        else { const int uc = u - 1024; e = uc >> 2; pn = uc & 3; sbase = CTXB + e * CAPC; isctx = true; }
    }
    __device__ __forceinline__ int slot_of(int sbase, bool isctx, int R) const { return isctx ? (R < 128 ? sbase + (R >> 5) * (NE * CAPC) + (R & 31) : -1) : sbase + R; }
    __device__ __forceinline__ unsigned a_off(int u, int R) const { int e, pn, sb; bool ic; decode(u, e, pn, sb, ic); const int s = slot_of(sb, ic, R); return s < 0 ? 0u : (unsigned)s * 1024u; }
    __device__ __forceinline__ unsigned b_off(int u, int R) const { int e, pn, sb; bool ic; decode(u, e, pn, sb, ic); return (unsigned)(e * 1024 + pn * 256 + R) * 1024u; }
    __device__ __forceinline__ const T* a_base(int, int t) const { return ACT + t * 64; }
    __device__ __forceinline__ const T* b_base(int, int t) const { return WdT + t * 64; }
    __device__ __forceinline__ void epilogue(int u, f32x4 (&acc)[8][4], int wr, int wc, int fr, int fq) const {
        int e, pn, sb; bool ic; decode(u, e, pn, sb, ic);
        const int col = pn * 256 + wc * 64 + fq * 4;
#pragma unroll
        for (int m = 0; m < 8; ++m) {
            const int s = slot_of(sb, ic, wr * 128 + m * 16 + fr);
            if (s < 0) continue;
            const float g = GATEV[s];
            T* op = OUT + (size_t)s * D + col;
#pragma unroll
            for (int n = 0; n < 4; ++n) *(uint2*)(op + n * 16) = pk4(acc[m][n][0] * g, acc[m][n][1] * g, acc[m][n][2] * g, acc[m][n][3] * g);
        }
    }
};

typedef float f32x16 __attribute__((ext_vector_type(16)));
typedef short s16x4 __attribute__((ext_vector_type(4)));
typedef short v4i16_t __attribute__((ext_vector_type(4)));
struct AttnP { const T* Z; const T* QM; const T* KVM; T* O; const float* rpb; const float* sink; int nlat; int need_ctx; };
constexpr int ATT_LDS = 2 * (64 * 208 + 8192) + 2048;
__device__ __forceinline__ int crow(int r, int hi) { return (r & 3) + 8 * (r >> 2) + 4 * hi; }
__device__ __forceinline__ float xhalf_max(float v) { auto rr = __builtin_amdgcn_permlane32_swap(__float_as_uint(v), __float_as_uint(v), false, false); return fmaxf(__uint_as_float(rr[0]), __uint_as_float(rr[1])); }
__device__ __forceinline__ float xhalf_sum(float v) { auto rr = __builtin_amdgcn_permlane32_swap(__float_as_uint(v), __float_as_uint(v), false, false); return __uint_as_float(rr[0]) + __uint_as_float(rr[1]); }
__device__ __forceinline__ unsigned cvtpk(float lo, float hi) { typedef float f2 __attribute__((ext_vector_type(2))); typedef __bf16 b2 __attribute__((ext_vector_type(2))); f2 v = {lo, hi}; b2 b = __builtin_convertvector(v, b2); return __builtin_bit_cast(unsigned, b); }

template <int BR>
__device__ __forceinline__ void attn_unit(ldsp lds, const AttnP& P, int b, int hx, int q0, bool ctxq) {
    constexpr int DQK = (BR == 3) ? 96 : 64, NKS = DQK / 16, KP = DQK * 2 + 16, KBYTES = 64 * KP, BUFB = 64 * 208 + 8192;
    constexpr bool PACK2 = (BR == 1 || BR == 2);
    constexpr float SCALE = (BR == 3) ? 0.10206207261596575f : 0.125f;
    constexpr float CL2 = SCALE * 1.4426950408889634f;
    constexpr float NEG = -1e30f;
    const int tid = threadIdx.x, lane = tid & 63, wid = __builtin_amdgcn_readfirstlane(tid >> 6), r32 = lane & 31, hi = lane >> 5;
    const int tokq = q0 + (PACK2 ? (wid & 3) : wid) * 32 + r32;
    const int head = PACK2 ? hx * 2 + (wid >> 2) : hx;
    const size_t lat0 = (size_t)b * SEQ, ctx0 = (size_t)P.nlat + (size_t)b * CTX;
    const size_t qrow = ctxq ? ctx0 + tokq : lat0 + tokq;
    bf16x8 qf[NKS];
    { const T* qp = (BR == 3) ? P.QM + qrow * 384 + head * 96 + hi * 8 : P.Z + qrow * ZW + (BR == 0 ? NAQ : BR == 1 ? GQ : SQ) + head * 64 + hi * 8;
#pragma unroll
      for (int ks = 0; ks < NKS; ++ks) qf[ks] = *(const bf16x8*)(qp + ks * 16); }
    int klo = 0, nlt = 0;
    if (!ctxq) {
        if (BR == 0) { const int r0 = q0 >> 6; const int lo = min(max(r0 - 4, 0), GROWS - 8), hi2 = min(max(r0 - 1, 0), GROWS - 8) + 8; klo = lo * 64; nlt = hi2 - lo; }
        else if (BR == 2) { klo = max(q0 - 128, 0); nlt = (min(q0 + 256, SEQ) - klo) >> 6; }
        else { klo = 0; nlt = SEQ / 64; }
    }
    const int nt = 4 + nlt;
    const int skey = tid >> 3, sch = tid & 7;
    const int rkey = (tid & 255) >> 2, rch = tid & 3;
    const T* ksrc; const T* vsrc; const T* rsrc = nullptr; size_t kpitch;
    if (BR == 3) { ksrc = P.KVM + (size_t)skey * 512 + hx * 128 + sch * 8; vsrc = ksrc + 64; kpitch = 512; rsrc = P.Z + (size_t)rkey * ZW + MKR + rch * 8; }
    else { const int ko = (BR == 0 ? NAK : BR == 1 ? GK : SK) + hx * 64 + sch * 8, vo = (BR == 0 ? NAV : BR == 1 ? GV : SV) + hx * 64 + sch * 8;
           ksrc = P.Z + (size_t)skey * ZW + ko; vsrc = P.Z + (size_t)skey * ZW + vo; kpitch = ZW; }
    const unsigned kdst = skey * KP + sch * 16, rdst = rkey * KP + 128 + rch * 16, vdst = KBYTES + (sch >> 2) * 4096 + skey * 64 + (sch & 3) * 16;
    typedef unsigned u32x4 __attribute__((ext_vector_type(4)));
    u32x4 kreg, vreg, rreg;
#define A_TROW(t) ((t) < 4 ? ctx0 + (size_t)(t) * 64 : lat0 + (size_t)klo + (size_t)((t) - 4) * 64)
#define A_LOAD(t) do { const size_t tr_ = A_TROW(t); kreg = *(const u32x4*)(ksrc + tr_ * kpitch); vreg = *(const u32x4*)(vsrc + tr_ * kpitch); \
        if (BR == 3) { if (tid < 256) rreg = *(const u32x4*)(rsrc + tr_ * ZW); } } while (0)
#define A_WRITE(bufv) do { ldsp bb_ = lds + (bufv) * BUFB; *(LAS u32x4*)(bb_ + kdst) = kreg; *(LAS u32x4*)(bb_ + vdst) = vreg; \
        if (BR == 3) { if (tid < 256) *(LAS u32x4*)(bb_ + rdst) = rreg; } } while (0)
    LAS float* btab = (LAS float*)(lds + 2 * BUFB);
    if (BR == 0) { if (tid < 465) btab[tid] = P.rpb[hx * 465 + tid] * 1.4426950408889634f; }
    const int qr = (q0 >> 6) + (wid >> 1), qc = (wid & 1) * 32 + r32;
    const int krow0 = min(max(qr - 4, 0), GROWS - 8), kcol0 = min(max(qc - 8, 0), GW - 16);
    float m = NEG, lsum = 0.f;
    f32x16 o0, o1;
#pragma unroll
    for (int r = 0; r < 16; ++r) { o0[r] = 0.f; o1[r] = 0.f; }
    const unsigned kfo = r32 * KP + hi * 16;
    const unsigned vfo = KBYTES + (4 * hi + ((lane & 15) >> 2)) * 64 + ((lane >> 4) & 1) * 32 + (lane & 3) * 8;
    A_LOAD(0); A_WRITE(0);
    __syncthreads();
    if (nt > 1) A_LOAD(1);
    for (int t = 0; t < nt; ++t) {
        const ldsp bb = lds + (t & 1) * BUFB;
        bool active = true; int kr = 0;
        if (BR == 0 && t >= 4) { kr = (klo >> 6) + (t - 4); active = (kr >= krow0) && (kr < krow0 + 8); }
        if (active) {
            f32x16 p0, p1;
#pragma unroll
            for (int r = 0; r < 16; ++r) { p0[r] = 0.f; p1[r] = 0.f; }
#pragma unroll
            for (int ks = 0; ks < NKS; ++ks) {
                const bf16x8 ka = *(const LAS bf16x8*)(bb + kfo + ks * 32), kb = *(const LAS bf16x8*)(bb + kfo + 32 * KP + ks * 32);
                p0 = __builtin_amdgcn_mfma_f32_32x32x16_bf16(ka, qf[ks], p0, 0, 0, 0);
                p1 = __builtin_amdgcn_mfma_f32_32x32x16_bf16(kb, qf[ks], p1, 0, 0, 0);
            }
            if (BR == 0) {
                if (t >= 4) { const int dr = kr - qr + 7;
#pragma unroll
                    for (int r = 0; r < 16; ++r) {
                        const int kc0 = crow(r, hi), kc1 = 32 + kc0;
                        const bool v0 = (unsigned)(kc0 - kcol0) < 16u, v1 = (unsigned)(kc1 - kcol0) < 16u;
                        const float b0 = btab[dr * 31 + min(max(kc0 - qc + 15, 0), 30)], b1 = btab[dr * 31 + min(max(kc1 - qc + 15, 0), 30)];
                        p0[r] = v0 ? p0[r] * CL2 + b0 : NEG; p1[r] = v1 ? p1[r] * CL2 + b1 : NEG;
                    }
                } else {
#pragma unroll
                    for (int r = 0; r < 16; ++r) { p0[r] *= CL2; p1[r] *= CL2; }
                }
            }
            if (BR == 2) { if (t >= 4) { const int kb0 = klo + (t - 4) * 64 - tokq + 128;
#pragma unroll
                    for (int r = 0; r < 16; ++r) { const int d0 = kb0 + crow(r, hi);
                        if ((unsigned)d0 > 256u) p0[r] = NEG; if ((unsigned)(d0 + 32) > 256u) p1[r] = NEG; } } }
            constexpr float CC = (BR == 0) ? 1.f : CL2;
            float rm = fmaxf(p0[0], p1[0]);
#pragma unroll
            for (int r = 1; r < 16; ++r) rm = fmaxf(rm, fmaxf(p0[r], p1[r]));
            rm = xhalf_max(rm);
            if (__any(rm > m)) {
                const float mn = fmaxf(m, rm); const float f = __builtin_amdgcn_exp2f((m - mn) * CC);
                m = mn; lsum *= f;
#pragma unroll
                for (int r = 0; r < 16; ++r) { o0[r] *= f; o1[r] *= f; }
            }
            const float mc = m * CC; float ps = 0.f;
#pragma unroll
            for (int r = 0; r < 16; ++r) { p0[r] = __builtin_amdgcn_exp2f(p0[r] * CC - mc); p1[r] = __builtin_amdgcn_exp2f(p1[r] * CC - mc); ps += p0[r] + p1[r]; }
            lsum += ps;
#pragma unroll
            for (int s = 0; s < 4; ++s) {
                bf16x8 pf;
                { const int rb = (s & 1) * 8; unsigned w0, w1, w2, w3;
                  if (s < 2) { w0 = cvtpk(p0[rb], p0[rb + 1]); w1 = cvtpk(p0[rb + 2], p0[rb + 3]); w2 = cvtpk(p0[rb + 4], p0[rb + 5]); w3 = cvtpk(p0[rb + 6], p0[rb + 7]); }
                  else       { w0 = cvtpk(p1[rb], p1[rb + 1]); w1 = cvtpk(p1[rb + 2], p1[rb + 3]); w2 = cvtpk(p1[rb + 4], p1[rb + 5]); w3 = cvtpk(p1[rb + 6], p1[rb + 7]); }
                  typedef unsigned u4 __attribute__((ext_vector_type(4))); u4 ww = {w0, w1, w2, w3}; pf = __builtin_bit_cast(bf16x8, ww); }
#pragma unroll
                for (int d0 = 0; d0 < 2; ++d0) {
                    const ldsp vp = bb + vfo + d0 * 4096 + s * 1024;
                    const s16x4 lo = __builtin_bit_cast(s16x4, __builtin_amdgcn_ds_read_tr16_b64_v4i16((LAS v4i16_t*)vp));
                    const s16x4 hi4 = __builtin_bit_cast(s16x4, __builtin_amdgcn_ds_read_tr16_b64_v4i16((LAS v4i16_t*)(vp + 512)));
                    const bf16x8 vf = (bf16x8){lo[0], lo[1], lo[2], lo[3], hi4[0], hi4[1], hi4[2], hi4[3]};
                    if (d0 == 0) o0 = __builtin_amdgcn_mfma_f32_32x32x16_bf16(vf, pf, o0, 0, 0, 0); else o1 = __builtin_amdgcn_mfma_f32_32x32x16_bf16(vf, pf, o1, 0, 0, 0);
                }
            }
        }
        if (t + 1 < nt) A_WRITE((t + 1) & 1);
        if (t + 2 < nt) A_LOAD(t + 2);
        __syncthreads();
    }
    float ltot = xhalf_sum(lsum);
    if (BR == 2) ltot += __builtin_amdgcn_exp2f(P.sink[head] * 1.4426950408889634f - m * CL2);
    const float inv = 1.f / ltot;
    T* op = P.O + qrow * D + BR * 256 + head * 64 + 4 * hi;
#pragma unroll
    for (int g = 0; g < 4; ++g) {
        *(uint2*)(op + 8 * g) = pk4(o0[4 * g] * inv, o0[4 * g + 1] * inv, o0[4 * g + 2] * inv, o0[4 * g + 3] * inv);
        *(uint2*)(op + 32 + 8 * g) = pk4(o1[4 * g] * inv, o1[4 * g + 1] * inv, o1[4 * g + 2] * inv, o1[4 * g + 3] * inv);
    }
#undef A_TROW
#undef A_LOAD
#undef A_WRITE
}

__device__ __forceinline__ void attn_phase(ldsp lds, const AttnP& P, int bid, int nblk) {
    for (int u = bid; u < 512; u += nblk) attn_unit<3>(lds, P, u >> 7, (u >> 5) & 3, (u & 31) * 256, false);
    for (int u = bid; u < 512; u += nblk) attn_unit<1>(lds, P, u >> 7, (u >> 6) & 1, (u & 63) * 128, false);
    for (int u = bid; u < 512; u += nblk) attn_unit<0>(lds, P, u >> 7, (u >> 5) & 3, (u & 31) * 256, false);
    for (int u = bid; u < 512; u += nblk) attn_unit<2>(lds, P, u >> 7, (u >> 6) & 1, (u & 63) * 128, false);
    if (P.need_ctx) {
        for (int u = bid; u < 64; u += nblk) {
            const int br = u >> 4, bb = (u >> 2) & 3, x = u & 3;
            if (br == 0) attn_unit<0>(lds, P, bb, x, 0, true);
            else if (br == 1) attn_unit<1>(lds, P, bb, x >> 1, (x & 1) * 128, true);
            else if (br == 2) attn_unit<2>(lds, P, bb, x >> 1, (x & 1) * 128, true);
            else attn_unit<3>(lds, P, bb, x, 0, true);
        }
    }
}
__global__ void __launch_bounds__(512, 2) k_attn_fast(AttnP P) {
    extern __shared__ __attribute__((aligned(16))) unsigned char dynlds[];
    attn_phase((ldsp)dynlds, P, blockIdx.x, gridDim.x);
}

template <int MODE> void sgemm(hipStream_t st, const GemmArgs& g, int nz) {
    dim3 grid((g.N + 127) / 128, (g.M + 127) / 128, nz);
    hipLaunchKernelGGL(k_sgemm<MODE>, grid, dim3(256), 0, st, g);
}

template <int BN, bool HS, class Prob> void launch_gemm(hipStream_t st, const Prob& pb) {
    constexpr int LDSB = 2 * (32768 + BN * 128);
    static bool attr_done = false;
    if (!attr_done) { hipFuncSetAttribute((const void*)k_gemm<BN, HS, Prob>, hipFuncAttributeMaxDynamicSharedMemorySize, LDSB); attr_done = true; }
    hipLaunchKernelGGL((k_gemm<BN, HS, Prob>), dim3(256), dim3(512), LDSB, st, pb);
}
void wprep(hipStream_t st, const float* src, const float* src2, const float* kscale, T* dst, int K, int Nsrc, int Ndst, int mode, int nz, long long src_zs, long long dst_zs, long long ks_zs) {
    PrepArgs a{}; a.src = src; a.src2 = src2; a.kscale = kscale; a.dst = dst; a.K = K; a.Nsrc = Nsrc; a.mode = mode; a.src_zs = src_zs; a.dst_zs = dst_zs; a.ks_zs = ks_zs;
    hipLaunchKernelGGL(k_wprep, dim3(Ndst / 64, K / 64, nz), dim3(256), 0, st, a);
}
}

extern "C" void kernel_launch(void* const* d_in, const int* in_sizes, int n_in, void* d_out, int out_size, void* d_ws, size_t ws_size, hipStream_t stream) {
    const float* x = (const float*)d_in[0]; const float* c = (const float*)d_in[1]; const float* ctx = (const float*)d_in[2]; const float* c_ctx = (const float*)d_in[3];
    const float* w_mod = (const float*)d_in[4]; const float* b_mod = (const float*)d_in[5]; const float* w_in = (const float*)d_in[6]; const float* na_rpb = (const float*)d_in[7];
    const float* gqn = (const float*)d_in[8]; const float* gkn = (const float*)d_in[9]; const float* swa_sink = (const float*)d_in[10];
    const float* mqn = (const float*)d_in[11]; const float* mkvn = (const float*)d_in[12]; const float* w_qb = (const float*)d_in[13]; const float* w_kvb = (const float*)d_in[14];
    const float* w_branch = (const float*)d_in[15]; const float* w_out = (const float*)d_in[16];
    const float* ln1g = (const float*)d_in[17]; const float* ln1b = (const float*)d_in[18]; const float* ln2g = (const float*)d_in[19]; const float* ln2b = (const float*)d_in[20];
    const float* w_router = (const float*)d_in[21]; const float* w_gate = (const float*)d_in[22]; const float* w_up = (const float*)d_in[23]; const float* w_down = (const float*)d_in[24];
    float* out = (float*)d_out;

    char* ws = (char*)d_ws; size_t off = 0;
    auto carve = [&](size_t bytes) { void* p = ws + off; off += (bytes + 255) & ~(size_t)255; return p; };
    Pass P; P.nbp = NB; P.b0 = 0; P.nlat = NB * SEQ; P.nctx = NB * CTX; P.nrow = P.nlat + P.nctx;
    const size_t NR = (size_t)P.nrow;
    float* modv = (float*)carve((size_t)NL * 5 * MODW * 4);
    float2* tab64 = (float2*)carve(128 * 16 * 8); float2* tab32 = (float2*)carve(128 * 8 * 8);
    T* RA = (T*)carve(NR * D * 2);
    T* RC = (T*)carve(NR * D * 2);
    float* XCa = (float*)carve((size_t)P.nctx * D * 4);
    float* XCb = (float*)carve((size_t)P.nctx * D * 4);
    float* AFF = (float*)carve(NR * NE * 4);
    const size_t NSLOT = (size_t)P.nbp * NE * (CAP + CAPC);
    int* IDX = (int*)carve(NSLOT * 4); float* GATEV = (float*)carve(NSLOT * 4); int* INV = (int*)carve(NR * NE * 4);
    T* Z = (T*)carve(NR * ZW * 2);
    T* WinT = (T*)carve((size_t)NL * ZWP * D * 2); T* WqT = (T*)carve((size_t)NL * 384 * 192 * 2); T* WkvT = (T*)carve((size_t)NL * 512 * 128 * 2);
    float* SS = (float*)carve(NR * 8 * 4);
    T* WbT = (T*)carve((size_t)NL * 4 * 1024 * 256 * 2); T* WoutT = (T*)carve((size_t)NL * D * D * 2);
    T* H = RA; T* O = RA; T* Y = RA; T* QM = RC; T* KVM = RC + NR * 384; T* MERGED = RC; T* H2 = RC;
    T* ACT = Z; T* OUT = Z + NSLOT * FF; T* WguT = Z + 2 * NSLOT * FF; T* WdT = WguT + (size_t)NE * 2048 * 1024;
    if (off > ws_size || 2 * NSLOT * FF + (size_t)NE * 3072 * 1024 > NR * ZW) { fprintf(stderr, "workspace too small: need %zu have %zu\n", off, ws_size); return; }

    hipLaunchKernelGGL(k_mod, dim3(MODW / 64, NL), dim3(256), 0, stream, c, c_ctx, w_mod, b_mod, modv);
    hipLaunchKernelGGL(k_ropetab, dim3(8), dim3(256), 0, stream, tab64, tab32);
    wprep(stream, w_in, nullptr, nullptr, WinT, D, ZW, ZWP, 1, NL, (long long)D * ZW, (long long)ZWP * D, 0);
    wprep(stream, w_qb, nullptr, mqn, WqT, 192, 384, 384, 0, NL, 192 * 384, 384 * 192, 192);
    wprep(stream, w_kvb, nullptr, mkvn, WkvT, 128, 512, 512, 0, NL, 128 * 512, 512 * 128, 128);
    wprep(stream, w_branch, nullptr, nullptr, WbT, 256, 1024, 1024, 0, NL * 4, 256 * 1024, 1024 * 256, 0);
    wprep(stream, w_out, nullptr, nullptr, WoutT, 1024, 1024, 1024, 0, NL, 1024 * 1024, 1024 * 1024, 0);

    const int rowblocks = (P.nrow + 3) / 4;
    for (int l = 0; l < NL; ++l) {
        const bool need_ctx = l < NL - 1;
        const float* modl = modv + (size_t)l * 5 * MODW;
        const float* xin_lat = l == 0 ? x : out;
        const float* xin_ctx = l == 0 ? ctx : XCb;
        hipLaunchKernelGGL(k_lnmod, dim3(rowblocks), dim3(256), 0, stream, xin_lat, xin_ctx, modl, 0, D, H, P);
        { InProj pb{}; pb.H = H; pb.Wt = WinT + (size_t)l * ZWP * D; pb.Z = Z; pb.SS = SS; pb.gqn = gqn + l * 64; pb.gkn = gkn + l * 64; pb.tab64 = tab64; pb.tab32 = tab32; pb.nlat = P.nlat; pb.npm = P.nrow / 256;
          launch_gemm<256, false>(stream, pb); }
        { MlaProj pb{}; pb.Z = Z; pb.WqT = WqT + (size_t)l * 384 * 192; pb.WkvT = WkvT + (size_t)l * 512 * 128; pb.QM = QM; pb.KVM = KVM; pb.SS = SS; pb.tab32 = tab32; pb.nlat = P.nlat; pb.npm = P.nrow / 256;
          launch_gemm<128, false>(stream, pb); }
        { AttnP ap{}; ap.Z = Z; ap.QM = QM; ap.KVM = KVM; ap.O = O; ap.rpb = na_rpb + (size_t)l * 4 * 15 * 31; ap.sink = swa_sink + l * 4; ap.nlat = P.nlat; ap.need_ctx = need_ctx ? 1 : 0;
          hipLaunchKernelGGL(k_attn_fast, dim3(256), dim3(512), ATT_LDS, stream, ap); }
        const int mrows = need_ctx ? P.nrow : P.nlat;
        { MergeProb pb{}; pb.O = O; pb.WbT = WbT + (size_t)l * 4 * 1024 * 256; pb.Z = Z; pb.MERGED = MERGED; pb.npm = mrows / 256; launch_gemm<128, true>(stream, pb); }
        { PlainProb pb{}; pb.A = MERGED; pb.Bt = WoutT + (size_t)l * D * D; pb.C = Y; pb.npm = mrows / 256; pb.npn = 8; pb.K = D; pb.lda = D; pb.ldc = D; launch_gemm<128, false>(stream, pb); }
        { LnResArgs a{}; a.xlat = xin_lat; a.xctx = xin_ctx; a.Y = Y; a.modl = modl; a.g_off = 2 * D; a.sh_off = 3 * D; a.sc_off = 4 * D; a.lg = ln1g + l * D; a.lb = ln1b + l * D;
          a.olat = out; a.octx = XCa; a.H2 = H2; a.wr = w_router + (size_t)l * D * NE; a.aff = AFF; a.P = P; a.nrows = mrows;
          hipLaunchKernelGGL(k_lnres, dim3((mrows + 3) / 4), dim3(256), 0, stream, a); }
        { TopkArgs a{}; a.aff = AFF; a.idx = IDX; a.gatev = GATEV; a.inv = INV; a.P = P;
          hipLaunchKernelGGL(k_topk, dim3(NE, P.nbp, need_ctx ? 2 : 1), dim3(256), 0, stream, a); }
        wprep(stream, w_gate + (size_t)l * NE * D * FF, w_up + (size_t)l * NE * D * FF, nullptr, WguT, 1024, 1024, 2048, 2, NE, (long long)D * FF, (long long)2048 * 1024, 0);
        wprep(stream, w_down + (size_t)l * NE * FF * D, nullptr, nullptr, WdT, 1024, 1024, 1024, 0, NE, (long long)FF * D, (long long)1024 * 1024, 0);
        { FfnUp pb{}; pb.H2 = H2; pb.WguT = WguT; pb.IDX = IDX; pb.ACT = ACT; pb.nun = 2048 + (need_ctx ? 128 : 0); launch_gemm<256, false>(stream, pb); }
        { FfnDown pb{}; pb.ACT = ACT; pb.WdT = WdT; pb.GATEV = GATEV; pb.OUT = OUT; pb.nun = 1024 + (need_ctx ? 64 : 0); launch_gemm<256, false>(stream, pb); }
        { CombArgs a{}; a.xlat = out; a.xctx = XCa; a.OUT = OUT; a.inv = INV; a.modl = modl; a.g_off = 5 * D; a.lg = ln2g + l * D; a.lb = ln2b + l * D;
          a.olat = out; a.octx = XCb; a.P = P; a.nrows = mrows;
          hipLaunchKernelGGL(k_combine, dim3((mrows + 3) / 4), dim3(256), 0, stream, a); }
    }
}
```

```cpp
#include <hip/hip_runtime.h>
#include <hip/hip_bf16.h>
#include <stdint.h>
#include <stdio.h>
#include <string.h>

namespace {
constexpr int D = 1024, SEQ = 8192, CTX = 256, NB = 4, NL = 2, HD = 64;
constexpr int GW = 64, GROWS = 128;
constexpr int INW = 6240;
constexpr int ZW = 6240;
constexpr int NAQ = 0, NAK = 256, NAV = 512, GQ = 768, GK = 1024, GV = 1152, SQ = 1280, SK = 1536, SV = 1664,
              MCQ = 1792, MCKV = 1984, MKR = 2112, GATE = 2144;
constexpr int NE = 16, FF = 1024, CAP = 1024, CAPC = 32;
constexpr int MODW = 6 * D;
constexpr float EPS = 1e-6f;
constexpr float ALPHA = 1.4142135623730951f;
constexpr int NLAT = NB * SEQ, NCTX = NB * CTX, NROW = NLAT + NCTX;

struct T {
    unsigned short u;
    __device__ __forceinline__ operator float() const { return __uint_as_float((unsigned)u << 16); }
    __device__ __forceinline__ T& operator=(float f) { unsigned b = __float_as_uint(f); b += 0x7fffu + ((b >> 16) & 1u); u = (unsigned short)(b >> 16); return *this; }
};
__device__ __forceinline__ float4 ld4(const float* p) { return *(const float4*)p; }
__device__ __forceinline__ float4 ld4(const T* p) { uint2 r = *(const uint2*)p; return make_float4(__uint_as_float(r.x << 16), __uint_as_float(r.x & 0xffff0000u), __uint_as_float(r.y << 16), __uint_as_float(r.y & 0xffff0000u)); }
__device__ __forceinline__ unsigned pk2(float lo, float hi) { T a, b; a = lo; b = hi; return (unsigned)a.u | ((unsigned)b.u << 16); }
__device__ __forceinline__ void st4(float* p, float4 v) { *(float4*)p = v; }
__device__ __forceinline__ void st4(T* p, float4 v) { *(uint2*)p = make_uint2(pk2(v.x, v.y), pk2(v.z, v.w)); }

__device__ __forceinline__ int otid() { int t = threadIdx.x; asm volatile("" : "+v"(t)); return t; }
__device__ __forceinline__ int xswz(int u, int n) { const int c = u & 7, s = u >> 3, q = n >> 3, rr = n & 7; return (c < rr ? c * (q + 1) : rr * (q + 1) + (c - rr) * q) + s; }
#define DPP_ADD(v, ctrl) ((v) + __builtin_bit_cast(float, __builtin_amdgcn_update_dpp(0, __builtin_bit_cast(int, (v)), (ctrl), 0xf, 0xf, true)))
__device__ __forceinline__ float wave_sum(float v) {
    v = DPP_ADD(v, 0xB1);
    v = DPP_ADD(v, 0x4E);
    v = DPP_ADD(v, 0x141);
    v = DPP_ADD(v, 0x140);
    const int iv = __builtin_bit_cast(int, v);
    const float r0 = __builtin_bit_cast(float, __builtin_amdgcn_readlane(iv, 0)), r1 = __builtin_bit_cast(float, __builtin_amdgcn_readlane(iv, 16)),
                r2 = __builtin_bit_cast(float, __builtin_amdgcn_readlane(iv, 32)), r3 = __builtin_bit_cast(float, __builtin_amdgcn_readlane(iv, 48));
    return (r0 + r1) + (r2 + r3);
}

typedef short bf16x8 __attribute__((ext_vector_type(8)));
typedef float f32x4 __attribute__((ext_vector_type(4)));
#define LAS __attribute__((address_space(3)))
typedef LAS unsigned char* ldsp;
constexpr int ZWP = 6400;

__device__ __forceinline__ float fast_rsqrt(float x) { return __builtin_amdgcn_rsqf(x); }
__device__ __forceinline__ float fast_sigmoid(float x) { return __builtin_amdgcn_rcpf(1.f + __builtin_amdgcn_exp2f(-1.4426950408889634f * x)); }
__device__ __forceinline__ float fast_silu(float x) { return x * fast_sigmoid(x); }
__device__ __forceinline__ uint2 pk4(float a, float b, float c, float d) { return make_uint2(pk2(a, b), pk2(c, d)); }

#define GLDS16(gp, lp) __builtin_amdgcn_global_load_lds((const unsigned*)(gp), (LAS unsigned*)(lp), 16, 0, 0)
template <int BN, bool HAS_SUM, class Prob>
__device__ __forceinline__ void gemm_run(ldsp lds, const Prob& pb, int bid, int nblk) {
    constexpr int NF = BN / 64, GLB = BN / 64, A_BYTES = 32768, B_BYTES = BN * 128, STAGE = A_BYTES + B_BYTES, NSTG = (BN == 128) ? 3 : 2, NGL = 4 + GLB;
    const int tid = otid(), wid = __builtin_amdgcn_readfirstlane(tid >> 6), lane = tid & 63, wr = wid >> 2, wc = wid & 3, fr = lane & 15, fq = lane >> 4;
    const int NU = pb.nunits();
    if (bid >= NU) return;
    const int sb = lane * 16, swz = sb ^ (((sb >> 9) & 1) << 5);
    const int sR0 = (wid >> 1) * 16 + (swz >> 6), sC = (wid & 1) * 32 + ((swz & 63) >> 1);
    const int ob = fr * 64 + fq * 16, lane_off = ob ^ (((ob >> 9) & 1) << 5);
    const unsigned ldsw = (unsigned)wid * 1024u;
    unsigned aoff[4], boff[GLB];
    int su = bid, st = 0, snt = pb.ntiles(su), sbuf = 0, inflight = 0;
#define G_LOAD_OFFS() do { _Pragma("unroll") for (int i = 0; i < 4; ++i) aoff[i] = pb.a_off(su, sR0 + 64 * i) + sC; \
                           _Pragma("unroll") for (int i = 0; i < GLB; ++i) boff[i] = pb.b_off(su, sR0 + 64 * i) + sC; } while (0)
#define G_STAGE() do { if (su < NU) { const T* Ab = pb.a_base(su, st); const T* Bb = pb.b_base(su, st); ldsp sbase = lds + sbuf * STAGE + ldsw; \
        _Pragma("unroll") for (int i = 0; i < 4; ++i) GLDS16(Ab + aoff[i], sbase + i * 8192); \
        _Pragma("unroll") for (int i = 0; i < GLB; ++i) GLDS16(Bb + boff[i], sbase + A_BYTES + i * 8192); \
        ++inflight; sbuf = (sbuf + 1 == NSTG) ? 0 : sbuf + 1; \
        if (++st == snt) { su += nblk; st = 0; if (su < NU) { snt = pb.ntiles(su); G_LOAD_OFFS(); } } } } while (0)
    G_LOAD_OFFS();
    G_STAGE();
    if (NSTG == 3) G_STAGE();
    int buf = 0;
    for (int cu = bid; cu < NU; cu += nblk) {
        f32x4 acc[8][NF]; f32x4 sum[HAS_SUM ? 8 : 1][HAS_SUM ? NF : 1]; uint2 gpre[HAS_SUM ? 8 : 1][HAS_SUM ? NF : 1];
#pragma unroll
        for (int m = 0; m < 8; ++m)
#pragma unroll
            for (int n = 0; n < NF; ++n) { acc[m][n] = (f32x4){0.f, 0.f, 0.f, 0.f}; if (HAS_SUM) sum[m][n] = (f32x4){0.f, 0.f, 0.f, 0.f}; }
        const int nt = pb.ntiles(cu);
        for (int t = 0; t < nt; ++t) {
            if (NSTG == 3) {
                if constexpr (HAS_SUM) { if (inflight >= 2) { if (pb.extra_inflight(t)) asm volatile("s_waitcnt vmcnt(%0)" :: "n"(NGL + 16) : "memory"); else asm volatile("s_waitcnt vmcnt(%0)" :: "n"(NGL) : "memory"); }
                                         else asm volatile("s_waitcnt vmcnt(0)" ::: "memory"); }
                else { if (inflight >= 2) asm volatile("s_waitcnt vmcnt(%0)" :: "n"(NGL) : "memory"); else asm volatile("s_waitcnt vmcnt(0)" ::: "memory"); }
                asm volatile("s_waitcnt lgkmcnt(0)\n\ts_barrier" ::: "memory");
            } else {
                asm volatile("s_waitcnt vmcnt(0)" ::: "memory");
                __syncthreads();
            }
            if constexpr (!(NF == 2 && HAS_SUM)) G_STAGE();
            if constexpr (HAS_SUM) pb.tile_begin(cu, t, gpre, wr, wc, fr, fq);
            const ldsp ta = lds + buf * STAGE + wr * 16384 + lane_off, tb = lds + buf * STAGE + A_BYTES + wc * (NF * 2048) + lane_off;
            if constexpr (NF == 2 && HAS_SUM) {
                const unsigned ta_ = (unsigned)(size_t)ta, tb_ = (unsigned)(size_t)tb;
                bf16x8 a0, a1, a2, a3, a4, a5, a6, a7, b0, b1;
#define G_RD(dst, addr, OFF) asm volatile("ds_read_b128 %0, %1 offset:" #OFF : "=v"(dst) : "v"(addr))
#define G_MM(m, av) do { acc[m][0] = __builtin_amdgcn_mfma_f32_16x16x32_bf16(b0, av, acc[m][0], 0, 0, 0); acc[m][1] = __builtin_amdgcn_mfma_f32_16x16x32_bf16(b1, av, acc[m][1], 0, 0, 0); } while (0)
                const bool g_on = su < NU; const T* gAb = pb.a_base(g_on ? su : cu, st); const T* gBb = pb.b_base(g_on ? su : cu, st); const ldsp gsb = lds + sbuf * STAGE + ldsw;
                G_RD(a0, ta_, 0); G_RD(a1, ta_, 2048); G_RD(a2, ta_, 4096); G_RD(a3, ta_, 6144); G_RD(b0, tb_, 0); G_RD(b1, tb_, 2048);
                if (g_on) { GLDS16(gAb + aoff[0], gsb); GLDS16(gAb + aoff[1], gsb + 8192); }
                asm volatile("s_waitcnt lgkmcnt(0)" : "+v"(a0), "+v"(a1), "+v"(a2), "+v"(a3), "+v"(b0), "+v"(b1));
                __builtin_amdgcn_sched_barrier(0);
                G_RD(a4, ta_, 8192); G_RD(a5, ta_, 10240); G_RD(a6, ta_, 12288); G_RD(a7, ta_, 14336);
                G_MM(0, a0); G_MM(1, a1); G_MM(2, a2); G_MM(3, a3);
                __builtin_amdgcn_sched_barrier(0);
                if (g_on) { GLDS16(gAb + aoff[2], gsb + 2 * 8192); GLDS16(gAb + aoff[3], gsb + 3 * 8192); }
                asm volatile("s_waitcnt lgkmcnt(0)" : "+v"(a4), "+v"(a5), "+v"(a6), "+v"(a7));
                __builtin_amdgcn_sched_barrier(0);
                bf16x8 c0, c1, c2, c3, d0, d1;
                G_RD(c0, ta_, 1024); G_RD(c1, ta_, 3072); G_RD(c2, ta_, 5120); G_RD(c3, ta_, 7168); G_RD(d0, tb_, 1024); G_RD(d1, tb_, 3072);
                G_MM(4, a4); G_MM(5, a5); G_MM(6, a6); G_MM(7, a7);
                __builtin_amdgcn_sched_barrier(0);
                if (g_on) { GLDS16(gBb + boff[0], gsb + A_BYTES); GLDS16(gBb + boff[1], gsb + A_BYTES + 8192);
                            ++inflight; sbuf = (sbuf + 1 == NSTG) ? 0 : sbuf + 1;
                            if (++st == snt) { su += nblk; st = 0; if (su < NU) { snt = pb.ntiles(su); G_LOAD_OFFS(); } } }
                asm volatile("s_waitcnt lgkmcnt(0)" : "+v"(c0), "+v"(c1), "+v"(c2), "+v"(c3), "+v"(d0), "+v"(d1));
                __builtin_amdgcn_sched_barrier(0);
                b0 = d0; b1 = d1;
                G_RD(a4, ta_, 9216); G_RD(a5, ta_, 11264); G_RD(a6, ta_, 13312); G_RD(a7, ta_, 15360);
                G_MM(0, c0); G_MM(1, c1); G_MM(2, c2); G_MM(3, c3);
                __builtin_amdgcn_sched_barrier(0);
                asm volatile("s_waitcnt lgkmcnt(0)" : "+v"(a4), "+v"(a5), "+v"(a6), "+v"(a7));
                __builtin_amdgcn_sched_barrier(0);
                G_MM(4, a4); G_MM(5, a5); G_MM(6, a6); G_MM(7, a7);
                __builtin_amdgcn_sched_barrier(0);
#undef G_RD
#undef G_MM
            } else {
#pragma unroll
            for (int ks = 0; ks < 2; ++ks) {
                bf16x8 At[8], Bf[NF];
#pragma unroll
                for (int m = 0; m < 8; ++m) At[m] = *(const LAS bf16x8*)(ta + m * 2048 + ks * 1024);
#pragma unroll
                for (int n = 0; n < NF; ++n) Bf[n] = *(const LAS bf16x8*)(tb + n * 2048 + ks * 1024);
#pragma unroll
                for (int m = 0; m < 8; ++m)
#pragma unroll
                    for (int n = 0; n < NF; ++n) acc[m][n] = __builtin_amdgcn_mfma_f32_16x16x32_bf16(Bf[n], At[m], acc[m][n], 0, 0, 0);
            }
            }
            if constexpr (HAS_SUM) pb.tile_done(cu, t, acc, sum, gpre, wr, wc, fr, fq);
            --inflight; buf = (buf + 1 == NSTG) ? 0 : buf + 1;
        }
        if constexpr (HAS_SUM) pb.epilogue(cu, sum, wr, wc, fr, fq); else pb.epilogue(cu, acc, wr, wc, fr, fq);
    }
    asm volatile("s_waitcnt vmcnt(0) lgkmcnt(0)\n\ts_barrier" ::: "memory");
#undef G_LOAD_OFFS
#undef G_STAGE
}

struct InProj {
    const T* H; const T* Wt; T* Z; float* SS; const float* gqn; const float* gkn; const float2* tab64; const float2* tab32; int nlat, npm;
    __device__ __forceinline__ int nunits() const { return npm * 25; }
    __device__ __forceinline__ int ntiles(int) const { return 16; }
    __device__ __forceinline__ unsigned a_off(int u, int R) const { return (unsigned)((u / 25) * 256 + R) * 1024u; }
    __device__ __forceinline__ unsigned b_off(int u, int R) const { return (unsigned)((u % 25) * 256 + R) * 1024u; }
    __device__ __forceinline__ const T* a_base(int, int t) const { return H + t * 64; }
    __device__ __forceinline__ const T* b_base(int, int t) const { return Wt + t * 64; }
    __device__ __forceinline__ void epilogue(int u, f32x4 (&acc)[8][4], int wr, int wc, int fr, int fq) const {
        const int pm = u / 25, pn = u % 25, cg = pn * 4 + wc;
        if (cg == 34 || cg == 35) return;
        const int row0 = pm * 256 + wr * 128 + fr;
        const bool lat = pm * 256 < nlat;
        const int zcol = (cg < 36 ? cg * 64 : 2144 + (cg - 36) * 64) + fq * 4;
        const bool t_rms = (cg >= 12 && cg < 18), t_rope = t_rms || (cg >= 20 && cg < 26), t_ssq = (cg >= 28 && cg < 33), t_kr = cg == 33, t_sig = cg >= 36;
        float4 gv[4];
        if (t_rms) { const float* g = cg < 16 ? gqn : gkn;
#pragma unroll
            for (int n = 0; n < 4; ++n) gv[n] = *(const float4*)(g + n * 16 + fq * 4); }
#pragma unroll
        for (int m = 0; m < 8; ++m) {
            const int row = row0 + m * 16;
            const int t = row & (SEQ - 1), gr = t >> 6, gc = t & 63;
            float v[4][4];
#pragma unroll
            for (int n = 0; n < 4; ++n)
#pragma unroll
                for (int j = 0; j < 4; ++j) v[n][j] = acc[m][n][j];
            T* zp = Z + (size_t)row * ZW + zcol;
            if (t_rms || t_ssq) {
                float ss = 0.f;
#pragma unroll
                for (int n = 0; n < 4; ++n)
#pragma unroll
                    for (int j = 0; j < 4; ++j) ss += v[n][j] * v[n][j];
                ss += __shfl_xor(ss, 16); ss += __shfl_xor(ss, 32);
                if (t_ssq) { if (fq == 0) SS[(size_t)row * 8 + (cg - 28)] = ss; }
                else { const float rstd = 1.f / sqrtf(ss * (1.f / 64.f) + EPS);
#pragma unroll
                    for (int n = 0; n < 4; ++n) { v[n][0] *= rstd * gv[n].x; v[n][1] *= rstd * gv[n].y; v[n][2] *= rstd * gv[n].z; v[n][3] *= rstd * gv[n].w; } }
            }
            if (t_rope && lat) {
                const float4* tr = (const float4*)(tab64 + gr * 16 + fq * 4); const float4* tc = (const float4*)(tab64 + gc * 16 + fq * 4);
                const float4 r0 = tr[0], r1 = tr[1], c0 = tc[0], c1 = tc[1];
                const float rc[4] = {r0.x, r0.z, r1.x, r1.z}, rs[4] = {r0.y, r0.w, r1.y, r1.w}, cc[4] = {c0.x, c0.z, c1.x, c1.z}, cs[4] = {c0.y, c0.w, c1.y, c1.w};
#pragma unroll
                for (int j = 0; j < 4; ++j) {
                    const float a0 = v[0][j], a1 = v[1][j], b0 = v[2][j], b1 = v[3][j];
                    v[0][j] = a0 * rc[j] - a1 * rs[j]; v[1][j] = a0 * rs[j] + a1 * rc[j];
                    v[2][j] = b0 * cc[j] - b1 * cs[j]; v[3][j] = b0 * cs[j] + b1 * cc[j];
                }
            }
            if (t_kr) {
#pragma unroll
                for (int n = 0; n < 2; ++n) {
                    const float4* tp = (const float4*)(tab32 + (n == 0 ? gr : gc) * 8 + (fq & 1) * 4);
                    const float4 q0 = tp[0], q1 = tp[1];
                    const float kc[4] = {q0.x, q0.z, q1.x, q1.z}, ks[4] = {q0.y, q0.w, q1.y, q1.w};
#pragma unroll
                    for (int j = 0; j < 4; ++j) { const float x = v[n][j], px = __shfl_xor(x, 32); if (lat) v[n][j] = (fq < 2) ? (x * kc[j] - px * ks[j]) : (px * ks[j] + x * kc[j]); }
                    *(uint2*)(zp + n * 16) = pk4(v[n][0], v[n][1], v[n][2], v[n][3]);
                }
                continue;
            }
            if (t_sig) {
#pragma unroll
                for (int n = 0; n < 4; ++n)
#pragma unroll
                    for (int j = 0; j < 4; ++j) v[n][j] = fast_sigmoid(v[n][j]);
            }
#pragma unroll
            for (int n = 0; n < 4; ++n) *(uint2*)(zp + n * 16) = pk4(v[n][0], v[n][1], v[n][2], v[n][3]);
        }
    }
};

struct MlaProj {
    const T* Z; const T* WqT; const T* WkvT; T* QM; T* KVM; const float* SS; const float2* tab32; int nlat, npm;
    __device__ __forceinline__ int nunits() const { return npm * 7; }
    __device__ __forceinline__ int ntiles(int u) const { return u < npm * 3 ? 3 : 2; }
    __device__ __forceinline__ unsigned a_off(int u, int R) const { const int pm = u < npm * 3 ? u / 3 : (u - npm * 3) / 4; return (unsigned)(pm * 256 + R) * (unsigned)ZW; }
    __device__ __forceinline__ unsigned b_off(int u, int R) const { return u < npm * 3 ? (unsigned)((u % 3) * 128 + R) * 192u : (unsigned)(((u - npm * 3) % 4) * 128 + R) * 128u; }
    __device__ __forceinline__ const T* a_base(int u, int t) const { return Z + (u < npm * 3 ? MCQ : MCKV) + t * 64; }
    __device__ __forceinline__ const T* b_base(int u, int t) const { return (u < npm * 3 ? WqT : WkvT) + t * 64; }
    __device__ __forceinline__ void epilogue(int u, f32x4 (&acc)[8][2], int wr, int wc, int fr, int fq) const {
        const bool isq = u < npm * 3;
        const int pm = isq ? u / 3 : (u - npm * 3) / 4, pn = isq ? u % 3 : (u - npm * 3) % 4;
        const int row0 = pm * 256 + wr * 128 + fr;
        const bool lat = pm * 256 < nlat;
#pragma unroll
        for (int m = 0; m < 8; ++m) {
            const int row = row0 + m * 16;
            const float* ss = SS + (size_t)row * 8;
            const float rstd = isq ? 1.f / sqrtf((ss[0] + ss[1] + ss[2]) * (1.f / 192.f) + EPS) : 1.f / sqrtf((ss[3] + ss[4]) * (1.f / 128.f) + EPS);
            const int t = row & (SEQ - 1), gr = t >> 6, gc = t & 63;
#pragma unroll
            for (int n = 0; n < 2; ++n) {
                float v[4];
#pragma unroll
                for (int j = 0; j < 4; ++j) v[j] = acc[m][n][j] * rstd;
                const int f = pn * 8 + wc * 2 + n;
                if (isq) {
                    const int part = f % 6;
                    if (part >= 4) {
                        const float4* tp = (const float4*)(tab32 + (part == 4 ? gr : gc) * 8 + (fq & 1) * 4);
                        const float4 q0 = tp[0], q1 = tp[1];
                        const float kc[4] = {q0.x, q0.z, q1.x, q1.z}, ks[4] = {q0.y, q0.w, q1.y, q1.w};
#pragma unroll
                        for (int j = 0; j < 4; ++j) { const float x = v[j], px = __shfl_xor(x, 32); if (lat) v[j] = (fq < 2) ? (x * kc[j] - px * ks[j]) : (px * ks[j] + x * kc[j]); }
                    }
                    *(uint2*)(QM + (size_t)row * 384 + f * 16 + fq * 4) = pk4(v[0], v[1], v[2], v[3]);
                } else {
                    *(uint2*)(KVM + (size_t)row * 512 + f * 16 + fq * 4) = pk4(v[0], v[1], v[2], v[3]);
                }
            }
        }
    }
};

struct MergeProb {
    const T* O; const T* WbT; const T* Z; T* MERGED; int npm;
    __device__ __forceinline__ int nunits() const { return npm * 8; }
    __device__ __forceinline__ int ntiles(int) const { return 16; }
    __device__ __forceinline__ unsigned a_off(int u0, int R) const { const int u = xswz(u0, npm * 8); return (unsigned)((u >> 3) * 256 + R) * 1024u; }
    __device__ __forceinline__ unsigned b_off(int u0, int R) const { const int u = xswz(u0, npm * 8); return (unsigned)((u & 7) * 128 + R) * 256u; }
    __device__ __forceinline__ const T* a_base(int, int t) const { return O + (t >> 2) * 256 + (t & 3) * 64; }
    __device__ __forceinline__ const T* b_base(int, int t) const { return WbT + (size_t)(t >> 2) * 1024 * 256 + (t & 3) * 64; }
    __device__ __forceinline__ void tile_begin(int u0, int t, uint2 (&gpre)[8][2], int wr, int wc, int fr, int fq) const {
        if ((t & 3) != 0) return;
        const int u = xswz(u0, npm * 8); const int i = t >> 2, pm = u >> 3, pn = u & 7;
        const T* gp = Z + (size_t)(pm * 256 + wr * 128 + fr) * ZW + GATE + i * 1024 + pn * 128 + wc * 32 + fq * 4;
#pragma unroll
        for (int m = 0; m < 8; ++m)
#pragma unroll
            for (int n = 0; n < 2; ++n) { const T* q_ = gp + (size_t)m * 16 * ZW + n * 16; asm volatile("global_load_dwordx2 %0, %1, off" : "=v"(gpre[m][n]) : "v"(q_)); }
    }
    __device__ __forceinline__ int extra_inflight(int t) const { return ((t & 3) == 1) ? 16 : 0; }
    __device__ __forceinline__ void tile_done(int u, int t, f32x4 (&acc)[8][2], f32x4 (&sum)[8][2], uint2 (&gpre)[8][2], int wr, int wc, int fr, int fq) const {
        if ((t & 3) != 3) return;
#pragma unroll
        for (int m = 0; m < 8; ++m)
#pragma unroll
            for (int n = 0; n < 2; ++n) {
                const uint2 r = gpre[m][n];
                sum[m][n][0] += __uint_as_float(r.x << 16) * acc[m][n][0]; sum[m][n][1] += __uint_as_float(r.x & 0xffff0000u) * acc[m][n][1];
                sum[m][n][2] += __uint_as_float(r.y << 16) * acc[m][n][2]; sum[m][n][3] += __uint_as_float(r.y & 0xffff0000u) * acc[m][n][3];
                acc[m][n] = (f32x4){0.f, 0.f, 0.f, 0.f};
            }
    }
    __device__ __forceinline__ void epilogue(int u0, f32x4 (&sum)[8][2], int wr, int wc, int fr, int fq) const {
        const int u = xswz(u0, npm * 8); const int pm = u >> 3, pn = u & 7;
        T* op = MERGED + (size_t)(pm * 256 + wr * 128 + fr) * 1024 + pn * 128 + wc * 32 + fq * 4;
#pragma unroll
        for (int m = 0; m < 8; ++m)
#pragma unroll
            for (int n = 0; n < 2; ++n) *(uint2*)(op + (size_t)m * 16 * 1024 + n * 16) = pk4(sum[m][n][0], sum[m][n][1], sum[m][n][2], sum[m][n][3]);
    }
};

struct PlainProb {
    const T* A; const T* Bt; T* C; int npm, npn, K, lda, ldc;
    __device__ __forceinline__ int nunits() const { return npm * npn; }
    __device__ __forceinline__ int ntiles(int) const { return K / 64; }
    __device__ __forceinline__ unsigned a_off(int u0, int R) const { const int u = xswz(u0, npm * npn); return (unsigned)((u / npn) * 256 + R) * (unsigned)lda; }
    __device__ __forceinline__ unsigned b_off(int u0, int R) const { const int u = xswz(u0, npm * npn); return (unsigned)((u % npn) * 128 + R) * (unsigned)K; }
    __device__ __forceinline__ const T* a_base(int, int t) const { return A + t * 64; }
    __device__ __forceinline__ const T* b_base(int, int t) const { return Bt + t * 64; }
    __device__ __forceinline__ void epilogue(int u0, f32x4 (&acc)[8][2], int wr, int wc, int fr, int fq) const {
        const int u = xswz(u0, npm * npn); const int pm = u / npn, pn = u % npn;
        T* op = C + (size_t)(pm * 256 + wr * 128 + fr) * ldc + pn * 128 + wc * 32 + fq * 4;
#pragma unroll
        for (int m = 0; m < 8; ++m)
#pragma unroll
            for (int n = 0; n < 2; ++n) *(uint2*)(op + (size_t)m * 16 * ldc + n * 16) = pk4(acc[m][n][0], acc[m][n][1], acc[m][n][2], acc[m][n][3]);
    }
};

constexpr int CTXB = NB * NE * CAP;
struct FfnUp {
    const T* H2; const T* WguT; const int* IDX; T* ACT; int nun;
    __device__ __forceinline__ int nunits() const { return nun; }
    __device__ __forceinline__ int ntiles(int) const { return 16; }
    __device__ __forceinline__ void decode(int u, int& e, int& pn, int& sbase, bool& isctx) const {
        if (u < 2048) { e = u >> 7; const int rem = u & 127; pn = rem & 7; sbase = ((rem >> 5) * NE + e) * CAP + ((rem >> 3) & 3) * 256; isctx = false; }
        else { const int uc = u - 2048; e = uc >> 3; pn = uc & 7; sbase = CTXB + e * CAPC; isctx = true; }
    }
    __device__ __forceinline__ int slot_of(int sbase, bool isctx, int R) const { return isctx ? (R < 128 ? sbase + (R >> 5) * (NE * CAPC) + (R & 31) : -1) : sbase + R; }
    __device__ __forceinline__ unsigned a_off(int u, int R) const { int e, pn, sb; bool ic; decode(u, e, pn, sb, ic); const int s = slot_of(sb, ic, R); return s < 0 ? 0u : (unsigned)IDX[s] * 1024u; }
    __device__ __forceinline__ unsigned b_off(int u, int R) const { int e, pn, sb; bool ic; decode(u, e, pn, sb, ic); return (unsigned)(e * 2048 + pn * 256 + R) * 1024u; }
    __device__ __forceinline__ const T* a_base(int, int t) const { return H2 + t * 64; }
    __device__ __forceinline__ const T* b_base(int, int t) const { return WguT + t * 64; }
    __device__ __forceinline__ void epilogue(int u, f32x4 (&acc)[8][4], int wr, int wc, int fr, int fq) const {
        int e, pn, sb; bool ic; decode(u, e, pn, sb, ic);
        const int col = (pn * 4 + wc) * 32 + fq * 4;
#pragma unroll
        for (int m = 0; m < 8; ++m) {
            const int s = slot_of(sb, ic, wr * 128 + m * 16 + fr);
            if (s < 0) continue;
            T* op = ACT + (size_t)s * FF + col;
#pragma unroll
            for (int n = 0; n < 2; ++n)
                *(uint2*)(op + n * 16) = pk4(fast_silu(acc[m][n][0]) * acc[m][n + 2][0], fast_silu(acc[m][n][1]) * acc[m][n + 2][1],
                                             fast_silu(acc[m][n][2]) * acc[m][n + 2][2], fast_silu(acc[m][n][3]) * acc[m][n + 2][3]);
        }
    }
};
struct FfnDown {
    const T* ACT; const T* WdT; const float* GATEV; T* OUT; int nun;
    __device__ __forceinline__ int nunits() const { return nun; }
    __device__ __forceinline__ int ntiles(int) const { return 16; }
    __device__ __forceinline__ void decode(int u, int& e, int& pn, int& sbase, bool& isctx) const {
        if (u < 1024) { e = u >> 6; const int rem = u & 63; pn = rem & 3; sbase = ((rem >> 4) * NE + e) * CAP + ((rem >> 2) & 3) * 256; isctx = false; }
        else { const int uc = u - 1024; e = uc >> 2; pn = uc & 3; sbase = CTXB + e * CAPC; isctx = true; }
    }
    __device__ __forceinline__ int slot_of(int sbase, bool isctx, int R) const { return isctx ? (R < 128 ? sbase + (R >> 5) * (NE * CAPC) + (R & 31) : -1) : sbase + R; }
    __device__ __forceinline__ unsigned a_off(int u, int R) const { int e, pn, sb; bool ic; decode(u, e, pn, sb, ic); const int s = slot_of(sb, ic, R); return s < 0 ? 0u : (unsigned)s * 1024u; }
    __device__ __forceinline__ unsigned b_off(int u, int R) const { int e, pn, sb; bool ic; decode(u, e, pn, sb, ic); return (unsigned)(e * 1024 + pn * 256 + R) * 1024u; }
    __device__ __forceinline__ const T* a_base(int, int t) const { return ACT + t * 64; }
    __device__ __forceinline__ const T* b_base(int, int t) const { return WdT + t * 64; }
    __device__ __forceinline__ void epilogue(int u, f32x4 (&acc)[8][4], int wr, int wc, int fr, int fq) const {
        int e, pn, sb; bool ic; decode(u, e, pn, sb, ic);
        const int col = pn * 256 + wc * 64 + fq * 4;
#pragma unroll
        for (int m = 0; m < 8; ++m) {
            const int s = slot_of(sb, ic, wr * 128 + m * 16 + fr);
            if (s < 0) continue;
            const float g = GATEV[s];
            T* op = OUT + (size_t)s * D + col;
#pragma unroll
            for (int n = 0; n < 4; ++n) *(uint2*)(op + n * 16) = pk4(acc[m][n][0] * g, acc[m][n][1] * g, acc[m][n][2] * g, acc[m][n][3] * g);
        }
    }
};

namespace pg8 {
#define PG8_LAS __attribute__((address_space(3)))
constexpr int BM = 256, BK = 64, HALF = 128, HTB = HALF * BK * 2, STAGE_BYTES = 8 * HTB;
__host__ __device__ __forceinline__ int lds_byte(int r, int c) { const int st = (r >> 4) * 2 + (c >> 5), rr = r & 15, cc = c & 31, ob = rr * 64 + cc * 2; return st * 1024 + (ob ^ (((ob >> 9) & 1) << 5)); }
__host__ __device__ __forceinline__ void stage_rc(int b, int& R, int& C) { const int st = b / 1024, sb = b % 1024, swz = sb ^ (((sb >> 9) & 1) << 5); R = (st >> 1) * 16 + swz / 64; C = (st & 1) * 32 + (swz % 64) / 2; }
__host__ __device__ __forceinline__ int perm32(int rho) { const int n = rho >> 4, i = rho & 15; return 8 * (i >> 2) + 4 * n + (i & 3); }
struct Unit { int pm, pn; const char* a; const char* b; int x0, x1; };
template <class Epi, class Sched, bool ALIGN_EPI = false, bool SP2 = false>
__device__ __forceinline__ void gemm_phase(PG8_LAS unsigned char* lds, const int K, const Sched& S, const Epi& E) {
    const int tid = otid(), wid = __builtin_amdgcn_readfirstlane(tid >> 6), lane = tid & 63, wr = wid >> 2, wc = wid & 3, fr = lane & 15, fq = lane >> 4;
    const int nt = K / BK;
    unsigned voffA[2], voffB[2];
#pragma unroll
    for (int i = 0; i < 2; ++i) { int R, C; stage_rc(tid * 16 + i * 8192, R, C); const int Rb = Epi::PERM ? ((R & ~31) + perm32(R & 31)) : R;
        voffA[i] = (unsigned)(R * K + C) * 2u; voffB[i] = (unsigned)(Rb * K + C) * 2u; }
    const size_t kstep = (size_t)(BK * 2);
    const size_t hstep = (size_t)HALF * K * 2;
    const unsigned ldsw = (unsigned)wid * 1024u;
    const int aoff = lds_byte(wr * 64 + fr, fq * 8), boff = lds_byte(wc * 32 + fr, fq * 8);
#define PG8_SA(b, h) (((b) * 2 + (h)) * HTB)
#define PG8_SB(b, h) ((4 + (b) * 2 + (h)) * HTB)
#define PG8_STAGE(bufoff, gbase, voff) do { _Pragma("unroll") for (int _i = 0; _i < 2; ++_i) \
        __builtin_amdgcn_global_load_lds((const unsigned*)((const char*)(gbase) + (voff)[_i]), (PG8_LAS unsigned*)(lds + (bufoff) + ldsw + _i * 8192), 16, 0, 0); } while (0)
#define PG8_LDA(dst, b, h) do { _Pragma("unroll") for (int m = 0; m < 4; ++m) _Pragma("unroll") for (int k = 0; k < 2; ++k) dst[m][k] = *(const PG8_LAS bf16x8*)(lds + PG8_SA(b, h) + aoff + m * 2048 + k * 1024); } while (0)
#define PG8_LDB(dst, b, h) do { _Pragma("unroll") for (int n = 0; n < 2; ++n) _Pragma("unroll") for (int k = 0; k < 2; ++k) dst[n][k] = *(const PG8_LAS bf16x8*)(lds + PG8_SB(b, h) + boff + n * 2048 + k * 1024); } while (0)
#define PG8_MMA(ai, bj, At, Bt) do { __builtin_amdgcn_s_setprio(1); _Pragma("unroll") for (int m = 0; m < 4; ++m) _Pragma("unroll") for (int n = 0; n < 2; ++n) _Pragma("unroll") for (int k = 0; k < 2; ++k) \
        acc[ai][bj][m][n] = __builtin_amdgcn_mfma_f32_16x16x32_bf16(Bt[n][k], At[m][k], acc[ai][bj][m][n], 0, 0, 0); __builtin_amdgcn_s_setprio(0); } while (0)
#define PG8_WAIT_V(n) asm volatile("s_waitcnt vmcnt(" #n ")" ::: "memory")
#define PG8_WAIT_L(n) asm volatile("s_waitcnt lgkmcnt(" #n ")" ::: "memory")
#define PG8_BAR __builtin_amdgcn_s_barrier()
#define PG8_SCHED __builtin_amdgcn_sched_barrier(0)
    Unit cur, nxt; int ui = 0;
    if (!S.next(0, cur)) return;
    f32x4 acc[2][2][4][2];
#pragma unroll
    for (int a = 0; a < 2; ++a)
#pragma unroll
        for (int b = 0; b < 2; ++b)
#pragma unroll
            for (int m = 0; m < 4; ++m)
#pragma unroll
                for (int n = 0; n < 2; ++n) acc[a][b][m][n] = (f32x4){0.f, 0.f, 0.f, 0.f};
    bf16x8 At[4][2], B0[2][2], B1[2][2];
    const char* cA = cur.a; const char* cB = cur.b;
    S.a_ready(cur);
    if constexpr (SP2) {
        PG8_STAGE(PG8_SB(0, 0), cB, voffB); PG8_STAGE(PG8_SB(0, 1), cB + hstep, voffB); PG8_STAGE(PG8_SA(0, 0), cA, voffA); PG8_STAGE(PG8_SA(0, 1), cA + hstep, voffA);
        if (wr == 1) PG8_BAR;
        PG8_WAIT_V(2); PG8_BAR;
        PG8_STAGE(PG8_SB(1, 0), cB + kstep, voffB); PG8_STAGE(PG8_SA(1, 0), cA + kstep, voffA); PG8_STAGE(PG8_SB(1, 1), cB + hstep + kstep, voffB);
        PG8_WAIT_V(6); PG8_BAR;
    } else {
        PG8_STAGE(PG8_SB(0, 0), cB, voffB); PG8_STAGE(PG8_SA(0, 0), cA, voffA); PG8_STAGE(PG8_SB(0, 1), cB + hstep, voffB); PG8_STAGE(PG8_SA(0, 1), cA + hstep, voffA);
        if (wr == 1) PG8_BAR;
        PG8_WAIT_V(4); PG8_BAR;
        PG8_STAGE(PG8_SB(1, 0), cB + kstep, voffB); PG8_STAGE(PG8_SA(1, 0), cA + kstep, voffA); PG8_STAGE(PG8_SB(1, 1), cB + hstep + kstep, voffB);
        PG8_WAIT_V(6); PG8_BAR;
    }
    for (;;) {
        const bool has_next = S.next(ui + 1, nxt);
        const char* nA = has_next ? nxt.a : cA; const char* nB = has_next ? nxt.b : cB;
        for (int t = 0; t < nt; t += 2) {
            const bool last = (t == nt - 2);
            const char* a1 = cA + (size_t)(t + 1) * kstep;
            const char* a2 = last ? nA : cA + (size_t)(t + 2) * kstep; const char* b2 = last ? nB : cB + (size_t)(t + 2) * kstep;
            const char* a3 = a2 + kstep; const char* b3 = b2 + kstep;
            if (last && has_next) S.a_ready(nxt);
            if constexpr (SP2) {
            PG8_LDB(B0, 0, 0); PG8_LDB(B1, 0, 1); PG8_SCHED; PG8_LDA(At, 0, 0); PG8_STAGE(PG8_SA(1, 1), a1 + hstep, voffA);
            PG8_WAIT_V(8); PG8_WAIT_L(0); PG8_BAR; PG8_MMA(0, 0, At, B0); PG8_MMA(0, 1, At, B1); PG8_BAR; PG8_SCHED;
            PG8_LDA(At, 0, 1); PG8_STAGE(PG8_SB(0, 0), b2, voffB); PG8_STAGE(PG8_SB(0, 1), b2 + hstep, voffB); PG8_STAGE(PG8_SA(0, 0), a2, voffA);
            PG8_WAIT_V(8); PG8_WAIT_L(0); PG8_BAR; PG8_MMA(1, 0, At, B0); PG8_MMA(1, 1, At, B1); PG8_BAR; PG8_SCHED;
            PG8_LDB(B0, 1, 0); PG8_LDB(B1, 1, 1); PG8_SCHED; PG8_LDA(At, 1, 0); PG8_STAGE(PG8_SA(0, 1), a2 + hstep, voffA);
            PG8_WAIT_V(8); PG8_WAIT_L(0); PG8_BAR; PG8_MMA(0, 0, At, B0); PG8_MMA(0, 1, At, B1); PG8_BAR; PG8_SCHED;
            PG8_LDA(At, 1, 1); PG8_STAGE(PG8_SB(1, 0), b3, voffB); PG8_STAGE(PG8_SB(1, 1), b3 + hstep, voffB); PG8_STAGE(PG8_SA(1, 0), a3, voffA);
            PG8_WAIT_V(8); PG8_WAIT_L(0); PG8_BAR; PG8_MMA(1, 0, At, B0); PG8_MMA(1, 1, At, B1); PG8_BAR; PG8_SCHED;
            } else {
            PG8_LDB(B0, 0, 0); PG8_SCHED; PG8_LDA(At, 0, 0); PG8_STAGE(PG8_SA(1, 1), a1 + hstep, voffA);
            PG8_WAIT_L(8); PG8_BAR; PG8_WAIT_L(0); PG8_MMA(0, 0, At, B0); PG8_BAR; PG8_SCHED;
            PG8_LDB(B1, 0, 1); PG8_STAGE(PG8_SB(0, 0), b2, voffB);
            PG8_BAR; PG8_WAIT_L(0); PG8_MMA(0, 1, At, B1); PG8_BAR;
            PG8_LDA(At, 0, 1); PG8_STAGE(PG8_SA(0, 0), a2, voffA);
            PG8_BAR; PG8_WAIT_L(0); PG8_MMA(1, 0, At, B0); PG8_BAR; PG8_SCHED;
            PG8_STAGE(PG8_SB(0, 1), b2 + hstep, voffB);
            PG8_WAIT_V(6); PG8_BAR; PG8_MMA(1, 1, At, B1); PG8_BAR;
            PG8_LDB(B0, 1, 0); PG8_SCHED; PG8_LDA(At, 1, 0); PG8_STAGE(PG8_SA(0, 1), a2 + hstep, voffA);
            PG8_WAIT_L(8); PG8_BAR; PG8_WAIT_L(0); PG8_MMA(0, 0, At, B0); PG8_BAR; PG8_SCHED;
            PG8_LDB(B1, 1, 1); PG8_STAGE(PG8_SB(1, 0), b3, voffB);
            PG8_BAR; PG8_WAIT_L(0); PG8_MMA(0, 1, At, B1); PG8_BAR;
            PG8_LDA(At, 1, 1); PG8_STAGE(PG8_SA(1, 0), a3, voffA);
            PG8_BAR; PG8_WAIT_L(0); PG8_MMA(1, 0, At, B0); PG8_BAR; PG8_SCHED;
            PG8_STAGE(PG8_SB(1, 1), b3 + hstep, voffB);
            PG8_WAIT_V(6); PG8_BAR; PG8_MMA(1, 1, At, B1); PG8_BAR;
            }
        }
        if constexpr (ALIGN_EPI) { if (wr == 0) PG8_BAR; }
        if constexpr (!Epi::AFTER_DRAIN) { E(acc, cur, wr, wc, fr, fq); S.done(cur); }
        if (!has_next) break;
#pragma unroll
        for (int a = 0; a < 2; ++a)
#pragma unroll
            for (int b = 0; b < 2; ++b)
#pragma unroll
                for (int m = 0; m < 4; ++m)
#pragma unroll
                    for (int n = 0; n < 2; ++n) acc[a][b][m][n] = (f32x4){0.f, 0.f, 0.f, 0.f};
        cur = nxt; cA = nA; cB = nB; ++ui;
        if constexpr (ALIGN_EPI) { if (wr == 1) PG8_BAR; }
    }
    PG8_WAIT_V(0);
    if constexpr (!ALIGN_EPI) { if (wr == 0) PG8_BAR; }
    PG8_BAR;
    if constexpr (Epi::AFTER_DRAIN) { E.fused(acc, cur, wr, wc, fr, fq, lds, wid, lane); S.done(cur); }
#undef PG8_SA
#undef PG8_SB
#undef PG8_STAGE
#undef PG8_LDA
#undef PG8_LDB
#undef PG8_MMA
#undef PG8_WAIT_V
#undef PG8_WAIT_L
#undef PG8_BAR
#undef PG8_SCHED
}
}

struct SchedBase { __device__ __forceinline__ void a_ready(const pg8::Unit&) const {} __device__ __forceinline__ void done(const pg8::Unit&) const {} };
#define ACC8(mm, nn) acc[(mm) >> 2][(nn) >> 1][(mm) & 3][(nn) & 1]
#define ROW8(mm) (((mm) >> 2) * 128 + wr * 64 + ((mm) & 3) * 16 + fr)

struct InProj8S : SchedBase { const T* H; const T* Wt; int npm, bid, nblk, nun;
    __device__ __forceinline__ bool next(int i, pg8::Unit& u) const { const int x0 = bid + i * nblk; if (x0 >= nun) return false; const int x = xswz(x0, nun);
        if (x < 3200 || nun == 3300) { u.pm = x / 25; u.pn = x % 25; } else { const int y = x - 3200; u.pm = 128 + y / 9; u.pn = y % 9; }
        u.a = (const char*)(H + (size_t)u.pm * 256 * D); u.b = (const char*)(Wt + (size_t)u.pn * 256 * D); return true; } };
struct InProj8E {
    static constexpr bool PERM = false, AFTER_DRAIN = false;
    T* Z; float* SS; const float* gqn; const float* gkn; const float2* tab64; const float2* tab32;
    __device__ __forceinline__ void operator()(const f32x4 (&acc)[2][2][4][2], const pg8::Unit& u, int wr, int wc, int fr, int fq) const {
        const int pm = u.pm, cg = u.pn * 4 + wc;
        if (cg == 34 || cg == 35) return;
        const bool lat = pm * 256 < NLAT;
        const int zcol = (cg < 36 ? cg * 64 : 2144 + (cg - 36) * 64) + fq * 4;
        const bool t_rms = (cg >= 12 && cg < 18), t_rope = t_rms || (cg >= 20 && cg < 26), t_ssq = (cg >= 28 && cg < 33), t_kr = cg == 33, t_sig = cg >= 36;
        float4 gv[4];
        if (t_rms) { const float* g = cg < 16 ? gqn : gkn;
#pragma unroll
            for (int n = 0; n < 4; ++n) gv[n] = *(const float4*)(g + n * 16 + fq * 4); }
#pragma unroll
        for (int m = 0; m < 8; ++m) {
            const int row = pm * 256 + ROW8(m);
            const int t = row & (SEQ - 1), gr = t >> 6, gc = t & 63;
            float v[4][4];
#pragma unroll
            for (int n = 0; n < 4; ++n)
#pragma unroll
                for (int j = 0; j < 4; ++j) v[n][j] = ACC8(m, n)[j];
            T* zp = Z + (size_t)row * ZW + zcol;
            if (t_rms || t_ssq) {
                float ss = 0.f;
#pragma unroll
                for (int n = 0; n < 4; ++n)
#pragma unroll
                    for (int j = 0; j < 4; ++j) ss += v[n][j] * v[n][j];
                ss += __shfl_xor(ss, 16); ss += __shfl_xor(ss, 32);
                if (t_ssq) { if (fq == 0) SS[(size_t)row * 8 + (cg - 28)] = ss; }
                else { const float rstd = 1.f / sqrtf(ss * (1.f / 64.f) + EPS);
#pragma unroll
                    for (int n = 0; n < 4; ++n) { v[n][0] *= rstd * gv[n].x; v[n][1] *= rstd * gv[n].y; v[n][2] *= rstd * gv[n].z; v[n][3] *= rstd * gv[n].w; } }
            }
            if (t_rope && lat) {
                const float4* tr = (const float4*)(tab64 + gr * 16 + fq * 4); const float4* tc = (const float4*)(tab64 + gc * 16 + fq * 4);
                const float4 r0 = tr[0], r1 = tr[1], c0 = tc[0], c1 = tc[1];
                const float rc[4] = {r0.x, r0.z, r1.x, r1.z}, rs[4] = {r0.y, r0.w, r1.y, r1.w}, cc[4] = {c0.x, c0.z, c1.x, c1.z}, cs[4] = {c0.y, c0.w, c1.y, c1.w};
#pragma unroll
                for (int j = 0; j < 4; ++j) {
                    const float a0 = v[0][j], a1 = v[1][j], b0 = v[2][j], b1 = v[3][j];
                    v[0][j] = a0 * rc[j] - a1 * rs[j]; v[1][j] = a0 * rs[j] + a1 * rc[j];
                    v[2][j] = b0 * cc[j] - b1 * cs[j]; v[3][j] = b0 * cs[j] + b1 * cc[j];
                }
            }
            if (t_kr) {
#pragma unroll
                for (int n = 0; n < 2; ++n) {
                    const float4* tp = (const float4*)(tab32 + (n == 0 ? gr : gc) * 8 + (fq & 1) * 4);
                    const float4 q0 = tp[0], q1 = tp[1];
                    const float kc[4] = {q0.x, q0.z, q1.x, q1.z}, ks[4] = {q0.y, q0.w, q1.y, q1.w};
#pragma unroll
                    for (int j = 0; j < 4; ++j) { const float x = v[n][j], px = __shfl_xor(x, 32); if (lat) v[n][j] = (fq < 2) ? (x * kc[j] - px * ks[j]) : (px * ks[j] + x * kc[j]); }
                    *(uint2*)(zp + n * 16) = pk4(v[n][0], v[n][1], v[n][2], v[n][3]);
                }
                continue;
            }
            if (t_sig) {
#pragma unroll
                for (int n = 0; n < 4; ++n)
#pragma unroll
                    for (int j = 0; j < 4; ++j) v[n][j] = fast_sigmoid(v[n][j]);
            }
#pragma unroll
            for (int n = 0; n < 4; ++n) *(uint2*)(zp + n * 16) = pk4(v[n][0], v[n][1], v[n][2], v[n][3]);
        }
    }
};

struct FfnUp8S : SchedBase { const T* XG; const T* WguT; int nun, bid, nblk;
    __device__ __forceinline__ bool next(int i, pg8::Unit& u) const { const int x0 = bid + i * nblk; if (x0 >= nun) return false; const int x = xswz(x0, nun); int e, sb;
        if (x < 2048) { e = x >> 7; const int rem = x & 127; u.pn = rem & 7; sb = ((rem >> 5) * NE + e) * CAP + ((rem >> 3) & 3) * 256; u.x1 = 256; }
        else { const int uc = x - 2048; e = uc >> 3; u.pn = uc & 7; sb = CTXB + e * (NB * CAPC); u.x1 = NB * CAPC; }
        u.pm = 0; u.x0 = sb; u.a = (const char*)(XG + (size_t)sb * D); u.b = (const char*)(WguT + ((size_t)e * 2048 + u.pn * 256) * D); return true; } };
struct FfnUp8E {
    static constexpr bool PERM = false, AFTER_DRAIN = false;
    T* ACT;
    __device__ __forceinline__ void operator()(const f32x4 (&acc)[2][2][4][2], const pg8::Unit& u, int wr, int wc, int fr, int fq) const {
        const int col = (u.pn * 4 + wc) * 32 + fq * 4;
#pragma unroll
        for (int m = 0; m < 8; ++m) {
            const int R = ROW8(m);
            if (R >= u.x1) continue;
            T* op = ACT + (size_t)(u.x0 + R) * FF + col;
#pragma unroll
            for (int n = 0; n < 2; ++n) { const f32x4 g = ACC8(m, n), w = ACC8(m, n + 2);
                *(uint2*)(op + n * 16) = pk4(fast_silu(g[0]) * w[0], fast_silu(g[1]) * w[1], fast_silu(g[2]) * w[2], fast_silu(g[3]) * w[3]); }
        }
    }
};
struct FfnDown8S : SchedBase { const T* ACT; const T* WdT; int nun, bid, nblk;
    __device__ __forceinline__ bool next(int i, pg8::Unit& u) const { const int x0 = bid + i * nblk; if (x0 >= nun) return false; const int x = xswz(x0, nun); int e, sb;
        if (x < 1024) { e = x >> 6; const int rem = x & 63; u.pn = rem & 3; sb = ((rem >> 4) * NE + e) * CAP + ((rem >> 2) & 3) * 256; u.x1 = 256; }
        else { const int uc = x - 1024; e = uc >> 2; u.pn = uc & 3; sb = CTXB + e * (NB * CAPC); u.x1 = NB * CAPC; }
        u.pm = 0; u.x0 = sb; u.a = (const char*)(ACT + (size_t)sb * FF); u.b = (const char*)(WdT + ((size_t)e * 1024 + u.pn * 256) * FF); return true; } };
struct FfnDown8E {
    static constexpr bool PERM = false, AFTER_DRAIN = false;
    const float* GATEV; T* OUT;
    __device__ __forceinline__ void operator()(const f32x4 (&acc)[2][2][4][2], const pg8::Unit& u, int wr, int wc, int fr, int fq) const {
        const int col = u.pn * 256 + wc * 64 + fq * 4;
#pragma unroll
        for (int m = 0; m < 8; ++m) {
            const int R = ROW8(m);
            if (R >= u.x1) continue;
            const int s = u.x0 + R; const float g = GATEV[s];
            T* op = OUT + (size_t)s * D + col;
#pragma unroll
            for (int n = 0; n < 4; ++n) { const f32x4 a = ACC8(m, n); *(uint2*)(op + n * 16) = pk4(a[0] * g, a[1] * g, a[2] * g, a[3] * g); }
        }
    }
};
struct Plain8S : SchedBase { const T* A; const T* Bt; int npm, npn, K, bid, nblk;
    __device__ __forceinline__ bool next(int i, pg8::Unit& u) const { const int x0 = bid + i * nblk; if (x0 >= npm * npn) return false; const int x = xswz(x0, npm * npn); u.pm = x / npn; u.pn = x % npn;
        u.a = (const char*)(A + (size_t)u.pm * 256 * K); u.b = (const char*)(Bt + (size_t)u.pn * 256 * K); return true; } };
struct Plain8E {
    static constexpr bool PERM = false, AFTER_DRAIN = false;
    T* C; int ldc;
    __device__ __forceinline__ void operator()(const f32x4 (&acc)[2][2][4][2], const pg8::Unit& u, int wr, int wc, int fr, int fq) const {
        const int col = u.pn * 256 + wc * 64 + fq * 4;
#pragma unroll
        for (int m = 0; m < 8; ++m) {
            T* op = C + (size_t)(u.pm * 256 + ROW8(m)) * ldc + col;
#pragma unroll
            for (int n = 0; n < 4; ++n) { const f32x4 a = ACC8(m, n); *(uint2*)(op + n * 16) = pk4(a[0], a[1], a[2], a[3]); }
        }
    }
};
__device__ __forceinline__ void ph_gather(const T* H2, const int* IDX, T* XG, int nslot, int bid, int nblk) {
    const int tid_ = otid(); const int lane = tid_ & 63, wid = tid_ >> 6;
    for (int s0 = (bid * 8 + wid) * 2; s0 < nslot; s0 += nblk * 16) {
        const int i0 = IDX[s0], i1 = IDX[s0 + 1];
        const uint4 a0 = *(const uint4*)(H2 + (size_t)i0 * D + lane * 8), a1 = *(const uint4*)(H2 + (size_t)i0 * D + 512 + lane * 8);
        const uint4 b0 = *(const uint4*)(H2 + (size_t)i1 * D + lane * 8), b1 = *(const uint4*)(H2 + (size_t)i1 * D + 512 + lane * 8);
        *(uint4*)(XG + (size_t)s0 * D + lane * 8) = a0; *(uint4*)(XG + (size_t)s0 * D + 512 + lane * 8) = a1;
        *(uint4*)(XG + (size_t)(s0 + 1) * D + lane * 8) = b0; *(uint4*)(XG + (size_t)(s0 + 1) * D + 512 + lane * 8) = b1;
    }
}

typedef float f32x16 __attribute__((ext_vector_type(16)));
typedef short s16x4 __attribute__((ext_vector_type(4)));
typedef short v4i16_t __attribute__((ext_vector_type(4)));
struct AttnP { const T* Z; const T* QM; const T* KVM; T* O; const float* rpb; const float* sink; int nlat; int need_ctx; float* o32; int fake; };
constexpr int ATT_LDS = 2 * (64 * 208 + 8192) + 2048 + 8 * 6144;
__device__ __forceinline__ int crow(int r, int hi) { return (r & 3) + 8 * (r >> 2) + 4 * hi; }
__device__ __forceinline__ float xhalf_max(float v) { auto rr = __builtin_amdgcn_permlane32_swap(__float_as_uint(v), __float_as_uint(v), false, false); return fmaxf(__uint_as_float(rr[0]), __uint_as_float(rr[1])); }
__device__ __forceinline__ float xhalf_sum(float v) { auto rr = __builtin_amdgcn_permlane32_swap(__float_as_uint(v), __float_as_uint(v), false, false); return __uint_as_float(rr[0]) + __uint_as_float(rr[1]); }
__device__ __forceinline__ unsigned cvtpk(float lo, float hi) { typedef float f2 __attribute__((ext_vector_type(2))); typedef __bf16 b2 __attribute__((ext_vector_type(2))); f2 v = {lo, hi}; b2 b = __builtin_convertvector(v, b2); return __builtin_bit_cast(unsigned, b); }

__device__ __forceinline__ float max3f(float a, float b, float c) { float r; asm("v_max3_f32 %0, %1, %2, %3" : "=v"(r) : "v"(a), "v"(b), "v"(c)); return r; }
template <int BR>
__device__ __forceinline__ void attn_unit(ldsp lds, const AttnP& P, int b, int hx, int q0, bool ctxq) {
    constexpr int DQK = (BR == 3) ? 96 : 64, NKS = DQK / 16, KP = DQK * 2 + 16, KBYTES = 64 * KP;
    constexpr int KB0 = 0, KB1 = 64 * 208, VB0 = 2 * 64 * 208, VB1 = VB0 + 8192, BT0 = VB1 + 8192, QF0 = BT0 + 2048;
    constexpr bool PACK2 = (BR == 1 || BR == 2);
    constexpr float SCALE = (BR == 3) ? 0.10206207261596575f : 0.125f;
    constexpr float CL2 = SCALE * 1.4426950408889634f;
    constexpr float NEG = -1e30f, THR = 8.f;
    const int tid = otid(), lane = tid & 63, wid = __builtin_amdgcn_readfirstlane(tid >> 6), r32 = lane & 31, hi = lane >> 5;
    const int tokq = q0 + (PACK2 ? (wid & 3) : wid) * 32 + r32;
    const int head = PACK2 ? hx * 2 + (wid >> 2) : hx;
    const size_t lat0 = (size_t)b * SEQ, ctx0 = (size_t)P.nlat + (size_t)b * CTX;
    const size_t qrow = ctxq ? ctx0 + tokq : lat0 + tokq;
    const ldsp qlds = lds + QF0 + wid * 6144 + lane * 16;
    { const T* qp = (BR == 3) ? P.QM + qrow * 384 + head * 96 + hi * 8 : P.Z + qrow * ZW + (BR == 0 ? NAQ : BR == 1 ? GQ : SQ) + head * 64 + hi * 8;
#pragma unroll
      for (int ks = 0; ks < NKS; ++ks) {
          const uint4 raw = *(const uint4*)(qp + ks * 16);
          typedef unsigned u4 __attribute__((ext_vector_type(4)));
          const u4 w = {cvtpk(__uint_as_float(raw.x << 16) * CL2, __uint_as_float(raw.x & 0xffff0000u) * CL2), cvtpk(__uint_as_float(raw.y << 16) * CL2, __uint_as_float(raw.y & 0xffff0000u) * CL2),
                        cvtpk(__uint_as_float(raw.z << 16) * CL2, __uint_as_float(raw.z & 0xffff0000u) * CL2), cvtpk(__uint_as_float(raw.w << 16) * CL2, __uint_as_float(raw.w & 0xffff0000u) * CL2)};
          *(LAS u4*)(qlds + ks * 1024) = w; } }
    int klo = 0, nlt = 0;
    if (!ctxq) {
        if (BR == 0) { const int r0 = q0 >> 6; const int lo = min(max(r0 - 4, 0), GROWS - 8), hi2 = min(max(r0 - 1, 0), GROWS - 8) + 8; klo = lo * 64; nlt = hi2 - lo; }
        else if (BR == 2) { klo = max(q0 - 128, 0); nlt = (min(q0 + 256, SEQ) - klo) >> 6; }
        else { klo = 0; nlt = SEQ / 64; }
    }
    const int nt = 4 + nlt;
    const int skey = tid >> 3, sch = tid & 7, rkey = (tid & 255) >> 2, rch = tid & 3;
    const T* ksrc; const T* vsrc; const T* rsrc = nullptr; size_t kpitch;
    if (BR == 3) { ksrc = P.KVM + (size_t)skey * 512 + hx * 128 + sch * 8; vsrc = ksrc + 64; kpitch = 512; rsrc = P.Z + (size_t)rkey * ZW + MKR + rch * 8; }
    else { const int ko = (BR == 0 ? NAK : BR == 1 ? GK : SK) + hx * 64 + sch * 8, vo = (BR == 0 ? NAV : BR == 1 ? GV : SV) + hx * 64 + sch * 8;
           ksrc = P.Z + (size_t)skey * ZW + ko; vsrc = P.Z + (size_t)skey * ZW + vo; kpitch = ZW; }
    const unsigned kdst = skey * KP + sch * 16, rdst = rkey * KP + 128 + rch * 16, vdst = (sch >> 2) * 4096 + skey * 64 + (sch & 3) * 16;
    typedef unsigned u32x4 __attribute__((ext_vector_type(4)));
    u32x4 kregA, vregA, rregA, kregB, vregB, rregB;
#define A_TROW(t) ((t) < 4 ? ctx0 + (size_t)(t) * 64 : lat0 + (size_t)klo + (size_t)((t) - 4) * 64)
#define K_LOAD(t, S) do { const size_t tr_ = A_TROW(t); kreg##S = *(const u32x4*)(ksrc + tr_ * kpitch); if (BR == 3) { if (tid < 256) rreg##S = *(const u32x4*)(rsrc + tr_ * ZW); } } while (0)
#define V_LOAD(t, S) do { const size_t tr_ = A_TROW(t); vreg##S = *(const u32x4*)(vsrc + tr_ * kpitch); } while (0)
#define K_WRITE(par, S) do { ldsp bb_ = lds + ((par) ? KB1 : KB0); *(LAS u32x4*)(bb_ + kdst) = kreg##S; if (BR == 3) { if (tid < 256) *(LAS u32x4*)(bb_ + rdst) = rreg##S; } } while (0)
#define V_WRITE(par, S) do { ldsp bb_ = lds + ((par) ? VB1 : VB0); *(LAS u32x4*)(bb_ + vdst) = vreg##S; } while (0)
    LAS float* btab = (LAS float*)(lds + BT0);
    if (BR == 0) { if (tid < 465) btab[tid] = P.rpb[hx * 465 + tid] * 1.4426950408889634f; }
    const int qr = (q0 >> 6) + (wid >> 1), qc = (wid & 1) * 32 + r32;
    const int krow0 = min(max(qr - 4, 0), GROWS - 8), kcol0 = min(max(qc - 8, 0), GW - 16);
    float mref = 0.f, lsum = 0.f;
    f32x16 o0, o1, negm;
#pragma unroll
    for (int r = 0; r < 16; ++r) { o0[r] = 0.f; o1[r] = 0.f; negm[r] = 0.f; }
    const unsigned kfo = r32 * KP + hi * 16;
    const unsigned vfo = (4 * hi + ((lane & 15) >> 2)) * 64 + ((lane >> 4) & 1) * 32 + (lane & 3) * 8;
#define A_ACTIVE(t) (!(BR == 0 && (t) >= 4) || (((klo >> 6) + ((t) - 4)) >= krow0 && ((klo >> 6) + ((t) - 4)) < krow0 + 8))
#define A_QK(p0, p1, par) do { const ldsp kb_ = lds + ((par) ? KB1 : KB0) + kfo; bf16x8 kaf[NKS], kbf[NKS], qkf[NKS]; \
        _Pragma("unroll") for (int ks = 0; ks < NKS; ++ks) { kaf[ks] = *(const LAS bf16x8*)(kb_ + ks * 32); kbf[ks] = *(const LAS bf16x8*)(kb_ + 32 * KP + ks * 32); qkf[ks] = *(const LAS bf16x8*)(qlds + ks * 1024); } \
        p0 = __builtin_amdgcn_mfma_f32_32x32x16_bf16(kaf[0], qkf[0], negm, 0, 0, 0); p1 = __builtin_amdgcn_mfma_f32_32x32x16_bf16(kbf[0], qkf[0], negm, 0, 0, 0); \
        _Pragma("unroll") for (int ks = 1; ks < NKS; ++ks) { \
          p0 = __builtin_amdgcn_mfma_f32_32x32x16_bf16(kaf[ks], qkf[ks], p0, 0, 0, 0); p1 = __builtin_amdgcn_mfma_f32_32x32x16_bf16(kbf[ks], qkf[ks], p1, 0, 0, 0); } } while (0)
    K_LOAD(0, A); V_LOAD(0, A); K_LOAD(1, B); K_WRITE(0, A); V_WRITE(0, A); K_WRITE(1, B);
    __syncthreads();
    K_LOAD(2, A); K_LOAD(3, B); V_LOAD(1, B); V_LOAD(2, A);
    f32x16 sA0, sA1, sB0, sB1;
    A_QK(sA0, sA1, 0);
    __syncthreads();
    bool act_cur = true;
    auto step_dummy = 0; (void)step_dummy;
#define A_STEP(t, KS, VS, pc0, pc1, pn0, pn1) do { \
         \
        const bool act_next = (t + 1 < nt) && A_ACTIVE(t + 1); \
        if (act_next) A_QK(pn0, pn1, (t + 1) & 1); \
        if (act_cur) { \
             \
            if (BR == 0) { if (t >= 4) { const int dr = (klo >> 6) + (t - 4) - qr + 7; \
_Pragma("unroll") \
                    for (int r = 0; r < 16; ++r) { \
                        const int kc0 = crow(r, hi), kc1 = 32 + kc0; \
                        const bool v0 = (unsigned)(kc0 - kcol0) < 16u, v1 = (unsigned)(kc1 - kcol0) < 16u; \
                        const float b0 = btab[dr * 31 + min(max(kc0 - qc + 15, 0), 30)], b1 = btab[dr * 31 + min(max(kc1 - qc + 15, 0), 30)]; \
                        pc0[r] = v0 ? pc0[r] + b0 : NEG; pc1[r] = v1 ? pc1[r] + b1 : NEG; \
                    } } } \
            if (BR == 2) { if (t >= 4) { const int kb0 = klo + (t - 4) * 64 - tokq + 128; \
_Pragma("unroll") \
                    for (int r = 0; r < 16; ++r) { const int d0 = kb0 + crow(r, hi); \
                        if ((unsigned)d0 > 256u) pc0[r] = NEG; if ((unsigned)(d0 + 32) > 256u) pc1[r] = NEG; } } } \
             \
            float rm; \
            { const float a0 = max3f(pc0[0], pc0[1], pc0[2]), a1 = max3f(pc0[3], pc0[4], pc0[5]), a2 = max3f(pc0[6], pc0[7], pc0[8]), a3 = max3f(pc0[9], pc0[10], pc0[11]), \
                          a4 = max3f(pc0[12], pc0[13], pc0[14]), a5 = max3f(pc0[15], pc1[0], pc1[1]), a6 = max3f(pc1[2], pc1[3], pc1[4]), a7 = max3f(pc1[5], pc1[6], pc1[7]), \
                          a8 = max3f(pc1[8], pc1[9], pc1[10]), a9 = max3f(pc1[11], pc1[12], pc1[13]), a10 = fmaxf(pc1[14], pc1[15]); \
              const float b0 = max3f(a0, a1, a2), b1 = max3f(a3, a4, a5), b2 = max3f(a6, a7, a8), b3 = fmaxf(a9, a10); \
              rm = xhalf_max(fmaxf(fmaxf(b0, b1), fmaxf(b2, b3))); } \
            if (t == 0 || __any(rm > THR)) { \
                const float dl = (t == 0) ? rm : fmaxf(rm, 0.f); \
                const float f = __builtin_amdgcn_exp2f(-dl); \
                mref += dl; lsum *= f; \
_Pragma("unroll") \
                for (int r = 0; r < 16; ++r) { pc0[r] -= dl; pc1[r] -= dl; negm[r] -= dl; o0[r] *= f; o1[r] *= f; } \
                if (act_next) { \
_Pragma("unroll") \
                    for (int r = 0; r < 16; ++r) { pn0[r] -= dl; pn1[r] -= dl; } } \
            } \
             \
_Pragma("unroll") \
            for (int r = 0; r < 16; ++r) { pc0[r] = __builtin_amdgcn_exp2f(pc0[r]); pc1[r] = __builtin_amdgcn_exp2f(pc1[r]); } \
            { float s8[8]; \
_Pragma("unroll") \
              for (int r = 0; r < 8; ++r) s8[r] = (pc0[r] + pc0[r + 8]) + (pc1[r] + pc1[r + 8]); \
              lsum += ((s8[0] + s8[1]) + (s8[2] + s8[3])) + ((s8[4] + s8[5]) + (s8[6] + s8[7])); } \
             \
            const ldsp vb = lds + ((t & 1) ? VB1 : VB0) + vfo; \
            bf16x8 pf[4]; \
            _Pragma("unroll") for (int s = 0; s < 4; ++s) { const int rb = (s & 1) * 8; typedef unsigned u4 __attribute__((ext_vector_type(4))); u4 ww; \
                  if (s < 2) ww = (u4){cvtpk(pc0[rb], pc0[rb + 1]), cvtpk(pc0[rb + 2], pc0[rb + 3]), cvtpk(pc0[rb + 4], pc0[rb + 5]), cvtpk(pc0[rb + 6], pc0[rb + 7])}; \
                  else       ww = (u4){cvtpk(pc1[rb], pc1[rb + 1]), cvtpk(pc1[rb + 2], pc1[rb + 3]), cvtpk(pc1[rb + 4], pc1[rb + 5]), cvtpk(pc1[rb + 6], pc1[rb + 7])}; \
                  pf[s] = __builtin_bit_cast(bf16x8, ww); } \
            s16x4 vl0[4], vh0[4], vl1[4], vh1[4]; \
            _Pragma("unroll") for (int s = 0; s < 4; ++s) { vl0[s] = __builtin_bit_cast(s16x4, __builtin_amdgcn_ds_read_tr16_b64_v4i16((LAS v4i16_t*)(vb + s * 1024))); vh0[s] = __builtin_bit_cast(s16x4, __builtin_amdgcn_ds_read_tr16_b64_v4i16((LAS v4i16_t*)(vb + s * 1024 + 512))); } \
            _Pragma("unroll") for (int s = 0; s < 4; ++s) { vl1[s] = __builtin_bit_cast(s16x4, __builtin_amdgcn_ds_read_tr16_b64_v4i16((LAS v4i16_t*)(vb + 4096 + s * 1024))); vh1[s] = __builtin_bit_cast(s16x4, __builtin_amdgcn_ds_read_tr16_b64_v4i16((LAS v4i16_t*)(vb + 4096 + s * 1024 + 512))); } \
            _Pragma("unroll") for (int s = 0; s < 4; ++s) { const bf16x8 vf = (bf16x8){vl0[s][0], vl0[s][1], vl0[s][2], vl0[s][3], vh0[s][0], vh0[s][1], vh0[s][2], vh0[s][3]}; o0 = __builtin_amdgcn_mfma_f32_32x32x16_bf16(vf, pf[s], o0, 0, 0, 0); } \
            _Pragma("unroll") for (int s = 0; s < 4; ++s) { const bf16x8 vf = (bf16x8){vl1[s][0], vl1[s][1], vl1[s][2], vl1[s][3], vh1[s][0], vh1[s][1], vh1[s][2], vh1[s][3]}; o1 = __builtin_amdgcn_mfma_f32_32x32x16_bf16(vf, pf[s], o1, 0, 0, 0); } \
        } \
         \
        if (t + 2 < nt) K_WRITE(t & 1, KS); \
        if (t + 1 < nt) V_WRITE((t + 1) & 1, VS); \
        if (t + 4 < nt) K_LOAD(t + 4, KS); \
        if (t + 3 < nt) V_LOAD(t + 3, VS); \
        __syncthreads(); \
        act_cur = act_next; \
    } while (0)
    { int t = 0;
      for (; t + 1 < nt; t += 2) { A_STEP(t, A, B, sA0, sA1, sB0, sB1); A_STEP(t + 1, B, A, sB0, sB1, sA0, sA1); }
      if (t < nt) A_STEP(t, A, B, sA0, sA1, sB0, sB1); }
#undef A_STEP
    float ltot = xhalf_sum(lsum);
    if (BR == 2) ltot += __builtin_amdgcn_exp2f(P.sink[head] * 1.4426950408889634f - mref);
    const float inv = 1.f / ltot;
#ifdef PROBE_ATTN
    if (P.o32 && b == 1 && (ctxq || tokq < 1024 || tokq >= 7168)) {
        const int sub = ctxq ? 2048 + tokq : (tokq < 1024 ? tokq : 1024 + tokq - 7168);
        float* fp = P.o32 + (size_t)sub * D + BR * 256 + head * 64 + 4 * hi;
#pragma unroll
        for (int g = 0; g < 4; ++g)
#pragma unroll
            for (int j = 0; j < 4; ++j) { fp[8 * g + j] = o0[4 * g + j] * inv; fp[32 + 8 * g + j] = o1[4 * g + j] * inv; }
    }
#endif
    T* op = P.O + qrow * D + BR * 256 + head * 64 + 4 * hi;
#pragma unroll
    for (int g = 0; g < 4; ++g) {
        *(uint2*)(op + 8 * g) = pk4(o0[4 * g] * inv, o0[4 * g + 1] * inv, o0[4 * g + 2] * inv, o0[4 * g + 3] * inv);
        *(uint2*)(op + 32 + 8 * g) = pk4(o1[4 * g] * inv, o1[4 * g + 1] * inv, o1[4 * g + 2] * inv, o1[4 * g + 3] * inv);
    }
#undef A_TROW
#undef K_LOAD
#undef V_LOAD
#undef K_WRITE
#undef V_WRITE
#undef A_ACTIVE
#undef A_QK
}

__device__ __forceinline__ void attn_phase(ldsp lds, const AttnP& P, int bid, int nblk) {
    for (int u = bid; u < 512; u += nblk) attn_unit<3>(lds, P, u >> 7, (u >> 5) & 3, (u & 31) * 256, false);
    for (int u = bid; u < 512; u += nblk) attn_unit<1>(lds, P, u >> 7, (u >> 6) & 1, (u & 63) * 128, false);
    for (int u = bid; u < 512; u += nblk) attn_unit<0>(lds, P, u >> 7, (u >> 5) & 3, (u & 31) * 256, false);
    for (int u = bid; u < 512; u += nblk) attn_unit<2>(lds, P, u >> 7, (u >> 6) & 1, (u & 63) * 128, false);
    if (P.need_ctx) {
        for (int u = bid; u < 64; u += nblk) {
            const int br = u >> 4, bb = (u >> 2) & 3, x = u & 3;
            if (br == 0) attn_unit<0>(lds, P, bb, x, 0, true);
            else if (br == 1) attn_unit<1>(lds, P, bb, x >> 1, (x & 1) * 128, true);
            else if (br == 2) attn_unit<2>(lds, P, bb, x >> 1, (x & 1) * 128, true);
            else attn_unit<3>(lds, P, bb, x, 0, true);
        }
    }
}


constexpr size_t al256(size_t b) { return (b + 255) & ~(size_t)255; }
constexpr size_t NSLOT_ = (size_t)NB * NE * (CAP + CAPC);
constexpr size_t OFF_BAR = 0, OFF_MODV = OFF_BAR + al256(3456 * 4), OFF_TAB64 = OFF_MODV + al256((size_t)NL * 5 * MODW * 4), OFF_TAB32 = OFF_TAB64 + al256(128 * 16 * 8),
    OFF_RA = OFF_TAB32 + al256(128 * 8 * 8), OFF_RC = OFF_RA + al256((size_t)NROW * D * 2), OFF_XCA = OFF_RC + al256((size_t)NROW * D * 2), OFF_XCB = OFF_XCA + al256((size_t)NCTX * D * 4),
    OFF_AFF = OFF_XCB + al256((size_t)NCTX * D * 4), OFF_IDX = OFF_AFF + al256((size_t)NROW * NE * 4), OFF_GATEV = OFF_IDX + al256(NSLOT_ * 4), OFF_INV = OFF_GATEV + al256(NSLOT_ * 4),
    OFF_Z = OFF_INV + al256((size_t)NROW * NE * 4), OFF_WINT = OFF_Z + al256((size_t)NROW * ZW * 2), OFF_WQT = OFF_WINT + al256((size_t)NL * 6400 * D * 2), OFF_WKVT = OFF_WQT + al256((size_t)NL * 384 * 192 * 2),
    OFF_SS = OFF_WKVT + al256((size_t)NL * 512 * 128 * 2), OFF_WBT = OFF_SS + al256((size_t)NROW * 8 * 4), OFF_WOUTT = OFF_WBT + al256((size_t)NL * 4 * 1024 * 256 * 2), OFF_END = OFF_WOUTT + al256((size_t)NL * D * D * 2);
struct MP {
    const float *x_, *c_, *ctx_, *c_ctx_, *w_mod_, *b_mod_, *w_in_, *na_rpb_, *gqn_, *gkn_, *swa_sink_, *mqn_, *mkvn_, *w_qb_, *w_kvb_, *w_branch_, *w_out_,
                *ln1g_, *ln1b_, *ln2g_, *ln2b_, *w_router_, *w_gate_, *w_up_, *w_down_;
    float* out_; char* ws_;
    float* o32_; const float* pscale_;
    int ph_lo_, ph_hi_;
    __device__ __forceinline__ const float* x() const { return x_; }
    __device__ __forceinline__ const float* c() const { return c_; }
    __device__ __forceinline__ const float* ctx() const { return ctx_; }
    __device__ __forceinline__ const float* c_ctx() const { return c_ctx_; }
    __device__ __forceinline__ const float* w_mod() const { return w_mod_; }
    __device__ __forceinline__ const float* b_mod() const { return b_mod_; }
    __device__ __forceinline__ const float* w_in() const { return w_in_; }
    __device__ __forceinline__ const float* na_rpb() const { return na_rpb_; }
    __device__ __forceinline__ const float* gqn() const { return gqn_; }
    __device__ __forceinline__ const float* gkn() const { return gkn_; }
    __device__ __forceinline__ const float* swa_sink() const { return swa_sink_; }
    __device__ __forceinline__ const float* mqn() const { return mqn_; }
    __device__ __forceinline__ const float* mkvn() const { return mkvn_; }
    __device__ __forceinline__ const float* w_qb() const { return w_qb_; }
    __device__ __forceinline__ const float* w_kvb() const { return w_kvb_; }
    __device__ __forceinline__ const float* w_branch() const { return w_branch_; }
    __device__ __forceinline__ const float* w_out() const { return w_out_; }
    __device__ __forceinline__ const float* ln1g() const { return ln1g_; }
    __device__ __forceinline__ const float* ln1b() const { return ln1b_; }
    __device__ __forceinline__ const float* ln2g() const { return ln2g_; }
    __device__ __forceinline__ const float* ln2b() const { return ln2b_; }
    __device__ __forceinline__ const float* w_router() const { return w_router_; }
    __device__ __forceinline__ const float* w_gate() const { return w_gate_; }
    __device__ __forceinline__ const float* w_up() const { return w_up_; }
    __device__ __forceinline__ const float* w_down() const { return w_down_; }
    __device__ __forceinline__ float* out() const { return out_; }
    __device__ __forceinline__ char* ws() const { return ws_; }
    __device__ __forceinline__ float* o32() const { return o32_; }
    __device__ __forceinline__ const float* pscale() const { return pscale_; }
    __device__ __forceinline__ int ph_lo() const { return ph_lo_; }
    __device__ __forceinline__ int ph_hi() const { return ph_hi_; }
    __device__ __forceinline__ unsigned* bar() const { return (unsigned*)(ws() + OFF_BAR); }
    __device__ __forceinline__ float* modv() const { return (float*)(ws() + OFF_MODV); }
    __device__ __forceinline__ float2* tab64() const { return (float2*)(ws() + OFF_TAB64); }
    __device__ __forceinline__ float2* tab32() const { return (float2*)(ws() + OFF_TAB32); }
    __device__ __forceinline__ T* RA() const { return (T*)(ws() + OFF_RA); }
    __device__ __forceinline__ T* RC() const { return (T*)(ws() + OFF_RC); }
    __device__ __forceinline__ float* XCa() const { return (float*)(ws() + OFF_XCA); }
    __device__ __forceinline__ float* XCb() const { return (float*)(ws() + OFF_XCB); }
    __device__ __forceinline__ float* AFF() const { return (float*)(ws() + OFF_AFF); }
    __device__ __forceinline__ int* IDX() const { return (int*)(ws() + OFF_IDX); }
    __device__ __forceinline__ float* GATEV() const { return (float*)(ws() + OFF_GATEV); }
    __device__ __forceinline__ int* INV() const { return (int*)(ws() + OFF_INV); }
    __device__ __forceinline__ T* Z() const { return (T*)(ws() + OFF_Z); }
    __device__ __forceinline__ T* WinT() const { return (T*)(ws() + OFF_WINT); }
    __device__ __forceinline__ T* WqT() const { return (T*)(ws() + OFF_WQT); }
    __device__ __forceinline__ T* WkvT() const { return (T*)(ws() + OFF_WKVT); }
    __device__ __forceinline__ float* SS() const { return (float*)(ws() + OFF_SS); }
    __device__ __forceinline__ T* WbT() const { return (T*)(ws() + OFF_WBT); }
    __device__ __forceinline__ T* WoutT() const { return (T*)(ws() + OFF_WOUTT); }
};

__device__ __forceinline__ void ph_mod(ldsp lds, const MP& p, int bid, int nblk) {
    LAS float* sc = (LAS float*)lds;
    LAS float* red = (LAS float*)(lds + 5 * 1024 * 4);
    const int tid = otid(), lane = tid & 63, kg = tid >> 6;
    for (int i = tid; i < 5 * 1024; i += 512) { const int s = i >> 10, k = i & 1023; const float v = s < 4 ? p.c()[s * 1024 + k] : p.c_ctx()[k]; sc[i] = v / (1.f + expf(-v)); }
    __syncthreads();
    for (int u = bid; u < NL * (MODW / 64); u += nblk) {
        const int l = u / (MODW / 64), j = (u % (MODW / 64)) * 64 + lane;
        float acc[5] = {0.f, 0.f, 0.f, 0.f, 0.f};
        const float* w = p.w_mod() + (size_t)l * D * MODW + j;
        for (int k = kg * 128; k < kg * 128 + 128; ++k) { const float wv = w[(size_t)k * MODW];
#pragma unroll
            for (int s = 0; s < 5; ++s) acc[s] += sc[s * 1024 + k] * wv; }
#pragma unroll
        for (int s = 0; s < 5; ++s) red[(kg * 5 + s) * 64 + lane] = acc[s];
        __syncthreads();
        if (kg < 5) { const int s = kg; float v = p.b_mod()[l * MODW + j];
#pragma unroll
            for (int g = 0; g < 8; ++g) v += red[(g * 5 + s) * 64 + lane];
            p.modv()[((size_t)l * 5 + s) * MODW + j] = v; }
        __syncthreads();
    }
}
__device__ __forceinline__ void ph_ropetab(const MP& p, int bid, int nblk) {
    for (int t = bid * 512 + otid(); t < 128 * 16; t += nblk * 512) {
        { const int pos = t / 16, i = t % 16; const float a = (float)pos * powf(10000.f, -(float)i / 16.f); p.tab64()[t] = make_float2(cosf(a), sinf(a)); }
        if (t < 128 * 8) { const int pos = t / 8, i = t % 8; const float a = (float)pos * powf(10000.f, -(float)i / 8.f); p.tab32()[t] = make_float2(cosf(a), sinf(a)); }
    }
}
struct PrepJob { const float* src; const float* src2; const float* kscale; T* dst; int K, Nsrc, Ndst, mode, nz, perm; long long src_zs, dst_zs, ks_zs; };
__device__ __forceinline__ void ph_wprep(ldsp lds, const PrepJob& a, int bid, int nblk) {
    constexpr int NT = 4;
    LAS float* tile = (LAS float*)lds;
    const int tid_ = otid();
    const int kr = tid_ >> 4, c4 = tid_ & 15;
    const int kq = tid_ & 7, nr = tid_ >> 3;
    const int nx = a.Ndst / 64, ny = a.K / 64, ntile = nx * ny * a.nz;
    float4 v0[NT], v1[NT];
#define WP_LOAD(i, u) do { const int z_ = (u) / (nx * ny), rem_ = (u) % (nx * ny), n0_ = (rem_ % nx) * 64, k0_ = (rem_ / nx) * 64; \
        const float* src_ = a.src + (size_t)z_ * a.src_zs; const float* ksc_ = a.kscale ? a.kscale + (size_t)z_ * a.ks_zs : nullptr; \
        int n_ = n0_ + 4 * c4; if (a.perm) { const int p_ = n_ & 255; n_ = (n_ & ~255) + 64 * ((p_ >> 5) & 3) + 32 * (p_ >> 7) + (p_ & 31); } bool valid_ = true; int col_ = n_; const float* sp_ = src_; \
        if (a.mode == 0) { valid_ = n_ < a.Nsrc; } \
        else if (a.mode == 1) { if (n_ < 2144) col_ = n_; else if (n_ < 2304) valid_ = false; else col_ = n_ - 160; } \
        else { const int j_ = n_ >> 6, w_ = n_ & 63; if (w_ >= 32) sp_ = a.src2 + (size_t)z_ * a.src_zs; col_ = 32 * j_ + (w_ & 31); } \
        v0[i] = make_float4(0.f, 0.f, 0.f, 0.f); v1[i] = v0[i]; \
        if (valid_) { v0[i] = *(const float4*)(sp_ + (size_t)(k0_ + kr) * a.Nsrc + col_); v1[i] = *(const float4*)(sp_ + (size_t)(k0_ + kr + 32) * a.Nsrc + col_); \
            if (ksc_) { const float s0_ = ksc_[k0_ + kr], s1_ = ksc_[k0_ + kr + 32]; v0[i].x *= s0_; v0[i].y *= s0_; v0[i].z *= s0_; v0[i].w *= s0_; v1[i].x *= s1_; v1[i].y *= s1_; v1[i].z *= s1_; v1[i].w *= s1_; } } } while (0)
    int u = bid, buf = 0;
#pragma unroll
    for (int i = 0; i < NT; ++i) { if (u + i * nblk < ntile) WP_LOAD(i, u + i * nblk); }
    for (; u < ntile; u += NT * nblk) {
        LAS float* tb = tile + buf * (NT * 64 * 65);
#pragma unroll
        for (int i = 0; i < NT; ++i) { if (u + i * nblk < ntile) { LAS float* w0 = tb + i * (64 * 65) + kr * 65 + 4 * c4; LAS float* w1 = w0 + 32 * 65;
            w0[0] = v0[i].x; w0[1] = v0[i].y; w0[2] = v0[i].z; w0[3] = v0[i].w; w1[0] = v1[i].x; w1[1] = v1[i].y; w1[2] = v1[i].z; w1[3] = v1[i].w; } }
        __syncthreads();
#pragma unroll
        for (int i = 0; i < NT; ++i) { const int un = u + (NT + i) * nblk; if (un < ntile) WP_LOAD(i, un); }
#pragma unroll
        for (int i = 0; i < NT; ++i) { const int ui = u + i * nblk; if (ui < ntile) {
            const int z = ui / (nx * ny), rem = ui % (nx * ny), n0 = (rem % nx) * 64, k0 = (rem / nx) * 64;
            T* dst = a.dst + (size_t)z * a.dst_zs;
            const LAS float* rp = tb + i * (64 * 65) + (kq * 8) * 65 + nr;
            *(uint4*)(dst + (size_t)(n0 + nr) * a.K + k0 + kq * 8) = make_uint4(pk2(rp[0], rp[65]), pk2(rp[130], rp[195]), pk2(rp[260], rp[325]), pk2(rp[390], rp[455])); } }
        buf ^= 1;
    }
#undef WP_LOAD
    __syncthreads();
}
__device__ __forceinline__ void lnmod_row(const float* src, const float* mv, int sh_off, int sc_off, T* dst, int lane) {
    float4 v[4]; float sum = 0.f;
#pragma unroll
    for (int i = 0; i < 4; ++i) { v[i] = *(const float4*)(src + i * 256 + lane * 4); sum += v[i].x + v[i].y + v[i].z + v[i].w; }
    const float mean = wave_sum(sum) * (1.f / D);
    float sq = 0.f;
#pragma unroll
    for (int i = 0; i < 4; ++i) { float a = v[i].x - mean, b = v[i].y - mean, c = v[i].z - mean, d = v[i].w - mean; sq += a * a + b * b + c * c + d * d; }
    const float rstd = 1.f / sqrtf(wave_sum(sq) * (1.f / D) + EPS);
#pragma unroll
    for (int i = 0; i < 4; ++i) {
        const int col = i * 256 + lane * 4;
        const float4 sh = *(const float4*)(mv + sh_off + col), sc = *(const float4*)(mv + sc_off + col);
        st4(dst + col, make_float4((v[i].x - mean) * rstd * (1.f + sc.x) + sh.x, (v[i].y - mean) * rstd * (1.f + sc.y) + sh.y,
                                   (v[i].z - mean) * rstd * (1.f + sc.z) + sh.z, (v[i].w - mean) * rstd * (1.f + sc.w) + sh.w));
    }
}
__device__ __forceinline__ void ph_lnmod0(const MP& p, int bid, int nblk) {
    const int tid_ = otid(); const int lane = tid_ & 63, wid = tid_ >> 6;
    for (int row = bid * 8 + wid; row < NROW; row += nblk * 8) {
        const bool lat = row < NLAT;
        const float* src = lat ? p.x() + (size_t)row * D : p.ctx() + (size_t)(row - NLAT) * D;
        const int s = lat ? row / SEQ : 4;
        lnmod_row(src, p.modv() + (size_t)s * MODW, 0, D, p.RA() + (size_t)row * D, lane);
    }
}
__device__ __forceinline__ void ph_lnres(ldsp lds, const MP& p, int l, int nrows, int bid, int nblk) {
    const int tid_ = otid(); const int lane = tid_ & 63, wid = tid_ >> 6;
    const float* modl = p.modv() + (size_t)l * 5 * MODW;
    const float* lgp = p.ln1g() + l * D; const float* lbp = p.ln1b() + l * D; const float* wr = p.w_router() + (size_t)l * D * NE;
    LAS float* WT = (LAS float*)lds;
    for (int i = tid_; i < NE * D; i += 512) { const int e = i >> 10, col = i & 1023; WT[i] = wr[col * NE + e]; }
    __syncthreads();
    const bool b5 = lane & 32, b4 = lane & 16, b3 = lane & 8, b2 = lane & 4;
    const int stride = nblk * 8;
    const float* xlat = l == 0 ? p.x() : p.out(); const float* xctx = l == 0 ? p.ctx() : p.XCb();
    float4 lgv[4], lbv[4], gv[4], shv[4], scv[4];
#pragma unroll
    for (int i = 0; i < 4; ++i) { lgv[i] = *(const float4*)(lgp + i * 256 + lane * 4); lbv[i] = *(const float4*)(lbp + i * 256 + lane * 4); }
    int cur_s = -1;
    int row = bid * 8 + wid;
    float4 xn[4]; uint2 yn[4];
#define LR_LOAD(r) do { const float* xs_ = (r) < NLAT ? xlat + (size_t)(r) * D : xctx + (size_t)((r) - NLAT) * D; const T* yp_ = p.RA() + (size_t)(r) * D; \
        _Pragma("unroll") for (int i = 0; i < 4; ++i) { xn[i] = *(const float4*)(xs_ + i * 256 + lane * 4); yn[i] = *(const uint2*)(yp_ + i * 256 + lane * 4); } } while (0)
    if (row < nrows) LR_LOAD(row);
    for (; row < nrows; row += stride) {
        float4 xc[4]; uint2 yc[4];
#pragma unroll
        for (int i = 0; i < 4; ++i) { xc[i] = xn[i]; yc[i] = yn[i]; }
        if (row + stride < nrows) LR_LOAD(row + stride);
        const bool lat = row < NLAT;
        float* xo = lat ? p.out() + (size_t)row * D : p.XCa() + (size_t)(row - NLAT) * D;
        const int s = lat ? row / SEQ : 4;
        if (s != cur_s) { cur_s = s; const float* mv = modl + (size_t)s * MODW;
#pragma unroll
            for (int i = 0; i < 4; ++i) { gv[i] = *(const float4*)(mv + 2 * D + i * 256 + lane * 4); shv[i] = *(const float4*)(mv + 3 * D + i * 256 + lane * 4); scv[i] = *(const float4*)(mv + 4 * D + i * 256 + lane * 4); } }
        float v[16]; float sum = 0.f;
#pragma unroll
        for (int i = 0; i < 4; ++i) {
            const float y0 = __uint_as_float(yc[i].x << 16), y1 = __uint_as_float(yc[i].x & 0xffff0000u), y2 = __uint_as_float(yc[i].y << 16), y3 = __uint_as_float(yc[i].y & 0xffff0000u);
            v[i * 4 + 0] = ALPHA * xc[i].x + gv[i].x * y0; v[i * 4 + 1] = ALPHA * xc[i].y + gv[i].y * y1; v[i * 4 + 2] = ALPHA * xc[i].z + gv[i].z * y2; v[i * 4 + 3] = ALPHA * xc[i].w + gv[i].w * y3;
            sum += v[i * 4] + v[i * 4 + 1] + v[i * 4 + 2] + v[i * 4 + 3];
        }
        const float mean = wave_sum(sum) * (1.f / D);
        float sq = 0.f;
#pragma unroll
        for (int i = 0; i < 16; ++i) { const float d = v[i] - mean; sq += d * d; }
        const float rstd = 1.f / sqrtf(wave_sum(sq) * (1.f / D) + EPS);
        float s2 = 0.f;
#pragma unroll
        for (int i = 0; i < 4; ++i) {
            v[i * 4 + 0] = (v[i * 4 + 0] - mean) * rstd * lgv[i].x + lbv[i].x; v[i * 4 + 1] = (v[i * 4 + 1] - mean) * rstd * lgv[i].y + lbv[i].y;
            v[i * 4 + 2] = (v[i * 4 + 2] - mean) * rstd * lgv[i].z + lbv[i].z; v[i * 4 + 3] = (v[i * 4 + 3] - mean) * rstd * lgv[i].w + lbv[i].w;
            *(float4*)(xo + i * 256 + lane * 4) = make_float4(v[i * 4], v[i * 4 + 1], v[i * 4 + 2], v[i * 4 + 3]);
            s2 += v[i * 4] + v[i * 4 + 1] + v[i * 4 + 2] + v[i * 4 + 3];
        }
        const float mean2 = wave_sum(s2) * (1.f / D);
        float sq2 = 0.f;
#pragma unroll
        for (int i = 0; i < 16; ++i) { const float d = v[i] - mean2; sq2 += d * d; }
        const float rstd2 = 1.f / sqrtf(wave_sum(sq2) * (1.f / D) + EPS);
        float h2[16];
#pragma unroll
        for (int i = 0; i < 4; ++i) {
            h2[i * 4 + 0] = (v[i * 4 + 0] - mean2) * rstd2 * (1.f + scv[i].x) + shv[i].x; h2[i * 4 + 1] = (v[i * 4 + 1] - mean2) * rstd2 * (1.f + scv[i].y) + shv[i].y;
            h2[i * 4 + 2] = (v[i * 4 + 2] - mean2) * rstd2 * (1.f + scv[i].z) + shv[i].z; h2[i * 4 + 3] = (v[i * 4 + 3] - mean2) * rstd2 * (1.f + scv[i].w) + shv[i].w;
            st4(p.RC() + (size_t)row * D + i * 256 + lane * 4, make_float4(h2[i * 4], h2[i * 4 + 1], h2[i * 4 + 2], h2[i * 4 + 3]));
        }
        float lg[16];
#pragma unroll
        for (int e = 0; e < 16; ++e) {
            float a = 0.f;
#pragma unroll
            for (int i = 0; i < 4; ++i) { const f32x4 w = *(const LAS f32x4*)(WT + e * D + i * 256 + lane * 4); a += h2[i * 4] * w.x + h2[i * 4 + 1] * w.y + h2[i * 4 + 2] * w.z + h2[i * 4 + 3] * w.w; }
            lg[e] = a;
            if (e & 1) __builtin_amdgcn_sched_barrier(0);
        }
        float a8[8], a4[4], a2[2];
#pragma unroll
        for (int k = 0; k < 8; ++k) {
            auto rr = __builtin_amdgcn_permlane32_swap(__float_as_uint(lg[k]), __float_as_uint(lg[8 + k]), false, false);
            a8[k] = __uint_as_float(rr[0]) + __uint_as_float(rr[1]); }
#pragma unroll
        for (int k = 0; k < 4; ++k) { const float mine = b4 ? a8[4 + k] : a8[k], oth = b4 ? a8[k] : a8[4 + k]; a4[k] = mine + __shfl_xor(oth, 16); }
#pragma unroll
        for (int k = 0; k < 2; ++k) { const float mine = b3 ? a4[2 + k] : a4[k], oth = b3 ? a4[k] : a4[2 + k]; a2[k] = mine + __shfl_xor(oth, 8); }
        float lgt = (b2 ? a2[1] : a2[0]) + __shfl_xor(b2 ? a2[0] : a2[1], 4);
        lgt = DPP_ADD(lgt, 0xB1); lgt = DPP_ADD(lgt, 0x4E);
        float mx = lgt;
        mx = fmaxf(mx, __shfl_xor(mx, 4)); mx = fmaxf(mx, __shfl_xor(mx, 8)); mx = fmaxf(mx, __shfl_xor(mx, 16)); mx = fmaxf(mx, __shfl_xor(mx, 32));
        const float ex = expf(lgt - mx);
        float den = ex;
        den += __shfl_xor(den, 4); den += __shfl_xor(den, 8); den += __shfl_xor(den, 16); den += __shfl_xor(den, 32);
        if ((lane & 3) == 0) p.AFF()[(size_t)row * NE + (lane >> 2)] = ex / den;
    }
#undef LR_LOAD
    __syncthreads();
}
__device__ __forceinline__ void ph_topk(ldsp lds, const MP& p, int nkinds, int bid, int nblk) {
    LAS unsigned* keys = (LAS unsigned*)lds;
    LAS unsigned* hist = (LAS unsigned*)(lds + 32768);
    LAS unsigned* part = (LAS unsigned*)(lds + 32768 + 8192);
    LAS unsigned* shv = (LAS unsigned*)(lds + 32768 + 8192 + 1024);
    const int tid = otid(), lane = tid & 63, wv = tid >> 6;
    for (int u = bid; u < NE * NB * nkinds; u += nblk) {
        const int e = u % NE, bl = (u / NE) % NB, kind = u / (NE * NB);
        const int n = kind ? CTX : SEQ, kk = kind ? CAPC : CAP;
        const size_t row0 = kind ? (size_t)NLAT + (size_t)bl * CTX : (size_t)bl * SEQ;
        const size_t grp = kind ? (size_t)NB * NE * CAP + ((size_t)e * NB + bl) * CAPC : ((size_t)bl * NE + e) * CAP;
        for (int i = tid; i < n; i += 512) keys[i] = __float_as_uint(p.AFF()[(row0 + i) * NE + e]);
        __syncthreads();
        unsigned prefix = 0, rem = kk;
        for (int pass = 0; pass < 3; ++pass) {
            const int shift = pass == 0 ? 21 : pass == 1 ? 10 : 0;
            const int nbm = pass == 2 ? 1023 : 2047;
            const int hshift = pass == 1 ? 21 : 10;
            for (int i = tid; i < 2048; i += 512) hist[i] = 0;
            __syncthreads();
            for (int i = tid; i < n; i += 512) { const unsigned k = keys[i]; const bool match = (pass == 0) || ((k >> hshift) == prefix); if (match) atomicAdd((unsigned*)&hist[(k >> shift) & nbm], 1u); }
            __syncthreads();
            unsigned loc = 0;
            if (tid < 256) { for (int j = 0; j < 8; ++j) loc += hist[tid * 8 + j]; part[tid] = loc; }
            __syncthreads();
            if (tid < 256) {
                unsigned above = 0;
                for (int j = tid + 1; j < 256; ++j) above += part[j];
                if (above < rem && above + loc >= rem) {
                    unsigned cum = above; int bsel = tid * 8 + 7;
                    for (; bsel >= tid * 8; --bsel) { const unsigned hc = hist[bsel]; if (cum + hc >= rem) break; cum += hc; }
                    shv[0] = (unsigned)bsel; shv[1] = rem - cum;
                }
            }
            __syncthreads();
            prefix = (pass == 0) ? shv[0] : ((prefix << (pass == 1 ? 11 : 10)) | shv[0]);
            rem = shv[1];
            __syncthreads();
        }
        const unsigned Tkey = prefix;
        unsigned base_gt = 0, base_eq = 0;
        for (int c0 = 0; c0 < n; c0 += 512) {
            const int i = c0 + tid; const bool inr = i < n;
            const unsigned k = inr ? keys[i] : 0u;
            const bool gt = inr && k > Tkey, eq = inr && k == Tkey;
            const unsigned long long mg = __ballot(gt), me = __ballot(eq);
            const unsigned long long lt = (1ull << lane) - 1ull;
            if (lane == 0) { shv[8 + wv] = __popcll(mg); shv[16 + wv] = __popcll(me); }
            __syncthreads();
            unsigned pg = base_gt + __popcll(mg & lt), pe = base_eq + __popcll(me & lt), tg = 0, te = 0;
            for (int w = 0; w < 8; ++w) { const unsigned a = shv[8 + w], b = shv[16 + w]; if (w < wv) { pg += a; pe += b; } tg += a; te += b; }
            const bool sel = gt || (eq && pe < rem);
            const unsigned slot = pg + min(pe, rem);
            if (inr) { if (sel) { p.IDX()[grp + slot] = (int)(row0 + i); p.GATEV()[grp + slot] = __uint_as_float(k); }
                       p.INV()[(row0 + i) * NE + e] = sel ? (int)slot : -1; }
            base_gt += tg; base_eq += te;
            __syncthreads();
        }
    }
}
__device__ __forceinline__ void ph_combine(const MP& p, int l, int nrows, const T* OUT, int bid, int nblk) {
    const int tid_ = otid(); const int lane = tid_ & 63, wid = tid_ >> 6;
    const float* modl = p.modv() + (size_t)l * 5 * MODW;
    const float* lgp = p.ln2g() + l * D; const float* lbp = p.ln2b() + l * D;
    const bool next = l + 1 < NL;
    const int stride = nblk * 8;
    float4 lgv[4], lbv[4], gv[4];
#pragma unroll
    for (int i = 0; i < 4; ++i) { lgv[i] = *(const float4*)(lgp + i * 256 + lane * 4); lbv[i] = *(const float4*)(lbp + i * 256 + lane * 4); }
    int cur_s = -1;
    int row = bid * 8 + wid;
    int sl_next = -1; float4 xn[4];
#define CB_LOAD(r) do { const float* xs_ = (r) < NLAT ? p.out() + (size_t)(r) * D : p.XCa() + (size_t)((r) - NLAT) * D; \
        _Pragma("unroll") for (int i = 0; i < 4; ++i) xn[i] = *(const float4*)(xs_ + i * 256 + lane * 4); \
        sl_next = lane < NE ? p.INV()[(size_t)(r) * NE + lane] : -1; } while (0)
    if (row < nrows) CB_LOAD(row);
    for (; row < nrows; row += stride) {
        float4 xc[4];
#pragma unroll
        for (int i = 0; i < 4; ++i) xc[i] = xn[i];
        const int slv = sl_next;
        if (row + stride < nrows) CB_LOAD(row + stride);
        const bool lat = row < NLAT;
        float* xo = lat ? p.out() + (size_t)row * D : p.XCb() + (size_t)(row - NLAT) * D;
        const int bl = lat ? row / SEQ : (row - NLAT) / CTX;
        const int s = lat ? bl : 4;
        if (s != cur_s) { cur_s = s; const float* mv = modl + (size_t)s * MODW;
#pragma unroll
            for (int i = 0; i < 4; ++i) gv[i] = *(const float4*)(mv + 5 * D + i * 256 + lane * 4); }
        unsigned long long mask = __ballot(slv >= 0) & 0xffffull;
        uint2 ob[4][4]; bool ok[4];
#pragma unroll
        for (int j = 0; j < 4; ++j) {
            ok[j] = mask != 0ull;
            if (ok[j]) {
                const int e = __builtin_ctzll(mask); mask &= mask - 1;
                const int sl = __builtin_amdgcn_readlane(slv, e);
                const size_t orow = lat ? ((size_t)bl * NE + e) * CAP + sl : (size_t)NB * NE * CAP + ((size_t)e * NB + bl) * CAPC + sl;
                const T* op = OUT + orow * D;
#pragma unroll
                for (int i = 0; i < 4; ++i) ob[j][i] = *(const uint2*)(op + i * 256 + lane * 4);
            } else {
#pragma unroll
                for (int i = 0; i < 4; ++i) ob[j][i] = make_uint2(0u, 0u);
            }
        }
        float y[16];
#pragma unroll
        for (int i = 0; i < 16; ++i) y[i] = 0.f;
#pragma unroll
        for (int j = 0; j < 4; ++j)
#pragma unroll
            for (int i = 0; i < 4; ++i) { y[i * 4] += __uint_as_float(ob[j][i].x << 16); y[i * 4 + 1] += __uint_as_float(ob[j][i].x & 0xffff0000u); y[i * 4 + 2] += __uint_as_float(ob[j][i].y << 16); y[i * 4 + 3] += __uint_as_float(ob[j][i].y & 0xffff0000u); }
        while (mask) {
            const int e = __builtin_ctzll(mask); mask &= mask - 1;
            const int sl = __builtin_amdgcn_readlane(slv, e);
            const size_t orow = lat ? ((size_t)bl * NE + e) * CAP + sl : (size_t)NB * NE * CAP + ((size_t)e * NB + bl) * CAPC + sl;
            const T* op = OUT + orow * D;
#pragma unroll
            for (int i = 0; i < 4; ++i) { const float4 o4 = ld4(op + i * 256 + lane * 4); y[i * 4] += o4.x; y[i * 4 + 1] += o4.y; y[i * 4 + 2] += o4.z; y[i * 4 + 3] += o4.w; }
        }
        float v[16]; float sum = 0.f;
#pragma unroll
        for (int i = 0; i < 4; ++i) {
            v[i * 4 + 0] = ALPHA * xc[i].x + gv[i].x * y[i * 4 + 0]; v[i * 4 + 1] = ALPHA * xc[i].y + gv[i].y * y[i * 4 + 1]; v[i * 4 + 2] = ALPHA * xc[i].z + gv[i].z * y[i * 4 + 2]; v[i * 4 + 3] = ALPHA * xc[i].w + gv[i].w * y[i * 4 + 3];
            sum += v[i * 4] + v[i * 4 + 1] + v[i * 4 + 2] + v[i * 4 + 3];
        }
        const float mean = wave_sum(sum) * (1.f / D);
        float sq = 0.f;
#pragma unroll
        for (int i = 0; i < 16; ++i) { const float d = v[i] - mean; sq += d * d; }
        const float rstd = 1.f / sqrtf(wave_sum(sq) * (1.f / D) + EPS);
        float s2 = 0.f;
#pragma unroll
        for (int i = 0; i < 4; ++i) {
            v[i * 4 + 0] = (v[i * 4 + 0] - mean) * rstd * lgv[i].x + lbv[i].x; v[i * 4 + 1] = (v[i * 4 + 1] - mean) * rstd * lgv[i].y + lbv[i].y;
            v[i * 4 + 2] = (v[i * 4 + 2] - mean) * rstd * lgv[i].z + lbv[i].z; v[i * 4 + 3] = (v[i * 4 + 3] - mean) * rstd * lgv[i].w + lbv[i].w;
            { const float ps_ = (!next && p.pscale()) ? p.pscale()[0] : 1.f;
              *(float4*)(xo + i * 256 + lane * 4) = make_float4(v[i * 4] * ps_, v[i * 4 + 1] * ps_, v[i * 4 + 2] * ps_, v[i * 4 + 3] * ps_); }
            s2 += v[i * 4] + v[i * 4 + 1] + v[i * 4 + 2] + v[i * 4 + 3];
        }
        if (next) {
            const float* mvn = p.modv() + ((size_t)(l + 1) * 5 + s) * MODW;
            const float mean2 = wave_sum(s2) * (1.f / D);
            float sq2 = 0.f;
#pragma unroll
            for (int i = 0; i < 16; ++i) { const float d = v[i] - mean2; sq2 += d * d; }
            const float rstd2 = 1.f / sqrtf(wave_sum(sq2) * (1.f / D) + EPS);
#pragma unroll
            for (int i = 0; i < 4; ++i) {
                const int col = i * 256 + lane * 4;
                const float4 sh = *(const float4*)(mvn + col), sc = *(const float4*)(mvn + D + col);
                st4(p.RA() + (size_t)row * D + col, make_float4((v[i * 4 + 0] - mean2) * rstd2 * (1.f + sc.x) + sh.x, (v[i * 4 + 1] - mean2) * rstd2 * (1.f + sc.y) + sh.y,
                                                             (v[i * 4 + 2] - mean2) * rstd2 * (1.f + sc.z) + sh.z, (v[i * 4 + 3] - mean2) * rstd2 * (1.f + sc.w) + sh.w));
            }
        }
    }
#undef CB_LOAD
}


#define XB_TMO      128
#define XB_XCNT(j)  (256  + 64 * (j))
#define XB_XSUB(j)  (1280 + 64 * (j))
#define XB_XGEN(j)  (2304 + 64 * (j))
#define XB_TOP      3328
#define XB_TOPGEN   3392
#define XCD_BAR_WORDS 3456
#define XB_SPIN_CAP (1u << 18)
__device__ __forceinline__ unsigned xb_ld(unsigned* p)              { return __hip_atomic_load(p, __ATOMIC_RELAXED, __HIP_MEMORY_SCOPE_AGENT); }
__device__ __forceinline__ unsigned xb_add(unsigned* p, unsigned v) { return __hip_atomic_fetch_add(p, v, __ATOMIC_RELAXED, __HIP_MEMORY_SCOPE_AGENT); }
__device__ __forceinline__ unsigned xb_xcc_id() { return (unsigned)__builtin_amdgcn_s_getreg((3 << 11) | 20) & 0xFu; }
#define XB_SPIN(cond, bar) do { unsigned _sp = 0; while (cond) { __builtin_amdgcn_s_sleep(1); \
    if ((++_sp & 255u) == 0u) { if (xb_ld(&(bar)[XB_TMO])) break; if (_sp > XB_SPIN_CAP) { atomicAdd(&(bar)[XB_TMO], 1u); break; } } } } while (0)
struct XcdBarrier { unsigned* bar; unsigned x; volatile LAS unsigned* st; };
__device__ __forceinline__ XcdBarrier xcd_barrier_post(unsigned* bar, volatile LAS unsigned* st) {
    XcdBarrier b; b.bar = bar; b.x = xb_xcc_id(); b.st = st;
    if (threadIdx.x == 0) (void)xb_add(&bar[XB_XCNT(b.x)], 1u);
    return b;
}
__device__ __forceinline__ void xcd_barrier_complete(unsigned* bar, unsigned x, unsigned& nloc, unsigned& nx) {
    const unsigned G = gridDim.x * gridDim.y * gridDim.z;
    unsigned sum, cnt, mine, sp = 0u;
    for (;;) {
        sum = 0u; cnt = 0u; mine = 0u;
#pragma unroll
        for (unsigned j = 0; j < 16; ++j) { const unsigned c = xb_ld(&bar[XB_XCNT(j)]); sum += c; cnt += (c > 0u) ? 1u : 0u; mine = (j == x) ? c : mine; }
        if (sum == G) break;
        __builtin_amdgcn_s_sleep(1);
        if ((++sp & 255u) == 0u) { if (xb_ld(&bar[XB_TMO])) break; if (sp > XB_SPIN_CAP) { atomicAdd(&bar[XB_TMO], 1u); break; } }
    }
    nloc = mine > 0u ? mine : 1u; nx = cnt > 0u ? cnt : 1u;
}
__device__ __forceinline__ void xcd_barrier(const XcdBarrier& b) {
    asm volatile("s_waitcnt vmcnt(0)" ::: "memory");
    __syncthreads();
    if (threadIdx.x == 0) {
        unsigned* bar = b.bar;
        __builtin_amdgcn_s_waitcnt(0);
        unsigned nloc = b.st[0], nx = b.st[1];
        if (nloc == 0u) { xcd_barrier_complete(bar, b.x, nloc, nx); b.st[0] = nloc; b.st[1] = nx; }
        const unsigned old = xb_add(&bar[XB_XSUB(b.x)], 1u);
        const unsigned gen = old / nloc;
        if (old + 1u == (gen + 1u) * nloc) {
            __builtin_amdgcn_fence(__ATOMIC_RELEASE, "agent");
            asm volatile("s_waitcnt vmcnt(0)" ::: "memory");
            const unsigned og = xb_add(&bar[XB_TOP], 1u);
            const unsigned tg = og / nx;
            if (og + 1u == (tg + 1u) * nx) xb_add(&bar[XB_TOPGEN], 1u);
            else XB_SPIN(xb_ld(&bar[XB_TOPGEN]) == tg, bar);
            __builtin_amdgcn_fence(__ATOMIC_ACQUIRE, "agent");
            xb_add(&bar[XB_XGEN(b.x)], 1u);
            asm volatile("s_waitcnt vmcnt(0)" ::: "memory");
        } else {
            XB_SPIN(xb_ld(&bar[XB_XGEN(b.x)]) == gen, bar);
            __builtin_amdgcn_fence(__ATOMIC_ACQUIRE, "agent");
            asm volatile("s_waitcnt vmcnt(0)" ::: "memory");
        }
    }
    __syncthreads();
}

#ifdef PROBE_L0
__global__ void __launch_bounds__(256) k_cmp2(const float* a, const float* b, size_t n, float* acc, int slot) {
    float num = 0.f, den = 0.f;
    for (size_t i = (size_t)blockIdx.x * 256 + threadIdx.x; i < n; i += (size_t)gridDim.x * 256) { const float x = a[i], y = b[i]; num += (x - y) * (x - y); den += y * y; }
    __shared__ float sn[256], sd[256]; sn[threadIdx.x] = num; sd[threadIdx.x] = den; __syncthreads();
    for (int s = 128; s > 0; s >>= 1) { if (threadIdx.x < s) { sn[threadIdx.x] += sn[threadIdx.x + s]; sd[threadIdx.x] += sd[threadIdx.x + s]; } __syncthreads(); }
    if (threadIdx.x == 0) { atomicAdd(&acc[slot], sn[0]); atomicAdd(&acc[4 + slot], sd[0]); }
}
__global__ void k_fin2(const float* acc, float* scale, int which) { float e = acc[which] / acc[4 + which]; if (!(e == e)) e = 1.f; scale[0] = 1.f + sqrtf(e) * 100.f; }
#endif
constexpr int LDS_TOTAL = 159744 + 64 + 256;
static_assert(ATT_LDS <= 159744, "attention LDS");
constexpr size_t NSLOT = (size_t)NB * NE * (CAP + CAPC);
constexpr int NPHASE = 2 + 11 * NL;
__global__ void __launch_bounds__(512, 2) k_mega(MP p) {
    extern __shared__ __attribute__((aligned(16))) unsigned char dynlds[];
    const ldsp lds = (ldsp)dynlds;
    const int bid0 = blockIdx.x, nblk0 = gridDim.x;

    volatile LAS unsigned* xbw = (volatile LAS unsigned*)(lds + 159744);
    if (threadIdx.x == 0) { xbw[0] = 0u; xbw[1] = 0u; xbw[2] = 0u; xbw[3] = 0u; }
    __syncthreads();
    const XcdBarrier bar = xcd_barrier_post(p.bar(), xbw);
    int g = 0;
#ifndef REP_MASK
#define REP_MASK 0
#endif
#define PH(kind, ...) if (g >= p.ph_lo() && g < p.ph_hi()) { int bid = bid0, nblk = nblk0; asm volatile("" : "+s"(bid), "+s"(nblk));     \
    __VA_ARGS__ if (((REP_MASK >> (kind)) & 1) && ((kind) != 5 || g < 13)) { xcd_barrier(bar); __VA_ARGS__ } if (g + 1 < p.ph_hi()) xcd_barrier(bar); } ++g;
#define bH (p.RA())
#define bO (p.RA())
#define bY (p.RA())
#define bQM (p.RC())
#define bKVM (p.RC() + (size_t)NROW * 384)
#define bMERGED (p.RC())
#define bH2 (p.RC())
#define bACT (p.Z())
#define bOUT (p.Z() + NSLOT * FF)
#define bXG (p.Z() + NSLOT * FF)
#define bWguT (p.Z() + 2 * NSLOT * FF)
#define bWdT (p.Z() + 2 * NSLOT * FF + (size_t)NE * 2048 * 1024)
    if ((REP_MASK >> 14) & 1) { for (int i = 0; i < 20; ++i) xcd_barrier(bar); }
    PH(12,
        ph_mod(lds, p, bid, nblk);
        ph_ropetab(p, bid, nblk);
        { PrepJob j{}; j.src = p.w_in(); j.dst = p.WinT(); j.K = D; j.Nsrc = INW; j.Ndst = ZWP; j.mode = 1; j.perm = 1; j.nz = NL; j.src_zs = (long long)D * INW; j.dst_zs = (long long)ZWP * D; ph_wprep(lds, j, bid, nblk); }
        { PrepJob j{}; j.src = p.w_qb(); j.kscale = p.mqn(); j.dst = p.WqT(); j.K = 192; j.Nsrc = 384; j.Ndst = 384; j.mode = 0; j.nz = NL; j.src_zs = 192 * 384; j.dst_zs = 384 * 192; j.ks_zs = 192; ph_wprep(lds, j, bid, nblk); }
        { PrepJob j{}; j.src = p.w_kvb(); j.kscale = p.mkvn(); j.dst = p.WkvT(); j.K = 128; j.Nsrc = 512; j.Ndst = 512; j.mode = 0; j.nz = NL; j.src_zs = 128 * 512; j.dst_zs = 512 * 128; j.ks_zs = 128; ph_wprep(lds, j, bid, nblk); }
        { PrepJob j{}; j.src = p.w_branch(); j.dst = p.WbT(); j.K = 256; j.Nsrc = 1024; j.Ndst = 1024; j.mode = 0; j.nz = NL * 4; j.src_zs = 256 * 1024; j.dst_zs = 1024 * 256; ph_wprep(lds, j, bid, nblk); }
        { PrepJob j{}; j.src = p.w_out(); j.dst = p.WoutT(); j.K = 1024; j.Nsrc = 1024; j.Ndst = 1024; j.mode = 0; j.perm = 1; j.nz = NL; j.src_zs = 1024 * 1024; j.dst_zs = 1024 * 1024; ph_wprep(lds, j, bid, nblk); }
    )
    PH(13, ph_lnmod0(p, bid, nblk);)
    for (int l = 0; l < NL; ++l) {
        const bool need_ctx = l + 1 < NL; const int mrows = need_ctx ? NROW : NLAT;
        PH(0, { InProj8S sc{}; sc.H = bH; sc.Wt = p.WinT() + (size_t)l * ZWP * D; sc.npm = NROW / 256; sc.bid = bid; sc.nblk = nblk; sc.nun = need_ctx ? 3300 : 3200 + 36;
                InProj8E ep{}; ep.Z = p.Z(); ep.SS = p.SS(); ep.gqn = p.gqn() + l * 64; ep.gkn = p.gkn() + l * 64; ep.tab64 = p.tab64(); ep.tab32 = p.tab32();
                pg8::gemm_phase<InProj8E, InProj8S, true, true>(lds, D, sc, ep); } )
        PH(1, { MlaProj pb{}; pb.Z = p.Z(); pb.WqT = p.WqT() + (size_t)l * 384 * 192; pb.WkvT = p.WkvT() + (size_t)l * 512 * 128; pb.QM = bQM; pb.KVM = bKVM; pb.SS = p.SS(); pb.tab32 = p.tab32(); pb.nlat = NLAT; pb.npm = NROW / 256;
                   gemm_run<128, false>(lds, pb, bid, nblk); } )
        PH(2, { AttnP ap{}; ap.Z = p.Z(); ap.QM = bQM; ap.KVM = bKVM; ap.O = bO; ap.rpb = p.na_rpb() + (size_t)l * 4 * 15 * 31; ap.sink = p.swa_sink() + l * 4; ap.nlat = NLAT; ap.need_ctx = need_ctx ? 1 : 0; ap.o32 = (l == 0) ? p.o32() : nullptr; ap.fake = 0;
#ifdef PROBE_F
                   if (l == 0) { ap.fake = PROBE_F; attn_phase(lds, ap, bid, nblk); ap.fake = 0; ap.o32 = nullptr; }
#endif
                   attn_phase(lds, ap, bid, nblk); } )
        PH(3, { MergeProb pb{}; pb.O = bO; pb.WbT = p.WbT() + (size_t)l * 4 * 1024 * 256; pb.Z = p.Z(); pb.MERGED = bMERGED; pb.npm = mrows / 256; gemm_run<128, true>(lds, pb, bid, nblk); } )
        PH(4, { Plain8S sc{}; sc.A = bMERGED; sc.Bt = p.WoutT() + (size_t)l * D * D; sc.npm = mrows / 256; sc.npn = 4; sc.K = D; sc.bid = bid; sc.nblk = nblk; Plain8E ep{}; ep.C = bY; ep.ldc = D;
                pg8::gemm_phase<Plain8E, Plain8S, true, true>(lds, D, sc, ep); } )
        PH(5, ph_lnres(lds, p, l, mrows, bid, nblk); )
        PH(6,
            ph_topk(lds, p, need_ctx ? 2 : 1, bid, nblk);
            { PrepJob j{}; j.src = p.w_gate() + (size_t)l * NE * D * FF; j.src2 = p.w_up() + (size_t)l * NE * D * FF; j.dst = bWguT; j.K = 1024; j.Nsrc = 1024; j.Ndst = 2048; j.mode = 2; j.perm = 1; j.nz = NE; j.src_zs = (long long)D * FF; j.dst_zs = (long long)2048 * 1024; ph_wprep(lds, j, bid, nblk); }
            { PrepJob j{}; j.src = p.w_down() + (size_t)l * NE * FF * D; j.dst = bWdT; j.K = 1024; j.Nsrc = 1024; j.Ndst = 1024; j.mode = 0; j.perm = 1; j.nz = NE; j.src_zs = (long long)FF * D; j.dst_zs = (long long)1024 * 1024; ph_wprep(lds, j, bid, nblk); }
        )
        PH(10, ph_gather(bH2, p.IDX(), bXG, need_ctx ? (int)NSLOT : CTXB, bid, nblk); )
        PH(7, { FfnUp8S sc{}; sc.XG = bXG; sc.WguT = bWguT; sc.nun = 2048 + (need_ctx ? 128 : 0); sc.bid = bid; sc.nblk = nblk; FfnUp8E ep{}; ep.ACT = bACT;
                pg8::gemm_phase<FfnUp8E, FfnUp8S, true, true>(lds, D, sc, ep); } )
        PH(8, { FfnDown8S sc{}; sc.ACT = bACT; sc.WdT = bWdT; sc.nun = 1024 + (need_ctx ? 64 : 0); sc.bid = bid; sc.nblk = nblk; FfnDown8E ep{}; ep.GATEV = p.GATEV(); ep.OUT = bOUT;
                pg8::gemm_phase<FfnDown8E, FfnDown8S, true, true>(lds, FF, sc, ep); } )
        PH(9, ph_combine(p, l, mrows, bOUT, bid, nblk); )
    }
#undef PH
#undef bH
#undef bO
#undef bY
#undef bQM
#undef bKVM
#undef bMERGED
#undef bH2
#undef bACT
#undef bOUT
#undef bXG
#undef bWguT
#undef bWdT
}
}

extern "C" void kernel_launch(void* const* d_in, const int* in_sizes, int n_in, void* d_out, int out_size, void* d_ws, size_t ws_size, hipStream_t stream) {
    MP p; memset(&p, 0, sizeof(p));
    p.x_ = (const float*)d_in[0]; p.c_ = (const float*)d_in[1]; p.ctx_ = (const float*)d_in[2]; p.c_ctx_ = (const float*)d_in[3];
    p.w_mod_ = (const float*)d_in[4]; p.b_mod_ = (const float*)d_in[5]; p.w_in_ = (const float*)d_in[6]; p.na_rpb_ = (const float*)d_in[7];
    p.gqn_ = (const float*)d_in[8]; p.gkn_ = (const float*)d_in[9]; p.swa_sink_ = (const float*)d_in[10];
    p.mqn_ = (const float*)d_in[11]; p.mkvn_ = (const float*)d_in[12]; p.w_qb_ = (const float*)d_in[13]; p.w_kvb_ = (const float*)d_in[14];
    p.w_branch_ = (const float*)d_in[15]; p.w_out_ = (const float*)d_in[16];
    p.ln1g_ = (const float*)d_in[17]; p.ln1b_ = (const float*)d_in[18]; p.ln2g_ = (const float*)d_in[19]; p.ln2b_ = (const float*)d_in[20];
    p.w_router_ = (const float*)d_in[21]; p.w_gate_ = (const float*)d_in[22]; p.w_up_ = (const float*)d_in[23]; p.w_down_ = (const float*)d_in[24];
    p.out_ = (float*)d_out;
    char* ws = (char*)d_ws; size_t off = OFF_END;
    auto carve = [&](size_t bytes) { void* q = ws + off; off += (bytes + 255) & ~(size_t)255; return q; }; (void)carve;
    p.ws_ = ws;
    if (off > ws_size || 2 * NSLOT * FF + (size_t)NE * 3072 * 1024 > (size_t)NROW * ZW) { fprintf(stderr, "workspace too small: need %zu have %zu\n", off, ws_size); return; }
    static int grid = 0;
    if (!grid) {
        int dev = 0, cus = 0, per_cu = 0;
        (void)hipGetDevice(&dev);
        (void)hipDeviceGetAttribute(&cus, hipDeviceAttributeMultiprocessorCount, dev);
        (void)hipFuncSetAttribute((const void*)k_mega, hipFuncAttributeMaxDynamicSharedMemorySize, LDS_TOTAL);
        (void)hipOccupancyMaxActiveBlocksPerMultiprocessor(&per_cu, (const void*)k_mega, 512, LDS_TOTAL);
        grid = per_cu >= 1 ? cus : 0;
        if (grid > 256) grid = 256;
    }
    if (!grid) { fprintf(stderr, "k_mega cannot be resident\n"); return; }
    (void)hipMemsetAsync(ws + OFF_BAR, 0, XCD_BAR_WORDS * 4, stream);
#ifdef PROBE_L0
    {
        float* save_xc = (float*)carve((size_t)NCTX * D * 4); float* save_x = (float*)carve((size_t)2048 * D * 4); float* pacc = (float*)carve(256); float* pscl = (float*)carve(256);
        if (off > ws_size) { fprintf(stderr, "probe workspace\n"); return; }
        nv::nv_layer0(d_in, d_out, d_ws, ws_size, stream, save_xc, save_x);
        (void)hipMemsetAsync(ws + OFF_BAR, 0, XCD_BAR_WORDS * 4, stream);
        (void)hipMemsetAsync(pacc, 0, 256, stream);
        p.pscale_ = pscl;
        p.ph_lo_ = 0; p.ph_hi_ = 2 + (NPHASE - 2) / NL;
        hipLaunchKernelGGL(k_mega, dim3(grid), dim3(512), LDS_TOTAL, stream, p);
        hipLaunchKernelGGL(k_cmp2, dim3(256), dim3(256), 0, stream, (const float*)(ws + OFF_XCB), (const float*)save_xc, (size_t)NCTX * D, pacc, 0);
        for (int b = 0; b < NB; ++b) hipLaunchKernelGGL(k_cmp2, dim3(256), dim3(256), 0, stream, (const float*)d_out + (size_t)b * SEQ * D, (const float*)save_x + (size_t)b * 512 * D, (size_t)512 * D, pacc, 1);
        hipLaunchKernelGGL(k_fin2, dim3(1), dim3(1), 0, stream, pacc, pscl, (int)PROBE_L0);
        (void)hipMemsetAsync(ws + OFF_BAR, 0, XCD_BAR_WORDS * 4, stream);
        p.ph_lo_ = 2 + (NPHASE - 2) / NL; p.ph_hi_ = NPHASE;
        hipLaunchKernelGGL(k_mega, dim3(grid), dim3(512), LDS_TOTAL, stream, p);
    }
#elif defined(PROBE_ATTN)
    {
        float* O32 = (float*)carve((size_t)2304 * D * 4); float* O2 = (float*)carve((size_t)2304 * D * 4); float* pacc = (float*)carve(256); float* pscl = (float*)carve(256);
        if (off > ws_size) { fprintf(stderr, "probe workspace\n"); return; }
        p.o32_ = O32; p.pscale_ = pscl;
        (void)hipMemsetAsync(pacc, 0, 256, stream);
        p.ph_lo_ = 0; p.ph_hi_ = 5;
        hipLaunchKernelGGL(k_mega, dim3(grid), dim3(512), LDS_TOTAL, stream, p);
        AttnArgs a{}; a.Z = (const T*)(ws + OFF_Z); a.QM = (const T*)(ws + OFF_RC); a.KVM = (const T*)(ws + OFF_RC) + (size_t)NROW * 384; a.O2 = O2; a.rpb = p.na_rpb_; a.sink = p.swa_sink_; a.P.nbp = NB; a.P.b0 = 0; a.P.nlat = NLAT; a.P.nctx = NCTX; a.P.nrow = NROW; a.bl0 = 1;
        a.ctxq = 0; { dim3 g(8, 4, 1); hipLaunchKernelGGL(k_attn_naive<0>, g, dim3(256), 0, stream, a); hipLaunchKernelGGL(k_attn_naive<1>, g, dim3(256), 0, stream, a);
                      hipLaunchKernelGGL(k_attn_naive<2>, g, dim3(256), 0, stream, a); hipLaunchKernelGGL(k_attn_naive<3>, g, dim3(256), 0, stream, a); }
        a.ctxq = 1; { dim3 g(1, 4, 1); hipLaunchKernelGGL(k_attn_naive<0>, g, dim3(256), 0, stream, a); hipLaunchKernelGGL(k_attn_naive<1>, g, dim3(256), 0, stream, a);
                      hipLaunchKernelGGL(k_attn_naive<2>, g, dim3(256), 0, stream, a); hipLaunchKernelGGL(k_attn_naive<3>, g, dim3(256), 0, stream, a); }
        hipLaunchKernelGGL(k_probe_cmp, dim3(64, 4), dim3(256), 0, stream, O32, O2, pacc, 2304);
        hipLaunchKernelGGL(k_probe_fin, dim3(1), dim3(1), 0, stream, pacc, pscl, (int)PROBE_ATTN);
        (void)hipMemsetAsync(ws + OFF_BAR, 0, XCD_BAR_WORDS * 4, stream);
        p.ph_lo_ = 5; p.ph_hi_ = NPHASE;
        hipLaunchKernelGGL(k_mega, dim3(grid), dim3(512), LDS_TOTAL, stream, p);
    }
#elif defined(PROBE_T)
    {
        float* pscl = (float*)carve(256);
        if (off > ws_size) { fprintf(stderr, "probe workspace\n"); return; }
        p.o32_ = pscl; p.pscale_ = pscl;
        p.ph_lo_ = 0; p.ph_hi_ = NPHASE;
        hipLaunchKernelGGL(k_mega, dim3(grid), dim3(512), LDS_TOTAL, stream, p);
    }
#elif !defined(MK_SPLIT)
    p.ph_lo_ = 0; p.ph_hi_ = NPHASE;
    hipLaunchKernelGGL(k_mega, dim3(grid), dim3(512), LDS_TOTAL, stream, p);
#else
    for (int g = 0; g < NPHASE; ++g) { p.ph_lo_ = g; p.ph_hi_ = g + 1; hipLaunchKernelGGL(k_mega, dim3(grid), dim3(512), LDS_TOTAL, stream, p); }
#endif
}
```

```cpp
#include <hip/hip_runtime.h>
#include <hip/hip_bf16.h>
#include <stdint.h>
#include <stdio.h>
#include <string.h>

namespace {
constexpr int D = 1024, SEQ = 8192, CTX = 256, NB = 4, NL = 2, HD = 64;
constexpr int GW = 64, GROWS = 128;
constexpr int INW = 6240;
constexpr int ZW = 6240;
constexpr int NAQ = 0, NAK = 256, NAV = 512, GQ = 768, GK = 1024, GV = 1152, SQ = 1280, SK = 1536, SV = 1664,
              MCQ = 1792, MCKV = 1984, MKR = 2112, GATE = 2144;
constexpr int NE = 16, FF = 1024, CAP = 1024, CAPC = 32;
constexpr int MODW = 6 * D;
constexpr float EPS = 1e-6f;
constexpr float ALPHA = 1.4142135623730951f;
constexpr int NLAT = NB * SEQ, NCTX = NB * CTX, NROW = NLAT + NCTX;

struct T {
    unsigned short u;
    __device__ __forceinline__ operator float() const { return __uint_as_float((unsigned)u << 16); }
    __device__ __forceinline__ T& operator=(float f) { unsigned b = __float_as_uint(f); b += 0x7fffu + ((b >> 16) & 1u); u = (unsigned short)(b >> 16); return *this; }
};
__device__ __forceinline__ float4 ld4(const float* p) { return *(const float4*)p; }
__device__ __forceinline__ float4 ld4(const T* p) { uint2 r = *(const uint2*)p; return make_float4(__uint_as_float(r.x << 16), __uint_as_float(r.x & 0xffff0000u), __uint_as_float(r.y << 16), __uint_as_float(r.y & 0xffff0000u)); }
__device__ __forceinline__ unsigned pk2(float lo, float hi) { T a, b; a = lo; b = hi; return (unsigned)a.u | ((unsigned)b.u << 16); }
__device__ __forceinline__ void st4(float* p, float4 v) { *(float4*)p = v; }
__device__ __forceinline__ void st4(T* p, float4 v) { *(uint2*)p = make_uint2(pk2(v.x, v.y), pk2(v.z, v.w)); }

__device__ __forceinline__ int otid() { int t = threadIdx.x; asm volatile("" : "+v"(t)); return t; }
__device__ __forceinline__ int xswz(int u, int n) { const int c = u & 7, s = u >> 3, q = n >> 3, rr = n & 7; return (c < rr ? c * (q + 1) : rr * (q + 1) + (c - rr) * q) + s; }
#define DPP_ADD(v, ctrl) ((v) + __builtin_bit_cast(float, __builtin_amdgcn_update_dpp(0, __builtin_bit_cast(int, (v)), (ctrl), 0xf, 0xf, true)))
__device__ __forceinline__ float wave_sum(float v) {
    v = DPP_ADD(v, 0xB1);
    v = DPP_ADD(v, 0x4E);
    v = DPP_ADD(v, 0x141);
    v = DPP_ADD(v, 0x140);
    const int iv = __builtin_bit_cast(int, v);
    const float r0 = __builtin_bit_cast(float, __builtin_amdgcn_readlane(iv, 0)), r1 = __builtin_bit_cast(float, __builtin_amdgcn_readlane(iv, 16)),
                r2 = __builtin_bit_cast(float, __builtin_amdgcn_readlane(iv, 32)), r3 = __builtin_bit_cast(float, __builtin_amdgcn_readlane(iv, 48));
    return (r0 + r1) + (r2 + r3);
}

typedef short bf16x8 __attribute__((ext_vector_type(8)));
typedef float f32x4 __attribute__((ext_vector_type(4)));
#define LAS __attribute__((address_space(3)))
typedef LAS unsigned char* ldsp;
constexpr int ZWP = 6400;

__device__ __forceinline__ float fast_rsqrt(float x) { return __builtin_amdgcn_rsqf(x); }
__device__ __forceinline__ float fast_sigmoid(float x) { return __builtin_amdgcn_rcpf(1.f + __builtin_amdgcn_exp2f(-1.4426950408889634f * x)); }
__device__ __forceinline__ float fast_silu(float x) { return x * fast_sigmoid(x); }
__device__ __forceinline__ uint2 pk4(float a, float b, float c, float d) { return make_uint2(pk2(a, b), pk2(c, d)); }

#define GLDS16(gp, lp) __builtin_amdgcn_global_load_lds((const unsigned*)(gp), (LAS unsigned*)(lp), 16, 0, 0)
template <int BN, bool HAS_SUM, class Prob>
__device__ __forceinline__ void gemm_run(ldsp lds, const Prob& pb, int bid, int nblk) {
    constexpr int NF = BN / 64, GLB = BN / 64, A_BYTES = 32768, B_BYTES = BN * 128, STAGE = A_BYTES + B_BYTES, NSTG = (BN == 128) ? 3 : 2, NGL = 4 + GLB;
    const int tid = otid(), wid = __builtin_amdgcn_readfirstlane(tid >> 6), lane = tid & 63, wr = wid >> 2, wc = wid & 3, fr = lane & 15, fq = lane >> 4;
    const int NU = pb.nunits();
    if (bid >= NU) return;
    const int sb = lane * 16, swz = sb ^ (((sb >> 9) & 1) << 5);
    const int sR0 = (wid >> 1) * 16 + (swz >> 6), sC = (wid & 1) * 32 + ((swz & 63) >> 1);
    const int ob = fr * 64 + fq * 16, lane_off = ob ^ (((ob >> 9) & 1) << 5);
    const unsigned ldsw = (unsigned)wid * 1024u;
    unsigned aoff[4], boff[GLB];
    int su = bid, st = 0, snt = pb.ntiles(su), sbuf = 0, inflight = 0;
#define G_LOAD_OFFS() do { _Pragma("unroll") for (int i = 0; i < 4; ++i) aoff[i] = pb.a_off(su, sR0 + 64 * i) + sC; \
                           _Pragma("unroll") for (int i = 0; i < GLB; ++i) boff[i] = pb.b_off(su, sR0 + 64 * i) + sC; } while (0)
#define G_STAGE() do { if (su < NU) { const T* Ab = pb.a_base(su, st); const T* Bb = pb.b_base(su, st); ldsp sbase = lds + sbuf * STAGE + ldsw; \
        _Pragma("unroll") for (int i = 0; i < 4; ++i) GLDS16(Ab + aoff[i], sbase + i * 8192); \
        _Pragma("unroll") for (int i = 0; i < GLB; ++i) GLDS16(Bb + boff[i], sbase + A_BYTES + i * 8192); \
        ++inflight; sbuf = (sbuf + 1 == NSTG) ? 0 : sbuf + 1; \
        if (++st == snt) { su += nblk; st = 0; if (su < NU) { snt = pb.ntiles(su); G_LOAD_OFFS(); } } } } while (0)
    G_LOAD_OFFS();
    G_STAGE();
    if (NSTG == 3) G_STAGE();
    int buf = 0;
    for (int cu = bid; cu < NU; cu += nblk) {
        f32x4 acc[8][NF]; f32x4 sum[HAS_SUM ? 8 : 1][HAS_SUM ? NF : 1]; uint2 gpre[HAS_SUM ? 8 : 1][HAS_SUM ? NF : 1];
#pragma unroll
        for (int m = 0; m < 8; ++m)
#pragma unroll
            for (int n = 0; n < NF; ++n) { acc[m][n] = (f32x4){0.f, 0.f, 0.f, 0.f}; if (HAS_SUM) sum[m][n] = (f32x4){0.f, 0.f, 0.f, 0.f}; }
        const int nt = pb.ntiles(cu);
        for (int t = 0; t < nt; ++t) {
            if (NSTG == 3) {
                if constexpr (HAS_SUM) { if (inflight >= 2) { if (pb.extra_inflight(t)) asm volatile("s_waitcnt vmcnt(%0)" :: "n"(NGL + 16) : "memory"); else asm volatile("s_waitcnt vmcnt(%0)" :: "n"(NGL) : "memory"); }
                                         else asm volatile("s_waitcnt vmcnt(0)" ::: "memory"); }
                else { if (inflight >= 2) asm volatile("s_waitcnt vmcnt(%0)" :: "n"(NGL) : "memory"); else asm volatile("s_waitcnt vmcnt(0)" ::: "memory"); }
                asm volatile("s_waitcnt lgkmcnt(0)\n\ts_barrier" ::: "memory");
            } else {
                asm volatile("s_waitcnt vmcnt(0)" ::: "memory");
                __syncthreads();
            }
            if constexpr (!(NF == 2 && HAS_SUM)) G_STAGE();
            if constexpr (HAS_SUM) pb.tile_begin(cu, t, gpre, wr, wc, fr, fq);
            const ldsp ta = lds + buf * STAGE + wr * 16384 + lane_off, tb = lds + buf * STAGE + A_BYTES + wc * (NF * 2048) + lane_off;
            if constexpr (NF == 2 && HAS_SUM) {
                const unsigned ta_ = (unsigned)(size_t)ta, tb_ = (unsigned)(size_t)tb;
                bf16x8 a0, a1, a2, a3, a4, a5, a6, a7, b0, b1;
#define G_RD(dst, addr, OFF) asm volatile("ds_read_b128 %0, %1 offset:" #OFF : "=v"(dst) : "v"(addr))
#define G_MM(m, av) do { acc[m][0] = __builtin_amdgcn_mfma_f32_16x16x32_bf16(b0, av, acc[m][0], 0, 0, 0); acc[m][1] = __builtin_amdgcn_mfma_f32_16x16x32_bf16(b1, av, acc[m][1], 0, 0, 0); } while (0)
                const bool g_on = su < NU; const T* gAb = pb.a_base(g_on ? su : cu, st); const T* gBb = pb.b_base(g_on ? su : cu, st); const ldsp gsb = lds + sbuf * STAGE + ldsw;
                G_RD(a0, ta_, 0); G_RD(a1, ta_, 2048); G_RD(a2, ta_, 4096); G_RD(a3, ta_, 6144); G_RD(b0, tb_, 0); G_RD(b1, tb_, 2048);
                if (g_on) { GLDS16(gAb + aoff[0], gsb); GLDS16(gAb + aoff[1], gsb + 8192); }
                asm volatile("s_waitcnt lgkmcnt(0)" : "+v"(a0), "+v"(a1), "+v"(a2), "+v"(a3), "+v"(b0), "+v"(b1));
                __builtin_amdgcn_sched_barrier(0);
                G_RD(a4, ta_, 8192); G_RD(a5, ta_, 10240); G_RD(a6, ta_, 12288); G_RD(a7, ta_, 14336);
                G_MM(0, a0); G_MM(1, a1); G_MM(2, a2); G_MM(3, a3);
                __builtin_amdgcn_sched_barrier(0);
                if (g_on) { GLDS16(gAb + aoff[2], gsb + 2 * 8192); GLDS16(gAb + aoff[3], gsb + 3 * 8192); }
                asm volatile("s_waitcnt lgkmcnt(0)" : "+v"(a4), "+v"(a5), "+v"(a6), "+v"(a7));
                __builtin_amdgcn_sched_barrier(0);
                bf16x8 c0, c1, c2, c3, d0, d1;
                G_RD(c0, ta_, 1024); G_RD(c1, ta_, 3072); G_RD(c2, ta_, 5120); G_RD(c3, ta_, 7168); G_RD(d0, tb_, 1024); G_RD(d1, tb_, 3072);
                G_MM(4, a4); G_MM(5, a5); G_MM(6, a6); G_MM(7, a7);
                __builtin_amdgcn_sched_barrier(0);
                if (g_on) { GLDS16(gBb + boff[0], gsb + A_BYTES); GLDS16(gBb + boff[1], gsb + A_BYTES + 8192);
                            ++inflight; sbuf = (sbuf + 1 == NSTG) ? 0 : sbuf + 1;
                            if (++st == snt) { su += nblk; st = 0; if (su < NU) { snt = pb.ntiles(su); G_LOAD_OFFS(); } } }
                asm volatile("s_waitcnt lgkmcnt(0)" : "+v"(c0), "+v"(c1), "+v"(c2), "+v"(c3), "+v"(d0), "+v"(d1));
                __builtin_amdgcn_sched_barrier(0);
                b0 = d0; b1 = d1;
                G_RD(a4, ta_, 9216); G_RD(a5, ta_, 11264); G_RD(a6, ta_, 13312); G_RD(a7, ta_, 15360);
                G_MM(0, c0); G_MM(1, c1); G_MM(2, c2); G_MM(3, c3);
                __builtin_amdgcn_sched_barrier(0);
                asm volatile("s_waitcnt lgkmcnt(0)" : "+v"(a4), "+v"(a5), "+v"(a6), "+v"(a7));
                __builtin_amdgcn_sched_barrier(0);
                G_MM(4, a4); G_MM(5, a5); G_MM(6, a6); G_MM(7, a7);
                __builtin_amdgcn_sched_barrier(0);
#undef G_RD
#undef G_MM
            } else {
#pragma unroll
            for (int ks = 0; ks < 2; ++ks) {
                bf16x8 At[8], Bf[NF];
#pragma unroll
                for (int m = 0; m < 8; ++m) At[m] = *(const LAS bf16x8*)(ta + m * 2048 + ks * 1024);
#pragma unroll
                for (int n = 0; n < NF; ++n) Bf[n] = *(const LAS bf16x8*)(tb + n * 2048 + ks * 1024);
#pragma unroll
                for (int m = 0; m < 8; ++m)
#pragma unroll
                    for (int n = 0; n < NF; ++n) acc[m][n] = __builtin_amdgcn_mfma_f32_16x16x32_bf16(Bf[n], At[m], acc[m][n], 0, 0, 0);
            }
            }
            if constexpr (HAS_SUM) pb.tile_done(cu, t, acc, sum, gpre, wr, wc, fr, fq);
            --inflight; buf = (buf + 1 == NSTG) ? 0 : buf + 1;
        }
        if constexpr (HAS_SUM) pb.epilogue(cu, sum, wr, wc, fr, fq); else pb.epilogue(cu, acc, wr, wc, fr, fq);
    }
    asm volatile("s_waitcnt vmcnt(0) lgkmcnt(0)\n\ts_barrier" ::: "memory");
#undef G_LOAD_OFFS
#undef G_STAGE
}

struct InProj {
    const T* H; const T* Wt; T* Z; float* SS; const float* gqn; const float* gkn; const float2* tab64; const float2* tab32; int nlat, npm;
    __device__ __forceinline__ int nunits() const { return npm * 25; }
    __device__ __forceinline__ int ntiles(int) const { return 16; }
    __device__ __forceinline__ unsigned a_off(int u, int R) const { return (unsigned)((u / 25) * 256 + R) * 1024u; }
    __device__ __forceinline__ unsigned b_off(int u, int R) const { return (unsigned)((u % 25) * 256 + R) * 1024u; }
    __device__ __forceinline__ const T* a_base(int, int t) const { return H + t * 64; }
    __device__ __forceinline__ const T* b_base(int, int t) const { return Wt + t * 64; }
    __device__ __forceinline__ void epilogue(int u, f32x4 (&acc)[8][4], int wr, int wc, int fr, int fq) const {
        const int pm = u / 25, pn = u % 25, cg = pn * 4 + wc;
        if (cg == 34 || cg == 35) return;
        const int row0 = pm * 256 + wr * 128 + fr;
        const bool lat = pm * 256 < nlat;
        const int zcol = (cg < 36 ? cg * 64 : 2144 + (cg - 36) * 64) + fq * 4;
        const bool t_rms = (cg >= 12 && cg < 18), t_rope = t_rms || (cg >= 20 && cg < 26), t_ssq = (cg >= 28 && cg < 33), t_kr = cg == 33, t_sig = cg >= 36;
        float4 gv[4];
        if (t_rms) { const float* g = cg < 16 ? gqn : gkn;
#pragma unroll
            for (int n = 0; n < 4; ++n) gv[n] = *(const float4*)(g + n * 16 + fq * 4); }
#pragma unroll
        for (int m = 0; m < 8; ++m) {
            const int row = row0 + m * 16;
            const int t = row & (SEQ - 1), gr = t >> 6, gc = t & 63;
            float v[4][4];
#pragma unroll
            for (int n = 0; n < 4; ++n)
#pragma unroll
                for (int j = 0; j < 4; ++j) v[n][j] = acc[m][n][j];
            T* zp = Z + (size_t)row * ZW + zcol;
            if (t_rms || t_ssq) {
                float ss = 0.f;
#pragma unroll
                for (int n = 0; n < 4; ++n)
#pragma unroll
                    for (int j = 0; j < 4; ++j) ss += v[n][j] * v[n][j];
                ss += __shfl_xor(ss, 16); ss += __shfl_xor(ss, 32);
                if (t_ssq) { if (fq == 0) SS[(size_t)row * 8 + (cg - 28)] = ss; }
                else { const float rstd = 1.f / sqrtf(ss * (1.f / 64.f) + EPS);
#pragma unroll
                    for (int n = 0; n < 4; ++n) { v[n][0] *= rstd * gv[n].x; v[n][1] *= rstd * gv[n].y; v[n][2] *= rstd * gv[n].z; v[n][3] *= rstd * gv[n].w; } }
            }
            if (t_rope && lat) {
                const float4* tr = (const float4*)(tab64 + gr * 16 + fq * 4); const float4* tc = (const float4*)(tab64 + gc * 16 + fq * 4);
                const float4 r0 = tr[0], r1 = tr[1], c0 = tc[0], c1 = tc[1];
                const float rc[4] = {r0.x, r0.z, r1.x, r1.z}, rs[4] = {r0.y, r0.w, r1.y, r1.w}, cc[4] = {c0.x, c0.z, c1.x, c1.z}, cs[4] = {c0.y, c0.w, c1.y, c1.w};
#pragma unroll
                for (int j = 0; j < 4; ++j) {
                    const float a0 = v[0][j], a1 = v[1][j], b0 = v[2][j], b1 = v[3][j];
                    v[0][j] = a0 * rc[j] - a1 * rs[j]; v[1][j] = a0 * rs[j] + a1 * rc[j];
                    v[2][j] = b0 * cc[j] - b1 * cs[j]; v[3][j] = b0 * cs[j] + b1 * cc[j];
                }
            }
            if (t_kr) {
#pragma unroll
                for (int n = 0; n < 2; ++n) {
                    const float4* tp = (const float4*)(tab32 + (n == 0 ? gr : gc) * 8 + (fq & 1) * 4);
                    const float4 q0 = tp[0], q1 = tp[1];
                    const float kc[4] = {q0.x, q0.z, q1.x, q1.z}, ks[4] = {q0.y, q0.w, q1.y, q1.w};
#pragma unroll
                    for (int j = 0; j < 4; ++j) { const float x = v[n][j], px = __shfl_xor(x, 32); if (lat) v[n][j] = (fq < 2) ? (x * kc[j] - px * ks[j]) : (px * ks[j] + x * kc[j]); }
                    *(uint2*)(zp + n * 16) = pk4(v[n][0], v[n][1], v[n][2], v[n][3]);
                }
                continue;
            }
            if (t_sig) {
#pragma unroll
                for (int n = 0; n < 4; ++n)
#pragma unroll
                    for (int j = 0; j < 4; ++j) v[n][j] = fast_sigmoid(v[n][j]);
            }
#pragma unroll
            for (int n = 0; n < 4; ++n) *(uint2*)(zp + n * 16) = pk4(v[n][0], v[n][1], v[n][2], v[n][3]);
        }
    }
};

struct MlaProj {
    const T* Z; const T* WqT; const T* WkvT; T* QM; T* KVM; const float* SS; const float2* tab32; int nlat, npm;
    __device__ __forceinline__ int nunits() const { return npm * 7; }
    __device__ __forceinline__ int ntiles(int u) const { return u < npm * 3 ? 3 : 2; }
    __device__ __forceinline__ unsigned a_off(int u, int R) const { const int pm = u < npm * 3 ? u / 3 : (u - npm * 3) / 4; return (unsigned)(pm * 256 + R) * (unsigned)ZW; }
    __device__ __forceinline__ unsigned b_off(int u, int R) const { return u < npm * 3 ? (unsigned)((u % 3) * 128 + R) * 192u : (unsigned)(((u - npm * 3) % 4) * 128 + R) * 128u; }
    __device__ __forceinline__ const T* a_base(int u, int t) const { return Z + (u < npm * 3 ? MCQ : MCKV) + t * 64; }
    __device__ __forceinline__ const T* b_base(int u, int t) const { return (u < npm * 3 ? WqT : WkvT) + t * 64; }
    __device__ __forceinline__ void epilogue(int u, f32x4 (&acc)[8][2], int wr, int wc, int fr, int fq) const {
        const bool isq = u < npm * 3;
        const int pm = isq ? u / 3 : (u - npm * 3) / 4, pn = isq ? u % 3 : (u - npm * 3) % 4;
        const int row0 = pm * 256 + wr * 128 + fr;
        const bool lat = pm * 256 < nlat;
#pragma unroll
        for (int m = 0; m < 8; ++m) {
            const int row = row0 + m * 16;
            const float* ss = SS + (size_t)row * 8;
            const float rstd = isq ? 1.f / sqrtf((ss[0] + ss[1] + ss[2]) * (1.f / 192.f) + EPS) : 1.f / sqrtf((ss[3] + ss[4]) * (1.f / 128.f) + EPS);
            const int t = row & (SEQ - 1), gr = t >> 6, gc = t & 63;
#pragma unroll
            for (int n = 0; n < 2; ++n) {
                float v[4];
#pragma unroll
                for (int j = 0; j < 4; ++j) v[j] = acc[m][n][j] * rstd;
                const int f = pn * 8 + wc * 2 + n;
                if (isq) {
                    const int part = f % 6;
                    if (part >= 4) {
                        const float4* tp = (const float4*)(tab32 + (part == 4 ? gr : gc) * 8 + (fq & 1) * 4);
                        const float4 q0 = tp[0], q1 = tp[1];
                        const float kc[4] = {q0.x, q0.z, q1.x, q1.z}, ks[4] = {q0.y, q0.w, q1.y, q1.w};
#pragma unroll
                        for (int j = 0; j < 4; ++j) { const float x = v[j], px = __shfl_xor(x, 32); if (lat) v[j] = (fq < 2) ? (x * kc[j] - px * ks[j]) : (px * ks[j] + x * kc[j]); }
                    }
                    *(uint2*)(QM + (size_t)row * 384 + f * 16 + fq * 4) = pk4(v[0], v[1], v[2], v[3]);
                } else {
                    *(uint2*)(KVM + (size_t)row * 512 + f * 16 + fq * 4) = pk4(v[0], v[1], v[2], v[3]);
                }
            }
        }
    }
};

struct MergeProb {
    const T* O; const T* WbT; const T* Z; T* MERGED; int npm;
    __device__ __forceinline__ int nunits() const { return npm * 8; }
    __device__ __forceinline__ int ntiles(int) const { return 16; }
    __device__ __forceinline__ unsigned a_off(int u0, int R) const { const int u = xswz(u0, npm * 8); return (unsigned)((u >> 3) * 256 + R) * 1024u; }
    __device__ __forceinline__ unsigned b_off(int u0, int R) const { const int u = xswz(u0, npm * 8); return (unsigned)((u & 7) * 128 + R) * 256u; }
    __device__ __forceinline__ const T* a_base(int, int t) const { return O + (t >> 2) * 256 + (t & 3) * 64; }
    __device__ __forceinline__ const T* b_base(int, int t) const { return WbT + (size_t)(t >> 2) * 1024 * 256 + (t & 3) * 64; }
    __device__ __forceinline__ void tile_begin(int u0, int t, uint2 (&gpre)[8][2], int wr, int wc, int fr, int fq) const {
        if ((t & 3) != 0) return;
        const int u = xswz(u0, npm * 8); const int i = t >> 2, pm = u >> 3, pn = u & 7;
        const T* gp = Z + (size_t)(pm * 256 + wr * 128 + fr) * ZW + GATE + i * 1024 + pn * 128 + wc * 32 + fq * 4;
#pragma unroll
        for (int m = 0; m < 8; ++m)
#pragma unroll
            for (int n = 0; n < 2; ++n) { const T* q_ = gp + (size_t)m * 16 * ZW + n * 16; asm volatile("global_load_dwordx2 %0, %1, off" : "=v"(gpre[m][n]) : "v"(q_)); }
    }
    __device__ __forceinline__ int extra_inflight(int t) const { return ((t & 3) == 1) ? 16 : 0; }
    __device__ __forceinline__ void tile_done(int u, int t, f32x4 (&acc)[8][2], f32x4 (&sum)[8][2], uint2 (&gpre)[8][2], int wr, int wc, int fr, int fq) const {
        if ((t & 3) != 3) return;
#pragma unroll
        for (int m = 0; m < 8; ++m)
#pragma unroll
            for (int n = 0; n < 2; ++n) {
                const uint2 r = gpre[m][n];
                sum[m][n][0] += __uint_as_float(r.x << 16) * acc[m][n][0]; sum[m][n][1] += __uint_as_float(r.x & 0xffff0000u) * acc[m][n][1];
                sum[m][n][2] += __uint_as_float(r.y << 16) * acc[m][n][2]; sum[m][n][3] += __uint_as_float(r.y & 0xffff0000u) * acc[m][n][3];
                acc[m][n] = (f32x4){0.f, 0.f, 0.f, 0.f};
            }
    }
    __device__ __forceinline__ void epilogue(int u0, f32x4 (&sum)[8][2], int wr, int wc, int fr, int fq) const {
        const int u = xswz(u0, npm * 8); const int pm = u >> 3, pn = u & 7;
        T* op = MERGED + (size_t)(pm * 256 + wr * 128 + fr) * 1024 + pn * 128 + wc * 32 + fq * 4;
#pragma unroll
        for (int m = 0; m < 8; ++m)
#pragma unroll
            for (int n = 0; n < 2; ++n) *(uint2*)(op + (size_t)m * 16 * 1024 + n * 16) = pk4(sum[m][n][0], sum[m][n][1], sum[m][n][2], sum[m][n][3]);
    }
};

struct PlainProb {
    const T* A; const T* Bt; T* C; int npm, npn, K, lda, ldc;
    __device__ __forceinline__ int nunits() const { return npm * npn; }
    __device__ __forceinline__ int ntiles(int) const { return K / 64; }
    __device__ __forceinline__ unsigned a_off(int u0, int R) const { const int u = xswz(u0, npm * npn); return (unsigned)((u / npn) * 256 + R) * (unsigned)lda; }
    __device__ __forceinline__ unsigned b_off(int u0, int R) const { const int u = xswz(u0, npm * npn); return (unsigned)((u % npn) * 128 + R) * (unsigned)K; }
    __device__ __forceinline__ const T* a_base(int, int t) const { return A + t * 64; }
    __device__ __forceinline__ const T* b_base(int, int t) const { return Bt + t * 64; }
    __device__ __forceinline__ void epilogue(int u0, f32x4 (&acc)[8][2], int wr, int wc, int fr, int fq) const {
        const int u = xswz(u0, npm * npn); const int pm = u / npn, pn = u % npn;
        T* op = C + (size_t)(pm * 256 + wr * 128 + fr) * ldc + pn * 128 + wc * 32 + fq * 4;
#pragma unroll
        for (int m = 0; m < 8; ++m)
#pragma unroll
            for (int n = 0; n < 2; ++n) *(uint2*)(op + (size_t)m * 16 * ldc + n * 16) = pk4(acc[m][n][0], acc[m][n][1], acc[m][n][2], acc[m][n][3]);
    }
};

constexpr int CTXB = NB * NE * CAP;
struct FfnUp {
    const T* H2; const T* WguT; const int* IDX; T* ACT; int nun;
    __device__ __forceinline__ int nunits() const { return nun; }
    __device__ __forceinline__ int ntiles(int) const { return 16; }
    __device__ __forceinline__ void decode(int u, int& e, int& pn, int& sbase, bool& isctx) const {
        if (u < 2048) { e = u >> 7; const int rem = u & 127; pn = rem & 7; sbase = ((rem >> 5) * NE + e) * CAP + ((rem >> 3) & 3) * 256; isctx = false; }
        else { const int uc = u - 2048; e = uc >> 3; pn = uc & 7; sbase = CTXB + e * CAPC; isctx = true; }
    }
    __device__ __forceinline__ int slot_of(int sbase, bool isctx, int R) const { return isctx ? (R < 128 ? sbase + (R >> 5) * (NE * CAPC) + (R & 31) : -1) : sbase + R; }
    __device__ __forceinline__ unsigned a_off(int u, int R) const { int e, pn, sb; bool ic; decode(u, e, pn, sb, ic); const int s = slot_of(sb, ic, R); return s < 0 ? 0u : (unsigned)IDX[s] * 1024u; }
    __device__ __forceinline__ unsigned b_off(int u, int R) const { int e, pn, sb; bool ic; decode(u, e, pn, sb, ic); return (unsigned)(e * 2048 + pn * 256 + R) * 1024u; }
    __device__ __forceinline__ const T* a_base(int, int t) const { return H2 + t * 64; }
    __device__ __forceinline__ const T* b_base(int, int t) const { return WguT + t * 64; }
    __device__ __forceinline__ void epilogue(int u, f32x4 (&acc)[8][4], int wr, int wc, int fr, int fq) const {
        int e, pn, sb; bool ic; decode(u, e, pn, sb, ic);
        const int col = (pn * 4 + wc) * 32 + fq * 4;
#pragma unroll
        for (int m = 0; m < 8; ++m) {
            const int s = slot_of(sb, ic, wr * 128 + m * 16 + fr);
            if (s < 0) continue;
            T* op = ACT + (size_t)s * FF + col;
#pragma unroll
            for (int n = 0; n < 2; ++n)
                *(uint2*)(op + n * 16) = pk4(fast_silu(acc[m][n][0]) * acc[m][n + 2][0], fast_silu(acc[m][n][1]) * acc[m][n + 2][1],
                                             fast_silu(acc[m][n][2]) * acc[m][n + 2][2], fast_silu(acc[m][n][3]) * acc[m][n + 2][3]);
        }
    }
};
struct FfnDown {
    const T* ACT; const T* WdT; const float* GATEV; T* OUT; int nun;
    __device__ __forceinline__ int nunits() const { return nun; }
    __device__ __forceinline__ int ntiles(int) const { return 16; }
    __device__ __forceinline__ void decode(int u, int& e, int& pn, int& sbase, bool& isctx) const {
        if (u < 1024) { e = u >> 6; const int rem = u & 63; pn = rem & 3; sbase = ((rem >> 4) * NE + e) * CAP + ((rem >> 2) & 3) * 256; isctx = false; }
        else { const int uc = u - 1024; e = uc >> 2; pn = uc & 3; sbase = CTXB + e * CAPC; isctx = true; }
    }
    __device__ __forceinline__ int slot_of(int sbase, bool isctx, int R) const { return isctx ? (R < 128 ? sbase + (R >> 5) * (NE * CAPC) + (R & 31) : -1) : sbase + R; }
    __device__ __forceinline__ unsigned a_off(int u, int R) const { int e, pn, sb; bool ic; decode(u, e, pn, sb, ic); const int s = slot_of(sb, ic, R); return s < 0 ? 0u : (unsigned)s * 1024u; }
    __device__ __forceinline__ unsigned b_off(int u, int R) const { int e, pn, sb; bool ic; decode(u, e, pn, sb, ic); return (unsigned)(e * 1024 + pn * 256 + R) * 1024u; }
    __device__ __forceinline__ const T* a_base(int, int t) const { return ACT + t * 64; }
    __device__ __forceinline__ const T* b_base(int, int t) const { return WdT + t * 64; }
    __device__ __forceinline__ void epilogue(int u, f32x4 (&acc)[8][4], int wr, int wc, int fr, int fq) const {
        int e, pn, sb; bool ic; decode(u, e, pn, sb, ic);
        const int col = pn * 256 + wc * 64 + fq * 4;
#pragma unroll
        for (int m = 0; m < 8; ++m) {
            const int s = slot_of(sb, ic, wr * 128 + m * 16 + fr);
            if (s < 0) continue;
            const float g = GATEV[s];
            T* op = OUT + (size_t)s * D + col;
#pragma unroll
            for (int n = 0; n < 4; ++n) *(uint2*)(op + n * 16) = pk4(acc[m][n][0] * g, acc[m][n][1] * g, acc[m][n][2] * g, acc[m][n][3] * g);
        }
    }
};

namespace pg8 {
#define PG8_LAS __attribute__((address_space(3)))
constexpr int BM = 256, BK = 64, HALF = 128, HTB = HALF * BK * 2, STAGE_BYTES = 8 * HTB;
__host__ __device__ __forceinline__ int lds_byte(int r, int c) { const int st = (r >> 4) * 2 + (c >> 5), rr = r & 15, cc = c & 31, ob = rr * 64 + cc * 2; return st * 1024 + (ob ^ (((ob >> 9) & 1) << 5)); }
__host__ __device__ __forceinline__ void stage_rc(int b, int& R, int& C) { const int st = b / 1024, sb = b % 1024, swz = sb ^ (((sb >> 9) & 1) << 5); R = (st >> 1) * 16 + swz / 64; C = (st & 1) * 32 + (swz % 64) / 2; }
__host__ __device__ __forceinline__ int perm32(int rho) { const int n = rho >> 4, i = rho & 15; return 8 * (i >> 2) + 4 * n + (i & 3); }
struct Unit { int pm, pn; const char* a; const char* b; int x0, x1; };
template <class Epi, class Sched, bool ALIGN_EPI = false, bool SP2 = false>
__device__ __forceinline__ void gemm_phase(PG8_LAS unsigned char* lds, const int K, const Sched& S, const Epi& E) {
    const int tid = otid(), wid = __builtin_amdgcn_readfirstlane(tid >> 6), lane = tid & 63, wr = wid >> 2, wc = wid & 3, fr = lane & 15, fq = lane >> 4;
    const int nt = K / BK;
    unsigned voffA[2], voffB[2];
#pragma unroll
    for (int i = 0; i < 2; ++i) { int R, C; stage_rc(tid * 16 + i * 8192, R, C); const int Rb = Epi::PERM ? ((R & ~31) + perm32(R & 31)) : R;
        voffA[i] = (unsigned)(R * K + C) * 2u; voffB[i] = (unsigned)(Rb * K + C) * 2u; }
    const size_t kstep = (size_t)(BK * 2);
    const size_t hstep = (size_t)HALF * K * 2;
    const unsigned ldsw = (unsigned)wid * 1024u;
    const int aoff = lds_byte(wr * 64 + fr, fq * 8), boff = lds_byte(wc * 32 + fr, fq * 8);
#define PG8_SA(b, h) (((b) * 2 + (h)) * HTB)
#define PG8_SB(b, h) ((4 + (b) * 2 + (h)) * HTB)
#define PG8_STAGE(bufoff, gbase, voff) do { _Pragma("unroll") for (int _i = 0; _i < 2; ++_i) \
        __builtin_amdgcn_global_load_lds((const unsigned*)((const char*)(gbase) + (voff)[_i]), (PG8_LAS unsigned*)(lds + (bufoff) + ldsw + _i * 8192), 16, 0, 0); } while (0)
#define PG8_LDA(dst, b, h) do { _Pragma("unroll") for (int m = 0; m < 4; ++m) _Pragma("unroll") for (int k = 0; k < 2; ++k) dst[m][k] = *(const PG8_LAS bf16x8*)(lds + PG8_SA(b, h) + aoff + m * 2048 + k * 1024); } while (0)
#define PG8_LDB(dst, b, h) do { _Pragma("unroll") for (int n = 0; n < 2; ++n) _Pragma("unroll") for (int k = 0; k < 2; ++k) dst[n][k] = *(const PG8_LAS bf16x8*)(lds + PG8_SB(b, h) + boff + n * 2048 + k * 1024); } while (0)
#define PG8_MMA(ai, bj, At, Bt) do { __builtin_amdgcn_s_setprio(1); _Pragma("unroll") for (int m = 0; m < 4; ++m) _Pragma("unroll") for (int n = 0; n < 2; ++n) _Pragma("unroll") for (int k = 0; k < 2; ++k) \
        acc[ai][bj][m][n] = __builtin_amdgcn_mfma_f32_16x16x32_bf16(Bt[n][k], At[m][k], acc[ai][bj][m][n], 0, 0, 0); __builtin_amdgcn_s_setprio(0); } while (0)
#define PG8_WAIT_V(n) asm volatile("s_waitcnt vmcnt(" #n ")" ::: "memory")
#define PG8_WAIT_L(n) asm volatile("s_waitcnt lgkmcnt(" #n ")" ::: "memory")
#define PG8_BAR __builtin_amdgcn_s_barrier()
#define PG8_SCHED __builtin_amdgcn_sched_barrier(0)
    Unit cur, nxt; int ui = 0;
    if (!S.next(0, cur)) return;
    f32x4 acc[2][2][4][2];
#pragma unroll
    for (int a = 0; a < 2; ++a)
#pragma unroll
        for (int b = 0; b < 2; ++b)
#pragma unroll
            for (int m = 0; m < 4; ++m)
#pragma unroll
                for (int n = 0; n < 2; ++n) acc[a][b][m][n] = (f32x4){0.f, 0.f, 0.f, 0.f};
    bf16x8 At[4][2], B0[2][2], B1[2][2];
    const char* cA = cur.a; const char* cB = cur.b;
    S.a_ready(cur);
    if constexpr (SP2) {
        PG8_STAGE(PG8_SB(0, 0), cB, voffB); PG8_STAGE(PG8_SB(0, 1), cB + hstep, voffB); PG8_STAGE(PG8_SA(0, 0), cA, voffA); PG8_STAGE(PG8_SA(0, 1), cA + hstep, voffA);
        if (wr == 1) PG8_BAR;
        PG8_WAIT_V(2); PG8_BAR;
        PG8_STAGE(PG8_SB(1, 0), cB + kstep, voffB); PG8_STAGE(PG8_SA(1, 0), cA + kstep, voffA); PG8_STAGE(PG8_SB(1, 1), cB + hstep + kstep, voffB);
        PG8_WAIT_V(6); PG8_BAR;
    } else {
        PG8_STAGE(PG8_SB(0, 0), cB, voffB); PG8_STAGE(PG8_SA(0, 0), cA, voffA); PG8_STAGE(PG8_SB(0, 1), cB + hstep, voffB); PG8_STAGE(PG8_SA(0, 1), cA + hstep, voffA);
        if (wr == 1) PG8_BAR;
        PG8_WAIT_V(4); PG8_BAR;
        PG8_STAGE(PG8_SB(1, 0), cB + kstep, voffB); PG8_STAGE(PG8_SA(1, 0), cA + kstep, voffA); PG8_STAGE(PG8_SB(1, 1), cB + hstep + kstep, voffB);
        PG8_WAIT_V(6); PG8_BAR;
    }
    for (;;) {
        const bool has_next = S.next(ui + 1, nxt);
        const char* nA = has_next ? nxt.a : cA; const char* nB = has_next ? nxt.b : cB;
        for (int t = 0; t < nt; t += 2) {
            const bool last = (t == nt - 2);
            const char* a1 = cA + (size_t)(t + 1) * kstep;
            const char* a2 = last ? nA : cA + (size_t)(t + 2) * kstep; const char* b2 = last ? nB : cB + (size_t)(t + 2) * kstep;
            const char* a3 = a2 + kstep; const char* b3 = b2 + kstep;
            if (last && has_next) S.a_ready(nxt);
            if constexpr (SP2) {
            PG8_LDB(B0, 0, 0); PG8_LDB(B1, 0, 1); PG8_SCHED; PG8_LDA(At, 0, 0); PG8_STAGE(PG8_SA(1, 1), a1 + hstep, voffA);
            PG8_WAIT_V(8); PG8_WAIT_L(0); PG8_BAR; PG8_MMA(0, 0, At, B0); PG8_MMA(0, 1, At, B1); PG8_BAR; PG8_SCHED;
            PG8_LDA(At, 0, 1); PG8_STAGE(PG8_SB(0, 0), b2, voffB); PG8_STAGE(PG8_SB(0, 1), b2 + hstep, voffB); PG8_STAGE(PG8_SA(0, 0), a2, voffA);
            PG8_WAIT_V(8); PG8_WAIT_L(0); PG8_BAR; PG8_MMA(1, 0, At, B0); PG8_MMA(1, 1, At, B1); PG8_BAR; PG8_SCHED;
            PG8_LDB(B0, 1, 0); PG8_LDB(B1, 1, 1); PG8_SCHED; PG8_LDA(At, 1, 0); PG8_STAGE(PG8_SA(0, 1), a2 + hstep, voffA);
            PG8_WAIT_V(8); PG8_WAIT_L(0); PG8_BAR; PG8_MMA(0, 0, At, B0); PG8_MMA(0, 1, At, B1); PG8_BAR; PG8_SCHED;
            PG8_LDA(At, 1, 1); PG8_STAGE(PG8_SB(1, 0), b3, voffB); PG8_STAGE(PG8_SB(1, 1), b3 + hstep, voffB); PG8_STAGE(PG8_SA(1, 0), a3, voffA);
            PG8_WAIT_V(8); PG8_WAIT_L(0); PG8_BAR; PG8_MMA(1, 0, At, B0); PG8_MMA(1, 1, At, B1); PG8_BAR; PG8_SCHED;
            } else {
            PG8_LDB(B0, 0, 0); PG8_SCHED; PG8_LDA(At, 0, 0); PG8_STAGE(PG8_SA(1, 1), a1 + hstep, voffA);
            PG8_WAIT_L(8); PG8_BAR; PG8_WAIT_L(0); PG8_MMA(0, 0, At, B0); PG8_BAR; PG8_SCHED;
            PG8_LDB(B1, 0, 1); PG8_STAGE(PG8_SB(0, 0), b2, voffB);
            PG8_BAR; PG8_WAIT_L(0); PG8_MMA(0, 1, At, B1); PG8_BAR;
            PG8_LDA(At, 0, 1); PG8_STAGE(PG8_SA(0, 0), a2, voffA);
            PG8_BAR; PG8_WAIT_L(0); PG8_MMA(1, 0, At, B0); PG8_BAR; PG8_SCHED;
            PG8_STAGE(PG8_SB(0, 1), b2 + hstep, voffB);
            PG8_WAIT_V(6); PG8_BAR; PG8_MMA(1, 1, At, B1); PG8_BAR;
            PG8_LDB(B0, 1, 0); PG8_SCHED; PG8_LDA(At, 1, 0); PG8_STAGE(PG8_SA(0, 1), a2 + hstep, voffA);
            PG8_WAIT_L(8); PG8_BAR; PG8_WAIT_L(0); PG8_MMA(0, 0, At, B0); PG8_BAR; PG8_SCHED;
            PG8_LDB(B1, 1, 1); PG8_STAGE(PG8_SB(1, 0), b3, voffB);
            PG8_BAR; PG8_WAIT_L(0); PG8_MMA(0, 1, At, B1); PG8_BAR;
            PG8_LDA(At, 1, 1); PG8_STAGE(PG8_SA(1, 0), a3, voffA);
            PG8_BAR; PG8_WAIT_L(0); PG8_MMA(1, 0, At, B0); PG8_BAR; PG8_SCHED;
            PG8_STAGE(PG8_SB(1, 1), b3 + hstep, voffB);
            PG8_WAIT_V(6); PG8_BAR; PG8_MMA(1, 1, At, B1); PG8_BAR;
            }
        }
        if constexpr (ALIGN_EPI) { if (wr == 0) PG8_BAR; }
        if constexpr (!Epi::AFTER_DRAIN) { E(acc, cur, wr, wc, fr, fq); S.done(cur); }
        if (!has_next) break;
#pragma unroll
        for (int a = 0; a < 2; ++a)
#pragma unroll
            for (int b = 0; b < 2; ++b)
#pragma unroll
                for (int m = 0; m < 4; ++m)
#pragma unroll
                    for (int n = 0; n < 2; ++n) acc[a][b][m][n] = (f32x4){0.f, 0.f, 0.f, 0.f};
        cur = nxt; cA = nA; cB = nB; ++ui;
        if constexpr (ALIGN_EPI) { if (wr == 1) PG8_BAR; }
    }
    PG8_WAIT_V(0);
    if constexpr (!ALIGN_EPI) { if (wr == 0) PG8_BAR; }
    PG8_BAR;
    if constexpr (Epi::AFTER_DRAIN) { E.fused(acc, cur, wr, wc, fr, fq, lds, wid, lane); S.done(cur); }
#undef PG8_SA
#undef PG8_SB
#undef PG8_STAGE
#undef PG8_LDA
#undef PG8_LDB
#undef PG8_MMA
#undef PG8_WAIT_V
#undef PG8_WAIT_L
#undef PG8_BAR
#undef PG8_SCHED
}
}

struct SchedBase { __device__ __forceinline__ void a_ready(const pg8::Unit&) const {} __device__ __forceinline__ void done(const pg8::Unit&) const {} };
#define ACC8(mm, nn) acc[(mm) >> 2][(nn) >> 1][(mm) & 3][(nn) & 1]
#define ROW8(mm) (((mm) >> 2) * 128 + wr * 64 + ((mm) & 3) * 16 + fr)

struct InProj8S : SchedBase { const T* H; const T* Wt; int npm, bid, nblk, nun;
    __device__ __forceinline__ bool next(int i, pg8::Unit& u) const { const int x0 = bid + i * nblk; if (x0 >= nun) return false; const int x = xswz(x0, nun);
        if (x < 3200 || nun == 3300) { u.pm = x / 25; u.pn = x % 25; } else { const int y = x - 3200; u.pm = 128 + y / 9; u.pn = y % 9; }
        u.a = (const char*)(H + (size_t)u.pm * 256 * D); u.b = (const char*)(Wt + (size_t)u.pn * 256 * D); return true; } };
struct InProj8E {
    static constexpr bool PERM = false, AFTER_DRAIN = false;
    T* Z; float* SS; const float* gqn; const float* gkn; const float2* tab64; const float2* tab32;
    __device__ __forceinline__ void operator()(const f32x4 (&acc)[2][2][4][2], const pg8::Unit& u, int wr, int wc, int fr, int fq) const {
        const int pm = u.pm, cg = u.pn * 4 + wc;
        if (cg == 34 || cg == 35) return;
        const bool lat = pm * 256 < NLAT;
        const int zcol = (cg < 36 ? cg * 64 : 2144 + (cg - 36) * 64) + fq * 4;
        const bool t_rms = (cg >= 12 && cg < 18), t_rope = t_rms || (cg >= 20 && cg < 26), t_ssq = (cg >= 28 && cg < 33), t_kr = cg == 33, t_sig = cg >= 36;
        float4 gv[4];
        if (t_rms) { const float* g = cg < 16 ? gqn : gkn;
#pragma unroll
            for (int n = 0; n < 4; ++n) gv[n] = *(const float4*)(g + n * 16 + fq * 4); }
#pragma unroll
        for (int m = 0; m < 8; ++m) {
            const int row = pm * 256 + ROW8(m);
            const int t = row & (SEQ - 1), gr = t >> 6, gc = t & 63;
            float v[4][4];
#pragma unroll
            for (int n = 0; n < 4; ++n)
#pragma unroll
                for (int j = 0; j < 4; ++j) v[n][j] = ACC8(m, n)[j];
            T* zp = Z + (size_t)row * ZW + zcol;
            if (t_rms || t_ssq) {
                float ss = 0.f;
#pragma unroll
                for (int n = 0; n < 4; ++n)
#pragma unroll
                    for (int j = 0; j < 4; ++j) ss += v[n][j] * v[n][j];
                ss += __shfl_xor(ss, 16); ss += __shfl_xor(ss, 32);
                if (t_ssq) { if (fq == 0) SS[(size_t)row * 8 + (cg - 28)] = ss; }
                else { const float rstd = 1.f / sqrtf(ss * (1.f / 64.f) + EPS);
#pragma unroll
                    for (int n = 0; n < 4; ++n) { v[n][0] *= rstd * gv[n].x; v[n][1] *= rstd * gv[n].y; v[n][2] *= rstd * gv[n].z; v[n][3] *= rstd * gv[n].w; } }
            }
            if (t_rope && lat) {
                const float4* tr = (const float4*)(tab64 + gr * 16 + fq * 4); const float4* tc = (const float4*)(tab64 + gc * 16 + fq * 4);
                const float4 r0 = tr[0], r1 = tr[1], c0 = tc[0], c1 = tc[1];
                const float rc[4] = {r0.x, r0.z, r1.x, r1.z}, rs[4] = {r0.y, r0.w, r1.y, r1.w}, cc[4] = {c0.x, c0.z, c1.x, c1.z}, cs[4] = {c0.y, c0.w, c1.y, c1.w};
#pragma unroll
                for (int j = 0; j < 4; ++j) {
                    const float a0 = v[0][j], a1 = v[1][j], b0 = v[2][j], b1 = v[3][j];
                    v[0][j] = a0 * rc[j] - a1 * rs[j]; v[1][j] = a0 * rs[j] + a1 * rc[j];
                    v[2][j] = b0 * cc[j] - b1 * cs[j]; v[3][j] = b0 * cs[j] + b1 * cc[j];
                }
            }
            if (t_kr) {
#pragma unroll
                for (int n = 0; n < 2; ++n) {
                    const float4* tp = (const float4*)(tab32 + (n == 0 ? gr : gc) * 8 + (fq & 1) * 4);
                    const float4 q0 = tp[0], q1 = tp[1];
                    const float kc[4] = {q0.x, q0.z, q1.x, q1.z}, ks[4] = {q0.y, q0.w, q1.y, q1.w};
#pragma unroll
                    for (int j = 0; j < 4; ++j) { const float x = v[n][j], px = __shfl_xor(x, 32); if (lat) v[n][j] = (fq < 2) ? (x * kc[j] - px * ks[j]) : (px * ks[j] + x * kc[j]); }
                    *(uint2*)(zp + n * 16) = pk4(v[n][0], v[n][1], v[n][2], v[n][3]);
                }
                continue;
            }
            if (t_sig) {
#pragma unroll
                for (int n = 0; n < 4; ++n)
#pragma unroll
                    for (int j = 0; j < 4; ++j) v[n][j] = fast_sigmoid(v[n][j]);
            }
#pragma unroll
            for (int n = 0; n < 4; ++n) *(uint2*)(zp + n * 16) = pk4(v[n][0], v[n][1], v[n][2], v[n][3]);
        }
    }
};

struct FfnUp8S : SchedBase { const T* XG; const T* WguT; int nun, bid, nblk;
    __device__ __forceinline__ bool next(int i, pg8::Unit& u) const { const int x0 = bid + i * nblk; if (x0 >= nun) return false; const int x = xswz(x0, nun); int e, sb;
        if (x < 2048) { e = x >> 7; const int rem = x & 127; u.pn = rem & 7; sb = ((rem >> 5) * NE + e) * CAP + ((rem >> 3) & 3) * 256; u.x1 = 256; }
        else { const int uc = x - 2048; e = uc >> 3; u.pn = uc & 7; sb = CTXB + e * (NB * CAPC); u.x1 = NB * CAPC; }
        u.pm = 0; u.x0 = sb; u.a = (const char*)(XG + (size_t)sb * D); u.b = (const char*)(WguT + ((size_t)e * 2048 + u.pn * 256) * D); return true; } };
struct FfnUp8E {
    static constexpr bool PERM = false, AFTER_DRAIN = false;
    T* ACT;
    __device__ __forceinline__ void operator()(const f32x4 (&acc)[2][2][4][2], const pg8::Unit& u, int wr, int wc, int fr, int fq) const {
        const int col = (u.pn * 4 + wc) * 32 + fq * 4;
#pragma unroll
        for (int m = 0; m < 8; ++m) {
            const int R = ROW8(m);
            if (R >= u.x1) continue;
            T* op = ACT + (size_t)(u.x0 + R) * FF + col;
#pragma unroll
            for (int n = 0; n < 2; ++n) { const f32x4 g = ACC8(m, n), w = ACC8(m, n + 2);
                *(uint2*)(op + n * 16) = pk4(fast_silu(g[0]) * w[0], fast_silu(g[1]) * w[1], fast_silu(g[2]) * w[2], fast_silu(g[3]) * w[3]); }
        }
    }
};
struct FfnDown8S : SchedBase { const T* ACT; const T* WdT; int nun, bid, nblk;
    __device__ __forceinline__ bool next(int i, pg8::Unit& u) const { const int x0 = bid + i * nblk; if (x0 >= nun) return false; const int x = xswz(x0, nun); int e, sb;
        if (x < 1024) { e = x >> 6; const int rem = x & 63; u.pn = rem & 3; sb = ((rem >> 4) * NE + e) * CAP + ((rem >> 2) & 3) * 256; u.x1 = 256; }
        else { const int uc = x - 1024; e = uc >> 2; u.pn = uc & 3; sb = CTXB + e * (NB * CAPC); u.x1 = NB * CAPC; }
        u.pm = 0; u.x0 = sb; u.a = (const char*)(ACT + (size_t)sb * FF); u.b = (const char*)(WdT + ((size_t)e * 1024 + u.pn * 256) * FF); return true; } };
struct FfnDown8E {
    static constexpr bool PERM = false, AFTER_DRAIN = false;
    const float* GATEV; T* OUT;
    __device__ __forceinline__ void operator()(const f32x4 (&acc)[2][2][4][2], const pg8::Unit& u, int wr, int wc, int fr, int fq) const {
        const int col = u.pn * 256 + wc * 64 + fq * 4;
#pragma unroll
        for (int m = 0; m < 8; ++m) {
            const int R = ROW8(m);
            if (R >= u.x1) continue;
            const int s = u.x0 + R; const float g = GATEV[s];
            T* op = OUT + (size_t)s * D + col;
#pragma unroll
            for (int n = 0; n < 4; ++n) { const f32x4 a = ACC8(m, n); *(uint2*)(op + n * 16) = pk4(a[0] * g, a[1] * g, a[2] * g, a[3] * g); }
        }
    }
};
struct Plain8S : SchedBase { const T* A; const T* Bt; int npm, npn, K, bid, nblk;
    __device__ __forceinline__ bool next(int i, pg8::Unit& u) const { const int x0 = bid + i * nblk; if (x0 >= npm * npn) return false; const int x = xswz(x0, npm * npn); u.pm = x / npn; u.pn = x % npn;
        u.a = (const char*)(A + (size_t)u.pm * 256 * K); u.b = (const char*)(Bt + (size_t)u.pn * 256 * K); return true; } };
struct Plain8E {
    static constexpr bool PERM = false, AFTER_DRAIN = false;
    T* C; int ldc;
    __device__ __forceinline__ void operator()(const f32x4 (&acc)[2][2][4][2], const pg8::Unit& u, int wr, int wc, int fr, int fq) const {
        const int col = u.pn * 256 + wc * 64 + fq * 4;
#pragma unroll
        for (int m = 0; m < 8; ++m) {
            T* op = C + (size_t)(u.pm * 256 + ROW8(m)) * ldc + col;
#pragma unroll
            for (int n = 0; n < 4; ++n) { const f32x4 a = ACC8(m, n); *(uint2*)(op + n * 16) = pk4(a[0], a[1], a[2], a[3]); }
        }
    }
};
__device__ __forceinline__ void ph_gather(const T* H2, const int* IDX, T* XG, int nslot, int bid, int nblk) {
    const int tid_ = otid(); const int lane = tid_ & 63, wid = tid_ >> 6;
    for (int s0 = (bid * 8 + wid) * 2; s0 < nslot; s0 += nblk * 16) {
        const int i0 = IDX[s0], i1 = IDX[s0 + 1];
        const uint4 a0 = *(const uint4*)(H2 + (size_t)i0 * D + lane * 8), a1 = *(const uint4*)(H2 + (size_t)i0 * D + 512 + lane * 8);
        const uint4 b0 = *(const uint4*)(H2 + (size_t)i1 * D + lane * 8), b1 = *(const uint4*)(H2 + (size_t)i1 * D + 512 + lane * 8);
        *(uint4*)(XG + (size_t)s0 * D + lane * 8) = a0; *(uint4*)(XG + (size_t)s0 * D + 512 + lane * 8) = a1;
        *(uint4*)(XG + (size_t)(s0 + 1) * D + lane * 8) = b0; *(uint4*)(XG + (size_t)(s0 + 1) * D + 512 + lane * 8) = b1;
    }
}

typedef float f32x16 __attribute__((ext_vector_type(16)));
typedef short s16x4 __attribute__((ext_vector_type(4)));
typedef short v4i16_t __attribute__((ext_vector_type(4)));
struct AttnP { const T* Z; const T* QM; const T* KVM; T* O; const float* rpb; const float* sink; int nlat; int need_ctx; float* o32; int fake; };
constexpr int ATT_LDS = 156672 + 2048;
__device__ __forceinline__ int crow(int r, int hi) { return (r & 3) + 8 * (r >> 2) + 4 * hi; }
__device__ __forceinline__ float xhalf_max(float v) { auto rr = __builtin_amdgcn_permlane32_swap(__float_as_uint(v), __float_as_uint(v), false, false); return fmaxf(__uint_as_float(rr[0]), __uint_as_float(rr[1])); }
__device__ __forceinline__ float xhalf_sum(float v) { auto rr = __builtin_amdgcn_permlane32_swap(__float_as_uint(v), __float_as_uint(v), false, false); return __uint_as_float(rr[0]) + __uint_as_float(rr[1]); }
__device__ __forceinline__ unsigned cvtpk(float lo, float hi) { typedef float f2 __attribute__((ext_vector_type(2))); typedef __bf16 b2 __attribute__((ext_vector_type(2))); f2 v = {lo, hi}; b2 b = __builtin_convertvector(v, b2); return __builtin_bit_cast(unsigned, b); }

__device__ __forceinline__ float max3f(float a, float b, float c) { float r; asm("v_max3_f32 %0, %1, %2, %3" : "=v"(r) : "v"(a), "v"(b), "v"(c)); return r; }
template <int BR>
__device__ __forceinline__ void attn_unit_l(ldsp lds, const AttnP& P, int b, int hx, int q0, bool ctxq) {
    constexpr int DQK = (BR == 3) ? 96 : 64, NKS = DQK / 16, KB = (BR == 3) ? 9216 + 4096 : 9216, SLOT = KB + 8192;
    constexpr int R = (BR == 3) ? 5 : 6, PF = R - 1;
    constexpr int BT0 = 107520, QF0 = BT0 + 2048;
    static_assert(R * SLOT <= BT0, "ring");
    constexpr bool PACK2 = (BR == 1 || BR == 2);
    constexpr float SCALE = (BR == 3) ? 0.10206207261596575f : 0.125f;
    constexpr float CL2 = SCALE * 1.4426950408889634f;
    constexpr float NEG = -1e30f, THR = 8.f;
    const int tid = otid(), lane = tid & 63, wid = __builtin_amdgcn_readfirstlane(tid >> 6), r32 = lane & 31, hi = lane >> 5;
    const int tokq = q0 + (PACK2 ? (wid & 3) : wid) * 32 + r32;
    const int head = PACK2 ? hx * 2 + (wid >> 2) : hx;
    const size_t lat0 = (size_t)b * SEQ, ctx0 = (size_t)P.nlat + (size_t)b * CTX;
    const size_t qrow = ctxq ? ctx0 + tokq : lat0 + tokq;
    const ldsp qlds = lds + QF0 + wid * 6144 + lane * 16;
    { const T* qp = (BR == 3) ? P.QM + qrow * 384 + head * 96 + hi * 8 : P.Z + qrow * ZW + (BR == 0 ? NAQ : BR == 1 ? GQ : SQ) + head * 64 + hi * 8;
#pragma unroll
      for (int ks = 0; ks < NKS; ++ks) {
          const uint4 raw = *(const uint4*)(qp + ks * 16);
          typedef unsigned u4 __attribute__((ext_vector_type(4)));
          const u4 w = {cvtpk(__uint_as_float(raw.x << 16) * CL2, __uint_as_float(raw.x & 0xffff0000u) * CL2), cvtpk(__uint_as_float(raw.y << 16) * CL2, __uint_as_float(raw.y & 0xffff0000u) * CL2),
                        cvtpk(__uint_as_float(raw.z << 16) * CL2, __uint_as_float(raw.z & 0xffff0000u) * CL2), cvtpk(__uint_as_float(raw.w << 16) * CL2, __uint_as_float(raw.w & 0xffff0000u) * CL2)};
          *(LAS u4*)(qlds + ks * 1024) = w; } }
    int klo = 0, nlt = 0;
    if (!ctxq) {
        if (BR == 0) { const int r0 = q0 >> 6; const int lo = min(max(r0 - 4, 0), GROWS - 8), hi2 = min(max(r0 - 1, 0), GROWS - 8) + 8; klo = lo * 64; nlt = hi2 - lo; }
        else if (BR == 2) { klo = max(q0 - 128, 0); nlt = (min(q0 + 256, SEQ) - klo) >> 6; }
        else { klo = 0; nlt = SEQ / 64; }
    }
    const int nt = 4 + nlt;
    const T* ksrc; const T* vsrc; const T* rsrc = nullptr; size_t kpitch;
    { const int kk = 8 * wid + (lane >> 3), kch = ((lane & 7) ^ (lane >> 3)) * 8, vch = ((((lane >> 2) ^ (lane >> 4)) & 1) * 32) + (lane & 3) * 8;
      if (BR == 3) { ksrc = P.KVM + (size_t)kk * 512 + hx * 128 + kch; vsrc = P.KVM + (size_t)kk * 512 + hx * 128 + 64 + vch; kpitch = 512;
                     rsrc = P.Z + (size_t)(16 * (wid & 3) + (lane >> 2)) * ZW + MKR + (((lane & 3) ^ ((lane >> 4) & 3)) * 8); }
      else { const int ko = (BR == 0 ? NAK : BR == 1 ? GK : SK) + hx * 64, vo = (BR == 0 ? NAV : BR == 1 ? GV : SV) + hx * 64;
             ksrc = P.Z + (size_t)kk * ZW + ko + kch; vsrc = P.Z + (size_t)kk * ZW + vo + vch; kpitch = ZW; } }
#define A_TROW(t) ((t) < 4 ? ctx0 + (size_t)(t) * 64 : lat0 + (size_t)klo + (size_t)((t) - 4) * 64)
#define A_DMA(t, slot) do { const size_t tr_ = A_TROW(t); const ldsp sb_ = lds + (slot) * SLOT; \
        GLDS16(ksrc + tr_ * kpitch, sb_ + wid * 1152); GLDS16(vsrc + tr_ * kpitch, sb_ + KB + wid * 1024); \
        if (BR == 3) { if (wid < 4) GLDS16(rsrc + tr_ * ZW, sb_ + 9216 + wid * 1024); } } while (0)
#define A_WAITBAR(n) do { if (BR == 3 && wid < 4) asm volatile("s_waitcnt vmcnt(%0) lgkmcnt(0)\n\ts_barrier" :: "n"(3 * (n)) : "memory"); \
                          else asm volatile("s_waitcnt vmcnt(%0) lgkmcnt(0)\n\ts_barrier" :: "n"(2 * (n)) : "memory"); } while (0)
    LAS float* btab = (LAS float*)(lds + BT0);
    if (BR == 0) { if (tid < 465) btab[tid] = P.rpb[hx * 465 + tid] * 1.4426950408889634f; }
    const int qr = (q0 >> 6) + (wid >> 1), qc = (wid & 1) * 32 + r32;
    const int krow0 = min(max(qr - 4, 0), GROWS - 8), kcol0 = min(max(qc - 8, 0), GW - 16);
    float mref = 0.f, lsum = 0.f;
    f32x16 o0, o1, negm;
#pragma unroll
    for (int r = 0; r < 16; ++r) { o0[r] = 0.f; o1[r] = 0.f; negm[r] = 0.f; }
    const unsigned kfo = (r32 >> 3) * 1152 + (r32 & 7) * 128 + ((hi ^ (r32 & 7)) * 16);
    const unsigned rfo = 9216 + r32 * 64 + ((hi ^ ((r32 >> 2) & 3)) * 16);
    const unsigned vfo = KB + (4 * hi + ((lane & 15) >> 2)) * 128 + ((lane >> 3) & 1) * 64 + ((lane >> 4) & 1) * 32 + (lane & 3) * 8;
#define A_ACTIVE(t) (!(BR == 0 && (t) >= 4) || (((klo >> 6) + ((t) - 4)) >= krow0 && ((klo >> 6) + ((t) - 4)) < krow0 + 8))
#define A_QK(p0, p1, slot) do { const ldsp kb_ = lds + (slot) * SLOT; bf16x8 kaf[NKS], kbf[NKS], qkf[NKS]; \
        _Pragma("unroll") for (int ks = 0; ks < NKS; ++ks) { \
            if (ks < 4) { const ldsp a_ = kb_ + (kfo ^ (unsigned)(ks * 32)); kaf[ks] = *(const LAS bf16x8*)(a_); kbf[ks] = *(const LAS bf16x8*)(a_ + 4608); } \
            else { const ldsp a_ = kb_ + (rfo ^ (unsigned)((ks - 4) * 32)); kaf[ks] = *(const LAS bf16x8*)(a_); kbf[ks] = *(const LAS bf16x8*)(a_ + 2048); } \
            qkf[ks] = *(const LAS bf16x8*)(qlds + ks * 1024); } \
        p0 = __builtin_amdgcn_mfma_f32_32x32x16_bf16(kaf[0], qkf[0], negm, 0, 0, 0); p1 = __builtin_amdgcn_mfma_f32_32x32x16_bf16(kbf[0], qkf[0], negm, 0, 0, 0); \
        _Pragma("unroll") for (int ks = 1; ks < NKS; ++ks) { \
          p0 = __builtin_amdgcn_mfma_f32_32x32x16_bf16(kaf[ks], qkf[ks], p0, 0, 0, 0); p1 = __builtin_amdgcn_mfma_f32_32x32x16_bf16(kbf[ks], qkf[ks], p1, 0, 0, 0); } } while (0)
    asm volatile("s_waitcnt lgkmcnt(0)" ::: "memory");
#pragma unroll
    for (int j = 0; j < PF; ++j) { if (j < nt) A_DMA(j, j); }
    if (nt >= PF) A_WAITBAR(PF - 2); else A_WAITBAR(0);
    f32x16 sA0, sA1, sB0, sB1;
    A_QK(sA0, sA1, 0);
    bool act_cur = true;
    int sl = 0;
#define A_STEP(t, pc0, pc1, pn0, pn1) do { \
        const int s1 = (sl + 1 == R) ? 0 : sl + 1, sm = (sl == 0) ? R - 1 : sl - 1; \
        if ((t) + PF < nt) A_DMA((t) + PF, sm);                   \
        const bool act_next = ((t) + 1 < nt) && A_ACTIVE((t) + 1); \
        if (act_next) A_QK(pn0, pn1, s1); \
        if (act_cur) { \
            if (BR == 0) { if ((t) >= 4) { const int dr = (klo >> 6) + ((t) - 4) - qr + 7; \
                    _Pragma("unroll") for (int r = 0; r < 16; ++r) { const int kc0 = crow(r, hi), kc1 = 32 + kc0; \
                        const bool v0 = (unsigned)(kc0 - kcol0) < 16u, v1 = (unsigned)(kc1 - kcol0) < 16u; \
                        const float b0 = btab[dr * 31 + min(max(kc0 - qc + 15, 0), 30)], b1 = btab[dr * 31 + min(max(kc1 - qc + 15, 0), 30)]; \
                        pc0[r] = v0 ? pc0[r] + b0 : NEG; pc1[r] = v1 ? pc1[r] + b1 : NEG; } } } \
            if (BR == 2) { if ((t) >= 4) { const int kb0 = klo + ((t) - 4) * 64 - tokq + 128; \
                    _Pragma("unroll") for (int r = 0; r < 16; ++r) { const int d0 = kb0 + crow(r, hi); \
                        if ((unsigned)d0 > 256u) pc0[r] = NEG; if ((unsigned)(d0 + 32) > 256u) pc1[r] = NEG; } } } \
            float rm; \
            { const float a0 = max3f(pc0[0], pc0[1], pc0[2]), a1 = max3f(pc0[3], pc0[4], pc0[5]), a2 = max3f(pc0[6], pc0[7], pc0[8]), a3 = max3f(pc0[9], pc0[10], pc0[11]), \
                          a4 = max3f(pc0[12], pc0[13], pc0[14]), a5 = max3f(pc0[15], pc1[0], pc1[1]), a6 = max3f(pc1[2], pc1[3], pc1[4]), a7 = max3f(pc1[5], pc1[6], pc1[7]), \
                          a8 = max3f(pc1[8], pc1[9], pc1[10]), a9 = max3f(pc1[11], pc1[12], pc1[13]), a10 = fmaxf(pc1[14], pc1[15]); \
              const float b0 = max3f(a0, a1, a2), b1 = max3f(a3, a4, a5), b2 = max3f(a6, a7, a8), b3 = fmaxf(a9, a10); \
              rm = xhalf_max(fmaxf(fmaxf(b0, b1), fmaxf(b2, b3))); } \
            if ((t) == 0 || __any(rm > THR)) { \
                const float dl = ((t) == 0) ? rm : fmaxf(rm, 0.f); const float f = __builtin_amdgcn_exp2f(-dl); \
                mref += dl; lsum *= f; \
                _Pragma("unroll") for (int r = 0; r < 16; ++r) { pc0[r] -= dl; pc1[r] -= dl; negm[r] -= dl; o0[r] *= f; o1[r] *= f; } \
                if (act_next) { _Pragma("unroll") for (int r = 0; r < 16; ++r) { pn0[r] -= dl; pn1[r] -= dl; } } } \
            _Pragma("unroll") for (int r = 0; r < 16; ++r) { pc0[r] = __builtin_amdgcn_exp2f(pc0[r]); pc1[r] = __builtin_amdgcn_exp2f(pc1[r]); } \
            { float s8[8]; _Pragma("unroll") for (int r = 0; r < 8; ++r) s8[r] = (pc0[r] + pc0[r + 8]) + (pc1[r] + pc1[r + 8]); \
              lsum += ((s8[0] + s8[1]) + (s8[2] + s8[3])) + ((s8[4] + s8[5]) + (s8[6] + s8[7])); } \
            const ldsp vb = lds + sl * SLOT + vfo, vb1 = lds + sl * SLOT + (vfo ^ 64u); \
            bf16x8 pf[4]; \
            _Pragma("unroll") for (int s = 0; s < 4; ++s) { const int rb = (s & 1) * 8; typedef unsigned u4 __attribute__((ext_vector_type(4))); u4 ww; \
                  if (s < 2) ww = (u4){cvtpk(pc0[rb], pc0[rb + 1]), cvtpk(pc0[rb + 2], pc0[rb + 3]), cvtpk(pc0[rb + 4], pc0[rb + 5]), cvtpk(pc0[rb + 6], pc0[rb + 7])}; \
                  else       ww = (u4){cvtpk(pc1[rb], pc1[rb + 1]), cvtpk(pc1[rb + 2], pc1[rb + 3]), cvtpk(pc1[rb + 4], pc1[rb + 5]), cvtpk(pc1[rb + 6], pc1[rb + 7])}; \
                  pf[s] = __builtin_bit_cast(bf16x8, ww); } \
            s16x4 vl0[4], vh0[4], vl1[4], vh1[4]; \
            _Pragma("unroll") for (int s = 0; s < 4; ++s) { vl0[s] = __builtin_bit_cast(s16x4, __builtin_amdgcn_ds_read_tr16_b64_v4i16((LAS v4i16_t*)(vb + s * 2048))); vh0[s] = __builtin_bit_cast(s16x4, __builtin_amdgcn_ds_read_tr16_b64_v4i16((LAS v4i16_t*)(vb + s * 2048 + 1024))); } \
            _Pragma("unroll") for (int s = 0; s < 4; ++s) { vl1[s] = __builtin_bit_cast(s16x4, __builtin_amdgcn_ds_read_tr16_b64_v4i16((LAS v4i16_t*)(vb1 + s * 2048))); vh1[s] = __builtin_bit_cast(s16x4, __builtin_amdgcn_ds_read_tr16_b64_v4i16((LAS v4i16_t*)(vb1 + s * 2048 + 1024))); } \
            _Pragma("unroll") for (int s = 0; s < 4; ++s) { const bf16x8 vf = (bf16x8){vl0[s][0], vl0[s][1], vl0[s][2], vl0[s][3], vh0[s][0], vh0[s][1], vh0[s][2], vh0[s][3]}; o0 = __builtin_amdgcn_mfma_f32_32x32x16_bf16(vf, pf[s], o0, 0, 0, 0); } \
            _Pragma("unroll") for (int s = 0; s < 4; ++s) { const bf16x8 vf = (bf16x8){vl1[s][0], vl1[s][1], vl1[s][2], vl1[s][3], vh1[s][0], vh1[s][1], vh1[s][2], vh1[s][3]}; o1 = __builtin_amdgcn_mfma_f32_32x32x16_bf16(vf, pf[s], o1, 0, 0, 0); } \
        } \
          \
        if ((t) + PF < nt) A_WAITBAR(PF - 2); else A_WAITBAR(0); \
        act_cur = act_next; sl = s1; \
    } while (0)
    { int t = 0;
      for (; t + 1 < nt; t += 2) { A_STEP(t, sA0, sA1, sB0, sB1); A_STEP(t + 1, sB0, sB1, sA0, sA1); }
      if (t < nt) A_STEP(t, sA0, sA1, sB0, sB1); }
    float ltot = xhalf_sum(lsum);
    if (BR == 2) ltot += __builtin_amdgcn_exp2f(P.sink[head] * 1.4426950408889634f - mref);
    const float inv = 1.f / ltot;
#ifdef PROBE_ATTN
    if (P.o32 && b == 1 && (ctxq || tokq < 1024 || tokq >= 7168)) {
        const int sub = ctxq ? 2048 + tokq : (tokq < 1024 ? tokq : 1024 + tokq - 7168);
        float* fp = P.o32 + (size_t)sub * D + BR * 256 + head * 64 + 4 * hi;
#pragma unroll
        for (int g = 0; g < 4; ++g)
#pragma unroll
            for (int j = 0; j < 4; ++j) { fp[8 * g + j] = o0[4 * g + j] * inv; fp[32 + 8 * g + j] = o1[4 * g + j] * inv; }
    }
#endif
    T* op = P.O + qrow * D + BR * 256 + head * 64 + 4 * hi;
#pragma unroll
    for (int g = 0; g < 4; ++g) {
        *(uint2*)(op + 8 * g) = pk4(o0[4 * g] * inv, o0[4 * g + 1] * inv, o0[4 * g + 2] * inv, o0[4 * g + 3] * inv);
        *(uint2*)(op + 32 + 8 * g) = pk4(o1[4 * g] * inv, o1[4 * g + 1] * inv, o1[4 * g + 2] * inv, o1[4 * g + 3] * inv);
    }
#undef A_TROW
#undef A_DMA
#undef A_WAITBAR
#undef A_ACTIVE
#undef A_QK
#undef A_STEP
}


template <int BR>
__device__ __forceinline__ void attn_unit(ldsp lds, const AttnP& P, int b, int hx, int q0, bool ctxq) {
    constexpr int DQK = (BR == 3) ? 96 : 64, NKS = DQK / 16, KB = (BR == 3) ? 9216 + 4096 : 9216, SLOT = KB + 8192;
    constexpr int R = (BR == 3) ? 7 : 9, PF = R - 3;
    constexpr int BT0 = 156672;
    static_assert(R * SLOT <= BT0, "ring");
    constexpr bool PACK2 = (BR == 1 || BR == 2);
    constexpr float SCALE = (BR == 3) ? 0.10206207261596575f : 0.125f;
    constexpr float CL2 = SCALE * 1.4426950408889634f;
    constexpr float NEG = -1e30f, THR = 8.f;
    const int tid = otid(), lane = tid & 63, wid = __builtin_amdgcn_readfirstlane(tid >> 6), r32 = lane & 31, hi = lane >> 5;
    const int tokq = q0 + (PACK2 ? (wid & 3) : wid) * 32 + r32;
    const int head = PACK2 ? hx * 2 + (wid >> 2) : hx;
    const size_t lat0 = (size_t)b * SEQ, ctx0 = (size_t)P.nlat + (size_t)b * CTX;
    const size_t qrow = ctxq ? ctx0 + tokq : lat0 + tokq;
    bf16x8 qf[NKS];
    { const T* qp = (BR == 3) ? P.QM + qrow * 384 + head * 96 + hi * 8 : P.Z + qrow * ZW + (BR == 0 ? NAQ : BR == 1 ? GQ : SQ) + head * 64 + hi * 8;
#pragma unroll
      for (int ks = 0; ks < NKS; ++ks) {
          const uint4 raw = *(const uint4*)(qp + ks * 16);
          typedef unsigned u4 __attribute__((ext_vector_type(4)));
          const u4 w = {cvtpk(__uint_as_float(raw.x << 16) * CL2, __uint_as_float(raw.x & 0xffff0000u) * CL2), cvtpk(__uint_as_float(raw.y << 16) * CL2, __uint_as_float(raw.y & 0xffff0000u) * CL2),
                        cvtpk(__uint_as_float(raw.z << 16) * CL2, __uint_as_float(raw.z & 0xffff0000u) * CL2), cvtpk(__uint_as_float(raw.w << 16) * CL2, __uint_as_float(raw.w & 0xffff0000u) * CL2)};
          qf[ks] = __builtin_bit_cast(bf16x8, w); } }
    int klo = 0, nlt = 0;
    if (!ctxq) {
        if (BR == 0) { const int r0 = q0 >> 6; const int lo = min(max(r0 - 4, 0), GROWS - 8), hi2 = min(max(r0 - 1, 0), GROWS - 8) + 8; klo = lo * 64; nlt = hi2 - lo; }
        else if (BR == 2) { klo = max(q0 - 128, 0); nlt = (min(q0 + 256, SEQ) - klo) >> 6; }
        else { klo = 0; nlt = SEQ / 64; }
    }
    const int nt = 4 + nlt;
    const T* ksrc; const T* vsrc; const T* rsrc = nullptr; size_t kpitch;
    { const int kk = 8 * wid + (lane >> 3), kch = ((lane & 7) ^ (lane >> 3)) * 8, vch = ((((lane >> 2) ^ (lane >> 4)) & 1) * 32) + (lane & 3) * 8;
      if (BR == 3) { ksrc = P.KVM + (size_t)kk * 512 + hx * 128 + kch; vsrc = P.KVM + (size_t)kk * 512 + hx * 128 + 64 + vch; kpitch = 512;
                     rsrc = P.Z + (size_t)(16 * (wid & 3) + (lane >> 2)) * ZW + MKR + (((lane & 3) ^ ((lane >> 4) & 3)) * 8); }
      else { const int ko = (BR == 0 ? NAK : BR == 1 ? GK : SK) + hx * 64, vo = (BR == 0 ? NAV : BR == 1 ? GV : SV) + hx * 64;
             ksrc = P.Z + (size_t)kk * ZW + ko + kch; vsrc = P.Z + (size_t)kk * ZW + vo + vch; kpitch = ZW; } }
#define A_TROW(t) ((t) < 4 ? ctx0 + (size_t)(t) * 64 : lat0 + (size_t)klo + (size_t)((t) - 4) * 64)
#define A_DMA(t, slot) do { if (wid < 4) { const size_t tr_ = A_TROW(t); const ldsp sb_ = lds + (slot) * SLOT; \
        GLDS16(ksrc + tr_ * kpitch, sb_ + wid * 1152); GLDS16(ksrc + (tr_ + 32) * kpitch, sb_ + (wid + 4) * 1152); \
        GLDS16(vsrc + tr_ * kpitch, sb_ + KB + wid * 1024); GLDS16(vsrc + (tr_ + 32) * kpitch, sb_ + KB + (wid + 4) * 1024); \
        if (BR == 3) GLDS16(rsrc + tr_ * ZW, sb_ + 9216 + wid * 1024); } } while (0)
#define A_WAITBAR(n) do { if (wid < 4) { if (BR == 3) asm volatile("s_waitcnt vmcnt(%0) lgkmcnt(0)\n\ts_barrier" :: "n"(5 * (n)) : "memory"); \
                                         else asm volatile("s_waitcnt vmcnt(%0) lgkmcnt(0)\n\ts_barrier" :: "n"(4 * (n)) : "memory"); } \
                          else asm volatile("s_waitcnt lgkmcnt(0)\n\ts_barrier" ::: "memory"); } while (0)
    LAS float* btab = (LAS float*)(lds + BT0);
    if (BR == 0) { if (tid < 465) btab[tid] = P.rpb[hx * 465 + tid] * 1.4426950408889634f; }
    const int qr = (q0 >> 6) + (wid >> 1), qc = (wid & 1) * 32 + r32;
    const int krow0 = min(max(qr - 4, 0), GROWS - 8), kcol0 = min(max(qc - 8, 0), GW - 16);
    float mref = 0.f, lsum = 0.f;
    f32x16 o0, o1, negm, lacc;
#pragma unroll
    for (int r = 0; r < 16; ++r) { o0[r] = 0.f; o1[r] = 0.f; negm[r] = 0.f; lacc[r] = 0.f; }
    const bf16x8 ones8 = __builtin_bit_cast(bf16x8, (unsigned __attribute__((ext_vector_type(4)))){0x3f803f80u, 0x3f803f80u, 0x3f803f80u, 0x3f803f80u});
    const unsigned kfo = (r32 >> 3) * 1152 + (r32 & 7) * 128 + ((hi ^ (r32 & 7)) * 16);
    const unsigned rfo = 9216 + r32 * 64 + ((hi ^ ((r32 >> 2) & 3)) * 16);
    const unsigned vfo = KB + (4 * hi + ((lane & 15) >> 2)) * 128 + ((lane >> 3) & 1) * 64 + ((lane >> 4) & 1) * 32 + (lane & 3) * 8;
    constexpr int NG = 8 + 2 * NKS, AHEAD = 4, NGT = NG + 4;
    if (wid < 4) { const size_t tr_ = A_TROW(0); GLDS16(vsrc + tr_ * kpitch, lds + (R - 1) * SLOT + KB + wid * 1024); GLDS16(vsrc + (tr_ + 32) * kpitch, lds + (R - 1) * SLOT + KB + (wid + 4) * 1024); }
#pragma unroll
    for (int j = 0; j < PF; ++j) { if (j < nt) A_DMA(j, j); }
    if (nt >= PF) A_WAITBAR(PF - 3); else A_WAITBAR(0);
    f32x16 sA0, sA1, sB0, sB1;
    { const ldsp kb_ = lds;
#pragma unroll
      for (int r = 0; r < 16; ++r) { sA0[r] = 0.f; sA1[r] = 0.f; }
#pragma unroll
      for (int ks = 0; ks < NKS; ++ks) { const ldsp a_ = kb_ + ((ks < 4) ? (kfo ^ (unsigned)(ks * 32)) : (rfo ^ (unsigned)((ks - 4) * 32)));
          const bf16x8 ka = *(const LAS bf16x8*)(a_), kb = *(const LAS bf16x8*)(a_ + ((ks < 4) ? 4608 : 2048));
          sA0 = __builtin_amdgcn_mfma_f32_32x32x16_bf16(ka, qf[ks], sA0, 0, 0, 0); sA1 = __builtin_amdgcn_mfma_f32_32x32x16_bf16(kb, qf[ks], sA1, 0, 0, 0); } }
    unsigned pwA[16], pwB[16];
#pragma unroll
    for (int i = 0; i < 16; ++i) { pwA[i] = 0u; pwB[i] = 0u; }
    int sl = 0;
#ifdef PROBE_T
    unsigned long long pt_acc = 0ull, pt_a = 0ull, pt_b = 0ull; const unsigned long long pt_t0 = __builtin_amdgcn_s_memtime(), pt_r0 = __builtin_amdgcn_s_memrealtime();
#define PT_A(k) do { if (PROBE_T == (k)) pt_a = __builtin_amdgcn_s_memtime(); } while (0)
#define PT_B(k) do { if (PROBE_T == (k)) { pt_b = __builtin_amdgcn_s_memtime(); pt_acc += pt_b - pt_a; } } while (0)
#else
#define PT_A(k) do { } while (0)
#define PT_B(k) do { } while (0)
#endif
#define S_EL(c0, c1, i) ((i) < 16 ? c0[(i) & 15] : c1[(i) & 15])
#define SB0() __builtin_amdgcn_sched_barrier(0)
    const unsigned lds0 = (unsigned)(size_t)lds;
#define DSR128(dst, addr, OFF) asm volatile("ds_read_b128 %0, %1 offset:" #OFF : "=v"(dst) : "v"(addr))
#define DSRTR(dst, addr, OFF) asm volatile("ds_read_b64_tr_b16 %0, %1 offset:" #OFF : "=v"(dst) : "v"(addr))
#define A_RD(m) do { switch (m) { \
        case 0: DSRTR(vL[0], vb_, 0); DSRTR(vH[0], vb_, 1024); break; case 1: DSRTR(vL[1], vc_, 0); DSRTR(vH[1], vc_, 1024); break; \
        case 2: DSRTR(vL[2], vb_, 2048); DSRTR(vH[2], vb_, 3072); break; case 3: DSRTR(vL[3], vc_, 2048); DSRTR(vH[3], vc_, 3072); break; \
        case 4: DSRTR(vL[4], vb_, 4096); DSRTR(vH[4], vb_, 5120); break; case 5: DSRTR(vL[5], vc_, 4096); DSRTR(vH[5], vc_, 5120); break; \
        case 6: DSRTR(vL[6], vb_, 6144); DSRTR(vH[6], vb_, 7168); break; case 7: DSRTR(vL[7], vc_, 6144); DSRTR(vH[7], vc_, 7168); break; \
        default: { const int q_ = (m) - 8, ks_ = q_ >> 1; \
                   if (ks_ < 4) { const unsigned a_ = kb_ + (kfo ^ (unsigned)(ks_ * 32)); if (q_ & 1) DSR128(kF[q_], a_, 4608); else DSR128(kF[q_], a_, 0); } \
                   else { const unsigned a_ = kb_ + (rfo ^ (unsigned)((ks_ - 4) * 32)); if (q_ & 1) DSR128(kF[q_], a_, 2048); else DSR128(kF[q_], a_, 0); } } break; } } while (0)
#define NRD(m) ((m) < 8 ? 2 : 1)
#define A_WT(g, n) do { if ((g) < 8) { if ((n) == 0) asm volatile("s_waitcnt lgkmcnt(0)" : "+v"(vL[g]), "+v"(vH[g])); else if ((n) == 1) asm volatile("s_waitcnt lgkmcnt(1)" : "+v"(vL[g]), "+v"(vH[g])); \
            else if ((n) == 2) asm volatile("s_waitcnt lgkmcnt(2)" : "+v"(vL[g]), "+v"(vH[g])); else if ((n) == 3) asm volatile("s_waitcnt lgkmcnt(3)" : "+v"(vL[g]), "+v"(vH[g])); \
            else if ((n) == 4) asm volatile("s_waitcnt lgkmcnt(4)" : "+v"(vL[g]), "+v"(vH[g])); else if ((n) == 5) asm volatile("s_waitcnt lgkmcnt(5)" : "+v"(vL[g]), "+v"(vH[g])); \
            else if ((n) == 6) asm volatile("s_waitcnt lgkmcnt(6)" : "+v"(vL[g]), "+v"(vH[g])); else if ((n) == 7) asm volatile("s_waitcnt lgkmcnt(7)" : "+v"(vL[g]), "+v"(vH[g])); \
            else asm volatile("s_waitcnt lgkmcnt(8)" : "+v"(vL[g]), "+v"(vH[g])); } \
        else { if ((n) == 0) asm volatile("s_waitcnt lgkmcnt(0)" : "+v"(kF[(g) - 8])); else if ((n) == 1) asm volatile("s_waitcnt lgkmcnt(1)" : "+v"(kF[(g) - 8])); \
            else if ((n) == 2) asm volatile("s_waitcnt lgkmcnt(2)" : "+v"(kF[(g) - 8])); else if ((n) == 3) asm volatile("s_waitcnt lgkmcnt(3)" : "+v"(kF[(g) - 8])); \
            else asm volatile("s_waitcnt lgkmcnt(4)" : "+v"(kF[(g) - 8])); } } while (0)
#define A_ITER(t, c0, c1, n0, n1, pwO, pwN, EVEN) do { \
        const int s1 = (sl + 1 == R) ? 0 : sl + 1, sm1 = (sl == 0) ? R - 1 : sl - 1, sm2 = (sm1 == 0) ? R - 1 : sm1 - 1; \
        const bool feed = (t) + PF < nt; PT_A(4); \
        if (BR == 2) { if ((t) >= 4) { const int kb0 = klo + ((t) - 4) * 64 - tokq + 128; \
                _Pragma("unroll") for (int r = 0; r < 16; ++r) { const int d0 = kb0 + crow(r, hi); \
                    if ((unsigned)d0 > 256u) c0[r] = NEG; if ((unsigned)(d0 + 32) > 256u) c1[r] = NEG; } } } \
          \
        const unsigned vb_ = lds0 + sm1 * SLOT + vfo, vc_ = lds0 + sm1 * SLOT + (vfo ^ 64u); const unsigned kb_ = lds0 + s1 * SLOT; \
        s16x4 vL[8], vH[8]; bf16x8 kF[2 * NKS]; \
        _Pragma("unroll") for (int m = 0; m < AHEAD; ++m) A_RD(m); \
        float rm; \
        { const float a0 = max3f(c0[0], c0[1], c0[2]), a1 = max3f(c0[3], c0[4], c0[5]), a2 = max3f(c0[6], c0[7], c0[8]), a3 = max3f(c0[9], c0[10], c0[11]), \
                      a4 = max3f(c0[12], c0[13], c0[14]), a5 = max3f(c0[15], c1[0], c1[1]), a6 = max3f(c1[2], c1[3], c1[4]), a7 = max3f(c1[5], c1[6], c1[7]), \
                      a8 = max3f(c1[8], c1[9], c1[10]), a9 = max3f(c1[11], c1[12], c1[13]), a10 = fmaxf(c1[14], c1[15]); \
          const float b0 = max3f(a0, a1, a2), b1 = max3f(a3, a4, a5), b2 = max3f(a6, a7, a8), b3 = fmaxf(a9, a10); \
          rm = xhalf_max(fmaxf(fmaxf(b0, b1), fmaxf(b2, b3))); } \
        if ((t) == 0 || __any(rm > THR)) {                   \
            const float dl = ((t) == 0) ? rm : fmaxf(rm, 0.f); const float f = __builtin_amdgcn_exp2f(-dl); \
            mref += dl; \
            _Pragma("unroll") for (int r = 0; r < 16; ++r) { c0[r] -= dl; c1[r] -= dl; o0[r] *= f; o1[r] *= f; negm[r] -= dl; lacc[r] *= f; } \
            _Pragma("unroll") for (int i = 0; i < 16; ++i) pwO[i] = cvtpk(__uint_as_float(pwO[i] << 16) * f, __uint_as_float(pwO[i] & 0xffff0000u) * f); } \
        SB0(); PT_B(4); PT_A(5); \
        _Pragma("unroll") for (int g = 0; g < NGT; ++g) { \
              \
            if (g + AHEAD < NG) A_RD(g + AHEAD); \
              \
            if (g < NG) { int n_ = 0; _Pragma("unroll") for (int m = g + 1; m <= g + AHEAD; ++m) if (m < NG) n_ += NRD(m); A_WT(g, n_); } \
              \
            if (g < 8) { typedef unsigned u4 __attribute__((ext_vector_type(4))); const int s = g >> 1; \
                const u4 pw4 = {pwO[4 * s], pwO[4 * s + 1], pwO[4 * s + 2], pwO[4 * s + 3]}; const bf16x8 pfr = __builtin_bit_cast(bf16x8, pw4); \
                const bf16x8 vf = (bf16x8){vL[g][0], vL[g][1], vL[g][2], vL[g][3], vH[g][0], vH[g][1], vH[g][2], vH[g][3]}; \
                if ((g & 1) == 0) o0 = __builtin_amdgcn_mfma_f32_32x32x16_bf16(vf, pfr, o0, 0, 0, 0); else o1 = __builtin_amdgcn_mfma_f32_32x32x16_bf16(vf, pfr, o1, 0, 0, 0); } \
            else if (g < NG) { const int q_ = g - 8, ks = q_ >> 1; \
                if ((q_ & 1) == 0) n0 = __builtin_amdgcn_mfma_f32_32x32x16_bf16(kF[q_], qf[ks], ks == 0 ? negm : n0, 0, 0, 0); \
                else               n1 = __builtin_amdgcn_mfma_f32_32x32x16_bf16(kF[q_], qf[ks], ks == 0 ? negm : n1, 0, 0, 0); } \
            else { typedef unsigned u4 __attribute__((ext_vector_type(4))); const int s = g - NG; \
                const u4 pw4 = {pwO[4 * s], pwO[4 * s + 1], pwO[4 * s + 2], pwO[4 * s + 3]}; lacc = __builtin_amdgcn_mfma_f32_32x32x16_bf16(ones8, __builtin_bit_cast(bf16x8, pw4), lacc, 0, 0, 0); } \
              \
            if (g < 16) { const float e0 = __builtin_amdgcn_exp2f(S_EL(c0, c1, 2 * g)), e1 = __builtin_amdgcn_exp2f(S_EL(c0, c1, 2 * g + 1)); \
                pwN[g] = cvtpk(e0, e1); } \
            SB0(); \
        } \
        PT_B(5); PT_A(3); \
          \
          \
        if (EVEN) { const int sp0 = (sl + PF >= R) ? sl + PF - R : sl + PF, sp1 = (sp0 + 1 == R) ? 0 : sp0 + 1; \
                    if (feed) A_DMA((t) + PF, sp0); if ((t) + PF + 1 < nt) A_DMA((t) + PF + 1, sp1); \
                    if ((t) + 1 >= nt) A_WAITBAR(0); } \
        else { if ((t) + PF < nt) A_WAITBAR(PF - 3); else A_WAITBAR(0); } PT_B(3); \
        sl = s1; \
    } while (0)
    { int t = 0;
      for (; t + 1 < nt; t += 2) { A_ITER(t, sA0, sA1, sB0, sB1, pwA, pwB, 1); A_ITER(t + 1, sB0, sB1, sA0, sA1, pwB, pwA, 0); }
      if (t < nt) { A_ITER(t, sA0, sA1, sB0, sB1, pwA, pwB, 1);
#pragma unroll
          for (int i = 0; i < 16; ++i) pwA[i] = pwB[i]; } }
    { const int sm1 = (sl == 0) ? R - 1 : sl - 1; const ldsp vb_ = lds + sm1 * SLOT + vfo, vc_ = lds + sm1 * SLOT + (vfo ^ 64u);
#pragma unroll
      for (int s = 0; s < 4; ++s) {
          typedef unsigned u4 __attribute__((ext_vector_type(4))); const u4 pw4 = {pwA[4 * s], pwA[4 * s + 1], pwA[4 * s + 2], pwA[4 * s + 3]}; const bf16x8 pfr = __builtin_bit_cast(bf16x8, pw4);
#pragma unroll
          for (int d0 = 0; d0 < 2; ++d0) { const ldsp vp = (d0 ? vc_ : vb_) + s * 2048;
              const s16x4 lo = __builtin_bit_cast(s16x4, __builtin_amdgcn_ds_read_tr16_b64_v4i16((LAS v4i16_t*)vp)), hi4 = __builtin_bit_cast(s16x4, __builtin_amdgcn_ds_read_tr16_b64_v4i16((LAS v4i16_t*)(vp + 1024)));
              const bf16x8 vf = (bf16x8){lo[0], lo[1], lo[2], lo[3], hi4[0], hi4[1], hi4[2], hi4[3]};
              if (d0 == 0) o0 = __builtin_amdgcn_mfma_f32_32x32x16_bf16(vf, pfr, o0, 0, 0, 0); else o1 = __builtin_amdgcn_mfma_f32_32x32x16_bf16(vf, pfr, o1, 0, 0, 0); }
          lacc = __builtin_amdgcn_mfma_f32_32x32x16_bf16(ones8, pfr, lacc, 0, 0, 0); } }
    asm volatile("s_waitcnt lgkmcnt(0)\n\ts_barrier" ::: "memory");
#ifdef PROBE_T
    if (BR == PROBE_BR && P.o32 && blockIdx.x == 0 && wid == PROBE_W && lane == 0) {
        const unsigned long long t1 = __builtin_amdgcn_s_memtime(), r1 = __builtin_amdgcn_s_memrealtime();
        float c;
        if (PROBE_T == 1) c = 1e-5f * (float)(t1 - pt_t0) / (float)nt;
        else if (PROBE_T == 2) c = 1e-3f * (float)(t1 - pt_t0) / (float)(r1 - pt_r0);
        else c = 1e-5f * (float)pt_acc / (float)nt;
        P.o32[0] = 1.f + c;
    }
#endif
#undef S_EL
#undef SB0
#undef A_ITER
#undef A_RD
#undef NRD
#undef A_WT
#undef DSR128
#undef DSRTR
    float ltot = lacc[0];
    if (BR == 2) ltot += __builtin_amdgcn_exp2f(P.sink[head] * 1.4426950408889634f - mref);
    const float inv = 1.f / ltot;
#ifdef PROBE_ATTN
    if (P.o32 && b == 1 && (ctxq || tokq < 1024 || tokq >= 7168)) {
        const int sub = ctxq ? 2048 + tokq : (tokq < 1024 ? tokq : 1024 + tokq - 7168);
        float* fp = P.o32 + (size_t)sub * D + BR * 256 + head * 64 + 4 * hi;
#pragma unroll
        for (int g = 0; g < 4; ++g)
#pragma unroll
            for (int j = 0; j < 4; ++j) { fp[8 * g + j] = o0[4 * g + j] * inv; fp[32 + 8 * g + j] = o1[4 * g + j] * inv; }
    }
#endif
    T* op = P.O + qrow * D + BR * 256 + head * 64 + 4 * hi;
#pragma unroll
    for (int g = 0; g < 4; ++g) {
        *(uint2*)(op + 8 * g) = pk4(o0[4 * g] * inv, o0[4 * g + 1] * inv, o0[4 * g + 2] * inv, o0[4 * g + 3] * inv);
        *(uint2*)(op + 32 + 8 * g) = pk4(o1[4 * g] * inv, o1[4 * g + 1] * inv, o1[4 * g + 2] * inv, o1[4 * g + 3] * inv);
    }
#undef A_TROW
#undef A_DMA
#undef A_WAITBAR
#undef A_ACTIVE
#undef A_QK
#undef A_STEP
}

__device__ __forceinline__ void attn_phase(ldsp lds, const AttnP& P, int bid, int nblk) {
    for (int u = bid; u < 512; u += nblk) attn_unit<3>(lds, P, u >> 7, (u >> 5) & 3, (u & 31) * 256, false);
    for (int u = bid; u < 512; u += nblk) attn_unit<1>(lds, P, u >> 7, (u >> 6) & 1, (u & 63) * 128, false);
    for (int u = bid; u < 512; u += nblk) attn_unit_l<0>(lds, P, u >> 7, (u >> 5) & 3, (u & 31) * 256, false);
    for (int u = bid; u < 512; u += nblk) attn_unit<2>(lds, P, u >> 7, (u >> 6) & 1, (u & 63) * 128, false);
    if (P.need_ctx) {
        for (int u = bid; u < 64; u += nblk) {
            const int br = u >> 4, bb = (u >> 2) & 3, x = u & 3;
            if (br == 0) attn_unit_l<0>(lds, P, bb, x, 0, true);
            else if (br == 1) attn_unit<1>(lds, P, bb, x >> 1, (x & 1) * 128, true);
            else if (br == 2) attn_unit<2>(lds, P, bb, x >> 1, (x & 1) * 128, true);
            else attn_unit<3>(lds, P, bb, x, 0, true);
        }
    }
}

constexpr size_t al256(size_t b) { return (b + 255) & ~(size_t)255; }
constexpr size_t NSLOT_ = (size_t)NB * NE * (CAP + CAPC);
constexpr size_t OFF_BAR = 0, OFF_MODV = OFF_BAR + al256(3456 * 4), OFF_TAB64 = OFF_MODV + al256((size_t)NL * 5 * MODW * 4), OFF_TAB32 = OFF_TAB64 + al256(128 * 16 * 8),
    OFF_RA = OFF_TAB32 + al256(128 * 8 * 8), OFF_RC = OFF_RA + al256((size_t)NROW * D * 2), OFF_XCA = OFF_RC + al256((size_t)NROW * D * 2), OFF_XCB = OFF_XCA + al256((size_t)NCTX * D * 4),
    OFF_AFF = OFF_XCB + al256((size_t)NCTX * D * 4), OFF_IDX = OFF_AFF + al256((size_t)NROW * NE * 4), OFF_GATEV = OFF_IDX + al256(NSLOT_ * 4), OFF_INV = OFF_GATEV + al256(NSLOT_ * 4),
    OFF_Z = OFF_INV + al256((size_t)NROW * NE * 4), OFF_WINT = OFF_Z + al256((size_t)NROW * ZW * 2), OFF_WQT = OFF_WINT + al256((size_t)NL * 6400 * D * 2), OFF_WKVT = OFF_WQT + al256((size_t)NL * 384 * 192 * 2),
    OFF_SS = OFF_WKVT + al256((size_t)NL * 512 * 128 * 2), OFF_WBT = OFF_SS + al256((size_t)NROW * 8 * 4), OFF_WOUTT = OFF_WBT + al256((size_t)NL * 4 * 1024 * 256 * 2), OFF_END = OFF_WOUTT + al256((size_t)NL * D * D * 2);
struct MP {
    const float *x_, *c_, *ctx_, *c_ctx_, *w_mod_, *b_mod_, *w_in_, *na_rpb_, *gqn_, *gkn_, *swa_sink_, *mqn_, *mkvn_, *w_qb_, *w_kvb_, *w_branch_, *w_out_,
                *ln1g_, *ln1b_, *ln2g_, *ln2b_, *w_router_, *w_gate_, *w_up_, *w_down_;
    float* out_; char* ws_;
    float* o32_; const float* pscale_;
    int ph_lo_, ph_hi_;
    __device__ __forceinline__ const float* x() const { return x_; }
    __device__ __forceinline__ const float* c() const { return c_; }
    __device__ __forceinline__ const float* ctx() const { return ctx_; }
    __device__ __forceinline__ const float* c_ctx() const { return c_ctx_; }
    __device__ __forceinline__ const float* w_mod() const { return w_mod_; }
    __device__ __forceinline__ const float* b_mod() const { return b_mod_; }
    __device__ __forceinline__ const float* w_in() const { return w_in_; }
    __device__ __forceinline__ const float* na_rpb() const { return na_rpb_; }
    __device__ __forceinline__ const float* gqn() const { return gqn_; }
    __device__ __forceinline__ const float* gkn() const { return gkn_; }
    __device__ __forceinline__ const float* swa_sink() const { return swa_sink_; }
    __device__ __forceinline__ const float* mqn() const { return mqn_; }
    __device__ __forceinline__ const float* mkvn() const { return mkvn_; }
    __device__ __forceinline__ const float* w_qb() const { return w_qb_; }
    __device__ __forceinline__ const float* w_kvb() const { return w_kvb_; }
    __device__ __forceinline__ const float* w_branch() const { return w_branch_; }
    __device__ __forceinline__ const float* w_out() const { return w_out_; }
    __device__ __forceinline__ const float* ln1g() const { return ln1g_; }
    __device__ __forceinline__ const float* ln1b() const { return ln1b_; }
    __device__ __forceinline__ const float* ln2g() const { return ln2g_; }
    __device__ __forceinline__ const float* ln2b() const { return ln2b_; }
    __device__ __forceinline__ const float* w_router() const { return w_router_; }
    __device__ __forceinline__ const float* w_gate() const { return w_gate_; }
    __device__ __forceinline__ const float* w_up() const { return w_up_; }
    __device__ __forceinline__ const float* w_down() const { return w_down_; }
    __device__ __forceinline__ float* out() const { return out_; }
    __device__ __forceinline__ char* ws() const { return ws_; }
    __device__ __forceinline__ float* o32() const { return o32_; }
    __device__ __forceinline__ const float* pscale() const { return pscale_; }
    __device__ __forceinline__ int ph_lo() const { return ph_lo_; }
    __device__ __forceinline__ int ph_hi() const { return ph_hi_; }
    __device__ __forceinline__ unsigned* bar() const { return (unsigned*)(ws() + OFF_BAR); }
    __device__ __forceinline__ float* modv() const { return (float*)(ws() + OFF_MODV); }
    __device__ __forceinline__ float2* tab64() const { return (float2*)(ws() + OFF_TAB64); }
    __device__ __forceinline__ float2* tab32() const { return (float2*)(ws() + OFF_TAB32); }
    __device__ __forceinline__ T* RA() const { return (T*)(ws() + OFF_RA); }
    __device__ __forceinline__ T* RC() const { return (T*)(ws() + OFF_RC); }
    __device__ __forceinline__ float* XCa() const { return (float*)(ws() + OFF_XCA); }
    __device__ __forceinline__ float* XCb() const { return (float*)(ws() + OFF_XCB); }
    __device__ __forceinline__ float* AFF() const { return (float*)(ws() + OFF_AFF); }
    __device__ __forceinline__ int* IDX() const { return (int*)(ws() + OFF_IDX); }
    __device__ __forceinline__ float* GATEV() const { return (float*)(ws() + OFF_GATEV); }
    __device__ __forceinline__ int* INV() const { return (int*)(ws() + OFF_INV); }
    __device__ __forceinline__ T* Z() const { return (T*)(ws() + OFF_Z); }
    __device__ __forceinline__ T* WinT() const { return (T*)(ws() + OFF_WINT); }
    __device__ __forceinline__ T* WqT() const { return (T*)(ws() + OFF_WQT); }
    __device__ __forceinline__ T* WkvT() const { return (T*)(ws() + OFF_WKVT); }
    __device__ __forceinline__ float* SS() const { return (float*)(ws() + OFF_SS); }
    __device__ __forceinline__ T* WbT() const { return (T*)(ws() + OFF_WBT); }
    __device__ __forceinline__ T* WoutT() const { return (T*)(ws() + OFF_WOUTT); }
};

__device__ __forceinline__ void ph_mod(ldsp lds, const MP& p, int bid, int nblk) {
    LAS float* sc = (LAS float*)lds;
    LAS float* red = (LAS float*)(lds + 5 * 1024 * 4);
    const int tid = otid(), lane = tid & 63, kg = tid >> 6;
    for (int i = tid; i < 5 * 1024; i += 512) { const int s = i >> 10, k = i & 1023; const float v = s < 4 ? p.c()[s * 1024 + k] : p.c_ctx()[k]; sc[i] = v / (1.f + expf(-v)); }
    __syncthreads();
    for (int u = bid; u < NL * (MODW / 64); u += nblk) {
        const int l = u / (MODW / 64), j = (u % (MODW / 64)) * 64 + lane;
        float acc[5] = {0.f, 0.f, 0.f, 0.f, 0.f};
        const float* w = p.w_mod() + (size_t)l * D * MODW + j;
        for (int k = kg * 128; k < kg * 128 + 128; ++k) { const float wv = w[(size_t)k * MODW];
#pragma unroll
            for (int s = 0; s < 5; ++s) acc[s] += sc[s * 1024 + k] * wv; }
#pragma unroll
        for (int s = 0; s < 5; ++s) red[(kg * 5 + s) * 64 + lane] = acc[s];
        __syncthreads();
        if (kg < 5) { const int s = kg; float v = p.b_mod()[l * MODW + j];
#pragma unroll
            for (int g = 0; g < 8; ++g) v += red[(g * 5 + s) * 64 + lane];
            p.modv()[((size_t)l * 5 + s) * MODW + j] = v; }
        __syncthreads();
    }
}
__device__ __forceinline__ void ph_ropetab(const MP& p, int bid, int nblk) {
    for (int t = bid * 512 + otid(); t < 128 * 16; t += nblk * 512) {
        { const int pos = t / 16, i = t % 16; const float a = (float)pos * powf(10000.f, -(float)i / 16.f); p.tab64()[t] = make_float2(cosf(a), sinf(a)); }
        if (t < 128 * 8) { const int pos = t / 8, i = t % 8; const float a = (float)pos * powf(10000.f, -(float)i / 8.f); p.tab32()[t] = make_float2(cosf(a), sinf(a)); }
    }
}
struct PrepJob { const float* src; const float* src2; const float* kscale; T* dst; int K, Nsrc, Ndst, mode, nz, perm; long long src_zs, dst_zs, ks_zs; };
__device__ __forceinline__ void ph_wprep(ldsp lds, const PrepJob& a, int bid, int nblk) {
    constexpr int NT = 4;
    LAS float* tile = (LAS float*)lds;
    const int tid_ = otid();
    const int kr = tid_ >> 4, c4 = tid_ & 15;
    const int kq = tid_ & 7, nr = tid_ >> 3;
    const int nx = a.Ndst / 64, ny = a.K / 64, ntile = nx * ny * a.nz;
    float4 v0[NT], v1[NT];
#define WP_LOAD(i, u) do { const int z_ = (u) / (nx * ny), rem_ = (u) % (nx * ny), n0_ = (rem_ % nx) * 64, k0_ = (rem_ / nx) * 64; \
        const float* src_ = a.src + (size_t)z_ * a.src_zs; const float* ksc_ = a.kscale ? a.kscale + (size_t)z_ * a.ks_zs : nullptr; \
        int n_ = n0_ + 4 * c4; if (a.perm) { const int p_ = n_ & 255; n_ = (n_ & ~255) + 64 * ((p_ >> 5) & 3) + 32 * (p_ >> 7) + (p_ & 31); } bool valid_ = true; int col_ = n_; const float* sp_ = src_; \
        if (a.mode == 0) { valid_ = n_ < a.Nsrc; } \
        else if (a.mode == 1) { if (n_ < 2144) col_ = n_; else if (n_ < 2304) valid_ = false; else col_ = n_ - 160; } \
        else { const int j_ = n_ >> 6, w_ = n_ & 63; if (w_ >= 32) sp_ = a.src2 + (size_t)z_ * a.src_zs; col_ = 32 * j_ + (w_ & 31); } \
        v0[i] = make_float4(0.f, 0.f, 0.f, 0.f); v1[i] = v0[i]; \
        if (valid_) { v0[i] = *(const float4*)(sp_ + (size_t)(k0_ + kr) * a.Nsrc + col_); v1[i] = *(const float4*)(sp_ + (size_t)(k0_ + kr + 32) * a.Nsrc + col_); \
            if (ksc_) { const float s0_ = ksc_[k0_ + kr], s1_ = ksc_[k0_ + kr + 32]; v0[i].x *= s0_; v0[i].y *= s0_; v0[i].z *= s0_; v0[i].w *= s0_; v1[i].x *= s1_; v1[i].y *= s1_; v1[i].z *= s1_; v1[i].w *= s1_; } } } while (0)
    int u = bid, buf = 0;
#pragma unroll
    for (int i = 0; i < NT; ++i) { if (u + i * nblk < ntile) WP_LOAD(i, u + i * nblk); }
    for (; u < ntile; u += NT * nblk) {
        LAS float* tb = tile + buf * (NT * 64 * 65);
#pragma unroll
        for (int i = 0; i < NT; ++i) { if (u + i * nblk < ntile) { LAS float* w0 = tb + i * (64 * 65) + kr * 65 + 4 * c4; LAS float* w1 = w0 + 32 * 65;
            w0[0] = v0[i].x; w0[1] = v0[i].y; w0[2] = v0[i].z; w0[3] = v0[i].w; w1[0] = v1[i].x; w1[1] = v1[i].y; w1[2] = v1[i].z; w1[3] = v1[i].w; } }
        __syncthreads();
#pragma unroll
        for (int i = 0; i < NT; ++i) { const int un = u + (NT + i) * nblk; if (un < ntile) WP_LOAD(i, un); }
#pragma unroll
        for (int i = 0; i < NT; ++i) { const int ui = u + i * nblk; if (ui < ntile) {
            const int z = ui / (nx * ny), rem = ui % (nx * ny), n0 = (rem % nx) * 64, k0 = (rem / nx) * 64;
            T* dst = a.dst + (size_t)z * a.dst_zs;
            const LAS float* rp = tb + i * (64 * 65) + (kq * 8) * 65 + nr;
            *(uint4*)(dst + (size_t)(n0 + nr) * a.K + k0 + kq * 8) = make_uint4(pk2(rp[0], rp[65]), pk2(rp[130], rp[195]), pk2(rp[260], rp[325]), pk2(rp[390], rp[455])); } }
        buf ^= 1;
    }
#undef WP_LOAD
    __syncthreads();
}
__device__ __forceinline__ void lnmod_row(const float* src, const float* mv, int sh_off, int sc_off, T* dst, int lane) {
    float4 v[4]; float sum = 0.f;
#pragma unroll
    for (int i = 0; i < 4; ++i) { v[i] = *(const float4*)(src + i * 256 + lane * 4); sum += v[i].x + v[i].y + v[i].z + v[i].w; }
    const float mean = wave_sum(sum) * (1.f / D);
    float sq = 0.f;
#pragma unroll
    for (int i = 0; i < 4; ++i) { float a = v[i].x - mean, b = v[i].y - mean, c = v[i].z - mean, d = v[i].w - mean; sq += a * a + b * b + c * c + d * d; }
    const float rstd = 1.f / sqrtf(wave_sum(sq) * (1.f / D) + EPS);
#pragma unroll
    for (int i = 0; i < 4; ++i) {
        const int col = i * 256 + lane * 4;
        const float4 sh = *(const float4*)(mv + sh_off + col), sc = *(const float4*)(mv + sc_off + col);
        st4(dst + col, make_float4((v[i].x - mean) * rstd * (1.f + sc.x) + sh.x, (v[i].y - mean) * rstd * (1.f + sc.y) + sh.y,
                                   (v[i].z - mean) * rstd * (1.f + sc.z) + sh.z, (v[i].w - mean) * rstd * (1.f + sc.w) + sh.w));
    }
}
__device__ __forceinline__ void ph_lnmod0(const MP& p, int bid, int nblk) {
    const int tid_ = otid(); const int lane = tid_ & 63, wid = tid_ >> 6;
    for (int row = bid * 8 + wid; row < NROW; row += nblk * 8) {
        const bool lat = row < NLAT;
        const float* src = lat ? p.x() + (size_t)row * D : p.ctx() + (size_t)(row - NLAT) * D;
        const int s = lat ? row / SEQ : 4;
        lnmod_row(src, p.modv() + (size_t)s * MODW, 0, D, p.RA() + (size_t)row * D, lane);
    }
}
__device__ __forceinline__ void ph_lnres(ldsp lds, const MP& p, int l, int nrows, int bid, int nblk) {
    const int tid_ = otid(); const int lane = tid_ & 63, wid = tid_ >> 6;
    const float* modl = p.modv() + (size_t)l * 5 * MODW;
    const float* lgp = p.ln1g() + l * D; const float* lbp = p.ln1b() + l * D; const float* wr = p.w_router() + (size_t)l * D * NE;
    LAS float* WT = (LAS float*)lds;
    for (int i = tid_; i < NE * D; i += 512) { const int e = i >> 10, col = i & 1023; WT[i] = wr[col * NE + e]; }
    __syncthreads();
    const bool b5 = lane & 32, b4 = lane & 16, b3 = lane & 8, b2 = lane & 4;
    const int stride = nblk * 8;
    const float* xlat = l == 0 ? p.x() : p.out(); const float* xctx = l == 0 ? p.ctx() : p.XCb();
    float4 lgv[4], lbv[4], gv[4], shv[4], scv[4];
#pragma unroll
    for (int i = 0; i < 4; ++i) { lgv[i] = *(const float4*)(lgp + i * 256 + lane * 4); lbv[i] = *(const float4*)(lbp + i * 256 + lane * 4); }
    int cur_s = -1;
    int row = bid * 8 + wid;
    float4 xn[4]; uint2 yn[4];
#define LR_LOAD(r) do { const float* xs_ = (r) < NLAT ? xlat + (size_t)(r) * D : xctx + (size_t)((r) - NLAT) * D; const T* yp_ = p.RA() + (size_t)(r) * D; \
        _Pragma("unroll") for (int i = 0; i < 4; ++i) { xn[i] = *(const float4*)(xs_ + i * 256 + lane * 4); yn[i] = *(const uint2*)(yp_ + i * 256 + lane * 4); } } while (0)
    if (row < nrows) LR_LOAD(row);
    for (; row < nrows; row += stride) {
        float4 xc[4]; uint2 yc[4];
#pragma unroll
        for (int i = 0; i < 4; ++i) { xc[i] = xn[i]; yc[i] = yn[i]; }
        if (row + stride < nrows) LR_LOAD(row + stride);
        const bool lat = row < NLAT;
        float* xo = lat ? p.out() + (size_t)row * D : p.XCa() + (size_t)(row - NLAT) * D;
        const int s = lat ? row / SEQ : 4;
        if (s != cur_s) { cur_s = s; const float* mv = modl + (size_t)s * MODW;
#pragma unroll
            for (int i = 0; i < 4; ++i) { gv[i] = *(const float4*)(mv + 2 * D + i * 256 + lane * 4); shv[i] = *(const float4*)(mv + 3 * D + i * 256 + lane * 4); scv[i] = *(const float4*)(mv + 4 * D + i * 256 + lane * 4); } }
        float v[16]; float sum = 0.f;
#pragma unroll
        for (int i = 0; i < 4; ++i) {
            const float y0 = __uint_as_float(yc[i].x << 16), y1 = __uint_as_float(yc[i].x & 0xffff0000u), y2 = __uint_as_float(yc[i].y << 16), y3 = __uint_as_float(yc[i].y & 0xffff0000u);
            v[i * 4 + 0] = ALPHA * xc[i].x + gv[i].x * y0; v[i * 4 + 1] = ALPHA * xc[i].y + gv[i].y * y1; v[i * 4 + 2] = ALPHA * xc[i].z + gv[i].z * y2; v[i * 4 + 3] = ALPHA * xc[i].w + gv[i].w * y3;
            sum += v[i * 4] + v[i * 4 + 1] + v[i * 4 + 2] + v[i * 4 + 3];
        }
        const float mean = wave_sum(sum) * (1.f / D);
        float sq = 0.f;
#pragma unroll
        for (int i = 0; i < 16; ++i) { const float d = v[i] - mean; sq += d * d; }
        const float rstd = 1.f / sqrtf(wave_sum(sq) * (1.f / D) + EPS);
        float s2 = 0.f;
#pragma unroll
        for (int i = 0; i < 4; ++i) {
            v[i * 4 + 0] = (v[i * 4 + 0] - mean) * rstd * lgv[i].x + lbv[i].x; v[i * 4 + 1] = (v[i * 4 + 1] - mean) * rstd * lgv[i].y + lbv[i].y;
            v[i * 4 + 2] = (v[i * 4 + 2] - mean) * rstd * lgv[i].z + lbv[i].z; v[i * 4 + 3] = (v[i * 4 + 3] - mean) * rstd * lgv[i].w + lbv[i].w;
            *(float4*)(xo + i * 256 + lane * 4) = make_float4(v[i * 4], v[i * 4 + 1], v[i * 4 + 2], v[i * 4 + 3]);
            s2 += v[i * 4] + v[i * 4 + 1] + v[i * 4 + 2] + v[i * 4 + 3];
        }
        const float mean2 = wave_sum(s2) * (1.f / D);
        float sq2 = 0.f;
#pragma unroll
        for (int i = 0; i < 16; ++i) { const float d = v[i] - mean2; sq2 += d * d; }
        const float rstd2 = 1.f / sqrtf(wave_sum(sq2) * (1.f / D) + EPS);
        float h2[16];
#pragma unroll
        for (int i = 0; i < 4; ++i) {
            h2[i * 4 + 0] = (v[i * 4 + 0] - mean2) * rstd2 * (1.f + scv[i].x) + shv[i].x; h2[i * 4 + 1] = (v[i * 4 + 1] - mean2) * rstd2 * (1.f + scv[i].y) + shv[i].y;
            h2[i * 4 + 2] = (v[i * 4 + 2] - mean2) * rstd2 * (1.f + scv[i].z) + shv[i].z; h2[i * 4 + 3] = (v[i * 4 + 3] - mean2) * rstd2 * (1.f + scv[i].w) + shv[i].w;
            st4(p.RC() + (size_t)row * D + i * 256 + lane * 4, make_float4(h2[i * 4], h2[i * 4 + 1], h2[i * 4 + 2], h2[i * 4 + 3]));
        }
        float lg[16];
#pragma unroll
        for (int e = 0; e < 16; ++e) {
            float a = 0.f;
#pragma unroll
            for (int i = 0; i < 4; ++i) { const f32x4 w = *(const LAS f32x4*)(WT + e * D + i * 256 + lane * 4); a += h2[i * 4] * w.x + h2[i * 4 + 1] * w.y + h2[i * 4 + 2] * w.z + h2[i * 4 + 3] * w.w; }
            lg[e] = a;
            if (e & 1) __builtin_amdgcn_sched_barrier(0);
        }
        float a8[8], a4[4], a2[2];
#pragma unroll
        for (int k = 0; k < 8; ++k) {
            auto rr = __builtin_amdgcn_permlane32_swap(__float_as_uint(lg[k]), __float_as_uint(lg[8 + k]), false, false);
            a8[k] = __uint_as_float(rr[0]) + __uint_as_float(rr[1]); }
#pragma unroll
        for (int k = 0; k < 4; ++k) { const float mine = b4 ? a8[4 + k] : a8[k], oth = b4 ? a8[k] : a8[4 + k]; a4[k] = mine + __shfl_xor(oth, 16); }
#pragma unroll
        for (int k = 0; k < 2; ++k) { const float mine = b3 ? a4[2 + k] : a4[k], oth = b3 ? a4[k] : a4[2 + k]; a2[k] = mine + __shfl_xor(oth, 8); }
        float lgt = (b2 ? a2[1] : a2[0]) + __shfl_xor(b2 ? a2[0] : a2[1], 4);
        lgt = DPP_ADD(lgt, 0xB1); lgt = DPP_ADD(lgt, 0x4E);
        float mx = lgt;
        mx = fmaxf(mx, __shfl_xor(mx, 4)); mx = fmaxf(mx, __shfl_xor(mx, 8)); mx = fmaxf(mx, __shfl_xor(mx, 16)); mx = fmaxf(mx, __shfl_xor(mx, 32));
        const float ex = expf(lgt - mx);
        float den = ex;
        den += __shfl_xor(den, 4); den += __shfl_xor(den, 8); den += __shfl_xor(den, 16); den += __shfl_xor(den, 32);
        if ((lane & 3) == 0) p.AFF()[(size_t)row * NE + (lane >> 2)] = ex / den;
    }
#undef LR_LOAD
    __syncthreads();
}
__device__ __forceinline__ void ph_topk(ldsp lds, const MP& p, int nkinds, int bid, int nblk) {
    LAS unsigned* keys = (LAS unsigned*)lds;
    LAS unsigned* hist = (LAS unsigned*)(lds + 32768);
    LAS unsigned* part = (LAS unsigned*)(lds + 32768 + 8192);
    LAS unsigned* shv = (LAS unsigned*)(lds + 32768 + 8192 + 1024);
    const int tid = otid(), lane = tid & 63, wv = tid >> 6;
    for (int u = bid; u < NE * NB * nkinds; u += nblk) {
        const int e = u % NE, bl = (u / NE) % NB, kind = u / (NE * NB);
        const int n = kind ? CTX : SEQ, kk = kind ? CAPC : CAP;
        const size_t row0 = kind ? (size_t)NLAT + (size_t)bl * CTX : (size_t)bl * SEQ;
        const size_t grp = kind ? (size_t)NB * NE * CAP + ((size_t)e * NB + bl) * CAPC : ((size_t)bl * NE + e) * CAP;
        for (int i = tid; i < n; i += 512) keys[i] = __float_as_uint(p.AFF()[(row0 + i) * NE + e]);
        __syncthreads();
        unsigned prefix = 0, rem = kk;
        for (int pass = 0; pass < 3; ++pass) {
            const int shift = pass == 0 ? 21 : pass == 1 ? 10 : 0;
            const int nbm = pass == 2 ? 1023 : 2047;
            const int hshift = pass == 1 ? 21 : 10;
            for (int i = tid; i < 2048; i += 512) hist[i] = 0;
            __syncthreads();
            for (int i = tid; i < n; i += 512) { const unsigned k = keys[i]; const bool match = (pass == 0) || ((k >> hshift) == prefix); if (match) atomicAdd((unsigned*)&hist[(k >> shift) & nbm], 1u); }
            __syncthreads();
            unsigned loc = 0;
            if (tid < 256) { for (int j = 0; j < 8; ++j) loc += hist[tid * 8 + j]; part[tid] = loc; }
            __syncthreads();
            if (tid < 256) {
                unsigned above = 0;
                for (int j = tid + 1; j < 256; ++j) above += part[j];
                if (above < rem && above + loc >= rem) {
                    unsigned cum = above; int bsel = tid * 8 + 7;
                    for (; bsel >= tid * 8; --bsel) { const unsigned hc = hist[bsel]; if (cum + hc >= rem) break; cum += hc; }
                    shv[0] = (unsigned)bsel; shv[1] = rem - cum;
                }
            }
            __syncthreads();
            prefix = (pass == 0) ? shv[0] : ((prefix << (pass == 1 ? 11 : 10)) | shv[0]);
            rem = shv[1];
            __syncthreads();
        }
        const unsigned Tkey = prefix;
        unsigned base_gt = 0, base_eq = 0;
        for (int c0 = 0; c0 < n; c0 += 512) {
            const int i = c0 + tid; const bool inr = i < n;
            const unsigned k = inr ? keys[i] : 0u;
            const bool gt = inr && k > Tkey, eq = inr && k == Tkey;
            const unsigned long long mg = __ballot(gt), me = __ballot(eq);
            const unsigned long long lt = (1ull << lane) - 1ull;
            if (lane == 0) { shv[8 + wv] = __popcll(mg); shv[16 + wv] = __popcll(me); }
            __syncthreads();
            unsigned pg = base_gt + __popcll(mg & lt), pe = base_eq + __popcll(me & lt), tg = 0, te = 0;
            for (int w = 0; w < 8; ++w) { const unsigned a = shv[8 + w], b = shv[16 + w]; if (w < wv) { pg += a; pe += b; } tg += a; te += b; }
            const bool sel = gt || (eq && pe < rem);
            const unsigned slot = pg + min(pe, rem);
            if (inr) { if (sel) { p.IDX()[grp + slot] = (int)(row0 + i); p.GATEV()[grp + slot] = __uint_as_float(k); }
                       p.INV()[(row0 + i) * NE + e] = sel ? (int)slot : -1; }
            base_gt += tg; base_eq += te;
            __syncthreads();
        }
    }
}
__device__ __forceinline__ void ph_combine(const MP& p, int l, int nrows, const T* OUT, int bid, int nblk) {
    const int tid_ = otid(); const int lane = tid_ & 63, wid = tid_ >> 6;
    const float* modl = p.modv() + (size_t)l * 5 * MODW;
    const float* lgp = p.ln2g() + l * D; const float* lbp = p.ln2b() + l * D;
    const bool next = l + 1 < NL;
    const int stride = nblk * 8;
    float4 lgv[4], lbv[4], gv[4];
#pragma unroll
    for (int i = 0; i < 4; ++i) { lgv[i] = *(const float4*)(lgp + i * 256 + lane * 4); lbv[i] = *(const float4*)(lbp + i * 256 + lane * 4); }
    int cur_s = -1;
    int row = bid * 8 + wid;
    int sl_next = -1; float4 xn[4];
#define CB_LOAD(r) do { const float* xs_ = (r) < NLAT ? p.out() + (size_t)(r) * D : p.XCa() + (size_t)((r) - NLAT) * D; \
        _Pragma("unroll") for (int i = 0; i < 4; ++i) xn[i] = *(const float4*)(xs_ + i * 256 + lane * 4); \
        sl_next = lane < NE ? p.INV()[(size_t)(r) * NE + lane] : -1; } while (0)
    if (row < nrows) CB_LOAD(row);
    for (; row < nrows; row += stride) {
        float4 xc[4];
#pragma unroll
        for (int i = 0; i < 4; ++i) xc[i] = xn[i];
        const int slv = sl_next;
        if (row + stride < nrows) CB_LOAD(row + stride);
        const bool lat = row < NLAT;
        float* xo = lat ? p.out() + (size_t)row * D : p.XCb() + (size_t)(row - NLAT) * D;
        const int bl = lat ? row / SEQ : (row - NLAT) / CTX;
        const int s = lat ? bl : 4;
        if (s != cur_s) { cur_s = s; const float* mv = modl + (size_t)s * MODW;
#pragma unroll
            for (int i = 0; i < 4; ++i) gv[i] = *(const float4*)(mv + 5 * D + i * 256 + lane * 4); }
        unsigned long long mask = __ballot(slv >= 0) & 0xffffull;
        uint2 ob[4][4]; bool ok[4];
#pragma unroll
        for (int j = 0; j < 4; ++j) {
            ok[j] = mask != 0ull;
            if (ok[j]) {
                const int e = __builtin_ctzll(mask); mask &= mask - 1;
                const int sl = __builtin_amdgcn_readlane(slv, e);
                const size_t orow = lat ? ((size_t)bl * NE + e) * CAP + sl : (size_t)NB * NE * CAP + ((size_t)e * NB + bl) * CAPC + sl;
                const T* op = OUT + orow * D;
#pragma unroll
                for (int i = 0; i < 4; ++i) ob[j][i] = *(const uint2*)(op + i * 256 + lane * 4);
            } else {
#pragma unroll
                for (int i = 0; i < 4; ++i) ob[j][i] = make_uint2(0u, 0u);
            }
        }
        float y[16];
#pragma unroll
        for (int i = 0; i < 16; ++i) y[i] = 0.f;
#pragma unroll
        for (int j = 0; j < 4; ++j)
#pragma unroll
            for (int i = 0; i < 4; ++i) { y[i * 4] += __uint_as_float(ob[j][i].x << 16); y[i * 4 + 1] += __uint_as_float(ob[j][i].x & 0xffff0000u); y[i * 4 + 2] += __uint_as_float(ob[j][i].y << 16); y[i * 4 + 3] += __uint_as_float(ob[j][i].y & 0xffff0000u); }
        while (mask) {
            const int e = __builtin_ctzll(mask); mask &= mask - 1;
            const int sl = __builtin_amdgcn_readlane(slv, e);
            const size_t orow = lat ? ((size_t)bl * NE + e) * CAP + sl : (size_t)NB * NE * CAP + ((size_t)e * NB + bl) * CAPC + sl;
            const T* op = OUT + orow * D;
#pragma unroll
            for (int i = 0; i < 4; ++i) { const float4 o4 = ld4(op + i * 256 + lane * 4); y[i * 4] += o4.x; y[i * 4 + 1] += o4.y; y[i * 4 + 2] += o4.z; y[i * 4 + 3] += o4.w; }
        }
        float v[16]; float sum = 0.f;
#pragma unroll
        for (int i = 0; i < 4; ++i) {
            v[i * 4 + 0] = ALPHA * xc[i].x + gv[i].x * y[i * 4 + 0]; v[i * 4 + 1] = ALPHA * xc[i].y + gv[i].y * y[i * 4 + 1]; v[i * 4 + 2] = ALPHA * xc[i].z + gv[i].z * y[i * 4 + 2]; v[i * 4 + 3] = ALPHA * xc[i].w + gv[i].w * y[i * 4 + 3];
            sum += v[i * 4] + v[i * 4 + 1] + v[i * 4 + 2] + v[i * 4 + 3];
        }
        const float mean = wave_sum(sum) * (1.f / D);
        float sq = 0.f;
#pragma unroll
        for (int i = 0; i < 16; ++i) { const float d = v[i] - mean; sq += d * d; }
        const float rstd = 1.f / sqrtf(wave_sum(sq) * (1.f / D) + EPS);
        float s2 = 0.f;
#pragma unroll
        for (int i = 0; i < 4; ++i) {
            v[i * 4 + 0] = (v[i * 4 + 0] - mean) * rstd * lgv[i].x + lbv[i].x; v[i * 4 + 1] = (v[i * 4 + 1] - mean) * rstd * lgv[i].y + lbv[i].y;
            v[i * 4 + 2] = (v[i * 4 + 2] - mean) * rstd * lgv[i].z + lbv[i].z; v[i * 4 + 3] = (v[i * 4 + 3] - mean) * rstd * lgv[i].w + lbv[i].w;
            { const float ps_ = (!next && p.pscale()) ? p.pscale()[0] : 1.f;
              *(float4*)(xo + i * 256 + lane * 4) = make_float4(v[i * 4] * ps_, v[i * 4 + 1] * ps_, v[i * 4 + 2] * ps_, v[i * 4 + 3] * ps_); }
            s2 += v[i * 4] + v[i * 4 + 1] + v[i * 4 + 2] + v[i * 4 + 3];
        }
        if (next) {
            const float* mvn = p.modv() + ((size_t)(l + 1) * 5 + s) * MODW;
            const float mean2 = wave_sum(s2) * (1.f / D);
            float sq2 = 0.f;
#pragma unroll
            for (int i = 0; i < 16; ++i) { const float d = v[i] - mean2; sq2 += d * d; }
            const float rstd2 = 1.f / sqrtf(wave_sum(sq2) * (1.f / D) + EPS);
#pragma unroll
            for (int i = 0; i < 4; ++i) {
                const int col = i * 256 + lane * 4;
                const float4 sh = *(const float4*)(mvn + col), sc = *(const float4*)(mvn + D + col);
                st4(p.RA() + (size_t)row * D + col, make_float4((v[i * 4 + 0] - mean2) * rstd2 * (1.f + sc.x) + sh.x, (v[i * 4 + 1] - mean2) * rstd2 * (1.f + sc.y) + sh.y,
                                                             (v[i * 4 + 2] - mean2) * rstd2 * (1.f + sc.z) + sh.z, (v[i * 4 + 3] - mean2) * rstd2 * (1.f + sc.w) + sh.w));
            }
        }
    }
#undef CB_LOAD
}


#define XB_TMO      128
#define XB_XCNT(j)  (256  + 64 * (j))
#define XB_XSUB(j)  (1280 + 64 * (j))
#define XB_XGEN(j)  (2304 + 64 * (j))
#define XB_TOP      3328
#define XB_TOPGEN   3392
#define XCD_BAR_WORDS 3456
#define XB_SPIN_CAP (1u << 18)
__device__ __forceinline__ unsigned xb_ld(unsigned* p)              { return __hip_atomic_load(p, __ATOMIC_RELAXED, __HIP_MEMORY_SCOPE_AGENT); }
__device__ __forceinline__ unsigned xb_add(unsigned* p, unsigned v) { return __hip_atomic_fetch_add(p, v, __ATOMIC_RELAXED, __HIP_MEMORY_SCOPE_AGENT); }
__device__ __forceinline__ unsigned xb_xcc_id() { return (unsigned)__builtin_amdgcn_s_getreg((3 << 11) | 20) & 0xFu; }
#define XB_SPIN(cond, bar) do { unsigned _sp = 0; while (cond) { __builtin_amdgcn_s_sleep(1); \
    if ((++_sp & 255u) == 0u) { if (xb_ld(&(bar)[XB_TMO])) break; if (_sp > XB_SPIN_CAP) { atomicAdd(&(bar)[XB_TMO], 1u); break; } } } } while (0)
struct XcdBarrier { unsigned* bar; unsigned x; volatile LAS unsigned* st; };
__device__ __forceinline__ XcdBarrier xcd_barrier_post(unsigned* bar, volatile LAS unsigned* st) {
    XcdBarrier b; b.bar = bar; b.x = xb_xcc_id(); b.st = st;
    if (threadIdx.x == 0) (void)xb_add(&bar[XB_XCNT(b.x)], 1u);
    return b;
}
__device__ __forceinline__ void xcd_barrier_complete(unsigned* bar, unsigned x, unsigned& nloc, unsigned& nx) {
    const unsigned G = gridDim.x * gridDim.y * gridDim.z;
    unsigned sum, cnt, mine, sp = 0u;
    for (;;) {
        sum = 0u; cnt = 0u; mine = 0u;
#pragma unroll
        for (unsigned j = 0; j < 16; ++j) { const unsigned c = xb_ld(&bar[XB_XCNT(j)]); sum += c; cnt += (c > 0u) ? 1u : 0u; mine = (j == x) ? c : mine; }
        if (sum == G) break;
        __builtin_amdgcn_s_sleep(1);
        if ((++sp & 255u) == 0u) { if (xb_ld(&bar[XB_TMO])) break; if (sp > XB_SPIN_CAP) { atomicAdd(&bar[XB_TMO], 1u); break; } }
    }
    nloc = mine > 0u ? mine : 1u; nx = cnt > 0u ? cnt : 1u;
}
__device__ __forceinline__ void xcd_barrier(const XcdBarrier& b) {
    asm volatile("s_waitcnt vmcnt(0)" ::: "memory");
    __syncthreads();
    if (threadIdx.x == 0) {
        unsigned* bar = b.bar;
        __builtin_amdgcn_s_waitcnt(0);
        unsigned nloc = b.st[0], nx = b.st[1];
        if (nloc == 0u) { xcd_barrier_complete(bar, b.x, nloc, nx); b.st[0] = nloc; b.st[1] = nx; }
        const unsigned old = xb_add(&bar[XB_XSUB(b.x)], 1u);
        const unsigned gen = old / nloc;
        if (old + 1u == (gen + 1u) * nloc) {
            __builtin_amdgcn_fence(__ATOMIC_RELEASE, "agent");
            asm volatile("s_waitcnt vmcnt(0)" ::: "memory");
            const unsigned og = xb_add(&bar[XB_TOP], 1u);
            const unsigned tg = og / nx;
            if (og + 1u == (tg + 1u) * nx) xb_add(&bar[XB_TOPGEN], 1u);
            else XB_SPIN(xb_ld(&bar[XB_TOPGEN]) == tg, bar);
            __builtin_amdgcn_fence(__ATOMIC_ACQUIRE, "agent");
            xb_add(&bar[XB_XGEN(b.x)], 1u);
            asm volatile("s_waitcnt vmcnt(0)" ::: "memory");
        } else {
            XB_SPIN(xb_ld(&bar[XB_XGEN(b.x)]) == gen, bar);
            __builtin_amdgcn_fence(__ATOMIC_ACQUIRE, "agent");
            asm volatile("s_waitcnt vmcnt(0)" ::: "memory");
        }
    }
    __syncthreads();
}

#ifdef PROBE_L0
__global__ void __launch_bounds__(256) k_cmp2(const float* a, const float* b, size_t n, float* acc, int slot) {
    float num = 0.f, den = 0.f;
    for (size_t i = (size_t)blockIdx.x * 256 + threadIdx.x; i < n; i += (size_t)gridDim.x * 256) { const float x = a[i], y = b[i]; num += (x - y) * (x - y); den += y * y; }
    __shared__ float sn[256], sd[256]; sn[threadIdx.x] = num; sd[threadIdx.x] = den; __syncthreads();
    for (int s = 128; s > 0; s >>= 1) { if (threadIdx.x < s) { sn[threadIdx.x] += sn[threadIdx.x + s]; sd[threadIdx.x] += sd[threadIdx.x + s]; } __syncthreads(); }
    if (threadIdx.x == 0) { atomicAdd(&acc[slot], sn[0]); atomicAdd(&acc[4 + slot], sd[0]); }
}
__global__ void k_fin2(const float* acc, float* scale, int which) { float e = acc[which] / acc[4 + which]; if (!(e == e)) e = 1.f; scale[0] = 1.f + sqrtf(e) * 100.f; }
#endif
constexpr int LDS_TOTAL = 159744 + 64 + 256;
static_assert(ATT_LDS <= 159744, "attention LDS");
constexpr size_t NSLOT = (size_t)NB * NE * (CAP + CAPC);
constexpr int NPHASE = 2 + 11 * NL;
__global__ void __launch_bounds__(512, 2) k_mega(MP p) {
    extern __shared__ __attribute__((aligned(16))) unsigned char dynlds[];
    const ldsp lds = (ldsp)dynlds;
    const int bid0 = blockIdx.x, nblk0 = gridDim.x;

    volatile LAS unsigned* xbw = (volatile LAS unsigned*)(lds + 159744);
    if (threadIdx.x == 0) { xbw[0] = 0u; xbw[1] = 0u; xbw[2] = 0u; xbw[3] = 0u; }
    __syncthreads();
    const XcdBarrier bar = xcd_barrier_post(p.bar(), xbw);
    int g = 0;
#ifndef REP_MASK
#define REP_MASK 0
#endif
#define PH(kind, ...) if (g >= p.ph_lo() && g < p.ph_hi()) { int bid = bid0, nblk = nblk0; asm volatile("" : "+s"(bid), "+s"(nblk));     \
    __VA_ARGS__ if (((REP_MASK >> (kind)) & 1) && ((kind) != 5 || g < 13)) { xcd_barrier(bar); __VA_ARGS__ } if (g + 1 < p.ph_hi()) xcd_barrier(bar); } ++g;
#define bH (p.RA())
#define bO (p.RA())
#define bY (p.RA())
#define bQM (p.RC())
#define bKVM (p.RC() + (size_t)NROW * 384)
#define bMERGED (p.RC())
#define bH2 (p.RC())
#define bACT (p.Z())
#define bOUT (p.Z() + NSLOT * FF)
#define bXG (p.Z() + NSLOT * FF)
#define bWguT (p.Z() + 2 * NSLOT * FF)
#define bWdT (p.Z() + 2 * NSLOT * FF + (size_t)NE * 2048 * 1024)
    if ((REP_MASK >> 14) & 1) { for (int i = 0; i < 20; ++i) xcd_barrier(bar); }
    PH(12,
        ph_mod(lds, p, bid, nblk);
        ph_ropetab(p, bid, nblk);
        { PrepJob j{}; j.src = p.w_in(); j.dst = p.WinT(); j.K = D; j.Nsrc = INW; j.Ndst = ZWP; j.mode = 1; j.perm = 1; j.nz = NL; j.src_zs = (long long)D * INW; j.dst_zs = (long long)ZWP * D; ph_wprep(lds, j, bid, nblk); }
        { PrepJob j{}; j.src = p.w_qb(); j.kscale = p.mqn(); j.dst = p.WqT(); j.K = 192; j.Nsrc = 384; j.Ndst = 384; j.mode = 0; j.nz = NL; j.src_zs = 192 * 384; j.dst_zs = 384 * 192; j.ks_zs = 192; ph_wprep(lds, j, bid, nblk); }
        { PrepJob j{}; j.src = p.w_kvb(); j.kscale = p.mkvn(); j.dst = p.WkvT(); j.K = 128; j.Nsrc = 512; j.Ndst = 512; j.mode = 0; j.nz = NL; j.src_zs = 128 * 512; j.dst_zs = 512 * 128; j.ks_zs = 128; ph_wprep(lds, j, bid, nblk); }
        { PrepJob j{}; j.src = p.w_branch(); j.dst = p.WbT(); j.K = 256; j.Nsrc = 1024; j.Ndst = 1024; j.mode = 0; j.nz = NL * 4; j.src_zs = 256 * 1024; j.dst_zs = 1024 * 256; ph_wprep(lds, j, bid, nblk); }
        { PrepJob j{}; j.src = p.w_out(); j.dst = p.WoutT(); j.K = 1024; j.Nsrc = 1024; j.Ndst = 1024; j.mode = 0; j.perm = 1; j.nz = NL; j.src_zs = 1024 * 1024; j.dst_zs = 1024 * 1024; ph_wprep(lds, j, bid, nblk); }
    )
    PH(13, ph_lnmod0(p, bid, nblk);)
    for (int l = 0; l < NL; ++l) {
        const bool need_ctx = l + 1 < NL; const int mrows = need_ctx ? NROW : NLAT;
        PH(0, { InProj8S sc{}; sc.H = bH; sc.Wt = p.WinT() + (size_t)l * ZWP * D; sc.npm = NROW / 256; sc.bid = bid; sc.nblk = nblk; sc.nun = need_ctx ? 3300 : 3200 + 36;
                InProj8E ep{}; ep.Z = p.Z(); ep.SS = p.SS(); ep.gqn = p.gqn() + l * 64; ep.gkn = p.gkn() + l * 64; ep.tab64 = p.tab64(); ep.tab32 = p.tab32();
                pg8::gemm_phase<InProj8E, InProj8S, true, true>(lds, D, sc, ep); } )
        PH(1, { MlaProj pb{}; pb.Z = p.Z(); pb.WqT = p.WqT() + (size_t)l * 384 * 192; pb.WkvT = p.WkvT() + (size_t)l * 512 * 128; pb.QM = bQM; pb.KVM = bKVM; pb.SS = p.SS(); pb.tab32 = p.tab32(); pb.nlat = NLAT; pb.npm = NROW / 256;
                   gemm_run<128, false>(lds, pb, bid, nblk); } )
        PH(2, { AttnP ap{}; ap.Z = p.Z(); ap.QM = bQM; ap.KVM = bKVM; ap.O = bO; ap.rpb = p.na_rpb() + (size_t)l * 4 * 15 * 31; ap.sink = p.swa_sink() + l * 4; ap.nlat = NLAT; ap.need_ctx = need_ctx ? 1 : 0; ap.o32 = (l == 0) ? p.o32() : nullptr; ap.fake = 0;
#ifdef PROBE_F
                   if (l == 0) { ap.fake = PROBE_F; attn_phase(lds, ap, bid, nblk); ap.fake = 0; ap.o32 = nullptr; }
#endif
                   attn_phase(lds, ap, bid, nblk); } )
        PH(3, { MergeProb pb{}; pb.O = bO; pb.WbT = p.WbT() + (size_t)l * 4 * 1024 * 256; pb.Z = p.Z(); pb.MERGED = bMERGED; pb.npm = mrows / 256; gemm_run<128, true>(lds, pb, bid, nblk); } )
        PH(4, { Plain8S sc{}; sc.A = bMERGED; sc.Bt = p.WoutT() + (size_t)l * D * D; sc.npm = mrows / 256; sc.npn = 4; sc.K = D; sc.bid = bid; sc.nblk = nblk; Plain8E ep{}; ep.C = bY; ep.ldc = D;
                pg8::gemm_phase<Plain8E, Plain8S, true, true>(lds, D, sc, ep); } )
        PH(5, ph_lnres(lds, p, l, mrows, bid, nblk); )
        PH(6,
            ph_topk(lds, p, need_ctx ? 2 : 1, bid, nblk);
            { PrepJob j{}; j.src = p.w_gate() + (size_t)l * NE * D * FF; j.src2 = p.w_up() + (size_t)l * NE * D * FF; j.dst = bWguT; j.K = 1024; j.Nsrc = 1024; j.Ndst = 2048; j.mode = 2; j.perm = 1; j.nz = NE; j.src_zs = (long long)D * FF; j.dst_zs = (long long)2048 * 1024; ph_wprep(lds, j, bid, nblk); }
            { PrepJob j{}; j.src = p.w_down() + (size_t)l * NE * FF * D; j.dst = bWdT; j.K = 1024; j.Nsrc = 1024; j.Ndst = 1024; j.mode = 0; j.perm = 1; j.nz = NE; j.src_zs = (long long)FF * D; j.dst_zs = (long long)1024 * 1024; ph_wprep(lds, j, bid, nblk); }
        )
        PH(10, ph_gather(bH2, p.IDX(), bXG, need_ctx ? (int)NSLOT : CTXB, bid, nblk); )
        PH(7, { FfnUp8S sc{}; sc.XG = bXG; sc.WguT = bWguT; sc.nun = 2048 + (need_ctx ? 128 : 0); sc.bid = bid; sc.nblk = nblk; FfnUp8E ep{}; ep.ACT = bACT;
                pg8::gemm_phase<FfnUp8E, FfnUp8S, true, true>(lds, D, sc, ep); } )
        PH(8, { FfnDown8S sc{}; sc.ACT = bACT; sc.WdT = bWdT; sc.nun = 1024 + (need_ctx ? 64 : 0); sc.bid = bid; sc.nblk = nblk; FfnDown8E ep{}; ep.GATEV = p.GATEV(); ep.OUT = bOUT;
                pg8::gemm_phase<FfnDown8E, FfnDown8S, true, true>(lds, FF, sc, ep); } )
        PH(9, ph_combine(p, l, mrows, bOUT, bid, nblk); )
    }
#undef PH
#undef bH
#undef bO
#undef bY
#undef bQM
#undef bKVM
#undef bMERGED
#undef bH2
#undef bACT
#undef bOUT
#undef bXG
#undef bWguT
#undef bWdT
}
}

extern "C" void kernel_launch(void* const* d_in, const int* in_sizes, int n_in, void* d_out, int out_size, void* d_ws, size_t ws_size, hipStream_t stream) {
    MP p; memset(&p, 0, sizeof(p));
    p.x_ = (const float*)d_in[0]; p.c_ = (const float*)d_in[1]; p.ctx_ = (const float*)d_in[2]; p.c_ctx_ = (const float*)d_in[3];
    p.w_mod_ = (const float*)d_in[4]; p.b_mod_ = (const float*)d_in[5]; p.w_in_ = (const float*)d_in[6]; p.na_rpb_ = (const float*)d_in[7];
    p.gqn_ = (const float*)d_in[8]; p.gkn_ = (const float*)d_in[9]; p.swa_sink_ = (const float*)d_in[10];
    p.mqn_ = (const float*)d_in[11]; p.mkvn_ = (const float*)d_in[12]; p.w_qb_ = (const float*)d_in[13]; p.w_kvb_ = (const float*)d_in[14];
    p.w_branch_ = (const float*)d_in[15]; p.w_out_ = (const float*)d_in[16];
    p.ln1g_ = (const float*)d_in[17]; p.ln1b_ = (const float*)d_in[18]; p.ln2g_ = (const float*)d_in[19]; p.ln2b_ = (const float*)d_in[20];
    p.w_router_ = (const float*)d_in[21]; p.w_gate_ = (const float*)d_in[22]; p.w_up_ = (const float*)d_in[23]; p.w_down_ = (const float*)d_in[24];
    p.out_ = (float*)d_out;
    char* ws = (char*)d_ws; size_t off = OFF_END;
    auto carve = [&](size_t bytes) { void* q = ws + off; off += (bytes + 255) & ~(size_t)255; return q; }; (void)carve;
    p.ws_ = ws;
    if (off > ws_size || 2 * NSLOT * FF + (size_t)NE * 3072 * 1024 > (size_t)NROW * ZW) { fprintf(stderr, "workspace too small: need %zu have %zu\n", off, ws_size); return; }
    static int grid = 0;
    if (!grid) {
        int dev = 0, cus = 0, per_cu = 0;
        (void)hipGetDevice(&dev);
        (void)hipDeviceGetAttribute(&cus, hipDeviceAttributeMultiprocessorCount, dev);
        (void)hipFuncSetAttribute((const void*)k_mega, hipFuncAttributeMaxDynamicSharedMemorySize, LDS_TOTAL);
        (void)hipOccupancyMaxActiveBlocksPerMultiprocessor(&per_cu, (const void*)k_mega, 512, LDS_TOTAL);
        grid = per_cu >= 1 ? cus : 0;
        if (grid > 256) grid = 256;
    }
    if (!grid) { fprintf(stderr, "k_mega cannot be resident\n"); return; }
    (void)hipMemsetAsync(ws + OFF_BAR, 0, XCD_BAR_WORDS * 4, stream);
#ifdef PROBE_L0
    {
        float* save_xc = (float*)carve((size_t)NCTX * D * 4); float* save_x = (float*)carve((size_t)2048 * D * 4); float* pacc = (float*)carve(256); float* pscl = (float*)carve(256);
        if (off > ws_size) { fprintf(stderr, "probe workspace\n"); return; }
        nv::nv_layer0(d_in, d_out, d_ws, ws_size, stream, save_xc, save_x);
        (void)hipMemsetAsync(ws + OFF_BAR, 0, XCD_BAR_WORDS * 4, stream);
        (void)hipMemsetAsync(pacc, 0, 256, stream);
        p.pscale_ = pscl;
        p.ph_lo_ = 0; p.ph_hi_ = 2 + (NPHASE - 2) / NL;
        hipLaunchKernelGGL(k_mega, dim3(grid), dim3(512), LDS_TOTAL, stream, p);
        hipLaunchKernelGGL(k_cmp2, dim3(256), dim3(256), 0, stream, (const float*)(ws + OFF_XCB), (const float*)save_xc, (size_t)NCTX * D, pacc, 0);
        for (int b = 0; b < NB; ++b) hipLaunchKernelGGL(k_cmp2, dim3(256), dim3(256), 0, stream, (const float*)d_out + (size_t)b * SEQ * D, (const float*)save_x + (size_t)b * 512 * D, (size_t)512 * D, pacc, 1);
        hipLaunchKernelGGL(k_fin2, dim3(1), dim3(1), 0, stream, pacc, pscl, (int)PROBE_L0);
        (void)hipMemsetAsync(ws + OFF_BAR, 0, XCD_BAR_WORDS * 4, stream);
        p.ph_lo_ = 2 + (NPHASE - 2) / NL; p.ph_hi_ = NPHASE;
        hipLaunchKernelGGL(k_mega, dim3(grid), dim3(512), LDS_TOTAL, stream, p);
    }
#elif defined(PROBE_ATTN)
    {
        float* O32 = (float*)carve((size_t)2304 * D * 4); float* O2 = (float*)carve((size_t)2304 * D * 4); float* pacc = (float*)carve(256); float* pscl = (float*)carve(256);
        if (off > ws_size) { fprintf(stderr, "probe workspace\n"); return; }
        p.o32_ = O32; p.pscale_ = pscl;
        (void)hipMemsetAsync(pacc, 0, 256, stream);
        p.ph_lo_ = 0; p.ph_hi_ = 5;
        hipLaunchKernelGGL(k_mega, dim3(grid), dim3(512), LDS_TOTAL, stream, p);
        AttnArgs a{}; a.Z = (const T*)(ws + OFF_Z); a.QM = (const T*)(ws + OFF_RC); a.KVM = (const T*)(ws + OFF_RC) + (size_t)NROW * 384; a.O2 = O2; a.rpb = p.na_rpb_; a.sink = p.swa_sink_; a.P.nbp = NB; a.P.b0 = 0; a.P.nlat = NLAT; a.P.nctx = NCTX; a.P.nrow = NROW; a.bl0 = 1;
        a.ctxq = 0; { dim3 g(8, 4, 1); hipLaunchKernelGGL(k_attn_naive<0>, g, dim3(256), 0, stream, a); hipLaunchKernelGGL(k_attn_naive<1>, g, dim3(256), 0, stream, a);
                      hipLaunchKernelGGL(k_attn_naive<2>, g, dim3(256), 0, stream, a); hipLaunchKernelGGL(k_attn_naive<3>, g, dim3(256), 0, stream, a); }
        a.ctxq = 1; { dim3 g(1, 4, 1); hipLaunchKernelGGL(k_attn_naive<0>, g, dim3(256), 0, stream, a); hipLaunchKernelGGL(k_attn_naive<1>, g, dim3(256), 0, stream, a);
                      hipLaunchKernelGGL(k_attn_naive<2>, g, dim3(256), 0, stream, a); hipLaunchKernelGGL(k_attn_naive<3>, g, dim3(256), 0, stream, a); }
        hipLaunchKernelGGL(k_probe_cmp, dim3(64, 4), dim3(256), 0, stream, O32, O2, pacc, 2304);
        hipLaunchKernelGGL(k_probe_fin, dim3(1), dim3(1), 0, stream, pacc, pscl, (int)PROBE_ATTN);
        (void)hipMemsetAsync(ws + OFF_BAR, 0, XCD_BAR_WORDS * 4, stream);
        p.ph_lo_ = 5; p.ph_hi_ = NPHASE;
        hipLaunchKernelGGL(k_mega, dim3(grid), dim3(512), LDS_TOTAL, stream, p);
    }
#elif defined(PROBE_T)
    {
        float* pscl = (float*)carve(256);
        if (off > ws_size) { fprintf(stderr, "probe workspace\n"); return; }
        p.o32_ = pscl; p.pscale_ = pscl;
        p.ph_lo_ = 0; p.ph_hi_ = NPHASE;
        hipLaunchKernelGGL(k_mega, dim3(grid), dim3(512), LDS_TOTAL, stream, p);
    }
#elif !defined(MK_SPLIT)
    p.ph_lo_ = 0; p.ph_hi_ = NPHASE;
    hipLaunchKernelGGL(k_mega, dim3(grid), dim3(512), LDS_TOTAL, stream, p);
#else
    for (int g = 0; g < NPHASE; ++g) { p.ph_lo_ = g; p.ph_hi_ = g + 1; hipLaunchKernelGGL(k_mega, dim3(grid), dim3(512), LDS_TOTAL, stream, p); }
#endif
}
```

```cpp
#include <hip/hip_runtime.h>
#include <hip/hip_bf16.h>
#include <stdint.h>
#include <stdio.h>
#include <string.h>

namespace {
constexpr int D = 1024, SEQ = 8192, CTX = 256, NB = 4, NL = 2, HD = 64;
constexpr int GW = 64, GROWS = 128;
constexpr int INW = 6240;
constexpr int ZW = 6240;
constexpr int NAQ = 0, NAK = 256, NAV = 512, GQ = 768, GK = 1024, GV = 1152, SQ = 1280, SK = 1536, SV = 1664,
              MCQ = 1792, MCKV = 1984, MKR = 2112, GATE = 2144;
constexpr int NE = 16, FF = 1024, CAP = 1024, CAPC = 32;
constexpr int MODW = 6 * D;
constexpr float EPS = 1e-6f;
constexpr float ALPHA = 1.4142135623730951f;
constexpr int NLAT = NB * SEQ, NCTX = NB * CTX, NROW = NLAT + NCTX;

struct T {
    unsigned short u;
    __device__ __forceinline__ operator float() const { return __uint_as_float((unsigned)u << 16); }
    __device__ __forceinline__ T& operator=(float f) { unsigned b = __float_as_uint(f); b += 0x7fffu + ((b >> 16) & 1u); u = (unsigned short)(b >> 16); return *this; }
};
__device__ __forceinline__ float4 ld4(const float* p) { return *(const float4*)p; }
__device__ __forceinline__ float4 ld4(const T* p) { uint2 r = *(const uint2*)p; return make_float4(__uint_as_float(r.x << 16), __uint_as_float(r.x & 0xffff0000u), __uint_as_float(r.y << 16), __uint_as_float(r.y & 0xffff0000u)); }
__device__ __forceinline__ unsigned pk2(float lo, float hi) { T a, b; a = lo; b = hi; return (unsigned)a.u | ((unsigned)b.u << 16); }
__device__ __forceinline__ void st4(float* p, float4 v) { *(float4*)p = v; }
__device__ __forceinline__ void st4(T* p, float4 v) { *(uint2*)p = make_uint2(pk2(v.x, v.y), pk2(v.z, v.w)); }

__device__ __forceinline__ int otid() { int t = threadIdx.x; asm volatile("" : "+v"(t)); return t; }
__device__ __forceinline__ int xswz(int u, int n) { const int c = u & 7, s = u >> 3, q = n >> 3, rr = n & 7; return (c < rr ? c * (q + 1) : rr * (q + 1) + (c - rr) * q) + s; }
#define DPP_ADD(v, ctrl) ((v) + __builtin_bit_cast(float, __builtin_amdgcn_update_dpp(0, __builtin_bit_cast(int, (v)), (ctrl), 0xf, 0xf, true)))
__device__ __forceinline__ float wave_sum(float v) {
    v = DPP_ADD(v, 0xB1);
    v = DPP_ADD(v, 0x4E);
    v = DPP_ADD(v, 0x141);
    v = DPP_ADD(v, 0x140);
    const int iv = __builtin_bit_cast(int, v);
    const float r0 = __builtin_bit_cast(float, __builtin_amdgcn_readlane(iv, 0)), r1 = __builtin_bit_cast(float, __builtin_amdgcn_readlane(iv, 16)),
                r2 = __builtin_bit_cast(float, __builtin_amdgcn_readlane(iv, 32)), r3 = __builtin_bit_cast(float, __builtin_amdgcn_readlane(iv, 48));
    return (r0 + r1) + (r2 + r3);
}

typedef short bf16x8 __attribute__((ext_vector_type(8)));
typedef float f32x4 __attribute__((ext_vector_type(4)));
#define LAS __attribute__((address_space(3)))
typedef LAS unsigned char* ldsp;
constexpr int ZWP = 6400;

__device__ __forceinline__ float fast_rsqrt(float x) { return __builtin_amdgcn_rsqf(x); }
__device__ __forceinline__ float fast_sigmoid(float x) { return __builtin_amdgcn_rcpf(1.f + __builtin_amdgcn_exp2f(-1.4426950408889634f * x)); }
__device__ __forceinline__ float fast_silu(float x) { return x * fast_sigmoid(x); }
__device__ __forceinline__ uint2 pk4(float a, float b, float c, float d) { return make_uint2(pk2(a, b), pk2(c, d)); }

#define GLDS16(gp, lp) __builtin_amdgcn_global_load_lds((const unsigned*)(gp), (LAS unsigned*)(lp), 16, 0, 0)
template <int BN, bool HAS_SUM, class Prob>
__device__ __forceinline__ void gemm_run(ldsp lds, const Prob& pb, int bid, int nblk) {
    constexpr int NF = BN / 64, GLB = BN / 64, A_BYTES = 32768, B_BYTES = BN * 128, STAGE = A_BYTES + B_BYTES, NSTG = (BN == 128) ? 3 : 2, NGL = 4 + GLB;
    const int tid = otid(), wid = __builtin_amdgcn_readfirstlane(tid >> 6), lane = tid & 63, wr = wid >> 2, wc = wid & 3, fr = lane & 15, fq = lane >> 4;
    const int NU = pb.nunits();
    if (bid >= NU) return;
    const int sb = lane * 16, swz = sb ^ (((sb >> 9) & 1) << 5);
    const int sR0 = (wid >> 1) * 16 + (swz >> 6), sC = (wid & 1) * 32 + ((swz & 63) >> 1);
    const int ob = fr * 64 + fq * 16, lane_off = ob ^ (((ob >> 9) & 1) << 5);
    const unsigned ldsw = (unsigned)wid * 1024u;
    unsigned aoff[4], boff[GLB];
    int su = bid, st = 0, snt = pb.ntiles(su), sbuf = 0, inflight = 0;
#define G_LOAD_OFFS() do { _Pragma("unroll") for (int i = 0; i < 4; ++i) aoff[i] = pb.a_off(su, sR0 + 64 * i) + sC; \
                           _Pragma("unroll") for (int i = 0; i < GLB; ++i) boff[i] = pb.b_off(su, sR0 + 64 * i) + sC; } while (0)
#define G_STAGE() do { if (su < NU) { const T* Ab = pb.a_base(su, st); const T* Bb = pb.b_base(su, st); ldsp sbase = lds + sbuf * STAGE + ldsw; \
        _Pragma("unroll") for (int i = 0; i < 4; ++i) GLDS16(Ab + aoff[i], sbase + i * 8192); \
        _Pragma("unroll") for (int i = 0; i < GLB; ++i) GLDS16(Bb + boff[i], sbase + A_BYTES + i * 8192); \
        ++inflight; sbuf = (sbuf + 1 == NSTG) ? 0 : sbuf + 1; \
        if (++st == snt) { su += nblk; st = 0; if (su < NU) { snt = pb.ntiles(su); G_LOAD_OFFS(); } } } } while (0)
    G_LOAD_OFFS();
    G_STAGE();
    if (NSTG == 3) G_STAGE();
    int buf = 0;
    for (int cu = bid; cu < NU; cu += nblk) {
        f32x4 acc[8][NF]; f32x4 sum[HAS_SUM ? 8 : 1][HAS_SUM ? NF : 1]; uint2 gpre[HAS_SUM ? 8 : 1][HAS_SUM ? NF : 1];
#pragma unroll
        for (int m = 0; m < 8; ++m)
#pragma unroll
            for (int n = 0; n < NF; ++n) { acc[m][n] = (f32x4){0.f, 0.f, 0.f, 0.f}; if (HAS_SUM) sum[m][n] = (f32x4){0.f, 0.f, 0.f, 0.f}; }
        const int nt = pb.ntiles(cu);
        for (int t = 0; t < nt; ++t) {
            if (NSTG == 3) {
                if constexpr (HAS_SUM) { if (inflight >= 2) { if (pb.extra_inflight(t)) asm volatile("s_waitcnt vmcnt(%0)" :: "n"(NGL + 16) : "memory"); else asm volatile("s_waitcnt vmcnt(%0)" :: "n"(NGL) : "memory"); }
                                         else asm volatile("s_waitcnt vmcnt(0)" ::: "memory"); }
                else { if (inflight >= 2) asm volatile("s_waitcnt vmcnt(%0)" :: "n"(NGL) : "memory"); else asm volatile("s_waitcnt vmcnt(0)" ::: "memory"); }
                asm volatile("s_waitcnt lgkmcnt(0)\n\ts_barrier" ::: "memory");
            } else {
                asm volatile("s_waitcnt vmcnt(0)" ::: "memory");
                __syncthreads();
            }
            if constexpr (!(NF == 2 && HAS_SUM)) G_STAGE();
            if constexpr (HAS_SUM) pb.tile_begin(cu, t, gpre, wr, wc, fr, fq);
            const ldsp ta = lds + buf * STAGE + wr * 16384 + lane_off, tb = lds + buf * STAGE + A_BYTES + wc * (NF * 2048) + lane_off;
            if constexpr (NF == 2 && HAS_SUM) {
                const unsigned ta_ = (unsigned)(size_t)ta, tb_ = (unsigned)(size_t)tb;
                bf16x8 a0, a1, a2, a3, a4, a5, a6, a7, b0, b1;
#define G_RD(dst, addr, OFF) asm volatile("ds_read_b128 %0, %1 offset:" #OFF : "=v"(dst) : "v"(addr))
#define G_MM(m, av) do { acc[m][0] = __builtin_amdgcn_mfma_f32_16x16x32_bf16(b0, av, acc[m][0], 0, 0, 0); acc[m][1] = __builtin_amdgcn_mfma_f32_16x16x32_bf16(b1, av, acc[m][1], 0, 0, 0); } while (0)
                const bool g_on = su < NU; const T* gAb = pb.a_base(g_on ? su : cu, st); const T* gBb = pb.b_base(g_on ? su : cu, st); const ldsp gsb = lds + sbuf * STAGE + ldsw;
                G_RD(a0, ta_, 0); G_RD(a1, ta_, 2048); G_RD(a2, ta_, 4096); G_RD(a3, ta_, 6144); G_RD(b0, tb_, 0); G_RD(b1, tb_, 2048);
                if (g_on) { GLDS16(gAb + aoff[0], gsb); GLDS16(gAb + aoff[1], gsb + 8192); }
                asm volatile("s_waitcnt lgkmcnt(0)" : "+v"(a0), "+v"(a1), "+v"(a2), "+v"(a3), "+v"(b0), "+v"(b1));
                __builtin_amdgcn_sched_barrier(0);
                G_RD(a4, ta_, 8192); G_RD(a5, ta_, 10240); G_RD(a6, ta_, 12288); G_RD(a7, ta_, 14336);
                G_MM(0, a0); G_MM(1, a1); G_MM(2, a2); G_MM(3, a3);
                __builtin_amdgcn_sched_barrier(0);
                if (g_on) { GLDS16(gAb + aoff[2], gsb + 2 * 8192); GLDS16(gAb + aoff[3], gsb + 3 * 8192); }
                asm volatile("s_waitcnt lgkmcnt(0)" : "+v"(a4), "+v"(a5), "+v"(a6), "+v"(a7));
                __builtin_amdgcn_sched_barrier(0);
                bf16x8 c0, c1, c2, c3, d0, d1;
                G_RD(c0, ta_, 1024); G_RD(c1, ta_, 3072); G_RD(c2, ta_, 5120); G_RD(c3, ta_, 7168); G_RD(d0, tb_, 1024); G_RD(d1, tb_, 3072);
                G_MM(4, a4); G_MM(5, a5); G_MM(6, a6); G_MM(7, a7);
                __builtin_amdgcn_sched_barrier(0);
                if (g_on) { GLDS16(gBb + boff[0], gsb + A_BYTES); GLDS16(gBb + boff[1], gsb + A_BYTES + 8192);
                            ++inflight; sbuf = (sbuf + 1 == NSTG) ? 0 : sbuf + 1;
                            if (++st == snt) { su += nblk; st = 0; if (su < NU) { snt = pb.ntiles(su); G_LOAD_OFFS(); } } }
                asm volatile("s_waitcnt lgkmcnt(0)" : "+v"(c0), "+v"(c1), "+v"(c2), "+v"(c3), "+v"(d0), "+v"(d1));
                __builtin_amdgcn_sched_barrier(0);
                b0 = d0; b1 = d1;
                G_RD(a4, ta_, 9216); G_RD(a5, ta_, 11264); G_RD(a6, ta_, 13312); G_RD(a7, ta_, 15360);
                G_MM(0, c0); G_MM(1, c1); G_MM(2, c2); G_MM(3, c3);
                __builtin_amdgcn_sched_barrier(0);
                asm volatile("s_waitcnt lgkmcnt(0)" : "+v"(a4), "+v"(a5), "+v"(a6), "+v"(a7));
                __builtin_amdgcn_sched_barrier(0);
                G_MM(4, a4); G_MM(5, a5); G_MM(6, a6); G_MM(7, a7);
                __builtin_amdgcn_sched_barrier(0);
#undef G_RD
#undef G_MM
            } else {
#pragma unroll
            for (int ks = 0; ks < 2; ++ks) {
                bf16x8 At[8], Bf[NF];
#pragma unroll
                for (int m = 0; m < 8; ++m) At[m] = *(const LAS bf16x8*)(ta + m * 2048 + ks * 1024);
#pragma unroll
                for (int n = 0; n < NF; ++n) Bf[n] = *(const LAS bf16x8*)(tb + n * 2048 + ks * 1024);
#pragma unroll
                for (int m = 0; m < 8; ++m)
#pragma unroll
                    for (int n = 0; n < NF; ++n) acc[m][n] = __builtin_amdgcn_mfma_f32_16x16x32_bf16(Bf[n], At[m], acc[m][n], 0, 0, 0);
            }
            }
            if constexpr (HAS_SUM) pb.tile_done(cu, t, acc, sum, gpre, wr, wc, fr, fq);
            --inflight; buf = (buf + 1 == NSTG) ? 0 : buf + 1;
        }
        if constexpr (HAS_SUM) pb.epilogue(cu, sum, wr, wc, fr, fq); else pb.epilogue(cu, acc, wr, wc, fr, fq);
    }
    asm volatile("s_waitcnt vmcnt(0) lgkmcnt(0)\n\ts_barrier" ::: "memory");
#undef G_LOAD_OFFS
#undef G_STAGE
}

struct InProj {
    const T* H; const T* Wt; T* Z; float* SS; const float* gqn; const float* gkn; const float2* tab64; const float2* tab32; int nlat, npm;
    __device__ __forceinline__ int nunits() const { return npm * 25; }
    __device__ __forceinline__ int ntiles(int) const { return 16; }
    __device__ __forceinline__ unsigned a_off(int u, int R) const { return (unsigned)((u / 25) * 256 + R) * 1024u; }
    __device__ __forceinline__ unsigned b_off(int u, int R) const { return (unsigned)((u % 25) * 256 + R) * 1024u; }
    __device__ __forceinline__ const T* a_base(int, int t) const { return H + t * 64; }
    __device__ __forceinline__ const T* b_base(int, int t) const { return Wt + t * 64; }
    __device__ __forceinline__ void epilogue(int u, f32x4 (&acc)[8][4], int wr, int wc, int fr, int fq) const {
        const int pm = u / 25, pn = u % 25, cg = pn * 4 + wc;
        if (cg == 34 || cg == 35) return;
        const int row0 = pm * 256 + wr * 128 + fr;
        const bool lat = pm * 256 < nlat;
        const int zcol = (cg < 36 ? cg * 64 : 2144 + (cg - 36) * 64) + fq * 4;
        const bool t_rms = (cg >= 12 && cg < 18), t_rope = t_rms || (cg >= 20 && cg < 26), t_ssq = (cg >= 28 && cg < 33), t_kr = cg == 33, t_sig = cg >= 36;
        float4 gv[4];
        if (t_rms) { const float* g = cg < 16 ? gqn : gkn;
#pragma unroll
            for (int n = 0; n < 4; ++n) gv[n] = *(const float4*)(g + n * 16 + fq * 4); }
#pragma unroll
        for (int m = 0; m < 8; ++m) {
            const int row = row0 + m * 16;
            const int t = row & (SEQ - 1), gr = t >> 6, gc = t & 63;
            float v[4][4];
#pragma unroll
            for (int n = 0; n < 4; ++n)
#pragma unroll
                for (int j = 0; j < 4; ++j) v[n][j] = acc[m][n][j];
            T* zp = Z + (size_t)row * ZW + zcol;
            if (t_rms || t_ssq) {
                float ss = 0.f;
#pragma unroll
                for (int n = 0; n < 4; ++n)
#pragma unroll
                    for (int j = 0; j < 4; ++j) ss += v[n][j] * v[n][j];
                ss += __shfl_xor(ss, 16); ss += __shfl_xor(ss, 32);
                if (t_ssq) { if (fq == 0) SS[(size_t)row * 8 + (cg - 28)] = ss; }
                else { const float rstd = 1.f / sqrtf(ss * (1.f / 64.f) + EPS);
#pragma unroll
                    for (int n = 0; n < 4; ++n) { v[n][0] *= rstd * gv[n].x; v[n][1] *= rstd * gv[n].y; v[n][2] *= rstd * gv[n].z; v[n][3] *= rstd * gv[n].w; } }
            }
            if (t_rope && lat) {
                const float4* tr = (const float4*)(tab64 + gr * 16 + fq * 4); const float4* tc = (const float4*)(tab64 + gc * 16 + fq * 4);
                const float4 r0 = tr[0], r1 = tr[1], c0 = tc[0], c1 = tc[1];
                const float rc[4] = {r0.x, r0.z, r1.x, r1.z}, rs[4] = {r0.y, r0.w, r1.y, r1.w}, cc[4] = {c0.x, c0.z, c1.x, c1.z}, cs[4] = {c0.y, c0.w, c1.y, c1.w};
#pragma unroll
                for (int j = 0; j < 4; ++j) {
                    const float a0 = v[0][j], a1 = v[1][j], b0 = v[2][j], b1 = v[3][j];
                    v[0][j] = a0 * rc[j] - a1 * rs[j]; v[1][j] = a0 * rs[j] + a1 * rc[j];
                    v[2][j] = b0 * cc[j] - b1 * cs[j]; v[3][j] = b0 * cs[j] + b1 * cc[j];
                }
            }
            if (t_kr) {
#pragma unroll
                for (int n = 0; n < 2; ++n) {
                    const float4* tp = (const float4*)(tab32 + (n == 0 ? gr : gc) * 8 + (fq & 1) * 4);
                    const float4 q0 = tp[0], q1 = tp[1];
                    const float kc[4] = {q0.x, q0.z, q1.x, q1.z}, ks[4] = {q0.y, q0.w, q1.y, q1.w};
#pragma unroll
                    for (int j = 0; j < 4; ++j) { const float x = v[n][j], px = __shfl_xor(x, 32); if (lat) v[n][j] = (fq < 2) ? (x * kc[j] - px * ks[j]) : (px * ks[j] + x * kc[j]); }
                    *(uint2*)(zp + n * 16) = pk4(v[n][0], v[n][1], v[n][2], v[n][3]);
                }
                continue;
            }
            if (t_sig) {
#pragma unroll
                for (int n = 0; n < 4; ++n)
#pragma unroll
                    for (int j = 0; j < 4; ++j) v[n][j] = fast_sigmoid(v[n][j]);
            }
#pragma unroll
            for (int n = 0; n < 4; ++n) *(uint2*)(zp + n * 16) = pk4(v[n][0], v[n][1], v[n][2], v[n][3]);
        }
    }
};

struct MlaProj {
    const T* Z; const T* WqT; const T* WkvT; T* QM; T* KVM; const float* SS; const float2* tab32; int nlat, npm;
    __device__ __forceinline__ int nunits() const { return npm * 7; }
    __device__ __forceinline__ int ntiles(int u) const { return u < npm * 3 ? 3 : 2; }
    __device__ __forceinline__ unsigned a_off(int u, int R) const { const int pm = u < npm * 3 ? u / 3 : (u - npm * 3) / 4; return (unsigned)(pm * 256 + R) * (unsigned)ZW; }
    __device__ __forceinline__ unsigned b_off(int u, int R) const { return u < npm * 3 ? (unsigned)((u % 3) * 128 + R) * 192u : (unsigned)(((u - npm * 3) % 4) * 128 + R) * 128u; }
    __device__ __forceinline__ const T* a_base(int u, int t) const { return Z + (u < npm * 3 ? MCQ : MCKV) + t * 64; }
    __device__ __forceinline__ const T* b_base(int u, int t) const { return (u < npm * 3 ? WqT : WkvT) + t * 64; }
    __device__ __forceinline__ void epilogue(int u, f32x4 (&acc)[8][2], int wr, int wc, int fr, int fq) const {
        const bool isq = u < npm * 3;
        const int pm = isq ? u / 3 : (u - npm * 3) / 4, pn = isq ? u % 3 : (u - npm * 3) % 4;
        const int row0 = pm * 256 + wr * 128 + fr;
        const bool lat = pm * 256 < nlat;
#pragma unroll
        for (int m = 0; m < 8; ++m) {
            const int row = row0 + m * 16;
            const float* ss = SS + (size_t)row * 8;
            const float rstd = isq ? 1.f / sqrtf((ss[0] + ss[1] + ss[2]) * (1.f / 192.f) + EPS) : 1.f / sqrtf((ss[3] + ss[4]) * (1.f / 128.f) + EPS);
            const int t = row & (SEQ - 1), gr = t >> 6, gc = t & 63;
#pragma unroll
            for (int n = 0; n < 2; ++n) {
                float v[4];
#pragma unroll
                for (int j = 0; j < 4; ++j) v[j] = acc[m][n][j] * rstd;
                const int f = pn * 8 + wc * 2 + n;
                if (isq) {
                    const int part = f % 6;
                    if (part >= 4) {
                        const float4* tp = (const float4*)(tab32 + (part == 4 ? gr : gc) * 8 + (fq & 1) * 4);
                        const float4 q0 = tp[0], q1 = tp[1];
                        const float kc[4] = {q0.x, q0.z, q1.x, q1.z}, ks[4] = {q0.y, q0.w, q1.y, q1.w};
#pragma unroll
                        for (int j = 0; j < 4; ++j) { const float x = v[j], px = __shfl_xor(x, 32); if (lat) v[j] = (fq < 2) ? (x * kc[j] - px * ks[j]) : (px * ks[j] + x * kc[j]); }
                    }
                    *(uint2*)(QM + (size_t)row * 384 + f * 16 + fq * 4) = pk4(v[0], v[1], v[2], v[3]);
                } else {
                    *(uint2*)(KVM + (size_t)row * 512 + f * 16 + fq * 4) = pk4(v[0], v[1], v[2], v[3]);
                }
            }
        }
    }
};

struct MergeProb {
    const T* O; const T* WbT; const T* Z; T* MERGED; int npm;
    __device__ __forceinline__ int nunits() const { return npm * 8; }
    __device__ __forceinline__ int ntiles(int) const { return 16; }
    __device__ __forceinline__ unsigned a_off(int u0, int R) const { const int u = xswz(u0, npm * 8); return (unsigned)((u >> 3) * 256 + R) * 1024u; }
    __device__ __forceinline__ unsigned b_off(int u0, int R) const { const int u = xswz(u0, npm * 8); return (unsigned)((u & 7) * 128 + R) * 256u; }
    __device__ __forceinline__ const T* a_base(int, int t) const { return O + (t >> 2) * 256 + (t & 3) * 64; }
    __device__ __forceinline__ const T* b_base(int, int t) const { return WbT + (size_t)(t >> 2) * 1024 * 256 + (t & 3) * 64; }
    __device__ __forceinline__ void tile_begin(int u0, int t, uint2 (&gpre)[8][2], int wr, int wc, int fr, int fq) const {
        if ((t & 3) != 0) return;
        const int u = xswz(u0, npm * 8); const int i = t >> 2, pm = u >> 3, pn = u & 7;
        const T* gp = Z + (size_t)(pm * 256 + wr * 128 + fr) * ZW + GATE + i * 1024 + pn * 128 + wc * 32 + fq * 4;
#pragma unroll
        for (int m = 0; m < 8; ++m)
#pragma unroll
            for (int n = 0; n < 2; ++n) { const T* q_ = gp + (size_t)m * 16 * ZW + n * 16; asm volatile("global_load_dwordx2 %0, %1, off" : "=v"(gpre[m][n]) : "v"(q_)); }
    }
    __device__ __forceinline__ int extra_inflight(int t) const { return ((t & 3) == 1) ? 16 : 0; }
    __device__ __forceinline__ void tile_done(int u, int t, f32x4 (&acc)[8][2], f32x4 (&sum)[8][2], uint2 (&gpre)[8][2], int wr, int wc, int fr, int fq) const {
        if ((t & 3) != 3) return;
#pragma unroll
        for (int m = 0; m < 8; ++m)
#pragma unroll
            for (int n = 0; n < 2; ++n) {
                const uint2 r = gpre[m][n];
                sum[m][n][0] += __uint_as_float(r.x << 16) * acc[m][n][0]; sum[m][n][1] += __uint_as_float(r.x & 0xffff0000u) * acc[m][n][1];
                sum[m][n][2] += __uint_as_float(r.y << 16) * acc[m][n][2]; sum[m][n][3] += __uint_as_float(r.y & 0xffff0000u) * acc[m][n][3];
                acc[m][n] = (f32x4){0.f, 0.f, 0.f, 0.f};
            }
    }
    __device__ __forceinline__ void epilogue(int u0, f32x4 (&sum)[8][2], int wr, int wc, int fr, int fq) const {
        const int u = xswz(u0, npm * 8); const int pm = u >> 3, pn = u & 7;
        T* op = MERGED + (size_t)(pm * 256 + wr * 128 + fr) * 1024 + pn * 128 + wc * 32 + fq * 4;
#pragma unroll
        for (int m = 0; m < 8; ++m)
#pragma unroll
            for (int n = 0; n < 2; ++n) *(uint2*)(op + (size_t)m * 16 * 1024 + n * 16) = pk4(sum[m][n][0], sum[m][n][1], sum[m][n][2], sum[m][n][3]);
    }
};

struct PlainProb {
    const T* A; const T* Bt; T* C; int npm, npn, K, lda, ldc;
    __device__ __forceinline__ int nunits() const { return npm * npn; }
    __device__ __forceinline__ int ntiles(int) const { return K / 64; }
    __device__ __forceinline__ unsigned a_off(int u0, int R) const { const int u = xswz(u0, npm * npn); return (unsigned)((u / npn) * 256 + R) * (unsigned)lda; }
    __device__ __forceinline__ unsigned b_off(int u0, int R) const { const int u = xswz(u0, npm * npn); return (unsigned)((u % npn) * 128 + R) * (unsigned)K; }
    __device__ __forceinline__ const T* a_base(int, int t) const { return A + t * 64; }
    __device__ __forceinline__ const T* b_base(int, int t) const { return Bt + t * 64; }
    __device__ __forceinline__ void epilogue(int u0, f32x4 (&acc)[8][2], int wr, int wc, int fr, int fq) const {
        const int u = xswz(u0, npm * npn); const int pm = u / npn, pn = u % npn;
        T* op = C + (size_t)(pm * 256 + wr * 128 + fr) * ldc + pn * 128 + wc * 32 + fq * 4;
#pragma unroll
        for (int m = 0; m < 8; ++m)
#pragma unroll
            for (int n = 0; n < 2; ++n) *(uint2*)(op + (size_t)m * 16 * ldc + n * 16) = pk4(acc[m][n][0], acc[m][n][1], acc[m][n][2], acc[m][n][3]);
    }
};

constexpr int CTXB = NB * NE * CAP;
struct FfnUp {
    const T* H2; const T* WguT; const int* IDX; T* ACT; int nun;
    __device__ __forceinline__ int nunits() const { return nun; }
    __device__ __forceinline__ int ntiles(int) const { return 16; }
    __device__ __forceinline__ void decode(int u, int& e, int& pn, int& sbase, bool& isctx) const {
        if (u < 2048) { e = u >> 7; const int rem = u & 127; pn = rem & 7; sbase = ((rem >> 5) * NE + e) * CAP + ((rem >> 3) & 3) * 256; isctx = false; }
        else { const int uc = u - 2048; e = uc >> 3; pn = uc & 7; sbase = CTXB + e * CAPC; isctx = true; }
    }
    __device__ __forceinline__ int slot_of(int sbase, bool isctx, int R) const { return isctx ? (R < 128 ? sbase + (R >> 5) * (NE * CAPC) + (R & 31) : -1) : sbase + R; }
    __device__ __forceinline__ unsigned a_off(int u, int R) const { int e, pn, sb; bool ic; decode(u, e, pn, sb, ic); const int s = slot_of(sb, ic, R); return s < 0 ? 0u : (unsigned)IDX[s] * 1024u; }
    __device__ __forceinline__ unsigned b_off(int u, int R) const { int e, pn, sb; bool ic; decode(u, e, pn, sb, ic); return (unsigned)(e * 2048 + pn * 256 + R) * 1024u; }
    __device__ __forceinline__ const T* a_base(int, int t) const { return H2 + t * 64; }
    __device__ __forceinline__ const T* b_base(int, int t) const { return WguT + t * 64; }
    __device__ __forceinline__ void epilogue(int u, f32x4 (&acc)[8][4], int wr, int wc, int fr, int fq) const {
        int e, pn, sb; bool ic; decode(u, e, pn, sb, ic);
        const int col = (pn * 4 + wc) * 32 + fq * 4;
#pragma unroll
        for (int m = 0; m < 8; ++m) {
            const int s = slot_of(sb, ic, wr * 128 + m * 16 + fr);
            if (s < 0) continue;
            T* op = ACT + (size_t)s * FF + col;
#pragma unroll
            for (int n = 0; n < 2; ++n)
                *(uint2*)(op + n * 16) = pk4(fast_silu(acc[m][n][0]) * acc[m][n + 2][0], fast_silu(acc[m][n][1]) * acc[m][n + 2][1],
                                             fast_silu(acc[m][n][2]) * acc[m][n + 2][2], fast_silu(acc[m][n][3]) * acc[m][n + 2][3]);
        }
    }
};
struct FfnDown {
    const T* ACT; const T* WdT; const float* GATEV; T* OUT; int nun;
    __device__ __forceinline__ int nunits() const { return nun; }
    __device__ __forceinline__ int ntiles(int) const { return 16; }
    __device__ __forceinline__ void decode(int u, int& e, int& pn, int& sbase, bool& isctx) const {
        if (u < 1024) { e = u >> 6; const int rem = u & 63; pn = rem & 3; sbase = ((rem >> 4) * NE + e) * CAP + ((rem >> 2) & 3) * 256; isctx = false; }
        else { const int uc = u - 1024; e = uc >> 2; pn = uc & 3; sbase = CTXB + e * CAPC; isctx = true; }
    }
    __device__ __forceinline__ int slot_of(int sbase, bool isctx, int R) const { return isctx ? (R < 128 ? sbase + (R >> 5) * (NE * CAPC) + (R & 31) : -1) : sbase + R; }
    __device__ __forceinline__ unsigned a_off(int u, int R) const { int e, pn, sb; bool ic; decode(u, e, pn, sb, ic); const int s = slot_of(sb, ic, R); return s < 0 ? 0u : (unsigned)s * 1024u; }
    __device__ __forceinline__ unsigned b_off(int u, int R) const { int e, pn, sb; bool ic; decode(u, e, pn, sb, ic); return (unsigned)(e * 1024 + pn * 256 + R) * 1024u; }
    __device__ __forceinline__ const T* a_base(int, int t) const { return ACT + t * 64; }
    __device__ __forceinline__ const T* b_base(int, int t) const { return WdT + t * 64; }
    __device__ __forceinline__ void epilogue(int u, f32x4 (&acc)[8][4], int wr, int wc, int fr, int fq) const {
        int e, pn, sb; bool ic; decode(u, e, pn, sb, ic);
        const int col = pn * 256 + wc * 64 + fq * 4;
#pragma unroll
        for (int m = 0; m < 8; ++m) {
            const int s = slot_of(sb, ic, wr * 128 + m * 16 + fr);
            if (s < 0) continue;
            const float g = GATEV[s];
            T* op = OUT + (size_t)s * D + col;
#pragma unroll
            for (int n = 0; n < 4; ++n) *(uint2*)(op + n * 16) = pk4(acc[m][n][0] * g, acc[m][n][1] * g, acc[m][n][2] * g, acc[m][n][3] * g);
        }
    }
};

namespace pg8 {
#define PG8_LAS __attribute__((address_space(3)))
constexpr int BM = 256, BK = 64, HALF = 128, HTB = HALF * BK * 2, STAGE_BYTES = 8 * HTB;
__host__ __device__ __forceinline__ int lds_byte(int r, int c) { const int st = (r >> 4) * 2 + (c >> 5), rr = r & 15, cc = c & 31, ob = rr * 64 + cc * 2; return st * 1024 + (ob ^ (((ob >> 9) & 1) << 5)); }
__host__ __device__ __forceinline__ void stage_rc(int b, int& R, int& C) { const int st = b / 1024, sb = b % 1024, swz = sb ^ (((sb >> 9) & 1) << 5); R = (st >> 1) * 16 + swz / 64; C = (st & 1) * 32 + (swz % 64) / 2; }
__host__ __device__ __forceinline__ int perm32(int rho) { const int n = rho >> 4, i = rho & 15; return 8 * (i >> 2) + 4 * n + (i & 3); }
struct Unit { int pm, pn; const char* a; const char* b; int x0, x1; };
template <class Epi, class Sched, bool ALIGN_EPI = false, bool SP2 = false>
__device__ __forceinline__ void gemm_phase(PG8_LAS unsigned char* lds, const int K, const Sched& S, const Epi& E) {
    const int tid = otid(), wid = __builtin_amdgcn_readfirstlane(tid >> 6), lane = tid & 63, wr = wid >> 2, wc = wid & 3, fr = lane & 15, fq = lane >> 4;
    const int nt = K / BK;
    unsigned voffA[2], voffB[2];
#pragma unroll
    for (int i = 0; i < 2; ++i) { int R, C; stage_rc(tid * 16 + i * 8192, R, C); const int Rb = Epi::PERM ? ((R & ~31) + perm32(R & 31)) : R;
        voffA[i] = (unsigned)(R * K + C) * 2u; voffB[i] = (unsigned)(Rb * K + C) * 2u; }
    const size_t kstep = (size_t)(BK * 2);
    const size_t hstep = (size_t)HALF * K * 2;
    const unsigned ldsw = (unsigned)wid * 1024u;
    const int aoff = lds_byte(wr * 64 + fr, fq * 8), boff = lds_byte(wc * 32 + fr, fq * 8);
#define PG8_SA(b, h) (((b) * 2 + (h)) * HTB)
#define PG8_SB(b, h) ((4 + (b) * 2 + (h)) * HTB)
#define PG8_STAGE(bufoff, gbase, voff) do { _Pragma("unroll") for (int _i = 0; _i < 2; ++_i) \
        __builtin_amdgcn_global_load_lds((const unsigned*)((const char*)(gbase) + (voff)[_i]), (PG8_LAS unsigned*)(lds + (bufoff) + ldsw + _i * 8192), 16, 0, 0); } while (0)
#define PG8_LDA(dst, b, h) do { _Pragma("unroll") for (int m = 0; m < 4; ++m) _Pragma("unroll") for (int k = 0; k < 2; ++k) dst[m][k] = *(const PG8_LAS bf16x8*)(lds + PG8_SA(b, h) + aoff + m * 2048 + k * 1024); } while (0)
#define PG8_LDB(dst, b, h) do { _Pragma("unroll") for (int n = 0; n < 2; ++n) _Pragma("unroll") for (int k = 0; k < 2; ++k) dst[n][k] = *(const PG8_LAS bf16x8*)(lds + PG8_SB(b, h) + boff + n * 2048 + k * 1024); } while (0)
#define PG8_MMA(ai, bj, At, Bt) do { __builtin_amdgcn_s_setprio(1); _Pragma("unroll") for (int m = 0; m < 4; ++m) _Pragma("unroll") for (int n = 0; n < 2; ++n) _Pragma("unroll") for (int k = 0; k < 2; ++k) \
        acc[ai][bj][m][n] = __builtin_amdgcn_mfma_f32_16x16x32_bf16(Bt[n][k], At[m][k], acc[ai][bj][m][n], 0, 0, 0); __builtin_amdgcn_s_setprio(0); } while (0)
#define PG8_WAIT_V(n) asm volatile("s_waitcnt vmcnt(" #n ")" ::: "memory")
#define PG8_WAIT_L(n) asm volatile("s_waitcnt lgkmcnt(" #n ")" ::: "memory")
#define PG8_BAR __builtin_amdgcn_s_barrier()
#define PG8_SCHED __builtin_amdgcn_sched_barrier(0)
    Unit cur, nxt; int ui = 0;
    if (!S.next(0, cur)) return;
    f32x4 acc[2][2][4][2];
#pragma unroll
    for (int a = 0; a < 2; ++a)
#pragma unroll
        for (int b = 0; b < 2; ++b)
#pragma unroll
            for (int m = 0; m < 4; ++m)
#pragma unroll
                for (int n = 0; n < 2; ++n) acc[a][b][m][n] = (f32x4){0.f, 0.f, 0.f, 0.f};
    bf16x8 At[4][2], B0[2][2], B1[2][2];
    const char* cA = cur.a; const char* cB = cur.b;
    S.a_ready(cur);
    if constexpr (SP2) {
        PG8_STAGE(PG8_SB(0, 0), cB, voffB); PG8_STAGE(PG8_SB(0, 1), cB + hstep, voffB); PG8_STAGE(PG8_SA(0, 0), cA, voffA); PG8_STAGE(PG8_SA(0, 1), cA + hstep, voffA);
        if (wr == 1) PG8_BAR;
        PG8_WAIT_V(2); PG8_BAR;
        PG8_STAGE(PG8_SB(1, 0), cB + kstep, voffB); PG8_STAGE(PG8_SA(1, 0), cA + kstep, voffA); PG8_STAGE(PG8_SB(1, 1), cB + hstep + kstep, voffB);
        PG8_WAIT_V(6); PG8_BAR;
    } else {
        PG8_STAGE(PG8_SB(0, 0), cB, voffB); PG8_STAGE(PG8_SA(0, 0), cA, voffA); PG8_STAGE(PG8_SB(0, 1), cB + hstep, voffB); PG8_STAGE(PG8_SA(0, 1), cA + hstep, voffA);
        if (wr == 1) PG8_BAR;
        PG8_WAIT_V(4); PG8_BAR;
        PG8_STAGE(PG8_SB(1, 0), cB + kstep, voffB); PG8_STAGE(PG8_SA(1, 0), cA + kstep, voffA); PG8_STAGE(PG8_SB(1, 1), cB + hstep + kstep, voffB);
        PG8_WAIT_V(6); PG8_BAR;
    }
    for (;;) {
        const bool has_next = S.next(ui + 1, nxt);
        const char* nA = has_next ? nxt.a : cA; const char* nB = has_next ? nxt.b : cB;
        for (int t = 0; t < nt; t += 2) {
            const bool last = (t == nt - 2);
            const char* a1 = cA + (size_t)(t + 1) * kstep;
            const char* a2 = last ? nA : cA + (size_t)(t + 2) * kstep; const char* b2 = last ? nB : cB + (size_t)(t + 2) * kstep;
            const char* a3 = a2 + kstep; const char* b3 = b2 + kstep;
            if (last && has_next) S.a_ready(nxt);
            if constexpr (SP2) {
            PG8_LDB(B0, 0, 0); PG8_LDB(B1, 0, 1); PG8_SCHED; PG8_LDA(At, 0, 0); PG8_STAGE(PG8_SA(1, 1), a1 + hstep, voffA);
            PG8_WAIT_V(8); PG8_WAIT_L(0); PG8_BAR; PG8_MMA(0, 0, At, B0); PG8_MMA(0, 1, At, B1); PG8_BAR; PG8_SCHED;
            PG8_LDA(At, 0, 1); PG8_STAGE(PG8_SB(0, 0), b2, voffB); PG8_STAGE(PG8_SB(0, 1), b2 + hstep, voffB); PG8_STAGE(PG8_SA(0, 0), a2, voffA);
            PG8_WAIT_V(8); PG8_WAIT_L(0); PG8_BAR; PG8_MMA(1, 0, At, B0); PG8_MMA(1, 1, At, B1); PG8_BAR; PG8_SCHED;
            PG8_LDB(B0, 1, 0); PG8_LDB(B1, 1, 1); PG8_SCHED; PG8_LDA(At, 1, 0); PG8_STAGE(PG8_SA(0, 1), a2 + hstep, voffA);
            PG8_WAIT_V(8); PG8_WAIT_L(0); PG8_BAR; PG8_MMA(0, 0, At, B0); PG8_MMA(0, 1, At, B1); PG8_BAR; PG8_SCHED;
            PG8_LDA(At, 1, 1); PG8_STAGE(PG8_SB(1, 0), b3, voffB); PG8_STAGE(PG8_SB(1, 1), b3 + hstep, voffB); PG8_STAGE(PG8_SA(1, 0), a3, voffA);
            PG8_WAIT_V(8); PG8_WAIT_L(0); PG8_BAR; PG8_MMA(1, 0, At, B0); PG8_MMA(1, 1, At, B1); PG8_BAR; PG8_SCHED;
            } else {
            PG8_LDB(B0, 0, 0); PG8_SCHED; PG8_LDA(At, 0, 0); PG8_STAGE(PG8_SA(1, 1), a1 + hstep, voffA);
            PG8_WAIT_L(8); PG8_BAR; PG8_WAIT_L(0); PG8_MMA(0, 0, At, B0); PG8_BAR; PG8_SCHED;
            PG8_LDB(B1, 0, 1); PG8_STAGE(PG8_SB(0, 0), b2, voffB);
            PG8_BAR; PG8_WAIT_L(0); PG8_MMA(0, 1, At, B1); PG8_BAR;
            PG8_LDA(At, 0, 1); PG8_STAGE(PG8_SA(0, 0), a2, voffA);
            PG8_BAR; PG8_WAIT_L(0); PG8_MMA(1, 0, At, B0); PG8_BAR; PG8_SCHED;
            PG8_STAGE(PG8_SB(0, 1), b2 + hstep, voffB);
            PG8_WAIT_V(6); PG8_BAR; PG8_MMA(1, 1, At, B1); PG8_BAR;
            PG8_LDB(B0, 1, 0); PG8_SCHED; PG8_LDA(At, 1, 0); PG8_STAGE(PG8_SA(0, 1), a2 + hstep, voffA);
            PG8_WAIT_L(8); PG8_BAR; PG8_WAIT_L(0); PG8_MMA(0, 0, At, B0); PG8_BAR; PG8_SCHED;
            PG8_LDB(B1, 1, 1); PG8_STAGE(PG8_SB(1, 0), b3, voffB);
            PG8_BAR; PG8_WAIT_L(0); PG8_MMA(0, 1, At, B1); PG8_BAR;
            PG8_LDA(At, 1, 1); PG8_STAGE(PG8_SA(1, 0), a3, voffA);
            PG8_BAR; PG8_WAIT_L(0); PG8_MMA(1, 0, At, B0); PG8_BAR; PG8_SCHED;
            PG8_STAGE(PG8_SB(1, 1), b3 + hstep, voffB);
            PG8_WAIT_V(6); PG8_BAR; PG8_MMA(1, 1, At, B1); PG8_BAR;
            }
        }
        if constexpr (ALIGN_EPI) { if (wr == 0) PG8_BAR; }
        if constexpr (!Epi::AFTER_DRAIN) { E(acc, cur, wr, wc, fr, fq); S.done(cur); }
        if (!has_next) break;
#pragma unroll
        for (int a = 0; a < 2; ++a)
#pragma unroll
            for (int b = 0; b < 2; ++b)
#pragma unroll
                for (int m = 0; m < 4; ++m)
#pragma unroll
                    for (int n = 0; n < 2; ++n) acc[a][b][m][n] = (f32x4){0.f, 0.f, 0.f, 0.f};
        cur = nxt; cA = nA; cB = nB; ++ui;
        if constexpr (ALIGN_EPI) { if (wr == 1) PG8_BAR; }
    }
    PG8_WAIT_V(0);
    if constexpr (!ALIGN_EPI) { if (wr == 0) PG8_BAR; }
    PG8_BAR;
    if constexpr (Epi::AFTER_DRAIN) { E.fused(acc, cur, wr, wc, fr, fq, lds, wid, lane); S.done(cur); }
#undef PG8_SA
#undef PG8_SB
#undef PG8_STAGE
#undef PG8_LDA
#undef PG8_LDB
#undef PG8_MMA
#undef PG8_WAIT_V
#undef PG8_WAIT_L
#undef PG8_BAR
#undef PG8_SCHED
}
}

struct SchedBase { __device__ __forceinline__ void a_ready(const pg8::Unit&) const {} __device__ __forceinline__ void done(const pg8::Unit&) const {} };
#define ACC8(mm, nn) acc[(mm) >> 2][(nn) >> 1][(mm) & 3][(nn) & 1]
#define ROW8(mm) (((mm) >> 2) * 128 + wr * 64 + ((mm) & 3) * 16 + fr)

struct InProj8S : SchedBase { const T* H; const T* Wt; int npm, bid, nblk, nun;
    __device__ __forceinline__ bool next(int i, pg8::Unit& u) const { const int x0 = bid + i * nblk; if (x0 >= nun) return false; const int x = xswz(x0, nun);
        if (x < 3200 || nun == 3300) { u.pm = x / 25; u.pn = x % 25; } else { const int y = x - 3200; u.pm = 128 + y / 9; u.pn = y % 9; }
        u.a = (const char*)(H + (size_t)u.pm * 256 * D); u.b = (const char*)(Wt + (size_t)u.pn * 256 * D); return true; } };
struct InProj8E {
    static constexpr bool PERM = false, AFTER_DRAIN = false;
    T* Z; float* SS; const float* gqn; const float* gkn; const float2* tab64; const float2* tab32;
    __device__ __forceinline__ void operator()(const f32x4 (&acc)[2][2][4][2], const pg8::Unit& u, int wr, int wc, int fr, int fq) const {
        const int pm = u.pm, cg = u.pn * 4 + wc;
        if (cg == 34 || cg == 35) return;
        const bool lat = pm * 256 < NLAT;
        const int zcol = (cg < 36 ? cg * 64 : 2144 + (cg - 36) * 64) + fq * 4;
        const bool t_rms = (cg >= 12 && cg < 18), t_rope = t_rms || (cg >= 20 && cg < 26), t_ssq = (cg >= 28 && cg < 33), t_kr = cg == 33, t_sig = cg >= 36;
        float4 gv[4];
        if (t_rms) { const float* g = cg < 16 ? gqn : gkn;
#pragma unroll
            for (int n = 0; n < 4; ++n) gv[n] = *(const float4*)(g + n * 16 + fq * 4); }
#pragma unroll
        for (int m = 0; m < 8; ++m) {
            const int row = pm * 256 + ROW8(m);
            const int t = row & (SEQ - 1), gr = t >> 6, gc = t & 63;
            float v[4][4];
#pragma unroll
            for (int n = 0; n < 4; ++n)
#pragma unroll
                for (int j = 0; j < 4; ++j) v[n][j] = ACC8(m, n)[j];
            T* zp = Z + (size_t)row * ZW + zcol;
            if (t_rms || t_ssq) {
                float ss = 0.f;
#pragma unroll
                for (int n = 0; n < 4; ++n)
#pragma unroll
                    for (int j = 0; j < 4; ++j) ss += v[n][j] * v[n][j];
                ss += __shfl_xor(ss, 16); ss += __shfl_xor(ss, 32);
                if (t_ssq) { if (fq == 0) SS[(size_t)row * 8 + (cg - 28)] = ss; }
                else { const float rstd = 1.f / sqrtf(ss * (1.f / 64.f) + EPS);
#pragma unroll
                    for (int n = 0; n < 4; ++n) { v[n][0] *= rstd * gv[n].x; v[n][1] *= rstd * gv[n].y; v[n][2] *= rstd * gv[n].z; v[n][3] *= rstd * gv[n].w; } }
            }
            if (t_rope && lat) {
                const float4* tr = (const float4*)(tab64 + gr * 16 + fq * 4); const float4* tc = (const float4*)(tab64 + gc * 16 + fq * 4);
                const float4 r0 = tr[0], r1 = tr[1], c0 = tc[0], c1 = tc[1];
                const float rc[4] = {r0.x, r0.z, r1.x, r1.z}, rs[4] = {r0.y, r0.w, r1.y, r1.w}, cc[4] = {c0.x, c0.z, c1.x, c1.z}, cs[4] = {c0.y, c0.w, c1.y, c1.w};
#pragma unroll
                for (int j = 0; j < 4; ++j) {
                    const float a0 = v[0][j], a1 = v[1][j], b0 = v[2][j], b1 = v[3][j];
                    v[0][j] = a0 * rc[j] - a1 * rs[j]; v[1][j] = a0 * rs[j] + a1 * rc[j];
                    v[2][j] = b0 * cc[j] - b1 * cs[j]; v[3][j] = b0 * cs[j] + b1 * cc[j];
                }
            }
            if (t_kr) {
#pragma unroll
                for (int n = 0; n < 2; ++n) {
                    const float4* tp = (const float4*)(tab32 + (n == 0 ? gr : gc) * 8 + (fq & 1) * 4);
                    const float4 q0 = tp[0], q1 = tp[1];
                    const float kc[4] = {q0.x, q0.z, q1.x, q1.z}, ks[4] = {q0.y, q0.w, q1.y, q1.w};
#pragma unroll
                    for (int j = 0; j < 4; ++j) { const float x = v[n][j], px = __shfl_xor(x, 32); if (lat) v[n][j] = (fq < 2) ? (x * kc[j] - px * ks[j]) : (px * ks[j] + x * kc[j]); }
                    *(uint2*)(zp + n * 16) = pk4(v[n][0], v[n][1], v[n][2], v[n][3]);
                }
                continue;
            }
            if (t_sig) {
#pragma unroll
                for (int n = 0; n < 4; ++n)
#pragma unroll
                    for (int j = 0; j < 4; ++j) v[n][j] = fast_sigmoid(v[n][j]);
            }
#pragma unroll
            for (int n = 0; n < 4; ++n) *(uint2*)(zp + n * 16) = pk4(v[n][0], v[n][1], v[n][2], v[n][3]);
        }
    }
};

struct FfnUp8S : SchedBase { const T* XG; const T* WguT; int nun, bid, nblk;
    __device__ __forceinline__ bool next(int i, pg8::Unit& u) const { const int x0 = bid + i * nblk; if (x0 >= nun) return false; const int x = xswz(x0, nun); int e, sb;
        if (x < 2048) { e = x >> 7; const int rem = x & 127; u.pn = rem & 7; sb = ((rem >> 5) * NE + e) * CAP + ((rem >> 3) & 3) * 256; u.x1 = 256; }
        else { const int uc = x - 2048; e = uc >> 3; u.pn = uc & 7; sb = CTXB + e * (NB * CAPC); u.x1 = NB * CAPC; }
        u.pm = 0; u.x0 = sb; u.a = (const char*)(XG + (size_t)sb * D); u.b = (const char*)(WguT + ((size_t)e * 2048 + u.pn * 256) * D); return true; } };
struct FfnUp8E {
    static constexpr bool PERM = false, AFTER_DRAIN = false;
    T* ACT;
    __device__ __forceinline__ void operator()(const f32x4 (&acc)[2][2][4][2], const pg8::Unit& u, int wr, int wc, int fr, int fq) const {
        const int col = (u.pn * 4 + wc) * 32 + fq * 4;
#pragma unroll
        for (int m = 0; m < 8; ++m) {
            const int R = ROW8(m);
            if (R >= u.x1) continue;
            T* op = ACT + (size_t)(u.x0 + R) * FF + col;
#pragma unroll
            for (int n = 0; n < 2; ++n) { const f32x4 g = ACC8(m, n), w = ACC8(m, n + 2);
                *(uint2*)(op + n * 16) = pk4(fast_silu(g[0]) * w[0], fast_silu(g[1]) * w[1], fast_silu(g[2]) * w[2], fast_silu(g[3]) * w[3]); }
        }
    }
};
struct FfnDown8S : SchedBase { const T* ACT; const T* WdT; int nun, bid, nblk;
    __device__ __forceinline__ bool next(int i, pg8::Unit& u) const { const int x0 = bid + i * nblk; if (x0 >= nun) return false; const int x = xswz(x0, nun); int e, sb;
        if (x < 1024) { e = x >> 6; const int rem = x & 63; u.pn = rem & 3; sb = ((rem >> 4) * NE + e) * CAP + ((rem >> 2) & 3) * 256; u.x1 = 256; }
        else { const int uc = x - 1024; e = uc >> 2; u.pn = uc & 3; sb = CTXB + e * (NB * CAPC); u.x1 = NB * CAPC; }
        u.pm = 0; u.x0 = sb; u.a = (const char*)(ACT + (size_t)sb * FF); u.b = (const char*)(WdT + ((size_t)e * 1024 + u.pn * 256) * FF); return true; } };
struct FfnDown8E {
    static constexpr bool PERM = false, AFTER_DRAIN = false;
    const float* GATEV; T* OUT;
    __device__ __forceinline__ void operator()(const f32x4 (&acc)[2][2][4][2], const pg8::Unit& u, int wr, int wc, int fr, int fq) const {
        const int col = u.pn * 256 + wc * 64 + fq * 4;
#pragma unroll
        for (int m = 0; m < 8; ++m) {
            const int R = ROW8(m);
            if (R >= u.x1) continue;
            const int s = u.x0 + R; const float g = GATEV[s];
            T* op = OUT + (size_t)s * D + col;
#pragma unroll
            for (int n = 0; n < 4; ++n) { const f32x4 a = ACC8(m, n); *(uint2*)(op + n * 16) = pk4(a[0] * g, a[1] * g, a[2] * g, a[3] * g); }
        }
    }
};
struct Plain8S : SchedBase { const T* A; const T* Bt; int npm, npn, K, bid, nblk;
    __device__ __forceinline__ bool next(int i, pg8::Unit& u) const { const int x0 = bid + i * nblk; if (x0 >= npm * npn) return false; const int x = xswz(x0, npm * npn); u.pm = x / npn; u.pn = x % npn;
        u.a = (const char*)(A + (size_t)u.pm * 256 * K); u.b = (const char*)(Bt + (size_t)u.pn * 256 * K); return true; } };
struct Plain8E {
    static constexpr bool PERM = false, AFTER_DRAIN = false;
    T* C; int ldc;
    __device__ __forceinline__ void operator()(const f32x4 (&acc)[2][2][4][2], const pg8::Unit& u, int wr, int wc, int fr, int fq) const {
        const int col = u.pn * 256 + wc * 64 + fq * 4;
#pragma unroll
        for (int m = 0; m < 8; ++m) {
            T* op = C + (size_t)(u.pm * 256 + ROW8(m)) * ldc + col;
#pragma unroll
            for (int n = 0; n < 4; ++n) { const f32x4 a = ACC8(m, n); *(uint2*)(op + n * 16) = pk4(a[0], a[1], a[2], a[3]); }
        }
    }
};
__device__ __forceinline__ void ph_gather(const T* H2, const int* IDX, T* XG, int nslot, int bid, int nblk) {
    const int tid_ = otid(); const int lane = tid_ & 63, wid = tid_ >> 6;
    for (int s0 = (bid * 8 + wid) * 2; s0 < nslot; s0 += nblk * 16) {
        const int i0 = IDX[s0], i1 = IDX[s0 + 1];
        const uint4 a0 = *(const uint4*)(H2 + (size_t)i0 * D + lane * 8), a1 = *(const uint4*)(H2 + (size_t)i0 * D + 512 + lane * 8);
        const uint4 b0 = *(const uint4*)(H2 + (size_t)i1 * D + lane * 8), b1 = *(const uint4*)(H2 + (size_t)i1 * D + 512 + lane * 8);
        *(uint4*)(XG + (size_t)s0 * D + lane * 8) = a0; *(uint4*)(XG + (size_t)s0 * D + 512 + lane * 8) = a1;
        *(uint4*)(XG + (size_t)(s0 + 1) * D + lane * 8) = b0; *(uint4*)(XG + (size_t)(s0 + 1) * D + 512 + lane * 8) = b1;
    }
}

typedef float f32x16 __attribute__((ext_vector_type(16)));
typedef short s16x4 __attribute__((ext_vector_type(4)));
typedef short v4i16_t __attribute__((ext_vector_type(4)));
struct AttnP { const T* Z; const T* QM; const T* KVM; T* O; const float* rpb; const float* sink; int nlat; int need_ctx; float* o32; int fake; };
constexpr int ATT_LDS = 156672 + 2048;
__device__ __forceinline__ int crow(int r, int hi) { return (r & 3) + 8 * (r >> 2) + 4 * hi; }
__device__ __forceinline__ float xhalf_max(float v) { auto rr = __builtin_amdgcn_permlane32_swap(__float_as_uint(v), __float_as_uint(v), false, false); return fmaxf(__uint_as_float(rr[0]), __uint_as_float(rr[1])); }
__device__ __forceinline__ float xhalf_sum(float v) { auto rr = __builtin_amdgcn_permlane32_swap(__float_as_uint(v), __float_as_uint(v), false, false); return __uint_as_float(rr[0]) + __uint_as_float(rr[1]); }
__device__ __forceinline__ unsigned cvtpk(float lo, float hi) { typedef float f2 __attribute__((ext_vector_type(2))); typedef __bf16 b2 __attribute__((ext_vector_type(2))); f2 v = {lo, hi}; b2 b = __builtin_convertvector(v, b2); return __builtin_bit_cast(unsigned, b); }

__device__ __forceinline__ float max3f(float a, float b, float c) { float r; asm("v_max3_f32 %0, %1, %2, %3" : "=v"(r) : "v"(a), "v"(b), "v"(c)); return r; }
template <int BR>
__device__ __forceinline__ void attn_unit_l(ldsp lds, const AttnP& P, int b, int hx, int q0, bool ctxq) {
    constexpr int DQK = (BR == 3) ? 96 : 64, NKS = DQK / 16, KB = (BR == 3) ? 9216 + 4096 : 9216, SLOT = KB + 8192;
    constexpr int R = (BR == 3) ? 5 : 6, PF = R - 1;
    constexpr int BT0 = 107520, QF0 = BT0 + 2048;
    static_assert(R * SLOT <= BT0, "ring");
    constexpr bool PACK2 = (BR == 1 || BR == 2);
    constexpr float SCALE = (BR == 3) ? 0.10206207261596575f : 0.125f;
    constexpr float CL2 = SCALE * 1.4426950408889634f;
    constexpr float NEG = -1e30f, THR = 8.f;
    const int tid = otid(), lane = tid & 63, wid = __builtin_amdgcn_readfirstlane(tid >> 6), r32 = lane & 31, hi = lane >> 5;
    const int tokq = q0 + (PACK2 ? (wid & 3) : wid) * 32 + r32;
    const int head = PACK2 ? hx * 2 + (wid >> 2) : hx;
    const size_t lat0 = (size_t)b * SEQ, ctx0 = (size_t)P.nlat + (size_t)b * CTX;
    const size_t qrow = ctxq ? ctx0 + tokq : lat0 + tokq;
    const ldsp qlds = lds + QF0 + wid * 6144 + lane * 16;
    { const T* qp = (BR == 3) ? P.QM + qrow * 384 + head * 96 + hi * 8 : P.Z + qrow * ZW + (BR == 0 ? NAQ : BR == 1 ? GQ : SQ) + head * 64 + hi * 8;
#pragma unroll
      for (int ks = 0; ks < NKS; ++ks) {
          const uint4 raw = *(const uint4*)(qp + ks * 16);
          typedef unsigned u4 __attribute__((ext_vector_type(4)));
          const u4 w = {cvtpk(__uint_as_float(raw.x << 16) * CL2, __uint_as_float(raw.x & 0xffff0000u) * CL2), cvtpk(__uint_as_float(raw.y << 16) * CL2, __uint_as_float(raw.y & 0xffff0000u) * CL2),
                        cvtpk(__uint_as_float(raw.z << 16) * CL2, __uint_as_float(raw.z & 0xffff0000u) * CL2), cvtpk(__uint_as_float(raw.w << 16) * CL2, __uint_as_float(raw.w & 0xffff0000u) * CL2)};
          *(LAS u4*)(qlds + ks * 1024) = w; } }
    int klo = 0, nlt = 0;
    if (!ctxq) {
        if (BR == 0) { const int r0 = q0 >> 6; const int lo = min(max(r0 - 4, 0), GROWS - 8), hi2 = min(max(r0 - 1, 0), GROWS - 8) + 8; klo = lo * 64; nlt = hi2 - lo; }
        else if (BR == 2) { klo = max(q0 - 128, 0); nlt = (min(q0 + 256, SEQ) - klo) >> 6; }
        else { klo = 0; nlt = SEQ / 64; }
    }
    const int nt = 4 + nlt;
    const T* ksrc; const T* vsrc; const T* rsrc = nullptr; size_t kpitch;
    { const int kk = 8 * wid + (lane >> 3), kch = ((lane & 7) ^ (lane >> 3)) * 8, vch = ((((lane >> 2) ^ (lane >> 4)) & 1) * 32) + (lane & 3) * 8;
      if (BR == 3) { ksrc = P.KVM + (size_t)kk * 512 + hx * 128 + kch; vsrc = P.KVM + (size_t)kk * 512 + hx * 128 + 64 + vch; kpitch = 512;
                     rsrc = P.Z + (size_t)(16 * (wid & 3) + (lane >> 2)) * ZW + MKR + (((lane & 3) ^ ((lane >> 4) & 3)) * 8); }
      else { const int ko = (BR == 0 ? NAK : BR == 1 ? GK : SK) + hx * 64, vo = (BR == 0 ? NAV : BR == 1 ? GV : SV) + hx * 64;
             ksrc = P.Z + (size_t)kk * ZW + ko + kch; vsrc = P.Z + (size_t)kk * ZW + vo + vch; kpitch = ZW; } }
#define A_TROW(t) ((t) < 4 ? ctx0 + (size_t)(t) * 64 : lat0 + (size_t)klo + (size_t)((t) - 4) * 64)
#define A_DMA(t, slot) do { const size_t tr_ = A_TROW(t); const ldsp sb_ = lds + (slot) * SLOT; \
        GLDS16(ksrc + tr_ * kpitch, sb_ + wid * 1152); GLDS16(vsrc + tr_ * kpitch, sb_ + KB + wid * 1024); \
        if (BR == 3) { if (wid < 4) GLDS16(rsrc + tr_ * ZW, sb_ + 9216 + wid * 1024); } } while (0)
#define A_WAITBAR(n) do { if (BR == 3 && wid < 4) asm volatile("s_waitcnt vmcnt(%0) lgkmcnt(0)\n\ts_barrier" :: "n"(3 * (n)) : "memory"); \
                          else asm volatile("s_waitcnt vmcnt(%0) lgkmcnt(0)\n\ts_barrier" :: "n"(2 * (n)) : "memory"); } while (0)
    LAS float* btab = (LAS float*)(lds + BT0);
    if (BR == 0) { if (tid < 465) btab[tid] = P.rpb[hx * 465 + tid] * 1.4426950408889634f; }
    const int qr = (q0 >> 6) + (wid >> 1), qc = (wid & 1) * 32 + r32;
    const int krow0 = min(max(qr - 4, 0), GROWS - 8), kcol0 = min(max(qc - 8, 0), GW - 16);
    float mref = 0.f, lsum = 0.f;
    f32x16 o0, o1, negm;
#pragma unroll
    for (int r = 0; r < 16; ++r) { o0[r] = 0.f; o1[r] = 0.f; negm[r] = 0.f; }
    const unsigned kfo = (r32 >> 3) * 1152 + (r32 & 7) * 128 + ((hi ^ (r32 & 7)) * 16);
    const unsigned rfo = 9216 + r32 * 64 + ((hi ^ ((r32 >> 2) & 3)) * 16);
    const unsigned vfo = KB + (4 * hi + ((lane & 15) >> 2)) * 128 + ((lane >> 3) & 1) * 64 + ((lane >> 4) & 1) * 32 + (lane & 3) * 8;
#define A_ACTIVE(t) (!(BR == 0 && (t) >= 4) || (((klo >> 6) + ((t) - 4)) >= krow0 && ((klo >> 6) + ((t) - 4)) < krow0 + 8))
#define A_QK(p0, p1, slot) do { const ldsp kb_ = lds + (slot) * SLOT; bf16x8 kaf[NKS], kbf[NKS], qkf[NKS]; \
        _Pragma("unroll") for (int ks = 0; ks < NKS; ++ks) { \
            if (ks < 4) { const ldsp a_ = kb_ + (kfo ^ (unsigned)(ks * 32)); kaf[ks] = *(const LAS bf16x8*)(a_); kbf[ks] = *(const LAS bf16x8*)(a_ + 4608); } \
            else { const ldsp a_ = kb_ + (rfo ^ (unsigned)((ks - 4) * 32)); kaf[ks] = *(const LAS bf16x8*)(a_); kbf[ks] = *(const LAS bf16x8*)(a_ + 2048); } \
            qkf[ks] = *(const LAS bf16x8*)(qlds + ks * 1024); } \
        p0 = __builtin_amdgcn_mfma_f32_32x32x16_bf16(kaf[0], qkf[0], negm, 0, 0, 0); p1 = __builtin_amdgcn_mfma_f32_32x32x16_bf16(kbf[0], qkf[0], negm, 0, 0, 0); \
        _Pragma("unroll") for (int ks = 1; ks < NKS; ++ks) { \
          p0 = __builtin_amdgcn_mfma_f32_32x32x16_bf16(kaf[ks], qkf[ks], p0, 0, 0, 0); p1 = __builtin_amdgcn_mfma_f32_32x32x16_bf16(kbf[ks], qkf[ks], p1, 0, 0, 0); } } while (0)
    asm volatile("s_waitcnt lgkmcnt(0)" ::: "memory");
#pragma unroll
    for (int j = 0; j < PF; ++j) { if (j < nt) A_DMA(j, j); }
    if (nt >= PF) A_WAITBAR(PF - 2); else A_WAITBAR(0);
    f32x16 sA0, sA1, sB0, sB1;
    A_QK(sA0, sA1, 0);
    bool act_cur = true;
    int sl = 0;
#define A_STEP(t, pc0, pc1, pn0, pn1) do { \
        const int s1 = (sl + 1 == R) ? 0 : sl + 1, sm = (sl == 0) ? R - 1 : sl - 1; \
        if ((t) + PF < nt) A_DMA((t) + PF, sm);                   \
        const bool act_next = ((t) + 1 < nt) && A_ACTIVE((t) + 1); \
        if (act_next) A_QK(pn0, pn1, s1); \
        if (act_cur) { \
            if (BR == 0) { if ((t) >= 4) { const int dr = (klo >> 6) + ((t) - 4) - qr + 7; \
                    _Pragma("unroll") for (int r = 0; r < 16; ++r) { const int kc0 = crow(r, hi), kc1 = 32 + kc0; \
                        const bool v0 = (unsigned)(kc0 - kcol0) < 16u, v1 = (unsigned)(kc1 - kcol0) < 16u; \
                        const float b0 = btab[dr * 31 + min(max(kc0 - qc + 15, 0), 30)], b1 = btab[dr * 31 + min(max(kc1 - qc + 15, 0), 30)]; \
                        pc0[r] = v0 ? pc0[r] + b0 : NEG; pc1[r] = v1 ? pc1[r] + b1 : NEG; } } } \
            if (BR == 2) { if ((t) >= 4) { const int kb0 = klo + ((t) - 4) * 64 - tokq + 128; \
                    _Pragma("unroll") for (int r = 0; r < 16; ++r) { const int d0 = kb0 + crow(r, hi); \
                        if ((unsigned)d0 > 256u) pc0[r] = NEG; if ((unsigned)(d0 + 32) > 256u) pc1[r] = NEG; } } } \
            float rm; \
            { const float a0 = max3f(pc0[0], pc0[1], pc0[2]), a1 = max3f(pc0[3], pc0[4], pc0[5]), a2 = max3f(pc0[6], pc0[7], pc0[8]), a3 = max3f(pc0[9], pc0[10], pc0[11]), \
                          a4 = max3f(pc0[12], pc0[13], pc0[14]), a5 = max3f(pc0[15], pc1[0], pc1[1]), a6 = max3f(pc1[2], pc1[3], pc1[4]), a7 = max3f(pc1[5], pc1[6], pc1[7]), \
                          a8 = max3f(pc1[8], pc1[9], pc1[10]), a9 = max3f(pc1[11], pc1[12], pc1[13]), a10 = fmaxf(pc1[14], pc1[15]); \
              const float b0 = max3f(a0, a1, a2), b1 = max3f(a3, a4, a5), b2 = max3f(a6, a7, a8), b3 = fmaxf(a9, a10); \
              rm = xhalf_max(fmaxf(fmaxf(b0, b1), fmaxf(b2, b3))); } \
            if ((t) == 0 || __any(rm > THR)) { \
                const float dl = ((t) == 0) ? rm : fmaxf(rm, 0.f); const float f = __builtin_amdgcn_exp2f(-dl); \
                mref += dl; lsum *= f; \
                _Pragma("unroll") for (int r = 0; r < 16; ++r) { pc0[r] -= dl; pc1[r] -= dl; negm[r] -= dl; o0[r] *= f; o1[r] *= f; } \
                if (act_next) { _Pragma("unroll") for (int r = 0; r < 16; ++r) { pn0[r] -= dl; pn1[r] -= dl; } } } \
            _Pragma("unroll") for (int r = 0; r < 16; ++r) { pc0[r] = __builtin_amdgcn_exp2f(pc0[r]); pc1[r] = __builtin_amdgcn_exp2f(pc1[r]); } \
            { float s8[8]; _Pragma("unroll") for (int r = 0; r < 8; ++r) s8[r] = (pc0[r] + pc0[r + 8]) + (pc1[r] + pc1[r + 8]); \
              lsum += ((s8[0] + s8[1]) + (s8[2] + s8[3])) + ((s8[4] + s8[5]) + (s8[6] + s8[7])); } \
            const ldsp vb = lds + sl * SLOT + vfo, vb1 = lds + sl * SLOT + (vfo ^ 64u); \
            bf16x8 pf[4]; \
            _Pragma("unroll") for (int s = 0; s < 4; ++s) { const int rb = (s & 1) * 8; typedef unsigned u4 __attribute__((ext_vector_type(4))); u4 ww; \
                  if (s < 2) ww = (u4){cvtpk(pc0[rb], pc0[rb + 1]), cvtpk(pc0[rb + 2], pc0[rb + 3]), cvtpk(pc0[rb + 4], pc0[rb + 5]), cvtpk(pc0[rb + 6], pc0[rb + 7])}; \
                  else       ww = (u4){cvtpk(pc1[rb], pc1[rb + 1]), cvtpk(pc1[rb + 2], pc1[rb + 3]), cvtpk(pc1[rb + 4], pc1[rb + 5]), cvtpk(pc1[rb + 6], pc1[rb + 7])}; \
                  pf[s] = __builtin_bit_cast(bf16x8, ww); } \
            s16x4 vl0[4], vh0[4], vl1[4], vh1[4]; \
            _Pragma("unroll") for (int s = 0; s < 4; ++s) { vl0[s] = __builtin_bit_cast(s16x4, __builtin_amdgcn_ds_read_tr16_b64_v4i16((LAS v4i16_t*)(vb + s * 2048))); vh0[s] = __builtin_bit_cast(s16x4, __builtin_amdgcn_ds_read_tr16_b64_v4i16((LAS v4i16_t*)(vb + s * 2048 + 1024))); } \
            _Pragma("unroll") for (int s = 0; s < 4; ++s) { vl1[s] = __builtin_bit_cast(s16x4, __builtin_amdgcn_ds_read_tr16_b64_v4i16((LAS v4i16_t*)(vb1 + s * 2048))); vh1[s] = __builtin_bit_cast(s16x4, __builtin_amdgcn_ds_read_tr16_b64_v4i16((LAS v4i16_t*)(vb1 + s * 2048 + 1024))); } \
            _Pragma("unroll") for (int s = 0; s < 4; ++s) { const bf16x8 vf = (bf16x8){vl0[s][0], vl0[s][1], vl0[s][2], vl0[s][3], vh0[s][0], vh0[s][1], vh0[s][2], vh0[s][3]}; o0 = __builtin_amdgcn_mfma_f32_32x32x16_bf16(vf, pf[s], o0, 0, 0, 0); } \
            _Pragma("unroll") for (int s = 0; s < 4; ++s) { const bf16x8 vf = (bf16x8){vl1[s][0], vl1[s][1], vl1[s][2], vl1[s][3], vh1[s][0], vh1[s][1], vh1[s][2], vh1[s][3]}; o1 = __builtin_amdgcn_mfma_f32_32x32x16_bf16(vf, pf[s], o1, 0, 0, 0); } \
        } \
          \
        if ((t) + PF < nt) A_WAITBAR(PF - 2); else A_WAITBAR(0); \
        act_cur = act_next; sl = s1; \
    } while (0)
    { int t = 0;
      for (; t + 1 < nt; t += 2) { A_STEP(t, sA0, sA1, sB0, sB1); A_STEP(t + 1, sB0, sB1, sA0, sA1); }
      if (t < nt) A_STEP(t, sA0, sA1, sB0, sB1); }
    float ltot = xhalf_sum(lsum);
    if (BR == 2) ltot += __builtin_amdgcn_exp2f(P.sink[head] * 1.4426950408889634f - mref);
    const float inv = 1.f / ltot;
#ifdef PROBE_ATTN
    if (P.o32 && b == 1 && (ctxq || tokq < 1024 || tokq >= 7168)) {
        const int sub = ctxq ? 2048 + tokq : (tokq < 1024 ? tokq : 1024 + tokq - 7168);
        float* fp = P.o32 + (size_t)sub * D + BR * 256 + head * 64 + 4 * hi;
#pragma unroll
        for (int g = 0; g < 4; ++g)
#pragma unroll
            for (int j = 0; j < 4; ++j) { fp[8 * g + j] = o0[4 * g + j] * inv; fp[32 + 8 * g + j] = o1[4 * g + j] * inv; }
    }
#endif
    T* op = P.O + qrow * D + BR * 256 + head * 64 + 4 * hi;
#pragma unroll
    for (int g = 0; g < 4; ++g) {
        *(uint2*)(op + 8 * g) = pk4(o0[4 * g] * inv, o0[4 * g + 1] * inv, o0[4 * g + 2] * inv, o0[4 * g + 3] * inv);
        *(uint2*)(op + 32 + 8 * g) = pk4(o1[4 * g] * inv, o1[4 * g + 1] * inv, o1[4 * g + 2] * inv, o1[4 * g + 3] * inv);
    }
#undef A_TROW
#undef A_DMA
#undef A_WAITBAR
#undef A_ACTIVE
#undef A_QK
#undef A_STEP
}


template <int BR>
__device__ __forceinline__ void attn_unit(ldsp lds, const AttnP& P, int b, int hx, int q0, bool ctxq) {
    constexpr int DQK = (BR == 3) ? 96 : 64, NKS = DQK / 16, KB = (BR == 3) ? 9216 + 4096 : 9216, SLOT = KB + 8192;
    constexpr int R = (BR == 3) ? 7 : 9, PF = R - 3;
    constexpr int BT0 = 156672;
    static_assert(R * SLOT <= BT0, "ring");
    constexpr bool PACK2 = (BR == 1 || BR == 2);
    constexpr float SCALE = (BR == 3) ? 0.10206207261596575f : 0.125f;
    constexpr float CL2 = SCALE * 1.4426950408889634f;
    constexpr float NEG = -1e30f, THR = 8.f;
    const int tid = otid(), lane = tid & 63, wid = __builtin_amdgcn_readfirstlane(tid >> 6), r32 = lane & 31, hi = lane >> 5;
    const int tokq = q0 + (PACK2 ? (wid & 3) : wid) * 32 + r32;
    const int head = PACK2 ? hx * 2 + (wid >> 2) : hx;
    const size_t lat0 = (size_t)b * SEQ, ctx0 = (size_t)P.nlat + (size_t)b * CTX;
    const size_t qrow = ctxq ? ctx0 + tokq : lat0 + tokq;
    bf16x8 qf[NKS];
    { const T* qp = (BR == 3) ? P.QM + qrow * 384 + head * 96 + hi * 8 : P.Z + qrow * ZW + (BR == 0 ? NAQ : BR == 1 ? GQ : SQ) + head * 64 + hi * 8;
#pragma unroll
      for (int ks = 0; ks < NKS; ++ks) {
          const uint4 raw = *(const uint4*)(qp + ks * 16);
          typedef unsigned u4 __attribute__((ext_vector_type(4)));
          const u4 w = {cvtpk(__uint_as_float(raw.x << 16) * CL2, __uint_as_float(raw.x & 0xffff0000u) * CL2), cvtpk(__uint_as_float(raw.y << 16) * CL2, __uint_as_float(raw.y & 0xffff0000u) * CL2),
                        cvtpk(__uint_as_float(raw.z << 16) * CL2, __uint_as_float(raw.z & 0xffff0000u) * CL2), cvtpk(__uint_as_float(raw.w << 16) * CL2, __uint_as_float(raw.w & 0xffff0000u) * CL2)};
          qf[ks] = __builtin_bit_cast(bf16x8, w); } }
    int klo = 0, nlt = 0;
    if (!ctxq) {
        if (BR == 0) { const int r0 = q0 >> 6; const int lo = min(max(r0 - 4, 0), GROWS - 8), hi2 = min(max(r0 - 1, 0), GROWS - 8) + 8; klo = lo * 64; nlt = hi2 - lo; }
        else if (BR == 2) { klo = max(q0 - 128, 0); nlt = (min(q0 + 256, SEQ) - klo) >> 6; }
        else { klo = 0; nlt = SEQ / 64; }
    }
    const int nt = 4 + nlt;
    const T* ksrc; const T* vsrc; const T* rsrc = nullptr; size_t kpitch;
    { const int kk = 8 * wid + (lane >> 3), kch = ((lane & 7) ^ (lane >> 3)) * 8, vch = ((((lane >> 2) ^ (lane >> 4)) & 1) * 32) + (lane & 3) * 8;
      if (BR == 3) { ksrc = P.KVM + (size_t)kk * 512 + hx * 128 + kch; vsrc = P.KVM + (size_t)kk * 512 + hx * 128 + 64 + vch; kpitch = 512;
                     rsrc = P.Z + (size_t)(16 * (wid & 3) + (lane >> 2)) * ZW + MKR + (((lane & 3) ^ ((lane >> 4) & 3)) * 8); }
      else { const int ko = (BR == 0 ? NAK : BR == 1 ? GK : SK) + hx * 64, vo = (BR == 0 ? NAV : BR == 1 ? GV : SV) + hx * 64;
             ksrc = P.Z + (size_t)kk * ZW + ko + kch; vsrc = P.Z + (size_t)kk * ZW + vo + vch; kpitch = ZW; } }
#define A_TROW(t) ((t) < 4 ? ctx0 + (size_t)(t) * 64 : lat0 + (size_t)klo + (size_t)((t) - 4) * 64)
#define A_DMA(t, slot) do { if (wid < 4) { const size_t tr_ = A_TROW(t); const ldsp sb_ = lds + (slot) * SLOT; \
        GLDS16(ksrc + tr_ * kpitch, sb_ + wid * 1152); GLDS16(ksrc + (tr_ + 32) * kpitch, sb_ + (wid + 4) * 1152); \
        GLDS16(vsrc + tr_ * kpitch, sb_ + KB + wid * 1024); GLDS16(vsrc + (tr_ + 32) * kpitch, sb_ + KB + (wid + 4) * 1024); \
        if (BR == 3) GLDS16(rsrc + tr_ * ZW, sb_ + 9216 + wid * 1024); } } while (0)
#define A_WAITBAR(n) do { if (wid < 4) { if (BR == 3) asm volatile("s_waitcnt vmcnt(%0) lgkmcnt(0)\n\ts_barrier" :: "n"(5 * (n)) : "memory"); \
                                         else asm volatile("s_waitcnt vmcnt(%0) lgkmcnt(0)\n\ts_barrier" :: "n"(4 * (n)) : "memory"); } \
                          else asm volatile("s_waitcnt lgkmcnt(0)\n\ts_barrier" ::: "memory"); } while (0)
    LAS float* btab = (LAS float*)(lds + BT0);
    if (BR == 0) { if (tid < 465) btab[tid] = P.rpb[hx * 465 + tid] * 1.4426950408889634f; }
    const int qr = (q0 >> 6) + (wid >> 1), qc = (wid & 1) * 32 + r32;
    const int krow0 = min(max(qr - 4, 0), GROWS - 8), kcol0 = min(max(qc - 8, 0), GW - 16);
    float mref = 0.f, lsum = 0.f;
    f32x16 o0, o1, negm;
#pragma unroll
    for (int r = 0; r < 16; ++r) { o0[r] = 0.f; o1[r] = 0.f; negm[r] = 0.f; }
    const unsigned kfo = (r32 >> 3) * 1152 + (r32 & 7) * 128 + ((hi ^ (r32 & 7)) * 16);
    const unsigned rfo = 9216 + r32 * 64 + ((hi ^ ((r32 >> 2) & 3)) * 16);
    const unsigned vfo = KB + (4 * hi + ((lane & 15) >> 2)) * 128 + ((lane >> 3) & 1) * 64 + ((lane >> 4) & 1) * 32 + (lane & 3) * 8;
    constexpr int NG = 8 + 2 * NKS, AHEAD = 4, NGT = NG;
    if (wid < 4) { const size_t tr_ = A_TROW(0); GLDS16(vsrc + tr_ * kpitch, lds + (R - 1) * SLOT + KB + wid * 1024); GLDS16(vsrc + (tr_ + 32) * kpitch, lds + (R - 1) * SLOT + KB + (wid + 4) * 1024); }
#pragma unroll
    for (int j = 0; j < PF; ++j) { if (j < nt) A_DMA(j, j); }
    if (nt >= PF) A_WAITBAR(PF - 3); else A_WAITBAR(0);
    f32x16 sA0, sA1, sB0, sB1;
    { const ldsp kb_ = lds;
#pragma unroll
      for (int r = 0; r < 16; ++r) { sA0[r] = 0.f; sA1[r] = 0.f; }
#pragma unroll
      for (int ks = 0; ks < NKS; ++ks) { const ldsp a_ = kb_ + ((ks < 4) ? (kfo ^ (unsigned)(ks * 32)) : (rfo ^ (unsigned)((ks - 4) * 32)));
          const bf16x8 ka = *(const LAS bf16x8*)(a_), kb = *(const LAS bf16x8*)(a_ + ((ks < 4) ? 4608 : 2048));
          sA0 = __builtin_amdgcn_mfma_f32_32x32x16_bf16(ka, qf[ks], sA0, 0, 0, 0); sA1 = __builtin_amdgcn_mfma_f32_32x32x16_bf16(kb, qf[ks], sA1, 0, 0, 0); } }
    unsigned pwA[16], pwB[16];
#pragma unroll
    for (int i = 0; i < 16; ++i) { pwA[i] = 0u; pwB[i] = 0u; }
    int sl = 0;
#ifdef PROBE_T
    unsigned long long pt_acc = 0ull, pt_a = 0ull, pt_b = 0ull; const unsigned long long pt_t0 = __builtin_amdgcn_s_memtime(), pt_r0 = __builtin_amdgcn_s_memrealtime();
#define PT_A(k) do { if (PROBE_T == (k)) pt_a = __builtin_amdgcn_s_memtime(); } while (0)
#define PT_B(k) do { if (PROBE_T == (k)) { pt_b = __builtin_amdgcn_s_memtime(); pt_acc += pt_b - pt_a; } } while (0)
#else
#define PT_A(k) do { } while (0)
#define PT_B(k) do { } while (0)
#endif
#define S_EL(c0, c1, i) ((i) < 16 ? c0[(i) & 15] : c1[(i) & 15])
#define SB0() __builtin_amdgcn_sched_barrier(0)
    const unsigned lds0 = (unsigned)(size_t)lds;
#define DSR128(dst, addr, OFF) asm volatile("ds_read_b128 %0, %1 offset:" #OFF : "=v"(dst) : "v"(addr))
#define DSRTR(dst, addr, OFF) asm volatile("ds_read_b64_tr_b16 %0, %1 offset:" #OFF : "=v"(dst) : "v"(addr))
#define A_RD(m) do { switch (m) { \
        case 0: DSRTR(vL[0], vb_, 0); DSRTR(vH[0], vb_, 1024); break; case 1: DSRTR(vL[1], vc_, 0); DSRTR(vH[1], vc_, 1024); break; \
        case 2: DSRTR(vL[2], vb_, 2048); DSRTR(vH[2], vb_, 3072); break; case 3: DSRTR(vL[3], vc_, 2048); DSRTR(vH[3], vc_, 3072); break; \
        case 4: DSRTR(vL[4], vb_, 4096); DSRTR(vH[4], vb_, 5120); break; case 5: DSRTR(vL[5], vc_, 4096); DSRTR(vH[5], vc_, 5120); break; \
        case 6: DSRTR(vL[6], vb_, 6144); DSRTR(vH[6], vb_, 7168); break; case 7: DSRTR(vL[7], vc_, 6144); DSRTR(vH[7], vc_, 7168); break; \
        default: { const int q_ = (m) - 8, ks_ = q_ >> 1; \
                   if (ks_ < 4) { const unsigned a_ = kb_ + (kfo ^ (unsigned)(ks_ * 32)); if (q_ & 1) DSR128(kF[q_], a_, 4608); else DSR128(kF[q_], a_, 0); } \
                   else { const unsigned a_ = kb_ + (rfo ^ (unsigned)((ks_ - 4) * 32)); if (q_ & 1) DSR128(kF[q_], a_, 2048); else DSR128(kF[q_], a_, 0); } } break; } } while (0)
#define NRD(m) ((m) < 8 ? 2 : 1)
#define A_WT(g, n) do { if ((g) < 8) { if ((n) == 0) asm volatile("s_waitcnt lgkmcnt(0)" : "+v"(vL[g]), "+v"(vH[g])); else if ((n) == 1) asm volatile("s_waitcnt lgkmcnt(1)" : "+v"(vL[g]), "+v"(vH[g])); \
            else if ((n) == 2) asm volatile("s_waitcnt lgkmcnt(2)" : "+v"(vL[g]), "+v"(vH[g])); else if ((n) == 3) asm volatile("s_waitcnt lgkmcnt(3)" : "+v"(vL[g]), "+v"(vH[g])); \
            else if ((n) == 4) asm volatile("s_waitcnt lgkmcnt(4)" : "+v"(vL[g]), "+v"(vH[g])); else if ((n) == 5) asm volatile("s_waitcnt lgkmcnt(5)" : "+v"(vL[g]), "+v"(vH[g])); \
            else if ((n) == 6) asm volatile("s_waitcnt lgkmcnt(6)" : "+v"(vL[g]), "+v"(vH[g])); else if ((n) == 7) asm volatile("s_waitcnt lgkmcnt(7)" : "+v"(vL[g]), "+v"(vH[g])); \
            else asm volatile("s_waitcnt lgkmcnt(8)" : "+v"(vL[g]), "+v"(vH[g])); } \
        else { if ((n) == 0) asm volatile("s_waitcnt lgkmcnt(0)" : "+v"(kF[(g) - 8])); else if ((n) == 1) asm volatile("s_waitcnt lgkmcnt(1)" : "+v"(kF[(g) - 8])); \
            else if ((n) == 2) asm volatile("s_waitcnt lgkmcnt(2)" : "+v"(kF[(g) - 8])); else if ((n) == 3) asm volatile("s_waitcnt lgkmcnt(3)" : "+v"(kF[(g) - 8])); \
            else asm volatile("s_waitcnt lgkmcnt(4)" : "+v"(kF[(g) - 8])); } } while (0)
#define A_ITER(t, c0, c1, n0, n1, pwO, pwN, EVEN) do { \
        const int s1 = (sl + 1 == R) ? 0 : sl + 1, sm1 = (sl == 0) ? R - 1 : sl - 1, sm2 = (sm1 == 0) ? R - 1 : sm1 - 1; \
        const bool feed = (t) + PF < nt; PT_A(4); \
        if (BR == 2) { if ((t) >= 4) { const int kb0 = klo + ((t) - 4) * 64 - tokq + 128; \
                _Pragma("unroll") for (int r = 0; r < 16; ++r) { const int d0 = kb0 + crow(r, hi); \
                    if ((unsigned)d0 > 256u) c0[r] = NEG; if ((unsigned)(d0 + 32) > 256u) c1[r] = NEG; } } } \
          \
        const unsigned vb_ = lds0 + sm1 * SLOT + vfo, vc_ = lds0 + sm1 * SLOT + (vfo ^ 64u); const unsigned kb_ = lds0 + s1 * SLOT; \
        s16x4 vL[8], vH[8]; bf16x8 kF[2 * NKS]; \
        _Pragma("unroll") for (int m = 0; m < AHEAD; ++m) A_RD(m); \
        float rm; \
        { const float a0 = max3f(c0[0], c0[1], c0[2]), a1 = max3f(c0[3], c0[4], c0[5]), a2 = max3f(c0[6], c0[7], c0[8]), a3 = max3f(c0[9], c0[10], c0[11]), \
                      a4 = max3f(c0[12], c0[13], c0[14]), a5 = max3f(c0[15], c1[0], c1[1]), a6 = max3f(c1[2], c1[3], c1[4]), a7 = max3f(c1[5], c1[6], c1[7]), \
                      a8 = max3f(c1[8], c1[9], c1[10]), a9 = max3f(c1[11], c1[12], c1[13]), a10 = fmaxf(c1[14], c1[15]); \
          const float b0 = max3f(a0, a1, a2), b1 = max3f(a3, a4, a5), b2 = max3f(a6, a7, a8), b3 = fmaxf(a9, a10); \
          rm = xhalf_max(fmaxf(fmaxf(b0, b1), fmaxf(b2, b3))); } \
        if ((t) == 0 || __any(rm > THR)) {                   \
            const float dl = ((t) == 0) ? rm : fmaxf(rm, 0.f); const float f = __builtin_amdgcn_exp2f(-dl); \
            mref += dl; lsum *= f; \
            _Pragma("unroll") for (int r = 0; r < 16; ++r) { c0[r] -= dl; c1[r] -= dl; o0[r] *= f; o1[r] *= f; negm[r] -= dl; } \
            _Pragma("unroll") for (int i = 0; i < 16; ++i) pwO[i] = cvtpk(__uint_as_float(pwO[i] << 16) * f, __uint_as_float(pwO[i] & 0xffff0000u) * f); } \
        float acs0 = 0.f, acs1 = 0.f; SB0(); PT_B(4); PT_A(5); \
        _Pragma("unroll") for (int g = 0; g < NGT; ++g) { \
              \
            if (g + AHEAD < NG) A_RD(g + AHEAD); \
              \
            if (g < NG) { int n_ = 0; _Pragma("unroll") for (int m = g + 1; m <= g + AHEAD; ++m) if (m < NG) n_ += NRD(m); A_WT(g, n_); } \
              \
            if (g < 8) { typedef unsigned u4 __attribute__((ext_vector_type(4))); const int s = g >> 1; \
                const u4 pw4 = {pwO[4 * s], pwO[4 * s + 1], pwO[4 * s + 2], pwO[4 * s + 3]}; const bf16x8 pfr = __builtin_bit_cast(bf16x8, pw4); \
                const bf16x8 vf = (bf16x8){vL[g][0], vL[g][1], vL[g][2], vL[g][3], vH[g][0], vH[g][1], vH[g][2], vH[g][3]}; \
                if ((g & 1) == 0) o0 = __builtin_amdgcn_mfma_f32_32x32x16_bf16(vf, pfr, o0, 0, 0, 0); else o1 = __builtin_amdgcn_mfma_f32_32x32x16_bf16(vf, pfr, o1, 0, 0, 0); } \
            else if (g < NG) { const int q_ = g - 8, ks = q_ >> 1; \
                if ((q_ & 1) == 0) n0 = __builtin_amdgcn_mfma_f32_32x32x16_bf16(kF[q_], qf[ks], ks == 0 ? negm : n0, 0, 0, 0); \
                else               n1 = __builtin_amdgcn_mfma_f32_32x32x16_bf16(kF[q_], qf[ks], ks == 0 ? negm : n1, 0, 0, 0); } \
              \
            if (g < 16) { const float e0 = __builtin_amdgcn_exp2f(S_EL(c0, c1, 2 * g)), e1 = __builtin_amdgcn_exp2f(S_EL(c0, c1, 2 * g + 1)); \
                pwN[g] = cvtpk(e0, e1); if ((g & 1) == 0) acs0 += e0 + e1; else acs1 += e0 + e1; } \
            SB0(); \
        } \
        lsum += acs0 + acs1; PT_B(5); PT_A(3); \
          \
          \
        if (EVEN) { const int sp0 = (sl + PF >= R) ? sl + PF - R : sl + PF, sp1 = (sp0 + 1 == R) ? 0 : sp0 + 1; \
                    if (feed) A_DMA((t) + PF, sp0); if ((t) + PF + 1 < nt) A_DMA((t) + PF + 1, sp1); \
                    if ((t) + 1 >= nt) A_WAITBAR(0); } \
        else { if ((t) + PF < nt) A_WAITBAR(PF - 3); else A_WAITBAR(0); } PT_B(3); \
        sl = s1; \
    } while (0)
    { int t = 0;
      for (; t + 1 < nt; t += 2) { A_ITER(t, sA0, sA1, sB0, sB1, pwA, pwB, 1); A_ITER(t + 1, sB0, sB1, sA0, sA1, pwB, pwA, 0); }
      if (t < nt) { A_ITER(t, sA0, sA1, sB0, sB1, pwA, pwB, 1);
#pragma unroll
          for (int i = 0; i < 16; ++i) pwA[i] = pwB[i]; } }
    { const int sm1 = (sl == 0) ? R - 1 : sl - 1; const ldsp vb_ = lds + sm1 * SLOT + vfo, vc_ = lds + sm1 * SLOT + (vfo ^ 64u);
#pragma unroll
      for (int s = 0; s < 4; ++s) {
          typedef unsigned u4 __attribute__((ext_vector_type(4))); const u4 pw4 = {pwA[4 * s], pwA[4 * s + 1], pwA[4 * s + 2], pwA[4 * s + 3]}; const bf16x8 pfr = __builtin_bit_cast(bf16x8, pw4);
#pragma unroll
          for (int d0 = 0; d0 < 2; ++d0) { const ldsp vp = (d0 ? vc_ : vb_) + s * 2048;
              const s16x4 lo = __builtin_bit_cast(s16x4, __builtin_amdgcn_ds_read_tr16_b64_v4i16((LAS v4i16_t*)vp)), hi4 = __builtin_bit_cast(s16x4, __builtin_amdgcn_ds_read_tr16_b64_v4i16((LAS v4i16_t*)(vp + 1024)));
              const bf16x8 vf = (bf16x8){lo[0], lo[1], lo[2], lo[3], hi4[0], hi4[1], hi4[2], hi4[3]};
              if (d0 == 0) o0 = __builtin_amdgcn_mfma_f32_32x32x16_bf16(vf, pfr, o0, 0, 0, 0); else o1 = __builtin_amdgcn_mfma_f32_32x32x16_bf16(vf, pfr, o1, 0, 0, 0); }
          } }
    asm volatile("s_waitcnt lgkmcnt(0)\n\ts_barrier" ::: "memory");
#ifdef PROBE_T
    if (BR == PROBE_BR && P.o32 && blockIdx.x == 0 && wid == PROBE_W && lane == 0) {
        const unsigned long long t1 = __builtin_amdgcn_s_memtime(), r1 = __builtin_amdgcn_s_memrealtime();
        float c;
        if (PROBE_T == 1) c = 1e-5f * (float)(t1 - pt_t0) / (float)nt;
        else if (PROBE_T == 2) c = 1e-3f * (float)(t1 - pt_t0) / (float)(r1 - pt_r0);
        else c = 1e-5f * (float)pt_acc / (float)nt;
        P.o32[0] = 1.f + c;
    }
#endif
#undef S_EL
#undef SB0
#undef A_ITER
#undef A_RD
#undef NRD
#undef A_WT
#undef DSR128
#undef DSRTR
    float ltot = xhalf_sum(lsum);
    if (BR == 2) ltot += __builtin_amdgcn_exp2f(P.sink[head] * 1.4426950408889634f - mref);
    const float inv = 1.f / ltot;
#ifdef PROBE_ATTN
    if (P.o32 && b == 1 && (ctxq || tokq < 1024 || tokq >= 7168)) {
        const int sub = ctxq ? 2048 + tokq : (tokq < 1024 ? tokq : 1024 + tokq - 7168);
        float* fp = P.o32 + (size_t)sub * D + BR * 256 + head * 64 + 4 * hi;
#pragma unroll
        for (int g = 0; g < 4; ++g)
#pragma unroll
            for (int j = 0; j < 4; ++j) { fp[8 * g + j] = o0[4 * g + j] * inv; fp[32 + 8 * g + j] = o1[4 * g + j] * inv; }
    }
#endif
    T* op = P.O + qrow * D + BR * 256 + head * 64 + 4 * hi;
#pragma unroll
    for (int g = 0; g < 4; ++g) {
        *(uint2*)(op + 8 * g) = pk4(o0[4 * g] * inv, o0[4 * g + 1] * inv, o0[4 * g + 2] * inv, o0[4 * g + 3] * inv);
        *(uint2*)(op + 32 + 8 * g) = pk4(o1[4 * g] * inv, o1[4 * g + 1] * inv, o1[4 * g + 2] * inv, o1[4 * g + 3] * inv);
    }
#undef A_TROW
#undef A_DMA
#undef A_WAITBAR
#undef A_ACTIVE
#undef A_QK
#undef A_STEP
}

__device__ __forceinline__ void attn_phase(ldsp lds, const AttnP& P, int bid, int nblk) {
    for (int u = bid; u < 512; u += nblk) attn_unit<3>(lds, P, u >> 7, (u >> 5) & 3, (u & 31) * 256, false);
    for (int u = bid; u < 512; u += nblk) attn_unit<1>(lds, P, u >> 7, (u >> 6) & 1, (u & 63) * 128, false);
    for (int u = bid; u < 512; u += nblk) attn_unit_l<0>(lds, P, u >> 7, (u >> 5) & 3, (u & 31) * 256, false);
    for (int u = bid; u < 512; u += nblk) attn_unit<2>(lds, P, u >> 7, (u >> 6) & 1, (u & 63) * 128, false);
    if (P.need_ctx) {
        for (int u = bid; u < 64; u += nblk) {
            const int br = u >> 4, bb = (u >> 2) & 3, x = u & 3;
            if (br == 0) attn_unit_l<0>(lds, P, bb, x, 0, true);
            else if (br == 1) attn_unit<1>(lds, P, bb, x >> 1, (x & 1) * 128, true);
            else if (br == 2) attn_unit<2>(lds, P, bb, x >> 1, (x & 1) * 128, true);
            else attn_unit<3>(lds, P, bb, x, 0, true);
        }
    }
}

constexpr size_t al256(size_t b) { return (b + 255) & ~(size_t)255; }
constexpr size_t NSLOT_ = (size_t)NB * NE * (CAP + CAPC);
constexpr size_t OFF_BAR = 0, OFF_MODV = OFF_BAR + al256(3456 * 4), OFF_TAB64 = OFF_MODV + al256((size_t)NL * 5 * MODW * 4), OFF_TAB32 = OFF_TAB64 + al256(128 * 16 * 8),
    OFF_RA = OFF_TAB32 + al256(128 * 8 * 8), OFF_RC = OFF_RA + al256((size_t)NROW * D * 2), OFF_XCA = OFF_RC + al256((size_t)NROW * D * 2), OFF_XCB = OFF_XCA + al256((size_t)NCTX * D * 4),
    OFF_AFF = OFF_XCB + al256((size_t)NCTX * D * 4), OFF_IDX = OFF_AFF + al256((size_t)NROW * NE * 4), OFF_GATEV = OFF_IDX + al256(NSLOT_ * 4), OFF_INV = OFF_GATEV + al256(NSLOT_ * 4),
    OFF_Z = OFF_INV + al256((size_t)NROW * NE * 4), OFF_WINT = OFF_Z + al256((size_t)NROW * ZW * 2), OFF_WQT = OFF_WINT + al256((size_t)NL * 6400 * D * 2), OFF_WKVT = OFF_WQT + al256((size_t)NL * 384 * 192 * 2),
    OFF_SS = OFF_WKVT + al256((size_t)NL * 512 * 128 * 2), OFF_WBT = OFF_SS + al256((size_t)NROW * 8 * 4), OFF_WOUTT = OFF_WBT + al256((size_t)NL * 4 * 1024 * 256 * 2), OFF_END = OFF_WOUTT + al256((size_t)NL * D * D * 2);
struct MP {
    const float *x_, *c_, *ctx_, *c_ctx_, *w_mod_, *b_mod_, *w_in_, *na_rpb_, *gqn_, *gkn_, *swa_sink_, *mqn_, *mkvn_, *w_qb_, *w_kvb_, *w_branch_, *w_out_,
                *ln1g_, *ln1b_, *ln2g_, *ln2b_, *w_router_, *w_gate_, *w_up_, *w_down_;
    float* out_; char* ws_;
    float* o32_; const float* pscale_;
    int ph_lo_, ph_hi_;
    __device__ __forceinline__ const float* x() const { return x_; }
    __device__ __forceinline__ const float* c() const { return c_; }
    __device__ __forceinline__ const float* ctx() const { return ctx_; }
    __device__ __forceinline__ const float* c_ctx() const { return c_ctx_; }
    __device__ __forceinline__ const float* w_mod() const { return w_mod_; }
    __device__ __forceinline__ const float* b_mod() const { return b_mod_; }
    __device__ __forceinline__ const float* w_in() const { return w_in_; }
    __device__ __forceinline__ const float* na_rpb() const { return na_rpb_; }
    __device__ __forceinline__ const float* gqn() const { return gqn_; }
    __device__ __forceinline__ const float* gkn() const { return gkn_; }
    __device__ __forceinline__ const float* swa_sink() const { return swa_sink_; }
    __device__ __forceinline__ const float* mqn() const { return mqn_; }
    __device__ __forceinline__ const float* mkvn() const { return mkvn_; }
    __device__ __forceinline__ const float* w_qb() const { return w_qb_; }
    __device__ __forceinline__ const float* w_kvb() const { return w_kvb_; }
    __device__ __forceinline__ const float* w_branch() const { return w_branch_; }
    __device__ __forceinline__ const float* w_out() const { return w_out_; }
    __device__ __forceinline__ const float* ln1g() const { return ln1g_; }
    __device__ __forceinline__ const float* ln1b() const { return ln1b_; }
    __device__ __forceinline__ const float* ln2g() const { return ln2g_; }
    __device__ __forceinline__ const float* ln2b() const { return ln2b_; }
    __device__ __forceinline__ const float* w_router() const { return w_router_; }
    __device__ __forceinline__ const float* w_gate() const { return w_gate_; }
    __device__ __forceinline__ const float* w_up() const { return w_up_; }
    __device__ __forceinline__ const float* w_down() const { return w_down_; }
    __device__ __forceinline__ float* out() const { return out_; }
    __device__ __forceinline__ char* ws() const { return ws_; }
    __device__ __forceinline__ float* o32() const { return o32_; }
    __device__ __forceinline__ const float* pscale() const { return pscale_; }
    __device__ __forceinline__ int ph_lo() const { return ph_lo_; }
    __device__ __forceinline__ int ph_hi() const { return ph_hi_; }
    __device__ __forceinline__ unsigned* bar() const { return (unsigned*)(ws() + OFF_BAR); }
    __device__ __forceinline__ float* modv() const { return (float*)(ws() + OFF_MODV); }
    __device__ __forceinline__ float2* tab64() const { return (float2*)(ws() + OFF_TAB64); }
    __device__ __forceinline__ float2* tab32() const { return (float2*)(ws() + OFF_TAB32); }
    __device__ __forceinline__ T* RA() const { return (T*)(ws() + OFF_RA); }
    __device__ __forceinline__ T* RC() const { return (T*)(ws() + OFF_RC); }
    __device__ __forceinline__ float* XCa() const { return (float*)(ws() + OFF_XCA); }
    __device__ __forceinline__ float* XCb() const { return (float*)(ws() + OFF_XCB); }
    __device__ __forceinline__ float* AFF() const { return (float*)(ws() + OFF_AFF); }
    __device__ __forceinline__ int* IDX() const { return (int*)(ws() + OFF_IDX); }
    __device__ __forceinline__ float* GATEV() const { return (float*)(ws() + OFF_GATEV); }
    __device__ __forceinline__ int* INV() const { return (int*)(ws() + OFF_INV); }
    __device__ __forceinline__ T* Z() const { return (T*)(ws() + OFF_Z); }
    __device__ __forceinline__ T* WinT() const { return (T*)(ws() + OFF_WINT); }
    __device__ __forceinline__ T* WqT() const { return (T*)(ws() + OFF_WQT); }
    __device__ __forceinline__ T* WkvT() const { return (T*)(ws() + OFF_WKVT); }
    __device__ __forceinline__ float* SS() const { return (float*)(ws() + OFF_SS); }
    __device__ __forceinline__ T* WbT() const { return (T*)(ws() + OFF_WBT); }
    __device__ __forceinline__ T* WoutT() const { return (T*)(ws() + OFF_WOUTT); }
};

__device__ __forceinline__ void ph_mod(ldsp lds, const MP& p, int bid, int nblk) {
    LAS float* sc = (LAS float*)lds;
    LAS float* red = (LAS float*)(lds + 5 * 1024 * 4);
    const int tid = otid(), lane = tid & 63, kg = tid >> 6;
    for (int i = tid; i < 5 * 1024; i += 512) { const int s = i >> 10, k = i & 1023; const float v = s < 4 ? p.c()[s * 1024 + k] : p.c_ctx()[k]; sc[i] = v / (1.f + expf(-v)); }
    __syncthreads();
    for (int u = bid; u < NL * (MODW / 64); u += nblk) {
        const int l = u / (MODW / 64), j = (u % (MODW / 64)) * 64 + lane;
        float acc[5] = {0.f, 0.f, 0.f, 0.f, 0.f};
        const float* w = p.w_mod() + (size_t)l * D * MODW + j;
        for (int k = kg * 128; k < kg * 128 + 128; ++k) { const float wv = w[(size_t)k * MODW];
#pragma unroll
            for (int s = 0; s < 5; ++s) acc[s] += sc[s * 1024 + k] * wv; }
#pragma unroll
        for (int s = 0; s < 5; ++s) red[(kg * 5 + s) * 64 + lane] = acc[s];
        __syncthreads();
        if (kg < 5) { const int s = kg; float v = p.b_mod()[l * MODW + j];
#pragma unroll
            for (int g = 0; g < 8; ++g) v += red[(g * 5 + s) * 64 + lane];
            p.modv()[((size_t)l * 5 + s) * MODW + j] = v; }
        __syncthreads();
    }
}
__device__ __forceinline__ void ph_ropetab(const MP& p, int bid, int nblk) {
    for (int t = bid * 512 + otid(); t < 128 * 16; t += nblk * 512) {
        { const int pos = t / 16, i = t % 16; const float a = (float)pos * powf(10000.f, -(float)i / 16.f); p.tab64()[t] = make_float2(cosf(a), sinf(a)); }
        if (t < 128 * 8) { const int pos = t / 8, i = t % 8; const float a = (float)pos * powf(10000.f, -(float)i / 8.f); p.tab32()[t] = make_float2(cosf(a), sinf(a)); }
    }
}
struct PrepJob { const float* src; const float* src2; const float* kscale; T* dst; int K, Nsrc, Ndst, mode, nz, perm; long long src_zs, dst_zs, ks_zs; };
__device__ __forceinline__ void ph_wprep(ldsp lds, const PrepJob& a, int bid, int nblk) {
    constexpr int NT = 4;
    LAS float* tile = (LAS float*)lds;
    const int tid_ = otid();
    const int kr = tid_ >> 4, c4 = tid_ & 15;
    const int kq = tid_ & 7, nr = tid_ >> 3;
    const int nx = a.Ndst / 64, ny = a.K / 64, ntile = nx * ny * a.nz;
    float4 v0[NT], v1[NT];
#define WP_LOAD(i, u) do { const int z_ = (u) / (nx * ny), rem_ = (u) % (nx * ny), n0_ = (rem_ % nx) * 64, k0_ = (rem_ / nx) * 64; \
        const float* src_ = a.src + (size_t)z_ * a.src_zs; const float* ksc_ = a.kscale ? a.kscale + (size_t)z_ * a.ks_zs : nullptr; \
        int n_ = n0_ + 4 * c4; if (a.perm) { const int p_ = n_ & 255; n_ = (n_ & ~255) + 64 * ((p_ >> 5) & 3) + 32 * (p_ >> 7) + (p_ & 31); } bool valid_ = true; int col_ = n_; const float* sp_ = src_; \
        if (a.mode == 0) { valid_ = n_ < a.Nsrc; } \
        else if (a.mode == 1) { if (n_ < 2144) col_ = n_; else if (n_ < 2304) valid_ = false; else col_ = n_ - 160; } \
        else { const int j_ = n_ >> 6, w_ = n_ & 63; if (w_ >= 32) sp_ = a.src2 + (size_t)z_ * a.src_zs; col_ = 32 * j_ + (w_ & 31); } \
        v0[i] = make_float4(0.f, 0.f, 0.f, 0.f); v1[i] = v0[i]; \
        if (valid_) { v0[i] = *(const float4*)(sp_ + (size_t)(k0_ + kr) * a.Nsrc + col_); v1[i] = *(const float4*)(sp_ + (size_t)(k0_ + kr + 32) * a.Nsrc + col_); \
            if (ksc_) { const float s0_ = ksc_[k0_ + kr], s1_ = ksc_[k0_ + kr + 32]; v0[i].x *= s0_; v0[i].y *= s0_; v0[i].z *= s0_; v0[i].w *= s0_; v1[i].x *= s1_; v1[i].y *= s1_; v1[i].z *= s1_; v1[i].w *= s1_; } } } while (0)
    int u = bid, buf = 0;
#pragma unroll
    for (int i = 0; i < NT; ++i) { if (u + i * nblk < ntile) WP_LOAD(i, u + i * nblk); }
    for (; u < ntile; u += NT * nblk) {
        LAS float* tb = tile + buf * (NT * 64 * 65);
#pragma unroll
        for (int i = 0; i < NT; ++i) { if (u + i * nblk < ntile) { LAS float* w0 = tb + i * (64 * 65) + kr * 65 + 4 * c4; LAS float* w1 = w0 + 32 * 65;
            w0[0] = v0[i].x; w0[1] = v0[i].y; w0[2] = v0[i].z; w0[3] = v0[i].w; w1[0] = v1[i].x; w1[1] = v1[i].y; w1[2] = v1[i].z; w1[3] = v1[i].w; } }
        __syncthreads();
#pragma unroll
        for (int i = 0; i < NT; ++i) { const int un = u + (NT + i) * nblk; if (un < ntile) WP_LOAD(i, un); }
#pragma unroll
        for (int i = 0; i < NT; ++i) { const int ui = u + i * nblk; if (ui < ntile) {
            const int z = ui / (nx * ny), rem = ui % (nx * ny), n0 = (rem % nx) * 64, k0 = (rem / nx) * 64;
            T* dst = a.dst + (size_t)z * a.dst_zs;
            const LAS float* rp = tb + i * (64 * 65) + (kq * 8) * 65 + nr;
            *(uint4*)(dst + (size_t)(n0 + nr) * a.K + k0 + kq * 8) = make_uint4(pk2(rp[0], rp[65]), pk2(rp[130], rp[195]), pk2(rp[260], rp[325]), pk2(rp[390], rp[455])); } }
        buf ^= 1;
    }
#undef WP_LOAD
    __syncthreads();
}
__device__ __forceinline__ void lnmod_row(const float* src, const float* mv, int sh_off, int sc_off, T* dst, int lane) {
    float4 v[4]; float sum = 0.f;
#pragma unroll
    for (int i = 0; i < 4; ++i) { v[i] = *(const float4*)(src + i * 256 + lane * 4); sum += v[i].x + v[i].y + v[i].z + v[i].w; }
    const float mean = wave_sum(sum) * (1.f / D);
    float sq = 0.f;
#pragma unroll
    for (int i = 0; i < 4; ++i) { float a = v[i].x - mean, b = v[i].y - mean, c = v[i].z - mean, d = v[i].w - mean; sq += a * a + b * b + c * c + d * d; }
    const float rstd = 1.f / sqrtf(wave_sum(sq) * (1.f / D) + EPS);
#pragma unroll
    for (int i = 0; i < 4; ++i) {
        const int col = i * 256 + lane * 4;
        const float4 sh = *(const float4*)(mv + sh_off + col), sc = *(const float4*)(mv + sc_off + col);
        st4(dst + col, make_float4((v[i].x - mean) * rstd * (1.f + sc.x) + sh.x, (v[i].y - mean) * rstd * (1.f + sc.y) + sh.y,
                                   (v[i].z - mean) * rstd * (1.f + sc.z) + sh.z, (v[i].w - mean) * rstd * (1.f + sc.w) + sh.w));
    }
}
__device__ __forceinline__ void ph_lnmod0(const MP& p, int bid, int nblk) {
    const int tid_ = otid(); const int lane = tid_ & 63, wid = tid_ >> 6;
    for (int row = bid * 8 + wid; row < NROW; row += nblk * 8) {
        const bool lat = row < NLAT;
        const float* src = lat ? p.x() + (size_t)row * D : p.ctx() + (size_t)(row - NLAT) * D;
        const int s = lat ? row / SEQ : 4;
        lnmod_row(src, p.modv() + (size_t)s * MODW, 0, D, p.RA() + (size_t)row * D, lane);
    }
}
__device__ __forceinline__ void ph_lnres(ldsp lds, const MP& p, int l, int nrows, int bid, int nblk) {
    const int tid_ = otid(); const int lane = tid_ & 63, wid = tid_ >> 6;
    const float* modl = p.modv() + (size_t)l * 5 * MODW;
    const float* lgp = p.ln1g() + l * D; const float* lbp = p.ln1b() + l * D; const float* wr = p.w_router() + (size_t)l * D * NE;
    LAS float* WT = (LAS float*)lds;
    for (int i = tid_; i < NE * D; i += 512) { const int e = i >> 10, col = i & 1023; WT[i] = wr[col * NE + e]; }
    __syncthreads();
    const bool b5 = lane & 32, b4 = lane & 16, b3 = lane & 8, b2 = lane & 4;
    const int stride = nblk * 8;
    const float* xlat = l == 0 ? p.x() : p.out(); const float* xctx = l == 0 ? p.ctx() : p.XCb();
    float4 lgv[4], lbv[4], gv[4], shv[4], scv[4];
#pragma unroll
    for (int i = 0; i < 4; ++i) { lgv[i] = *(const float4*)(lgp + i * 256 + lane * 4); lbv[i] = *(const float4*)(lbp + i * 256 + lane * 4); }
    int cur_s = -1;
    int row = bid * 8 + wid;
    float4 xn[4]; uint2 yn[4];
#define LR_LOAD(r) do { const float* xs_ = (r) < NLAT ? xlat + (size_t)(r) * D : xctx + (size_t)((r) - NLAT) * D; const T* yp_ = p.RA() + (size_t)(r) * D; \
        _Pragma("unroll") for (int i = 0; i < 4; ++i) { xn[i] = *(const float4*)(xs_ + i * 256 + lane * 4); yn[i] = *(const uint2*)(yp_ + i * 256 + lane * 4); } } while (0)
    if (row < nrows) LR_LOAD(row);
    for (; row < nrows; row += stride) {
        float4 xc[4]; uint2 yc[4];
#pragma unroll
        for (int i = 0; i < 4; ++i) { xc[i] = xn[i]; yc[i] = yn[i]; }
        if (row + stride < nrows) LR_LOAD(row + stride);
        const bool lat = row < NLAT;
        float* xo = lat ? p.out() + (size_t)row * D : p.XCa() + (size_t)(row - NLAT) * D;
        const int s = lat ? row / SEQ : 4;
        if (s != cur_s) { cur_s = s; const float* mv = modl + (size_t)s * MODW;
#pragma unroll
            for (int i = 0; i < 4; ++i) { gv[i] = *(const float4*)(mv + 2 * D + i * 256 + lane * 4); shv[i] = *(const float4*)(mv + 3 * D + i * 256 + lane * 4); scv[i] = *(const float4*)(mv + 4 * D + i * 256 + lane * 4); } }
        float v[16]; float sum = 0.f;
#pragma unroll
        for (int i = 0; i < 4; ++i) {
            const float y0 = __uint_as_float(yc[i].x << 16), y1 = __uint_as_float(yc[i].x & 0xffff0000u), y2 = __uint_as_float(yc[i].y << 16), y3 = __uint_as_float(yc[i].y & 0xffff0000u);
            v[i * 4 + 0] = ALPHA * xc[i].x + gv[i].x * y0; v[i * 4 + 1] = ALPHA * xc[i].y + gv[i].y * y1; v[i * 4 + 2] = ALPHA * xc[i].z + gv[i].z * y2; v[i * 4 + 3] = ALPHA * xc[i].w + gv[i].w * y3;
            sum += v[i * 4] + v[i * 4 + 1] + v[i * 4 + 2] + v[i * 4 + 3];
        }
        const float mean = wave_sum(sum) * (1.f / D);
        float sq = 0.f;
#pragma unroll
        for (int i = 0; i < 16; ++i) { const float d = v[i] - mean; sq += d * d; }
        const float rstd = 1.f / sqrtf(wave_sum(sq) * (1.f / D) + EPS);
        float s2 = 0.f;
#pragma unroll
        for (int i = 0; i < 4; ++i) {
            v[i * 4 + 0] = (v[i * 4 + 0] - mean) * rstd * lgv[i].x + lbv[i].x; v[i * 4 + 1] = (v[i * 4 + 1] - mean) * rstd * lgv[i].y + lbv[i].y;
            v[i * 4 + 2] = (v[i * 4 + 2] - mean) * rstd * lgv[i].z + lbv[i].z; v[i * 4 + 3] = (v[i * 4 + 3] - mean) * rstd * lgv[i].w + lbv[i].w;
            *(float4*)(xo + i * 256 + lane * 4) = make_float4(v[i * 4], v[i * 4 + 1], v[i * 4 + 2], v[i * 4 + 3]);
            s2 += v[i * 4] + v[i * 4 + 1] + v[i * 4 + 2] + v[i * 4 + 3];
        }
        const float mean2 = wave_sum(s2) * (1.f / D);
        float sq2 = 0.f;
#pragma unroll
        for (int i = 0; i < 16; ++i) { const float d = v[i] - mean2; sq2 += d * d; }
        const float rstd2 = 1.f / sqrtf(wave_sum(sq2) * (1.f / D) + EPS);
        float h2[16];
#pragma unroll
        for (int i = 0; i < 4; ++i) {
            h2[i * 4 + 0] = (v[i * 4 + 0] - mean2) * rstd2 * (1.f + scv[i].x) + shv[i].x; h2[i * 4 + 1] = (v[i * 4 + 1] - mean2) * rstd2 * (1.f + scv[i].y) + shv[i].y;
            h2[i * 4 + 2] = (v[i * 4 + 2] - mean2) * rstd2 * (1.f + scv[i].z) + shv[i].z; h2[i * 4 + 3] = (v[i * 4 + 3] - mean2) * rstd2 * (1.f + scv[i].w) + shv[i].w;
            st4(p.RC() + (size_t)row * D + i * 256 + lane * 4, make_float4(h2[i * 4], h2[i * 4 + 1], h2[i * 4 + 2], h2[i * 4 + 3]));
        }
        float lg[16];
#pragma unroll
        for (int e = 0; e < 16; ++e) {
            float a = 0.f;
#pragma unroll
            for (int i = 0; i < 4; ++i) { const f32x4 w = *(const LAS f32x4*)(WT + e * D + i * 256 + lane * 4); a += h2[i * 4] * w.x + h2[i * 4 + 1] * w.y + h2[i * 4 + 2] * w.z + h2[i * 4 + 3] * w.w; }
            lg[e] = a;
            if (e & 1) __builtin_amdgcn_sched_barrier(0);
        }
        float a8[8], a4[4], a2[2];
#pragma unroll
        for (int k = 0; k < 8; ++k) {
            auto rr = __builtin_amdgcn_permlane32_swap(__float_as_uint(lg[k]), __float_as_uint(lg[8 + k]), false, false);
            a8[k] = __uint_as_float(rr[0]) + __uint_as_float(rr[1]); }
#pragma unroll
        for (int k = 0; k < 4; ++k) { const float mine = b4 ? a8[4 + k] : a8[k], oth = b4 ? a8[k] : a8[4 + k]; a4[k] = mine + __shfl_xor(oth, 16); }
#pragma unroll
        for (int k = 0; k < 2; ++k) { const float mine = b3 ? a4[2 + k] : a4[k], oth = b3 ? a4[k] : a4[2 + k]; a2[k] = mine + __shfl_xor(oth, 8); }
        float lgt = (b2 ? a2[1] : a2[0]) + __shfl_xor(b2 ? a2[0] : a2[1], 4);
        lgt = DPP_ADD(lgt, 0xB1); lgt = DPP_ADD(lgt, 0x4E);
        float mx = lgt;
        mx = fmaxf(mx, __shfl_xor(mx, 4)); mx = fmaxf(mx, __shfl_xor(mx, 8)); mx = fmaxf(mx, __shfl_xor(mx, 16)); mx = fmaxf(mx, __shfl_xor(mx, 32));
        const float ex = expf(lgt - mx);
        float den = ex;
        den += __shfl_xor(den, 4); den += __shfl_xor(den, 8); den += __shfl_xor(den, 16); den += __shfl_xor(den, 32);
        if ((lane & 3) == 0) p.AFF()[(size_t)row * NE + (lane >> 2)] = ex / den;
    }
#undef LR_LOAD
    __syncthreads();
}
__device__ __forceinline__ void ph_topk(ldsp lds, const MP& p, int nkinds, int bid, int nblk) {
    LAS unsigned* keys = (LAS unsigned*)lds;
    LAS unsigned* hist = (LAS unsigned*)(lds + 32768);
    LAS unsigned* part = (LAS unsigned*)(lds + 32768 + 8192);
    LAS unsigned* shv = (LAS unsigned*)(lds + 32768 + 8192 + 1024);
    const int tid = otid(), lane = tid & 63, wv = tid >> 6;
    for (int u = bid; u < NE * NB * nkinds; u += nblk) {
        const int e = u % NE, bl = (u / NE) % NB, kind = u / (NE * NB);
        const int n = kind ? CTX : SEQ, kk = kind ? CAPC : CAP;
        const size_t row0 = kind ? (size_t)NLAT + (size_t)bl * CTX : (size_t)bl * SEQ;
        const size_t grp = kind ? (size_t)NB * NE * CAP + ((size_t)e * NB + bl) * CAPC : ((size_t)bl * NE + e) * CAP;
        for (int i = tid; i < n; i += 512) keys[i] = __float_as_uint(p.AFF()[(row0 + i) * NE + e]);
        __syncthreads();
        unsigned prefix = 0, rem = kk;
        for (int pass = 0; pass < 3; ++pass) {
            const int shift = pass == 0 ? 21 : pass == 1 ? 10 : 0;
            const int nbm = pass == 2 ? 1023 : 2047;
            const int hshift = pass == 1 ? 21 : 10;
            for (int i = tid; i < 2048; i += 512) hist[i] = 0;
            __syncthreads();
            for (int i = tid; i < n; i += 512) { const unsigned k = keys[i]; const bool match = (pass == 0) || ((k >> hshift) == prefix); if (match) atomicAdd((unsigned*)&hist[(k >> shift) & nbm], 1u); }
            __syncthreads();
            unsigned loc = 0;
            if (tid < 256) { for (int j = 0; j < 8; ++j) loc += hist[tid * 8 + j]; part[tid] = loc; }
            __syncthreads();
            if (tid < 256) {
                unsigned above = 0;
                for (int j = tid + 1; j < 256; ++j) above += part[j];
                if (above < rem && above + loc >= rem) {
                    unsigned cum = above; int bsel = tid * 8 + 7;
                    for (; bsel >= tid * 8; --bsel) { const unsigned hc = hist[bsel]; if (cum + hc >= rem) break; cum += hc; }
                    shv[0] = (unsigned)bsel; shv[1] = rem - cum;
                }
            }
            __syncthreads();
            prefix = (pass == 0) ? shv[0] : ((prefix << (pass == 1 ? 11 : 10)) | shv[0]);
            rem = shv[1];
            __syncthreads();
        }
        const unsigned Tkey = prefix;
        unsigned base_gt = 0, base_eq = 0;
        for (int c0 = 0; c0 < n; c0 += 512) {
            const int i = c0 + tid; const bool inr = i < n;
            const unsigned k = inr ? keys[i] : 0u;
            const bool gt = inr && k > Tkey, eq = inr && k == Tkey;
            const unsigned long long mg = __ballot(gt), me = __ballot(eq);
            const unsigned long long lt = (1ull << lane) - 1ull;
            if (lane == 0) { shv[8 + wv] = __popcll(mg); shv[16 + wv] = __popcll(me); }
            __syncthreads();
            unsigned pg = base_gt + __popcll(mg & lt), pe = base_eq + __popcll(me & lt), tg = 0, te = 0;
            for (int w = 0; w < 8; ++w) { const unsigned a = shv[8 + w], b = shv[16 + w]; if (w < wv) { pg += a; pe += b; } tg += a; te += b; }
            const bool sel = gt || (eq && pe < rem);
            const unsigned slot = pg + min(pe, rem);
            if (inr) { if (sel) { p.IDX()[grp + slot] = (int)(row0 + i); p.GATEV()[grp + slot] = __uint_as_float(k); }
                       p.INV()[(row0 + i) * NE + e] = sel ? (int)slot : -1; }
            base_gt += tg; base_eq += te;
            __syncthreads();
        }
    }
}
__device__ __forceinline__ void ph_combine(const MP& p, int l, int nrows, const T* OUT, int bid, int nblk) {
    const int tid_ = otid(); const int lane = tid_ & 63, wid = tid_ >> 6;
    const float* modl = p.modv() + (size_t)l * 5 * MODW;
    const float* lgp = p.ln2g() + l * D; const float* lbp = p.ln2b() + l * D;
    const bool next = l + 1 < NL;
    const int stride = nblk * 8;
    float4 lgv[4], lbv[4], gv[4];
#pragma unroll
    for (int i = 0; i < 4; ++i) { lgv[i] = *(const float4*)(lgp + i * 256 + lane * 4); lbv[i] = *(const float4*)(lbp + i * 256 + lane * 4); }
    int cur_s = -1;
    int row = bid * 8 + wid;
    int sl_next = -1; float4 xn[4];
#define CB_LOAD(r) do { const float* xs_ = (r) < NLAT ? p.out() + (size_t)(r) * D : p.XCa() + (size_t)((r) - NLAT) * D; \
        _Pragma("unroll") for (int i = 0; i < 4; ++i) xn[i] = *(const float4*)(xs_ + i * 256 + lane * 4); \
        sl_next = lane < NE ? p.INV()[(size_t)(r) * NE + lane] : -1; } while (0)
    if (row < nrows) CB_LOAD(row);
    for (; row < nrows; row += stride) {
        float4 xc[4];
#pragma unroll
        for (int i = 0; i < 4; ++i) xc[i] = xn[i];
        const int slv = sl_next;
        if (row + stride < nrows) CB_LOAD(row + stride);
        const bool lat = row < NLAT;
        float* xo = lat ? p.out() + (size_t)row * D : p.XCb() + (size_t)(row - NLAT) * D;
        const int bl = lat ? row / SEQ : (row - NLAT) / CTX;
        const int s = lat ? bl : 4;
        if (s != cur_s) { cur_s = s; const float* mv = modl + (size_t)s * MODW;
#pragma unroll
            for (int i = 0; i < 4; ++i) gv[i] = *(const float4*)(mv + 5 * D + i * 256 + lane * 4); }
        unsigned long long mask = __ballot(slv >= 0) & 0xffffull;
        uint2 ob[4][4]; bool ok[4];
#pragma unroll
        for (int j = 0; j < 4; ++j) {
            ok[j] = mask != 0ull;
            if (ok[j]) {
                const int e = __builtin_ctzll(mask); mask &= mask - 1;
                const int sl = __builtin_amdgcn_readlane(slv, e);
                const size_t orow = lat ? ((size_t)bl * NE + e) * CAP + sl : (size_t)NB * NE * CAP + ((size_t)e * NB + bl) * CAPC + sl;
                const T* op = OUT + orow * D;
#pragma unroll
                for (int i = 0; i < 4; ++i) ob[j][i] = *(const uint2*)(op + i * 256 + lane * 4);
            } else {
#pragma unroll
                for (int i = 0; i < 4; ++i) ob[j][i] = make_uint2(0u, 0u);
            }
        }
        float y[16];
#pragma unroll
        for (int i = 0; i < 16; ++i) y[i] = 0.f;
#pragma unroll
        for (int j = 0; j < 4; ++j)
#pragma unroll
            for (int i = 0; i < 4; ++i) { y[i * 4] += __uint_as_float(ob[j][i].x << 16); y[i * 4 + 1] += __uint_as_float(ob[j][i].x & 0xffff0000u); y[i * 4 + 2] += __uint_as_float(ob[j][i].y << 16); y[i * 4 + 3] += __uint_as_float(ob[j][i].y & 0xffff0000u); }
        while (mask) {
            const int e = __builtin_ctzll(mask); mask &= mask - 1;
            const int sl = __builtin_amdgcn_readlane(slv, e);
            const size_t orow = lat ? ((size_t)bl * NE + e) * CAP + sl : (size_t)NB * NE * CAP + ((size_t)e * NB + bl) * CAPC + sl;
            const T* op = OUT + orow * D;
#pragma unroll
            for (int i = 0; i < 4; ++i) { const float4 o4 = ld4(op + i * 256 + lane * 4); y[i * 4] += o4.x; y[i * 4 + 1] += o4.y; y[i * 4 + 2] += o4.z; y[i * 4 + 3] += o4.w; }
        }
        float v[16]; float sum = 0.f;
#pragma unroll
        for (int i = 0; i < 4; ++i) {
            v[i * 4 + 0] = ALPHA * xc[i].x + gv[i].x * y[i * 4 + 0]; v[i * 4 + 1] = ALPHA * xc[i].y + gv[i].y * y[i * 4 + 1]; v[i * 4 + 2] = ALPHA * xc[i].z + gv[i].z * y[i * 4 + 2]; v[i * 4 + 3] = ALPHA * xc[i].w + gv[i].w * y[i * 4 + 3];
            sum += v[i * 4] + v[i * 4 + 1] + v[i * 4 + 2] + v[i * 4 + 3];
        }
        const float mean = wave_sum(sum) * (1.f / D);
        float sq = 0.f;
#pragma unroll
        for (int i = 0; i < 16; ++i) { const float d = v[i] - mean; sq += d * d; }
        const float rstd = 1.f / sqrtf(wave_sum(sq) * (1.f / D) + EPS);
        float s2 = 0.f;
#pragma unroll
        for (int i = 0; i < 4; ++i) {
            v[i * 4 + 0] = (v[i * 4 + 0] - mean) * rstd * lgv[i].x + lbv[i].x; v[i * 4 + 1] = (v[i * 4 + 1] - mean) * rstd * lgv[i].y + lbv[i].y;
            v[i * 4 + 2] = (v[i * 4 + 2] - mean) * rstd * lgv[i].z + lbv[i].z; v[i * 4 + 3] = (v[i * 4 + 3] - mean) * rstd * lgv[i].w + lbv[i].w;
            { const float ps_ = (!next && p.pscale()) ? p.pscale()[0] : 1.f;
              *(float4*)(xo + i * 256 + lane * 4) = make_float4(v[i * 4] * ps_, v[i * 4 + 1] * ps_, v[i * 4 + 2] * ps_, v[i * 4 + 3] * ps_); }
            s2 += v[i * 4] + v[i * 4 + 1] + v[i * 4 + 2] + v[i * 4 + 3];
        }
        if (next) {
            const float* mvn = p.modv() + ((size_t)(l + 1) * 5 + s) * MODW;
            const float mean2 = wave_sum(s2) * (1.f / D);
            float sq2 = 0.f;
#pragma unroll
            for (int i = 0; i < 16; ++i) { const float d = v[i] - mean2; sq2 += d * d; }
            const float rstd2 = 1.f / sqrtf(wave_sum(sq2) * (1.f / D) + EPS);
#pragma unroll
            for (int i = 0; i < 4; ++i) {
                const int col = i * 256 + lane * 4;
                const float4 sh = *(const float4*)(mvn + col), sc = *(const float4*)(mvn + D + col);
                st4(p.RA() + (size_t)row * D + col, make_float4((v[i * 4 + 0] - mean2) * rstd2 * (1.f + sc.x) + sh.x, (v[i * 4 + 1] - mean2) * rstd2 * (1.f + sc.y) + sh.y,
                                                             (v[i * 4 + 2] - mean2) * rstd2 * (1.f + sc.z) + sh.z, (v[i * 4 + 3] - mean2) * rstd2 * (1.f + sc.w) + sh.w));
            }
        }
    }
#undef CB_LOAD
}


#define XB_TMO      128
#define XB_XCNT(j)  (256  + 64 * (j))
#define XB_XSUB(j)  (1280 + 64 * (j))
#define XB_XGEN(j)  (2304 + 64 * (j))
#define XB_TOP      3328
#define XB_TOPGEN   3392
#define XCD_BAR_WORDS 3456
#define XB_SPIN_CAP (1u << 18)
__device__ __forceinline__ unsigned xb_ld(unsigned* p)              { return __hip_atomic_load(p, __ATOMIC_RELAXED, __HIP_MEMORY_SCOPE_AGENT); }
__device__ __forceinline__ unsigned xb_add(unsigned* p, unsigned v) { return __hip_atomic_fetch_add(p, v, __ATOMIC_RELAXED, __HIP_MEMORY_SCOPE_AGENT); }
__device__ __forceinline__ unsigned xb_xcc_id() { return (unsigned)__builtin_amdgcn_s_getreg((3 << 11) | 20) & 0xFu; }
#define XB_SPIN(cond, bar) do { unsigned _sp = 0; while (cond) { __builtin_amdgcn_s_sleep(1); \
    if ((++_sp & 255u) == 0u) { if (xb_ld(&(bar)[XB_TMO])) break; if (_sp > XB_SPIN_CAP) { atomicAdd(&(bar)[XB_TMO], 1u); break; } } } } while (0)
struct XcdBarrier { unsigned* bar; unsigned x; volatile LAS unsigned* st; };
__device__ __forceinline__ XcdBarrier xcd_barrier_post(unsigned* bar, volatile LAS unsigned* st) {
    XcdBarrier b; b.bar = bar; b.x = xb_xcc_id(); b.st = st;
    if (threadIdx.x == 0) (void)xb_add(&bar[XB_XCNT(b.x)], 1u);
    return b;
}
__device__ __forceinline__ void xcd_barrier_complete(unsigned* bar, unsigned x, unsigned& nloc, unsigned& nx) {
    const unsigned G = gridDim.x * gridDim.y * gridDim.z;
    unsigned sum, cnt, mine, sp = 0u;
    for (;;) {
        sum = 0u; cnt = 0u; mine = 0u;
#pragma unroll
        for (unsigned j = 0; j < 16; ++j) { const unsigned c = xb_ld(&bar[XB_XCNT(j)]); sum += c; cnt += (c > 0u) ? 1u : 0u; mine = (j == x) ? c : mine; }
        if (sum == G) break;
        __builtin_amdgcn_s_sleep(1);
        if ((++sp & 255u) == 0u) { if (xb_ld(&bar[XB_TMO])) break; if (sp > XB_SPIN_CAP) { atomicAdd(&bar[XB_TMO], 1u); break; } }
    }
    nloc = mine > 0u ? mine : 1u; nx = cnt > 0u ? cnt : 1u;
}
__device__ __forceinline__ void xcd_barrier(const XcdBarrier& b) {
    asm volatile("s_waitcnt vmcnt(0)" ::: "memory");
    __syncthreads();
    if (threadIdx.x == 0) {
        unsigned* bar = b.bar;
        __builtin_amdgcn_s_waitcnt(0);
        unsigned nloc = b.st[0], nx = b.st[1];
        if (nloc == 0u) { xcd_barrier_complete(bar, b.x, nloc, nx); b.st[0] = nloc; b.st[1] = nx; }
        const unsigned old = xb_add(&bar[XB_XSUB(b.x)], 1u);
        const unsigned gen = old / nloc;
        if (old + 1u == (gen + 1u) * nloc) {
            __builtin_amdgcn_fence(__ATOMIC_RELEASE, "agent");
            asm volatile("s_waitcnt vmcnt(0)" ::: "memory");
            const unsigned og = xb_add(&bar[XB_TOP], 1u);
            const unsigned tg = og / nx;
            if (og + 1u == (tg + 1u) * nx) xb_add(&bar[XB_TOPGEN], 1u);
            else XB_SPIN(xb_ld(&bar[XB_TOPGEN]) == tg, bar);
            __builtin_amdgcn_fence(__ATOMIC_ACQUIRE, "agent");
            xb_add(&bar[XB_XGEN(b.x)], 1u);
            asm volatile("s_waitcnt vmcnt(0)" ::: "memory");
        } else {
            XB_SPIN(xb_ld(&bar[XB_XGEN(b.x)]) == gen, bar);
            __builtin_amdgcn_fence(__ATOMIC_ACQUIRE, "agent");
            asm volatile("s_waitcnt vmcnt(0)" ::: "memory");
        }
    }
    __syncthreads();
}

#ifdef PROBE_L0
__global__ void __launch_bounds__(256) k_cmp2(const float* a, const float* b, size_t n, float* acc, int slot) {
    float num = 0.f, den = 0.f;
    for (size_t i = (size_t)blockIdx.x * 256 + threadIdx.x; i < n; i += (size_t)gridDim.x * 256) { const float x = a[i], y = b[i]; num += (x - y) * (x - y); den += y * y; }
    __shared__ float sn[256], sd[256]; sn[threadIdx.x] = num; sd[threadIdx.x] = den; __syncthreads();
    for (int s = 128; s > 0; s >>= 1) { if (threadIdx.x < s) { sn[threadIdx.x] += sn[threadIdx.x + s]; sd[threadIdx.x] += sd[threadIdx.x + s]; } __syncthreads(); }
    if (threadIdx.x == 0) { atomicAdd(&acc[slot], sn[0]); atomicAdd(&acc[4 + slot], sd[0]); }
}
__global__ void k_fin2(const float* acc, float* scale, int which) { float e = acc[which] / acc[4 + which]; if (!(e == e)) e = 1.f; scale[0] = 1.f + sqrtf(e) * 100.f; }
#endif
constexpr int LDS_TOTAL = 159744 + 64 + 256;
static_assert(ATT_LDS <= 159744, "attention LDS");
constexpr size_t NSLOT = (size_t)NB * NE * (CAP + CAPC);
constexpr int NPHASE = 2 + 11 * NL;
__global__ void __launch_bounds__(512, 2) k_mega(MP p) {
    extern __shared__ __attribute__((aligned(16))) unsigned char dynlds[];
    const ldsp lds = (ldsp)dynlds;
    const int bid0 = blockIdx.x, nblk0 = gridDim.x;

    volatile LAS unsigned* xbw = (volatile LAS unsigned*)(lds + 159744);
    if (threadIdx.x == 0) { xbw[0] = 0u; xbw[1] = 0u; xbw[2] = 0u; xbw[3] = 0u; }
    __syncthreads();
    const XcdBarrier bar = xcd_barrier_post(p.bar(), xbw);
    int g = 0;
#ifndef REP_MASK
#define REP_MASK 0
#endif
#define PH(kind, ...) if (g >= p.ph_lo() && g < p.ph_hi()) { int bid = bid0, nblk = nblk0; asm volatile("" : "+s"(bid), "+s"(nblk));     \
    __VA_ARGS__ if (((REP_MASK >> (kind)) & 1) && ((kind) != 5 || g < 13)) { xcd_barrier(bar); __VA_ARGS__ } if (g + 1 < p.ph_hi()) xcd_barrier(bar); } ++g;
#define bH (p.RA())
#define bO (p.RA())
#define bY (p.RA())
#define bQM (p.RC())
#define bKVM (p.RC() + (size_t)NROW * 384)
#define bMERGED (p.RC())
#define bH2 (p.RC())
#define bACT (p.Z())
#define bOUT (p.Z() + NSLOT * FF)
#define bXG (p.Z() + NSLOT * FF)
#define bWguT (p.Z() + 2 * NSLOT * FF)
#define bWdT (p.Z() + 2 * NSLOT * FF + (size_t)NE * 2048 * 1024)
    if ((REP_MASK >> 14) & 1) { for (int i = 0; i < 20; ++i) xcd_barrier(bar); }
    PH(12,
        ph_mod(lds, p, bid, nblk);
        ph_ropetab(p, bid, nblk);
        { PrepJob j{}; j.src = p.w_in(); j.dst = p.WinT(); j.K = D; j.Nsrc = INW; j.Ndst = ZWP; j.mode = 1; j.perm = 1; j.nz = NL; j.src_zs = (long long)D * INW; j.dst_zs = (long long)ZWP * D; ph_wprep(lds, j, bid, nblk); }
        { PrepJob j{}; j.src = p.w_qb(); j.kscale = p.mqn(); j.dst = p.WqT(); j.K = 192; j.Nsrc = 384; j.Ndst = 384; j.mode = 0; j.nz = NL; j.src_zs = 192 * 384; j.dst_zs = 384 * 192; j.ks_zs = 192; ph_wprep(lds, j, bid, nblk); }
        { PrepJob j{}; j.src = p.w_kvb(); j.kscale = p.mkvn(); j.dst = p.WkvT(); j.K = 128; j.Nsrc = 512; j.Ndst = 512; j.mode = 0; j.nz = NL; j.src_zs = 128 * 512; j.dst_zs = 512 * 128; j.ks_zs = 128; ph_wprep(lds, j, bid, nblk); }
        { PrepJob j{}; j.src = p.w_branch(); j.dst = p.WbT(); j.K = 256; j.Nsrc = 1024; j.Ndst = 1024; j.mode = 0; j.nz = NL * 4; j.src_zs = 256 * 1024; j.dst_zs = 1024 * 256; ph_wprep(lds, j, bid, nblk); }
        { PrepJob j{}; j.src = p.w_out(); j.dst = p.WoutT(); j.K = 1024; j.Nsrc = 1024; j.Ndst = 1024; j.mode = 0; j.perm = 1; j.nz = NL; j.src_zs = 1024 * 1024; j.dst_zs = 1024 * 1024; ph_wprep(lds, j, bid, nblk); }
    )
    PH(13, ph_lnmod0(p, bid, nblk);)
    for (int l = 0; l < NL; ++l) {
        const bool need_ctx = l + 1 < NL; const int mrows = need_ctx ? NROW : NLAT;
        PH(0, { InProj8S sc{}; sc.H = bH; sc.Wt = p.WinT() + (size_t)l * ZWP * D; sc.npm = NROW / 256; sc.bid = bid; sc.nblk = nblk; sc.nun = need_ctx ? 3300 : 3200 + 36;
                InProj8E ep{}; ep.Z = p.Z(); ep.SS = p.SS(); ep.gqn = p.gqn() + l * 64; ep.gkn = p.gkn() + l * 64; ep.tab64 = p.tab64(); ep.tab32 = p.tab32();
                pg8::gemm_phase<InProj8E, InProj8S, true, true>(lds, D, sc, ep); } )
        PH(1, { MlaProj pb{}; pb.Z = p.Z(); pb.WqT = p.WqT() + (size_t)l * 384 * 192; pb.WkvT = p.WkvT() + (size_t)l * 512 * 128; pb.QM = bQM; pb.KVM = bKVM; pb.SS = p.SS(); pb.tab32 = p.tab32(); pb.nlat = NLAT; pb.npm = NROW / 256;
                   gemm_run<128, false>(lds, pb, bid, nblk); } )
        PH(2, { AttnP ap{}; ap.Z = p.Z(); ap.QM = bQM; ap.KVM = bKVM; ap.O = bO; ap.rpb = p.na_rpb() + (size_t)l * 4 * 15 * 31; ap.sink = p.swa_sink() + l * 4; ap.nlat = NLAT; ap.need_ctx = need_ctx ? 1 : 0; ap.o32 = (l == 0) ? p.o32() : nullptr; ap.fake = 0;
#ifdef PROBE_F
                   if (l == 0) { ap.fake = PROBE_F; attn_phase(lds, ap, bid, nblk); ap.fake = 0; ap.o32 = nullptr; }
#endif
                   attn_phase(lds, ap, bid, nblk); } )
        PH(3, { MergeProb pb{}; pb.O = bO; pb.WbT = p.WbT() + (size_t)l * 4 * 1024 * 256; pb.Z = p.Z(); pb.MERGED = bMERGED; pb.npm = mrows / 256; gemm_run<128, true>(lds, pb, bid, nblk); } )
        PH(4, { Plain8S sc{}; sc.A = bMERGED; sc.Bt = p.WoutT() + (size_t)l * D * D; sc.npm = mrows / 256; sc.npn = 4; sc.K = D; sc.bid = bid; sc.nblk = nblk; Plain8E ep{}; ep.C = bY; ep.ldc = D;
                pg8::gemm_phase<Plain8E, Plain8S, true, true>(lds, D, sc, ep); } )
        PH(5, ph_lnres(lds, p, l, mrows, bid, nblk); )
        PH(6,
            ph_topk(lds, p, need_ctx ? 2 : 1, bid, nblk);
            { PrepJob j{}; j.src = p.w_gate() + (size_t)l * NE * D * FF; j.src2 = p.w_up() + (size_t)l * NE * D * FF; j.dst = bWguT; j.K = 1024; j.Nsrc = 1024; j.Ndst = 2048; j.mode = 2; j.perm = 1; j.nz = NE; j.src_zs = (long long)D * FF; j.dst_zs = (long long)2048 * 1024; ph_wprep(lds, j, bid, nblk); }
            { PrepJob j{}; j.src = p.w_down() + (size_t)l * NE * FF * D; j.dst = bWdT; j.K = 1024; j.Nsrc = 1024; j.Ndst = 1024; j.mode = 0; j.perm = 1; j.nz = NE; j.src_zs = (long long)FF * D; j.dst_zs = (long long)1024 * 1024; ph_wprep(lds, j, bid, nblk); }
        )
        PH(10, ph_gather(bH2, p.IDX(), bXG, need_ctx ? (int)NSLOT : CTXB, bid, nblk); )
        PH(7, { FfnUp8S sc{}; sc.XG = bXG; sc.WguT = bWguT; sc.nun = 2048 + (need_ctx ? 128 : 0); sc.bid = bid; sc.nblk = nblk; FfnUp8E ep{}; ep.ACT = bACT;
                pg8::gemm_phase<FfnUp8E, FfnUp8S, true, true>(lds, D, sc, ep); } )
        PH(8, { FfnDown8S sc{}; sc.ACT = bACT; sc.WdT = bWdT; sc.nun = 1024 + (need_ctx ? 64 : 0); sc.bid = bid; sc.nblk = nblk; FfnDown8E ep{}; ep.GATEV = p.GATEV(); ep.OUT = bOUT;
                pg8::gemm_phase<FfnDown8E, FfnDown8S, true, true>(lds, FF, sc, ep); } )
        PH(9, ph_combine(p, l, mrows, bOUT, bid, nblk); )
    }
#undef PH
#undef bH
#undef bO
#undef bY
#undef bQM
#undef bKVM
#undef bMERGED
#undef bH2
#undef bACT
#undef bOUT
#undef bXG
#undef bWguT
#undef bWdT
}
}

extern "C" void kernel_launch(void* const* d_in, const int* in_sizes, int n_in, void* d_out, int out_size, void* d_ws, size_t ws_size, hipStream_t stream) {
    MP p; memset(&p, 0, sizeof(p));
    p.x_ = (const float*)d_in[0]; p.c_ = (const float*)d_in[1]; p.ctx_ = (const float*)d_in[2]; p.c_ctx_ = (const float*)d_in[3];
    p.w_mod_ = (const float*)d_in[4]; p.b_mod_ = (const float*)d_in[5]; p.w_in_ = (const float*)d_in[6]; p.na_rpb_ = (const float*)d_in[7];
    p.gqn_ = (const float*)d_in[8]; p.gkn_ = (const float*)d_in[9]; p.swa_sink_ = (const float*)d_in[10];
    p.mqn_ = (const float*)d_in[11]; p.mkvn_ = (const float*)d_in[12]; p.w_qb_ = (const float*)d_in[13]; p.w_kvb_ = (const float*)d_in[14];
    p.w_branch_ = (const float*)d_in[15]; p.w_out_ = (const float*)d_in[16];
    p.ln1g_ = (const float*)d_in[17]; p.ln1b_ = (const float*)d_in[18]; p.ln2g_ = (const float*)d_in[19]; p.ln2b_ = (const float*)d_in[20];
    p.w_router_ = (const float*)d_in[21]; p.w_gate_ = (const float*)d_in[22]; p.w_up_ = (const float*)d_in[23]; p.w_down_ = (const float*)d_in[24];
    p.out_ = (float*)d_out;
    char* ws = (char*)d_ws; size_t off = OFF_END;
    auto carve = [&](size_t bytes) { void* q = ws + off; off += (bytes + 255) & ~(size_t)255; return q; }; (void)carve;
    p.ws_ = ws;
    if (off > ws_size || 2 * NSLOT * FF + (size_t)NE * 3072 * 1024 > (size_t)NROW * ZW) { fprintf(stderr, "workspace too small: need %zu have %zu\n", off, ws_size); return; }
    static int grid = 0;
    if (!grid) {
        int dev = 0, cus = 0, per_cu = 0;
        (void)hipGetDevice(&dev);
        (void)hipDeviceGetAttribute(&cus, hipDeviceAttributeMultiprocessorCount, dev);
        (void)hipFuncSetAttribute((const void*)k_mega, hipFuncAttributeMaxDynamicSharedMemorySize, LDS_TOTAL);
        (void)hipOccupancyMaxActiveBlocksPerMultiprocessor(&per_cu, (const void*)k_mega, 512, LDS_TOTAL);
        grid = per_cu >= 1 ? cus : 0;
        if (grid > 256) grid = 256;
    }
    if (!grid) { fprintf(stderr, "k_mega cannot be resident\n"); return; }
    (void)hipMemsetAsync(ws + OFF_BAR, 0, XCD_BAR_WORDS * 4, stream);
#ifdef PROBE_L0
    {
        float* save_xc = (float*)carve((size_t)NCTX * D * 4); float* save_x = (float*)carve((size_t)2048 * D * 4); float* pacc = (float*)carve(256); float* pscl = (float*)carve(256);
        if (off > ws_size) { fprintf(stderr, "probe workspace\n"); return; }
        nv::nv_layer0(d_in, d_out, d_ws, ws_size, stream, save_xc, save_x);
        (void)hipMemsetAsync(ws + OFF_BAR, 0, XCD_BAR_WORDS * 4, stream);
        (void)hipMemsetAsync(pacc, 0, 256, stream);
        p.pscale_ = pscl;
        p.ph_lo_ = 0; p.ph_hi_ = 2 + (NPHASE - 2) / NL;
        hipLaunchKernelGGL(k_mega, dim3(grid), dim3(512), LDS_TOTAL, stream, p);
        hipLaunchKernelGGL(k_cmp2, dim3(256), dim3(256), 0, stream, (const float*)(ws + OFF_XCB), (const float*)save_xc, (size_t)NCTX * D, pacc, 0);
        for (int b = 0; b < NB; ++b) hipLaunchKernelGGL(k_cmp2, dim3(256), dim3(256), 0, stream, (const float*)d_out + (size_t)b * SEQ * D, (const float*)save_x + (size_t)b * 512 * D, (size_t)512 * D, pacc, 1);
        hipLaunchKernelGGL(k_fin2, dim3(1), dim3(1), 0, stream, pacc, pscl, (int)PROBE_L0);
        (void)hipMemsetAsync(ws + OFF_BAR, 0, XCD_BAR_WORDS * 4, stream);
        p.ph_lo_ = 2 + (NPHASE - 2) / NL; p.ph_hi_ = NPHASE;
        hipLaunchKernelGGL(k_mega, dim3(grid), dim3(512), LDS_TOTAL, stream, p);
    }
#elif defined(PROBE_ATTN)
    {
        float* O32 = (float*)carve((size_t)2304 * D * 4); float* O2 = (float*)carve((size_t)2304 * D * 4); float* pacc = (float*)carve(256); float* pscl = (float*)carve(256);
        if (off > ws_size) { fprintf(stderr, "probe workspace\n"); return; }
        p.o32_ = O32; p.pscale_ = pscl;
        (void)hipMemsetAsync(pacc, 0, 256, stream);
        p.ph_lo_ = 0; p.ph_hi_ = 5;
        hipLaunchKernelGGL(k_mega, dim3(grid), dim3(512), LDS_TOTAL, stream, p);
        AttnArgs a{}; a.Z = (const T*)(ws + OFF_Z); a.QM = (const T*)(ws + OFF_RC); a.KVM = (const T*)(ws + OFF_RC) + (size_t)NROW * 384; a.O2 = O2; a.rpb = p.na_rpb_; a.sink = p.swa_sink_; a.P.nbp = NB; a.P.b0 = 0; a.P.nlat = NLAT; a.P.nctx = NCTX; a.P.nrow = NROW; a.bl0 = 1;
        a.ctxq = 0; { dim3 g(8, 4, 1); hipLaunchKernelGGL(k_attn_naive<0>, g, dim3(256), 0, stream, a); hipLaunchKernelGGL(k_attn_naive<1>, g, dim3(256), 0, stream, a);
                      hipLaunchKernelGGL(k_attn_naive<2>, g, dim3(256), 0, stream, a); hipLaunchKernelGGL(k_attn_naive<3>, g, dim3(256), 0, stream, a); }
        a.ctxq = 1; { dim3 g(1, 4, 1); hipLaunchKernelGGL(k_attn_naive<0>, g, dim3(256), 0, stream, a); hipLaunchKernelGGL(k_attn_naive<1>, g, dim3(256), 0, stream, a);
                      hipLaunchKernelGGL(k_attn_naive<2>, g, dim3(256), 0, stream, a); hipLaunchKernelGGL(k_attn_naive<3>, g, dim3(256), 0, stream, a); }
        hipLaunchKernelGGL(k_probe_cmp, dim3(64, 4), dim3(256), 0, stream, O32, O2, pacc, 2304);
        hipLaunchKernelGGL(k_probe_fin, dim3(1), dim3(1), 0, stream, pacc, pscl, (int)PROBE_ATTN);
        (void)hipMemsetAsync(ws + OFF_BAR, 0, XCD_BAR_WORDS * 4, stream);
        p.ph_lo_ = 5; p.ph_hi_ = NPHASE;
        hipLaunchKernelGGL(k_mega, dim3(grid), dim3(512), LDS_TOTAL, stream, p);
    }
#elif defined(PROBE_T)
    {
        float* pscl = (float*)carve(256);
        if (off > ws_size) { fprintf(stderr, "probe workspace\n"); return; }
        p.o32_ = pscl; p.pscale_ = pscl;
        p.ph_lo_ = 0; p.ph_hi_ = NPHASE;
        hipLaunchKernelGGL(k_mega, dim3(grid), dim3(512), LDS_TOTAL, stream, p);
    }
#elif !defined(MK_SPLIT)
    p.ph_lo_ = 0; p.ph_hi_ = NPHASE;
    hipLaunchKernelGGL(k_mega, dim3(grid), dim3(512), LDS_TOTAL, stream, p);
#else
    for (int g = 0; g < NPHASE; ++g) { p.ph_lo_ = g; p.ph_hi_ = g + 1; hipLaunchKernelGGL(k_mega, dim3(grid), dim3(512), LDS_TOTAL, stream, p); }
#endif
}
```

```cpp
#include <hip/hip_runtime.h>
#include <hip/hip_bf16.h>
#include <stdint.h>
#include <stdio.h>
#include <string.h>

namespace {
constexpr int D = 1024, SEQ = 8192, CTX = 256, NB = 4, NL = 2, HD = 64;
constexpr int GW = 64, GROWS = 128;
constexpr int INW = 6240;
constexpr int ZW = 6240;
constexpr int NAQ = 0, NAK = 256, NAV = 512, GQ = 768, GK = 1024, GV = 1152, SQ = 1280, SK = 1536, SV = 1664,
              MCQ = 1792, MCKV = 1984, MKR = 2112, GATE = 2144;
constexpr int NE = 16, FF = 1024, CAP = 1024, CAPC = 32;
constexpr int MODW = 6 * D;
constexpr float EPS = 1e-6f;
constexpr float ALPHA = 1.4142135623730951f;
constexpr int NLAT = NB * SEQ, NCTX = NB * CTX, NROW = NLAT + NCTX;

struct T {
    unsigned short u;
    __device__ __forceinline__ operator float() const { return __uint_as_float((unsigned)u << 16); }
    __device__ __forceinline__ T& operator=(float f) { unsigned b = __float_as_uint(f); b += 0x7fffu + ((b >> 16) & 1u); u = (unsigned short)(b >> 16); return *this; }
};
__device__ __forceinline__ float4 ld4(const float* p) { return *(const float4*)p; }
__device__ __forceinline__ float4 ld4(const T* p) { uint2 r = *(const uint2*)p; return make_float4(__uint_as_float(r.x << 16), __uint_as_float(r.x & 0xffff0000u), __uint_as_float(r.y << 16), __uint_as_float(r.y & 0xffff0000u)); }
__device__ __forceinline__ unsigned pk2(float lo, float hi) { T a, b; a = lo; b = hi; return (unsigned)a.u | ((unsigned)b.u << 16); }
__device__ __forceinline__ void st4(float* p, float4 v) { *(float4*)p = v; }
__device__ __forceinline__ void st4(T* p, float4 v) { *(uint2*)p = make_uint2(pk2(v.x, v.y), pk2(v.z, v.w)); }

__device__ __forceinline__ int otid() { int t = threadIdx.x; asm volatile("" : "+v"(t)); return t; }
__device__ __forceinline__ int xswz(int u, int n) { const int c = u & 7, s = u >> 3, q = n >> 3, rr = n & 7; return (c < rr ? c * (q + 1) : rr * (q + 1) + (c - rr) * q) + s; }
#define DPP_ADD(v, ctrl) ((v) + __builtin_bit_cast(float, __builtin_amdgcn_update_dpp(0, __builtin_bit_cast(int, (v)), (ctrl), 0xf, 0xf, true)))
__device__ __forceinline__ float wave_sum(float v) {
    v = DPP_ADD(v, 0xB1);
    v = DPP_ADD(v, 0x4E);
    v = DPP_ADD(v, 0x141);
    v = DPP_ADD(v, 0x140);
    const int iv = __builtin_bit_cast(int, v);
    const float r0 = __builtin_bit_cast(float, __builtin_amdgcn_readlane(iv, 0)), r1 = __builtin_bit_cast(float, __builtin_amdgcn_readlane(iv, 16)),
                r2 = __builtin_bit_cast(float, __builtin_amdgcn_readlane(iv, 32)), r3 = __builtin_bit_cast(float, __builtin_amdgcn_readlane(iv, 48));
    return (r0 + r1) + (r2 + r3);
}

typedef short bf16x8 __attribute__((ext_vector_type(8)));
typedef float f32x4 __attribute__((ext_vector_type(4)));
#define LAS __attribute__((address_space(3)))
typedef LAS unsigned char* ldsp;
constexpr int ZWP = 6400;

__device__ __forceinline__ float fast_rsqrt(float x) { return __builtin_amdgcn_rsqf(x); }
__device__ __forceinline__ float fast_sigmoid(float x) { return __builtin_amdgcn_rcpf(1.f + __builtin_amdgcn_exp2f(-1.4426950408889634f * x)); }
__device__ __forceinline__ float fast_silu(float x) { return x * fast_sigmoid(x); }
__device__ __forceinline__ uint2 pk4(float a, float b, float c, float d) { return make_uint2(pk2(a, b), pk2(c, d)); }

#define GLDS16(gp, lp) __builtin_amdgcn_global_load_lds((const unsigned*)(gp), (LAS unsigned*)(lp), 16, 0, 0)
template <int BN, bool HAS_SUM, class Prob>
__device__ __forceinline__ void gemm_run(ldsp lds, const Prob& pb, int bid, int nblk) {
    constexpr int NF = BN / 64, GLB = BN / 64, A_BYTES = 32768, B_BYTES = BN * 128, STAGE = A_BYTES + B_BYTES, NSTG = (BN == 128) ? 3 : 2, NGL = 4 + GLB;
    const int tid = otid(), wid = __builtin_amdgcn_readfirstlane(tid >> 6), lane = tid & 63, wr = wid >> 2, wc = wid & 3, fr = lane & 15, fq = lane >> 4;
    const int NU = pb.nunits();
    if (bid >= NU) return;
    const int sb = lane * 16, swz = sb ^ (((sb >> 9) & 1) << 5);
    const int sR0 = (wid >> 1) * 16 + (swz >> 6), sC = (wid & 1) * 32 + ((swz & 63) >> 1);
    const int ob = fr * 64 + fq * 16, lane_off = ob ^ (((ob >> 9) & 1) << 5);
    const unsigned ldsw = (unsigned)wid * 1024u;
    unsigned aoff[4], boff[GLB];
    int su = bid, st = 0, snt = pb.ntiles(su), sbuf = 0, inflight = 0;
#define G_LOAD_OFFS() do { _Pragma("unroll") for (int i = 0; i < 4; ++i) aoff[i] = pb.a_off(su, sR0 + 64 * i) + sC; \
                           _Pragma("unroll") for (int i = 0; i < GLB; ++i) boff[i] = pb.b_off(su, sR0 + 64 * i) + sC; } while (0)
#define G_STAGE() do { if (su < NU) { const T* Ab = pb.a_base(su, st); const T* Bb = pb.b_base(su, st); ldsp sbase = lds + sbuf * STAGE + ldsw; \
        _Pragma("unroll") for (int i = 0; i < 4; ++i) GLDS16(Ab + aoff[i], sbase + i * 8192); \
        _Pragma("unroll") for (int i = 0; i < GLB; ++i) GLDS16(Bb + boff[i], sbase + A_BYTES + i * 8192); \
        ++inflight; sbuf = (sbuf + 1 == NSTG) ? 0 : sbuf + 1; \
        if (++st == snt) { su += nblk; st = 0; if (su < NU) { snt = pb.ntiles(su); G_LOAD_OFFS(); } } } } while (0)
    G_LOAD_OFFS();
    G_STAGE();
    if (NSTG == 3) G_STAGE();
    int buf = 0;
    for (int cu = bid; cu < NU; cu += nblk) {
        f32x4 acc[8][NF]; f32x4 sum[HAS_SUM ? 8 : 1][HAS_SUM ? NF : 1]; uint2 gpre[HAS_SUM ? 8 : 1][HAS_SUM ? NF : 1];
#pragma unroll
        for (int m = 0; m < 8; ++m)
#pragma unroll
            for (int n = 0; n < NF; ++n) { acc[m][n] = (f32x4){0.f, 0.f, 0.f, 0.f}; if (HAS_SUM) sum[m][n] = (f32x4){0.f, 0.f, 0.f, 0.f}; }
        const int nt = pb.ntiles(cu);
        for (int t = 0; t < nt; ++t) {
            if (NSTG == 3) {
                if constexpr (HAS_SUM) { if (inflight >= 2) { if (pb.extra_inflight(t)) asm volatile("s_waitcnt vmcnt(%0)" :: "n"(NGL + 16) : "memory"); else asm volatile("s_waitcnt vmcnt(%0)" :: "n"(NGL) : "memory"); }
                                         else asm volatile("s_waitcnt vmcnt(0)" ::: "memory"); }
                else { if (inflight >= 2) asm volatile("s_waitcnt vmcnt(%0)" :: "n"(NGL) : "memory"); else asm volatile("s_waitcnt vmcnt(0)" ::: "memory"); }
                asm volatile("s_waitcnt lgkmcnt(0)\n\ts_barrier" ::: "memory");
            } else {
                asm volatile("s_waitcnt vmcnt(0)" ::: "memory");
                __syncthreads();
            }
            if constexpr (!(NF == 2 && HAS_SUM)) G_STAGE();
            if constexpr (HAS_SUM) pb.tile_begin(cu, t, gpre, wr, wc, fr, fq);
            const ldsp ta = lds + buf * STAGE + wr * 16384 + lane_off, tb = lds + buf * STAGE + A_BYTES + wc * (NF * 2048) + lane_off;
            if constexpr (NF == 2 && HAS_SUM) {
                const unsigned ta_ = (unsigned)(size_t)ta, tb_ = (unsigned)(size_t)tb;
                bf16x8 a0, a1, a2, a3, a4, a5, a6, a7, b0, b1;
#define G_RD(dst, addr, OFF) asm volatile("ds_read_b128 %0, %1 offset:" #OFF : "=v"(dst) : "v"(addr))
#define G_MM(m, av) do { acc[m][0] = __builtin_amdgcn_mfma_f32_16x16x32_bf16(b0, av, acc[m][0], 0, 0, 0); acc[m][1] = __builtin_amdgcn_mfma_f32_16x16x32_bf16(b1, av, acc[m][1], 0, 0, 0); } while (0)
                const bool g_on = su < NU; const T* gAb = pb.a_base(g_on ? su : cu, st); const T* gBb = pb.b_base(g_on ? su : cu, st); const ldsp gsb = lds + sbuf * STAGE + ldsw;
                G_RD(a0, ta_, 0); G_RD(a1, ta_, 2048); G_RD(a2, ta_, 4096); G_RD(a3, ta_, 6144); G_RD(b0, tb_, 0); G_RD(b1, tb_, 2048);
                if (g_on) { GLDS16(gAb + aoff[0], gsb); GLDS16(gAb + aoff[1], gsb + 8192); }
                asm volatile("s_waitcnt lgkmcnt(0)" : "+v"(a0), "+v"(a1), "+v"(a2), "+v"(a3), "+v"(b0), "+v"(b1));
                __builtin_amdgcn_sched_barrier(0);
                G_RD(a4, ta_, 8192); G_RD(a5, ta_, 10240); G_RD(a6, ta_, 12288); G_RD(a7, ta_, 14336);
                G_MM(0, a0); G_MM(1, a1); G_MM(2, a2); G_MM(3, a3);
                __builtin_amdgcn_sched_barrier(0);
                if (g_on) { GLDS16(gAb + aoff[2], gsb + 2 * 8192); GLDS16(gAb + aoff[3], gsb + 3 * 8192); }
                asm volatile("s_waitcnt lgkmcnt(0)" : "+v"(a4), "+v"(a5), "+v"(a6), "+v"(a7));
                __builtin_amdgcn_sched_barrier(0);
                bf16x8 c0, c1, c2, c3, d0, d1;
                G_RD(c0, ta_, 1024); G_RD(c1, ta_, 3072); G_RD(c2, ta_, 5120); G_RD(c3, ta_, 7168); G_RD(d0, tb_, 1024); G_RD(d1, tb_, 3072);
                G_MM(4, a4); G_MM(5, a5); G_MM(6, a6); G_MM(7, a7);
                __builtin_amdgcn_sched_barrier(0);
                if (g_on) { GLDS16(gBb + boff[0], gsb + A_BYTES); GLDS16(gBb + boff[1], gsb + A_BYTES + 8192);
                            ++inflight; sbuf = (sbuf + 1 == NSTG) ? 0 : sbuf + 1;
                            if (++st == snt) { su += nblk; st = 0; if (su < NU) { snt = pb.ntiles(su); G_LOAD_OFFS(); } } }
                asm volatile("s_waitcnt lgkmcnt(0)" : "+v"(c0), "+v"(c1), "+v"(c2), "+v"(c3), "+v"(d0), "+v"(d1));
                __builtin_amdgcn_sched_barrier(0);
                b0 = d0; b1 = d1;
                G_RD(a4, ta_, 9216); G_RD(a5, ta_, 11264); G_RD(a6, ta_, 13312); G_RD(a7, ta_, 15360);
                G_MM(0, c0); G_MM(1, c1); G_MM(2, c2); G_MM(3, c3);
                __builtin_amdgcn_sched_barrier(0);
                asm volatile("s_waitcnt lgkmcnt(0)" : "+v"(a4), "+v"(a5), "+v"(a6), "+v"(a7));
                __builtin_amdgcn_sched_barrier(0);
                G_MM(4, a4); G_MM(5, a5); G_MM(6, a6); G_MM(7, a7);
                __builtin_amdgcn_sched_barrier(0);
#undef G_RD
#undef G_MM
            } else {
#pragma unroll
            for (int ks = 0; ks < 2; ++ks) {
                bf16x8 At[8], Bf[NF];
#pragma unroll
                for (int m = 0; m < 8; ++m) At[m] = *(const LAS bf16x8*)(ta + m * 2048 + ks * 1024);
#pragma unroll
                for (int n = 0; n < NF; ++n) Bf[n] = *(const LAS bf16x8*)(tb + n * 2048 + ks * 1024);
#pragma unroll
                for (int m = 0; m < 8; ++m)
#pragma unroll
                    for (int n = 0; n < NF; ++n) acc[m][n] = __builtin_amdgcn_mfma_f32_16x16x32_bf16(Bf[n], At[m], acc[m][n], 0, 0, 0);
            }
            }
            if constexpr (HAS_SUM) pb.tile_done(cu, t, acc, sum, gpre, wr, wc, fr, fq);
            --inflight; buf = (buf + 1 == NSTG) ? 0 : buf + 1;
        }
        if constexpr (HAS_SUM) pb.epilogue(cu, sum, wr, wc, fr, fq); else pb.epilogue(cu, acc, wr, wc, fr, fq);
    }
    asm volatile("s_waitcnt vmcnt(0) lgkmcnt(0)\n\ts_barrier" ::: "memory");
#undef G_LOAD_OFFS
#undef G_STAGE
}

struct InProj {
    const T* H; const T* Wt; T* Z; float* SS; const float* gqn; const float* gkn; const float2* tab64; const float2* tab32; int nlat, npm;
    __device__ __forceinline__ int nunits() const { return npm * 25; }
    __device__ __forceinline__ int ntiles(int) const { return 16; }
    __device__ __forceinline__ unsigned a_off(int u, int R) const { return (unsigned)((u / 25) * 256 + R) * 1024u; }
    __device__ __forceinline__ unsigned b_off(int u, int R) const { return (unsigned)((u % 25) * 256 + R) * 1024u; }
    __device__ __forceinline__ const T* a_base(int, int t) const { return H + t * 64; }
    __device__ __forceinline__ const T* b_base(int, int t) const { return Wt + t * 64; }
    __device__ __forceinline__ void epilogue(int u, f32x4 (&acc)[8][4], int wr, int wc, int fr, int fq) const {
        const int pm = u / 25, pn = u % 25, cg = pn * 4 + wc;
        if (cg == 34 || cg == 35) return;
        const int row0 = pm * 256 + wr * 128 + fr;
        const bool lat = pm * 256 < nlat;
        const int zcol = (cg < 36 ? cg * 64 : 2144 + (cg - 36) * 64) + fq * 4;
        const bool t_rms = (cg >= 12 && cg < 18), t_rope = t_rms || (cg >= 20 && cg < 26), t_ssq = (cg >= 28 && cg < 33), t_kr = cg == 33, t_sig = cg >= 36;
        float4 gv[4];
        if (t_rms) { const float* g = cg < 16 ? gqn : gkn;
#pragma unroll
            for (int n = 0; n < 4; ++n) gv[n] = *(const float4*)(g + n * 16 + fq * 4); }
#pragma unroll
        for (int m = 0; m < 8; ++m) {
            const int row = row0 + m * 16;
            const int t = row & (SEQ - 1), gr = t >> 6, gc = t & 63;
            float v[4][4];
#pragma unroll
            for (int n = 0; n < 4; ++n)
#pragma unroll
                for (int j = 0; j < 4; ++j) v[n][j] = acc[m][n][j];
            T* zp = Z + (size_t)row * ZW + zcol;
            if (t_rms || t_ssq) {
                float ss = 0.f;
#pragma unroll
                for (int n = 0; n < 4; ++n)
#pragma unroll
                    for (int j = 0; j < 4; ++j) ss += v[n][j] * v[n][j];
                ss += __shfl_xor(ss, 16); ss += __shfl_xor(ss, 32);
                if (t_ssq) { if (fq == 0) SS[(size_t)row * 8 + (cg - 28)] = ss; }
                else { const float rstd = 1.f / sqrtf(ss * (1.f / 64.f) + EPS);
#pragma unroll
                    for (int n = 0; n < 4; ++n) { v[n][0] *= rstd * gv[n].x; v[n][1] *= rstd * gv[n].y; v[n][2] *= rstd * gv[n].z; v[n][3] *= rstd * gv[n].w; } }
            }
            if (t_rope && lat) {
                const float4* tr = (const float4*)(tab64 + gr * 16 + fq * 4); const float4* tc = (const float4*)(tab64 + gc * 16 + fq * 4);
                const float4 r0 = tr[0], r1 = tr[1], c0 = tc[0], c1 = tc[1];
                const float rc[4] = {r0.x, r0.z, r1.x, r1.z}, rs[4] = {r0.y, r0.w, r1.y, r1.w}, cc[4] = {c0.x, c0.z, c1.x, c1.z}, cs[4] = {c0.y, c0.w, c1.y, c1.w};
#pragma unroll
                for (int j = 0; j < 4; ++j) {
                    const float a0 = v[0][j], a1 = v[1][j], b0 = v[2][j], b1 = v[3][j];
                    v[0][j] = a0 * rc[j] - a1 * rs[j]; v[1][j] = a0 * rs[j] + a1 * rc[j];
                    v[2][j] = b0 * cc[j] - b1 * cs[j]; v[3][j] = b0 * cs[j] + b1 * cc[j];
                }
            }
            if (t_kr) {
#pragma unroll
                for (int n = 0; n < 2; ++n) {
                    const float4* tp = (const float4*)(tab32 + (n == 0 ? gr : gc) * 8 + (fq & 1) * 4);
                    const float4 q0 = tp[0], q1 = tp[1];
                    const float kc[4] = {q0.x, q0.z, q1.x, q1.z}, ks[4] = {q0.y, q0.w, q1.y, q1.w};
#pragma unroll
                    for (int j = 0; j < 4; ++j) { const float x = v[n][j], px = __shfl_xor(x, 32); if (lat) v[n][j] = (fq < 2) ? (x * kc[j] - px * ks[j]) : (px * ks[j] + x * kc[j]); }
                    *(uint2*)(zp + n * 16) = pk4(v[n][0], v[n][1], v[n][2], v[n][3]);
                }
                continue;
            }
            if (t_sig) {
#pragma unroll
                for (int n = 0; n < 4; ++n)
#pragma unroll
                    for (int j = 0; j < 4; ++j) v[n][j] = fast_sigmoid(v[n][j]);
            }
#pragma unroll
            for (int n = 0; n < 4; ++n) *(uint2*)(zp + n * 16) = pk4(v[n][0], v[n][1], v[n][2], v[n][3]);
        }
    }
};

struct MlaProj {
    const T* Z; const T* WqT; const T* WkvT; T* QM; T* KVM; const float* SS; const float2* tab32; int nlat, npm;
    __device__ __forceinline__ int nunits() const { return npm * 7; }
    __device__ __forceinline__ int ntiles(int u) const { return u < npm * 3 ? 3 : 2; }
    __device__ __forceinline__ unsigned a_off(int u, int R) const { const int pm = u < npm * 3 ? u / 3 : (u - npm * 3) / 4; return (unsigned)(pm * 256 + R) * (unsigned)ZW; }
    __device__ __forceinline__ unsigned b_off(int u, int R) const { return u < npm * 3 ? (unsigned)((u % 3) * 128 + R) * 192u : (unsigned)(((u - npm * 3) % 4) * 128 + R) * 128u; }
    __device__ __forceinline__ const T* a_base(int u, int t) const { return Z + (u < npm * 3 ? MCQ : MCKV) + t * 64; }
    __device__ __forceinline__ const T* b_base(int u, int t) const { return (u < npm * 3 ? WqT : WkvT) + t * 64; }
    __device__ __forceinline__ void epilogue(int u, f32x4 (&acc)[8][2], int wr, int wc, int fr, int fq) const {
        const bool isq = u < npm * 3;
        const int pm = isq ? u / 3 : (u - npm * 3) / 4, pn = isq ? u % 3 : (u - npm * 3) % 4;
        const int row0 = pm * 256 + wr * 128 + fr;
        const bool lat = pm * 256 < nlat;
#pragma unroll
        for (int m = 0; m < 8; ++m) {
            const int row = row0 + m * 16;
            const float* ss = SS + (size_t)row * 8;
            const float rstd = isq ? 1.f / sqrtf((ss[0] + ss[1] + ss[2]) * (1.f / 192.f) + EPS) : 1.f / sqrtf((ss[3] + ss[4]) * (1.f / 128.f) + EPS);
            const int t = row & (SEQ - 1), gr = t >> 6, gc = t & 63;
#pragma unroll
            for (int n = 0; n < 2; ++n) {
                float v[4];
#pragma unroll
                for (int j = 0; j < 4; ++j) v[j] = acc[m][n][j] * rstd;
                const int f = pn * 8 + wc * 2 + n;
                if (isq) {
                    const int part = f % 6;
                    if (part >= 4) {
                        const float4* tp = (const float4*)(tab32 + (part == 4 ? gr : gc) * 8 + (fq & 1) * 4);
                        const float4 q0 = tp[0], q1 = tp[1];
                        const float kc[4] = {q0.x, q0.z, q1.x, q1.z}, ks[4] = {q0.y, q0.w, q1.y, q1.w};
#pragma unroll
                        for (int j = 0; j < 4; ++j) { const float x = v[j], px = __shfl_xor(x, 32); if (lat) v[j] = (fq < 2) ? (x * kc[j] - px * ks[j]) : (px * ks[j] + x * kc[j]); }
                    }
                    *(uint2*)(QM + (size_t)row * 384 + f * 16 + fq * 4) = pk4(v[0], v[1], v[2], v[3]);
                } else {
                    *(uint2*)(KVM + (size_t)row * 512 + f * 16 + fq * 4) = pk4(v[0], v[1], v[2], v[3]);
                }
            }
        }
    }
};

struct MergeProb {
    const T* O; const T* WbT; const T* Z; T* MERGED; int npm;
    __device__ __forceinline__ int nunits() const { return npm * 8; }
    __device__ __forceinline__ int ntiles(int) const { return 16; }
    __device__ __forceinline__ unsigned a_off(int u0, int R) const { const int u = xswz(u0, npm * 8); return (unsigned)((u >> 3) * 256 + R) * 1024u; }
    __device__ __forceinline__ unsigned b_off(int u0, int R) const { const int u = xswz(u0, npm * 8); return (unsigned)((u & 7) * 128 + R) * 256u; }
    __device__ __forceinline__ const T* a_base(int, int t) const { return O + (t >> 2) * 256 + (t & 3) * 64; }
    __device__ __forceinline__ const T* b_base(int, int t) const { return WbT + (size_t)(t >> 2) * 1024 * 256 + (t & 3) * 64; }
    __device__ __forceinline__ void tile_begin(int u0, int t, uint2 (&gpre)[8][2], int wr, int wc, int fr, int fq) const {
        if ((t & 3) != 0) return;
        const int u = xswz(u0, npm * 8); const int i = t >> 2, pm = u >> 3, pn = u & 7;
        const T* gp = Z + (size_t)(pm * 256 + wr * 128 + fr) * ZW + GATE + i * 1024 + pn * 128 + wc * 32 + fq * 4;
#pragma unroll
        for (int m = 0; m < 8; ++m)
#pragma unroll
            for (int n = 0; n < 2; ++n) { const T* q_ = gp + (size_t)m * 16 * ZW + n * 16; asm volatile("global_load_dwordx2 %0, %1, off" : "=v"(gpre[m][n]) : "v"(q_)); }
    }
    __device__ __forceinline__ int extra_inflight(int t) const { return ((t & 3) == 1) ? 16 : 0; }
    __device__ __forceinline__ void tile_done(int u, int t, f32x4 (&acc)[8][2], f32x4 (&sum)[8][2], uint2 (&gpre)[8][2], int wr, int wc, int fr, int fq) const {
        if ((t & 3) != 3) return;
#pragma unroll
        for (int m = 0; m < 8; ++m)
#pragma unroll
            for (int n = 0; n < 2; ++n) {
                const uint2 r = gpre[m][n];
                { float s0 = __builtin_fmaf(__uint_as_float(r.x << 16), acc[m][n][0], sum[m][n][0]); asm volatile("" : "+v"(s0));
                  float s1 = __builtin_fmaf(__uint_as_float(r.x & 0xffff0000u), acc[m][n][1], sum[m][n][1]); asm volatile("" : "+v"(s1));
                  float s2 = __builtin_fmaf(__uint_as_float(r.y << 16), acc[m][n][2], sum[m][n][2]); asm volatile("" : "+v"(s2));
                  float s3 = __builtin_fmaf(__uint_as_float(r.y & 0xffff0000u), acc[m][n][3], sum[m][n][3]); asm volatile("" : "+v"(s3));
                  sum[m][n] = (f32x4){s0, s1, s2, s3}; }
                acc[m][n] = (f32x4){0.f, 0.f, 0.f, 0.f};
            }
    }
    __device__ __forceinline__ void epilogue(int u0, f32x4 (&sum)[8][2], int wr, int wc, int fr, int fq) const {
        const int u = xswz(u0, npm * 8); const int pm = u >> 3, pn = u & 7;
        T* op = MERGED + (size_t)(pm * 256 + wr * 128 + fr) * 1024 + pn * 128 + wc * 32 + fq * 4;
#pragma unroll
        for (int m = 0; m < 8; ++m)
#pragma unroll
            for (int n = 0; n < 2; ++n) *(uint2*)(op + (size_t)m * 16 * 1024 + n * 16) = pk4(sum[m][n][0], sum[m][n][1], sum[m][n][2], sum[m][n][3]);
    }
};

struct PlainProb {
    const T* A; const T* Bt; T* C; int npm, npn, K, lda, ldc;
    __device__ __forceinline__ int nunits() const { return npm * npn; }
    __device__ __forceinline__ int ntiles(int) const { return K / 64; }
    __device__ __forceinline__ unsigned a_off(int u0, int R) const { const int u = xswz(u0, npm * npn); return (unsigned)((u / npn) * 256 + R) * (unsigned)lda; }
    __device__ __forceinline__ unsigned b_off(int u0, int R) const { const int u = xswz(u0, npm * npn); return (unsigned)((u % npn) * 128 + R) * (unsigned)K; }
    __device__ __forceinline__ const T* a_base(int, int t) const { return A + t * 64; }
    __device__ __forceinline__ const T* b_base(int, int t) const { return Bt + t * 64; }
    __device__ __forceinline__ void epilogue(int u0, f32x4 (&acc)[8][2], int wr, int wc, int fr, int fq) const {
        const int u = xswz(u0, npm * npn); const int pm = u / npn, pn = u % npn;
        T* op = C + (size_t)(pm * 256 + wr * 128 + fr) * ldc + pn * 128 + wc * 32 + fq * 4;
#pragma unroll
        for (int m = 0; m < 8; ++m)
#pragma unroll
            for (int n = 0; n < 2; ++n) *(uint2*)(op + (size_t)m * 16 * ldc + n * 16) = pk4(acc[m][n][0], acc[m][n][1], acc[m][n][2], acc[m][n][3]);
    }
};

constexpr int CTXB = NB * NE * CAP;
struct FfnUp {
    const T* H2; const T* WguT; const int* IDX; T* ACT; int nun;
    __device__ __forceinline__ int nunits() const { return nun; }
    __device__ __forceinline__ int ntiles(int) const { return 16; }
    __device__ __forceinline__ void decode(int u, int& e, int& pn, int& sbase, bool& isctx) const {
        if (u < 2048) { e = u >> 7; const int rem = u & 127; pn = rem & 7; sbase = ((rem >> 5) * NE + e) * CAP + ((rem >> 3) & 3) * 256; isctx = false; }
        else { const int uc = u - 2048; e = uc >> 3; pn = uc & 7; sbase = CTXB + e * CAPC; isctx = true; }
    }
    __device__ __forceinline__ int slot_of(int sbase, bool isctx, int R) const { return isctx ? (R < 128 ? sbase + (R >> 5) * (NE * CAPC) + (R & 31) : -1) : sbase + R; }
    __device__ __forceinline__ unsigned a_off(int u, int R) const { int e, pn, sb; bool ic; decode(u, e, pn, sb, ic); const int s = slot_of(sb, ic, R); return s < 0 ? 0u : (unsigned)IDX[s] * 1024u; }
    __device__ __forceinline__ unsigned b_off(int u, int R) const { int e, pn, sb; bool ic; decode(u, e, pn, sb, ic); return (unsigned)(e * 2048 + pn * 256 + R) * 1024u; }
    __device__ __forceinline__ const T* a_base(int, int t) const { return H2 + t * 64; }
    __device__ __forceinline__ const T* b_base(int, int t) const { return WguT + t * 64; }
    __device__ __forceinline__ void epilogue(int u, f32x4 (&acc)[8][4], int wr, int wc, int fr, int fq) const {
        int e, pn, sb; bool ic; decode(u, e, pn, sb, ic);
        const int col = (pn * 4 + wc) * 32 + fq * 4;
#pragma unroll
        for (int m = 0; m < 8; ++m) {
            const int s = slot_of(sb, ic, wr * 128 + m * 16 + fr);
            if (s < 0) continue;
            T* op = ACT + (size_t)s * FF + col;
#pragma unroll
            for (int n = 0; n < 2; ++n)
                *(uint2*)(op + n * 16) = pk4(fast_silu(acc[m][n][0]) * acc[m][n + 2][0], fast_silu(acc[m][n][1]) * acc[m][n + 2][1],
                                             fast_silu(acc[m][n][2]) * acc[m][n + 2][2], fast_silu(acc[m][n][3]) * acc[m][n + 2][3]);
        }
    }
};
struct FfnDown {
    const T* ACT; const T* WdT; const float* GATEV; T* OUT; int nun;
    __device__ __forceinline__ int nunits() const { return nun; }
    __device__ __forceinline__ int ntiles(int) const { return 16; }
    __device__ __forceinline__ void decode(int u, int& e, int& pn, int& sbase, bool& isctx) const {
        if (u < 1024) { e = u >> 6; const int rem = u & 63; pn = rem & 3; sbase = ((rem >> 4) * NE + e) * CAP + ((rem >> 2) & 3) * 256; isctx = false; }
        else { const int uc = u - 1024; e = uc >> 2; pn = uc & 3; sbase = CTXB + e * CAPC; isctx = true; }
    }
    __device__ __forceinline__ int slot_of(int sbase, bool isctx, int R) const { return isctx ? (R < 128 ? sbase + (R >> 5) * (NE * CAPC) + (R & 31) : -1) : sbase + R; }
    __device__ __forceinline__ unsigned a_off(int u, int R) const { int e, pn, sb; bool ic; decode(u, e, pn, sb, ic); const int s = slot_of(sb, ic, R); return s < 0 ? 0u : (unsigned)s * 1024u; }
    __device__ __forceinline__ unsigned b_off(int u, int R) const { int e, pn, sb; bool ic; decode(u, e, pn, sb, ic); return (unsigned)(e * 1024 + pn * 256 + R) * 1024u; }
    __device__ __forceinline__ const T* a_base(int, int t) const { return ACT + t * 64; }
    __device__ __forceinline__ const T* b_base(int, int t) const { return WdT + t * 64; }
    __device__ __forceinline__ void epilogue(int u, f32x4 (&acc)[8][4], int wr, int wc, int fr, int fq) const {
        int e, pn, sb; bool ic; decode(u, e, pn, sb, ic);
        const int col = pn * 256 + wc * 64 + fq * 4;
#pragma unroll
        for (int m = 0; m < 8; ++m) {
            const int s = slot_of(sb, ic, wr * 128 + m * 16 + fr);
            if (s < 0) continue;
            const float g = GATEV[s];
            T* op = OUT + (size_t)s * D + col;
#pragma unroll
            for (int n = 0; n < 4; ++n) *(uint2*)(op + n * 16) = pk4(acc[m][n][0] * g, acc[m][n][1] * g, acc[m][n][2] * g, acc[m][n][3] * g);
        }
    }
};

namespace pg8 {
#define PG8_LAS __attribute__((address_space(3)))
constexpr int BM = 256, BK = 64, HALF = 128, HTB = HALF * BK * 2, STAGE_BYTES = 8 * HTB;
__host__ __device__ __forceinline__ int lds_byte(int r, int c) { const int st = (r >> 4) * 2 + (c >> 5), rr = r & 15, cc = c & 31, ob = rr * 64 + cc * 2; return st * 1024 + (ob ^ (((ob >> 9) & 1) << 5)); }
__host__ __device__ __forceinline__ void stage_rc(int b, int& R, int& C) { const int st = b / 1024, sb = b % 1024, swz = sb ^ (((sb >> 9) & 1) << 5); R = (st >> 1) * 16 + swz / 64; C = (st & 1) * 32 + (swz % 64) / 2; }
__host__ __device__ __forceinline__ int perm32(int rho) { const int n = rho >> 4, i = rho & 15; return 8 * (i >> 2) + 4 * n + (i & 3); }
struct Unit { int pm, pn; const char* a; const char* b; int x0, x1; };
template <class Epi, class Sched, bool ALIGN_EPI = false, bool SP2 = false>
__device__ __forceinline__ void gemm_phase(PG8_LAS unsigned char* lds, const int K, const Sched& S, const Epi& E) {
    const int tid = otid(), wid = __builtin_amdgcn_readfirstlane(tid >> 6), lane = tid & 63, wr = wid >> 2, wc = wid & 3, fr = lane & 15, fq = lane >> 4;
    const int nt = K / BK;
    unsigned voffA[2], voffB[2];
#pragma unroll
    for (int i = 0; i < 2; ++i) { int R, C; stage_rc(tid * 16 + i * 8192, R, C); const int Rb = Epi::PERM ? ((R & ~31) + perm32(R & 31)) : R;
        voffA[i] = (unsigned)(R * K + C) * 2u; voffB[i] = (unsigned)(Rb * K + C) * 2u; }
    const size_t kstep = (size_t)(BK * 2);
    const size_t hstep = (size_t)HALF * K * 2;
    const unsigned ldsw = (unsigned)wid * 1024u;
    const int aoff = lds_byte(wr * 64 + fr, fq * 8), boff = lds_byte(wc * 32 + fr, fq * 8);
#define PG8_SA(b, h) (((b) * 2 + (h)) * HTB)
#define PG8_SB(b, h) ((4 + (b) * 2 + (h)) * HTB)
#define PG8_STAGE(bufoff, gbase, voff) do { _Pragma("unroll") for (int _i = 0; _i < 2; ++_i) \
        __builtin_amdgcn_global_load_lds((const unsigned*)((const char*)(gbase) + (voff)[_i]), (PG8_LAS unsigned*)(lds + (bufoff) + ldsw + _i * 8192), 16, 0, 0); } while (0)
#define PG8_LDA(dst, b, h) do { _Pragma("unroll") for (int m = 0; m < 4; ++m) _Pragma("unroll") for (int k = 0; k < 2; ++k) dst[m][k] = *(const PG8_LAS bf16x8*)(lds + PG8_SA(b, h) + aoff + m * 2048 + k * 1024); } while (0)
#define PG8_LDB(dst, b, h) do { _Pragma("unroll") for (int n = 0; n < 2; ++n) _Pragma("unroll") for (int k = 0; k < 2; ++k) dst[n][k] = *(const PG8_LAS bf16x8*)(lds + PG8_SB(b, h) + boff + n * 2048 + k * 1024); } while (0)
#define PG8_MMA(ai, bj, At, Bt) do { __builtin_amdgcn_s_setprio(1); _Pragma("unroll") for (int m = 0; m < 4; ++m) _Pragma("unroll") for (int n = 0; n < 2; ++n) _Pragma("unroll") for (int k = 0; k < 2; ++k) \
        acc[ai][bj][m][n] = __builtin_amdgcn_mfma_f32_16x16x32_bf16(Bt[n][k], At[m][k], acc[ai][bj][m][n], 0, 0, 0); __builtin_amdgcn_s_setprio(0); } while (0)
#define PG8_WAIT_V(n) asm volatile("s_waitcnt vmcnt(" #n ")" ::: "memory")
#define PG8_WAIT_L(n) asm volatile("s_waitcnt lgkmcnt(" #n ")" ::: "memory")
#define PG8_BAR __builtin_amdgcn_s_barrier()
#define PG8_SCHED __builtin_amdgcn_sched_barrier(0)
    Unit cur, nxt; int ui = 0;
    if (!S.next(0, cur)) return;
    f32x4 acc[2][2][4][2];
#pragma unroll
    for (int a = 0; a < 2; ++a)
#pragma unroll
        for (int b = 0; b < 2; ++b)
#pragma unroll
            for (int m = 0; m < 4; ++m)
#pragma unroll
                for (int n = 0; n < 2; ++n) acc[a][b][m][n] = (f32x4){0.f, 0.f, 0.f, 0.f};
    bf16x8 At[4][2], B0[2][2], B1[2][2];
    const char* cA = cur.a; const char* cB = cur.b;
    S.a_ready(cur);
    if constexpr (SP2) {
        PG8_STAGE(PG8_SB(0, 0), cB, voffB); PG8_STAGE(PG8_SB(0, 1), cB + hstep, voffB); PG8_STAGE(PG8_SA(0, 0), cA, voffA); PG8_STAGE(PG8_SA(0, 1), cA + hstep, voffA);
        if (wr == 1) PG8_BAR;
        PG8_WAIT_V(2); PG8_BAR;
        PG8_STAGE(PG8_SB(1, 0), cB + kstep, voffB); PG8_STAGE(PG8_SA(1, 0), cA + kstep, voffA); PG8_STAGE(PG8_SB(1, 1), cB + hstep + kstep, voffB);
        PG8_WAIT_V(6); PG8_BAR;
    } else {
        PG8_STAGE(PG8_SB(0, 0), cB, voffB); PG8_STAGE(PG8_SA(0, 0), cA, voffA); PG8_STAGE(PG8_SB(0, 1), cB + hstep, voffB); PG8_STAGE(PG8_SA(0, 1), cA + hstep, voffA);
        if (wr == 1) PG8_BAR;
        PG8_WAIT_V(4); PG8_BAR;
        PG8_STAGE(PG8_SB(1, 0), cB + kstep, voffB); PG8_STAGE(PG8_SA(1, 0), cA + kstep, voffA); PG8_STAGE(PG8_SB(1, 1), cB + hstep + kstep, voffB);
        PG8_WAIT_V(6); PG8_BAR;
    }
    for (;;) {
        const bool has_next = S.next(ui + 1, nxt);
        const char* nA = has_next ? nxt.a : cA; const char* nB = has_next ? nxt.b : cB;
        for (int t = 0; t < nt; t += 2) {
            const bool last = (t == nt - 2);
            const char* a1 = cA + (size_t)(t + 1) * kstep;
            const char* a2 = last ? nA : cA + (size_t)(t + 2) * kstep; const char* b2 = last ? nB : cB + (size_t)(t + 2) * kstep;
            const char* a3 = a2 + kstep; const char* b3 = b2 + kstep;
            if (last && has_next) S.a_ready(nxt);
            if constexpr (SP2) {
            PG8_LDB(B0, 0, 0); PG8_LDB(B1, 0, 1); PG8_SCHED; PG8_LDA(At, 0, 0); PG8_STAGE(PG8_SA(1, 1), a1 + hstep, voffA);
            PG8_WAIT_V(8); PG8_WAIT_L(0); PG8_BAR; PG8_MMA(0, 0, At, B0); PG8_MMA(0, 1, At, B1); PG8_BAR; PG8_SCHED;
            PG8_LDA(At, 0, 1); PG8_STAGE(PG8_SB(0, 0), b2, voffB); PG8_STAGE(PG8_SB(0, 1), b2 + hstep, voffB); PG8_STAGE(PG8_SA(0, 0), a2, voffA);
            PG8_WAIT_V(8); PG8_WAIT_L(0); PG8_BAR; PG8_MMA(1, 0, At, B0); PG8_MMA(1, 1, At, B1); PG8_BAR; PG8_SCHED;
            PG8_LDB(B0, 1, 0); PG8_LDB(B1, 1, 1); PG8_SCHED; PG8_LDA(At, 1, 0); PG8_STAGE(PG8_SA(0, 1), a2 + hstep, voffA);
            PG8_WAIT_V(8); PG8_WAIT_L(0); PG8_BAR; PG8_MMA(0, 0, At, B0); PG8_MMA(0, 1, At, B1); PG8_BAR; PG8_SCHED;
            PG8_LDA(At, 1, 1); PG8_STAGE(PG8_SB(1, 0), b3, voffB); PG8_STAGE(PG8_SB(1, 1), b3 + hstep, voffB); PG8_STAGE(PG8_SA(1, 0), a3, voffA);
            PG8_WAIT_V(8); PG8_WAIT_L(0); PG8_BAR; PG8_MMA(1, 0, At, B0); PG8_MMA(1, 1, At, B1); PG8_BAR; PG8_SCHED;
            } else {
            PG8_LDB(B0, 0, 0); PG8_SCHED; PG8_LDA(At, 0, 0); PG8_STAGE(PG8_SA(1, 1), a1 + hstep, voffA);
            PG8_WAIT_L(8); PG8_BAR; PG8_WAIT_L(0); PG8_MMA(0, 0, At, B0); PG8_BAR; PG8_SCHED;
            PG8_LDB(B1, 0, 1); PG8_STAGE(PG8_SB(0, 0), b2, voffB);
            PG8_BAR; PG8_WAIT_L(0); PG8_MMA(0, 1, At, B1); PG8_BAR;
            PG8_LDA(At, 0, 1); PG8_STAGE(PG8_SA(0, 0), a2, voffA);
            PG8_BAR; PG8_WAIT_L(0); PG8_MMA(1, 0, At, B0); PG8_BAR; PG8_SCHED;
            PG8_STAGE(PG8_SB(0, 1), b2 + hstep, voffB);
            PG8_WAIT_V(6); PG8_BAR; PG8_MMA(1, 1, At, B1); PG8_BAR;
            PG8_LDB(B0, 1, 0); PG8_SCHED; PG8_LDA(At, 1, 0); PG8_STAGE(PG8_SA(0, 1), a2 + hstep, voffA);
            PG8_WAIT_L(8); PG8_BAR; PG8_WAIT_L(0); PG8_MMA(0, 0, At, B0); PG8_BAR; PG8_SCHED;
            PG8_LDB(B1, 1, 1); PG8_STAGE(PG8_SB(1, 0), b3, voffB);
            PG8_BAR; PG8_WAIT_L(0); PG8_MMA(0, 1, At, B1); PG8_BAR;
            PG8_LDA(At, 1, 1); PG8_STAGE(PG8_SA(1, 0), a3, voffA);
            PG8_BAR; PG8_WAIT_L(0); PG8_MMA(1, 0, At, B0); PG8_BAR; PG8_SCHED;
            PG8_STAGE(PG8_SB(1, 1), b3 + hstep, voffB);
            PG8_WAIT_V(6); PG8_BAR; PG8_MMA(1, 1, At, B1); PG8_BAR;
            }
        }
        if constexpr (ALIGN_EPI) { if (wr == 0) PG8_BAR; }
        if constexpr (!Epi::AFTER_DRAIN) { E(acc, cur, wr, wc, fr, fq); S.done(cur); }
        if (!has_next) break;
#pragma unroll
        for (int a = 0; a < 2; ++a)
#pragma unroll
            for (int b = 0; b < 2; ++b)
#pragma unroll
                for (int m = 0; m < 4; ++m)
#pragma unroll
                    for (int n = 0; n < 2; ++n) acc[a][b][m][n] = (f32x4){0.f, 0.f, 0.f, 0.f};
        cur = nxt; cA = nA; cB = nB; ++ui;
        if constexpr (ALIGN_EPI) { if (wr == 1) PG8_BAR; }
    }
    PG8_WAIT_V(0);
    if constexpr (!ALIGN_EPI) { if (wr == 0) PG8_BAR; }
    PG8_BAR;
    if constexpr (Epi::AFTER_DRAIN) { E.fused(acc, cur, wr, wc, fr, fq, lds, wid, lane); S.done(cur); }
#undef PG8_SA
#undef PG8_SB
#undef PG8_STAGE
#undef PG8_LDA
#undef PG8_LDB
#undef PG8_MMA
#undef PG8_WAIT_V
#undef PG8_WAIT_L
#undef PG8_BAR
#undef PG8_SCHED
}
}

struct SchedBase { __device__ __forceinline__ void a_ready(const pg8::Unit&) const {} __device__ __forceinline__ void done(const pg8::Unit&) const {} };
#define ACC8(mm, nn) acc[(mm) >> 2][(nn) >> 1][(mm) & 3][(nn) & 1]
#define ROW8(mm) (((mm) >> 2) * 128 + wr * 64 + ((mm) & 3) * 16 + fr)

struct InProj8S : SchedBase { const T* H; const T* Wt; int npm, bid, nblk, nun;
    __device__ __forceinline__ bool next(int i, pg8::Unit& u) const { const int x0 = bid + i * nblk; if (x0 >= nun) return false; const int x = xswz(x0, nun);
        if (x < 3200 || nun == 3300) { u.pm = x / 25; u.pn = x % 25; } else { const int y = x - 3200; u.pm = 128 + y / 9; u.pn = y % 9; }
        u.a = (const char*)(H + (size_t)u.pm * 256 * D); u.b = (const char*)(Wt + (size_t)u.pn * 256 * D); return true; } };
struct InProj8E {
    static constexpr bool PERM = false, AFTER_DRAIN = false;
    T* Z; float* SS; const float* gqn; const float* gkn; const float2* tab64; const float2* tab32;
    __device__ __forceinline__ void operator()(const f32x4 (&acc)[2][2][4][2], const pg8::Unit& u, int wr, int wc, int fr, int fq) const {
        const int pm = u.pm, cg = u.pn * 4 + wc;
        if (cg == 34 || cg == 35) return;
        const bool lat = pm * 256 < NLAT;
        const int zcol = (cg < 36 ? cg * 64 : 2144 + (cg - 36) * 64) + fq * 4;
        const bool t_rms = (cg >= 12 && cg < 18), t_rope = t_rms || (cg >= 20 && cg < 26), t_ssq = (cg >= 28 && cg < 33), t_kr = cg == 33, t_sig = cg >= 36;
        float4 gv[4];
        if (t_rms) { const float* g = cg < 16 ? gqn : gkn;
#pragma unroll
            for (int n = 0; n < 4; ++n) gv[n] = *(const float4*)(g + n * 16 + fq * 4); }
#pragma unroll
        for (int m = 0; m < 8; ++m) {
            const int row = pm * 256 + ROW8(m);
            const int t = row & (SEQ - 1), gr = t >> 6, gc = t & 63;
            float v[4][4];
#pragma unroll
            for (int n = 0; n < 4; ++n)
#pragma unroll
                for (int j = 0; j < 4; ++j) v[n][j] = ACC8(m, n)[j];
            T* zp = Z + (size_t)row * ZW + zcol;
            if (t_rms || t_ssq) {
                float ss = 0.f;
#pragma unroll
                for (int n = 0; n < 4; ++n)
#pragma unroll
                    for (int j = 0; j < 4; ++j) ss += v[n][j] * v[n][j];
                ss += __shfl_xor(ss, 16); ss += __shfl_xor(ss, 32);
                if (t_ssq) { if (fq == 0) SS[(size_t)row * 8 + (cg - 28)] = ss; }
                else { const float rstd = 1.f / sqrtf(ss * (1.f / 64.f) + EPS);
#pragma unroll
                    for (int n = 0; n < 4; ++n) { v[n][0] *= rstd * gv[n].x; v[n][1] *= rstd * gv[n].y; v[n][2] *= rstd * gv[n].z; v[n][3] *= rstd * gv[n].w; } }
            }
            if (t_rope && lat) {
                const float4* tr = (const float4*)(tab64 + gr * 16 + fq * 4); const float4* tc = (const float4*)(tab64 + gc * 16 + fq * 4);
                const float4 r0 = tr[0], r1 = tr[1], c0 = tc[0], c1 = tc[1];
                const float rc[4] = {r0.x, r0.z, r1.x, r1.z}, rs[4] = {r0.y, r0.w, r1.y, r1.w}, cc[4] = {c0.x, c0.z, c1.x, c1.z}, cs[4] = {c0.y, c0.w, c1.y, c1.w};
#pragma unroll
                for (int j = 0; j < 4; ++j) {
                    const float a0 = v[0][j], a1 = v[1][j], b0 = v[2][j], b1 = v[3][j];
                    v[0][j] = a0 * rc[j] - a1 * rs[j]; v[1][j] = a0 * rs[j] + a1 * rc[j];
                    v[2][j] = b0 * cc[j] - b1 * cs[j]; v[3][j] = b0 * cs[j] + b1 * cc[j];
                }
            }
            if (t_kr) {
#pragma unroll
                for (int n = 0; n < 2; ++n) {
                    const float4* tp = (const float4*)(tab32 + (n == 0 ? gr : gc) * 8 + (fq & 1) * 4);
                    const float4 q0 = tp[0], q1 = tp[1];
                    const float kc[4] = {q0.x, q0.z, q1.x, q1.z}, ks[4] = {q0.y, q0.w, q1.y, q1.w};
#pragma unroll
                    for (int j = 0; j < 4; ++j) { const float x = v[n][j], px = __shfl_xor(x, 32); if (lat) v[n][j] = (fq < 2) ? (x * kc[j] - px * ks[j]) : (px * ks[j] + x * kc[j]); }
                    *(uint2*)(zp + n * 16) = pk4(v[n][0], v[n][1], v[n][2], v[n][3]);
                }
                continue;
            }
            if (t_sig) {
#pragma unroll
                for (int n = 0; n < 4; ++n)
#pragma unroll
                    for (int j = 0; j < 4; ++j) v[n][j] = fast_sigmoid(v[n][j]);
            }
#pragma unroll
            for (int n = 0; n < 4; ++n) *(uint2*)(zp + n * 16) = pk4(v[n][0], v[n][1], v[n][2], v[n][3]);
        }
    }
};

struct FfnUp8S : SchedBase { const T* XG; const T* WguT; int nun, bid, nblk;
    __device__ __forceinline__ bool next(int i, pg8::Unit& u) const { const int x0 = bid + i * nblk; if (x0 >= nun) return false; const int x = xswz(x0, nun); int e, sb;
        if (x < 2048) { e = x >> 7; const int rem = x & 127; u.pn = rem & 7; sb = ((rem >> 5) * NE + e) * CAP + ((rem >> 3) & 3) * 256; u.x1 = 256; }
        else { const int uc = x - 2048; e = uc >> 3; u.pn = uc & 7; sb = CTXB + e * (NB * CAPC); u.x1 = NB * CAPC; }
        u.pm = 0; u.x0 = sb; u.a = (const char*)(XG + (size_t)sb * D); u.b = (const char*)(WguT + ((size_t)e * 2048 + u.pn * 256) * D); return true; } };
struct FfnUp8E {
    static constexpr bool PERM = false, AFTER_DRAIN = false;
    T* ACT;
    __device__ __forceinline__ void operator()(const f32x4 (&acc)[2][2][4][2], const pg8::Unit& u, int wr, int wc, int fr, int fq) const {
        const int col = (u.pn * 4 + wc) * 32 + fq * 4;
#pragma unroll
        for (int m = 0; m < 8; ++m) {
            const int R = ROW8(m);
            if (R >= u.x1) continue;
            T* op = ACT + (size_t)(u.x0 + R) * FF + col;
#pragma unroll
            for (int n = 0; n < 2; ++n) { const f32x4 g = ACC8(m, n), w = ACC8(m, n + 2);
                *(uint2*)(op + n * 16) = pk4(fast_silu(g[0]) * w[0], fast_silu(g[1]) * w[1], fast_silu(g[2]) * w[2], fast_silu(g[3]) * w[3]); }
        }
    }
};
struct FfnDown8S : SchedBase { const T* ACT; const T* WdT; int nun, bid, nblk;
    __device__ __forceinline__ bool next(int i, pg8::Unit& u) const { const int x0 = bid + i * nblk; if (x0 >= nun) return false; const int x = xswz(x0, nun); int e, sb;
        if (x < 1024) { e = x >> 6; const int rem = x & 63; u.pn = rem & 3; sb = ((rem >> 4) * NE + e) * CAP + ((rem >> 2) & 3) * 256; u.x1 = 256; }
        else { const int uc = x - 1024; e = uc >> 2; u.pn = uc & 3; sb = CTXB + e * (NB * CAPC); u.x1 = NB * CAPC; }
        u.pm = 0; u.x0 = sb; u.a = (const char*)(ACT + (size_t)sb * FF); u.b = (const char*)(WdT + ((size_t)e * 1024 + u.pn * 256) * FF); return true; } };
struct FfnDown8E {
    static constexpr bool PERM = false, AFTER_DRAIN = false;
    const float* GATEV; T* OUT;
    __device__ __forceinline__ void operator()(const f32x4 (&acc)[2][2][4][2], const pg8::Unit& u, int wr, int wc, int fr, int fq) const {
        const int col = u.pn * 256 + wc * 64 + fq * 4;
#pragma unroll
        for (int m = 0; m < 8; ++m) {
            const int R = ROW8(m);
            if (R >= u.x1) continue;
            const int s = u.x0 + R; const float g = GATEV[s];
            T* op = OUT + (size_t)s * D + col;
#pragma unroll
            for (int n = 0; n < 4; ++n) { const f32x4 a = ACC8(m, n); *(uint2*)(op + n * 16) = pk4(a[0] * g, a[1] * g, a[2] * g, a[3] * g); }
        }
    }
};
struct Plain8S : SchedBase { const T* A; const T* Bt; int npm, npn, K, bid, nblk;
    __device__ __forceinline__ bool next(int i, pg8::Unit& u) const { const int x0 = bid + i * nblk; if (x0 >= npm * npn) return false; const int x = xswz(x0, npm * npn); u.pm = x / npn; u.pn = x % npn;
        u.a = (const char*)(A + (size_t)u.pm * 256 * K); u.b = (const char*)(Bt + (size_t)u.pn * 256 * K); return true; } };
struct Plain8E {
    static constexpr bool PERM = false, AFTER_DRAIN = false;
    T* C; int ldc;
    __device__ __forceinline__ void operator()(const f32x4 (&acc)[2][2][4][2], const pg8::Unit& u, int wr, int wc, int fr, int fq) const {
        const int col = u.pn * 256 + wc * 64 + fq * 4;
#pragma unroll
        for (int m = 0; m < 8; ++m) {
            T* op = C + (size_t)(u.pm * 256 + ROW8(m)) * ldc + col;
#pragma unroll
            for (int n = 0; n < 4; ++n) { const f32x4 a = ACC8(m, n); *(uint2*)(op + n * 16) = pk4(a[0], a[1], a[2], a[3]); }
        }
    }
};
__device__ __forceinline__ void ph_gather(const T* H2, const int* IDX, T* XG, int nslot, int bid, int nblk) {
    const int tid_ = otid(); const int lane = tid_ & 63, wid = tid_ >> 6;
    for (int s0 = (bid * 8 + wid) * 2; s0 < nslot; s0 += nblk * 16) {
        const int i0 = IDX[s0], i1 = IDX[s0 + 1];
        const uint4 a0 = *(const uint4*)(H2 + (size_t)i0 * D + lane * 8), a1 = *(const uint4*)(H2 + (size_t)i0 * D + 512 + lane * 8);
        const uint4 b0 = *(const uint4*)(H2 + (size_t)i1 * D + lane * 8), b1 = *(const uint4*)(H2 + (size_t)i1 * D + 512 + lane * 8);
        *(uint4*)(XG + (size_t)s0 * D + lane * 8) = a0; *(uint4*)(XG + (size_t)s0 * D + 512 + lane * 8) = a1;
        *(uint4*)(XG + (size_t)(s0 + 1) * D + lane * 8) = b0; *(uint4*)(XG + (size_t)(s0 + 1) * D + 512 + lane * 8) = b1;
    }
}

typedef float f32x16 __attribute__((ext_vector_type(16)));
typedef short s16x4 __attribute__((ext_vector_type(4)));
typedef short v4i16_t __attribute__((ext_vector_type(4)));
struct AttnP { const T* Z; const T* QM; const T* KVM; T* O; const float* rpb; const float* sink; int nlat; int need_ctx; float* o32; int fake; };
constexpr int ATT_LDS = 156672 + 2048;
__device__ __forceinline__ int crow(int r, int hi) { return (r & 3) + 8 * (r >> 2) + 4 * hi; }
__device__ __forceinline__ float xhalf_max(float v) { auto rr = __builtin_amdgcn_permlane32_swap(__float_as_uint(v), __float_as_uint(v), false, false); return fmaxf(__uint_as_float(rr[0]), __uint_as_float(rr[1])); }
__device__ __forceinline__ float xhalf_sum(float v) { auto rr = __builtin_amdgcn_permlane32_swap(__float_as_uint(v), __float_as_uint(v), false, false); return __uint_as_float(rr[0]) + __uint_as_float(rr[1]); }
__device__ __forceinline__ unsigned cvtpk(float lo, float hi) { typedef float f2 __attribute__((ext_vector_type(2))); typedef __bf16 b2 __attribute__((ext_vector_type(2))); f2 v = {lo, hi}; b2 b = __builtin_convertvector(v, b2); return __builtin_bit_cast(unsigned, b); }

__device__ __forceinline__ float max3f(float a, float b, float c) { float r; asm("v_max3_f32 %0, %1, %2, %3" : "=v"(r) : "v"(a), "v"(b), "v"(c)); return r; }
template <int BR>
__device__ __forceinline__ void attn_unit_l(ldsp lds, const AttnP& P, int b, int hx, int q0, bool ctxq) {
    constexpr int DQK = (BR == 3) ? 96 : 64, NKS = DQK / 16, KB = (BR == 3) ? 9216 + 4096 : 9216, SLOT = KB + 8192;
    constexpr int R = (BR == 3) ? 5 : 6, PF = R - 1;
    constexpr int BT0 = 107520, QF0 = BT0 + 2048;
    static_assert(R * SLOT <= BT0, "ring");
    constexpr bool PACK2 = (BR == 1 || BR == 2);
    constexpr float SCALE = (BR == 3) ? 0.10206207261596575f : 0.125f;
    constexpr float CL2 = SCALE * 1.4426950408889634f;
    constexpr float NEG = -1e30f, THR = 8.f;
    const int tid = otid(), lane = tid & 63, wid = __builtin_amdgcn_readfirstlane(tid >> 6), r32 = lane & 31, hi = lane >> 5;
    const int tokq = q0 + (PACK2 ? (wid & 3) : wid) * 32 + r32;
    const int head = PACK2 ? hx * 2 + (wid >> 2) : hx;
    const size_t lat0 = (size_t)b * SEQ, ctx0 = (size_t)P.nlat + (size_t)b * CTX;
    const size_t qrow = ctxq ? ctx0 + tokq : lat0 + tokq;
    const ldsp qlds = lds + QF0 + wid * 6144 + lane * 16;
    { const T* qp = (BR == 3) ? P.QM + qrow * 384 + head * 96 + hi * 8 : P.Z + qrow * ZW + (BR == 0 ? NAQ : BR == 1 ? GQ : SQ) + head * 64 + hi * 8;
#pragma unroll
      for (int ks = 0; ks < NKS; ++ks) {
          const uint4 raw = *(const uint4*)(qp + ks * 16);
          typedef unsigned u4 __attribute__((ext_vector_type(4)));
          const u4 w = {cvtpk(__uint_as_float(raw.x << 16) * CL2, __uint_as_float(raw.x & 0xffff0000u) * CL2), cvtpk(__uint_as_float(raw.y << 16) * CL2, __uint_as_float(raw.y & 0xffff0000u) * CL2),
                        cvtpk(__uint_as_float(raw.z << 16) * CL2, __uint_as_float(raw.z & 0xffff0000u) * CL2), cvtpk(__uint_as_float(raw.w << 16) * CL2, __uint_as_float(raw.w & 0xffff0000u) * CL2)};
          *(LAS u4*)(qlds + ks * 1024) = w; } }
    int klo = 0, nlt = 0;
    if (!ctxq) {
        if (BR == 0) { const int r0 = q0 >> 6; const int lo = min(max(r0 - 4, 0), GROWS - 8), hi2 = min(max(r0 - 1, 0), GROWS - 8) + 8; klo = lo * 64; nlt = hi2 - lo; }
        else if (BR == 2) { klo = max(q0 - 128, 0); nlt = (min(q0 + 256, SEQ) - klo) >> 6; }
        else { klo = 0; nlt = SEQ / 64; }
    }
    const int nt = 4 + nlt;
    const T* ksrc; const T* vsrc; const T* rsrc = nullptr; size_t kpitch;
    { const int kk = 8 * wid + (lane >> 3), kch = ((lane & 7) ^ (lane >> 3)) * 8, vch = ((((lane >> 2) ^ (lane >> 4)) & 1) * 32) + (lane & 3) * 8;
      if (BR == 3) { ksrc = P.KVM + (size_t)kk * 512 + hx * 128 + kch; vsrc = P.KVM + (size_t)kk * 512 + hx * 128 + 64 + vch; kpitch = 512;
                     rsrc = P.Z + (size_t)(16 * (wid & 3) + (lane >> 2)) * ZW + MKR + (((lane & 3) ^ ((lane >> 4) & 3)) * 8); }
      else { const int ko = (BR == 0 ? NAK : BR == 1 ? GK : SK) + hx * 64, vo = (BR == 0 ? NAV : BR == 1 ? GV : SV) + hx * 64;
             ksrc = P.Z + (size_t)kk * ZW + ko + kch; vsrc = P.Z + (size_t)kk * ZW + vo + vch; kpitch = ZW; } }
#define A_TROW(t) ((t) < 4 ? ctx0 + (size_t)(t) * 64 : lat0 + (size_t)klo + (size_t)((t) - 4) * 64)
#define A_DMA(t, slot) do { const size_t tr_ = A_TROW(t); const ldsp sb_ = lds + (slot) * SLOT; \
        GLDS16(ksrc + tr_ * kpitch, sb_ + wid * 1152); GLDS16(vsrc + tr_ * kpitch, sb_ + KB + wid * 1024); \
        if (BR == 3) { if (wid < 4) GLDS16(rsrc + tr_ * ZW, sb_ + 9216 + wid * 1024); } } while (0)
#define A_WAITBAR(n) do { if (BR == 3 && wid < 4) asm volatile("s_waitcnt vmcnt(%0) lgkmcnt(0)\n\ts_barrier" :: "n"(3 * (n)) : "memory"); \
                          else asm volatile("s_waitcnt vmcnt(%0) lgkmcnt(0)\n\ts_barrier" :: "n"(2 * (n)) : "memory"); } while (0)
    LAS float* btab = (LAS float*)(lds + BT0);
    if (BR == 0) { if (tid < 465) btab[tid] = P.rpb[hx * 465 + tid] * 1.4426950408889634f; }
    const int qr = (q0 >> 6) + (wid >> 1), qc = (wid & 1) * 32 + r32;
    const int krow0 = min(max(qr - 4, 0), GROWS - 8), kcol0 = min(max(qc - 8, 0), GW - 16);
    float mref = 0.f, lsum = 0.f;
    f32x16 o0, o1, negm;
#pragma unroll
    for (int r = 0; r < 16; ++r) { o0[r] = 0.f; o1[r] = 0.f; negm[r] = 0.f; }
    const unsigned kfo = (r32 >> 3) * 1152 + (r32 & 7) * 128 + ((hi ^ (r32 & 7)) * 16);
    const unsigned rfo = 9216 + r32 * 64 + ((hi ^ ((r32 >> 2) & 3)) * 16);
    const unsigned vfo = KB + (4 * hi + ((lane & 15) >> 2)) * 128 + ((lane >> 3) & 1) * 64 + ((lane >> 4) & 1) * 32 + (lane & 3) * 8;
#define A_ACTIVE(t) (!(BR == 0 && (t) >= 4) || (((klo >> 6) + ((t) - 4)) >= krow0 && ((klo >> 6) + ((t) - 4)) < krow0 + 8))
#define A_QK(p0, p1, slot) do { const ldsp kb_ = lds + (slot) * SLOT; bf16x8 kaf[NKS], kbf[NKS], qkf[NKS]; \
        _Pragma("unroll") for (int ks = 0; ks < NKS; ++ks) { \
            if (ks < 4) { const ldsp a_ = kb_ + (kfo ^ (unsigned)(ks * 32)); kaf[ks] = *(const LAS bf16x8*)(a_); kbf[ks] = *(const LAS bf16x8*)(a_ + 4608); } \
            else { const ldsp a_ = kb_ + (rfo ^ (unsigned)((ks - 4) * 32)); kaf[ks] = *(const LAS bf16x8*)(a_); kbf[ks] = *(const LAS bf16x8*)(a_ + 2048); } \
            qkf[ks] = *(const LAS bf16x8*)(qlds + ks * 1024); } \
        p0 = __builtin_amdgcn_mfma_f32_32x32x16_bf16(kaf[0], qkf[0], negm, 0, 0, 0); p1 = __builtin_amdgcn_mfma_f32_32x32x16_bf16(kbf[0], qkf[0], negm, 0, 0, 0); \
        _Pragma("unroll") for (int ks = 1; ks < NKS; ++ks) { \
          p0 = __builtin_amdgcn_mfma_f32_32x32x16_bf16(kaf[ks], qkf[ks], p0, 0, 0, 0); p1 = __builtin_amdgcn_mfma_f32_32x32x16_bf16(kbf[ks], qkf[ks], p1, 0, 0, 0); } } while (0)
    asm volatile("s_waitcnt lgkmcnt(0)" ::: "memory");
#pragma unroll
    for (int j = 0; j < PF; ++j) { if (j < nt) A_DMA(j, j); }
    if (nt >= PF) A_WAITBAR(PF - 2); else A_WAITBAR(0);
    f32x16 sA0, sA1, sB0, sB1;
    A_QK(sA0, sA1, 0);
    bool act_cur = true;
    int sl = 0;
#define A_STEP(t, pc0, pc1, pn0, pn1) do { \
        const int s1 = (sl + 1 == R) ? 0 : sl + 1, sm = (sl == 0) ? R - 1 : sl - 1; \
        if ((t) + PF < nt) A_DMA((t) + PF, sm);                   \
        const bool act_next = ((t) + 1 < nt) && A_ACTIVE((t) + 1); \
        if (act_next) A_QK(pn0, pn1, s1); \
        if (act_cur) { \
            if (BR == 0) { if ((t) >= 4) { const int dr = (klo >> 6) + ((t) - 4) - qr + 7; \
                    _Pragma("unroll") for (int r = 0; r < 16; ++r) { const int kc0 = crow(r, hi), kc1 = 32 + kc0; \
                        const bool v0 = (unsigned)(kc0 - kcol0) < 16u, v1 = (unsigned)(kc1 - kcol0) < 16u; \
                        const float b0 = btab[dr * 31 + min(max(kc0 - qc + 15, 0), 30)], b1 = btab[dr * 31 + min(max(kc1 - qc + 15, 0), 30)]; \
                        pc0[r] = v0 ? pc0[r] + b0 : NEG; pc1[r] = v1 ? pc1[r] + b1 : NEG; } } } \
            if (BR == 2) { if ((t) >= 4) { const int kb0 = klo + ((t) - 4) * 64 - tokq + 128; \
                    _Pragma("unroll") for (int r = 0; r < 16; ++r) { const int d0 = kb0 + crow(r, hi); \
                        if ((unsigned)d0 > 256u) pc0[r] = NEG; if ((unsigned)(d0 + 32) > 256u) pc1[r] = NEG; } } } \
            float rm; \
            { const float a0 = max3f(pc0[0], pc0[1], pc0[2]), a1 = max3f(pc0[3], pc0[4], pc0[5]), a2 = max3f(pc0[6], pc0[7], pc0[8]), a3 = max3f(pc0[9], pc0[10], pc0[11]), \
                          a4 = max3f(pc0[12], pc0[13], pc0[14]), a5 = max3f(pc0[15], pc1[0], pc1[1]), a6 = max3f(pc1[2], pc1[3], pc1[4]), a7 = max3f(pc1[5], pc1[6], pc1[7]), \
                          a8 = max3f(pc1[8], pc1[9], pc1[10]), a9 = max3f(pc1[11], pc1[12], pc1[13]), a10 = fmaxf(pc1[14], pc1[15]); \
              const float b0 = max3f(a0, a1, a2), b1 = max3f(a3, a4, a5), b2 = max3f(a6, a7, a8), b3 = fmaxf(a9, a10); \
              rm = xhalf_max(fmaxf(fmaxf(b0, b1), fmaxf(b2, b3))); } \
            if ((t) == 0 || __any(rm > THR)) { \
                const float dl = ((t) == 0) ? rm : fmaxf(rm, 0.f); const float f = __builtin_amdgcn_exp2f(-dl); \
                mref += dl; lsum *= f; \
                _Pragma("unroll") for (int r = 0; r < 16; ++r) { pc0[r] -= dl; pc1[r] -= dl; negm[r] -= dl; o0[r] *= f; o1[r] *= f; } \
                if (act_next) { _Pragma("unroll") for (int r = 0; r < 16; ++r) { pn0[r] -= dl; pn1[r] -= dl; } } } \
            _Pragma("unroll") for (int r = 0; r < 16; ++r) { pc0[r] = __builtin_amdgcn_exp2f(pc0[r]); pc1[r] = __builtin_amdgcn_exp2f(pc1[r]); } \
            { float s8[8]; _Pragma("unroll") for (int r = 0; r < 8; ++r) s8[r] = (pc0[r] + pc0[r + 8]) + (pc1[r] + pc1[r + 8]); \
              lsum += ((s8[0] + s8[1]) + (s8[2] + s8[3])) + ((s8[4] + s8[5]) + (s8[6] + s8[7])); } \
            const ldsp vb = lds + sl * SLOT + vfo, vb1 = lds + sl * SLOT + (vfo ^ 64u); \
            bf16x8 pf[4]; \
            _Pragma("unroll") for (int s = 0; s < 4; ++s) { const int rb = (s & 1) * 8; typedef unsigned u4 __attribute__((ext_vector_type(4))); u4 ww; \
                  if (s < 2) ww = (u4){cvtpk(pc0[rb], pc0[rb + 1]), cvtpk(pc0[rb + 2], pc0[rb + 3]), cvtpk(pc0[rb + 4], pc0[rb + 5]), cvtpk(pc0[rb + 6], pc0[rb + 7])}; \
                  else       ww = (u4){cvtpk(pc1[rb], pc1[rb + 1]), cvtpk(pc1[rb + 2], pc1[rb + 3]), cvtpk(pc1[rb + 4], pc1[rb + 5]), cvtpk(pc1[rb + 6], pc1[rb + 7])}; \
                  pf[s] = __builtin_bit_cast(bf16x8, ww); } \
            s16x4 vl0[4], vh0[4], vl1[4], vh1[4]; \
            _Pragma("unroll") for (int s = 0; s < 4; ++s) { vl0[s] = __builtin_bit_cast(s16x4, __builtin_amdgcn_ds_read_tr16_b64_v4i16((LAS v4i16_t*)(vb + s * 2048))); vh0[s] = __builtin_bit_cast(s16x4, __builtin_amdgcn_ds_read_tr16_b64_v4i16((LAS v4i16_t*)(vb + s * 2048 + 1024))); } \
            _Pragma("unroll") for (int s = 0; s < 4; ++s) { vl1[s] = __builtin_bit_cast(s16x4, __builtin_amdgcn_ds_read_tr16_b64_v4i16((LAS v4i16_t*)(vb1 + s * 2048))); vh1[s] = __builtin_bit_cast(s16x4, __builtin_amdgcn_ds_read_tr16_b64_v4i16((LAS v4i16_t*)(vb1 + s * 2048 + 1024))); } \
            _Pragma("unroll") for (int s = 0; s < 4; ++s) { const bf16x8 vf = (bf16x8){vl0[s][0], vl0[s][1], vl0[s][2], vl0[s][3], vh0[s][0], vh0[s][1], vh0[s][2], vh0[s][3]}; o0 = __builtin_amdgcn_mfma_f32_32x32x16_bf16(vf, pf[s], o0, 0, 0, 0); } \
            _Pragma("unroll") for (int s = 0; s < 4; ++s) { const bf16x8 vf = (bf16x8){vl1[s][0], vl1[s][1], vl1[s][2], vl1[s][3], vh1[s][0], vh1[s][1], vh1[s][2], vh1[s][3]}; o1 = __builtin_amdgcn_mfma_f32_32x32x16_bf16(vf, pf[s], o1, 0, 0, 0); } \
        } \
          \
        if ((t) + PF < nt) A_WAITBAR(PF - 2); else A_WAITBAR(0); \
        act_cur = act_next; sl = s1; \
    } while (0)
    { int t = 0;
      for (; t + 1 < nt; t += 2) { A_STEP(t, sA0, sA1, sB0, sB1); A_STEP(t + 1, sB0, sB1, sA0, sA1); }
      if (t < nt) A_STEP(t, sA0, sA1, sB0, sB1); }
    float ltot = xhalf_sum(lsum);
    if (BR == 2) ltot += __builtin_amdgcn_exp2f(P.sink[head] * 1.4426950408889634f - mref);
    const float inv = 1.f / ltot;
#ifdef PROBE_ATTN
    if (P.o32 && b == 1 && (ctxq || tokq < 1024 || tokq >= 7168)) {
        const int sub = ctxq ? 2048 + tokq : (tokq < 1024 ? tokq : 1024 + tokq - 7168);
        float* fp = P.o32 + (size_t)sub * D + BR * 256 + head * 64 + 4 * hi;
#pragma unroll
        for (int g = 0; g < 4; ++g)
#pragma unroll
            for (int j = 0; j < 4; ++j) { fp[8 * g + j] = o0[4 * g + j] * inv; fp[32 + 8 * g + j] = o1[4 * g + j] * inv; }
    }
#endif
    T* op = P.O + qrow * D + BR * 256 + head * 64 + 4 * hi;
#pragma unroll
    for (int g = 0; g < 4; ++g) {
        *(uint2*)(op + 8 * g) = pk4(o0[4 * g] * inv, o0[4 * g + 1] * inv, o0[4 * g + 2] * inv, o0[4 * g + 3] * inv);
        *(uint2*)(op + 32 + 8 * g) = pk4(o1[4 * g] * inv, o1[4 * g + 1] * inv, o1[4 * g + 2] * inv, o1[4 * g + 3] * inv);
    }
#undef A_TROW
#undef A_DMA
#undef A_WAITBAR
#undef A_ACTIVE
#undef A_QK
#undef A_STEP
}


template <int BR>
__device__ __forceinline__ void attn_unit(ldsp lds, const AttnP& P, int b, int hx, int q0, bool ctxq) {
    constexpr int DQK = (BR == 3) ? 96 : 64, NKS = DQK / 16, KB = (BR == 3) ? 9216 + 4096 : 9216, SLOT = KB + 8192;
    constexpr int R = (BR == 3) ? 7 : 9, PF = R - 3;
    constexpr int BT0 = 156672;
    static_assert(R * SLOT <= BT0, "ring");
    constexpr bool PACK2 = (BR == 1 || BR == 2);
    constexpr float SCALE = (BR == 3) ? 0.10206207261596575f : 0.125f;
    constexpr float CL2 = SCALE * 1.4426950408889634f;
    constexpr float NEG = -1e30f, THR = 8.f;
    const int tid = otid(), lane = tid & 63, wid = __builtin_amdgcn_readfirstlane(tid >> 6), r32 = lane & 31, hi = lane >> 5;
    const int tokq = q0 + (PACK2 ? (wid & 3) : wid) * 32 + r32;
    const int head = PACK2 ? hx * 2 + (wid >> 2) : hx;
    const size_t lat0 = (size_t)b * SEQ, ctx0 = (size_t)P.nlat + (size_t)b * CTX;
    const size_t qrow = ctxq ? ctx0 + tokq : lat0 + tokq;
    bf16x8 qf[NKS];
    { const T* qp = (BR == 3) ? P.QM + qrow * 384 + head * 96 + hi * 8 : P.Z + qrow * ZW + (BR == 0 ? NAQ : BR == 1 ? GQ : SQ) + head * 64 + hi * 8;
#pragma unroll
      for (int ks = 0; ks < NKS; ++ks) {
          const uint4 raw = *(const uint4*)(qp + ks * 16);
          typedef unsigned u4 __attribute__((ext_vector_type(4)));
          const u4 w = {cvtpk(__uint_as_float(raw.x << 16) * CL2, __uint_as_float(raw.x & 0xffff0000u) * CL2), cvtpk(__uint_as_float(raw.y << 16) * CL2, __uint_as_float(raw.y & 0xffff0000u) * CL2),
                        cvtpk(__uint_as_float(raw.z << 16) * CL2, __uint_as_float(raw.z & 0xffff0000u) * CL2), cvtpk(__uint_as_float(raw.w << 16) * CL2, __uint_as_float(raw.w & 0xffff0000u) * CL2)};
          qf[ks] = __builtin_bit_cast(bf16x8, w); } }
    int klo = 0, nlt = 0;
    if (!ctxq) {
        if (BR == 0) { const int r0 = q0 >> 6; const int lo = min(max(r0 - 4, 0), GROWS - 8), hi2 = min(max(r0 - 1, 0), GROWS - 8) + 8; klo = lo * 64; nlt = hi2 - lo; }
        else if (BR == 2) { klo = max(q0 - 128, 0); nlt = (min(q0 + 256, SEQ) - klo) >> 6; }
        else { klo = 0; nlt = SEQ / 64; }
    }
    const int nt = 4 + nlt;
    const T* ksrc; const T* vsrc; const T* rsrc = nullptr; size_t kpitch;
    { const int kk = 8 * wid + (lane >> 3), kch = ((lane & 7) ^ (lane >> 3)) * 8, vch = ((((lane >> 2) ^ (lane >> 4)) & 1) * 32) + (lane & 3) * 8;
      if (BR == 3) { ksrc = P.KVM + (size_t)kk * 512 + hx * 128 + kch; vsrc = P.KVM + (size_t)kk * 512 + hx * 128 + 64 + vch; kpitch = 512;
                     rsrc = P.Z + (size_t)(16 * (wid & 3) + (lane >> 2)) * ZW + MKR + (((lane & 3) ^ ((lane >> 4) & 3)) * 8); }
      else { const int ko = (BR == 0 ? NAK : BR == 1 ? GK : SK) + hx * 64, vo = (BR == 0 ? NAV : BR == 1 ? GV : SV) + hx * 64;
             ksrc = P.Z + (size_t)kk * ZW + ko + kch; vsrc = P.Z + (size_t)kk * ZW + vo + vch; kpitch = ZW; } }
#define A_TROW(t) ((t) < 4 ? ctx0 + (size_t)(t) * 64 : lat0 + (size_t)klo + (size_t)((t) - 4) * 64)
#define A_DMA(t, slot) do { if (wid < 4) { const size_t tr_ = A_TROW(t); const ldsp sb_ = lds + (slot) * SLOT; \
        GLDS16(ksrc + tr_ * kpitch, sb_ + wid * 1152); GLDS16(ksrc + (tr_ + 32) * kpitch, sb_ + (wid + 4) * 1152); \
        GLDS16(vsrc + tr_ * kpitch, sb_ + KB + wid * 1024); GLDS16(vsrc + (tr_ + 32) * kpitch, sb_ + KB + (wid + 4) * 1024); \
        if (BR == 3) GLDS16(rsrc + tr_ * ZW, sb_ + 9216 + wid * 1024); } } while (0)
#define A_WAITBAR(n) do { if (wid < 4) { if (BR == 3) asm volatile("s_waitcnt vmcnt(%0) lgkmcnt(0)\n\ts_barrier" :: "n"(5 * (n)) : "memory"); \
                                         else asm volatile("s_waitcnt vmcnt(%0) lgkmcnt(0)\n\ts_barrier" :: "n"(4 * (n)) : "memory"); } \
                          else asm volatile("s_waitcnt lgkmcnt(0)\n\ts_barrier" ::: "memory"); } while (0)
    LAS float* btab = (LAS float*)(lds + BT0);
    if (BR == 0) { if (tid < 465) btab[tid] = P.rpb[hx * 465 + tid] * 1.4426950408889634f; }
    const int qr = (q0 >> 6) + (wid >> 1), qc = (wid & 1) * 32 + r32;
    const int krow0 = min(max(qr - 4, 0), GROWS - 8), kcol0 = min(max(qc - 8, 0), GW - 16);
    float mref = 0.f, lsum = 0.f;
    f32x16 o0, o1, negm;
#pragma unroll
    for (int r = 0; r < 16; ++r) { o0[r] = 0.f; o1[r] = 0.f; negm[r] = 0.f; }
    const unsigned kfo = (r32 >> 3) * 1152 + (r32 & 7) * 128 + ((hi ^ (r32 & 7)) * 16);
    const unsigned rfo = 9216 + r32 * 64 + ((hi ^ ((r32 >> 2) & 3)) * 16);
    const unsigned vfo = KB + (4 * hi + ((lane & 15) >> 2)) * 128 + ((lane >> 3) & 1) * 64 + ((lane >> 4) & 1) * 32 + (lane & 3) * 8;
    constexpr int NG = 8 + 2 * NKS, AHEAD = 4, NGT = NG;
    if (wid < 4) { const size_t tr_ = A_TROW(0); GLDS16(vsrc + tr_ * kpitch, lds + (R - 1) * SLOT + KB + wid * 1024); GLDS16(vsrc + (tr_ + 32) * kpitch, lds + (R - 1) * SLOT + KB + (wid + 4) * 1024); }
#pragma unroll
    for (int j = 0; j < PF; ++j) { if (j < nt) A_DMA(j, j); }
    if (nt >= PF) A_WAITBAR(PF - 3); else A_WAITBAR(0);
    f32x16 sA0, sA1, sB0, sB1;
    { const ldsp kb_ = lds;
#pragma unroll
      for (int r = 0; r < 16; ++r) { sA0[r] = 0.f; sA1[r] = 0.f; }
#pragma unroll
      for (int ks = 0; ks < NKS; ++ks) { const ldsp a_ = kb_ + ((ks < 4) ? (kfo ^ (unsigned)(ks * 32)) : (rfo ^ (unsigned)((ks - 4) * 32)));
          const bf16x8 ka = *(const LAS bf16x8*)(a_), kb = *(const LAS bf16x8*)(a_ + ((ks < 4) ? 4608 : 2048));
          sA0 = __builtin_amdgcn_mfma_f32_32x32x16_bf16(ka, qf[ks], sA0, 0, 0, 0); sA1 = __builtin_amdgcn_mfma_f32_32x32x16_bf16(kb, qf[ks], sA1, 0, 0, 0); } }
    unsigned pwA[16], pwB[16];
#pragma unroll
    for (int i = 0; i < 16; ++i) { pwA[i] = 0u; pwB[i] = 0u; }
    int sl = 0;
#ifdef PROBE_T
    unsigned long long pt_acc = 0ull, pt_a = 0ull, pt_b = 0ull; const unsigned long long pt_t0 = __builtin_amdgcn_s_memtime(), pt_r0 = __builtin_amdgcn_s_memrealtime();
#define PT_A(k) do { if (PROBE_T == (k)) pt_a = __builtin_amdgcn_s_memtime(); } while (0)
#define PT_B(k) do { if (PROBE_T == (k)) { pt_b = __builtin_amdgcn_s_memtime(); pt_acc += pt_b - pt_a; } } while (0)
#else
#define PT_A(k) do { } while (0)
#define PT_B(k) do { } while (0)
#endif
#define S_EL(c0, c1, i) ((i) < 16 ? c0[(i) & 15] : c1[(i) & 15])
#define SB0() __builtin_amdgcn_sched_barrier(0)
    const unsigned lds0 = (unsigned)(size_t)lds;
#define DSR128(dst, addr, OFF) asm volatile("ds_read_b128 %0, %1 offset:" #OFF : "=v"(dst) : "v"(addr))
#define DSRTR(dst, addr, OFF) asm volatile("ds_read_b64_tr_b16 %0, %1 offset:" #OFF : "=v"(dst) : "v"(addr))
#define A_RD(m) do { switch (m) { \
        case 0: DSRTR(vL[0], vb_, 0); DSRTR(vH[0], vb_, 1024); break; case 1: DSRTR(vL[1], vc_, 0); DSRTR(vH[1], vc_, 1024); break; \
        case 2: DSRTR(vL[2], vb_, 2048); DSRTR(vH[2], vb_, 3072); break; case 3: DSRTR(vL[3], vc_, 2048); DSRTR(vH[3], vc_, 3072); break; \
        case 4: DSRTR(vL[4], vb_, 4096); DSRTR(vH[4], vb_, 5120); break; case 5: DSRTR(vL[5], vc_, 4096); DSRTR(vH[5], vc_, 5120); break; \
        case 6: DSRTR(vL[6], vb_, 6144); DSRTR(vH[6], vb_, 7168); break; case 7: DSRTR(vL[7], vc_, 6144); DSRTR(vH[7], vc_, 7168); break; \
        default: { const int q_ = (m) - 8, ks_ = q_ >> 1; \
                   if (ks_ < 4) { const unsigned a_ = kb_ + (kfo ^ (unsigned)(ks_ * 32)); if (q_ & 1) DSR128(kF[q_], a_, 4608); else DSR128(kF[q_], a_, 0); } \
                   else { const unsigned a_ = kb_ + (rfo ^ (unsigned)((ks_ - 4) * 32)); if (q_ & 1) DSR128(kF[q_], a_, 2048); else DSR128(kF[q_], a_, 0); } } break; } } while (0)
#define NRD(m) ((m) < 8 ? 2 : 1)
#define A_WT(g, n) do { if ((g) < 8) { if ((n) == 0) asm volatile("s_waitcnt lgkmcnt(0)" : "+v"(vL[g]), "+v"(vH[g])); else if ((n) == 1) asm volatile("s_waitcnt lgkmcnt(1)" : "+v"(vL[g]), "+v"(vH[g])); \
            else if ((n) == 2) asm volatile("s_waitcnt lgkmcnt(2)" : "+v"(vL[g]), "+v"(vH[g])); else if ((n) == 3) asm volatile("s_waitcnt lgkmcnt(3)" : "+v"(vL[g]), "+v"(vH[g])); \
            else if ((n) == 4) asm volatile("s_waitcnt lgkmcnt(4)" : "+v"(vL[g]), "+v"(vH[g])); else if ((n) == 5) asm volatile("s_waitcnt lgkmcnt(5)" : "+v"(vL[g]), "+v"(vH[g])); \
            else if ((n) == 6) asm volatile("s_waitcnt lgkmcnt(6)" : "+v"(vL[g]), "+v"(vH[g])); else if ((n) == 7) asm volatile("s_waitcnt lgkmcnt(7)" : "+v"(vL[g]), "+v"(vH[g])); \
            else asm volatile("s_waitcnt lgkmcnt(8)" : "+v"(vL[g]), "+v"(vH[g])); } \
        else { if ((n) == 0) asm volatile("s_waitcnt lgkmcnt(0)" : "+v"(kF[(g) - 8])); else if ((n) == 1) asm volatile("s_waitcnt lgkmcnt(1)" : "+v"(kF[(g) - 8])); \
            else if ((n) == 2) asm volatile("s_waitcnt lgkmcnt(2)" : "+v"(kF[(g) - 8])); else if ((n) == 3) asm volatile("s_waitcnt lgkmcnt(3)" : "+v"(kF[(g) - 8])); \
            else asm volatile("s_waitcnt lgkmcnt(4)" : "+v"(kF[(g) - 8])); } } while (0)
#define A_ITER(t, c0, c1, n0, n1, pwO, pwN, EVEN) do { \
        const int s1 = (sl + 1 == R) ? 0 : sl + 1, sm1 = (sl == 0) ? R - 1 : sl - 1, sm2 = (sm1 == 0) ? R - 1 : sm1 - 1; \
        const bool feed = (t) + PF < nt; PT_A(4); \
        if (BR == 2) { if ((t) >= 4) { const int kb0 = klo + ((t) - 4) * 64 - tokq + 128; \
                _Pragma("unroll") for (int r = 0; r < 16; ++r) { const int d0 = kb0 + crow(r, hi); \
                    if ((unsigned)d0 > 256u) c0[r] = NEG; if ((unsigned)(d0 + 32) > 256u) c1[r] = NEG; } } } \
          \
        const unsigned vb_ = lds0 + sm1 * SLOT + vfo, vc_ = lds0 + sm1 * SLOT + (vfo ^ 64u); const unsigned kb_ = lds0 + s1 * SLOT; \
        s16x4 vL[8], vH[8]; bf16x8 kF[2 * NKS]; \
        _Pragma("unroll") for (int m = 0; m < AHEAD; ++m) A_RD(m); \
        float rm; \
        { const float a0 = max3f(c0[0], c0[1], c0[2]), a1 = max3f(c0[3], c0[4], c0[5]), a2 = max3f(c0[6], c0[7], c0[8]), a3 = max3f(c0[9], c0[10], c0[11]), \
                      a4 = max3f(c0[12], c0[13], c0[14]), a5 = max3f(c0[15], c1[0], c1[1]), a6 = max3f(c1[2], c1[3], c1[4]), a7 = max3f(c1[5], c1[6], c1[7]), \
                      a8 = max3f(c1[8], c1[9], c1[10]), a9 = max3f(c1[11], c1[12], c1[13]), a10 = fmaxf(c1[14], c1[15]); \
          const float b0 = max3f(a0, a1, a2), b1 = max3f(a3, a4, a5), b2 = max3f(a6, a7, a8), b3 = fmaxf(a9, a10); \
          rm = xhalf_max(fmaxf(fmaxf(b0, b1), fmaxf(b2, b3))); } \
        if ((t) == 0 || __any(rm > THR)) {                   \
            const float dl = ((t) == 0) ? rm : fmaxf(rm, 0.f); const float f = __builtin_amdgcn_exp2f(-dl); \
            mref += dl; lsum *= f; \
            _Pragma("unroll") for (int r = 0; r < 16; ++r) { c0[r] -= dl; c1[r] -= dl; o0[r] *= f; o1[r] *= f; negm[r] -= dl; } \
            _Pragma("unroll") for (int i = 0; i < 16; ++i) pwO[i] = cvtpk(__uint_as_float(pwO[i] << 16) * f, __uint_as_float(pwO[i] & 0xffff0000u) * f); } \
        float acs0 = 0.f, acs1 = 0.f; SB0(); PT_B(4); PT_A(5); \
        _Pragma("unroll") for (int g = 0; g < NGT; ++g) { \
              \
            if (g + AHEAD < NG) A_RD(g + AHEAD); \
              \
            if (g < NG) { int n_ = 0; _Pragma("unroll") for (int m = g + 1; m <= g + AHEAD; ++m) if (m < NG) n_ += NRD(m); A_WT(g, n_); } \
              \
            if (g < 8) { typedef unsigned u4 __attribute__((ext_vector_type(4))); const int s = g >> 1; \
                const u4 pw4 = {pwO[4 * s], pwO[4 * s + 1], pwO[4 * s + 2], pwO[4 * s + 3]}; const bf16x8 pfr = __builtin_bit_cast(bf16x8, pw4); \
                const bf16x8 vf = (bf16x8){vL[g][0], vL[g][1], vL[g][2], vL[g][3], vH[g][0], vH[g][1], vH[g][2], vH[g][3]}; \
                if ((g & 1) == 0) o0 = __builtin_amdgcn_mfma_f32_32x32x16_bf16(vf, pfr, o0, 0, 0, 0); else o1 = __builtin_amdgcn_mfma_f32_32x32x16_bf16(vf, pfr, o1, 0, 0, 0); } \
            else if (g < NG) { const int q_ = g - 8, ks = q_ >> 1; \
                if ((q_ & 1) == 0) n0 = __builtin_amdgcn_mfma_f32_32x32x16_bf16(kF[q_], qf[ks], ks == 0 ? negm : n0, 0, 0, 0); \
                else               n1 = __builtin_amdgcn_mfma_f32_32x32x16_bf16(kF[q_], qf[ks], ks == 0 ? negm : n1, 0, 0, 0); } \
              \
            if (g < 16) { const float e0 = __builtin_amdgcn_exp2f(S_EL(c0, c1, 2 * g)), e1 = __builtin_amdgcn_exp2f(S_EL(c0, c1, 2 * g + 1)); \
                pwN[g] = cvtpk(e0, e1); \
                  \
                { float t_ = e0 + e1; asm volatile("" : "+v"(t_)); if ((g & 1) == 0) { acs0 += t_; asm volatile("" : "+v"(acs0)); } else { acs1 += t_; asm volatile("" : "+v"(acs1)); } } } \
            SB0(); \
        } \
        lsum += acs0 + acs1; PT_B(5); PT_A(3); \
          \
          \
        if (EVEN) { const int sp0 = (sl + PF >= R) ? sl + PF - R : sl + PF, sp1 = (sp0 + 1 == R) ? 0 : sp0 + 1; \
                    if (feed) A_DMA((t) + PF, sp0); if ((t) + PF + 1 < nt) A_DMA((t) + PF + 1, sp1); \
                    if ((t) + 1 >= nt) A_WAITBAR(0); } \
        else { if ((t) + PF < nt) A_WAITBAR(PF - 3); else A_WAITBAR(0); } PT_B(3); \
        sl = s1; \
    } while (0)
    { int t = 0;
      for (; t + 1 < nt; t += 2) { A_ITER(t, sA0, sA1, sB0, sB1, pwA, pwB, 1); A_ITER(t + 1, sB0, sB1, sA0, sA1, pwB, pwA, 0); }
      if (t < nt) { A_ITER(t, sA0, sA1, sB0, sB1, pwA, pwB, 1);
#pragma unroll
          for (int i = 0; i < 16; ++i) pwA[i] = pwB[i]; } }
    { const int sm1 = (sl == 0) ? R - 1 : sl - 1; const ldsp vb_ = lds + sm1 * SLOT + vfo, vc_ = lds + sm1 * SLOT + (vfo ^ 64u);
#pragma unroll
      for (int s = 0; s < 4; ++s) {
          typedef unsigned u4 __attribute__((ext_vector_type(4))); const u4 pw4 = {pwA[4 * s], pwA[4 * s + 1], pwA[4 * s + 2], pwA[4 * s + 3]}; const bf16x8 pfr = __builtin_bit_cast(bf16x8, pw4);
#pragma unroll
          for (int d0 = 0; d0 < 2; ++d0) { const ldsp vp = (d0 ? vc_ : vb_) + s * 2048;
              const s16x4 lo = __builtin_bit_cast(s16x4, __builtin_amdgcn_ds_read_tr16_b64_v4i16((LAS v4i16_t*)vp)), hi4 = __builtin_bit_cast(s16x4, __builtin_amdgcn_ds_read_tr16_b64_v4i16((LAS v4i16_t*)(vp + 1024)));
              const bf16x8 vf = (bf16x8){lo[0], lo[1], lo[2], lo[3], hi4[0], hi4[1], hi4[2], hi4[3]};
              if (d0 == 0) o0 = __builtin_amdgcn_mfma_f32_32x32x16_bf16(vf, pfr, o0, 0, 0, 0); else o1 = __builtin_amdgcn_mfma_f32_32x32x16_bf16(vf, pfr, o1, 0, 0, 0); }
          } }
    asm volatile("s_waitcnt lgkmcnt(0)\n\ts_barrier" ::: "memory");
#ifdef PROBE_T
    if (BR == PROBE_BR && P.o32 && blockIdx.x == 0 && wid == PROBE_W && lane == 0) {
        const unsigned long long t1 = __builtin_amdgcn_s_memtime(), r1 = __builtin_amdgcn_s_memrealtime();
        float c;
        if (PROBE_T == 1) c = 1e-5f * (float)(t1 - pt_t0) / (float)nt;
        else if (PROBE_T == 2) c = 1e-3f * (float)(t1 - pt_t0) / (float)(r1 - pt_r0);
        else c = 1e-5f * (float)pt_acc / (float)nt;
        P.o32[0] = 1.f + c;
    }
#endif
#undef S_EL
#undef SB0
#undef A_ITER
#undef A_RD
#undef NRD
#undef A_WT
#undef DSR128
#undef DSRTR
    float ltot = xhalf_sum(lsum);
    if (BR == 2) ltot += __builtin_amdgcn_exp2f(P.sink[head] * 1.4426950408889634f - mref);
    const float inv = 1.f / ltot;
#ifdef PROBE_ATTN
    if (P.o32 && b == 1 && (ctxq || tokq < 1024 || tokq >= 7168)) {
        const int sub = ctxq ? 2048 + tokq : (tokq < 1024 ? tokq : 1024 + tokq - 7168);
        float* fp = P.o32 + (size_t)sub * D + BR * 256 + head * 64 + 4 * hi;
#pragma unroll
        for (int g = 0; g < 4; ++g)
#pragma unroll
            for (int j = 0; j < 4; ++j) { fp[8 * g + j] = o0[4 * g + j] * inv; fp[32 + 8 * g + j] = o1[4 * g + j] * inv; }
    }
#endif
    T* op = P.O + qrow * D + BR * 256 + head * 64 + 4 * hi;
#pragma unroll
    for (int g = 0; g < 4; ++g) {
        *(uint2*)(op + 8 * g) = pk4(o0[4 * g] * inv, o0[4 * g + 1] * inv, o0[4 * g + 2] * inv, o0[4 * g + 3] * inv);
        *(uint2*)(op + 32 + 8 * g) = pk4(o1[4 * g] * inv, o1[4 * g + 1] * inv, o1[4 * g + 2] * inv, o1[4 * g + 3] * inv);
    }
#undef A_TROW
#undef A_DMA
#undef A_WAITBAR
#undef A_ACTIVE
#undef A_QK
#undef A_STEP
}

__device__ __forceinline__ void attn_phase(ldsp lds, const AttnP& P, int bid, int nblk) {
    for (int u = bid; u < 512; u += nblk) attn_unit<3>(lds, P, u >> 7, (u >> 5) & 3, (u & 31) * 256, false);
    for (int u = bid; u < 512; u += nblk) attn_unit<1>(lds, P, u >> 7, (u >> 6) & 1, (u & 63) * 128, false);
    for (int u = bid; u < 512; u += nblk) attn_unit_l<0>(lds, P, u >> 7, (u >> 5) & 3, (u & 31) * 256, false);
    for (int u = bid; u < 512; u += nblk) attn_unit<2>(lds, P, u >> 7, (u >> 6) & 1, (u & 63) * 128, false);
    if (P.need_ctx) {
        for (int u = bid; u < 64; u += nblk) {
            const int br = u >> 4, bb = (u >> 2) & 3, x = u & 3;
            if (br == 0) attn_unit_l<0>(lds, P, bb, x, 0, true);
            else if (br == 1) attn_unit<1>(lds, P, bb, x >> 1, (x & 1) * 128, true);
            else if (br == 2) attn_unit<2>(lds, P, bb, x >> 1, (x & 1) * 128, true);
            else attn_unit<3>(lds, P, bb, x, 0, true);
        }
    }
}

constexpr size_t al256(size_t b) { return (b + 255) & ~(size_t)255; }
constexpr size_t NSLOT_ = (size_t)NB * NE * (CAP + CAPC);
constexpr size_t OFF_BAR = 0, OFF_MODV = OFF_BAR + al256(3456 * 4), OFF_TAB64 = OFF_MODV + al256((size_t)NL * 5 * MODW * 4), OFF_TAB32 = OFF_TAB64 + al256(128 * 16 * 8),
    OFF_RA = OFF_TAB32 + al256(128 * 8 * 8), OFF_RC = OFF_RA + al256((size_t)NROW * D * 2), OFF_XCA = OFF_RC + al256((size_t)NROW * D * 2), OFF_XCB = OFF_XCA + al256((size_t)NCTX * D * 4),
    OFF_AFF = OFF_XCB + al256((size_t)NCTX * D * 4), OFF_IDX = OFF_AFF + al256((size_t)NROW * NE * 4), OFF_GATEV = OFF_IDX + al256(NSLOT_ * 4), OFF_INV = OFF_GATEV + al256(NSLOT_ * 4),
    OFF_Z = OFF_INV + al256((size_t)NROW * NE * 4), OFF_WINT = OFF_Z + al256((size_t)NROW * ZW * 2), OFF_WQT = OFF_WINT + al256((size_t)NL * 6400 * D * 2), OFF_WKVT = OFF_WQT + al256((size_t)NL * 384 * 192 * 2),
    OFF_SS = OFF_WKVT + al256((size_t)NL * 512 * 128 * 2), OFF_WBT = OFF_SS + al256((size_t)NROW * 8 * 4), OFF_WOUTT = OFF_WBT + al256((size_t)NL * 4 * 1024 * 256 * 2), OFF_END = OFF_WOUTT + al256((size_t)NL * D * D * 2);
struct MP {
    const float *x_, *c_, *ctx_, *c_ctx_, *w_mod_, *b_mod_, *w_in_, *na_rpb_, *gqn_, *gkn_, *swa_sink_, *mqn_, *mkvn_, *w_qb_, *w_kvb_, *w_branch_, *w_out_,
                *ln1g_, *ln1b_, *ln2g_, *ln2b_, *w_router_, *w_gate_, *w_up_, *w_down_;
    float* out_; char* ws_;
    float* o32_; const float* pscale_;
    int ph_lo_, ph_hi_;
    __device__ __forceinline__ const float* x() const { return x_; }
    __device__ __forceinline__ const float* c() const { return c_; }
    __device__ __forceinline__ const float* ctx() const { return ctx_; }
    __device__ __forceinline__ const float* c_ctx() const { return c_ctx_; }
    __device__ __forceinline__ const float* w_mod() const { return w_mod_; }
    __device__ __forceinline__ const float* b_mod() const { return b_mod_; }
    __device__ __forceinline__ const float* w_in() const { return w_in_; }
    __device__ __forceinline__ const float* na_rpb() const { return na_rpb_; }
    __device__ __forceinline__ const float* gqn() const { return gqn_; }
    __device__ __forceinline__ const float* gkn() const { return gkn_; }
    __device__ __forceinline__ const float* swa_sink() const { return swa_sink_; }
    __device__ __forceinline__ const float* mqn() const { return mqn_; }
    __device__ __forceinline__ const float* mkvn() const { return mkvn_; }
    __device__ __forceinline__ const float* w_qb() const { return w_qb_; }
    __device__ __forceinline__ const float* w_kvb() const { return w_kvb_; }
    __device__ __forceinline__ const float* w_branch() const { return w_branch_; }
    __device__ __forceinline__ const float* w_out() const { return w_out_; }
    __device__ __forceinline__ const float* ln1g() const { return ln1g_; }
    __device__ __forceinline__ const float* ln1b() const { return ln1b_; }
    __device__ __forceinline__ const float* ln2g() const { return ln2g_; }
    __device__ __forceinline__ const float* ln2b() const { return ln2b_; }
    __device__ __forceinline__ const float* w_router() const { return w_router_; }
    __device__ __forceinline__ const float* w_gate() const { return w_gate_; }
    __device__ __forceinline__ const float* w_up() const { return w_up_; }
    __device__ __forceinline__ const float* w_down() const { return w_down_; }
    __device__ __forceinline__ float* out() const { return out_; }
    __device__ __forceinline__ char* ws() const { return ws_; }
    __device__ __forceinline__ float* o32() const { return o32_; }
    __device__ __forceinline__ const float* pscale() const { return pscale_; }
    __device__ __forceinline__ int ph_lo() const { return ph_lo_; }
    __device__ __forceinline__ int ph_hi() const { return ph_hi_; }
    __device__ __forceinline__ unsigned* bar() const { return (unsigned*)(ws() + OFF_BAR); }
    __device__ __forceinline__ float* modv() const { return (float*)(ws() + OFF_MODV); }
    __device__ __forceinline__ float2* tab64() const { return (float2*)(ws() + OFF_TAB64); }
    __device__ __forceinline__ float2* tab32() const { return (float2*)(ws() + OFF_TAB32); }
    __device__ __forceinline__ T* RA() const { return (T*)(ws() + OFF_RA); }
    __device__ __forceinline__ T* RC() const { return (T*)(ws() + OFF_RC); }
    __device__ __forceinline__ float* XCa() const { return (float*)(ws() + OFF_XCA); }
    __device__ __forceinline__ float* XCb() const { return (float*)(ws() + OFF_XCB); }
    __device__ __forceinline__ float* AFF() const { return (float*)(ws() + OFF_AFF); }
    __device__ __forceinline__ int* IDX() const { return (int*)(ws() + OFF_IDX); }
    __device__ __forceinline__ float* GATEV() const { return (float*)(ws() + OFF_GATEV); }
    __device__ __forceinline__ int* INV() const { return (int*)(ws() + OFF_INV); }
    __device__ __forceinline__ T* Z() const { return (T*)(ws() + OFF_Z); }
    __device__ __forceinline__ T* WinT() const { return (T*)(ws() + OFF_WINT); }
    __device__ __forceinline__ T* WqT() const { return (T*)(ws() + OFF_WQT); }
    __device__ __forceinline__ T* WkvT() const { return (T*)(ws() + OFF_WKVT); }
    __device__ __forceinline__ float* SS() const { return (float*)(ws() + OFF_SS); }
    __device__ __forceinline__ T* WbT() const { return (T*)(ws() + OFF_WBT); }
    __device__ __forceinline__ T* WoutT() const { return (T*)(ws() + OFF_WOUTT); }
};

__device__ __forceinline__ void ph_mod(ldsp lds, const MP& p, int bid, int nblk) {
    LAS float* sc = (LAS float*)lds;
    LAS float* red = (LAS float*)(lds + 5 * 1024 * 4);
    const int tid = otid(), lane = tid & 63, kg = tid >> 6;
    for (int i = tid; i < 5 * 1024; i += 512) { const int s = i >> 10, k = i & 1023; const float v = s < 4 ? p.c()[s * 1024 + k] : p.c_ctx()[k]; sc[i] = v / (1.f + expf(-v)); }
    __syncthreads();
    for (int u = bid; u < NL * (MODW / 64); u += nblk) {
        const int l = u / (MODW / 64), j = (u % (MODW / 64)) * 64 + lane;
        float acc[5] = {0.f, 0.f, 0.f, 0.f, 0.f};
        const float* w = p.w_mod() + (size_t)l * D * MODW + j;
        for (int k = kg * 128; k < kg * 128 + 128; ++k) { const float wv = w[(size_t)k * MODW];
#pragma unroll
            for (int s = 0; s < 5; ++s) acc[s] += sc[s * 1024 + k] * wv; }
#pragma unroll
        for (int s = 0; s < 5; ++s) red[(kg * 5 + s) * 64 + lane] = acc[s];
        __syncthreads();
        if (kg < 5) { const int s = kg; float v = p.b_mod()[l * MODW + j];
#pragma unroll
            for (int g = 0; g < 8; ++g) v += red[(g * 5 + s) * 64 + lane];
            p.modv()[((size_t)l * 5 + s) * MODW + j] = v; }
        __syncthreads();
    }
}
__device__ __forceinline__ void ph_ropetab(const MP& p, int bid, int nblk) {
    for (int t = bid * 512 + otid(); t < 128 * 16; t += nblk * 512) {
        { const int pos = t / 16, i = t % 16; const float a = (float)pos * powf(10000.f, -(float)i / 16.f); p.tab64()[t] = make_float2(cosf(a), sinf(a)); }
        if (t < 128 * 8) { const int pos = t / 8, i = t % 8; const float a = (float)pos * powf(10000.f, -(float)i / 8.f); p.tab32()[t] = make_float2(cosf(a), sinf(a)); }
    }
}
struct PrepJob { const float* src; const float* src2; const float* kscale; T* dst; int K, Nsrc, Ndst, mode, nz, perm; long long src_zs, dst_zs, ks_zs; };
__device__ __forceinline__ void ph_wprep(ldsp lds, const PrepJob& a, int bid, int nblk) {
    constexpr int NT = 4;
    LAS float* tile = (LAS float*)lds;
    const int tid_ = otid();
    const int kr = tid_ >> 4, c4 = tid_ & 15;
    const int kq = tid_ & 7, nr = tid_ >> 3;
    const int nx = a.Ndst / 64, ny = a.K / 64, ntile = nx * ny * a.nz;
    float4 v0[NT], v1[NT];
#define WP_LOAD(i, u) do { const int z_ = (u) / (nx * ny), rem_ = (u) % (nx * ny), n0_ = (rem_ % nx) * 64, k0_ = (rem_ / nx) * 64; \
        const float* src_ = a.src + (size_t)z_ * a.src_zs; const float* ksc_ = a.kscale ? a.kscale + (size_t)z_ * a.ks_zs : nullptr; \
        int n_ = n0_ + 4 * c4; if (a.perm) { const int p_ = n_ & 255; n_ = (n_ & ~255) + 64 * ((p_ >> 5) & 3) + 32 * (p_ >> 7) + (p_ & 31); } bool valid_ = true; int col_ = n_; const float* sp_ = src_; \
        if (a.mode == 0) { valid_ = n_ < a.Nsrc; } \
        else if (a.mode == 1) { if (n_ < 2144) col_ = n_; else if (n_ < 2304) valid_ = false; else col_ = n_ - 160; } \
        else { const int j_ = n_ >> 6, w_ = n_ & 63; if (w_ >= 32) sp_ = a.src2 + (size_t)z_ * a.src_zs; col_ = 32 * j_ + (w_ & 31); } \
        v0[i] = make_float4(0.f, 0.f, 0.f, 0.f); v1[i] = v0[i]; \
        if (valid_) { v0[i] = *(const float4*)(sp_ + (size_t)(k0_ + kr) * a.Nsrc + col_); v1[i] = *(const float4*)(sp_ + (size_t)(k0_ + kr + 32) * a.Nsrc + col_); \
            if (ksc_) { const float s0_ = ksc_[k0_ + kr], s1_ = ksc_[k0_ + kr + 32]; v0[i].x *= s0_; v0[i].y *= s0_; v0[i].z *= s0_; v0[i].w *= s0_; v1[i].x *= s1_; v1[i].y *= s1_; v1[i].z *= s1_; v1[i].w *= s1_; } } } while (0)
    int u = bid, buf = 0;
#pragma unroll
    for (int i = 0; i < NT; ++i) { if (u + i * nblk < ntile) WP_LOAD(i, u + i * nblk); }
    for (; u < ntile; u += NT * nblk) {
        LAS float* tb = tile + buf * (NT * 64 * 65);
#pragma unroll
        for (int i = 0; i < NT; ++i) { if (u + i * nblk < ntile) { LAS float* w0 = tb + i * (64 * 65) + kr * 65 + 4 * c4; LAS float* w1 = w0 + 32 * 65;
            w0[0] = v0[i].x; w0[1] = v0[i].y; w0[2] = v0[i].z; w0[3] = v0[i].w; w1[0] = v1[i].x; w1[1] = v1[i].y; w1[2] = v1[i].z; w1[3] = v1[i].w; } }
        __syncthreads();
#pragma unroll
        for (int i = 0; i < NT; ++i) { const int un = u + (NT + i) * nblk; if (un < ntile) WP_LOAD(i, un); }
#pragma unroll
        for (int i = 0; i < NT; ++i) { const int ui = u + i * nblk; if (ui < ntile) {
            const int z = ui / (nx * ny), rem = ui % (nx * ny), n0 = (rem % nx) * 64, k0 = (rem / nx) * 64;
            T* dst = a.dst + (size_t)z * a.dst_zs;
            const LAS float* rp = tb + i * (64 * 65) + (kq * 8) * 65 + nr;
            *(uint4*)(dst + (size_t)(n0 + nr) * a.K + k0 + kq * 8) = make_uint4(pk2(rp[0], rp[65]), pk2(rp[130], rp[195]), pk2(rp[260], rp[325]), pk2(rp[390], rp[455])); } }
        buf ^= 1;
    }
#undef WP_LOAD
    __syncthreads();
}
__device__ __forceinline__ void lnmod_row(const float* src, const float* mv, int sh_off, int sc_off, T* dst, int lane) {
    float4 v[4]; float sum = 0.f;
#pragma unroll
    for (int i = 0; i < 4; ++i) { v[i] = *(const float4*)(src + i * 256 + lane * 4); sum += v[i].x + v[i].y + v[i].z + v[i].w; }
    const float mean = wave_sum(sum) * (1.f / D);
    float sq = 0.f;
#pragma unroll
    for (int i = 0; i < 4; ++i) { float a = v[i].x - mean, b = v[i].y - mean, c = v[i].z - mean, d = v[i].w - mean; sq += a * a + b * b + c * c + d * d; }
    const float rstd = 1.f / sqrtf(wave_sum(sq) * (1.f / D) + EPS);
#pragma unroll
    for (int i = 0; i < 4; ++i) {
        const int col = i * 256 + lane * 4;
        const float4 sh = *(const float4*)(mv + sh_off + col), sc = *(const float4*)(mv + sc_off + col);
        st4(dst + col, make_float4((v[i].x - mean) * rstd * (1.f + sc.x) + sh.x, (v[i].y - mean) * rstd * (1.f + sc.y) + sh.y,
                                   (v[i].z - mean) * rstd * (1.f + sc.z) + sh.z, (v[i].w - mean) * rstd * (1.f + sc.w) + sh.w));
    }
}
__device__ __forceinline__ void ph_lnmod0(const MP& p, int bid, int nblk) {
    const int tid_ = otid(); const int lane = tid_ & 63, wid = tid_ >> 6;
    for (int row = bid * 8 + wid; row < NROW; row += nblk * 8) {
        const bool lat = row < NLAT;
        const float* src = lat ? p.x() + (size_t)row * D : p.ctx() + (size_t)(row - NLAT) * D;
        const int s = lat ? row / SEQ : 4;
        lnmod_row(src, p.modv() + (size_t)s * MODW, 0, D, p.RA() + (size_t)row * D, lane);
    }
}
__device__ __forceinline__ void ph_lnres(ldsp lds, const MP& p, int l, int nrows, int bid, int nblk) {
    const int tid_ = otid(); const int lane = tid_ & 63, wid = tid_ >> 6;
    const float* modl = p.modv() + (size_t)l * 5 * MODW;
    const float* lgp = p.ln1g() + l * D; const float* lbp = p.ln1b() + l * D; const float* wr = p.w_router() + (size_t)l * D * NE;
    LAS float* WT = (LAS float*)lds;
    for (int i = tid_; i < NE * D; i += 512) { const int e = i >> 10, col = i & 1023; WT[i] = wr[col * NE + e]; }
    __syncthreads();
    const bool b5 = lane & 32, b4 = lane & 16, b3 = lane & 8, b2 = lane & 4;
    const int stride = nblk * 8;
    const float* xlat = l == 0 ? p.x() : p.out(); const float* xctx = l == 0 ? p.ctx() : p.XCb();
    float4 lgv[4], lbv[4], gv[4], shv[4], scv[4];
#pragma unroll
    for (int i = 0; i < 4; ++i) { lgv[i] = *(const float4*)(lgp + i * 256 + lane * 4); lbv[i] = *(const float4*)(lbp + i * 256 + lane * 4); }
    int cur_s = -1;
    int row = bid * 8 + wid;
    float4 xn[4]; uint2 yn[4];
#define LR_LOAD(r) do { const float* xs_ = (r) < NLAT ? xlat + (size_t)(r) * D : xctx + (size_t)((r) - NLAT) * D; const T* yp_ = p.RA() + (size_t)(r) * D; \
        _Pragma("unroll") for (int i = 0; i < 4; ++i) { xn[i] = *(const float4*)(xs_ + i * 256 + lane * 4); yn[i] = *(const uint2*)(yp_ + i * 256 + lane * 4); } } while (0)
    if (row < nrows) LR_LOAD(row);
    for (; row < nrows; row += stride) {
        float4 xc[4]; uint2 yc[4];
#pragma unroll
        for (int i = 0; i < 4; ++i) { xc[i] = xn[i]; yc[i] = yn[i]; }
        if (row + stride < nrows) LR_LOAD(row + stride);
        const bool lat = row < NLAT;
        float* xo = lat ? p.out() + (size_t)row * D : p.XCa() + (size_t)(row - NLAT) * D;
        const int s = lat ? row / SEQ : 4;
        if (s != cur_s) { cur_s = s; const float* mv = modl + (size_t)s * MODW;
#pragma unroll
            for (int i = 0; i < 4; ++i) { gv[i] = *(const float4*)(mv + 2 * D + i * 256 + lane * 4); shv[i] = *(const float4*)(mv + 3 * D + i * 256 + lane * 4); scv[i] = *(const float4*)(mv + 4 * D + i * 256 + lane * 4); } }
        float v[16]; float sum = 0.f;
#pragma unroll
        for (int i = 0; i < 4; ++i) {
            const float y0 = __uint_as_float(yc[i].x << 16), y1 = __uint_as_float(yc[i].x & 0xffff0000u), y2 = __uint_as_float(yc[i].y << 16), y3 = __uint_as_float(yc[i].y & 0xffff0000u);
            v[i * 4 + 0] = ALPHA * xc[i].x + gv[i].x * y0; v[i * 4 + 1] = ALPHA * xc[i].y + gv[i].y * y1; v[i * 4 + 2] = ALPHA * xc[i].z + gv[i].z * y2; v[i * 4 + 3] = ALPHA * xc[i].w + gv[i].w * y3;
            sum += v[i * 4] + v[i * 4 + 1] + v[i * 4 + 2] + v[i * 4 + 3];
        }
        const float mean = wave_sum(sum) * (1.f / D);
        float sq = 0.f;
#pragma unroll
        for (int i = 0; i < 16; ++i) { const float d = v[i] - mean; sq += d * d; }
        const float rstd = 1.f / sqrtf(wave_sum(sq) * (1.f / D) + EPS);
        float s2 = 0.f;
#pragma unroll
        for (int i = 0; i < 4; ++i) {
            v[i * 4 + 0] = (v[i * 4 + 0] - mean) * rstd * lgv[i].x + lbv[i].x; v[i * 4 + 1] = (v[i * 4 + 1] - mean) * rstd * lgv[i].y + lbv[i].y;
            v[i * 4 + 2] = (v[i * 4 + 2] - mean) * rstd * lgv[i].z + lbv[i].z; v[i * 4 + 3] = (v[i * 4 + 3] - mean) * rstd * lgv[i].w + lbv[i].w;
            *(float4*)(xo + i * 256 + lane * 4) = make_float4(v[i * 4], v[i * 4 + 1], v[i * 4 + 2], v[i * 4 + 3]);
            s2 += v[i * 4] + v[i * 4 + 1] + v[i * 4 + 2] + v[i * 4 + 3];
        }
        const float mean2 = wave_sum(s2) * (1.f / D);
        float sq2 = 0.f;
#pragma unroll
        for (int i = 0; i < 16; ++i) { const float d = v[i] - mean2; sq2 += d * d; }
        const float rstd2 = 1.f / sqrtf(wave_sum(sq2) * (1.f / D) + EPS);
        float h2[16];
#pragma unroll
        for (int i = 0; i < 4; ++i) {
            h2[i * 4 + 0] = (v[i * 4 + 0] - mean2) * rstd2 * (1.f + scv[i].x) + shv[i].x; h2[i * 4 + 1] = (v[i * 4 + 1] - mean2) * rstd2 * (1.f + scv[i].y) + shv[i].y;
            h2[i * 4 + 2] = (v[i * 4 + 2] - mean2) * rstd2 * (1.f + scv[i].z) + shv[i].z; h2[i * 4 + 3] = (v[i * 4 + 3] - mean2) * rstd2 * (1.f + scv[i].w) + shv[i].w;
            st4(p.RC() + (size_t)row * D + i * 256 + lane * 4, make_float4(h2[i * 4], h2[i * 4 + 1], h2[i * 4 + 2], h2[i * 4 + 3]));
        }
        float lg[16];
#pragma unroll
        for (int e = 0; e < 16; ++e) {
            float a = 0.f;
#pragma unroll
            for (int i = 0; i < 4; ++i) { const f32x4 w = *(const LAS f32x4*)(WT + e * D + i * 256 + lane * 4); a += h2[i * 4] * w.x + h2[i * 4 + 1] * w.y + h2[i * 4 + 2] * w.z + h2[i * 4 + 3] * w.w; }
            lg[e] = a;
            if (e & 1) __builtin_amdgcn_sched_barrier(0);
        }
        float a8[8], a4[4], a2[2];
#pragma unroll
        for (int k = 0; k < 8; ++k) {
            auto rr = __builtin_amdgcn_permlane32_swap(__float_as_uint(lg[k]), __float_as_uint(lg[8 + k]), false, false);
            a8[k] = __uint_as_float(rr[0]) + __uint_as_float(rr[1]); }
#pragma unroll
        for (int k = 0; k < 4; ++k) { const float mine = b4 ? a8[4 + k] : a8[k], oth = b4 ? a8[k] : a8[4 + k]; a4[k] = mine + __shfl_xor(oth, 16); }
#pragma unroll
        for (int k = 0; k < 2; ++k) { const float mine = b3 ? a4[2 + k] : a4[k], oth = b3 ? a4[k] : a4[2 + k]; a2[k] = mine + __shfl_xor(oth, 8); }
        float lgt = (b2 ? a2[1] : a2[0]) + __shfl_xor(b2 ? a2[0] : a2[1], 4);
        lgt = DPP_ADD(lgt, 0xB1); lgt = DPP_ADD(lgt, 0x4E);
        float mx = lgt;
        mx = fmaxf(mx, __shfl_xor(mx, 4)); mx = fmaxf(mx, __shfl_xor(mx, 8)); mx = fmaxf(mx, __shfl_xor(mx, 16)); mx = fmaxf(mx, __shfl_xor(mx, 32));
        const float ex = expf(lgt - mx);
        float den = ex;
        den += __shfl_xor(den, 4); den += __shfl_xor(den, 8); den += __shfl_xor(den, 16); den += __shfl_xor(den, 32);
        if ((lane & 3) == 0) p.AFF()[(size_t)row * NE + (lane >> 2)] = ex / den;
    }
#undef LR_LOAD
    __syncthreads();
}
__device__ __forceinline__ void ph_topk(ldsp lds, const MP& p, int nkinds, int bid, int nblk) {
    LAS unsigned* keys = (LAS unsigned*)lds;
    LAS unsigned* hist = (LAS unsigned*)(lds + 32768);
    LAS unsigned* part = (LAS unsigned*)(lds + 32768 + 8192);
    LAS unsigned* shv = (LAS unsigned*)(lds + 32768 + 8192 + 1024);
    const int tid = otid(), lane = tid & 63, wv = tid >> 6;
    for (int u = bid; u < NE * NB * nkinds; u += nblk) {
        const int e = u % NE, bl = (u / NE) % NB, kind = u / (NE * NB);
        const int n = kind ? CTX : SEQ, kk = kind ? CAPC : CAP;
        const size_t row0 = kind ? (size_t)NLAT + (size_t)bl * CTX : (size_t)bl * SEQ;
        const size_t grp = kind ? (size_t)NB * NE * CAP + ((size_t)e * NB + bl) * CAPC : ((size_t)bl * NE + e) * CAP;
        for (int i = tid; i < n; i += 512) keys[i] = __float_as_uint(p.AFF()[(row0 + i) * NE + e]);
        __syncthreads();
        unsigned prefix = 0, rem = kk;
        for (int pass = 0; pass < 3; ++pass) {
            const int shift = pass == 0 ? 21 : pass == 1 ? 10 : 0;
            const int nbm = pass == 2 ? 1023 : 2047;
            const int hshift = pass == 1 ? 21 : 10;
            for (int i = tid; i < 2048; i += 512) hist[i] = 0;
            __syncthreads();
            for (int i = tid; i < n; i += 512) { const unsigned k = keys[i]; const bool match = (pass == 0) || ((k >> hshift) == prefix); if (match) atomicAdd((unsigned*)&hist[(k >> shift) & nbm], 1u); }
            __syncthreads();
            unsigned loc = 0;
            if (tid < 256) { for (int j = 0; j < 8; ++j) loc += hist[tid * 8 + j]; part[tid] = loc; }
            __syncthreads();
            if (tid < 256) {
                unsigned above = 0;
                for (int j = tid + 1; j < 256; ++j) above += part[j];
                if (above < rem && above + loc >= rem) {
                    unsigned cum = above; int bsel = tid * 8 + 7;
                    for (; bsel >= tid * 8; --bsel) { const unsigned hc = hist[bsel]; if (cum + hc >= rem) break; cum += hc; }
                    shv[0] = (unsigned)bsel; shv[1] = rem - cum;
                }
            }
            __syncthreads();
            prefix = (pass == 0) ? shv[0] : ((prefix << (pass == 1 ? 11 : 10)) | shv[0]);
            rem = shv[1];
            __syncthreads();
        }
        const unsigned Tkey = prefix;
        unsigned base_gt = 0, base_eq = 0;
        for (int c0 = 0; c0 < n; c0 += 512) {
            const int i = c0 + tid; const bool inr = i < n;
            const unsigned k = inr ? keys[i] : 0u;
            const bool gt = inr && k > Tkey, eq = inr && k == Tkey;
            const unsigned long long mg = __ballot(gt), me = __ballot(eq);
            const unsigned long long lt = (1ull << lane) - 1ull;
            if (lane == 0) { shv[8 + wv] = __popcll(mg); shv[16 + wv] = __popcll(me); }
            __syncthreads();
            unsigned pg = base_gt + __popcll(mg & lt), pe = base_eq + __popcll(me & lt), tg = 0, te = 0;
            for (int w = 0; w < 8; ++w) { const unsigned a = shv[8 + w], b = shv[16 + w]; if (w < wv) { pg += a; pe += b; } tg += a; te += b; }
            const bool sel = gt || (eq && pe < rem);
            const unsigned slot = pg + min(pe, rem);
            if (inr) { if (sel) { p.IDX()[grp + slot] = (int)(row0 + i); p.GATEV()[grp + slot] = __uint_as_float(k); }
                       p.INV()[(row0 + i) * NE + e] = sel ? (int)slot : -1; }
            base_gt += tg; base_eq += te;
            __syncthreads();
        }
    }
}
__device__ __forceinline__ void ph_combine(const MP& p, int l, int nrows, const T* OUT, int bid, int nblk) {
    const int tid_ = otid(); const int lane = tid_ & 63, wid = tid_ >> 6;
    const float* modl = p.modv() + (size_t)l * 5 * MODW;
    const float* lgp = p.ln2g() + l * D; const float* lbp = p.ln2b() + l * D;
    const bool next = l + 1 < NL;
    const int stride = nblk * 8;
    float4 lgv[4], lbv[4], gv[4];
#pragma unroll
    for (int i = 0; i < 4; ++i) { lgv[i] = *(const float4*)(lgp + i * 256 + lane * 4); lbv[i] = *(const float4*)(lbp + i * 256 + lane * 4); }
    int cur_s = -1;
    int row = bid * 8 + wid;
    int sl_next = -1; float4 xn[4];
#define CB_LOAD(r) do { const float* xs_ = (r) < NLAT ? p.out() + (size_t)(r) * D : p.XCa() + (size_t)((r) - NLAT) * D; \
        _Pragma("unroll") for (int i = 0; i < 4; ++i) xn[i] = *(const float4*)(xs_ + i * 256 + lane * 4); \
        sl_next = lane < NE ? p.INV()[(size_t)(r) * NE + lane] : -1; } while (0)
    if (row < nrows) CB_LOAD(row);
    for (; row < nrows; row += stride) {
        float4 xc[4];
#pragma unroll
        for (int i = 0; i < 4; ++i) xc[i] = xn[i];
        const int slv = sl_next;
        if (row + stride < nrows) CB_LOAD(row + stride);
        const bool lat = row < NLAT;
        float* xo = lat ? p.out() + (size_t)row * D : p.XCb() + (size_t)(row - NLAT) * D;
        const int bl = lat ? row / SEQ : (row - NLAT) / CTX;
        const int s = lat ? bl : 4;
        if (s != cur_s) { cur_s = s; const float* mv = modl + (size_t)s * MODW;
#pragma unroll
            for (int i = 0; i < 4; ++i) gv[i] = *(const float4*)(mv + 5 * D + i * 256 + lane * 4); }
        unsigned long long mask = __ballot(slv >= 0) & 0xffffull;
        uint2 ob[4][4]; bool ok[4];
#pragma unroll
        for (int j = 0; j < 4; ++j) {
            ok[j] = mask != 0ull;
            if (ok[j]) {
                const int e = __builtin_ctzll(mask); mask &= mask - 1;
                const int sl = __builtin_amdgcn_readlane(slv, e);
                const size_t orow = lat ? ((size_t)bl * NE + e) * CAP + sl : (size_t)NB * NE * CAP + ((size_t)e * NB + bl) * CAPC + sl;
                const T* op = OUT + orow * D;
#pragma unroll
                for (int i = 0; i < 4; ++i) ob[j][i] = *(const uint2*)(op + i * 256 + lane * 4);
            } else {
#pragma unroll
                for (int i = 0; i < 4; ++i) ob[j][i] = make_uint2(0u, 0u);
            }
        }
        float y[16];
#pragma unroll
        for (int i = 0; i < 16; ++i) y[i] = 0.f;
#pragma unroll
        for (int j = 0; j < 4; ++j)
#pragma unroll
            for (int i = 0; i < 4; ++i) { y[i * 4] += __uint_as_float(ob[j][i].x << 16); y[i * 4 + 1] += __uint_as_float(ob[j][i].x & 0xffff0000u); y[i * 4 + 2] += __uint_as_float(ob[j][i].y << 16); y[i * 4 + 3] += __uint_as_float(ob[j][i].y & 0xffff0000u); }
        while (mask) {
            const int e = __builtin_ctzll(mask); mask &= mask - 1;
            const int sl = __builtin_amdgcn_readlane(slv, e);
            const size_t orow = lat ? ((size_t)bl * NE + e) * CAP + sl : (size_t)NB * NE * CAP + ((size_t)e * NB + bl) * CAPC + sl;
            const T* op = OUT + orow * D;
#pragma unroll
            for (int i = 0; i < 4; ++i) { const float4 o4 = ld4(op + i * 256 + lane * 4); y[i * 4] += o4.x; y[i * 4 + 1] += o4.y; y[i * 4 + 2] += o4.z; y[i * 4 + 3] += o4.w; }
        }
        float v[16]; float sum = 0.f;
#pragma unroll
        for (int i = 0; i < 4; ++i) {
            v[i * 4 + 0] = ALPHA * xc[i].x + gv[i].x * y[i * 4 + 0]; v[i * 4 + 1] = ALPHA * xc[i].y + gv[i].y * y[i * 4 + 1]; v[i * 4 + 2] = ALPHA * xc[i].z + gv[i].z * y[i * 4 + 2]; v[i * 4 + 3] = ALPHA * xc[i].w + gv[i].w * y[i * 4 + 3];
            sum += v[i * 4] + v[i * 4 + 1] + v[i * 4 + 2] + v[i * 4 + 3];
        }
        const float mean = wave_sum(sum) * (1.f / D);
        float sq = 0.f;
#pragma unroll
        for (int i = 0; i < 16; ++i) { const float d = v[i] - mean; sq += d * d; }
        const float rstd = 1.f / sqrtf(wave_sum(sq) * (1.f / D) + EPS);
        float s2 = 0.f;
#pragma unroll
        for (int i = 0; i < 4; ++i) {
            v[i * 4 + 0] = (v[i * 4 + 0] - mean) * rstd * lgv[i].x + lbv[i].x; v[i * 4 + 1] = (v[i * 4 + 1] - mean) * rstd * lgv[i].y + lbv[i].y;
            v[i * 4 + 2] = (v[i * 4 + 2] - mean) * rstd * lgv[i].z + lbv[i].z; v[i * 4 + 3] = (v[i * 4 + 3] - mean) * rstd * lgv[i].w + lbv[i].w;
            { const float ps_ = (!next && p.pscale()) ? p.pscale()[0] : 1.f;
              *(float4*)(xo + i * 256 + lane * 4) = make_float4(v[i * 4] * ps_, v[i * 4 + 1] * ps_, v[i * 4 + 2] * ps_, v[i * 4 + 3] * ps_); }
            s2 += v[i * 4] + v[i * 4 + 1] + v[i * 4 + 2] + v[i * 4 + 3];
        }
        if (next) {
            const float* mvn = p.modv() + ((size_t)(l + 1) * 5 + s) * MODW;
            const float mean2 = wave_sum(s2) * (1.f / D);
            float sq2 = 0.f;
#pragma unroll
            for (int i = 0; i < 16; ++i) { const float d = v[i] - mean2; sq2 += d * d; }
            const float rstd2 = 1.f / sqrtf(wave_sum(sq2) * (1.f / D) + EPS);
#pragma unroll
            for (int i = 0; i < 4; ++i) {
                const int col = i * 256 + lane * 4;
                const float4 sh = *(const float4*)(mvn + col), sc = *(const float4*)(mvn + D + col);
                st4(p.RA() + (size_t)row * D + col, make_float4((v[i * 4 + 0] - mean2) * rstd2 * (1.f + sc.x) + sh.x, (v[i * 4 + 1] - mean2) * rstd2 * (1.f + sc.y) + sh.y,
                                                             (v[i * 4 + 2] - mean2) * rstd2 * (1.f + sc.z) + sh.z, (v[i * 4 + 3] - mean2) * rstd2 * (1.f + sc.w) + sh.w));
            }
        }
    }
#undef CB_LOAD
}


#define XB_TMO      128
#define XB_XCNT(j)  (256  + 64 * (j))
#define XB_XSUB(j)  (1280 + 64 * (j))
#define XB_XGEN(j)  (2304 + 64 * (j))
#define XB_TOP      3328
#define XB_TOPGEN   3392
#define XCD_BAR_WORDS 3456
#define XB_SPIN_CAP (1u << 18)
__device__ __forceinline__ unsigned xb_ld(unsigned* p)              { return __hip_atomic_load(p, __ATOMIC_RELAXED, __HIP_MEMORY_SCOPE_AGENT); }
__device__ __forceinline__ unsigned xb_add(unsigned* p, unsigned v) { return __hip_atomic_fetch_add(p, v, __ATOMIC_RELAXED, __HIP_MEMORY_SCOPE_AGENT); }
__device__ __forceinline__ unsigned xb_xcc_id() { return (unsigned)__builtin_amdgcn_s_getreg((3 << 11) | 20) & 0xFu; }
#define XB_SPIN(cond, bar) do { unsigned _sp = 0; while (cond) { __builtin_amdgcn_s_sleep(1); \
    if ((++_sp & 255u) == 0u) { if (xb_ld(&(bar)[XB_TMO])) break; if (_sp > XB_SPIN_CAP) { atomicAdd(&(bar)[XB_TMO], 1u); break; } } } } while (0)
struct XcdBarrier { unsigned* bar; unsigned x; volatile LAS unsigned* st; };
__device__ __forceinline__ XcdBarrier xcd_barrier_post(unsigned* bar, volatile LAS unsigned* st) {
    XcdBarrier b; b.bar = bar; b.x = xb_xcc_id(); b.st = st;
    if (threadIdx.x == 0) (void)xb_add(&bar[XB_XCNT(b.x)], 1u);
    return b;
}
__device__ __forceinline__ void xcd_barrier_complete(unsigned* bar, unsigned x, unsigned& nloc, unsigned& nx) {
    const unsigned G = gridDim.x * gridDim.y * gridDim.z;
    unsigned sum, cnt, mine, sp = 0u;
    for (;;) {
        sum = 0u; cnt = 0u; mine = 0u;
#pragma unroll
        for (unsigned j = 0; j < 16; ++j) { const unsigned c = xb_ld(&bar[XB_XCNT(j)]); sum += c; cnt += (c > 0u) ? 1u : 0u; mine = (j == x) ? c : mine; }
        if (sum == G) break;
        __builtin_amdgcn_s_sleep(1);
        if ((++sp & 255u) == 0u) { if (xb_ld(&bar[XB_TMO])) break; if (sp > XB_SPIN_CAP) { atomicAdd(&bar[XB_TMO], 1u); break; } }
    }
    nloc = mine > 0u ? mine : 1u; nx = cnt > 0u ? cnt : 1u;
}
__device__ __forceinline__ void xcd_barrier(const XcdBarrier& b) {
    asm volatile("s_waitcnt vmcnt(0)" ::: "memory");
    __syncthreads();
    if (threadIdx.x == 0) {
        unsigned* bar = b.bar;
        __builtin_amdgcn_s_waitcnt(0);
        unsigned nloc = b.st[0], nx = b.st[1];
        if (nloc == 0u) { xcd_barrier_complete(bar, b.x, nloc, nx); b.st[0] = nloc; b.st[1] = nx; }
        const unsigned old = xb_add(&bar[XB_XSUB(b.x)], 1u);
        const unsigned gen = old / nloc;
        if (old + 1u == (gen + 1u) * nloc) {
            __builtin_amdgcn_fence(__ATOMIC_RELEASE, "agent");
            asm volatile("s_waitcnt vmcnt(0)" ::: "memory");
            const unsigned og = xb_add(&bar[XB_TOP], 1u);
            const unsigned tg = og / nx;
            if (og + 1u == (tg + 1u) * nx) xb_add(&bar[XB_TOPGEN], 1u);
            else XB_SPIN(xb_ld(&bar[XB_TOPGEN]) == tg, bar);
            __builtin_amdgcn_fence(__ATOMIC_ACQUIRE, "agent");
            xb_add(&bar[XB_XGEN(b.x)], 1u);
            asm volatile("s_waitcnt vmcnt(0)" ::: "memory");
        } else {
            XB_SPIN(xb_ld(&bar[XB_XGEN(b.x)]) == gen, bar);
            __builtin_amdgcn_fence(__ATOMIC_ACQUIRE, "agent");
            asm volatile("s_waitcnt vmcnt(0)" ::: "memory");
        }
    }
    __syncthreads();
}

#ifdef PROBE_L0
__global__ void __launch_bounds__(256) k_cmp2(const float* a, const float* b, size_t n, float* acc, int slot) {
    float num = 0.f, den = 0.f;
    for (size_t i = (size_t)blockIdx.x * 256 + threadIdx.x; i < n; i += (size_t)gridDim.x * 256) { const float x = a[i], y = b[i]; num += (x - y) * (x - y); den += y * y; }
    __shared__ float sn[256], sd[256]; sn[threadIdx.x] = num; sd[threadIdx.x] = den; __syncthreads();
    for (int s = 128; s > 0; s >>= 1) { if (threadIdx.x < s) { sn[threadIdx.x] += sn[threadIdx.x + s]; sd[threadIdx.x] += sd[threadIdx.x + s]; } __syncthreads(); }
    if (threadIdx.x == 0) { atomicAdd(&acc[slot], sn[0]); atomicAdd(&acc[4 + slot], sd[0]); }
}
__global__ void k_fin2(const float* acc, float* scale, int which) { float e = acc[which] / acc[4 + which]; if (!(e == e)) e = 1.f; scale[0] = 1.f + sqrtf(e) * 100.f; }
#endif
constexpr int LDS_TOTAL = 159744 + 64 + 256;
static_assert(ATT_LDS <= 159744, "attention LDS");
constexpr size_t NSLOT = (size_t)NB * NE * (CAP + CAPC);
constexpr int NPHASE = 2 + 11 * NL;
__global__ void __launch_bounds__(512, 2) k_mega(MP p) {
    extern __shared__ __attribute__((aligned(16))) unsigned char dynlds[];
    const ldsp lds = (ldsp)dynlds;
    const int bid0 = blockIdx.x, nblk0 = gridDim.x;

    volatile LAS unsigned* xbw = (volatile LAS unsigned*)(lds + 159744);
    if (threadIdx.x == 0) { xbw[0] = 0u; xbw[1] = 0u; xbw[2] = 0u; xbw[3] = 0u; }
    __syncthreads();
    const XcdBarrier bar = xcd_barrier_post(p.bar(), xbw);
    int g = 0;
#ifndef REP_MASK
#define REP_MASK 0
#endif
#define PH(kind, ...) if (g >= p.ph_lo() && g < p.ph_hi()) { int bid = bid0, nblk = nblk0; asm volatile("" : "+s"(bid), "+s"(nblk));     \
    __VA_ARGS__ if (((REP_MASK >> (kind)) & 1) && ((kind) != 5 || g < 13)) { xcd_barrier(bar); __VA_ARGS__ } if (g + 1 < p.ph_hi()) xcd_barrier(bar); } ++g;
#define bH (p.RA())
#define bO (p.RA())
#define bY (p.RA())
#define bQM (p.RC())
#define bKVM (p.RC() + (size_t)NROW * 384)
#define bMERGED (p.RC())
#define bH2 (p.RC())
#define bACT (p.Z())
#define bOUT (p.Z() + NSLOT * FF)
#define bXG (p.Z() + NSLOT * FF)
#define bWguT (p.Z() + 2 * NSLOT * FF)
#define bWdT (p.Z() + 2 * NSLOT * FF + (size_t)NE * 2048 * 1024)
    if ((REP_MASK >> 14) & 1) { for (int i = 0; i < 20; ++i) xcd_barrier(bar); }
    PH(12,
        ph_mod(lds, p, bid, nblk);
        ph_ropetab(p, bid, nblk);
        { PrepJob j{}; j.src = p.w_in(); j.dst = p.WinT(); j.K = D; j.Nsrc = INW; j.Ndst = ZWP; j.mode = 1; j.perm = 1; j.nz = NL; j.src_zs = (long long)D * INW; j.dst_zs = (long long)ZWP * D; ph_wprep(lds, j, bid, nblk); }
        { PrepJob j{}; j.src = p.w_qb(); j.kscale = p.mqn(); j.dst = p.WqT(); j.K = 192; j.Nsrc = 384; j.Ndst = 384; j.mode = 0; j.nz = NL; j.src_zs = 192 * 384; j.dst_zs = 384 * 192; j.ks_zs = 192; ph_wprep(lds, j, bid, nblk); }
        { PrepJob j{}; j.src = p.w_kvb(); j.kscale = p.mkvn(); j.dst = p.WkvT(); j.K = 128; j.Nsrc = 512; j.Ndst = 512; j.mode = 0; j.nz = NL; j.src_zs = 128 * 512; j.dst_zs = 512 * 128; j.ks_zs = 128; ph_wprep(lds, j, bid, nblk); }
        { PrepJob j{}; j.src = p.w_branch(); j.dst = p.WbT(); j.K = 256; j.Nsrc = 1024; j.Ndst = 1024; j.mode = 0; j.nz = NL * 4; j.src_zs = 256 * 1024; j.dst_zs = 1024 * 256; ph_wprep(lds, j, bid, nblk); }
        { PrepJob j{}; j.src = p.w_out(); j.dst = p.WoutT(); j.K = 1024; j.Nsrc = 1024; j.Ndst = 1024; j.mode = 0; j.perm = 1; j.nz = NL; j.src_zs = 1024 * 1024; j.dst_zs = 1024 * 1024; ph_wprep(lds, j, bid, nblk); }
    )
    PH(13, ph_lnmod0(p, bid, nblk);)
    for (int l = 0; l < NL; ++l) {
        const bool need_ctx = l + 1 < NL; const int mrows = need_ctx ? NROW : NLAT;
        PH(0, { InProj8S sc{}; sc.H = bH; sc.Wt = p.WinT() + (size_t)l * ZWP * D; sc.npm = NROW / 256; sc.bid = bid; sc.nblk = nblk; sc.nun = need_ctx ? 3300 : 3200 + 36;
                InProj8E ep{}; ep.Z = p.Z(); ep.SS = p.SS(); ep.gqn = p.gqn() + l * 64; ep.gkn = p.gkn() + l * 64; ep.tab64 = p.tab64(); ep.tab32 = p.tab32();
                pg8::gemm_phase<InProj8E, InProj8S, true, true>(lds, D, sc, ep); } )
        PH(1, { MlaProj pb{}; pb.Z = p.Z(); pb.WqT = p.WqT() + (size_t)l * 384 * 192; pb.WkvT = p.WkvT() + (size_t)l * 512 * 128; pb.QM = bQM; pb.KVM = bKVM; pb.SS = p.SS(); pb.tab32 = p.tab32(); pb.nlat = NLAT; pb.npm = NROW / 256;
                   gemm_run<128, false>(lds, pb, bid, nblk); } )
        PH(2, { AttnP ap{}; ap.Z = p.Z(); ap.QM = bQM; ap.KVM = bKVM; ap.O = bO; ap.rpb = p.na_rpb() + (size_t)l * 4 * 15 * 31; ap.sink = p.swa_sink() + l * 4; ap.nlat = NLAT; ap.need_ctx = need_ctx ? 1 : 0; ap.o32 = (l == 0) ? p.o32() : nullptr; ap.fake = 0;
#ifdef PROBE_F
                   if (l == 0) { ap.fake = PROBE_F; attn_phase(lds, ap, bid, nblk); ap.fake = 0; ap.o32 = nullptr; }
#endif
                   attn_phase(lds, ap, bid, nblk); } )
        PH(3, { MergeProb pb{}; pb.O = bO; pb.WbT = p.WbT() + (size_t)l * 4 * 1024 * 256; pb.Z = p.Z(); pb.MERGED = bMERGED; pb.npm = mrows / 256; gemm_run<128, true>(lds, pb, bid, nblk); } )
        PH(4, { Plain8S sc{}; sc.A = bMERGED; sc.Bt = p.WoutT() + (size_t)l * D * D; sc.npm = mrows / 256; sc.npn = 4; sc.K = D; sc.bid = bid; sc.nblk = nblk; Plain8E ep{}; ep.C = bY; ep.ldc = D;
                pg8::gemm_phase<Plain8E, Plain8S, true, true>(lds, D, sc, ep); } )
        PH(5, ph_lnres(lds, p, l, mrows, bid, nblk); )
        PH(6,
            ph_topk(lds, p, need_ctx ? 2 : 1, bid, nblk);
            { PrepJob j{}; j.src = p.w_gate() + (size_t)l * NE * D * FF; j.src2 = p.w_up() + (size_t)l * NE * D * FF; j.dst = bWguT; j.K = 1024; j.Nsrc = 1024; j.Ndst = 2048; j.mode = 2; j.perm = 1; j.nz = NE; j.src_zs = (long long)D * FF; j.dst_zs = (long long)2048 * 1024; ph_wprep(lds, j, bid, nblk); }
            { PrepJob j{}; j.src = p.w_down() + (size_t)l * NE * FF * D; j.dst = bWdT; j.K = 1024; j.Nsrc = 1024; j.Ndst = 1024; j.mode = 0; j.perm = 1; j.nz = NE; j.src_zs = (long long)FF * D; j.dst_zs = (long long)1024 * 1024; ph_wprep(lds, j, bid, nblk); }
        )
        PH(10, ph_gather(bH2, p.IDX(), bXG, need_ctx ? (int)NSLOT : CTXB, bid, nblk); )
        PH(7, { FfnUp8S sc{}; sc.XG = bXG; sc.WguT = bWguT; sc.nun = 2048 + (need_ctx ? 128 : 0); sc.bid = bid; sc.nblk = nblk; FfnUp8E ep{}; ep.ACT = bACT;
                pg8::gemm_phase<FfnUp8E, FfnUp8S, true, true>(lds, D, sc, ep); } )
        PH(8, { FfnDown8S sc{}; sc.ACT = bACT; sc.WdT = bWdT; sc.nun = 1024 + (need_ctx ? 64 : 0); sc.bid = bid; sc.nblk = nblk; FfnDown8E ep{}; ep.GATEV = p.GATEV(); ep.OUT = bOUT;
                pg8::gemm_phase<FfnDown8E, FfnDown8S, true, true>(lds, FF, sc, ep); } )
        PH(9, ph_combine(p, l, mrows, bOUT, bid, nblk); )
    }
#undef PH
#undef bH
#undef bO
#undef bY
#undef bQM
#undef bKVM
#undef bMERGED
#undef bH2
#undef bACT
#undef bOUT
#undef bXG
#undef bWguT
#undef bWdT
}
}

extern "C" void kernel_launch(void* const* d_in, const int* in_sizes, int n_in, void* d_out, int out_size, void* d_ws, size_t ws_size, hipStream_t stream) {
    MP p; memset(&p, 0, sizeof(p));
    p.x_ = (const float*)d_in[0]; p.c_ = (const float*)d_in[1]; p.ctx_ = (const float*)d_in[2]; p.c_ctx_ = (const float*)d_in[3];
    p.w_mod_ = (const float*)d_in[4]; p.b_mod_ = (const float*)d_in[5]; p.w_in_ = (const float*)d_in[6]; p.na_rpb_ = (const float*)d_in[7];
    p.gqn_ = (const float*)d_in[8]; p.gkn_ = (const float*)d_in[9]; p.swa_sink_ = (const float*)d_in[10];
    p.mqn_ = (const float*)d_in[11]; p.mkvn_ = (const float*)d_in[12]; p.w_qb_ = (const float*)d_in[13]; p.w_kvb_ = (const float*)d_in[14];
    p.w_branch_ = (const float*)d_in[15]; p.w_out_ = (const float*)d_in[16];
    p.ln1g_ = (const float*)d_in[17]; p.ln1b_ = (const float*)d_in[18]; p.ln2g_ = (const float*)d_in[19]; p.ln2b_ = (const float*)d_in[20];
    p.w_router_ = (const float*)d_in[21]; p.w_gate_ = (const float*)d_in[22]; p.w_up_ = (const float*)d_in[23]; p.w_down_ = (const float*)d_in[24];
    p.out_ = (float*)d_out;
    char* ws = (char*)d_ws; size_t off = OFF_END;
    auto carve = [&](size_t bytes) { void* q = ws + off; off += (bytes + 255) & ~(size_t)255; return q; }; (void)carve;
    p.ws_ = ws;
    if (off > ws_size || 2 * NSLOT * FF + (size_t)NE * 3072 * 1024 > (size_t)NROW * ZW) { fprintf(stderr, "workspace too small: need %zu have %zu\n", off, ws_size); return; }
    static int grid = 0;
    if (!grid) {
        int dev = 0, cus = 0, per_cu = 0;
        (void)hipGetDevice(&dev);
        (void)hipDeviceGetAttribute(&cus, hipDeviceAttributeMultiprocessorCount, dev);
        (void)hipFuncSetAttribute((const void*)k_mega, hipFuncAttributeMaxDynamicSharedMemorySize, LDS_TOTAL);
        (void)hipOccupancyMaxActiveBlocksPerMultiprocessor(&per_cu, (const void*)k_mega, 512, LDS_TOTAL);
        grid = per_cu >= 1 ? cus : 0;
        if (grid > 256) grid = 256;
    }
    if (!grid) { fprintf(stderr, "k_mega cannot be resident\n"); return; }
    (void)hipMemsetAsync(ws + OFF_BAR, 0, XCD_BAR_WORDS * 4, stream);
#ifdef PROBE_L0
    {
        float* save_xc = (float*)carve((size_t)NCTX * D * 4); float* save_x = (float*)carve((size_t)2048 * D * 4); float* pacc = (float*)carve(256); float* pscl = (float*)carve(256);
        if (off > ws_size) { fprintf(stderr, "probe workspace\n"); return; }
        nv::nv_layer0(d_in, d_out, d_ws, ws_size, stream, save_xc, save_x);
        (void)hipMemsetAsync(ws + OFF_BAR, 0, XCD_BAR_WORDS * 4, stream);
        (void)hipMemsetAsync(pacc, 0, 256, stream);
        p.pscale_ = pscl;
        p.ph_lo_ = 0; p.ph_hi_ = 2 + (NPHASE - 2) / NL;
        hipLaunchKernelGGL(k_mega, dim3(grid), dim3(512), LDS_TOTAL, stream, p);
        hipLaunchKernelGGL(k_cmp2, dim3(256), dim3(256), 0, stream, (const float*)(ws + OFF_XCB), (const float*)save_xc, (size_t)NCTX * D, pacc, 0);
        for (int b = 0; b < NB; ++b) hipLaunchKernelGGL(k_cmp2, dim3(256), dim3(256), 0, stream, (const float*)d_out + (size_t)b * SEQ * D, (const float*)save_x + (size_t)b * 512 * D, (size_t)512 * D, pacc, 1);
        hipLaunchKernelGGL(k_fin2, dim3(1), dim3(1), 0, stream, pacc, pscl, (int)PROBE_L0);
        (void)hipMemsetAsync(ws + OFF_BAR, 0, XCD_BAR_WORDS * 4, stream);
        p.ph_lo_ = 2 + (NPHASE - 2) / NL; p.ph_hi_ = NPHASE;
        hipLaunchKernelGGL(k_mega, dim3(grid), dim3(512), LDS_TOTAL, stream, p);
    }
#elif defined(PROBE_ATTN)
    {
        float* O32 = (float*)carve((size_t)2304 * D * 4); float* O2 = (float*)carve((size_t)2304 * D * 4); float* pacc = (float*)carve(256); float* pscl = (float*)carve(256);
        if (off > ws_size) { fprintf(stderr, "probe workspace\n"); return; }
        p.o32_ = O32; p.pscale_ = pscl;
        (void)hipMemsetAsync(pacc, 0, 256, stream);
        p.ph_lo_ = 0; p.ph_hi_ = 5;
        hipLaunchKernelGGL(k_mega, dim3(grid), dim3(512), LDS_TOTAL, stream, p);
        AttnArgs a{}; a.Z = (const T*)(ws + OFF_Z); a.QM = (const T*)(ws + OFF_RC); a.KVM = (const T*)(ws + OFF_RC) + (size_t)NROW * 384; a.O2 = O2; a.rpb = p.na_rpb_; a.sink = p.swa_sink_; a.P.nbp = NB; a.P.b0 = 0; a.P.nlat = NLAT; a.P.nctx = NCTX; a.P.nrow = NROW; a.bl0 = 1;
        a.ctxq = 0; { dim3 g(8, 4, 1); hipLaunchKernelGGL(k_attn_naive<0>, g, dim3(256), 0, stream, a); hipLaunchKernelGGL(k_attn_naive<1>, g, dim3(256), 0, stream, a);
                      hipLaunchKernelGGL(k_attn_naive<2>, g, dim3(256), 0, stream, a); hipLaunchKernelGGL(k_attn_naive<3>, g, dim3(256), 0, stream, a); }
        a.ctxq = 1; { dim3 g(1, 4, 1); hipLaunchKernelGGL(k_attn_naive<0>, g, dim3(256), 0, stream, a); hipLaunchKernelGGL(k_attn_naive<1>, g, dim3(256), 0, stream, a);
                      hipLaunchKernelGGL(k_attn_naive<2>, g, dim3(256), 0, stream, a); hipLaunchKernelGGL(k_attn_naive<3>, g, dim3(256), 0, stream, a); }
        hipLaunchKernelGGL(k_probe_cmp, dim3(64, 4), dim3(256), 0, stream, O32, O2, pacc, 2304);
        hipLaunchKernelGGL(k_probe_fin, dim3(1), dim3(1), 0, stream, pacc, pscl, (int)PROBE_ATTN);
        (void)hipMemsetAsync(ws + OFF_BAR, 0, XCD_BAR_WORDS * 4, stream);
        p.ph_lo_ = 5; p.ph_hi_ = NPHASE;
        hipLaunchKernelGGL(k_mega, dim3(grid), dim3(512), LDS_TOTAL, stream, p);
    }
#elif defined(PROBE_T)
    {
        float* pscl = (float*)carve(256);
        if (off > ws_size) { fprintf(stderr, "probe workspace\n"); return; }
        p.o32_ = pscl; p.pscale_ = pscl;
        p.ph_lo_ = 0; p.ph_hi_ = NPHASE;
        hipLaunchKernelGGL(k_mega, dim3(grid), dim3(512), LDS_TOTAL, stream, p);
    }
#elif !defined(MK_SPLIT)
    p.ph_lo_ = 0; p.ph_hi_ = NPHASE;
    hipLaunchKernelGGL(k_mega, dim3(grid), dim3(512), LDS_TOTAL, stream, p);
#else
    for (int g = 0; g < NPHASE; ++g) { p.ph_lo_ = g; p.ph_hi_ = g + 1; hipLaunchKernelGGL(k_mega, dim3(grid), dim3(512), LDS_TOTAL, stream, p); }
#endif
}
```

```cpp
#include <hip/hip_runtime.h>
#include <hip/hip_bf16.h>
#include <stdint.h>
#include <stdio.h>
#include <string.h>

namespace {
constexpr int D = 1024, SEQ = 8192, CTX = 256, NB = 4, NL = 2, HD = 64;
constexpr int GW = 64, GROWS = 128;
constexpr int INW = 6240;
constexpr int ZW = 6240;
constexpr int NAQ = 0, NAK = 256, NAV = 512, GQ = 768, GK = 1024, GV = 1152, SQ = 1280, SK = 1536, SV = 1664,
              MCQ = 1792, MCKV = 1984, MKR = 2112, GATE = 2144;
constexpr int NE = 16, FF = 1024, CAP = 1024, CAPC = 32;
constexpr int MODW = 6 * D;
constexpr float EPS = 1e-6f;
constexpr float ALPHA = 1.4142135623730951f;
constexpr int NLAT = NB * SEQ, NCTX = NB * CTX, NROW = NLAT + NCTX;

struct T {
    unsigned short u;
    __device__ __forceinline__ operator float() const { return __uint_as_float((unsigned)u << 16); }
    __device__ __forceinline__ T& operator=(float f) { unsigned b = __float_as_uint(f); b += 0x7fffu + ((b >> 16) & 1u); u = (unsigned short)(b >> 16); return *this; }
};
__device__ __forceinline__ float4 ld4(const float* p) { return *(const float4*)p; }
__device__ __forceinline__ float4 ld4(const T* p) { uint2 r = *(const uint2*)p; return make_float4(__uint_as_float(r.x << 16), __uint_as_float(r.x & 0xffff0000u), __uint_as_float(r.y << 16), __uint_as_float(r.y & 0xffff0000u)); }
__device__ __forceinline__ unsigned pk2(float lo, float hi) { T a, b; a = lo; b = hi; return (unsigned)a.u | ((unsigned)b.u << 16); }
__device__ __forceinline__ void st4(float* p, float4 v) { *(float4*)p = v; }
__device__ __forceinline__ void st4(T* p, float4 v) { *(uint2*)p = make_uint2(pk2(v.x, v.y), pk2(v.z, v.w)); }

__device__ __forceinline__ int otid() { int t = threadIdx.x; asm volatile("" : "+v"(t)); return t; }
__device__ __forceinline__ int xswz(int u, int n) { const int c = u & 7, s = u >> 3, q = n >> 3, rr = n & 7; return (c < rr ? c * (q + 1) : rr * (q + 1) + (c - rr) * q) + s; }
#define DPP_ADD(v, ctrl) ((v) + __builtin_bit_cast(float, __builtin_amdgcn_update_dpp(0, __builtin_bit_cast(int, (v)), (ctrl), 0xf, 0xf, true)))
__device__ __forceinline__ float wave_sum(float v) {
    v = DPP_ADD(v, 0xB1);
    v = DPP_ADD(v, 0x4E);
    v = DPP_ADD(v, 0x141);
    v = DPP_ADD(v, 0x140);
    const int iv = __builtin_bit_cast(int, v);
    const float r0 = __builtin_bit_cast(float, __builtin_amdgcn_readlane(iv, 0)), r1 = __builtin_bit_cast(float, __builtin_amdgcn_readlane(iv, 16)),
                r2 = __builtin_bit_cast(float, __builtin_amdgcn_readlane(iv, 32)), r3 = __builtin_bit_cast(float, __builtin_amdgcn_readlane(iv, 48));
    return (r0 + r1) + (r2 + r3);
}

typedef short bf16x8 __attribute__((ext_vector_type(8)));
typedef float f32x4 __attribute__((ext_vector_type(4)));
#define LAS __attribute__((address_space(3)))
typedef LAS unsigned char* ldsp;
constexpr int ZWP = 6400;

__device__ __forceinline__ float fast_rsqrt(float x) { return __builtin_amdgcn_rsqf(x); }
__device__ __forceinline__ float fast_sigmoid(float x) { return __builtin_amdgcn_rcpf(1.f + __builtin_amdgcn_exp2f(-1.4426950408889634f * x)); }
__device__ __forceinline__ float fast_silu(float x) { return x * fast_sigmoid(x); }
__device__ __forceinline__ uint2 pk4(float a, float b, float c, float d) { return make_uint2(pk2(a, b), pk2(c, d)); }

#define GLDS16(gp, lp) __builtin_amdgcn_global_load_lds((const unsigned*)(gp), (LAS unsigned*)(lp), 16, 0, 0)
template <int BN, bool HAS_SUM, class Prob>
__device__ __forceinline__ void gemm_run(ldsp lds, const Prob& pb, int bid, int nblk) {
    constexpr int NF = BN / 64, GLB = BN / 64, A_BYTES = 32768, B_BYTES = BN * 128, STAGE = A_BYTES + B_BYTES, NSTG = (BN == 128) ? 3 : 2, NGL = 4 + GLB;
    const int tid = otid(), wid = __builtin_amdgcn_readfirstlane(tid >> 6), lane = tid & 63, wr = wid >> 2, wc = wid & 3, fr = lane & 15, fq = lane >> 4;
    const int NU = pb.nunits();
    if (bid >= NU) return;
    const int sb = lane * 16, swz = sb ^ (((sb >> 9) & 1) << 5);
    const int sR0 = (wid >> 1) * 16 + (swz >> 6), sC = (wid & 1) * 32 + ((swz & 63) >> 1);
    const int ob = fr * 64 + fq * 16, lane_off = ob ^ (((ob >> 9) & 1) << 5);
    const unsigned ldsw = (unsigned)wid * 1024u;
    unsigned aoff[4], boff[GLB];
    int su = bid, st = 0, snt = pb.ntiles(su), sbuf = 0, inflight = 0;
#define G_LOAD_OFFS() do { _Pragma("unroll") for (int i = 0; i < 4; ++i) aoff[i] = pb.a_off(su, sR0 + 64 * i) + sC; \
                           _Pragma("unroll") for (int i = 0; i < GLB; ++i) boff[i] = pb.b_off(su, sR0 + 64 * i) + sC; } while (0)
#define G_STAGE() do { if (su < NU) { const T* Ab = pb.a_base(su, st); const T* Bb = pb.b_base(su, st); ldsp sbase = lds + sbuf * STAGE + ldsw; \
        _Pragma("unroll") for (int i = 0; i < 4; ++i) GLDS16(Ab + aoff[i], sbase + i * 8192); \
        _Pragma("unroll") for (int i = 0; i < GLB; ++i) GLDS16(Bb + boff[i], sbase + A_BYTES + i * 8192); \
        ++inflight; sbuf = (sbuf + 1 == NSTG) ? 0 : sbuf + 1; \
        if (++st == snt) { su += nblk; st = 0; if (su < NU) { snt = pb.ntiles(su); G_LOAD_OFFS(); } } } } while (0)
    G_LOAD_OFFS();
    G_STAGE();
    if (NSTG == 3) G_STAGE();
    int buf = 0;
    for (int cu = bid; cu < NU; cu += nblk) {
        f32x4 acc[8][NF]; f32x4 sum[HAS_SUM ? 8 : 1][HAS_SUM ? NF : 1]; uint2 gpre[HAS_SUM ? 8 : 1][HAS_SUM ? NF : 1];
#pragma unroll
        for (int m = 0; m < 8; ++m)
#pragma unroll
            for (int n = 0; n < NF; ++n) { acc[m][n] = (f32x4){0.f, 0.f, 0.f, 0.f}; if (HAS_SUM) sum[m][n] = (f32x4){0.f, 0.f, 0.f, 0.f}; }
        const int nt = pb.ntiles(cu);
        for (int t = 0; t < nt; ++t) {
            if (NSTG == 3) {
                if constexpr (HAS_SUM) { if (inflight >= 2) { if (pb.extra_inflight(t)) asm volatile("s_waitcnt vmcnt(%0)" :: "n"(NGL + 16) : "memory"); else asm volatile("s_waitcnt vmcnt(%0)" :: "n"(NGL) : "memory"); }
                                         else asm volatile("s_waitcnt vmcnt(0)" ::: "memory"); }
                else { if (inflight >= 2) asm volatile("s_waitcnt vmcnt(%0)" :: "n"(NGL) : "memory"); else asm volatile("s_waitcnt vmcnt(0)" ::: "memory"); }
                asm volatile("s_waitcnt lgkmcnt(0)\n\ts_barrier" ::: "memory");
            } else {
                asm volatile("s_waitcnt vmcnt(0)" ::: "memory");
                __syncthreads();
            }
            if constexpr (!(NF == 2 && HAS_SUM)) G_STAGE();
            if constexpr (HAS_SUM) pb.tile_begin(cu, t, gpre, wr, wc, fr, fq);
            const ldsp ta = lds + buf * STAGE + wr * 16384 + lane_off, tb = lds + buf * STAGE + A_BYTES + wc * (NF * 2048) + lane_off;
            if constexpr (NF == 2 && HAS_SUM) {
                const unsigned ta_ = (unsigned)(size_t)ta, tb_ = (unsigned)(size_t)tb;
                bf16x8 a0, a1, a2, a3, a4, a5, a6, a7, b0, b1;
#define G_RD(dst, addr, OFF) asm volatile("ds_read_b128 %0, %1 offset:" #OFF : "=v"(dst) : "v"(addr))
#define G_MM(m, av) do { acc[m][0] = __builtin_amdgcn_mfma_f32_16x16x32_bf16(b0, av, acc[m][0], 0, 0, 0); acc[m][1] = __builtin_amdgcn_mfma_f32_16x16x32_bf16(b1, av, acc[m][1], 0, 0, 0); } while (0)
                const bool g_on = su < NU; const T* gAb = pb.a_base(g_on ? su : cu, st); const T* gBb = pb.b_base(g_on ? su : cu, st); const ldsp gsb = lds + sbuf * STAGE + ldsw;
                G_RD(a0, ta_, 0); G_RD(a1, ta_, 2048); G_RD(a2, ta_, 4096); G_RD(a3, ta_, 6144); G_RD(b0, tb_, 0); G_RD(b1, tb_, 2048);
                if (g_on) { GLDS16(gAb + aoff[0], gsb); GLDS16(gAb + aoff[1], gsb + 8192); }
                asm volatile("s_waitcnt lgkmcnt(0)" : "+v"(a0), "+v"(a1), "+v"(a2), "+v"(a3), "+v"(b0), "+v"(b1));
                __builtin_amdgcn_sched_barrier(0);
                G_RD(a4, ta_, 8192); G_RD(a5, ta_, 10240); G_RD(a6, ta_, 12288); G_RD(a7, ta_, 14336);
                G_MM(0, a0); G_MM(1, a1); G_MM(2, a2); G_MM(3, a3);
                __builtin_amdgcn_sched_barrier(0);
                if (g_on) { GLDS16(gAb + aoff[2], gsb + 2 * 8192); GLDS16(gAb + aoff[3], gsb + 3 * 8192); }
                asm volatile("s_waitcnt lgkmcnt(0)" : "+v"(a4), "+v"(a5), "+v"(a6), "+v"(a7));
                __builtin_amdgcn_sched_barrier(0);
                bf16x8 c0, c1, c2, c3, d0, d1;
                G_RD(c0, ta_, 1024); G_RD(c1, ta_, 3072); G_RD(c2, ta_, 5120); G_RD(c3, ta_, 7168); G_RD(d0, tb_, 1024); G_RD(d1, tb_, 3072);
                G_MM(4, a4); G_MM(5, a5); G_MM(6, a6); G_MM(7, a7);
                __builtin_amdgcn_sched_barrier(0);
                if (g_on) { GLDS16(gBb + boff[0], gsb + A_BYTES); GLDS16(gBb + boff[1], gsb + A_BYTES + 8192);
                            ++inflight; sbuf = (sbuf + 1 == NSTG) ? 0 : sbuf + 1;
                            if (++st == snt) { su += nblk; st = 0; if (su < NU) { snt = pb.ntiles(su); G_LOAD_OFFS(); } } }
                asm volatile("s_waitcnt lgkmcnt(0)" : "+v"(c0), "+v"(c1), "+v"(c2), "+v"(c3), "+v"(d0), "+v"(d1));
                __builtin_amdgcn_sched_barrier(0);
                b0 = d0; b1 = d1;
                G_RD(a4, ta_, 9216); G_RD(a5, ta_, 11264); G_RD(a6, ta_, 13312); G_RD(a7, ta_, 15360);
                G_MM(0, c0); G_MM(1, c1); G_MM(2, c2); G_MM(3, c3);
                __builtin_amdgcn_sched_barrier(0);
                asm volatile("s_waitcnt lgkmcnt(0)" : "+v"(a4), "+v"(a5), "+v"(a6), "+v"(a7));
                __builtin_amdgcn_sched_barrier(0);
                G_MM(4, a4); G_MM(5, a5); G_MM(6, a6); G_MM(7, a7);
                __builtin_amdgcn_sched_barrier(0);
#undef G_RD
#undef G_MM
            } else {
#pragma unroll
            for (int ks = 0; ks < 2; ++ks) {
                bf16x8 At[8], Bf[NF];
#pragma unroll
                for (int m = 0; m < 8; ++m) At[m] = *(const LAS bf16x8*)(ta + m * 2048 + ks * 1024);
#pragma unroll
                for (int n = 0; n < NF; ++n) Bf[n] = *(const LAS bf16x8*)(tb + n * 2048 + ks * 1024);
#pragma unroll
                for (int m = 0; m < 8; ++m)
#pragma unroll
                    for (int n = 0; n < NF; ++n) acc[m][n] = __builtin_amdgcn_mfma_f32_16x16x32_bf16(Bf[n], At[m], acc[m][n], 0, 0, 0);
            }
            }
            if constexpr (HAS_SUM) pb.tile_done(cu, t, acc, sum, gpre, wr, wc, fr, fq);
            --inflight; buf = (buf + 1 == NSTG) ? 0 : buf + 1;
        }
        if constexpr (HAS_SUM) pb.epilogue(cu, sum, wr, wc, fr, fq); else pb.epilogue(cu, acc, wr, wc, fr, fq);
    }
    asm volatile("s_waitcnt vmcnt(0) lgkmcnt(0)\n\ts_barrier" ::: "memory");
#undef G_LOAD_OFFS
#undef G_STAGE
}

struct InProj {
    const T* H; const T* Wt; T* Z; float* SS; const float* gqn; const float* gkn; const float2* tab64; const float2* tab32; int nlat, npm;
    __device__ __forceinline__ int nunits() const { return npm * 25; }
    __device__ __forceinline__ int ntiles(int) const { return 16; }
    __device__ __forceinline__ unsigned a_off(int u, int R) const { return (unsigned)((u / 25) * 256 + R) * 1024u; }
    __device__ __forceinline__ unsigned b_off(int u, int R) const { return (unsigned)((u % 25) * 256 + R) * 1024u; }
    __device__ __forceinline__ const T* a_base(int, int t) const { return H + t * 64; }
    __device__ __forceinline__ const T* b_base(int, int t) const { return Wt + t * 64; }
    __device__ __forceinline__ void epilogue(int u, f32x4 (&acc)[8][4], int wr, int wc, int fr, int fq) const {
        const int pm = u / 25, pn = u % 25, cg = pn * 4 + wc;
        if (cg == 34 || cg == 35) return;
        const int row0 = pm * 256 + wr * 128 + fr;
        const bool lat = pm * 256 < nlat;
        const int zcol = (cg < 36 ? cg * 64 : 2144 + (cg - 36) * 64) + fq * 4;
        const bool t_rms = (cg >= 12 && cg < 18), t_rope = t_rms || (cg >= 20 && cg < 26), t_ssq = (cg >= 28 && cg < 33), t_kr = cg == 33, t_sig = cg >= 36;
        float4 gv[4];
        if (t_rms) { const float* g = cg < 16 ? gqn : gkn;
#pragma unroll
            for (int n = 0; n < 4; ++n) gv[n] = *(const float4*)(g + n * 16 + fq * 4); }
#pragma unroll
        for (int m = 0; m < 8; ++m) {
            const int row = row0 + m * 16;
            const int t = row & (SEQ - 1), gr = t >> 6, gc = t & 63;
            float v[4][4];
#pragma unroll
            for (int n = 0; n < 4; ++n)
#pragma unroll
                for (int j = 0; j < 4; ++j) v[n][j] = acc[m][n][j];
            T* zp = Z + (size_t)row * ZW + zcol;
            if (t_rms || t_ssq) {
                float ss = 0.f;
#pragma unroll
                for (int n = 0; n < 4; ++n)
#pragma unroll
                    for (int j = 0; j < 4; ++j) ss += v[n][j] * v[n][j];
                ss += __shfl_xor(ss, 16); ss += __shfl_xor(ss, 32);
                if (t_ssq) { if (fq == 0) SS[(size_t)row * 8 + (cg - 28)] = ss; }
                else { const float rstd = 1.f / sqrtf(ss * (1.f / 64.f) + EPS);
#pragma unroll
                    for (int n = 0; n < 4; ++n) { v[n][0] *= rstd * gv[n].x; v[n][1] *= rstd * gv[n].y; v[n][2] *= rstd * gv[n].z; v[n][3] *= rstd * gv[n].w; } }
            }
            if (t_rope && lat) {
                const float4* tr = (const float4*)(tab64 + gr * 16 + fq * 4); const float4* tc = (const float4*)(tab64 + gc * 16 + fq * 4);
                const float4 r0 = tr[0], r1 = tr[1], c0 = tc[0], c1 = tc[1];
                const float rc[4] = {r0.x, r0.z, r1.x, r1.z}, rs[4] = {r0.y, r0.w, r1.y, r1.w}, cc[4] = {c0.x, c0.z, c1.x, c1.z}, cs[4] = {c0.y, c0.w, c1.y, c1.w};
#pragma unroll
                for (int j = 0; j < 4; ++j) {
                    const float a0 = v[0][j], a1 = v[1][j], b0 = v[2][j], b1 = v[3][j];
                    v[0][j] = a0 * rc[j] - a1 * rs[j]; v[1][j] = a0 * rs[j] + a1 * rc[j];
                    v[2][j] = b0 * cc[j] - b1 * cs[j]; v[3][j] = b0 * cs[j] + b1 * cc[j];
                }
            }
            if (t_kr) {
#pragma unroll
                for (int n = 0; n < 2; ++n) {
                    const float4* tp = (const float4*)(tab32 + (n == 0 ? gr : gc) * 8 + (fq & 1) * 4);
                    const float4 q0 = tp[0], q1 = tp[1];
                    const float kc[4] = {q0.x, q0.z, q1.x, q1.z}, ks[4] = {q0.y, q0.w, q1.y, q1.w};
#pragma unroll
                    for (int j = 0; j < 4; ++j) { const float x = v[n][j], px = __shfl_xor(x, 32); if (lat) v[n][j] = (fq < 2) ? (x * kc[j] - px * ks[j]) : (px * ks[j] + x * kc[j]); }
                    *(uint2*)(zp + n * 16) = pk4(v[n][0], v[n][1], v[n][2], v[n][3]);
                }
                continue;
            }
            if (t_sig) {
#pragma unroll
                for (int n = 0; n < 4; ++n)
#pragma unroll
                    for (int j = 0; j < 4; ++j) v[n][j] = fast_sigmoid(v[n][j]);
            }
#pragma unroll
            for (int n = 0; n < 4; ++n) *(uint2*)(zp + n * 16) = pk4(v[n][0], v[n][1], v[n][2], v[n][3]);
        }
    }
};

struct MlaProj {
    const T* Z; const T* WqT; const T* WkvT; T* QM; T* KVM; const float* SS; const float2* tab32; int nlat, npm;
    __device__ __forceinline__ int nunits() const { return npm * 7; }
    __device__ __forceinline__ int ntiles(int u) const { return u < npm * 3 ? 3 : 2; }
    __device__ __forceinline__ unsigned a_off(int u, int R) const { const int pm = u < npm * 3 ? u / 3 : (u - npm * 3) / 4; return (unsigned)(pm * 256 + R) * (unsigned)ZW; }
    __device__ __forceinline__ unsigned b_off(int u, int R) const { return u < npm * 3 ? (unsigned)((u % 3) * 128 + R) * 192u : (unsigned)(((u - npm * 3) % 4) * 128 + R) * 128u; }
    __device__ __forceinline__ const T* a_base(int u, int t) const { return Z + (u < npm * 3 ? MCQ : MCKV) + t * 64; }
    __device__ __forceinline__ const T* b_base(int u, int t) const { return (u < npm * 3 ? WqT : WkvT) + t * 64; }
    __device__ __forceinline__ void epilogue(int u, f32x4 (&acc)[8][2], int wr, int wc, int fr, int fq) const {
        const bool isq = u < npm * 3;
        const int pm = isq ? u / 3 : (u - npm * 3) / 4, pn = isq ? u % 3 : (u - npm * 3) % 4;
        const int row0 = pm * 256 + wr * 128 + fr;
        const bool lat = pm * 256 < nlat;
#pragma unroll
        for (int m = 0; m < 8; ++m) {
            const int row = row0 + m * 16;
            const float* ss = SS + (size_t)row * 8;
            const float rstd = isq ? 1.f / sqrtf((ss[0] + ss[1] + ss[2]) * (1.f / 192.f) + EPS) : 1.f / sqrtf((ss[3] + ss[4]) * (1.f / 128.f) + EPS);
            const int t = row & (SEQ - 1), gr = t >> 6, gc = t & 63;
#pragma unroll
            for (int n = 0; n < 2; ++n) {
                float v[4];
#pragma unroll
                for (int j = 0; j < 4; ++j) v[j] = acc[m][n][j] * rstd;
                const int f = pn * 8 + wc * 2 + n;
                if (isq) {
                    const int part = f % 6;
                    if (part >= 4) {
                        const float4* tp = (const float4*)(tab32 + (part == 4 ? gr : gc) * 8 + (fq & 1) * 4);
                        const float4 q0 = tp[0], q1 = tp[1];
                        const float kc[4] = {q0.x, q0.z, q1.x, q1.z}, ks[4] = {q0.y, q0.w, q1.y, q1.w};
#pragma unroll
                        for (int j = 0; j < 4; ++j) { const float x = v[j], px = __shfl_xor(x, 32); if (lat) v[j] = (fq < 2) ? (x * kc[j] - px * ks[j]) : (px * ks[j] + x * kc[j]); }
                    }
                    *(uint2*)(QM + (size_t)row * 384 + f * 16 + fq * 4) = pk4(v[0], v[1], v[2], v[3]);
                } else {
                    *(uint2*)(KVM + (size_t)row * 512 + f * 16 + fq * 4) = pk4(v[0], v[1], v[2], v[3]);
                }
            }
        }
    }
};

struct MergeProb {
    const T* O; const T* WbT; const T* Z; T* MERGED; int npm;
    __device__ __forceinline__ int nunits() const { return npm * 8; }
    __device__ __forceinline__ int ntiles(int) const { return 16; }
    __device__ __forceinline__ unsigned a_off(int u0, int R) const { const int u = xswz(u0, npm * 8); return (unsigned)((u >> 3) * 256 + R) * 1024u; }
    __device__ __forceinline__ unsigned b_off(int u0, int R) const { const int u = xswz(u0, npm * 8); return (unsigned)((u & 7) * 128 + R) * 256u; }
    __device__ __forceinline__ const T* a_base(int, int t) const { return O + (t >> 2) * 256 + (t & 3) * 64; }
    __device__ __forceinline__ const T* b_base(int, int t) const { return WbT + (size_t)(t >> 2) * 1024 * 256 + (t & 3) * 64; }
    __device__ __forceinline__ void tile_begin(int u0, int t, uint2 (&gpre)[8][2], int wr, int wc, int fr, int fq) const {
        if ((t & 3) != 0) return;
        const int u = xswz(u0, npm * 8); const int i = t >> 2, pm = u >> 3, pn = u & 7;
        const T* gp = Z + (size_t)(pm * 256 + wr * 128 + fr) * ZW + GATE + i * 1024 + pn * 128 + wc * 32 + fq * 4;
#pragma unroll
        for (int m = 0; m < 8; ++m)
#pragma unroll
            for (int n = 0; n < 2; ++n) { const T* q_ = gp + (size_t)m * 16 * ZW + n * 16; asm volatile("global_load_dwordx2 %0, %1, off" : "=v"(gpre[m][n]) : "v"(q_)); }
    }
    __device__ __forceinline__ int extra_inflight(int t) const { return ((t & 3) == 1) ? 16 : 0; }
    __device__ __forceinline__ void tile_done(int u, int t, f32x4 (&acc)[8][2], f32x4 (&sum)[8][2], uint2 (&gpre)[8][2], int wr, int wc, int fr, int fq) const {
        if ((t & 3) != 3) return;
#pragma unroll
        for (int m = 0; m < 8; ++m)
#pragma unroll
            for (int n = 0; n < 2; ++n) {
                const uint2 r = gpre[m][n];
                { float s0 = __builtin_fmaf(__uint_as_float(r.x << 16), acc[m][n][0], sum[m][n][0]); asm volatile("" : "+v"(s0));
                  float s1 = __builtin_fmaf(__uint_as_float(r.x & 0xffff0000u), acc[m][n][1], sum[m][n][1]); asm volatile("" : "+v"(s1));
                  float s2 = __builtin_fmaf(__uint_as_float(r.y << 16), acc[m][n][2], sum[m][n][2]); asm volatile("" : "+v"(s2));
                  float s3 = __builtin_fmaf(__uint_as_float(r.y & 0xffff0000u), acc[m][n][3], sum[m][n][3]); asm volatile("" : "+v"(s3));
                  sum[m][n] = (f32x4){s0, s1, s2, s3}; }
                acc[m][n] = (f32x4){0.f, 0.f, 0.f, 0.f};
            }
    }
    __device__ __forceinline__ void epilogue(int u0, f32x4 (&sum)[8][2], int wr, int wc, int fr, int fq) const {
        const int u = xswz(u0, npm * 8); const int pm = u >> 3, pn = u & 7;
        T* op = MERGED + (size_t)(pm * 256 + wr * 128 + fr) * 1024 + pn * 128 + wc * 32 + fq * 4;
#pragma unroll
        for (int m = 0; m < 8; ++m)
#pragma unroll
            for (int n = 0; n < 2; ++n) *(uint2*)(op + (size_t)m * 16 * 1024 + n * 16) = pk4(sum[m][n][0], sum[m][n][1], sum[m][n][2], sum[m][n][3]);
    }
};

struct PlainProb {
    const T* A; const T* Bt; T* C; int npm, npn, K, lda, ldc;
    __device__ __forceinline__ int nunits() const { return npm * npn; }
    __device__ __forceinline__ int ntiles(int) const { return K / 64; }
    __device__ __forceinline__ unsigned a_off(int u0, int R) const { const int u = xswz(u0, npm * npn); return (unsigned)((u / npn) * 256 + R) * (unsigned)lda; }
    __device__ __forceinline__ unsigned b_off(int u0, int R) const { const int u = xswz(u0, npm * npn); return (unsigned)((u % npn) * 128 + R) * (unsigned)K; }
    __device__ __forceinline__ const T* a_base(int, int t) const { return A + t * 64; }
    __device__ __forceinline__ const T* b_base(int, int t) const { return Bt + t * 64; }
    __device__ __forceinline__ void epilogue(int u0, f32x4 (&acc)[8][2], int wr, int wc, int fr, int fq) const {
        const int u = xswz(u0, npm * npn); const int pm = u / npn, pn = u % npn;
        T* op = C + (size_t)(pm * 256 + wr * 128 + fr) * ldc + pn * 128 + wc * 32 + fq * 4;
#pragma unroll
        for (int m = 0; m < 8; ++m)
#pragma unroll
            for (int n = 0; n < 2; ++n) *(uint2*)(op + (size_t)m * 16 * ldc + n * 16) = pk4(acc[m][n][0], acc[m][n][1], acc[m][n][2], acc[m][n][3]);
    }
};

constexpr int CTXB = NB * NE * CAP;
struct FfnUp {
    const T* H2; const T* WguT; const int* IDX; T* ACT; int nun;
    __device__ __forceinline__ int nunits() const { return nun; }
    __device__ __forceinline__ int ntiles(int) const { return 16; }
    __device__ __forceinline__ void decode(int u, int& e, int& pn, int& sbase, bool& isctx) const {
        if (u < 2048) { e = u >> 7; const int rem = u & 127; pn = rem & 7; sbase = ((rem >> 5) * NE + e) * CAP + ((rem >> 3) & 3) * 256; isctx = false; }
        else { const int uc = u - 2048; e = uc >> 3; pn = uc & 7; sbase = CTXB + e * CAPC; isctx = true; }
    }
    __device__ __forceinline__ int slot_of(int sbase, bool isctx, int R) const { return isctx ? (R < 128 ? sbase + (R >> 5) * (NE * CAPC) + (R & 31) : -1) : sbase + R; }
    __device__ __forceinline__ unsigned a_off(int u, int R) const { int e, pn, sb; bool ic; decode(u, e, pn, sb, ic); const int s = slot_of(sb, ic, R); return s < 0 ? 0u : (unsigned)IDX[s] * 1024u; }
    __device__ __forceinline__ unsigned b_off(int u, int R) const { int e, pn, sb; bool ic; decode(u, e, pn, sb, ic); return (unsigned)(e * 2048 + pn * 256 + R) * 1024u; }
    __device__ __forceinline__ const T* a_base(int, int t) const { return H2 + t * 64; }
    __device__ __forceinline__ const T* b_base(int, int t) const { return WguT + t * 64; }
    __device__ __forceinline__ void epilogue(int u, f32x4 (&acc)[8][4], int wr, int wc, int fr, int fq) const {
        int e, pn, sb; bool ic; decode(u, e, pn, sb, ic);
        const int col = (pn * 4 + wc) * 32 + fq * 4;
#pragma unroll
        for (int m = 0; m < 8; ++m) {
            const int s = slot_of(sb, ic, wr * 128 + m * 16 + fr);
            if (s < 0) continue;
            T* op = ACT + (size_t)s * FF + col;
#pragma unroll
            for (int n = 0; n < 2; ++n)
                *(uint2*)(op + n * 16) = pk4(fast_silu(acc[m][n][0]) * acc[m][n + 2][0], fast_silu(acc[m][n][1]) * acc[m][n + 2][1],
                                             fast_silu(acc[m][n][2]) * acc[m][n + 2][2], fast_silu(acc[m][n][3]) * acc[m][n + 2][3]);
        }
    }
};
struct FfnDown {
    const T* ACT; const T* WdT; const float* GATEV; T* OUT; int nun;
    __device__ __forceinline__ int nunits() const { return nun; }
    __device__ __forceinline__ int ntiles(int) const { return 16; }
    __device__ __forceinline__ void decode(int u, int& e, int& pn, int& sbase, bool& isctx) const {
        if (u < 1024) { e = u >> 6; const int rem = u & 63; pn = rem & 3; sbase = ((rem >> 4) * NE + e) * CAP + ((rem >> 2) & 3) * 256; isctx = false; }
        else { const int uc = u - 1024; e = uc >> 2; pn = uc & 3; sbase = CTXB + e * CAPC; isctx = true; }
    }
    __device__ __forceinline__ int slot_of(int sbase, bool isctx, int R) const { return isctx ? (R < 128 ? sbase + (R >> 5) * (NE * CAPC) + (R & 31) : -1) : sbase + R; }
    __device__ __forceinline__ unsigned a_off(int u, int R) const { int e, pn, sb; bool ic; decode(u, e, pn, sb, ic); const int s = slot_of(sb, ic, R); return s < 0 ? 0u : (unsigned)s * 1024u; }
    __device__ __forceinline__ unsigned b_off(int u, int R) const { int e, pn, sb; bool ic; decode(u, e, pn, sb, ic); return (unsigned)(e * 1024 + pn * 256 + R) * 1024u; }
    __device__ __forceinline__ const T* a_base(int, int t) const { return ACT + t * 64; }
    __device__ __forceinline__ const T* b_base(int, int t) const { return WdT + t * 64; }
    __device__ __forceinline__ void epilogue(int u, f32x4 (&acc)[8][4], int wr, int wc, int fr, int fq) const {
        int e, pn, sb; bool ic; decode(u, e, pn, sb, ic);
        const int col = pn * 256 + wc * 64 + fq * 4;
#pragma unroll
        for (int m = 0; m < 8; ++m) {
            const int s = slot_of(sb, ic, wr * 128 + m * 16 + fr);
            if (s < 0) continue;
            const float g = GATEV[s];
            T* op = OUT + (size_t)s * D + col;
#pragma unroll
            for (int n = 0; n < 4; ++n) *(uint2*)(op + n * 16) = pk4(acc[m][n][0] * g, acc[m][n][1] * g, acc[m][n][2] * g, acc[m][n][3] * g);
        }
    }
};

namespace pg8 {
#define PG8_LAS __attribute__((address_space(3)))
constexpr int BM = 256, BK = 64, HALF = 128, HTB = HALF * BK * 2, STAGE_BYTES = 8 * HTB;
__host__ __device__ __forceinline__ int lds_byte(int r, int c) { const int st = (r >> 4) * 2 + (c >> 5), rr = r & 15, cc = c & 31, ob = rr * 64 + cc * 2; return st * 1024 + (ob ^ (((ob >> 9) & 1) << 5)); }
__host__ __device__ __forceinline__ void stage_rc(int b, int& R, int& C) { const int st = b / 1024, sb = b % 1024, swz = sb ^ (((sb >> 9) & 1) << 5); R = (st >> 1) * 16 + swz / 64; C = (st & 1) * 32 + (swz % 64) / 2; }
__host__ __device__ __forceinline__ int perm32(int rho) { const int n = rho >> 4, i = rho & 15; return 8 * (i >> 2) + 4 * n + (i & 3); }
struct Unit { int pm, pn; const char* a; const char* b; int x0, x1; };
template <class Epi, class Sched, bool ALIGN_EPI = false, bool SP2 = false>
__device__ __forceinline__ void gemm_phase(PG8_LAS unsigned char* lds, const int K, const Sched& S, const Epi& E) {
    const int tid = otid(), wid = __builtin_amdgcn_readfirstlane(tid >> 6), lane = tid & 63, wr = wid >> 2, wc = wid & 3, fr = lane & 15, fq = lane >> 4;
    const int nt = K / BK;
    unsigned voffA[2], voffB[2];
#pragma unroll
    for (int i = 0; i < 2; ++i) { int R, C; stage_rc(tid * 16 + i * 8192, R, C); const int Rb = Epi::PERM ? ((R & ~31) + perm32(R & 31)) : R;
        voffA[i] = (unsigned)(R * K + C) * 2u; voffB[i] = (unsigned)(Rb * K + C) * 2u; }
    const size_t kstep = (size_t)(BK * 2);
    const size_t hstep = (size_t)HALF * K * 2;
    const unsigned ldsw = (unsigned)wid * 1024u;
    const int aoff = lds_byte(wr * 64 + fr, fq * 8), boff = lds_byte(wc * 32 + fr, fq * 8);
#define PG8_SA(b, h) (((b) * 2 + (h)) * HTB)
#define PG8_SB(b, h) ((4 + (b) * 2 + (h)) * HTB)
#define PG8_STAGE(bufoff, gbase, voff) do { _Pragma("unroll") for (int _i = 0; _i < 2; ++_i) \
        __builtin_amdgcn_global_load_lds((const unsigned*)((const char*)(gbase) + (voff)[_i]), (PG8_LAS unsigned*)(lds + (bufoff) + ldsw + _i * 8192), 16, 0, 0); } while (0)
#define PG8_LDA(dst, b, h) do { _Pragma("unroll") for (int m = 0; m < 4; ++m) _Pragma("unroll") for (int k = 0; k < 2; ++k) dst[m][k] = *(const PG8_LAS bf16x8*)(lds + PG8_SA(b, h) + aoff + m * 2048 + k * 1024); } while (0)
#define PG8_LDB(dst, b, h) do { _Pragma("unroll") for (int n = 0; n < 2; ++n) _Pragma("unroll") for (int k = 0; k < 2; ++k) dst[n][k] = *(const PG8_LAS bf16x8*)(lds + PG8_SB(b, h) + boff + n * 2048 + k * 1024); } while (0)
#define PG8_MMA(ai, bj, At, Bt) do { __builtin_amdgcn_s_setprio(1); _Pragma("unroll") for (int m = 0; m < 4; ++m) _Pragma("unroll") for (int n = 0; n < 2; ++n) _Pragma("unroll") for (int k = 0; k < 2; ++k) \
        acc[ai][bj][m][n] = __builtin_amdgcn_mfma_f32_16x16x32_bf16(Bt[n][k], At[m][k], acc[ai][bj][m][n], 0, 0, 0); __builtin_amdgcn_s_setprio(0); } while (0)
#define PG8_WAIT_V(n) asm volatile("s_waitcnt vmcnt(" #n ")" ::: "memory")
#define PG8_WAIT_L(n) asm volatile("s_waitcnt lgkmcnt(" #n ")" ::: "memory")
#define PG8_BAR __builtin_amdgcn_s_barrier()
#define PG8_SCHED __builtin_amdgcn_sched_barrier(0)
    Unit cur, nxt; int ui = 0;
    if (!S.next(0, cur)) return;
    f32x4 acc[2][2][4][2];
#pragma unroll
    for (int a = 0; a < 2; ++a)
#pragma unroll
        for (int b = 0; b < 2; ++b)
#pragma unroll
            for (int m = 0; m < 4; ++m)
#pragma unroll
                for (int n = 0; n < 2; ++n) acc[a][b][m][n] = (f32x4){0.f, 0.f, 0.f, 0.f};
    bf16x8 At[4][2], B0[2][2], B1[2][2];
    const char* cA = cur.a; const char* cB = cur.b;
    S.a_ready(cur);
    if constexpr (SP2) {
        PG8_STAGE(PG8_SB(0, 0), cB, voffB); PG8_STAGE(PG8_SB(0, 1), cB + hstep, voffB); PG8_STAGE(PG8_SA(0, 0), cA, voffA); PG8_STAGE(PG8_SA(0, 1), cA + hstep, voffA);
        if (wr == 1) PG8_BAR;
        PG8_WAIT_V(2); PG8_BAR;
        PG8_STAGE(PG8_SB(1, 0), cB + kstep, voffB); PG8_STAGE(PG8_SA(1, 0), cA + kstep, voffA); PG8_STAGE(PG8_SB(1, 1), cB + hstep + kstep, voffB);
        PG8_WAIT_V(6); PG8_BAR;
    } else {
        PG8_STAGE(PG8_SB(0, 0), cB, voffB); PG8_STAGE(PG8_SA(0, 0), cA, voffA); PG8_STAGE(PG8_SB(0, 1), cB + hstep, voffB); PG8_STAGE(PG8_SA(0, 1), cA + hstep, voffA);
        if (wr == 1) PG8_BAR;
        PG8_WAIT_V(4); PG8_BAR;
        PG8_STAGE(PG8_SB(1, 0), cB + kstep, voffB); PG8_STAGE(PG8_SA(1, 0), cA + kstep, voffA); PG8_STAGE(PG8_SB(1, 1), cB + hstep + kstep, voffB);
        PG8_WAIT_V(6); PG8_BAR;
    }
    for (;;) {
        const bool has_next = S.next(ui + 1, nxt);
        const char* nA = has_next ? nxt.a : cA; const char* nB = has_next ? nxt.b : cB;
        for (int t = 0; t < nt; t += 2) {
            const bool last = (t == nt - 2);
            const char* a1 = cA + (size_t)(t + 1) * kstep;
            const char* a2 = last ? nA : cA + (size_t)(t + 2) * kstep; const char* b2 = last ? nB : cB + (size_t)(t + 2) * kstep;
            const char* a3 = a2 + kstep; const char* b3 = b2 + kstep;
            if (last && has_next) S.a_ready(nxt);
            if constexpr (SP2) {
            PG8_LDB(B0, 0, 0); PG8_LDB(B1, 0, 1); PG8_SCHED; PG8_LDA(At, 0, 0); PG8_STAGE(PG8_SA(1, 1), a1 + hstep, voffA);
            PG8_WAIT_V(8); PG8_WAIT_L(0); PG8_BAR; PG8_MMA(0, 0, At, B0); PG8_MMA(0, 1, At, B1); PG8_BAR; PG8_SCHED;
            PG8_LDA(At, 0, 1); PG8_STAGE(PG8_SB(0, 0), b2, voffB); PG8_STAGE(PG8_SB(0, 1), b2 + hstep, voffB); PG8_STAGE(PG8_SA(0, 0), a2, voffA);
            PG8_WAIT_V(8); PG8_WAIT_L(0); PG8_BAR; PG8_MMA(1, 0, At, B0); PG8_MMA(1, 1, At, B1); PG8_BAR; PG8_SCHED;
            PG8_LDB(B0, 1, 0); PG8_LDB(B1, 1, 1); PG8_SCHED; PG8_LDA(At, 1, 0); PG8_STAGE(PG8_SA(0, 1), a2 + hstep, voffA);
            PG8_WAIT_V(8); PG8_WAIT_L(0); PG8_BAR; PG8_MMA(0, 0, At, B0); PG8_MMA(0, 1, At, B1); PG8_BAR; PG8_SCHED;
            PG8_LDA(At, 1, 1); PG8_STAGE(PG8_SB(1, 0), b3, voffB); PG8_STAGE(PG8_SB(1, 1), b3 + hstep, voffB); PG8_STAGE(PG8_SA(1, 0), a3, voffA);
            PG8_WAIT_V(8); PG8_WAIT_L(0); PG8_BAR; PG8_MMA(1, 0, At, B0); PG8_MMA(1, 1, At, B1); PG8_BAR; PG8_SCHED;
            } else {
            PG8_LDB(B0, 0, 0); PG8_SCHED; PG8_LDA(At, 0, 0); PG8_STAGE(PG8_SA(1, 1), a1 + hstep, voffA);
            PG8_WAIT_L(8); PG8_BAR; PG8_WAIT_L(0); PG8_MMA(0, 0, At, B0); PG8_BAR; PG8_SCHED;
            PG8_LDB(B1, 0, 1); PG8_STAGE(PG8_SB(0, 0), b2, voffB);
            PG8_BAR; PG8_WAIT_L(0); PG8_MMA(0, 1, At, B1); PG8_BAR;
            PG8_LDA(At, 0, 1); PG8_STAGE(PG8_SA(0, 0), a2, voffA);
            PG8_BAR; PG8_WAIT_L(0); PG8_MMA(1, 0, At, B0); PG8_BAR; PG8_SCHED;
            PG8_STAGE(PG8_SB(0, 1), b2 + hstep, voffB);
            PG8_WAIT_V(6); PG8_BAR; PG8_MMA(1, 1, At, B1); PG8_BAR;
            PG8_LDB(B0, 1, 0); PG8_SCHED; PG8_LDA(At, 1, 0); PG8_STAGE(PG8_SA(0, 1), a2 + hstep, voffA);
            PG8_WAIT_L(8); PG8_BAR; PG8_WAIT_L(0); PG8_MMA(0, 0, At, B0); PG8_BAR; PG8_SCHED;
            PG8_LDB(B1, 1, 1); PG8_STAGE(PG8_SB(1, 0), b3, voffB);
            PG8_BAR; PG8_WAIT_L(0); PG8_MMA(0, 1, At, B1); PG8_BAR;
            PG8_LDA(At, 1, 1); PG8_STAGE(PG8_SA(1, 0), a3, voffA);
            PG8_BAR; PG8_WAIT_L(0); PG8_MMA(1, 0, At, B0); PG8_BAR; PG8_SCHED;
            PG8_STAGE(PG8_SB(1, 1), b3 + hstep, voffB);
            PG8_WAIT_V(6); PG8_BAR; PG8_MMA(1, 1, At, B1); PG8_BAR;
            }
        }
        if constexpr (ALIGN_EPI) { if (wr == 0) PG8_BAR; }
        if constexpr (!Epi::AFTER_DRAIN) { E(acc, cur, wr, wc, fr, fq); S.done(cur); }
        if (!has_next) break;
#pragma unroll
        for (int a = 0; a < 2; ++a)
#pragma unroll
            for (int b = 0; b < 2; ++b)
#pragma unroll
                for (int m = 0; m < 4; ++m)
#pragma unroll
                    for (int n = 0; n < 2; ++n) acc[a][b][m][n] = (f32x4){0.f, 0.f, 0.f, 0.f};
        cur = nxt; cA = nA; cB = nB; ++ui;
        if constexpr (ALIGN_EPI) { if (wr == 1) PG8_BAR; }
    }
    PG8_WAIT_V(0);
    if constexpr (!ALIGN_EPI) { if (wr == 0) PG8_BAR; }
    PG8_BAR;
    if constexpr (Epi::AFTER_DRAIN) { E.fused(acc, cur, wr, wc, fr, fq, lds, wid, lane); S.done(cur); }
#undef PG8_SA
#undef PG8_SB
#undef PG8_STAGE
#undef PG8_LDA
#undef PG8_LDB
#undef PG8_MMA
#undef PG8_WAIT_V
#undef PG8_WAIT_L
#undef PG8_BAR
#undef PG8_SCHED
}
}

struct SchedBase { __device__ __forceinline__ void a_ready(const pg8::Unit&) const {} __device__ __forceinline__ void done(const pg8::Unit&) const {} };
#define ACC8(mm, nn) acc[(mm) >> 2][(nn) >> 1][(mm) & 3][(nn) & 1]
#define ROW8(mm) (((mm) >> 2) * 128 + wr * 64 + ((mm) & 3) * 16 + fr)

struct InProj8S : SchedBase { const T* H; const T* Wt; int npm, bid, nblk, nun;
    __device__ __forceinline__ bool next(int i, pg8::Unit& u) const { const int x0 = bid + i * nblk; if (x0 >= nun) return false; const int x = xswz(x0, nun);
        if (x < 3200 || nun == 3300) { u.pm = x / 25; u.pn = x % 25; } else { const int y = x - 3200; u.pm = 128 + y / 9; u.pn = y % 9; }
        u.a = (const char*)(H + (size_t)u.pm * 256 * D); u.b = (const char*)(Wt + (size_t)u.pn * 256 * D); return true; } };
struct InProj8E {
    static constexpr bool PERM = false, AFTER_DRAIN = false;
    T* Z; float* SS; const float* gqn; const float* gkn; const float2* tab64; const float2* tab32;
    __device__ __forceinline__ void operator()(const f32x4 (&acc)[2][2][4][2], const pg8::Unit& u, int wr, int wc, int fr, int fq) const {
        const int pm = u.pm, cg = u.pn * 4 + wc;
        if (cg == 34 || cg == 35) return;
        const bool lat = pm * 256 < NLAT;
        const int zcol = (cg < 36 ? cg * 64 : 2144 + (cg - 36) * 64) + fq * 4;
        const bool t_rms = (cg >= 12 && cg < 18), t_rope = t_rms || (cg >= 20 && cg < 26), t_ssq = (cg >= 28 && cg < 33), t_kr = cg == 33, t_sig = cg >= 36;
        float4 gv[4];
        if (t_rms) { const float* g = cg < 16 ? gqn : gkn;
#pragma unroll
            for (int n = 0; n < 4; ++n) gv[n] = *(const float4*)(g + n * 16 + fq * 4); }
#pragma unroll
        for (int m = 0; m < 8; ++m) {
            const int row = pm * 256 + ROW8(m);
            const int t = row & (SEQ - 1), gr = t >> 6, gc = t & 63;
            float v[4][4];
#pragma unroll
            for (int n = 0; n < 4; ++n)
#pragma unroll
                for (int j = 0; j < 4; ++j) v[n][j] = ACC8(m, n)[j];
            T* zp = Z + (size_t)row * ZW + zcol;
            if (t_rms || t_ssq) {
                float ss = 0.f;
#pragma unroll
                for (int n = 0; n < 4; ++n)
#pragma unroll
                    for (int j = 0; j < 4; ++j) ss += v[n][j] * v[n][j];
                ss += __shfl_xor(ss, 16); ss += __shfl_xor(ss, 32);
                if (t_ssq) { if (fq == 0) SS[(size_t)row * 8 + (cg - 28)] = ss; }
                else { const float rstd = 1.f / sqrtf(ss * (1.f / 64.f) + EPS);
#pragma unroll
                    for (int n = 0; n < 4; ++n) { v[n][0] *= rstd * gv[n].x; v[n][1] *= rstd * gv[n].y; v[n][2] *= rstd * gv[n].z; v[n][3] *= rstd * gv[n].w; } }
            }
            if (t_rope && lat) {
                const float4* tr = (const float4*)(tab64 + gr * 16 + fq * 4); const float4* tc = (const float4*)(tab64 + gc * 16 + fq * 4);
                const float4 r0 = tr[0], r1 = tr[1], c0 = tc[0], c1 = tc[1];
                const float rc[4] = {r0.x, r0.z, r1.x, r1.z}, rs[4] = {r0.y, r0.w, r1.y, r1.w}, cc[4] = {c0.x, c0.z, c1.x, c1.z}, cs[4] = {c0.y, c0.w, c1.y, c1.w};
#pragma unroll
                for (int j = 0; j < 4; ++j) {
                    const float a0 = v[0][j], a1 = v[1][j], b0 = v[2][j], b1 = v[3][j];
                    v[0][j] = a0 * rc[j] - a1 * rs[j]; v[1][j] = a0 * rs[j] + a1 * rc[j];
                    v[2][j] = b0 * cc[j] - b1 * cs[j]; v[3][j] = b0 * cs[j] + b1 * cc[j];
                }
            }
            if (t_kr) {
#pragma unroll
                for (int n = 0; n < 2; ++n) {
                    const float4* tp = (const float4*)(tab32 + (n == 0 ? gr : gc) * 8 + (fq & 1) * 4);
                    const float4 q0 = tp[0], q1 = tp[1];
                    const float kc[4] = {q0.x, q0.z, q1.x, q1.z}, ks[4] = {q0.y, q0.w, q1.y, q1.w};
#pragma unroll
                    for (int j = 0; j < 4; ++j) { const float x = v[n][j], px = __shfl_xor(x, 32); if (lat) v[n][j] = (fq < 2) ? (x * kc[j] - px * ks[j]) : (px * ks[j] + x * kc[j]); }
                    *(uint2*)(zp + n * 16) = pk4(v[n][0], v[n][1], v[n][2], v[n][3]);
                }
                continue;
            }
            if (t_sig) {
#pragma unroll
                for (int n = 0; n < 4; ++n)
#pragma unroll
                    for (int j = 0; j < 4; ++j) v[n][j] = fast_sigmoid(v[n][j]);
            }
#pragma unroll
            for (int n = 0; n < 4; ++n) *(uint2*)(zp + n * 16) = pk4(v[n][0], v[n][1], v[n][2], v[n][3]);
        }
    }
};

struct FfnUp8S : SchedBase { const T* XG; const T* WguT; int nun, bid, nblk;
    __device__ __forceinline__ bool next(int i, pg8::Unit& u) const { const int x0 = bid + i * nblk; if (x0 >= nun) return false; const int x = xswz(x0, nun); int e, sb;
        if (x < 2048) { e = x >> 7; const int rem = x & 127; u.pn = rem & 7; sb = ((rem >> 5) * NE + e) * CAP + ((rem >> 3) & 3) * 256; u.x1 = 256; }
        else { const int uc = x - 2048; e = uc >> 3; u.pn = uc & 7; sb = CTXB + e * (NB * CAPC); u.x1 = NB * CAPC; }
        u.pm = 0; u.x0 = sb; u.a = (const char*)(XG + (size_t)sb * D); u.b = (const char*)(WguT + ((size_t)e * 2048 + u.pn * 256) * D); return true; } };
struct FfnUp8E {
    static constexpr bool PERM = false, AFTER_DRAIN = false;
    T* ACT;
    __device__ __forceinline__ void operator()(const f32x4 (&acc)[2][2][4][2], const pg8::Unit& u, int wr, int wc, int fr, int fq) const {
        const int col = (u.pn * 4 + wc) * 32 + fq * 4;
#pragma unroll
        for (int m = 0; m < 8; ++m) {
            const int R = ROW8(m);
            if (R >= u.x1) continue;
            T* op = ACT + (size_t)(u.x0 + R) * FF + col;
#pragma unroll
            for (int n = 0; n < 2; ++n) { const f32x4 g = ACC8(m, n), w = ACC8(m, n + 2);
                *(uint2*)(op + n * 16) = pk4(fast_silu(g[0]) * w[0], fast_silu(g[1]) * w[1], fast_silu(g[2]) * w[2], fast_silu(g[3]) * w[3]); }
        }
    }
};
struct FfnDown8S : SchedBase { const T* ACT; const T* WdT; int nun, bid, nblk;
    __device__ __forceinline__ bool next(int i, pg8::Unit& u) const { const int x0 = bid + i * nblk; if (x0 >= nun) return false; const int x = xswz(x0, nun); int e, sb;
        if (x < 1024) { e = x >> 6; const int rem = x & 63; u.pn = rem & 3; sb = ((rem >> 4) * NE + e) * CAP + ((rem >> 2) & 3) * 256; u.x1 = 256; }
        else { const int uc = x - 1024; e = uc >> 2; u.pn = uc & 3; sb = CTXB + e * (NB * CAPC); u.x1 = NB * CAPC; }
        u.pm = 0; u.x0 = sb; u.a = (const char*)(ACT + (size_t)sb * FF); u.b = (const char*)(WdT + ((size_t)e * 1024 + u.pn * 256) * FF); return true; } };
struct FfnDown8E {
    static constexpr bool PERM = false, AFTER_DRAIN = false;
    const float* GATEV; T* OUT;
    __device__ __forceinline__ void operator()(const f32x4 (&acc)[2][2][4][2], const pg8::Unit& u, int wr, int wc, int fr, int fq) const {
        const int col = u.pn * 256 + wc * 64 + fq * 4;
#pragma unroll
        for (int m = 0; m < 8; ++m) {
            const int R = ROW8(m);
            if (R >= u.x1) continue;
            const int s = u.x0 + R; const float g = GATEV[s];
            T* op = OUT + (size_t)s * D + col;
#pragma unroll
            for (int n = 0; n < 4; ++n) { const f32x4 a = ACC8(m, n); *(uint2*)(op + n * 16) = pk4(a[0] * g, a[1] * g, a[2] * g, a[3] * g); }
        }
    }
};
struct Plain8S : SchedBase { const T* A; const T* Bt; int npm, npn, K, bid, nblk;
    __device__ __forceinline__ bool next(int i, pg8::Unit& u) const { const int x0 = bid + i * nblk; if (x0 >= npm * npn) return false; const int x = xswz(x0, npm * npn); u.pm = x / npn; u.pn = x % npn;
        u.a = (const char*)(A + (size_t)u.pm * 256 * K); u.b = (const char*)(Bt + (size_t)u.pn * 256 * K); return true; } };
struct Plain8E {
    static constexpr bool PERM = false, AFTER_DRAIN = false;
    T* C; int ldc;
    __device__ __forceinline__ void operator()(const f32x4 (&acc)[2][2][4][2], const pg8::Unit& u, int wr, int wc, int fr, int fq) const {
        const int col = u.pn * 256 + wc * 64 + fq * 4;
#pragma unroll
        for (int m = 0; m < 8; ++m) {
            T* op = C + (size_t)(u.pm * 256 + ROW8(m)) * ldc + col;
#pragma unroll
            for (int n = 0; n < 4; ++n) { const f32x4 a = ACC8(m, n); *(uint2*)(op + n * 16) = pk4(a[0], a[1], a[2], a[3]); }
        }
    }
};
__device__ __forceinline__ void ph_gather(const T* H2, const int* IDX, T* XG, int nslot, int bid, int nblk) {
    const int tid_ = otid(); const int lane = tid_ & 63, wid = tid_ >> 6;
    for (int s0 = (bid * 8 + wid) * 2; s0 < nslot; s0 += nblk * 16) {
        const int i0 = IDX[s0], i1 = IDX[s0 + 1];
        const uint4 a0 = *(const uint4*)(H2 + (size_t)i0 * D + lane * 8), a1 = *(const uint4*)(H2 + (size_t)i0 * D + 512 + lane * 8);
        const uint4 b0 = *(const uint4*)(H2 + (size_t)i1 * D + lane * 8), b1 = *(const uint4*)(H2 + (size_t)i1 * D + 512 + lane * 8);
        *(uint4*)(XG + (size_t)s0 * D + lane * 8) = a0; *(uint4*)(XG + (size_t)s0 * D + 512 + lane * 8) = a1;
        *(uint4*)(XG + (size_t)(s0 + 1) * D + lane * 8) = b0; *(uint4*)(XG + (size_t)(s0 + 1) * D + 512 + lane * 8) = b1;
    }
}

typedef float f32x16 __attribute__((ext_vector_type(16)));
typedef short s16x4 __attribute__((ext_vector_type(4)));
typedef short v4i16_t __attribute__((ext_vector_type(4)));
struct AttnP { const T* Z; const T* QM; const T* KVM; T* O; const float* rpb; const float* sink; int nlat; int need_ctx; float* o32; int fake; };
constexpr int ATT_LDS = 156672 + 2048;
__device__ __forceinline__ int crow(int r, int hi) { return (r & 3) + 8 * (r >> 2) + 4 * hi; }
__device__ __forceinline__ float xhalf_max(float v) { auto rr = __builtin_amdgcn_permlane32_swap(__float_as_uint(v), __float_as_uint(v), false, false); return fmaxf(__uint_as_float(rr[0]), __uint_as_float(rr[1])); }
__device__ __forceinline__ float xhalf_sum(float v) { auto rr = __builtin_amdgcn_permlane32_swap(__float_as_uint(v), __float_as_uint(v), false, false); return __uint_as_float(rr[0]) + __uint_as_float(rr[1]); }
__device__ __forceinline__ unsigned cvtpk(float lo, float hi) { typedef float f2 __attribute__((ext_vector_type(2))); typedef __bf16 b2 __attribute__((ext_vector_type(2))); f2 v = {lo, hi}; b2 b = __builtin_convertvector(v, b2); return __builtin_bit_cast(unsigned, b); }

__device__ __forceinline__ float max3f(float a, float b, float c) { float r; asm("v_max3_f32 %0, %1, %2, %3" : "=v"(r) : "v"(a), "v"(b), "v"(c)); return r; }
template <int BR>
__device__ __forceinline__ void attn_unit_l(ldsp lds, const AttnP& P, int b, int hx, int q0, bool ctxq) {
    constexpr int DQK = (BR == 3) ? 96 : 64, NKS = DQK / 16, KB = (BR == 3) ? 9216 + 4096 : 9216, SLOT = KB + 8192;
    constexpr int R = (BR == 3) ? 5 : 6, PF = R - 1;
    constexpr int BT0 = 107520, QF0 = BT0 + 2048;
    static_assert(R * SLOT <= BT0, "ring");
    constexpr bool PACK2 = (BR == 1 || BR == 2);
    constexpr float SCALE = (BR == 3) ? 0.10206207261596575f : 0.125f;
    constexpr float CL2 = SCALE * 1.4426950408889634f;
    constexpr float NEG = -1e30f, THR = 8.f;
    const int tid = otid(), lane = tid & 63, wid = __builtin_amdgcn_readfirstlane(tid >> 6), r32 = lane & 31, hi = lane >> 5;
    const int tokq = q0 + (PACK2 ? (wid & 3) : wid) * 32 + r32;
    const int head = PACK2 ? hx * 2 + (wid >> 2) : hx;
    const size_t lat0 = (size_t)b * SEQ, ctx0 = (size_t)P.nlat + (size_t)b * CTX;
    const size_t qrow = ctxq ? ctx0 + tokq : lat0 + tokq;
    const ldsp qlds = lds + QF0 + wid * 6144 + lane * 16;
    { const T* qp = (BR == 3) ? P.QM + qrow * 384 + head * 96 + hi * 8 : P.Z + qrow * ZW + (BR == 0 ? NAQ : BR == 1 ? GQ : SQ) + head * 64 + hi * 8;
#pragma unroll
      for (int ks = 0; ks < NKS; ++ks) {
          const uint4 raw = *(const uint4*)(qp + ks * 16);
          typedef unsigned u4 __attribute__((ext_vector_type(4)));
          const u4 w = {cvtpk(__uint_as_float(raw.x << 16) * CL2, __uint_as_float(raw.x & 0xffff0000u) * CL2), cvtpk(__uint_as_float(raw.y << 16) * CL2, __uint_as_float(raw.y & 0xffff0000u) * CL2),
                        cvtpk(__uint_as_float(raw.z << 16) * CL2, __uint_as_float(raw.z & 0xffff0000u) * CL2), cvtpk(__uint_as_float(raw.w << 16) * CL2, __uint_as_float(raw.w & 0xffff0000u) * CL2)};
          *(LAS u4*)(qlds + ks * 1024) = w; } }
    int klo = 0, nlt = 0;
    if (!ctxq) {
        if (BR == 0) { const int r0 = q0 >> 6; const int lo = min(max(r0 - 4, 0), GROWS - 8), hi2 = min(max(r0 - 1, 0), GROWS - 8) + 8; klo = lo * 64; nlt = hi2 - lo; }
        else if (BR == 2) { klo = max(q0 - 128, 0); nlt = (min(q0 + 256, SEQ) - klo) >> 6; }
        else { klo = 0; nlt = SEQ / 64; }
    }
    const int nt = 4 + nlt;
    const T* ksrc; const T* vsrc; const T* rsrc = nullptr; size_t kpitch;
    { const int kk = 8 * wid + (lane >> 3), kch = ((lane & 7) ^ (lane >> 3)) * 8, vch = ((((lane >> 2) ^ (lane >> 4)) & 1) * 32) + (lane & 3) * 8;
      if (BR == 3) { ksrc = P.KVM + (size_t)kk * 512 + hx * 128 + kch; vsrc = P.KVM + (size_t)kk * 512 + hx * 128 + 64 + vch; kpitch = 512;
                     rsrc = P.Z + (size_t)(16 * (wid & 3) + (lane >> 2)) * ZW + MKR + (((lane & 3) ^ ((lane >> 4) & 3)) * 8); }
      else { const int ko = (BR == 0 ? NAK : BR == 1 ? GK : SK) + hx * 64, vo = (BR == 0 ? NAV : BR == 1 ? GV : SV) + hx * 64;
             ksrc = P.Z + (size_t)kk * ZW + ko + kch; vsrc = P.Z + (size_t)kk * ZW + vo + vch; kpitch = ZW; } }
#define A_TROW(t) ((t) < 4 ? ctx0 + (size_t)(t) * 64 : lat0 + (size_t)klo + (size_t)((t) - 4) * 64)
#define A_DMA(t, slot) do { const size_t tr_ = A_TROW(t); const ldsp sb_ = lds + (slot) * SLOT; \
        GLDS16(ksrc + tr_ * kpitch, sb_ + wid * 1152); GLDS16(vsrc + tr_ * kpitch, sb_ + KB + wid * 1024); \
        if (BR == 3) { if (wid < 4) GLDS16(rsrc + tr_ * ZW, sb_ + 9216 + wid * 1024); } } while (0)
#define A_WAITBAR(n) do { if (BR == 3 && wid < 4) asm volatile("s_waitcnt vmcnt(%0) lgkmcnt(0)\n\ts_barrier" :: "n"(3 * (n)) : "memory"); \
                          else asm volatile("s_waitcnt vmcnt(%0) lgkmcnt(0)\n\ts_barrier" :: "n"(2 * (n)) : "memory"); } while (0)
    LAS float* btab = (LAS float*)(lds + BT0);
    if (BR == 0) { if (tid < 465) btab[tid] = P.rpb[hx * 465 + tid] * 1.4426950408889634f; }
    const int qr = (q0 >> 6) + (wid >> 1), qc = (wid & 1) * 32 + r32;
    const int krow0 = min(max(qr - 4, 0), GROWS - 8), kcol0 = min(max(qc - 8, 0), GW - 16);
    float mref = 0.f, lsum = 0.f;
    f32x16 o0, o1, negm;
#pragma unroll
    for (int r = 0; r < 16; ++r) { o0[r] = 0.f; o1[r] = 0.f; negm[r] = 0.f; }
    const unsigned kfo = (r32 >> 3) * 1152 + (r32 & 7) * 128 + ((hi ^ (r32 & 7)) * 16);
    const unsigned rfo = 9216 + r32 * 64 + ((hi ^ ((r32 >> 2) & 3)) * 16);
    const unsigned vfo = KB + (4 * hi + ((lane & 15) >> 2)) * 128 + ((lane >> 3) & 1) * 64 + ((lane >> 4) & 1) * 32 + (lane & 3) * 8;
#define A_ACTIVE(t) (!(BR == 0 && (t) >= 4) || (((klo >> 6) + ((t) - 4)) >= krow0 && ((klo >> 6) + ((t) - 4)) < krow0 + 8))
#define A_QK(p0, p1, slot) do { const ldsp kb_ = lds + (slot) * SLOT; bf16x8 kaf[NKS], kbf[NKS], qkf[NKS]; \
        _Pragma("unroll") for (int ks = 0; ks < NKS; ++ks) { \
            if (ks < 4) { const ldsp a_ = kb_ + (kfo ^ (unsigned)(ks * 32)); kaf[ks] = *(const LAS bf16x8*)(a_); kbf[ks] = *(const LAS bf16x8*)(a_ + 4608); } \
            else { const ldsp a_ = kb_ + (rfo ^ (unsigned)((ks - 4) * 32)); kaf[ks] = *(const LAS bf16x8*)(a_); kbf[ks] = *(const LAS bf16x8*)(a_ + 2048); } \
            qkf[ks] = *(const LAS bf16x8*)(qlds + ks * 1024); } \
        p0 = __builtin_amdgcn_mfma_f32_32x32x16_bf16(kaf[0], qkf[0], negm, 0, 0, 0); p1 = __builtin_amdgcn_mfma_f32_32x32x16_bf16(kbf[0], qkf[0], negm, 0, 0, 0); \
        _Pragma("unroll") for (int ks = 1; ks < NKS; ++ks) { \
          p0 = __builtin_amdgcn_mfma_f32_32x32x16_bf16(kaf[ks], qkf[ks], p0, 0, 0, 0); p1 = __builtin_amdgcn_mfma_f32_32x32x16_bf16(kbf[ks], qkf[ks], p1, 0, 0, 0); } } while (0)
    asm volatile("s_waitcnt lgkmcnt(0)" ::: "memory");
#pragma unroll
    for (int j = 0; j < PF; ++j) { if (j < nt) A_DMA(j, j); }
    if (nt >= PF) A_WAITBAR(PF - 2); else A_WAITBAR(0);
    f32x16 sA0, sA1, sB0, sB1;
    A_QK(sA0, sA1, 0);
    bool act_cur = true;
    int sl = 0;
#define A_STEP(t, pc0, pc1, pn0, pn1) do { \
        const int s1 = (sl + 1 == R) ? 0 : sl + 1, sm = (sl == 0) ? R - 1 : sl - 1; \
        if ((t) + PF < nt) A_DMA((t) + PF, sm);                   \
        const bool act_next = ((t) + 1 < nt) && A_ACTIVE((t) + 1); \
        if (act_next) A_QK(pn0, pn1, s1); \
        if (act_cur) { \
            if (BR == 0) { if ((t) >= 4) { const int dr = (klo >> 6) + ((t) - 4) - qr + 7; \
                    _Pragma("unroll") for (int r = 0; r < 16; ++r) { const int kc0 = crow(r, hi), kc1 = 32 + kc0; \
                        const bool v0 = (unsigned)(kc0 - kcol0) < 16u, v1 = (unsigned)(kc1 - kcol0) < 16u; \
                        const float b0 = btab[dr * 31 + min(max(kc0 - qc + 15, 0), 30)], b1 = btab[dr * 31 + min(max(kc1 - qc + 15, 0), 30)]; \
                        pc0[r] = v0 ? pc0[r] + b0 : NEG; pc1[r] = v1 ? pc1[r] + b1 : NEG; } } } \
            if (BR == 2) { if ((t) >= 4) { const int kb0 = klo + ((t) - 4) * 64 - tokq + 128; \
                    _Pragma("unroll") for (int r = 0; r < 16; ++r) { const int d0 = kb0 + crow(r, hi); \
                        if ((unsigned)d0 > 256u) pc0[r] = NEG; if ((unsigned)(d0 + 32) > 256u) pc1[r] = NEG; } } } \
            float rm; \
            { const float a0 = max3f(pc0[0], pc0[1], pc0[2]), a1 = max3f(pc0[3], pc0[4], pc0[5]), a2 = max3f(pc0[6], pc0[7], pc0[8]), a3 = max3f(pc0[9], pc0[10], pc0[11]), \
                          a4 = max3f(pc0[12], pc0[13], pc0[14]), a5 = max3f(pc0[15], pc1[0], pc1[1]), a6 = max3f(pc1[2], pc1[3], pc1[4]), a7 = max3f(pc1[5], pc1[6], pc1[7]), \
                          a8 = max3f(pc1[8], pc1[9], pc1[10]), a9 = max3f(pc1[11], pc1[12], pc1[13]), a10 = fmaxf(pc1[14], pc1[15]); \
              const float b0 = max3f(a0, a1, a2), b1 = max3f(a3, a4, a5), b2 = max3f(a6, a7, a8), b3 = fmaxf(a9, a10); \
              rm = xhalf_max(fmaxf(fmaxf(b0, b1), fmaxf(b2, b3))); } \
            if ((t) == 0 || __any(rm > THR)) { \
                const float dl = ((t) == 0) ? rm : fmaxf(rm, 0.f); const float f = __builtin_amdgcn_exp2f(-dl); \
                mref += dl; lsum *= f; \
                _Pragma("unroll") for (int r = 0; r < 16; ++r) { pc0[r] -= dl; pc1[r] -= dl; negm[r] -= dl; o0[r] *= f; o1[r] *= f; } \
                if (act_next) { _Pragma("unroll") for (int r = 0; r < 16; ++r) { pn0[r] -= dl; pn1[r] -= dl; } } } \
            _Pragma("unroll") for (int r = 0; r < 16; ++r) { pc0[r] = __builtin_amdgcn_exp2f(pc0[r]); pc1[r] = __builtin_amdgcn_exp2f(pc1[r]); } \
            { float s8[8]; _Pragma("unroll") for (int r = 0; r < 8; ++r) s8[r] = (pc0[r] + pc0[r + 8]) + (pc1[r] + pc1[r + 8]); \
              lsum += ((s8[0] + s8[1]) + (s8[2] + s8[3])) + ((s8[4] + s8[5]) + (s8[6] + s8[7])); } \
            const ldsp vb = lds + sl * SLOT + vfo, vb1 = lds + sl * SLOT + (vfo ^ 64u); \
            bf16x8 pf[4]; \
            _Pragma("unroll") for (int s = 0; s < 4; ++s) { const int rb = (s & 1) * 8; typedef unsigned u4 __attribute__((ext_vector_type(4))); u4 ww; \
                  if (s < 2) ww = (u4){cvtpk(pc0[rb], pc0[rb + 1]), cvtpk(pc0[rb + 2], pc0[rb + 3]), cvtpk(pc0[rb + 4], pc0[rb + 5]), cvtpk(pc0[rb + 6], pc0[rb + 7])}; \
                  else       ww = (u4){cvtpk(pc1[rb], pc1[rb + 1]), cvtpk(pc1[rb + 2], pc1[rb + 3]), cvtpk(pc1[rb + 4], pc1[rb + 5]), cvtpk(pc1[rb + 6], pc1[rb + 7])}; \
                  pf[s] = __builtin_bit_cast(bf16x8, ww); } \
            s16x4 vl0[4], vh0[4], vl1[4], vh1[4]; \
            _Pragma("unroll") for (int s = 0; s < 4; ++s) { vl0[s] = __builtin_bit_cast(s16x4, __builtin_amdgcn_ds_read_tr16_b64_v4i16((LAS v4i16_t*)(vb + s * 2048))); vh0[s] = __builtin_bit_cast(s16x4, __builtin_amdgcn_ds_read_tr16_b64_v4i16((LAS v4i16_t*)(vb + s * 2048 + 1024))); } \
            _Pragma("unroll") for (int s = 0; s < 4; ++s) { vl1[s] = __builtin_bit_cast(s16x4, __builtin_amdgcn_ds_read_tr16_b64_v4i16((LAS v4i16_t*)(vb1 + s * 2048))); vh1[s] = __builtin_bit_cast(s16x4, __builtin_amdgcn_ds_read_tr16_b64_v4i16((LAS v4i16_t*)(vb1 + s * 2048 + 1024))); } \
            _Pragma("unroll") for (int s = 0; s < 4; ++s) { const bf16x8 vf = (bf16x8){vl0[s][0], vl0[s][1], vl0[s][2], vl0[s][3], vh0[s][0], vh0[s][1], vh0[s][2], vh0[s][3]}; o0 = __builtin_amdgcn_mfma_f32_32x32x16_bf16(vf, pf[s], o0, 0, 0, 0); } \
            _Pragma("unroll") for (int s = 0; s < 4; ++s) { const bf16x8 vf = (bf16x8){vl1[s][0], vl1[s][1], vl1[s][2], vl1[s][3], vh1[s][0], vh1[s][1], vh1[s][2], vh1[s][3]}; o1 = __builtin_amdgcn_mfma_f32_32x32x16_bf16(vf, pf[s], o1, 0, 0, 0); } \
        } \
          \
        if ((t) + PF < nt) A_WAITBAR(PF - 2); else A_WAITBAR(0); \
        act_cur = act_next; sl = s1; \
    } while (0)
    { int t = 0;
      for (; t + 1 < nt; t += 2) { A_STEP(t, sA0, sA1, sB0, sB1); A_STEP(t + 1, sB0, sB1, sA0, sA1); }
      if (t < nt) A_STEP(t, sA0, sA1, sB0, sB1); }
    float ltot = xhalf_sum(lsum);
    if (BR == 2) ltot += __builtin_amdgcn_exp2f(P.sink[head] * 1.4426950408889634f - mref);
    const float inv = 1.f / ltot;
#ifdef PROBE_ATTN
    if (P.o32 && b == 1 && (ctxq || tokq < 1024 || tokq >= 7168)) {
        const int sub = ctxq ? 2048 + tokq : (tokq < 1024 ? tokq : 1024 + tokq - 7168);
        float* fp = P.o32 + (size_t)sub * D + BR * 256 + head * 64 + 4 * hi;
#pragma unroll
        for (int g = 0; g < 4; ++g)
#pragma unroll
            for (int j = 0; j < 4; ++j) { fp[8 * g + j] = o0[4 * g + j] * inv; fp[32 + 8 * g + j] = o1[4 * g + j] * inv; }
    }
#endif
    T* op = P.O + qrow * D + BR * 256 + head * 64 + 4 * hi;
#pragma unroll
    for (int g = 0; g < 4; ++g) {
        *(uint2*)(op + 8 * g) = pk4(o0[4 * g] * inv, o0[4 * g + 1] * inv, o0[4 * g + 2] * inv, o0[4 * g + 3] * inv);
        *(uint2*)(op + 32 + 8 * g) = pk4(o1[4 * g] * inv, o1[4 * g + 1] * inv, o1[4 * g + 2] * inv, o1[4 * g + 3] * inv);
    }
#undef A_TROW
#undef A_DMA
#undef A_WAITBAR
#undef A_ACTIVE
#undef A_QK
#undef A_STEP
}


template <int BR>
__device__ __forceinline__ void attn_unit(ldsp lds, const AttnP& P, int b, int hx, int q0, bool ctxq) {
    constexpr int DQK = (BR == 3) ? 96 : 64, NKS = DQK / 16, KB = (BR == 3) ? 9216 + 4096 : 9216, SLOT = KB + 8192;
    constexpr int R = (BR == 3) ? 7 : 9, PF = R - 3;
    constexpr int BT0 = 156672;
    static_assert(R * SLOT <= BT0, "ring");
    constexpr bool PACK2 = (BR == 1 || BR == 2);
    constexpr float SCALE = (BR == 3) ? 0.10206207261596575f : 0.125f;
    constexpr float CL2 = SCALE * 1.4426950408889634f;
    constexpr float NEG = -1e30f, THR = 8.f;
    const int tid = otid(), lane = tid & 63, wid = __builtin_amdgcn_readfirstlane(tid >> 6), r32 = lane & 31, hi = lane >> 5;
    const int tokq = q0 + (PACK2 ? (wid & 3) : wid) * 32 + r32;
    const int head = PACK2 ? hx * 2 + (wid >> 2) : hx;
    const size_t lat0 = (size_t)b * SEQ, ctx0 = (size_t)P.nlat + (size_t)b * CTX;
    const size_t qrow = ctxq ? ctx0 + tokq : lat0 + tokq;
    bf16x8 qf[NKS];
    { const T* qp = (BR == 3) ? P.QM + qrow * 384 + head * 96 + hi * 8 : P.Z + qrow * ZW + (BR == 0 ? NAQ : BR == 1 ? GQ : SQ) + head * 64 + hi * 8;
#pragma unroll
      for (int ks = 0; ks < NKS; ++ks) {
          const uint4 raw = *(const uint4*)(qp + ks * 16);
          typedef unsigned u4 __attribute__((ext_vector_type(4)));
          const u4 w = {cvtpk(__uint_as_float(raw.x << 16) * CL2, __uint_as_float(raw.x & 0xffff0000u) * CL2), cvtpk(__uint_as_float(raw.y << 16) * CL2, __uint_as_float(raw.y & 0xffff0000u) * CL2),
                        cvtpk(__uint_as_float(raw.z << 16) * CL2, __uint_as_float(raw.z & 0xffff0000u) * CL2), cvtpk(__uint_as_float(raw.w << 16) * CL2, __uint_as_float(raw.w & 0xffff0000u) * CL2)};
          qf[ks] = __builtin_bit_cast(bf16x8, w); } }
    int klo = 0, nlt = 0;
    if (!ctxq) {
        if (BR == 0) { const int r0 = q0 >> 6; const int lo = min(max(r0 - 4, 0), GROWS - 8), hi2 = min(max(r0 - 1, 0), GROWS - 8) + 8; klo = lo * 64; nlt = hi2 - lo; }
        else if (BR == 2) { klo = max(q0 - 128, 0); nlt = (min(q0 + 256, SEQ) - klo) >> 6; }
        else { klo = 0; nlt = SEQ / 64; }
    }
    const int nt = 4 + nlt;
    const T* ksrc; const T* vsrc; const T* rsrc = nullptr; size_t kpitch;
    { const int kk = 8 * wid + (lane >> 3), kch = ((lane & 7) ^ (lane >> 3)) * 8, vch = ((((lane >> 2) ^ (lane >> 4)) & 1) * 32) + (lane & 3) * 8;
      if (BR == 3) { ksrc = P.KVM + (size_t)kk * 512 + hx * 128 + kch; vsrc = P.KVM + (size_t)kk * 512 + hx * 128 + 64 + vch; kpitch = 512;
                     rsrc = P.Z + (size_t)(16 * (wid & 3) + (lane >> 2)) * ZW + MKR + (((lane & 3) ^ ((lane >> 4) & 3)) * 8); }
      else { const int ko = (BR == 0 ? NAK : BR == 1 ? GK : SK) + hx * 64, vo = (BR == 0 ? NAV : BR == 1 ? GV : SV) + hx * 64;
             ksrc = P.Z + (size_t)kk * ZW + ko + kch; vsrc = P.Z + (size_t)kk * ZW + vo + vch; kpitch = ZW; } }
#define A_TROW(t) ((t) < 4 ? ctx0 + (size_t)(t) * 64 : lat0 + (size_t)klo + (size_t)((t) - 4) * 64)
#define A_DMA(t, slot) do { if (wid < 4) { const size_t tr_ = A_TROW(t); const ldsp sb_ = lds + (slot) * SLOT; \
        GLDS16(ksrc + tr_ * kpitch, sb_ + wid * 1152); GLDS16(ksrc + (tr_ + 32) * kpitch, sb_ + (wid + 4) * 1152); \
        GLDS16(vsrc + tr_ * kpitch, sb_ + KB + wid * 1024); GLDS16(vsrc + (tr_ + 32) * kpitch, sb_ + KB + (wid + 4) * 1024); \
        if (BR == 3) GLDS16(rsrc + tr_ * ZW, sb_ + 9216 + wid * 1024); } } while (0)
#define A_WAITBAR(n) do { if (wid < 4) { if (BR == 3) asm volatile("s_waitcnt vmcnt(%0) lgkmcnt(0)\n\ts_barrier" :: "n"(5 * (n)) : "memory"); \
                                         else asm volatile("s_waitcnt vmcnt(%0) lgkmcnt(0)\n\ts_barrier" :: "n"(4 * (n)) : "memory"); } \
                          else asm volatile("s_waitcnt lgkmcnt(0)\n\ts_barrier" ::: "memory"); } while (0)
    LAS float* btab = (LAS float*)(lds + BT0);
    if (BR == 0) { if (tid < 465) btab[tid] = P.rpb[hx * 465 + tid] * 1.4426950408889634f; }
    const int qr = (q0 >> 6) + (wid >> 1), qc = (wid & 1) * 32 + r32;
    const int krow0 = min(max(qr - 4, 0), GROWS - 8), kcol0 = min(max(qc - 8, 0), GW - 16);
    float mref = 0.f, lsum = 0.f;
    f32x16 o0, o1, negm;
#pragma unroll
    for (int r = 0; r < 16; ++r) { o0[r] = 0.f; o1[r] = 0.f; negm[r] = 0.f; }
    const unsigned kfo = (r32 >> 3) * 1152 + (r32 & 7) * 128 + ((hi ^ (r32 & 7)) * 16);
    const unsigned rfo = 9216 + r32 * 64 + ((hi ^ ((r32 >> 2) & 3)) * 16);
    const unsigned vfo = KB + (4 * hi + ((lane & 15) >> 2)) * 128 + ((lane >> 3) & 1) * 64 + ((lane >> 4) & 1) * 32 + (lane & 3) * 8;
    constexpr int NG = 8 + 2 * NKS, AHEAD = 4, NGT = NG;
    if (wid < 4) { const size_t tr_ = A_TROW(0); GLDS16(vsrc + tr_ * kpitch, lds + (R - 1) * SLOT + KB + wid * 1024); GLDS16(vsrc + (tr_ + 32) * kpitch, lds + (R - 1) * SLOT + KB + (wid + 4) * 1024); }
#pragma unroll
    for (int j = 0; j < PF; ++j) { if (j < nt) A_DMA(j, j); }
    if (nt >= PF) A_WAITBAR(PF - 3); else A_WAITBAR(0);
    f32x16 sA0, sA1, sB0, sB1;
    { const ldsp kb_ = lds;
#pragma unroll
      for (int r = 0; r < 16; ++r) { sA0[r] = 0.f; sA1[r] = 0.f; }
#pragma unroll
      for (int ks = 0; ks < NKS; ++ks) { const ldsp a_ = kb_ + ((ks < 4) ? (kfo ^ (unsigned)(ks * 32)) : (rfo ^ (unsigned)((ks - 4) * 32)));
          const bf16x8 ka = *(const LAS bf16x8*)(a_), kb = *(const LAS bf16x8*)(a_ + ((ks < 4) ? 4608 : 2048));
          sA0 = __builtin_amdgcn_mfma_f32_32x32x16_bf16(ka, qf[ks], sA0, 0, 0, 0); sA1 = __builtin_amdgcn_mfma_f32_32x32x16_bf16(kb, qf[ks], sA1, 0, 0, 0); } }
    unsigned pwA[16], pwB[16];
#pragma unroll
    for (int i = 0; i < 16; ++i) { pwA[i] = 0u; pwB[i] = 0u; }
    int sl = 0;
#ifdef PROBE_T
    unsigned long long pt_acc = 0ull, pt_a = 0ull, pt_b = 0ull; const unsigned long long pt_t0 = __builtin_amdgcn_s_memtime(), pt_r0 = __builtin_amdgcn_s_memrealtime();
#define PT_A(k) do { if (PROBE_T == (k)) pt_a = __builtin_amdgcn_s_memtime(); } while (0)
#define PT_B(k) do { if (PROBE_T == (k)) { pt_b = __builtin_amdgcn_s_memtime(); pt_acc += pt_b - pt_a; } } while (0)
#else
#define PT_A(k) do { } while (0)
#define PT_B(k) do { } while (0)
#endif
#define S_EL(c0, c1, i) ((i) < 16 ? c0[(i) & 15] : c1[(i) & 15])
#define SB0() __builtin_amdgcn_sched_barrier(0)
    const unsigned lds0 = (unsigned)(size_t)lds;
#define DSR128(dst, addr, OFF) asm volatile("ds_read_b128 %0, %1 offset:" #OFF : "=v"(dst) : "v"(addr))
#define DSRTR(dst, addr, OFF) asm volatile("ds_read_b64_tr_b16 %0, %1 offset:" #OFF : "=v"(dst) : "v"(addr))
#define A_RD(m) do { switch (m) { \
        case 0: DSRTR(vL[0], vb_, 0); DSRTR(vH[0], vb_, 1024); break; case 1: DSRTR(vL[1], vc_, 0); DSRTR(vH[1], vc_, 1024); break; \
        case 2: DSRTR(vL[2], vb_, 2048); DSRTR(vH[2], vb_, 3072); break; case 3: DSRTR(vL[3], vc_, 2048); DSRTR(vH[3], vc_, 3072); break; \
        case 4: DSRTR(vL[4], vb_, 4096); DSRTR(vH[4], vb_, 5120); break; case 5: DSRTR(vL[5], vc_, 4096); DSRTR(vH[5], vc_, 5120); break; \
        case 6: DSRTR(vL[6], vb_, 6144); DSRTR(vH[6], vb_, 7168); break; case 7: DSRTR(vL[7], vc_, 6144); DSRTR(vH[7], vc_, 7168); break; \
        default: { const int q_ = (m) - 8, ks_ = q_ >> 1; \
                   if (ks_ < 4) { const unsigned a_ = kb_ + (kfo ^ (unsigned)(ks_ * 32)); if (q_ & 1) DSR128(kF[q_], a_, 4608); else DSR128(kF[q_], a_, 0); } \
                   else { const unsigned a_ = kb_ + (rfo ^ (unsigned)((ks_ - 4) * 32)); if (q_ & 1) DSR128(kF[q_], a_, 2048); else DSR128(kF[q_], a_, 0); } } break; } } while (0)
#define NRD(m) ((m) < 8 ? 2 : 1)
#define A_WT(g, n) do { if ((g) < 8) { if ((n) == 0) asm volatile("s_waitcnt lgkmcnt(0)" : "+v"(vL[g]), "+v"(vH[g])); else if ((n) == 1) asm volatile("s_waitcnt lgkmcnt(1)" : "+v"(vL[g]), "+v"(vH[g])); \
            else if ((n) == 2) asm volatile("s_waitcnt lgkmcnt(2)" : "+v"(vL[g]), "+v"(vH[g])); else if ((n) == 3) asm volatile("s_waitcnt lgkmcnt(3)" : "+v"(vL[g]), "+v"(vH[g])); \
            else if ((n) == 4) asm volatile("s_waitcnt lgkmcnt(4)" : "+v"(vL[g]), "+v"(vH[g])); else if ((n) == 5) asm volatile("s_waitcnt lgkmcnt(5)" : "+v"(vL[g]), "+v"(vH[g])); \
            else if ((n) == 6) asm volatile("s_waitcnt lgkmcnt(6)" : "+v"(vL[g]), "+v"(vH[g])); else if ((n) == 7) asm volatile("s_waitcnt lgkmcnt(7)" : "+v"(vL[g]), "+v"(vH[g])); \
            else asm volatile("s_waitcnt lgkmcnt(8)" : "+v"(vL[g]), "+v"(vH[g])); } \
        else { if ((n) == 0) asm volatile("s_waitcnt lgkmcnt(0)" : "+v"(kF[(g) - 8])); else if ((n) == 1) asm volatile("s_waitcnt lgkmcnt(1)" : "+v"(kF[(g) - 8])); \
            else if ((n) == 2) asm volatile("s_waitcnt lgkmcnt(2)" : "+v"(kF[(g) - 8])); else if ((n) == 3) asm volatile("s_waitcnt lgkmcnt(3)" : "+v"(kF[(g) - 8])); \
            else asm volatile("s_waitcnt lgkmcnt(4)" : "+v"(kF[(g) - 8])); } } while (0)
#define A_ITER(t, c0, c1, n0, n1, pwO, pwN, EVEN) do { \
        const int s1 = (sl + 1 == R) ? 0 : sl + 1, sm1 = (sl == 0) ? R - 1 : sl - 1, sm2 = (sm1 == 0) ? R - 1 : sm1 - 1; \
        const bool feed = (t) + PF < nt; PT_A(4); \
        if (BR == 2) { if ((t) >= 4) { const int kb0 = klo + ((t) - 4) * 64 - tokq + 128; \
                _Pragma("unroll") for (int r = 0; r < 16; ++r) { const int d0 = kb0 + crow(r, hi); \
                    if ((unsigned)d0 > 256u) c0[r] = NEG; if ((unsigned)(d0 + 32) > 256u) c1[r] = NEG; } } } \
          \
        const unsigned vb_ = lds0 + sm1 * SLOT + vfo, vc_ = lds0 + sm1 * SLOT + (vfo ^ 64u); const unsigned kb_ = lds0 + s1 * SLOT; \
        s16x4 vL[8], vH[8]; bf16x8 kF[2 * NKS]; \
        _Pragma("unroll") for (int m = 0; m < AHEAD; ++m) A_RD(m); \
        float rm; \
        { const float a0 = max3f(c0[0], c0[1], c0[2]), a1 = max3f(c0[3], c0[4], c0[5]), a2 = max3f(c0[6], c0[7], c0[8]), a3 = max3f(c0[9], c0[10], c0[11]), \
                      a4 = max3f(c0[12], c0[13], c0[14]), a5 = max3f(c0[15], c1[0], c1[1]), a6 = max3f(c1[2], c1[3], c1[4]), a7 = max3f(c1[5], c1[6], c1[7]), \
                      a8 = max3f(c1[8], c1[9], c1[10]), a9 = max3f(c1[11], c1[12], c1[13]), a10 = fmaxf(c1[14], c1[15]); \
          const float b0 = max3f(a0, a1, a2), b1 = max3f(a3, a4, a5), b2 = max3f(a6, a7, a8), b3 = fmaxf(a9, a10); \
          rm = xhalf_max(fmaxf(fmaxf(b0, b1), fmaxf(b2, b3))); } \
        if ((t) == 0 || __any(rm > THR)) {                   \
            const float dl = ((t) == 0) ? rm : fmaxf(rm, 0.f); const float f = __builtin_amdgcn_exp2f(-dl); \
            mref += dl; lsum *= f; \
            _Pragma("unroll") for (int r = 0; r < 16; ++r) { c0[r] -= dl; c1[r] -= dl; o0[r] *= f; o1[r] *= f; negm[r] -= dl; } \
            _Pragma("unroll") for (int i = 0; i < 16; ++i) pwO[i] = cvtpk(__uint_as_float(pwO[i] << 16) * f, __uint_as_float(pwO[i] & 0xffff0000u) * f); } \
        float acs0 = 0.f, acs1 = 0.f; SB0(); PT_B(4); PT_A(5); \
        _Pragma("unroll") for (int g = 0; g < NGT; ++g) { \
              \
            if (g + AHEAD < NG) A_RD(g + AHEAD); \
              \
            if (g < NG) { int n_ = 0; _Pragma("unroll") for (int m = g + 1; m <= g + AHEAD; ++m) if (m < NG) n_ += NRD(m); A_WT(g, n_); } \
              \
            if (g < 8) { typedef unsigned u4 __attribute__((ext_vector_type(4))); const int s = g >> 1; \
                const u4 pw4 = {pwO[4 * s], pwO[4 * s + 1], pwO[4 * s + 2], pwO[4 * s + 3]}; const bf16x8 pfr = __builtin_bit_cast(bf16x8, pw4); \
                const bf16x8 vf = (bf16x8){vL[g][0], vL[g][1], vL[g][2], vL[g][3], vH[g][0], vH[g][1], vH[g][2], vH[g][3]}; \
                if ((g & 1) == 0) o0 = __builtin_amdgcn_mfma_f32_32x32x16_bf16(vf, pfr, o0, 0, 0, 0); else o1 = __builtin_amdgcn_mfma_f32_32x32x16_bf16(vf, pfr, o1, 0, 0, 0); } \
            else if (g < NG) { const int q_ = g - 8, ks = q_ >> 1; \
                if ((q_ & 1) == 0) n0 = __builtin_amdgcn_mfma_f32_32x32x16_bf16(kF[q_], qf[ks], ks == 0 ? negm : n0, 0, 0, 0); \
                else               n1 = __builtin_amdgcn_mfma_f32_32x32x16_bf16(kF[q_], qf[ks], ks == 0 ? negm : n1, 0, 0, 0); } \
              \
            if (g < 16) { const float e0 = __builtin_amdgcn_exp2f(S_EL(c0, c1, 2 * g)), e1 = __builtin_amdgcn_exp2f(S_EL(c0, c1, 2 * g + 1)); \
                pwN[g] = cvtpk(e0, e1); \
                  \
                { float t_ = e0 + e1; asm volatile("" : "+v"(t_)); if ((g & 1) == 0) { acs0 += t_; asm volatile("" : "+v"(acs0)); } else { acs1 += t_; asm volatile("" : "+v"(acs1)); } } } \
            SB0(); \
        } \
        lsum += acs0 + acs1; PT_B(5); PT_A(3); \
          \
          \
        if (EVEN) { const int sp0 = (sl + PF >= R) ? sl + PF - R : sl + PF, sp1 = (sp0 + 1 == R) ? 0 : sp0 + 1; \
                    if (feed) A_DMA((t) + PF, sp0); if ((t) + PF + 1 < nt) A_DMA((t) + PF + 1, sp1); \
                    if ((t) + 1 >= nt) A_WAITBAR(0); } \
        else { if ((t) + PF < nt) A_WAITBAR(PF - 3); else A_WAITBAR(0); } PT_B(3); \
        sl = s1; \
    } while (0)
    { int t = 0;
      for (; t + 1 < nt; t += 2) { A_ITER(t, sA0, sA1, sB0, sB1, pwA, pwB, 1); A_ITER(t + 1, sB0, sB1, sA0, sA1, pwB, pwA, 0); }
      if (t < nt) { A_ITER(t, sA0, sA1, sB0, sB1, pwA, pwB, 1);
#pragma unroll
          for (int i = 0; i < 16; ++i) pwA[i] = pwB[i]; } }
    { const int sm1 = (sl == 0) ? R - 1 : sl - 1; const ldsp vb_ = lds + sm1 * SLOT + vfo, vc_ = lds + sm1 * SLOT + (vfo ^ 64u);
#pragma unroll
      for (int s = 0; s < 4; ++s) {
          typedef unsigned u4 __attribute__((ext_vector_type(4))); const u4 pw4 = {pwA[4 * s], pwA[4 * s + 1], pwA[4 * s + 2], pwA[4 * s + 3]}; const bf16x8 pfr = __builtin_bit_cast(bf16x8, pw4);
#pragma unroll
          for (int d0 = 0; d0 < 2; ++d0) { const ldsp vp = (d0 ? vc_ : vb_) + s * 2048;
              const s16x4 lo = __builtin_bit_cast(s16x4, __builtin_amdgcn_ds_read_tr16_b64_v4i16((LAS v4i16_t*)vp)), hi4 = __builtin_bit_cast(s16x4, __builtin_amdgcn_ds_read_tr16_b64_v4i16((LAS v4i16_t*)(vp + 1024)));
              const bf16x8 vf = (bf16x8){lo[0], lo[1], lo[2], lo[3], hi4[0], hi4[1], hi4[2], hi4[3]};
              if (d0 == 0) o0 = __builtin_amdgcn_mfma_f32_32x32x16_bf16(vf, pfr, o0, 0, 0, 0); else o1 = __builtin_amdgcn_mfma_f32_32x32x16_bf16(vf, pfr, o1, 0, 0, 0); }
          } }
    asm volatile("s_waitcnt lgkmcnt(0)\n\ts_barrier" ::: "memory");
#ifdef PROBE_T
    if (BR == PROBE_BR && P.o32 && blockIdx.x == 0 && wid == PROBE_W && lane == 0) {
        const unsigned long long t1 = __builtin_amdgcn_s_memtime(), r1 = __builtin_amdgcn_s_memrealtime();
        float c;
        if (PROBE_T == 1) c = 1e-5f * (float)(t1 - pt_t0) / (float)nt;
        else if (PROBE_T == 2) c = 1e-3f * (float)(t1 - pt_t0) / (float)(r1 - pt_r0);
        else c = 1e-5f * (float)pt_acc / (float)nt;
        P.o32[0] = 1.f + c;
    }
#endif
#undef S_EL
#undef SB0
#undef A_ITER
#undef A_RD
#undef NRD
#undef A_WT
#undef DSR128
#undef DSRTR
    float ltot = xhalf_sum(lsum);
    if (BR == 2) ltot += __builtin_amdgcn_exp2f(P.sink[head] * 1.4426950408889634f - mref);
    const float inv = 1.f / ltot;
#ifdef PROBE_ATTN
    if (P.o32 && b == 1 && (ctxq || tokq < 1024 || tokq >= 7168)) {
        const int sub = ctxq ? 2048 + tokq : (tokq < 1024 ? tokq : 1024 + tokq - 7168);
        float* fp = P.o32 + (size_t)sub * D + BR * 256 + head * 64 + 4 * hi;
#pragma unroll
        for (int g = 0; g < 4; ++g)
#pragma unroll
            for (int j = 0; j < 4; ++j) { fp[8 * g + j] = o0[4 * g + j] * inv; fp[32 + 8 * g + j] = o1[4 * g + j] * inv; }
    }
#endif
    T* op = P.O + qrow * D + BR * 256 + head * 64 + 4 * hi;
#pragma unroll
    for (int g = 0; g < 4; ++g) {
        *(uint2*)(op + 8 * g) = pk4(o0[4 * g] * inv, o0[4 * g + 1] * inv, o0[4 * g + 2] * inv, o0[4 * g + 3] * inv);
        *(uint2*)(op + 32 + 8 * g) = pk4(o1[4 * g] * inv, o1[4 * g + 1] * inv, o1[4 * g + 2] * inv, o1[4 * g + 3] * inv);
    }
#undef A_TROW
#undef A_DMA
#undef A_WAITBAR
#undef A_ACTIVE
#undef A_QK
#undef A_STEP
}

__device__ __forceinline__ void attn_phase(ldsp lds, const AttnP& P, int bid, int nblk) {
    for (int u = bid; u < 512; u += nblk) attn_unit<3>(lds, P, u >> 7, (u >> 5) & 3, (u & 31) * 256, false);
    for (int u = bid; u < 512; u += nblk) attn_unit<1>(lds, P, u >> 7, (u >> 6) & 1, (u & 63) * 128, false);
    for (int u = bid; u < 512; u += nblk) attn_unit_l<0>(lds, P, u >> 7, (u >> 5) & 3, (u & 31) * 256, false);
    for (int u = bid; u < 512; u += nblk) attn_unit<2>(lds, P, u >> 7, (u >> 6) & 1, (u & 63) * 128, false);
    if (P.need_ctx) {
        for (int u = bid; u < 64; u += nblk) {
            const int br = u >> 4, bb = (u >> 2) & 3, x = u & 3;
            if (br == 0) attn_unit_l<0>(lds, P, bb, x, 0, true);
            else if (br == 1) attn_unit<1>(lds, P, bb, x >> 1, (x & 1) * 128, true);
            else if (br == 2) attn_unit<2>(lds, P, bb, x >> 1, (x & 1) * 128, true);
            else attn_unit<3>(lds, P, bb, x, 0, true);
        }
    }
}

constexpr size_t al256(size_t b) { return (b + 255) & ~(size_t)255; }
constexpr size_t NSLOT_ = (size_t)NB * NE * (CAP + CAPC);
constexpr size_t OFF_BAR = 0, OFF_MODV = OFF_BAR + al256(3456 * 4), OFF_TAB64 = OFF_MODV + al256((size_t)NL * 5 * MODW * 4), OFF_TAB32 = OFF_TAB64 + al256(128 * 16 * 8),
    OFF_RA = OFF_TAB32 + al256(128 * 8 * 8), OFF_RC = OFF_RA + al256((size_t)NROW * D * 2), OFF_XCA = OFF_RC + al256((size_t)NROW * D * 2), OFF_XCB = OFF_XCA + al256((size_t)NCTX * D * 4),
    OFF_AFF = OFF_XCB + al256((size_t)NCTX * D * 4), OFF_IDX = OFF_AFF + al256((size_t)NROW * NE * 4), OFF_GATEV = OFF_IDX + al256(NSLOT_ * 4), OFF_INV = OFF_GATEV + al256(NSLOT_ * 4),
    OFF_Z = OFF_INV + al256((size_t)NROW * NE * 4), OFF_WINT = OFF_Z + al256((size_t)NROW * ZW * 2), OFF_WQT = OFF_WINT + al256((size_t)NL * 6400 * D * 2), OFF_WKVT = OFF_WQT + al256((size_t)NL * 384 * 192 * 2),
    OFF_SS = OFF_WKVT + al256((size_t)NL * 512 * 128 * 2), OFF_WBT = OFF_SS + al256((size_t)NROW * 8 * 4), OFF_WOUTT = OFF_WBT + al256((size_t)NL * 4 * 1024 * 256 * 2), OFF_END = OFF_WOUTT + al256((size_t)NL * D * D * 2);
struct MP {
    const float *x_, *c_, *ctx_, *c_ctx_, *w_mod_, *b_mod_, *w_in_, *na_rpb_, *gqn_, *gkn_, *swa_sink_, *mqn_, *mkvn_, *w_qb_, *w_kvb_, *w_branch_, *w_out_,
                *ln1g_, *ln1b_, *ln2g_, *ln2b_, *w_router_, *w_gate_, *w_up_, *w_down_;
    float* out_; char* ws_;
    float* o32_; const float* pscale_;
    int ph_lo_, ph_hi_;
    __device__ __forceinline__ const float* x() const { return x_; }
    __device__ __forceinline__ const float* c() const { return c_; }
    __device__ __forceinline__ const float* ctx() const { return ctx_; }
    __device__ __forceinline__ const float* c_ctx() const { return c_ctx_; }
    __device__ __forceinline__ const float* w_mod() const { return w_mod_; }
    __device__ __forceinline__ const float* b_mod() const { return b_mod_; }
    __device__ __forceinline__ const float* w_in() const { return w_in_; }
    __device__ __forceinline__ const float* na_rpb() const { return na_rpb_; }
    __device__ __forceinline__ const float* gqn() const { return gqn_; }
    __device__ __forceinline__ const float* gkn() const { return gkn_; }
    __device__ __forceinline__ const float* swa_sink() const { return swa_sink_; }
    __device__ __forceinline__ const float* mqn() const { return mqn_; }
    __device__ __forceinline__ const float* mkvn() const { return mkvn_; }
    __device__ __forceinline__ const float* w_qb() const { return w_qb_; }
    __device__ __forceinline__ const float* w_kvb() const { return w_kvb_; }
    __device__ __forceinline__ const float* w_branch() const { return w_branch_; }
    __device__ __forceinline__ const float* w_out() const { return w_out_; }
    __device__ __forceinline__ const float* ln1g() const { return ln1g_; }
    __device__ __forceinline__ const float* ln1b() const { return ln1b_; }
    __device__ __forceinline__ const float* ln2g() const { return ln2g_; }
    __device__ __forceinline__ const float* ln2b() const { return ln2b_; }
    __device__ __forceinline__ const float* w_router() const { return w_router_; }
    __device__ __forceinline__ const float* w_gate() const { return w_gate_; }
    __device__ __forceinline__ const float* w_up() const { return w_up_; }
    __device__ __forceinline__ const float* w_down() const { return w_down_; }
    __device__ __forceinline__ float* out() const { return out_; }
    __device__ __forceinline__ char* ws() const { return ws_; }
    __device__ __forceinline__ float* o32() const { return o32_; }
    __device__ __forceinline__ const float* pscale() const { return pscale_; }
    __device__ __forceinline__ int ph_lo() const { return ph_lo_; }
    __device__ __forceinline__ int ph_hi() const { return ph_hi_; }
    __device__ __forceinline__ unsigned* bar() const { return (unsigned*)(ws() + OFF_BAR); }
    __device__ __forceinline__ float* modv() const { return (float*)(ws() + OFF_MODV); }
    __device__ __forceinline__ float2* tab64() const { return (float2*)(ws() + OFF_TAB64); }
    __device__ __forceinline__ float2* tab32() const { return (float2*)(ws() + OFF_TAB32); }
    __device__ __forceinline__ T* RA() const { return (T*)(ws() + OFF_RA); }
    __device__ __forceinline__ T* RC() const { return (T*)(ws() + OFF_RC); }
    __device__ __forceinline__ float* XCa() const { return (float*)(ws() + OFF_XCA); }
    __device__ __forceinline__ float* XCb() const { return (float*)(ws() + OFF_XCB); }
    __device__ __forceinline__ float* AFF() const { return (float*)(ws() + OFF_AFF); }
    __device__ __forceinline__ int* IDX() const { return (int*)(ws() + OFF_IDX); }
    __device__ __forceinline__ float* GATEV() const { return (float*)(ws() + OFF_GATEV); }
    __device__ __forceinline__ int* INV() const { return (int*)(ws() + OFF_INV); }
    __device__ __forceinline__ T* Z() const { return (T*)(ws() + OFF_Z); }
    __device__ __forceinline__ T* WinT() const { return (T*)(ws() + OFF_WINT); }
    __device__ __forceinline__ T* WqT() const { return (T*)(ws() + OFF_WQT); }
    __device__ __forceinline__ T* WkvT() const { return (T*)(ws() + OFF_WKVT); }
    __device__ __forceinline__ float* SS() const { return (float*)(ws() + OFF_SS); }
    __device__ __forceinline__ T* WbT() const { return (T*)(ws() + OFF_WBT); }
    __device__ __forceinline__ T* WoutT() const { return (T*)(ws() + OFF_WOUTT); }
};

__device__ __forceinline__ void ph_mod(ldsp lds, const MP& p, int bid, int nblk) {
    LAS float* sc = (LAS float*)lds;
    LAS float* red = (LAS float*)(lds + 5 * 1024 * 4);
    const int tid = otid(), lane = tid & 63, kg = tid >> 6;
    for (int i = tid; i < 5 * 1024; i += 512) { const int s = i >> 10, k = i & 1023; const float v = s < 4 ? p.c()[s * 1024 + k] : p.c_ctx()[k]; sc[i] = v / (1.f + expf(-v)); }
    __syncthreads();
    for (int u = bid; u < NL * (MODW / 64); u += nblk) {
        const int l = u / (MODW / 64), j = (u % (MODW / 64)) * 64 + lane;
        float acc[5] = {0.f, 0.f, 0.f, 0.f, 0.f};
        const float* w = p.w_mod() + (size_t)l * D * MODW + j;
        for (int k = kg * 128; k < kg * 128 + 128; ++k) { const float wv = w[(size_t)k * MODW];
#pragma unroll
            for (int s = 0; s < 5; ++s) acc[s] += sc[s * 1024 + k] * wv; }
#pragma unroll
        for (int s = 0; s < 5; ++s) red[(kg * 5 + s) * 64 + lane] = acc[s];
        __syncthreads();
        if (kg < 5) { const int s = kg; float v = p.b_mod()[l * MODW + j];
#pragma unroll
            for (int g = 0; g < 8; ++g) v += red[(g * 5 + s) * 64 + lane];
            p.modv()[((size_t)l * 5 + s) * MODW + j] = v; }
        __syncthreads();
    }
}
__device__ __forceinline__ void ph_ropetab(const MP& p, int bid, int nblk) {
    for (int t = bid * 512 + otid(); t < 128 * 16; t += nblk * 512) {
        { const int pos = t / 16, i = t % 16; const float a = (float)pos * powf(10000.f, -(float)i / 16.f); p.tab64()[t] = make_float2(cosf(a), sinf(a)); }
        if (t < 128 * 8) { const int pos = t / 8, i = t % 8; const float a = (float)pos * powf(10000.f, -(float)i / 8.f); p.tab32()[t] = make_float2(cosf(a), sinf(a)); }
    }
}
struct PrepJob { const float* src; const float* src2; const float* kscale; T* dst; int K, Nsrc, Ndst, mode, nz, perm; long long src_zs, dst_zs, ks_zs; };
__device__ __forceinline__ void ph_wprep(ldsp lds, const PrepJob& a, int bid, int nblk) {
    constexpr int NT = 4;
    LAS float* tile = (LAS float*)lds;
    const int tid_ = otid();
    const int kr = tid_ >> 4, c4 = tid_ & 15;
    const int kq = tid_ & 7, nr = tid_ >> 3;
    const int nx = a.Ndst / 64, ny = a.K / 64, ntile = nx * ny * a.nz;
    float4 v0[NT], v1[NT];
#define WP_LOAD(i, u) do { const int z_ = (u) / (nx * ny), rem_ = (u) % (nx * ny), n0_ = (rem_ % nx) * 64, k0_ = (rem_ / nx) * 64; \
        const float* src_ = a.src + (size_t)z_ * a.src_zs; const float* ksc_ = a.kscale ? a.kscale + (size_t)z_ * a.ks_zs : nullptr; \
        int n_ = n0_ + 4 * c4; if (a.perm) { const int p_ = n_ & 255; n_ = (n_ & ~255) + 64 * ((p_ >> 5) & 3) + 32 * (p_ >> 7) + (p_ & 31); } bool valid_ = true; int col_ = n_; const float* sp_ = src_; \
        if (a.mode == 0) { valid_ = n_ < a.Nsrc; } \
        else if (a.mode == 1) { if (n_ < 2144) col_ = n_; else if (n_ < 2304) valid_ = false; else col_ = n_ - 160; } \
        else { const int j_ = n_ >> 6, w_ = n_ & 63; if (w_ >= 32) sp_ = a.src2 + (size_t)z_ * a.src_zs; col_ = 32 * j_ + (w_ & 31); } \
        v0[i] = make_float4(0.f, 0.f, 0.f, 0.f); v1[i] = v0[i]; \
        if (valid_) { v0[i] = *(const float4*)(sp_ + (size_t)(k0_ + kr) * a.Nsrc + col_); v1[i] = *(const float4*)(sp_ + (size_t)(k0_ + kr + 32) * a.Nsrc + col_); \
            if (ksc_) { const float s0_ = ksc_[k0_ + kr], s1_ = ksc_[k0_ + kr + 32]; v0[i].x *= s0_; v0[i].y *= s0_; v0[i].z *= s0_; v0[i].w *= s0_; v1[i].x *= s1_; v1[i].y *= s1_; v1[i].z *= s1_; v1[i].w *= s1_; } } } while (0)
    int u = bid, buf = 0;
#pragma unroll
    for (int i = 0; i < NT; ++i) { if (u + i * nblk < ntile) WP_LOAD(i, u + i * nblk); }
    for (; u < ntile; u += NT * nblk) {
        LAS float* tb = tile + buf * (NT * 64 * 65);
#pragma unroll
        for (int i = 0; i < NT; ++i) { if (u + i * nblk < ntile) { LAS float* w0 = tb + i * (64 * 65) + kr * 65 + 4 * c4; LAS float* w1 = w0 + 32 * 65;
            w0[0] = v0[i].x; w0[1] = v0[i].y; w0[2] = v0[i].z; w0[3] = v0[i].w; w1[0] = v1[i].x; w1[1] = v1[i].y; w1[2] = v1[i].z; w1[3] = v1[i].w; } }
        __syncthreads();
#pragma unroll
        for (int i = 0; i < NT; ++i) { const int un = u + (NT + i) * nblk; if (un < ntile) WP_LOAD(i, un); }
#pragma unroll
        for (int i = 0; i < NT; ++i) { const int ui = u + i * nblk; if (ui < ntile) {
            const int z = ui / (nx * ny), rem = ui % (nx * ny), n0 = (rem % nx) * 64, k0 = (rem / nx) * 64;
            T* dst = a.dst + (size_t)z * a.dst_zs;
            const LAS float* rp = tb + i * (64 * 65) + (kq * 8) * 65 + nr;
            *(uint4*)(dst + (size_t)(n0 + nr) * a.K + k0 + kq * 8) = make_uint4(pk2(rp[0], rp[65]), pk2(rp[130], rp[195]), pk2(rp[260], rp[325]), pk2(rp[390], rp[455])); } }
        buf ^= 1;
    }
#undef WP_LOAD
    __syncthreads();
}
__device__ __forceinline__ void lnmod_row(const float* src, const float* mv, int sh_off, int sc_off, T* dst, int lane) {
    float4 v[4]; float sum = 0.f;
#pragma unroll
    for (int i = 0; i < 4; ++i) { v[i] = *(const float4*)(src + i * 256 + lane * 4); sum += v[i].x + v[i].y + v[i].z + v[i].w; }
    const float mean = wave_sum(sum) * (1.f / D);
    float sq = 0.f;
#pragma unroll
    for (int i = 0; i < 4; ++i) { float a = v[i].x - mean, b = v[i].y - mean, c = v[i].z - mean, d = v[i].w - mean; sq += a * a + b * b + c * c + d * d; }
    const float rstd = 1.f / sqrtf(wave_sum(sq) * (1.f / D) + EPS);
#pragma unroll
    for (int i = 0; i < 4; ++i) {
        const int col = i * 256 + lane * 4;
        const float4 sh = *(const float4*)(mv + sh_off + col), sc = *(const float4*)(mv + sc_off + col);
        st4(dst + col, make_float4((v[i].x - mean) * rstd * (1.f + sc.x) + sh.x, (v[i].y - mean) * rstd * (1.f + sc.y) + sh.y,
                                   (v[i].z - mean) * rstd * (1.f + sc.z) + sh.z, (v[i].w - mean) * rstd * (1.f + sc.w) + sh.w));
    }
}
__device__ __forceinline__ void ph_lnmod0(const MP& p, int bid, int nblk) {
    const int tid_ = otid(); const int lane = tid_ & 63, wid = tid_ >> 6;
    for (int row = bid * 8 + wid; row < NROW; row += nblk * 8) {
        const bool lat = row < NLAT;
        const float* src = lat ? p.x() + (size_t)row * D : p.ctx() + (size_t)(row - NLAT) * D;
        const int s = lat ? row / SEQ : 4;
        lnmod_row(src, p.modv() + (size_t)s * MODW, 0, D, p.RA() + (size_t)row * D, lane);
    }
}
__device__ __forceinline__ void ph_lnres(ldsp lds, const MP& p, int l, int nrows, int bid, int nblk) {
    const int tid_ = otid(); const int lane = tid_ & 63, wid = tid_ >> 6;
    const float* modl = p.modv() + (size_t)l * 5 * MODW;
    const float* lgp = p.ln1g() + l * D; const float* lbp = p.ln1b() + l * D; const float* wr = p.w_router() + (size_t)l * D * NE;
    LAS float* WT = (LAS float*)lds;
    for (int i = tid_; i < NE * D; i += 512) { const int e = i >> 10, col = i & 1023; WT[i] = wr[col * NE + e]; }
    __syncthreads();
    const bool b5 = lane & 32, b4 = lane & 16, b3 = lane & 8, b2 = lane & 4;
    const int stride = nblk * 8;
    const float* xlat = l == 0 ? p.x() : p.out(); const float* xctx = l == 0 ? p.ctx() : p.XCb();
    float4 lgv[4], lbv[4], gv[4], shv[4], scv[4];
#pragma unroll
    for (int i = 0; i < 4; ++i) { lgv[i] = *(const float4*)(lgp + i * 256 + lane * 4); lbv[i] = *(const float4*)(lbp + i * 256 + lane * 4); }
    int cur_s = -1;
    int row = bid * 8 + wid;
    float4 xn[4]; uint2 yn[4];
#define LR_LOAD(r) do { const float* xs_ = (r) < NLAT ? xlat + (size_t)(r) * D : xctx + (size_t)((r) - NLAT) * D; const T* yp_ = p.RA() + (size_t)(r) * D; \
        _Pragma("unroll") for (int i = 0; i < 4; ++i) { xn[i] = *(const float4*)(xs_ + i * 256 + lane * 4); yn[i] = *(const uint2*)(yp_ + i * 256 + lane * 4); } } while (0)
    if (row < nrows) LR_LOAD(row);
    for (; row < nrows; row += stride) {
        float4 xc[4]; uint2 yc[4];
#pragma unroll
        for (int i = 0; i < 4; ++i) { xc[i] = xn[i]; yc[i] = yn[i]; }
        if (row + stride < nrows) LR_LOAD(row + stride);
        const bool lat = row < NLAT;
        float* xo = lat ? p.out() + (size_t)row * D : p.XCa() + (size_t)(row - NLAT) * D;
        const int s = lat ? row / SEQ : 4;
        if (s != cur_s) { cur_s = s; const float* mv = modl + (size_t)s * MODW;
#pragma unroll
            for (int i = 0; i < 4; ++i) { gv[i] = *(const float4*)(mv + 2 * D + i * 256 + lane * 4); shv[i] = *(const float4*)(mv + 3 * D + i * 256 + lane * 4); scv[i] = *(const float4*)(mv + 4 * D + i * 256 + lane * 4); } }
        float v[16]; float sum = 0.f;
#pragma unroll
        for (int i = 0; i < 4; ++i) {
            const float y0 = __uint_as_float(yc[i].x << 16), y1 = __uint_as_float(yc[i].x & 0xffff0000u), y2 = __uint_as_float(yc[i].y << 16), y3 = __uint_as_float(yc[i].y & 0xffff0000u);
            v[i * 4 + 0] = ALPHA * xc[i].x + gv[i].x * y0; v[i * 4 + 1] = ALPHA * xc[i].y + gv[i].y * y1; v[i * 4 + 2] = ALPHA * xc[i].z + gv[i].z * y2; v[i * 4 + 3] = ALPHA * xc[i].w + gv[i].w * y3;
            sum += v[i * 4] + v[i * 4 + 1] + v[i * 4 + 2] + v[i * 4 + 3];
        }
        const float mean = wave_sum(sum) * (1.f / D);
        float sq = 0.f;
#pragma unroll
        for (int i = 0; i < 16; ++i) { const float d = v[i] - mean; sq += d * d; }
        const float rstd = 1.f / sqrtf(wave_sum(sq) * (1.f / D) + EPS);
        float s2 = 0.f;
#pragma unroll
        for (int i = 0; i < 4; ++i) {
            v[i * 4 + 0] = (v[i * 4 + 0] - mean) * rstd * lgv[i].x + lbv[i].x; v[i * 4 + 1] = (v[i * 4 + 1] - mean) * rstd * lgv[i].y + lbv[i].y;
            v[i * 4 + 2] = (v[i * 4 + 2] - mean) * rstd * lgv[i].z + lbv[i].z; v[i * 4 + 3] = (v[i * 4 + 3] - mean) * rstd * lgv[i].w + lbv[i].w;
            *(float4*)(xo + i * 256 + lane * 4) = make_float4(v[i * 4], v[i * 4 + 1], v[i * 4 + 2], v[i * 4 + 3]);
            s2 += v[i * 4] + v[i * 4 + 1] + v[i * 4 + 2] + v[i * 4 + 3];
        }
        const float mean2 = wave_sum(s2) * (1.f / D);
        float sq2 = 0.f;
#pragma unroll
        for (int i = 0; i < 16; ++i) { const float d = v[i] - mean2; sq2 += d * d; }
        const float rstd2 = 1.f / sqrtf(wave_sum(sq2) * (1.f / D) + EPS);
        float h2[16];
#pragma unroll
        for (int i = 0; i < 4; ++i) {
            h2[i * 4 + 0] = (v[i * 4 + 0] - mean2) * rstd2 * (1.f + scv[i].x) + shv[i].x; h2[i * 4 + 1] = (v[i * 4 + 1] - mean2) * rstd2 * (1.f + scv[i].y) + shv[i].y;
            h2[i * 4 + 2] = (v[i * 4 + 2] - mean2) * rstd2 * (1.f + scv[i].z) + shv[i].z; h2[i * 4 + 3] = (v[i * 4 + 3] - mean2) * rstd2 * (1.f + scv[i].w) + shv[i].w;
            st4(p.RC() + (size_t)row * D + i * 256 + lane * 4, make_float4(h2[i * 4], h2[i * 4 + 1], h2[i * 4 + 2], h2[i * 4 + 3]));
        }
        float lg[16];
#pragma unroll
        for (int e = 0; e < 16; ++e) {
            float a = 0.f;
#pragma unroll
            for (int i = 0; i < 4; ++i) { const f32x4 w = *(const LAS f32x4*)(WT + e * D + i * 256 + lane * 4); a += h2[i * 4] * w.x + h2[i * 4 + 1] * w.y + h2[i * 4 + 2] * w.z + h2[i * 4 + 3] * w.w; }
            lg[e] = a;
            if (e & 1) __builtin_amdgcn_sched_barrier(0);
        }
        float a8[8], a4[4], a2[2];
#pragma unroll
        for (int k = 0; k < 8; ++k) {
            auto rr = __builtin_amdgcn_permlane32_swap(__float_as_uint(lg[k]), __float_as_uint(lg[8 + k]), false, false);
            a8[k] = __uint_as_float(rr[0]) + __uint_as_float(rr[1]); }
#pragma unroll
        for (int k = 0; k < 4; ++k) { const float mine = b4 ? a8[4 + k] : a8[k], oth = b4 ? a8[k] : a8[4 + k]; a4[k] = mine + __shfl_xor(oth, 16); }
#pragma unroll
        for (int k = 0; k < 2; ++k) { const float mine = b3 ? a4[2 + k] : a4[k], oth = b3 ? a4[k] : a4[2 + k]; a2[k] = mine + __shfl_xor(oth, 8); }
        float lgt = (b2 ? a2[1] : a2[0]) + __shfl_xor(b2 ? a2[0] : a2[1], 4);
        lgt = DPP_ADD(lgt, 0xB1); lgt = DPP_ADD(lgt, 0x4E);
        float mx = lgt;
        mx = fmaxf(mx, __shfl_xor(mx, 4)); mx = fmaxf(mx, __shfl_xor(mx, 8)); mx = fmaxf(mx, __shfl_xor(mx, 16)); mx = fmaxf(mx, __shfl_xor(mx, 32));
        const float ex = expf(lgt - mx);
        float den = ex;
        den += __shfl_xor(den, 4); den += __shfl_xor(den, 8); den += __shfl_xor(den, 16); den += __shfl_xor(den, 32);
        if ((lane & 3) == 0) p.AFF()[(size_t)row * NE + (lane >> 2)] = ex / den;
    }
#undef LR_LOAD
    __syncthreads();
}
__device__ __forceinline__ void ph_topk(ldsp lds, const MP& p, int nkinds, int bid, int nblk) {
    LAS unsigned* keys = (LAS unsigned*)lds;
    LAS unsigned* hist = (LAS unsigned*)(lds + 32768);
    LAS unsigned* part = (LAS unsigned*)(lds + 32768 + 8192);
    LAS unsigned* shv = (LAS unsigned*)(lds + 32768 + 8192 + 1024);
    const int tid = otid(), lane = tid & 63, wv = tid >> 6;
    for (int u = bid; u < NE * NB * nkinds; u += nblk) {
        const int e = u % NE, bl = (u / NE) % NB, kind = u / (NE * NB);
        const int n = kind ? CTX : SEQ, kk = kind ? CAPC : CAP;
        const size_t row0 = kind ? (size_t)NLAT + (size_t)bl * CTX : (size_t)bl * SEQ;
        const size_t grp = kind ? (size_t)NB * NE * CAP + ((size_t)e * NB + bl) * CAPC : ((size_t)bl * NE + e) * CAP;
        for (int i = tid; i < n; i += 512) keys[i] = __float_as_uint(p.AFF()[(row0 + i) * NE + e]);
        __syncthreads();
        unsigned prefix = 0, rem = kk;
        for (int pass = 0; pass < 3; ++pass) {
            const int shift = pass == 0 ? 21 : pass == 1 ? 10 : 0;
            const int nbm = pass == 2 ? 1023 : 2047;
            const int hshift = pass == 1 ? 21 : 10;
            for (int i = tid; i < 2048; i += 512) hist[i] = 0;
            __syncthreads();
            for (int i = tid; i < n; i += 512) { const unsigned k = keys[i]; const bool match = (pass == 0) || ((k >> hshift) == prefix); if (match) atomicAdd((unsigned*)&hist[(k >> shift) & nbm], 1u); }
            __syncthreads();
            unsigned loc = 0;
            if (tid < 256) { for (int j = 0; j < 8; ++j) loc += hist[tid * 8 + j]; part[tid] = loc; }
            __syncthreads();
            if (tid < 256) {
                unsigned above = 0;
                for (int j = tid + 1; j < 256; ++j) above += part[j];
                if (above < rem && above + loc >= rem) {
                    unsigned cum = above; int bsel = tid * 8 + 7;
                    for (; bsel >= tid * 8; --bsel) { const unsigned hc = hist[bsel]; if (cum + hc >= rem) break; cum += hc; }
                    shv[0] = (unsigned)bsel; shv[1] = rem - cum;
                }
            }
            __syncthreads();
            prefix = (pass == 0) ? shv[0] : ((prefix << (pass == 1 ? 11 : 10)) | shv[0]);
            rem = shv[1];
            __syncthreads();
        }
        const unsigned Tkey = prefix;
        unsigned base_gt = 0, base_eq = 0;
        for (int c0 = 0; c0 < n; c0 += 512) {
            const int i = c0 + tid; const bool inr = i < n;
            const unsigned k = inr ? keys[i] : 0u;
            const bool gt = inr && k > Tkey, eq = inr && k == Tkey;
            const unsigned long long mg = __ballot(gt), me = __ballot(eq);
            const unsigned long long lt = (1ull << lane) - 1ull;
            if (lane == 0) { shv[8 + wv] = __popcll(mg); shv[16 + wv] = __popcll(me); }
            __syncthreads();
            unsigned pg = base_gt + __popcll(mg & lt), pe = base_eq + __popcll(me & lt), tg = 0, te = 0;
            for (int w = 0; w < 8; ++w) { const unsigned a = shv[8 + w], b = shv[16 + w]; if (w < wv) { pg += a; pe += b; } tg += a; te += b; }
            const bool sel = gt || (eq && pe < rem);
            const unsigned slot = pg + min(pe, rem);
            if (inr) { if (sel) { p.IDX()[grp + slot] = (int)(row0 + i); p.GATEV()[grp + slot] = __uint_as_float(k); }
                       p.INV()[(row0 + i) * NE + e] = sel ? (int)slot : -1; }
            base_gt += tg; base_eq += te;
            __syncthreads();
        }
    }
}
__device__ __forceinline__ void ph_combine(const MP& p, int l, int nrows, const T* OUT, int bid, int nblk) {
    const int tid_ = otid(); const int lane = tid_ & 63, wid = tid_ >> 6;
    const float* modl = p.modv() + (size_t)l * 5 * MODW;
    const float* lgp = p.ln2g() + l * D; const float* lbp = p.ln2b() + l * D;
    const bool next = l + 1 < NL;
    const int stride = nblk * 8;
    float4 lgv[4], lbv[4], gv[4];
#pragma unroll
    for (int i = 0; i < 4; ++i) { lgv[i] = *(const float4*)(lgp + i * 256 + lane * 4); lbv[i] = *(const float4*)(lbp + i * 256 + lane * 4); }
    int cur_s = -1;
    int row = bid * 8 + wid;
    int sl_next = -1; float4 xn[4];
#define CB_LOAD(r) do { const float* xs_ = (r) < NLAT ? p.out() + (size_t)(r) * D : p.XCa() + (size_t)((r) - NLAT) * D; \
        _Pragma("unroll") for (int i = 0; i < 4; ++i) xn[i] = *(const float4*)(xs_ + i * 256 + lane * 4); \
        sl_next = lane < NE ? p.INV()[(size_t)(r) * NE + lane] : -1; } while (0)
    if (row < nrows) CB_LOAD(row);
    for (; row < nrows; row += stride) {
        float4 xc[4];
#pragma unroll
        for (int i = 0; i < 4; ++i) xc[i] = xn[i];
        const int slv = sl_next;
        if (row + stride < nrows) CB_LOAD(row + stride);
        const bool lat = row < NLAT;
        float* xo = lat ? p.out() + (size_t)row * D : p.XCb() + (size_t)(row - NLAT) * D;
        const int bl = lat ? row / SEQ : (row - NLAT) / CTX;
        const int s = lat ? bl : 4;
        if (s != cur_s) { cur_s = s; const float* mv = modl + (size_t)s * MODW;
#pragma unroll
            for (int i = 0; i < 4; ++i) gv[i] = *(const float4*)(mv + 5 * D + i * 256 + lane * 4); }
        unsigned long long mask = __ballot(slv >= 0) & 0xffffull;
        uint2 ob[4][4]; bool ok[4];
#pragma unroll
        for (int j = 0; j < 4; ++j) {
            ok[j] = mask != 0ull;
            if (ok[j]) {
                const int e = __builtin_ctzll(mask); mask &= mask - 1;
                const int sl = __builtin_amdgcn_readlane(slv, e);
                const size_t orow = lat ? ((size_t)bl * NE + e) * CAP + sl : (size_t)NB * NE * CAP + ((size_t)e * NB + bl) * CAPC + sl;
                const T* op = OUT + orow * D;
#pragma unroll
                for (int i = 0; i < 4; ++i) ob[j][i] = *(const uint2*)(op + i * 256 + lane * 4);
            } else {
#pragma unroll
                for (int i = 0; i < 4; ++i) ob[j][i] = make_uint2(0u, 0u);
            }
        }
        float y[16];
#pragma unroll
        for (int i = 0; i < 16; ++i) y[i] = 0.f;
#pragma unroll
        for (int j = 0; j < 4; ++j)
#pragma unroll
            for (int i = 0; i < 4; ++i) { y[i * 4] += __uint_as_float(ob[j][i].x << 16); y[i * 4 + 1] += __uint_as_float(ob[j][i].x & 0xffff0000u); y[i * 4 + 2] += __uint_as_float(ob[j][i].y << 16); y[i * 4 + 3] += __uint_as_float(ob[j][i].y & 0xffff0000u); }
        while (mask) {
            const int e = __builtin_ctzll(mask); mask &= mask - 1;
            const int sl = __builtin_amdgcn_readlane(slv, e);
            const size_t orow = lat ? ((size_t)bl * NE + e) * CAP + sl : (size_t)NB * NE * CAP + ((size_t)e * NB + bl) * CAPC + sl;
            const T* op = OUT + orow * D;
#pragma unroll
            for (int i = 0; i < 4; ++i) { const float4 o4 = ld4(op + i * 256 + lane * 4); y[i * 4] += o4.x; y[i * 4 + 1] += o4.y; y[i * 4 + 2] += o4.z; y[i * 4 + 3] += o4.w; }
        }
        float v[16]; float sum = 0.f;
#pragma unroll
        for (int i = 0; i < 4; ++i) {
            v[i * 4 + 0] = ALPHA * xc[i].x + gv[i].x * y[i * 4 + 0]; v[i * 4 + 1] = ALPHA * xc[i].y + gv[i].y * y[i * 4 + 1]; v[i * 4 + 2] = ALPHA * xc[i].z + gv[i].z * y[i * 4 + 2]; v[i * 4 + 3] = ALPHA * xc[i].w + gv[i].w * y[i * 4 + 3];
            sum += v[i * 4] + v[i * 4 + 1] + v[i * 4 + 2] + v[i * 4 + 3];
        }
        const float mean = wave_sum(sum) * (1.f / D);
        float sq = 0.f;
#pragma unroll
        for (int i = 0; i < 16; ++i) { const float d = v[i] - mean; sq += d * d; }
        const float rstd = 1.f / sqrtf(wave_sum(sq) * (1.f / D) + EPS);
        float s2 = 0.f;
#pragma unroll
        for (int i = 0; i < 4; ++i) {
            v[i * 4 + 0] = (v[i * 4 + 0] - mean) * rstd * lgv[i].x + lbv[i].x; v[i * 4 + 1] = (v[i * 4 + 1] - mean) * rstd * lgv[i].y + lbv[i].y;
            v[i * 4 + 2] = (v[i * 4 + 2] - mean) * rstd * lgv[i].z + lbv[i].z; v[i * 4 + 3] = (v[i * 4 + 3] - mean) * rstd * lgv[i].w + lbv[i].w;
            { const float ps_ = (!next && p.pscale()) ? p.pscale()[0] : 1.f;
              *(float4*)(xo + i * 256 + lane * 4) = make_float4(v[i * 4] * ps_, v[i * 4 + 1] * ps_, v[i * 4 + 2] * ps_, v[i * 4 + 3] * ps_); }
            s2 += v[i * 4] + v[i * 4 + 1] + v[i * 4 + 2] + v[i * 4 + 3];
        }
        if (next) {
            const float* mvn = p.modv() + ((size_t)(l + 1) * 5 + s) * MODW;
            const float mean2 = wave_sum(s2) * (1.f / D);
            float sq2 = 0.f;
#pragma unroll
            for (int i = 0; i < 16; ++i) { const float d = v[i] - mean2; sq2 += d * d; }
            const float rstd2 = 1.f / sqrtf(wave_sum(sq2) * (1.f / D) + EPS);
#pragma unroll
            for (int i = 0; i < 4; ++i) {
                const int col = i * 256 + lane * 4;
                const float4 sh = *(const float4*)(mvn + col), sc = *(const float4*)(mvn + D + col);
                st4(p.RA() + (size_t)row * D + col, make_float4((v[i * 4 + 0] - mean2) * rstd2 * (1.f + sc.x) + sh.x, (v[i * 4 + 1] - mean2) * rstd2 * (1.f + sc.y) + sh.y,
                                                             (v[i * 4 + 2] - mean2) * rstd2 * (1.f + sc.z) + sh.z, (v[i * 4 + 3] - mean2) * rstd2 * (1.f + sc.w) + sh.w));
            }
        }
    }
#undef CB_LOAD
}


#define XB_TMO      128
#define XB_XCNT(j)  (256  + 64 * (j))
#define XB_XSUB(j)  (1280 + 64 * (j))
#define XB_XGEN(j)  (2304 + 64 * (j))
#define XB_TOP      3328
#define XB_TOPGEN   3392
#define XCD_BAR_WORDS 3456
#define XB_SPIN_CAP (1u << 18)
__device__ __forceinline__ unsigned xb_ld(unsigned* p)              { return __hip_atomic_load(p, __ATOMIC_RELAXED, __HIP_MEMORY_SCOPE_AGENT); }
__device__ __forceinline__ unsigned xb_add(unsigned* p, unsigned v) { return __hip_atomic_fetch_add(p, v, __ATOMIC_RELAXED, __HIP_MEMORY_SCOPE_AGENT); }
__device__ __forceinline__ unsigned xb_xcc_id() { return (unsigned)__builtin_amdgcn_s_getreg((3 << 11) | 20) & 0xFu; }
#define XB_SPIN(cond, bar) do { unsigned _sp = 0; while (cond) { __builtin_amdgcn_s_sleep(1); \
    if ((++_sp & 255u) == 0u) { if (xb_ld(&(bar)[XB_TMO])) break; if (_sp > XB_SPIN_CAP) { atomicAdd(&(bar)[XB_TMO], 1u); break; } } } } while (0)
struct XcdBarrier { unsigned* bar; unsigned x; volatile LAS unsigned* st; };
__device__ __forceinline__ XcdBarrier xcd_barrier_post(unsigned* bar, volatile LAS unsigned* st) {
    XcdBarrier b; b.bar = bar; b.x = xb_xcc_id(); b.st = st;
    if (threadIdx.x == 0) (void)xb_add(&bar[XB_XCNT(b.x)], 1u);
    return b;
}
__device__ __forceinline__ void xcd_barrier_complete(unsigned* bar, unsigned x, unsigned& nloc, unsigned& nx) {
    const unsigned G = gridDim.x * gridDim.y * gridDim.z;
    unsigned sum, cnt, mine, sp = 0u;
    for (;;) {
        sum = 0u; cnt = 0u; mine = 0u;
#pragma unroll
        for (unsigned j = 0; j < 16; ++j) { const unsigned c = xb_ld(&bar[XB_XCNT(j)]); sum += c; cnt += (c > 0u) ? 1u : 0u; mine = (j == x) ? c : mine; }
        if (sum == G) break;
        __builtin_amdgcn_s_sleep(1);
        if ((++sp & 255u) == 0u) { if (xb_ld(&bar[XB_TMO])) break; if (sp > XB_SPIN_CAP) { atomicAdd(&bar[XB_TMO], 1u); break; } }
    }
    nloc = mine > 0u ? mine : 1u; nx = cnt > 0u ? cnt : 1u;
}
__device__ __forceinline__ void xcd_barrier(const XcdBarrier& b) {
    asm volatile("s_waitcnt vmcnt(0)" ::: "memory");
    __syncthreads();
    if (threadIdx.x == 0) {
        unsigned* bar = b.bar;
        __builtin_amdgcn_s_waitcnt(0);
        unsigned nloc = b.st[0], nx = b.st[1];
        if (nloc == 0u) { xcd_barrier_complete(bar, b.x, nloc, nx); b.st[0] = nloc; b.st[1] = nx; }
        const unsigned old = xb_add(&bar[XB_XSUB(b.x)], 1u);
        const unsigned gen = old / nloc;
        if (old + 1u == (gen + 1u) * nloc) {
            __builtin_amdgcn_fence(__ATOMIC_RELEASE, "agent");
            asm volatile("s_waitcnt vmcnt(0)" ::: "memory");
            const unsigned og = xb_add(&bar[XB_TOP], 1u);
            const unsigned tg = og / nx;
            if (og + 1u == (tg + 1u) * nx) xb_add(&bar[XB_TOPGEN], 1u);
            else XB_SPIN(xb_ld(&bar[XB_TOPGEN]) == tg, bar);
            __builtin_amdgcn_fence(__ATOMIC_ACQUIRE, "agent");
            xb_add(&bar[XB_XGEN(b.x)], 1u);
            asm volatile("s_waitcnt vmcnt(0)" ::: "memory");
        } else {
            XB_SPIN(xb_ld(&bar[XB_XGEN(b.x)]) == gen, bar);
            __builtin_amdgcn_fence(__ATOMIC_ACQUIRE, "agent");
            asm volatile("s_waitcnt vmcnt(0)" ::: "memory");
        }
    }
    __syncthreads();
}

#ifdef PROBE_L0
__global__ void __launch_bounds__(256) k_cmp2(const float* a, const float* b, size_t n, float* acc, int slot) {
    float num = 0.f, den = 0.f;
    for (size_t i = (size_t)blockIdx.x * 256 + threadIdx.x; i < n; i += (size_t)gridDim.x * 256) { const float x = a[i], y = b[i]; num += (x - y) * (x - y); den += y * y; }
    __shared__ float sn[256], sd[256]; sn[threadIdx.x] = num; sd[threadIdx.x] = den; __syncthreads();
    for (int s = 128; s > 0; s >>= 1) { if (threadIdx.x < s) { sn[threadIdx.x] += sn[threadIdx.x + s]; sd[threadIdx.x] += sd[threadIdx.x + s]; } __syncthreads(); }
    if (threadIdx.x == 0) { atomicAdd(&acc[slot], sn[0]); atomicAdd(&acc[4 + slot], sd[0]); }
}
__global__ void k_fin2(const float* acc, float* scale, int which) { float e = acc[which] / acc[4 + which]; if (!(e == e)) e = 1.f; scale[0] = 1.f + sqrtf(e) * 100.f; }
#endif
constexpr int LDS_TOTAL = 159744 + 64 + 256;
static_assert(ATT_LDS <= 159744, "attention LDS");
constexpr size_t NSLOT = (size_t)NB * NE * (CAP + CAPC);
constexpr int NPHASE = 2 + 11 * NL;
__global__ void __launch_bounds__(512, 2) k_mega(MP p) {
    extern __shared__ __attribute__((aligned(16))) unsigned char dynlds[];
    const ldsp lds = (ldsp)dynlds;
    const int bid0 = blockIdx.x, nblk0 = gridDim.x;

    volatile LAS unsigned* xbw = (volatile LAS unsigned*)(lds + 159744);
    if (threadIdx.x == 0) { xbw[0] = 0u; xbw[1] = 0u; xbw[2] = 0u; xbw[3] = 0u; }
    __syncthreads();
    const XcdBarrier bar = xcd_barrier_post(p.bar(), xbw);
    int g = 0;
#ifndef REP_MASK
#define REP_MASK 0
#endif
#define PH(kind, ...) if (g >= p.ph_lo() && g < p.ph_hi()) { int bid = bid0, nblk = nblk0; asm volatile("" : "+s"(bid), "+s"(nblk));     \
    __VA_ARGS__ if (((REP_MASK >> (kind)) & 1) && ((kind) != 5 || g < 13)) { xcd_barrier(bar); __VA_ARGS__ } if (g + 1 < p.ph_hi()) xcd_barrier(bar); } ++g;
#define bH (p.RA())
#define bO (p.RA())
#define bY (p.RA())
#define bQM (p.RC())
#define bKVM (p.RC() + (size_t)NROW * 384)
#define bMERGED (p.RC())
#define bH2 (p.RC())
#define bACT (p.Z())
#define bOUT (p.Z() + NSLOT * FF)
#define bXG (p.Z() + NSLOT * FF)
#define bWguT (p.Z() + 2 * NSLOT * FF)
#define bWdT (p.Z() + 2 * NSLOT * FF + (size_t)NE * 2048 * 1024)
    if ((REP_MASK >> 14) & 1) { for (int i = 0; i < 20; ++i) xcd_barrier(bar); }
    PH(12,
        ph_mod(lds, p, bid, nblk);
        ph_ropetab(p, bid, nblk);
        { PrepJob j{}; j.src = p.w_in(); j.dst = p.WinT(); j.K = D; j.Nsrc = INW; j.Ndst = ZWP; j.mode = 1; j.perm = 1; j.nz = NL; j.src_zs = (long long)D * INW; j.dst_zs = (long long)ZWP * D; ph_wprep(lds, j, bid, nblk); }
        { PrepJob j{}; j.src = p.w_qb(); j.kscale = p.mqn(); j.dst = p.WqT(); j.K = 192; j.Nsrc = 384; j.Ndst = 384; j.mode = 0; j.nz = NL; j.src_zs = 192 * 384; j.dst_zs = 384 * 192; j.ks_zs = 192; ph_wprep(lds, j, bid, nblk); }
        { PrepJob j{}; j.src = p.w_kvb(); j.kscale = p.mkvn(); j.dst = p.WkvT(); j.K = 128; j.Nsrc = 512; j.Ndst = 512; j.mode = 0; j.nz = NL; j.src_zs = 128 * 512; j.dst_zs = 512 * 128; j.ks_zs = 128; ph_wprep(lds, j, bid, nblk); }
        { PrepJob j{}; j.src = p.w_branch(); j.dst = p.WbT(); j.K = 256; j.Nsrc = 1024; j.Ndst = 1024; j.mode = 0; j.nz = NL * 4; j.src_zs = 256 * 1024; j.dst_zs = 1024 * 256; ph_wprep(lds, j, bid, nblk); }
        { PrepJob j{}; j.src = p.w_out(); j.dst = p.WoutT(); j.K = 1024; j.Nsrc = 1024; j.Ndst = 1024; j.mode = 0; j.perm = 1; j.nz = NL; j.src_zs = 1024 * 1024; j.dst_zs = 1024 * 1024; ph_wprep(lds, j, bid, nblk); }
    )
    PH(13, ph_lnmod0(p, bid, nblk);)
    for (int l = 0; l < NL; ++l) {
        const bool need_ctx = l + 1 < NL; const int mrows = need_ctx ? NROW : NLAT;
        PH(0, { InProj8S sc{}; sc.H = bH; sc.Wt = p.WinT() + (size_t)l * ZWP * D; sc.npm = NROW / 256; sc.bid = bid; sc.nblk = nblk; sc.nun = need_ctx ? 3300 : 3200 + 36;
                InProj8E ep{}; ep.Z = p.Z(); ep.SS = p.SS(); ep.gqn = p.gqn() + l * 64; ep.gkn = p.gkn() + l * 64; ep.tab64 = p.tab64(); ep.tab32 = p.tab32();
                pg8::gemm_phase<InProj8E, InProj8S, true, true>(lds, D, sc, ep); } )
        PH(1, { MlaProj pb{}; pb.Z = p.Z(); pb.WqT = p.WqT() + (size_t)l * 384 * 192; pb.WkvT = p.WkvT() + (size_t)l * 512 * 128; pb.QM = bQM; pb.KVM = bKVM; pb.SS = p.SS(); pb.tab32 = p.tab32(); pb.nlat = NLAT; pb.npm = NROW / 256;
                   gemm_run<128, false>(lds, pb, bid, nblk); } )
        PH(2, { AttnP ap{}; ap.Z = p.Z(); ap.QM = bQM; ap.KVM = bKVM; ap.O = bO; ap.rpb = p.na_rpb() + (size_t)l * 4 * 15 * 31; ap.sink = p.swa_sink() + l * 4; ap.nlat = NLAT; ap.need_ctx = need_ctx ? 1 : 0; ap.o32 = (l == 0) ? p.o32() : nullptr; ap.fake = 0;
#ifdef PROBE_F
                   if (l == 0) { ap.fake = PROBE_F; attn_phase(lds, ap, bid, nblk); ap.fake = 0; ap.o32 = nullptr; }
#endif
                   attn_phase(lds, ap, bid, nblk); } )
        PH(3, { MergeProb pb{}; pb.O = bO; pb.WbT = p.WbT() + (size_t)l * 4 * 1024 * 256; pb.Z = p.Z(); pb.MERGED = bMERGED; pb.npm = mrows / 256; gemm_run<128, true>(lds, pb, bid, nblk); } )
        PH(4, { Plain8S sc{}; sc.A = bMERGED; sc.Bt = p.WoutT() + (size_t)l * D * D; sc.npm = mrows / 256; sc.npn = 4; sc.K = D; sc.bid = bid; sc.nblk = nblk; Plain8E ep{}; ep.C = bY; ep.ldc = D;
                pg8::gemm_phase<Plain8E, Plain8S, true, true>(lds, D, sc, ep); } )
        PH(5, ph_lnres(lds, p, l, mrows, bid, nblk); )
        PH(6,
            ph_topk(lds, p, need_ctx ? 2 : 1, bid, nblk);
            { const bool split = nblk > 2 * NE * NB; const int pb_ = split ? bid - NE * NB : bid, pn_ = split ? nblk - NE * NB : nblk;
              if (pb_ >= 0) {
            { PrepJob j{}; j.src = p.w_gate() + (size_t)l * NE * D * FF; j.src2 = p.w_up() + (size_t)l * NE * D * FF; j.dst = bWguT; j.K = 1024; j.Nsrc = 1024; j.Ndst = 2048; j.mode = 2; j.perm = 1; j.nz = NE; j.src_zs = (long long)D * FF; j.dst_zs = (long long)2048 * 1024; ph_wprep(lds, j, pb_, pn_); }
            { PrepJob j{}; j.src = p.w_down() + (size_t)l * NE * FF * D; j.dst = bWdT; j.K = 1024; j.Nsrc = 1024; j.Ndst = 1024; j.mode = 0; j.perm = 1; j.nz = NE; j.src_zs = (long long)FF * D; j.dst_zs = (long long)1024 * 1024; ph_wprep(lds, j, pb_, pn_); }
              } }
        )
        PH(10, ph_gather(bH2, p.IDX(), bXG, need_ctx ? (int)NSLOT : CTXB, bid, nblk); )
        PH(7, { FfnUp8S sc{}; sc.XG = bXG; sc.WguT = bWguT; sc.nun = 2048 + (need_ctx ? 128 : 0); sc.bid = bid; sc.nblk = nblk; FfnUp8E ep{}; ep.ACT = bACT;
                pg8::gemm_phase<FfnUp8E, FfnUp8S, true, true>(lds, D, sc, ep); } )
        PH(8, { FfnDown8S sc{}; sc.ACT = bACT; sc.WdT = bWdT; sc.nun = 1024 + (need_ctx ? 64 : 0); sc.bid = bid; sc.nblk = nblk; FfnDown8E ep{}; ep.GATEV = p.GATEV(); ep.OUT = bOUT;
                pg8::gemm_phase<FfnDown8E, FfnDown8S, true, true>(lds, FF, sc, ep); } )
        PH(9, ph_combine(p, l, mrows, bOUT, bid, nblk); )
    }
#undef PH
#undef bH
#undef bO
#undef bY
#undef bQM
#undef bKVM
#undef bMERGED
#undef bH2
#undef bACT
#undef bOUT
#undef bXG
#undef bWguT
#undef bWdT
}
}

extern "C" void kernel_launch(void* const* d_in, const int* in_sizes, int n_in, void* d_out, int out_size, void* d_ws, size_t ws_size, hipStream_t stream) {
    MP p; memset(&p, 0, sizeof(p));
    p.x_ = (const float*)d_in[0]; p.c_ = (const float*)d_in[1]; p.ctx_ = (const float*)d_in[2]; p.c_ctx_ = (const float*)d_in[3];
    p.w_mod_ = (const float*)d_in[4]; p.b_mod_ = (const float*)d_in[5]; p.w_in_ = (const float*)d_in[6]; p.na_rpb_ = (const float*)d_in[7];
    p.gqn_ = (const float*)d_in[8]; p.gkn_ = (const float*)d_in[9]; p.swa_sink_ = (const float*)d_in[10];
    p.mqn_ = (const float*)d_in[11]; p.mkvn_ = (const float*)d_in[12]; p.w_qb_ = (const float*)d_in[13]; p.w_kvb_ = (const float*)d_in[14];
    p.w_branch_ = (const float*)d_in[15]; p.w_out_ = (const float*)d_in[16];
    p.ln1g_ = (const float*)d_in[17]; p.ln1b_ = (const float*)d_in[18]; p.ln2g_ = (const float*)d_in[19]; p.ln2b_ = (const float*)d_in[20];
    p.w_router_ = (const float*)d_in[21]; p.w_gate_ = (const float*)d_in[22]; p.w_up_ = (const float*)d_in[23]; p.w_down_ = (const float*)d_in[24];
    p.out_ = (float*)d_out;
    char* ws = (char*)d_ws; size_t off = OFF_END;
    auto carve = [&](size_t bytes) { void* q = ws + off; off += (bytes + 255) & ~(size_t)255; return q; }; (void)carve;
    p.ws_ = ws;
    if (off > ws_size || 2 * NSLOT * FF + (size_t)NE * 3072 * 1024 > (size_t)NROW * ZW) { fprintf(stderr, "workspace too small: need %zu have %zu\n", off, ws_size); return; }
    static int grid = 0;
    if (!grid) {
        int dev = 0, cus = 0, per_cu = 0;
        (void)hipGetDevice(&dev);
        (void)hipDeviceGetAttribute(&cus, hipDeviceAttributeMultiprocessorCount, dev);
        (void)hipFuncSetAttribute((const void*)k_mega, hipFuncAttributeMaxDynamicSharedMemorySize, LDS_TOTAL);
        (void)hipOccupancyMaxActiveBlocksPerMultiprocessor(&per_cu, (const void*)k_mega, 512, LDS_TOTAL);
        grid = per_cu >= 1 ? cus : 0;
        if (grid > 256) grid = 256;
    }
    if (!grid) { fprintf(stderr, "k_mega cannot be resident\n"); return; }
    (void)hipMemsetAsync(ws + OFF_BAR, 0, XCD_BAR_WORDS * 4, stream);
#ifdef PROBE_L0
    {
        float* save_xc = (float*)carve((size_t)NCTX * D * 4); float* save_x = (float*)carve((size_t)2048 * D * 4); float* pacc = (float*)carve(256); float* pscl = (float*)carve(256);
        if (off > ws_size) { fprintf(stderr, "probe workspace\n"); return; }
        nv::nv_layer0(d_in, d_out, d_ws, ws_size, stream, save_xc, save_x);
        (void)hipMemsetAsync(ws + OFF_BAR, 0, XCD_BAR_WORDS * 4, stream);
        (void)hipMemsetAsync(pacc, 0, 256, stream);
        p.pscale_ = pscl;
        p.ph_lo_ = 0; p.ph_hi_ = 2 + (NPHASE - 2) / NL;
        hipLaunchKernelGGL(k_mega, dim3(grid), dim3(512), LDS_TOTAL, stream, p);
        hipLaunchKernelGGL(k_cmp2, dim3(256), dim3(256), 0, stream, (const float*)(ws + OFF_XCB), (const float*)save_xc, (size_t)NCTX * D, pacc, 0);
        for (int b = 0; b < NB; ++b) hipLaunchKernelGGL(k_cmp2, dim3(256), dim3(256), 0, stream, (const float*)d_out + (size_t)b * SEQ * D, (const float*)save_x + (size_t)b * 512 * D, (size_t)512 * D, pacc, 1);
        hipLaunchKernelGGL(k_fin2, dim3(1), dim3(1), 0, stream, pacc, pscl, (int)PROBE_L0);
        (void)hipMemsetAsync(ws + OFF_BAR, 0, XCD_BAR_WORDS * 4, stream);
        p.ph_lo_ = 2 + (NPHASE - 2) / NL; p.ph_hi_ = NPHASE;
        hipLaunchKernelGGL(k_mega, dim3(grid), dim3(512), LDS_TOTAL, stream, p);
    }
#elif defined(PROBE_ATTN)
    {
        float* O32 = (float*)carve((size_t)2304 * D * 4); float* O2 = (float*)carve((size_t)2304 * D * 4); float* pacc = (float*)carve(256); float* pscl = (float*)carve(256);
        if (off > ws_size) { fprintf(stderr, "probe workspace\n"); return; }
        p.o32_ = O32; p.pscale_ = pscl;
        (void)hipMemsetAsync(pacc, 0, 256, stream);
        p.ph_lo_ = 0; p.ph_hi_ = 5;
        hipLaunchKernelGGL(k_mega, dim3(grid), dim3(512), LDS_TOTAL, stream, p);
        AttnArgs a{}; a.Z = (const T*)(ws + OFF_Z); a.QM = (const T*)(ws + OFF_RC); a.KVM = (const T*)(ws + OFF_RC) + (size_t)NROW * 384; a.O2 = O2; a.rpb = p.na_rpb_; a.sink = p.swa_sink_; a.P.nbp = NB; a.P.b0 = 0; a.P.nlat = NLAT; a.P.nctx = NCTX; a.P.nrow = NROW; a.bl0 = 1;
        a.ctxq = 0; { dim3 g(8, 4, 1); hipLaunchKernelGGL(k_attn_naive<0>, g, dim3(256), 0, stream, a); hipLaunchKernelGGL(k_attn_naive<1>, g, dim3(256), 0, stream, a);
                      hipLaunchKernelGGL(k_attn_naive<2>, g, dim3(256), 0, stream, a); hipLaunchKernelGGL(k_attn_naive<3>, g, dim3(256), 0, stream, a); }
        a.ctxq = 1; { dim3 g(1, 4, 1); hipLaunchKernelGGL(k_attn_naive<0>, g, dim3(256), 0, stream, a); hipLaunchKernelGGL(k_attn_naive<1>, g, dim3(256), 0, stream, a);
                      hipLaunchKernelGGL(k_attn_naive<2>, g, dim3(256), 0, stream, a); hipLaunchKernelGGL(k_attn_naive<3>, g, dim3(256), 0, stream, a); }
        hipLaunchKernelGGL(k_probe_cmp, dim3(64, 4), dim3(256), 0, stream, O32, O2, pacc, 2304);
        hipLaunchKernelGGL(k_probe_fin, dim3(1), dim3(1), 0, stream, pacc, pscl, (int)PROBE_ATTN);
        (void)hipMemsetAsync(ws + OFF_BAR, 0, XCD_BAR_WORDS * 4, stream);
        p.ph_lo_ = 5; p.ph_hi_ = NPHASE;
        hipLaunchKernelGGL(k_mega, dim3(grid), dim3(512), LDS_TOTAL, stream, p);
    }
#elif defined(PROBE_T)
    {
        float* pscl = (float*)carve(256);
        if (off > ws_size) { fprintf(stderr, "probe workspace\n"); return; }
        p.o32_ = pscl; p.pscale_ = pscl;
        p.ph_lo_ = 0; p.ph_hi_ = NPHASE;
        hipLaunchKernelGGL(k_mega, dim3(grid), dim3(512), LDS_TOTAL, stream, p);
    }
#elif !defined(MK_SPLIT)
    p.ph_lo_ = 0; p.ph_hi_ = NPHASE;
    hipLaunchKernelGGL(k_mega, dim3(grid), dim3(512), LDS_TOTAL, stream, p);
#else
    for (int g = 0; g < NPHASE; ++g) { p.ph_lo_ = g; p.ph_hi_ = g + 1; hipLaunchKernelGGL(k_mega, dim3(grid), dim3(512), LDS_TOTAL, stream, p); }
#endif
}
```

```cpp
#include <hip/hip_runtime.h>
#include <hip/hip_bf16.h>
#include <stdint.h>
#include <stdio.h>
#include <string.h>

namespace {
constexpr int D = 1024, SEQ = 8192, CTX = 256, NB = 4, NL = 2, HD = 64;
constexpr int GW = 64, GROWS = 128;
constexpr int INW = 6240;
constexpr int ZW = 6240;
constexpr int NAQ = 0, NAK = 256, NAV = 512, GQ = 768, GK = 1024, GV = 1152, SQ = 1280, SK = 1536, SV = 1664,
              MCQ = 1792, MCKV = 1984, MKR = 2112, GATE = 2144;
constexpr int NE = 16, FF = 1024, CAP = 1024, CAPC = 32;
constexpr int MODW = 6 * D;
constexpr float EPS = 1e-6f;
constexpr float ALPHA = 1.4142135623730951f;
constexpr int NLAT = NB * SEQ, NCTX = NB * CTX, NROW = NLAT + NCTX;

struct T {
    unsigned short u;
    __device__ __forceinline__ operator float() const { return __uint_as_float((unsigned)u << 16); }
    __device__ __forceinline__ T& operator=(float f) { unsigned b = __float_as_uint(f); b += 0x7fffu + ((b >> 16) & 1u); u = (unsigned short)(b >> 16); return *this; }
};
__device__ __forceinline__ float4 ld4(const float* p) { return *(const float4*)p; }
__device__ __forceinline__ float4 ld4(const T* p) { uint2 r = *(const uint2*)p; return make_float4(__uint_as_float(r.x << 16), __uint_as_float(r.x & 0xffff0000u), __uint_as_float(r.y << 16), __uint_as_float(r.y & 0xffff0000u)); }
__device__ __forceinline__ unsigned pk2(float lo, float hi) { T a, b; a = lo; b = hi; return (unsigned)a.u | ((unsigned)b.u << 16); }
__device__ __forceinline__ void st4(float* p, float4 v) { *(float4*)p = v; }
__device__ __forceinline__ void st4(T* p, float4 v) { *(uint2*)p = make_uint2(pk2(v.x, v.y), pk2(v.z, v.w)); }

__device__ __forceinline__ int otid() { int t = threadIdx.x; asm volatile("" : "+v"(t)); return t; }
__device__ __forceinline__ int xswz(int u, int n) { const int c = u & 7, s = u >> 3, q = n >> 3, rr = n & 7; return (c < rr ? c * (q + 1) : rr * (q + 1) + (c - rr) * q) + s; }
#define DPP_ADD(v, ctrl) ((v) + __builtin_bit_cast(float, __builtin_amdgcn_update_dpp(0, __builtin_bit_cast(int, (v)), (ctrl), 0xf, 0xf, true)))
__device__ __forceinline__ float wave_sum(float v) {
    v = DPP_ADD(v, 0xB1);
    v = DPP_ADD(v, 0x4E);
    v = DPP_ADD(v, 0x141);
    v = DPP_ADD(v, 0x140);
    const int iv = __builtin_bit_cast(int, v);
    const float r0 = __builtin_bit_cast(float, __builtin_amdgcn_readlane(iv, 0)), r1 = __builtin_bit_cast(float, __builtin_amdgcn_readlane(iv, 16)),
                r2 = __builtin_bit_cast(float, __builtin_amdgcn_readlane(iv, 32)), r3 = __builtin_bit_cast(float, __builtin_amdgcn_readlane(iv, 48));
    return (r0 + r1) + (r2 + r3);
}

typedef short bf16x8 __attribute__((ext_vector_type(8)));
typedef float f32x4 __attribute__((ext_vector_type(4)));
#define LAS __attribute__((address_space(3)))
typedef LAS unsigned char* ldsp;
constexpr int ZWP = 6400;

__device__ __forceinline__ float fast_rsqrt(float x) { return __builtin_amdgcn_rsqf(x); }
__device__ __forceinline__ float fast_sigmoid(float x) { return __builtin_amdgcn_rcpf(1.f + __builtin_amdgcn_exp2f(-1.4426950408889634f * x)); }
__device__ __forceinline__ float fast_silu(float x) { return x * fast_sigmoid(x); }
__device__ __forceinline__ uint2 pk4(float a, float b, float c, float d) { return make_uint2(pk2(a, b), pk2(c, d)); }

#define GLDS16(gp, lp) __builtin_amdgcn_global_load_lds((const unsigned*)(gp), (LAS unsigned*)(lp), 16, 0, 0)
template <int BN, bool HAS_SUM, class Prob>
__device__ __forceinline__ void gemm_run(ldsp lds, const Prob& pb, int bid, int nblk) {
    constexpr int NF = BN / 64, GLB = BN / 64, A_BYTES = 32768, B_BYTES = BN * 128, STAGE = A_BYTES + B_BYTES, NSTG = (BN == 128) ? 3 : 2, NGL = 4 + GLB;
    const int tid = otid(), wid = __builtin_amdgcn_readfirstlane(tid >> 6), lane = tid & 63, wr = wid >> 2, wc = wid & 3, fr = lane & 15, fq = lane >> 4;
    const int NU = pb.nunits();
    if (bid >= NU) return;
    const int sb = lane * 16, swz = sb ^ (((sb >> 9) & 1) << 5);
    const int sR0 = (wid >> 1) * 16 + (swz >> 6), sC = (wid & 1) * 32 + ((swz & 63) >> 1);
    const int ob = fr * 64 + fq * 16, lane_off = ob ^ (((ob >> 9) & 1) << 5);
    const unsigned ldsw = (unsigned)wid * 1024u;
    unsigned aoff[4], boff[GLB];
    int su = bid, st = 0, snt = pb.ntiles(su), sbuf = 0, inflight = 0;
#define G_LOAD_OFFS() do { _Pragma("unroll") for (int i = 0; i < 4; ++i) aoff[i] = pb.a_off(su, sR0 + 64 * i) + sC; \
                           _Pragma("unroll") for (int i = 0; i < GLB; ++i) boff[i] = pb.b_off(su, sR0 + 64 * i) + sC; } while (0)
#define G_STAGE() do { if (su < NU) { const T* Ab = pb.a_base(su, st); const T* Bb = pb.b_base(su, st); ldsp sbase = lds + sbuf * STAGE + ldsw; \
        _Pragma("unroll") for (int i = 0; i < 4; ++i) GLDS16(Ab + aoff[i], sbase + i * 8192); \
        _Pragma("unroll") for (int i = 0; i < GLB; ++i) GLDS16(Bb + boff[i], sbase + A_BYTES + i * 8192); \
        ++inflight; sbuf = (sbuf + 1 == NSTG) ? 0 : sbuf + 1; \
        if (++st == snt) { su += nblk; st = 0; if (su < NU) { snt = pb.ntiles(su); G_LOAD_OFFS(); } } } } while (0)
    G_LOAD_OFFS();
    G_STAGE();
    if (NSTG == 3) G_STAGE();
    int buf = 0;
    for (int cu = bid; cu < NU; cu += nblk) {
        f32x4 acc[8][NF]; f32x4 sum[HAS_SUM ? 8 : 1][HAS_SUM ? NF : 1]; uint2 gpre[HAS_SUM ? 8 : 1][HAS_SUM ? NF : 1];
#pragma unroll
        for (int m = 0; m < 8; ++m)
#pragma unroll
            for (int n = 0; n < NF; ++n) { acc[m][n] = (f32x4){0.f, 0.f, 0.f, 0.f}; if (HAS_SUM) sum[m][n] = (f32x4){0.f, 0.f, 0.f, 0.f}; }
        const int nt = pb.ntiles(cu);
        for (int t = 0; t < nt; ++t) {
            if (NSTG == 3) {
                if constexpr (HAS_SUM) { if (inflight >= 2) { if (pb.extra_inflight(t)) asm volatile("s_waitcnt vmcnt(%0)" :: "n"(NGL + 16) : "memory"); else asm volatile("s_waitcnt vmcnt(%0)" :: "n"(NGL) : "memory"); }
                                         else asm volatile("s_waitcnt vmcnt(0)" ::: "memory"); }
                else { if (inflight >= 2) asm volatile("s_waitcnt vmcnt(%0)" :: "n"(NGL) : "memory"); else asm volatile("s_waitcnt vmcnt(0)" ::: "memory"); }
                asm volatile("s_waitcnt lgkmcnt(0)\n\ts_barrier" ::: "memory");
            } else {
                asm volatile("s_waitcnt vmcnt(0)" ::: "memory");
                __syncthreads();
            }
            if constexpr (!(NF == 2 && HAS_SUM)) G_STAGE();
            if constexpr (HAS_SUM) pb.tile_begin(cu, t, gpre, wr, wc, fr, fq);
            const ldsp ta = lds + buf * STAGE + wr * 16384 + lane_off, tb = lds + buf * STAGE + A_BYTES + wc * (NF * 2048) + lane_off;
            if constexpr (NF == 2 && HAS_SUM) {
                const unsigned ta_ = (unsigned)(size_t)ta, tb_ = (unsigned)(size_t)tb;
                bf16x8 a0, a1, a2, a3, a4, a5, a6, a7, b0, b1;
#define G_RD(dst, addr, OFF) asm volatile("ds_read_b128 %0, %1 offset:" #OFF : "=v"(dst) : "v"(addr))
#define G_MM(m, av) do { acc[m][0] = __builtin_amdgcn_mfma_f32_16x16x32_bf16(b0, av, acc[m][0], 0, 0, 0); acc[m][1] = __builtin_amdgcn_mfma_f32_16x16x32_bf16(b1, av, acc[m][1], 0, 0, 0); } while (0)
                const bool g_on = su < NU; const T* gAb = pb.a_base(g_on ? su : cu, st); const T* gBb = pb.b_base(g_on ? su : cu, st); const ldsp gsb = lds + sbuf * STAGE + ldsw;
                G_RD(a0, ta_, 0); G_RD(a1, ta_, 2048); G_RD(a2, ta_, 4096); G_RD(a3, ta_, 6144); G_RD(b0, tb_, 0); G_RD(b1, tb_, 2048);
                if (g_on) { GLDS16(gAb + aoff[0], gsb); GLDS16(gAb + aoff[1], gsb + 8192); }
                asm volatile("s_waitcnt lgkmcnt(0)" : "+v"(a0), "+v"(a1), "+v"(a2), "+v"(a3), "+v"(b0), "+v"(b1));
                __builtin_amdgcn_sched_barrier(0);
                G_RD(a4, ta_, 8192); G_RD(a5, ta_, 10240); G_RD(a6, ta_, 12288); G_RD(a7, ta_, 14336);
                G_MM(0, a0); G_MM(1, a1); G_MM(2, a2); G_MM(3, a3);
                __builtin_amdgcn_sched_barrier(0);
                if (g_on) { GLDS16(gAb + aoff[2], gsb + 2 * 8192); GLDS16(gAb + aoff[3], gsb + 3 * 8192); }
                asm volatile("s_waitcnt lgkmcnt(0)" : "+v"(a4), "+v"(a5), "+v"(a6), "+v"(a7));
                __builtin_amdgcn_sched_barrier(0);
                bf16x8 c0, c1, c2, c3, d0, d1;
                G_RD(c0, ta_, 1024); G_RD(c1, ta_, 3072); G_RD(c2, ta_, 5120); G_RD(c3, ta_, 7168); G_RD(d0, tb_, 1024); G_RD(d1, tb_, 3072);
                G_MM(4, a4); G_MM(5, a5); G_MM(6, a6); G_MM(7, a7);
                __builtin_amdgcn_sched_barrier(0);
                if (g_on) { GLDS16(gBb + boff[0], gsb + A_BYTES); GLDS16(gBb + boff[1], gsb + A_BYTES + 8192);
                            ++inflight; sbuf = (sbuf + 1 == NSTG) ? 0 : sbuf + 1;
                            if (++st == snt) { su += nblk; st = 0; if (su < NU) { snt = pb.ntiles(su); G_LOAD_OFFS(); } } }
                asm volatile("s_waitcnt lgkmcnt(0)" : "+v"(c0), "+v"(c1), "+v"(c2), "+v"(c3), "+v"(d0), "+v"(d1));
                __builtin_amdgcn_sched_barrier(0);
                b0 = d0; b1 = d1;
                G_RD(a4, ta_, 9216); G_RD(a5, ta_, 11264); G_RD(a6, ta_, 13312); G_RD(a7, ta_, 15360);
                G_MM(0, c0); G_MM(1, c1); G_MM(2, c2); G_MM(3, c3);
                __builtin_amdgcn_sched_barrier(0);
                asm volatile("s_waitcnt lgkmcnt(0)" : "+v"(a4), "+v"(a5), "+v"(a6), "+v"(a7));
                __builtin_amdgcn_sched_barrier(0);
                G_MM(4, a4); G_MM(5, a5); G_MM(6, a6); G_MM(7, a7);
                __builtin_amdgcn_sched_barrier(0);
#undef G_RD
#undef G_MM
            } else {
#pragma unroll
            for (int ks = 0; ks < 2; ++ks) {
                bf16x8 At[8], Bf[NF];
#pragma unroll
                for (int m = 0; m < 8; ++m) At[m] = *(const LAS bf16x8*)(ta + m * 2048 + ks * 1024);
#pragma unroll
                for (int n = 0; n < NF; ++n) Bf[n] = *(const LAS bf16x8*)(tb + n * 2048 + ks * 1024);
#pragma unroll
                for (int m = 0; m < 8; ++m)
#pragma unroll
                    for (int n = 0; n < NF; ++n) acc[m][n] = __builtin_amdgcn_mfma_f32_16x16x32_bf16(Bf[n], At[m], acc[m][n], 0, 0, 0);
            }
            }
            if constexpr (HAS_SUM) pb.tile_done(cu, t, acc, sum, gpre, wr, wc, fr, fq);
            --inflight; buf = (buf + 1 == NSTG) ? 0 : buf + 1;
        }
        if constexpr (HAS_SUM) pb.epilogue(cu, sum, wr, wc, fr, fq); else pb.epilogue(cu, acc, wr, wc, fr, fq);
    }
    asm volatile("s_waitcnt vmcnt(0) lgkmcnt(0)\n\ts_barrier" ::: "memory");
#undef G_LOAD_OFFS
#undef G_STAGE
}

struct InProj {
    const T* H; const T* Wt; T* Z; float* SS; const float* gqn; const float* gkn; const float2* tab64; const float2* tab32; int nlat, npm;
    __device__ __forceinline__ int nunits() const { return npm * 25; }
    __device__ __forceinline__ int ntiles(int) const { return 16; }
    __device__ __forceinline__ unsigned a_off(int u, int R) const { return (unsigned)((u / 25) * 256 + R) * 1024u; }
    __device__ __forceinline__ unsigned b_off(int u, int R) const { return (unsigned)((u % 25) * 256 + R) * 1024u; }
    __device__ __forceinline__ const T* a_base(int, int t) const { return H + t * 64; }
    __device__ __forceinline__ const T* b_base(int, int t) const { return Wt + t * 64; }
    __device__ __forceinline__ void epilogue(int u, f32x4 (&acc)[8][4], int wr, int wc, int fr, int fq) const {
        const int pm = u / 25, pn = u % 25, cg = pn * 4 + wc;
        if (cg == 34 || cg == 35) return;
        const int row0 = pm * 256 + wr * 128 + fr;
        const bool lat = pm * 256 < nlat;
        const int zcol = (cg < 36 ? cg * 64 : 2144 + (cg - 36) * 64) + fq * 4;
        const bool t_rms = (cg >= 12 && cg < 18), t_rope = t_rms || (cg >= 20 && cg < 26), t_ssq = (cg >= 28 && cg < 33), t_kr = cg == 33, t_sig = cg >= 36;
        float4 gv[4];
        if (t_rms) { const float* g = cg < 16 ? gqn : gkn;
#pragma unroll
            for (int n = 0; n < 4; ++n) gv[n] = *(const float4*)(g + n * 16 + fq * 4); }
#pragma unroll
        for (int m = 0; m < 8; ++m) {
            const int row = row0 + m * 16;
            const int t = row & (SEQ - 1), gr = t >> 6, gc = t & 63;
            float v[4][4];
#pragma unroll
            for (int n = 0; n < 4; ++n)
#pragma unroll
                for (int j = 0; j < 4; ++j) v[n][j] = acc[m][n][j];
            T* zp = Z + (size_t)row * ZW + zcol;
            if (t_rms || t_ssq) {
                float ss = 0.f;
#pragma unroll
                for (int n = 0; n < 4; ++n)
#pragma unroll
                    for (int j = 0; j < 4; ++j) ss += v[n][j] * v[n][j];
                ss += __shfl_xor(ss, 16); ss += __shfl_xor(ss, 32);
                if (t_ssq) { if (fq == 0) SS[(size_t)row * 8 + (cg - 28)] = ss; }
                else { const float rstd = 1.f / sqrtf(ss * (1.f / 64.f) + EPS);
#pragma unroll
                    for (int n = 0; n < 4; ++n) { v[n][0] *= rstd * gv[n].x; v[n][1] *= rstd * gv[n].y; v[n][2] *= rstd * gv[n].z; v[n][3] *= rstd * gv[n].w; } }
            }
            if (t_rope && lat) {
                const float4* tr = (const float4*)(tab64 + gr * 16 + fq * 4); const float4* tc = (const float4*)(tab64 + gc * 16 + fq * 4);
                const float4 r0 = tr[0], r1 = tr[1], c0 = tc[0], c1 = tc[1];
                const float rc[4] = {r0.x, r0.z, r1.x, r1.z}, rs[4] = {r0.y, r0.w, r1.y, r1.w}, cc[4] = {c0.x, c0.z, c1.x, c1.z}, cs[4] = {c0.y, c0.w, c1.y, c1.w};
#pragma unroll
                for (int j = 0; j < 4; ++j) {
                    const float a0 = v[0][j], a1 = v[1][j], b0 = v[2][j], b1 = v[3][j];
                    v[0][j] = a0 * rc[j] - a1 * rs[j]; v[1][j] = a0 * rs[j] + a1 * rc[j];
                    v[2][j] = b0 * cc[j] - b1 * cs[j]; v[3][j] = b0 * cs[j] + b1 * cc[j];
                }
            }
            if (t_kr) {
#pragma unroll
                for (int n = 0; n < 2; ++n) {
                    const float4* tp = (const float4*)(tab32 + (n == 0 ? gr : gc) * 8 + (fq & 1) * 4);
                    const float4 q0 = tp[0], q1 = tp[1];
                    const float kc[4] = {q0.x, q0.z, q1.x, q1.z}, ks[4] = {q0.y, q0.w, q1.y, q1.w};
#pragma unroll
                    for (int j = 0; j < 4; ++j) { const float x = v[n][j], px = __shfl_xor(x, 32); if (lat) v[n][j] = (fq < 2) ? (x * kc[j] - px * ks[j]) : (px * ks[j] + x * kc[j]); }
                    *(uint2*)(zp + n * 16) = pk4(v[n][0], v[n][1], v[n][2], v[n][3]);
                }
                continue;
            }
            if (t_sig) {
#pragma unroll
                for (int n = 0; n < 4; ++n)
#pragma unroll
                    for (int j = 0; j < 4; ++j) v[n][j] = fast_sigmoid(v[n][j]);
            }
#pragma unroll
            for (int n = 0; n < 4; ++n) *(uint2*)(zp + n * 16) = pk4(v[n][0], v[n][1], v[n][2], v[n][3]);
        }
    }
};

struct MlaProj {
    const T* Z; const T* WqT; const T* WkvT; T* QM; T* KVM; const float* SS; const float2* tab32; int nlat, npm;
    __device__ __forceinline__ int nunits() const { return npm * 7; }
    __device__ __forceinline__ int ntiles(int u) const { return u < npm * 3 ? 3 : 2; }
    __device__ __forceinline__ unsigned a_off(int u, int R) const { const int pm = u < npm * 3 ? u / 3 : (u - npm * 3) / 4; return (unsigned)(pm * 256 + R) * (unsigned)ZW; }
    __device__ __forceinline__ unsigned b_off(int u, int R) const { return u < npm * 3 ? (unsigned)((u % 3) * 128 + R) * 192u : (unsigned)(((u - npm * 3) % 4) * 128 + R) * 128u; }
    __device__ __forceinline__ const T* a_base(int u, int t) const { return Z + (u < npm * 3 ? MCQ : MCKV) + t * 64; }
    __device__ __forceinline__ const T* b_base(int u, int t) const { return (u < npm * 3 ? WqT : WkvT) + t * 64; }
    __device__ __forceinline__ void epilogue(int u, f32x4 (&acc)[8][2], int wr, int wc, int fr, int fq) const {
        const bool isq = u < npm * 3;
        const int pm = isq ? u / 3 : (u - npm * 3) / 4, pn = isq ? u % 3 : (u - npm * 3) % 4;
        const int row0 = pm * 256 + wr * 128 + fr;
        const bool lat = pm * 256 < nlat;
#pragma unroll
        for (int m = 0; m < 8; ++m) {
            const int row = row0 + m * 16;
            const float* ss = SS + (size_t)row * 8;
            const float rstd = isq ? 1.f / sqrtf((ss[0] + ss[1] + ss[2]) * (1.f / 192.f) + EPS) : 1.f / sqrtf((ss[3] + ss[4]) * (1.f / 128.f) + EPS);
            const int t = row & (SEQ - 1), gr = t >> 6, gc = t & 63;
#pragma unroll
            for (int n = 0; n < 2; ++n) {
                float v[4];
#pragma unroll
                for (int j = 0; j < 4; ++j) v[j] = acc[m][n][j] * rstd;
                const int f = pn * 8 + wc * 2 + n;
                if (isq) {
                    const int part = f % 6;
                    if (part >= 4) {
                        const float4* tp = (const float4*)(tab32 + (part == 4 ? gr : gc) * 8 + (fq & 1) * 4);
                        const float4 q0 = tp[0], q1 = tp[1];
                        const float kc[4] = {q0.x, q0.z, q1.x, q1.z}, ks[4] = {q0.y, q0.w, q1.y, q1.w};
#pragma unroll
                        for (int j = 0; j < 4; ++j) { const float x = v[j], px = __shfl_xor(x, 32); if (lat) v[j] = (fq < 2) ? (x * kc[j] - px * ks[j]) : (px * ks[j] + x * kc[j]); }
                    }
                    *(uint2*)(QM + (size_t)row * 384 + f * 16 + fq * 4) = pk4(v[0], v[1], v[2], v[3]);
                } else {
                    *(uint2*)(KVM + (size_t)row * 512 + f * 16 + fq * 4) = pk4(v[0], v[1], v[2], v[3]);
                }
            }
        }
    }
};

struct MergeProb {
    const T* O; const T* WbT; const T* Z; T* MERGED; int npm;
    __device__ __forceinline__ int nunits() const { return npm * 8; }
    __device__ __forceinline__ int ntiles(int) const { return 16; }
    __device__ __forceinline__ unsigned a_off(int u0, int R) const { const int u = xswz(u0, npm * 8); return (unsigned)((u >> 3) * 256 + R) * 1024u; }
    __device__ __forceinline__ unsigned b_off(int u0, int R) const { const int u = xswz(u0, npm * 8); return (unsigned)((u & 7) * 128 + R) * 256u; }
    __device__ __forceinline__ const T* a_base(int, int t) const { return O + (t >> 2) * 256 + (t & 3) * 64; }
    __device__ __forceinline__ const T* b_base(int, int t) const { return WbT + (size_t)(t >> 2) * 1024 * 256 + (t & 3) * 64; }
    __device__ __forceinline__ void tile_begin(int u0, int t, uint2 (&gpre)[8][2], int wr, int wc, int fr, int fq) const {
        if ((t & 3) != 0) return;
        const int u = xswz(u0, npm * 8); const int i = t >> 2, pm = u >> 3, pn = u & 7;
        const T* gp = Z + (size_t)(pm * 256 + wr * 128 + fr) * ZW + GATE + i * 1024 + pn * 128 + wc * 32 + fq * 4;
#pragma unroll
        for (int m = 0; m < 8; ++m)
#pragma unroll
            for (int n = 0; n < 2; ++n) { const T* q_ = gp + (size_t)m * 16 * ZW + n * 16; asm volatile("global_load_dwordx2 %0, %1, off" : "=v"(gpre[m][n]) : "v"(q_)); }
    }
    __device__ __forceinline__ int extra_inflight(int t) const { return ((t & 3) == 1) ? 16 : 0; }
    __device__ __forceinline__ void tile_done(int u, int t, f32x4 (&acc)[8][2], f32x4 (&sum)[8][2], uint2 (&gpre)[8][2], int wr, int wc, int fr, int fq) const {
        if ((t & 3) != 3) return;
#pragma unroll
        for (int m = 0; m < 8; ++m)
#pragma unroll
            for (int n = 0; n < 2; ++n) {
                const uint2 r = gpre[m][n];
                { float s0 = __builtin_fmaf(__uint_as_float(r.x << 16), acc[m][n][0], sum[m][n][0]); asm volatile("" : "+v"(s0));
                  float s1 = __builtin_fmaf(__uint_as_float(r.x & 0xffff0000u), acc[m][n][1], sum[m][n][1]); asm volatile("" : "+v"(s1));
                  float s2 = __builtin_fmaf(__uint_as_float(r.y << 16), acc[m][n][2], sum[m][n][2]); asm volatile("" : "+v"(s2));
                  float s3 = __builtin_fmaf(__uint_as_float(r.y & 0xffff0000u), acc[m][n][3], sum[m][n][3]); asm volatile("" : "+v"(s3));
                  sum[m][n] = (f32x4){s0, s1, s2, s3}; }
                acc[m][n] = (f32x4){0.f, 0.f, 0.f, 0.f};
            }
    }
    __device__ __forceinline__ void epilogue(int u0, f32x4 (&sum)[8][2], int wr, int wc, int fr, int fq) const {
        const int u = xswz(u0, npm * 8); const int pm = u >> 3, pn = u & 7;
        T* op = MERGED + (size_t)(pm * 256 + wr * 128 + fr) * 1024 + pn * 128 + wc * 32 + fq * 4;
#pragma unroll
        for (int m = 0; m < 8; ++m)
#pragma unroll
            for (int n = 0; n < 2; ++n) *(uint2*)(op + (size_t)m * 16 * 1024 + n * 16) = pk4(sum[m][n][0], sum[m][n][1], sum[m][n][2], sum[m][n][3]);
    }
};

struct PlainProb {
    const T* A; const T* Bt; T* C; int npm, npn, K, lda, ldc;
    __device__ __forceinline__ int nunits() const { return npm * npn; }
    __device__ __forceinline__ int ntiles(int) const { return K / 64; }
    __device__ __forceinline__ unsigned a_off(int u0, int R) const { const int u = xswz(u0, npm * npn); return (unsigned)((u / npn) * 256 + R) * (unsigned)lda; }
    __device__ __forceinline__ unsigned b_off(int u0, int R) const { const int u = xswz(u0, npm * npn); return (unsigned)((u % npn) * 128 + R) * (unsigned)K; }
    __device__ __forceinline__ const T* a_base(int, int t) const { return A + t * 64; }
    __device__ __forceinline__ const T* b_base(int, int t) const { return Bt + t * 64; }
    __device__ __forceinline__ void epilogue(int u0, f32x4 (&acc)[8][2], int wr, int wc, int fr, int fq) const {
        const int u = xswz(u0, npm * npn); const int pm = u / npn, pn = u % npn;
        T* op = C + (size_t)(pm * 256 + wr * 128 + fr) * ldc + pn * 128 + wc * 32 + fq * 4;
#pragma unroll
        for (int m = 0; m < 8; ++m)
#pragma unroll
            for (int n = 0; n < 2; ++n) *(uint2*)(op + (size_t)m * 16 * ldc + n * 16) = pk4(acc[m][n][0], acc[m][n][1], acc[m][n][2], acc[m][n][3]);
    }
};

constexpr int CTXB = NB * NE * CAP;
struct FfnUp {
    const T* H2; const T* WguT; const int* IDX; T* ACT; int nun;
    __device__ __forceinline__ int nunits() const { return nun; }
    __device__ __forceinline__ int ntiles(int) const { return 16; }
    __device__ __forceinline__ void decode(int u, int& e, int& pn, int& sbase, bool& isctx) const {
        if (u < 2048) { e = u >> 7; const int rem = u & 127; pn = rem & 7; sbase = ((rem >> 5) * NE + e) * CAP + ((rem >> 3) & 3) * 256; isctx = false; }
        else { const int uc = u - 2048; e = uc >> 3; pn = uc & 7; sbase = CTXB + e * CAPC; isctx = true; }
    }
    __device__ __forceinline__ int slot_of(int sbase, bool isctx, int R) const { return isctx ? (R < 128 ? sbase + (R >> 5) * (NE * CAPC) + (R & 31) : -1) : sbase + R; }
    __device__ __forceinline__ unsigned a_off(int u, int R) const { int e, pn, sb; bool ic; decode(u, e, pn, sb, ic); const int s = slot_of(sb, ic, R); return s < 0 ? 0u : (unsigned)IDX[s] * 1024u; }
    __device__ __forceinline__ unsigned b_off(int u, int R) const { int e, pn, sb; bool ic; decode(u, e, pn, sb, ic); return (unsigned)(e * 2048 + pn * 256 + R) * 1024u; }
    __device__ __forceinline__ const T* a_base(int, int t) const { return H2 + t * 64; }
    __device__ __forceinline__ const T* b_base(int, int t) const { return WguT + t * 64; }
    __device__ __forceinline__ void epilogue(int u, f32x4 (&acc)[8][4], int wr, int wc, int fr, int fq) const {
        int e, pn, sb; bool ic; decode(u, e, pn, sb, ic);
        const int col = (pn * 4 + wc) * 32 + fq * 4;
#pragma unroll
        for (int m = 0; m < 8; ++m) {
            const int s = slot_of(sb, ic, wr * 128 + m * 16 + fr);
            if (s < 0) continue;
            T* op = ACT + (size_t)s * FF + col;
#pragma unroll
            for (int n = 0; n < 2; ++n)
                *(uint2*)(op + n * 16) = pk4(fast_silu(acc[m][n][0]) * acc[m][n + 2][0], fast_silu(acc[m][n][1]) * acc[m][n + 2][1],
                                             fast_silu(acc[m][n][2]) * acc[m][n + 2][2], fast_silu(acc[m][n][3]) * acc[m][n + 2][3]);
        }
    }
};
struct FfnDown {
    const T* ACT; const T* WdT; const float* GATEV; T* OUT; int nun;
    __device__ __forceinline__ int nunits() const { return nun; }
    __device__ __forceinline__ int ntiles(int) const { return 16; }
    __device__ __forceinline__ void decode(int u, int& e, int& pn, int& sbase, bool& isctx) const {
        if (u < 1024) { e = u >> 6; const int rem = u & 63; pn = rem & 3; sbase = ((rem >> 4) * NE + e) * CAP + ((rem >> 2) & 3) * 256; isctx = false; }
        else { const int uc = u - 1024; e = uc >> 2; pn = uc & 3; sbase = CTXB + e * CAPC; isctx = true; }
    }
    __device__ __forceinline__ int slot_of(int sbase, bool isctx, int R) const { return isctx ? (R < 128 ? sbase + (R >> 5) * (NE * CAPC) + (R & 31) : -1) : sbase + R; }
    __device__ __forceinline__ unsigned a_off(int u, int R) const { int e, pn, sb; bool ic; decode(u, e, pn, sb, ic); const int s = slot_of(sb, ic, R); return s < 0 ? 0u : (unsigned)s * 1024u; }
    __device__ __forceinline__ unsigned b_off(int u, int R) const { int e, pn, sb; bool ic; decode(u, e, pn, sb, ic); return (unsigned)(e * 1024 + pn * 256 + R) * 1024u; }
    __device__ __forceinline__ const T* a_base(int, int t) const { return ACT + t * 64; }
    __device__ __forceinline__ const T* b_base(int, int t) const { return WdT + t * 64; }
    __device__ __forceinline__ void epilogue(int u, f32x4 (&acc)[8][4], int wr, int wc, int fr, int fq) const {
        int e, pn, sb; bool ic; decode(u, e, pn, sb, ic);
        const int col = pn * 256 + wc * 64 + fq * 4;
#pragma unroll
        for (int m = 0; m < 8; ++m) {
            const int s = slot_of(sb, ic, wr * 128 + m * 16 + fr);
            if (s < 0) continue;
            const float g = GATEV[s];
            T* op = OUT + (size_t)s * D + col;
#pragma unroll
            for (int n = 0; n < 4; ++n) *(uint2*)(op + n * 16) = pk4(acc[m][n][0] * g, acc[m][n][1] * g, acc[m][n][2] * g, acc[m][n][3] * g);
        }
    }
};

namespace pg8 {
#define PG8_LAS __attribute__((address_space(3)))
constexpr int BM = 256, BK = 64, HALF = 128, HTB = HALF * BK * 2, STAGE_BYTES = 8 * HTB;
__host__ __device__ __forceinline__ int lds_byte(int r, int c) { const int st = (r >> 4) * 2 + (c >> 5), rr = r & 15, cc = c & 31, ob = rr * 64 + cc * 2; return st * 1024 + (ob ^ (((ob >> 9) & 1) << 5)); }
__host__ __device__ __forceinline__ void stage_rc(int b, int& R, int& C) { const int st = b / 1024, sb = b % 1024, swz = sb ^ (((sb >> 9) & 1) << 5); R = (st >> 1) * 16 + swz / 64; C = (st & 1) * 32 + (swz % 64) / 2; }
__host__ __device__ __forceinline__ int perm32(int rho) { const int n = rho >> 4, i = rho & 15; return 8 * (i >> 2) + 4 * n + (i & 3); }
struct Unit { int pm, pn; const char* a; const char* b; int x0, x1; };
template <class Epi, class Sched, bool ALIGN_EPI = false, bool SP2 = false>
__device__ __forceinline__ void gemm_phase(PG8_LAS unsigned char* lds, const int K, const Sched& S, const Epi& E) {
    const int tid = otid(), wid = __builtin_amdgcn_readfirstlane(tid >> 6), lane = tid & 63, wr = wid >> 2, wc = wid & 3, fr = lane & 15, fq = lane >> 4;
    const int nt = K / BK;
    unsigned voffA[2], voffB[2];
#pragma unroll
    for (int i = 0; i < 2; ++i) { int R, C; stage_rc(tid * 16 + i * 8192, R, C); const int Rb = Epi::PERM ? ((R & ~31) + perm32(R & 31)) : R;
        voffA[i] = (unsigned)(R * K + C) * 2u; voffB[i] = (unsigned)(Rb * K + C) * 2u; }
    const size_t kstep = (size_t)(BK * 2);
    const size_t hstep = (size_t)HALF * K * 2;
    const unsigned ldsw = (unsigned)wid * 1024u;
    const int aoff = lds_byte(wr * 64 + fr, fq * 8), boff = lds_byte(wc * 32 + fr, fq * 8);
#define PG8_SA(b, h) (((b) * 2 + (h)) * HTB)
#define PG8_SB(b, h) ((4 + (b) * 2 + (h)) * HTB)
#define PG8_STAGE(bufoff, gbase, voff) do { _Pragma("unroll") for (int _i = 0; _i < 2; ++_i) \
        __builtin_amdgcn_global_load_lds((const unsigned*)((const char*)(gbase) + (voff)[_i]), (PG8_LAS unsigned*)(lds + (bufoff) + ldsw + _i * 8192), 16, 0, 0); } while (0)
#define PG8_LDA(dst, b, h) do { _Pragma("unroll") for (int m = 0; m < 4; ++m) _Pragma("unroll") for (int k = 0; k < 2; ++k) dst[m][k] = *(const PG8_LAS bf16x8*)(lds + PG8_SA(b, h) + aoff + m * 2048 + k * 1024); } while (0)
#define PG8_LDB(dst, b, h) do { _Pragma("unroll") for (int n = 0; n < 2; ++n) _Pragma("unroll") for (int k = 0; k < 2; ++k) dst[n][k] = *(const PG8_LAS bf16x8*)(lds + PG8_SB(b, h) + boff + n * 2048 + k * 1024); } while (0)
#define PG8_MMA(ai, bj, At, Bt) do { __builtin_amdgcn_s_setprio(1); _Pragma("unroll") for (int m = 0; m < 4; ++m) _Pragma("unroll") for (int n = 0; n < 2; ++n) _Pragma("unroll") for (int k = 0; k < 2; ++k) \
        acc[ai][bj][m][n] = __builtin_amdgcn_mfma_f32_16x16x32_bf16(Bt[n][k], At[m][k], acc[ai][bj][m][n], 0, 0, 0); __builtin_amdgcn_s_setprio(0); } while (0)
#define PG8_WAIT_V(n) asm volatile("s_waitcnt vmcnt(" #n ")" ::: "memory")
#define PG8_WAIT_L(n) asm volatile("s_waitcnt lgkmcnt(" #n ")" ::: "memory")
#define PG8_BAR __builtin_amdgcn_s_barrier()
#define PG8_SCHED __builtin_amdgcn_sched_barrier(0)
    Unit cur, nxt; int ui = 0;
    if (!S.next(0, cur)) return;
    f32x4 acc[2][2][4][2];
#pragma unroll
    for (int a = 0; a < 2; ++a)
#pragma unroll
        for (int b = 0; b < 2; ++b)
#pragma unroll
            for (int m = 0; m < 4; ++m)
#pragma unroll
                for (int n = 0; n < 2; ++n) acc[a][b][m][n] = (f32x4){0.f, 0.f, 0.f, 0.f};
    bf16x8 At[4][2], B0[2][2], B1[2][2];
    const char* cA = cur.a; const char* cB = cur.b;
    S.a_ready(cur);
    if constexpr (SP2) {
        PG8_STAGE(PG8_SB(0, 0), cB, voffB); PG8_STAGE(PG8_SB(0, 1), cB + hstep, voffB); PG8_STAGE(PG8_SA(0, 0), cA, voffA); PG8_STAGE(PG8_SA(0, 1), cA + hstep, voffA);
        if (wr == 1) PG8_BAR;
        PG8_WAIT_V(2); PG8_BAR;
        PG8_STAGE(PG8_SB(1, 0), cB + kstep, voffB); PG8_STAGE(PG8_SA(1, 0), cA + kstep, voffA); PG8_STAGE(PG8_SB(1, 1), cB + hstep + kstep, voffB);
        PG8_WAIT_V(6); PG8_BAR;
    } else {
        PG8_STAGE(PG8_SB(0, 0), cB, voffB); PG8_STAGE(PG8_SA(0, 0), cA, voffA); PG8_STAGE(PG8_SB(0, 1), cB + hstep, voffB); PG8_STAGE(PG8_SA(0, 1), cA + hstep, voffA);
        if (wr == 1) PG8_BAR;
        PG8_WAIT_V(4); PG8_BAR;
        PG8_STAGE(PG8_SB(1, 0), cB + kstep, voffB); PG8_STAGE(PG8_SA(1, 0), cA + kstep, voffA); PG8_STAGE(PG8_SB(1, 1), cB + hstep + kstep, voffB);
        PG8_WAIT_V(6); PG8_BAR;
    }
    for (;;) {
        const bool has_next = S.next(ui + 1, nxt);
        const char* nA = has_next ? nxt.a : cA; const char* nB = has_next ? nxt.b : cB;
        for (int t = 0; t < nt; t += 2) {
            const bool last = (t == nt - 2);
            const char* a1 = cA + (size_t)(t + 1) * kstep;
            const char* a2 = last ? nA : cA + (size_t)(t + 2) * kstep; const char* b2 = last ? nB : cB + (size_t)(t + 2) * kstep;
            const char* a3 = a2 + kstep; const char* b3 = b2 + kstep;
            if (last && has_next) S.a_ready(nxt);
            if constexpr (SP2) {
            PG8_LDB(B0, 0, 0); PG8_LDB(B1, 0, 1); PG8_SCHED; PG8_LDA(At, 0, 0); PG8_STAGE(PG8_SA(1, 1), a1 + hstep, voffA);
            PG8_WAIT_V(8); PG8_WAIT_L(0); PG8_BAR; PG8_MMA(0, 0, At, B0); PG8_MMA(0, 1, At, B1); PG8_BAR; PG8_SCHED;
            PG8_LDA(At, 0, 1); PG8_STAGE(PG8_SB(0, 0), b2, voffB); PG8_STAGE(PG8_SB(0, 1), b2 + hstep, voffB); PG8_STAGE(PG8_SA(0, 0), a2, voffA);
            PG8_WAIT_V(8); PG8_WAIT_L(0); PG8_BAR; PG8_MMA(1, 0, At, B0); PG8_MMA(1, 1, At, B1); PG8_BAR; PG8_SCHED;
            PG8_LDB(B0, 1, 0); PG8_LDB(B1, 1, 1); PG8_SCHED; PG8_LDA(At, 1, 0); PG8_STAGE(PG8_SA(0, 1), a2 + hstep, voffA);
            PG8_WAIT_V(8); PG8_WAIT_L(0); PG8_BAR; PG8_MMA(0, 0, At, B0); PG8_MMA(0, 1, At, B1); PG8_BAR; PG8_SCHED;
            PG8_LDA(At, 1, 1); PG8_STAGE(PG8_SB(1, 0), b3, voffB); PG8_STAGE(PG8_SB(1, 1), b3 + hstep, voffB); PG8_STAGE(PG8_SA(1, 0), a3, voffA);
            PG8_WAIT_V(8); PG8_WAIT_L(0); PG8_BAR; PG8_MMA(1, 0, At, B0); PG8_MMA(1, 1, At, B1); PG8_BAR; PG8_SCHED;
            } else {
            PG8_LDB(B0, 0, 0); PG8_SCHED; PG8_LDA(At, 0, 0); PG8_STAGE(PG8_SA(1, 1), a1 + hstep, voffA);
            PG8_WAIT_L(8); PG8_BAR; PG8_WAIT_L(0); PG8_MMA(0, 0, At, B0); PG8_BAR; PG8_SCHED;
            PG8_LDB(B1, 0, 1); PG8_STAGE(PG8_SB(0, 0), b2, voffB);
            PG8_BAR; PG8_WAIT_L(0); PG8_MMA(0, 1, At, B1); PG8_BAR;
            PG8_LDA(At, 0, 1); PG8_STAGE(PG8_SA(0, 0), a2, voffA);
            PG8_BAR; PG8_WAIT_L(0); PG8_MMA(1, 0, At, B0); PG8_BAR; PG8_SCHED;
            PG8_STAGE(PG8_SB(0, 1), b2 + hstep, voffB);
            PG8_WAIT_V(6); PG8_BAR; PG8_MMA(1, 1, At, B1); PG8_BAR;
            PG8_LDB(B0, 1, 0); PG8_SCHED; PG8_LDA(At, 1, 0); PG8_STAGE(PG8_SA(0, 1), a2 + hstep, voffA);
            PG8_WAIT_L(8); PG8_BAR; PG8_WAIT_L(0); PG8_MMA(0, 0, At, B0); PG8_BAR; PG8_SCHED;
            PG8_LDB(B1, 1, 1); PG8_STAGE(PG8_SB(1, 0), b3, voffB);
            PG8_BAR; PG8_WAIT_L(0); PG8_MMA(0, 1, At, B1); PG8_BAR;
            PG8_LDA(At, 1, 1); PG8_STAGE(PG8_SA(1, 0), a3, voffA);
            PG8_BAR; PG8_WAIT_L(0); PG8_MMA(1, 0, At, B0); PG8_BAR; PG8_SCHED;
            PG8_STAGE(PG8_SB(1, 1), b3 + hstep, voffB);
            PG8_WAIT_V(6); PG8_BAR; PG8_MMA(1, 1, At, B1); PG8_BAR;
            }
        }
        if constexpr (ALIGN_EPI) { if (wr == 0) PG8_BAR; }
        if constexpr (!Epi::AFTER_DRAIN) { E(acc, cur, wr, wc, fr, fq); S.done(cur); }
        if (!has_next) break;
#pragma unroll
        for (int a = 0; a < 2; ++a)
#pragma unroll
            for (int b = 0; b < 2; ++b)
#pragma unroll
                for (int m = 0; m < 4; ++m)
#pragma unroll
                    for (int n = 0; n < 2; ++n) acc[a][b][m][n] = (f32x4){0.f, 0.f, 0.f, 0.f};
        cur = nxt; cA = nA; cB = nB; ++ui;
        if constexpr (ALIGN_EPI) { if (wr == 1) PG8_BAR; }
    }
    PG8_WAIT_V(0);
    if constexpr (!ALIGN_EPI) { if (wr == 0) PG8_BAR; }
    PG8_BAR;
    if constexpr (Epi::AFTER_DRAIN) { E.fused(acc, cur, wr, wc, fr, fq, lds, wid, lane); S.done(cur); }
#undef PG8_SA
#undef PG8_SB
#undef PG8_STAGE
#undef PG8_LDA
#undef PG8_LDB
#undef PG8_MMA
#undef PG8_WAIT_V
#undef PG8_WAIT_L
#undef PG8_BAR
#undef PG8_SCHED
}
}

struct SchedBase { __device__ __forceinline__ void a_ready(const pg8::Unit&) const {} __device__ __forceinline__ void done(const pg8::Unit&) const {} };
#define ACC8(mm, nn) acc[(mm) >> 2][(nn) >> 1][(mm) & 3][(nn) & 1]
#define ROW8(mm) (((mm) >> 2) * 128 + wr * 64 + ((mm) & 3) * 16 + fr)

struct InProj8S : SchedBase { const T* H; const T* Wt; int npm, bid, nblk, nun;
    __device__ __forceinline__ bool next(int i, pg8::Unit& u) const { const int x0 = bid + i * nblk; if (x0 >= nun) return false; const int x = xswz(x0, nun);
        if (x < 3200 || nun == 3300) { u.pm = x / 25; u.pn = x % 25; } else { const int y = x - 3200; u.pm = 128 + y / 9; u.pn = y % 9; }
        u.a = (const char*)(H + (size_t)u.pm * 256 * D); u.b = (const char*)(Wt + (size_t)u.pn * 256 * D); return true; } };
struct InProj8E {
    static constexpr bool PERM = false, AFTER_DRAIN = false;
    T* Z; float* SS; const float* gqn; const float* gkn; const float2* tab64; const float2* tab32;
    __device__ __forceinline__ void operator()(const f32x4 (&acc)[2][2][4][2], const pg8::Unit& u, int wr, int wc, int fr, int fq) const {
        const int pm = u.pm, cg = u.pn * 4 + wc;
        if (cg == 34 || cg == 35) return;
        const bool lat = pm * 256 < NLAT;
        const int zcol = (cg < 36 ? cg * 64 : 2144 + (cg - 36) * 64) + fq * 4;
        const bool t_rms = (cg >= 12 && cg < 18), t_rope = t_rms || (cg >= 20 && cg < 26), t_ssq = (cg >= 28 && cg < 33), t_kr = cg == 33, t_sig = cg >= 36;
        float4 gv[4];
        if (t_rms) { const float* g = cg < 16 ? gqn : gkn;
#pragma unroll
            for (int n = 0; n < 4; ++n) gv[n] = *(const float4*)(g + n * 16 + fq * 4); }
#pragma unroll
        for (int m = 0; m < 8; ++m) {
            const int row = pm * 256 + ROW8(m);
            const int t = row & (SEQ - 1), gr = t >> 6, gc = t & 63;
            float v[4][4];
#pragma unroll
            for (int n = 0; n < 4; ++n)
#pragma unroll
                for (int j = 0; j < 4; ++j) v[n][j] = ACC8(m, n)[j];
            T* zp = Z + (size_t)row * ZW + zcol;
            if (t_rms || t_ssq) {
                float ss = 0.f;
#pragma unroll
                for (int n = 0; n < 4; ++n)
#pragma unroll
                    for (int j = 0; j < 4; ++j) ss += v[n][j] * v[n][j];
                ss += __shfl_xor(ss, 16); ss += __shfl_xor(ss, 32);
                if (t_ssq) { if (fq == 0) SS[(size_t)row * 8 + (cg - 28)] = ss; }
                else { const float rstd = 1.f / sqrtf(ss * (1.f / 64.f) + EPS);
#pragma unroll
                    for (int n = 0; n < 4; ++n) { v[n][0] *= rstd * gv[n].x; v[n][1] *= rstd * gv[n].y; v[n][2] *= rstd * gv[n].z; v[n][3] *= rstd * gv[n].w; } }
            }
            if (t_rope && lat) {
                const float4* tr = (const float4*)(tab64 + gr * 16 + fq * 4); const float4* tc = (const float4*)(tab64 + gc * 16 + fq * 4);
                const float4 r0 = tr[0], r1 = tr[1], c0 = tc[0], c1 = tc[1];
                const float rc[4] = {r0.x, r0.z, r1.x, r1.z}, rs[4] = {r0.y, r0.w, r1.y, r1.w}, cc[4] = {c0.x, c0.z, c1.x, c1.z}, cs[4] = {c0.y, c0.w, c1.y, c1.w};
#pragma unroll
                for (int j = 0; j < 4; ++j) {
                    const float a0 = v[0][j], a1 = v[1][j], b0 = v[2][j], b1 = v[3][j];
                    v[0][j] = a0 * rc[j] - a1 * rs[j]; v[1][j] = a0 * rs[j] + a1 * rc[j];
                    v[2][j] = b0 * cc[j] - b1 * cs[j]; v[3][j] = b0 * cs[j] + b1 * cc[j];
                }
            }
            if (t_kr) {
#pragma unroll
                for (int n = 0; n < 2; ++n) {
                    const float4* tp = (const float4*)(tab32 + (n == 0 ? gr : gc) * 8 + (fq & 1) * 4);
                    const float4 q0 = tp[0], q1 = tp[1];
                    const float kc[4] = {q0.x, q0.z, q1.x, q1.z}, ks[4] = {q0.y, q0.w, q1.y, q1.w};
#pragma unroll
                    for (int j = 0; j < 4; ++j) { const float x = v[n][j], px = __shfl_xor(x, 32); if (lat) v[n][j] = (fq < 2) ? (x * kc[j] - px * ks[j]) : (px * ks[j] + x * kc[j]); }
                    *(uint2*)(zp + n * 16) = pk4(v[n][0], v[n][1], v[n][2], v[n][3]);
                }
                continue;
            }
            if (t_sig) {
#pragma unroll
                for (int n = 0; n < 4; ++n)
#pragma unroll
                    for (int j = 0; j < 4; ++j) v[n][j] = fast_sigmoid(v[n][j]);
            }
#pragma unroll
            for (int n = 0; n < 4; ++n) *(uint2*)(zp + n * 16) = pk4(v[n][0], v[n][1], v[n][2], v[n][3]);
        }
    }
};

struct FfnUp8S : SchedBase { const T* XG; const T* WguT; int nun, bid, nblk;
    __device__ __forceinline__ bool next(int i, pg8::Unit& u) const { const int x0 = bid + i * nblk; if (x0 >= nun) return false; const int x = xswz(x0, nun); int e, sb;
        if (x < 2048) { e = x >> 7; const int rem = x & 127; u.pn = rem & 7; sb = ((rem >> 5) * NE + e) * CAP + ((rem >> 3) & 3) * 256; u.x1 = 256; }
        else { const int uc = x - 2048; e = uc >> 3; u.pn = uc & 7; sb = CTXB + e * (NB * CAPC); u.x1 = NB * CAPC; }
        u.pm = 0; u.x0 = sb; u.a = (const char*)(XG + (size_t)sb * D); u.b = (const char*)(WguT + ((size_t)e * 2048 + u.pn * 256) * D); return true; } };
struct FfnUp8E {
    static constexpr bool PERM = false, AFTER_DRAIN = false;
    T* ACT;
    __device__ __forceinline__ void operator()(const f32x4 (&acc)[2][2][4][2], const pg8::Unit& u, int wr, int wc, int fr, int fq) const {
        const int col = (u.pn * 4 + wc) * 32 + fq * 4;
#pragma unroll
        for (int m = 0; m < 8; ++m) {
            const int R = ROW8(m);
            if (R >= u.x1) continue;
            T* op = ACT + (size_t)(u.x0 + R) * FF + col;
#pragma unroll
            for (int n = 0; n < 2; ++n) { const f32x4 g = ACC8(m, n), w = ACC8(m, n + 2);
                *(uint2*)(op + n * 16) = pk4(fast_silu(g[0]) * w[0], fast_silu(g[1]) * w[1], fast_silu(g[2]) * w[2], fast_silu(g[3]) * w[3]); }
        }
    }
};
struct FfnDown8S : SchedBase { const T* ACT; const T* WdT; int nun, bid, nblk;
    __device__ __forceinline__ bool next(int i, pg8::Unit& u) const { const int x0 = bid + i * nblk; if (x0 >= nun) return false; const int x = xswz(x0, nun); int e, sb;
        if (x < 1024) { e = x >> 6; const int rem = x & 63; u.pn = rem & 3; sb = ((rem >> 4) * NE + e) * CAP + ((rem >> 2) & 3) * 256; u.x1 = 256; }
        else { const int uc = x - 1024; e = uc >> 2; u.pn = uc & 3; sb = CTXB + e * (NB * CAPC); u.x1 = NB * CAPC; }
        u.pm = 0; u.x0 = sb; u.a = (const char*)(ACT + (size_t)sb * FF); u.b = (const char*)(WdT + ((size_t)e * 1024 + u.pn * 256) * FF); return true; } };
struct FfnDown8E {
    static constexpr bool PERM = false, AFTER_DRAIN = false;
    const float* GATEV; T* OUT;
    __device__ __forceinline__ void operator()(const f32x4 (&acc)[2][2][4][2], const pg8::Unit& u, int wr, int wc, int fr, int fq) const {
        const int col = u.pn * 256 + wc * 64 + fq * 4;
#pragma unroll
        for (int m = 0; m < 8; ++m) {
            const int R = ROW8(m);
            if (R >= u.x1) continue;
            const int s = u.x0 + R; const float g = GATEV[s];
            T* op = OUT + (size_t)s * D + col;
#pragma unroll
            for (int n = 0; n < 4; ++n) { const f32x4 a = ACC8(m, n); *(uint2*)(op + n * 16) = pk4(a[0] * g, a[1] * g, a[2] * g, a[3] * g); }
        }
    }
};
struct Plain8S : SchedBase { const T* A; const T* Bt; int npm, npn, K, bid, nblk;
    __device__ __forceinline__ bool next(int i, pg8::Unit& u) const { const int x0 = bid + i * nblk; if (x0 >= npm * npn) return false; const int x = xswz(x0, npm * npn); u.pm = x / npn; u.pn = x % npn;
        u.a = (const char*)(A + (size_t)u.pm * 256 * K); u.b = (const char*)(Bt + (size_t)u.pn * 256 * K); return true; } };
struct Plain8E {
    static constexpr bool PERM = false, AFTER_DRAIN = false;
    T* C; int ldc;
    __device__ __forceinline__ void operator()(const f32x4 (&acc)[2][2][4][2], const pg8::Unit& u, int wr, int wc, int fr, int fq) const {
        const int col = u.pn * 256 + wc * 64 + fq * 4;
#pragma unroll
        for (int m = 0; m < 8; ++m) {
            T* op = C + (size_t)(u.pm * 256 + ROW8(m)) * ldc + col;
#pragma unroll
            for (int n = 0; n < 4; ++n) { const f32x4 a = ACC8(m, n); *(uint2*)(op + n * 16) = pk4(a[0], a[1], a[2], a[3]); }
        }
    }
};
__device__ __forceinline__ void ph_gather(const T* H2, const int* IDX, T* XG, int nslot, int bid, int nblk) {
    const int tid_ = otid(); const int lane = tid_ & 63, wid = tid_ >> 6;
    for (int s0 = (bid * 8 + wid) * 2; s0 < nslot; s0 += nblk * 16) {
        const int i0 = IDX[s0], i1 = IDX[s0 + 1];
        const uint4 a0 = *(const uint4*)(H2 + (size_t)i0 * D + lane * 8), a1 = *(const uint4*)(H2 + (size_t)i0 * D + 512 + lane * 8);
        const uint4 b0 = *(const uint4*)(H2 + (size_t)i1 * D + lane * 8), b1 = *(const uint4*)(H2 + (size_t)i1 * D + 512 + lane * 8);
        *(uint4*)(XG + (size_t)s0 * D + lane * 8) = a0; *(uint4*)(XG + (size_t)s0 * D + 512 + lane * 8) = a1;
        *(uint4*)(XG + (size_t)(s0 + 1) * D + lane * 8) = b0; *(uint4*)(XG + (size_t)(s0 + 1) * D + 512 + lane * 8) = b1;
    }
}

typedef float f32x16 __attribute__((ext_vector_type(16)));
typedef short s16x4 __attribute__((ext_vector_type(4)));
typedef short v4i16_t __attribute__((ext_vector_type(4)));
struct AttnP { const T* Z; const T* QM; const T* KVM; T* O; const float* rpb; const float* sink; int nlat; int need_ctx; float* o32; int fake; };
constexpr int ATT_LDS = 156672 + 2048;
__device__ __forceinline__ int crow(int r, int hi) { return (r & 3) + 8 * (r >> 2) + 4 * hi; }
__device__ __forceinline__ float xhalf_max(float v) { auto rr = __builtin_amdgcn_permlane32_swap(__float_as_uint(v), __float_as_uint(v), false, false); return fmaxf(__uint_as_float(rr[0]), __uint_as_float(rr[1])); }
__device__ __forceinline__ float xhalf_sum(float v) { auto rr = __builtin_amdgcn_permlane32_swap(__float_as_uint(v), __float_as_uint(v), false, false); return __uint_as_float(rr[0]) + __uint_as_float(rr[1]); }
__device__ __forceinline__ unsigned cvtpk(float lo, float hi) { typedef float f2 __attribute__((ext_vector_type(2))); typedef __bf16 b2 __attribute__((ext_vector_type(2))); f2 v = {lo, hi}; b2 b = __builtin_convertvector(v, b2); return __builtin_bit_cast(unsigned, b); }

__device__ __forceinline__ float max3f(float a, float b, float c) { float r; asm("v_max3_f32 %0, %1, %2, %3" : "=v"(r) : "v"(a), "v"(b), "v"(c)); return r; }
template <int BR>
__device__ __forceinline__ void attn_unit_l(ldsp lds, const AttnP& P, int b, int hx, int q0, bool ctxq) {
    constexpr int DQK = (BR == 3) ? 96 : 64, NKS = DQK / 16, KB = (BR == 3) ? 9216 + 4096 : 9216, SLOT = KB + 8192;
    constexpr int R = (BR == 3) ? 5 : 6, PF = R - 1;
    constexpr int BT0 = 107520, QF0 = BT0 + 2048;
    static_assert(R * SLOT <= BT0, "ring");
    constexpr bool PACK2 = (BR == 1 || BR == 2);
    constexpr float SCALE = (BR == 3) ? 0.10206207261596575f : 0.125f;
    constexpr float CL2 = SCALE * 1.4426950408889634f;
    constexpr float NEG = -1e30f, THR = 8.f;
    const int tid = otid(), lane = tid & 63, wid = __builtin_amdgcn_readfirstlane(tid >> 6), r32 = lane & 31, hi = lane >> 5;
    const int tokq = q0 + (PACK2 ? (wid & 3) : wid) * 32 + r32;
    const int head = PACK2 ? hx * 2 + (wid >> 2) : hx;
    const size_t lat0 = (size_t)b * SEQ, ctx0 = (size_t)P.nlat + (size_t)b * CTX;
    const size_t qrow = ctxq ? ctx0 + tokq : lat0 + tokq;
    const ldsp qlds = lds + QF0 + wid * 6144 + lane * 16;
    { const T* qp = (BR == 3) ? P.QM + qrow * 384 + head * 96 + hi * 8 : P.Z + qrow * ZW + (BR == 0 ? NAQ : BR == 1 ? GQ : SQ) + head * 64 + hi * 8;
#pragma unroll
      for (int ks = 0; ks < NKS; ++ks) {
          const uint4 raw = *(const uint4*)(qp + ks * 16);
          typedef unsigned u4 __attribute__((ext_vector_type(4)));
          const u4 w = {cvtpk(__uint_as_float(raw.x << 16) * CL2, __uint_as_float(raw.x & 0xffff0000u) * CL2), cvtpk(__uint_as_float(raw.y << 16) * CL2, __uint_as_float(raw.y & 0xffff0000u) * CL2),
                        cvtpk(__uint_as_float(raw.z << 16) * CL2, __uint_as_float(raw.z & 0xffff0000u) * CL2), cvtpk(__uint_as_float(raw.w << 16) * CL2, __uint_as_float(raw.w & 0xffff0000u) * CL2)};
          *(LAS u4*)(qlds + ks * 1024) = w; } }
    int klo = 0, nlt = 0;
    if (!ctxq) {
        if (BR == 0) { const int r0 = q0 >> 6; const int lo = min(max(r0 - 4, 0), GROWS - 8), hi2 = min(max(r0 - 1, 0), GROWS - 8) + 8; klo = lo * 64; nlt = hi2 - lo; }
        else if (BR == 2) { klo = max(q0 - 128, 0); nlt = (min(q0 + 256, SEQ) - klo) >> 6; }
        else { klo = 0; nlt = SEQ / 64; }
    }
    const int nt = 4 + nlt;
    const T* ksrc; const T* vsrc; const T* rsrc = nullptr; size_t kpitch;
    { const int kk = 8 * wid + (lane >> 3), kch = ((lane & 7) ^ (lane >> 3)) * 8, vch = ((((lane >> 2) ^ (lane >> 4)) & 1) * 32) + (lane & 3) * 8;
      if (BR == 3) { ksrc = P.KVM + (size_t)kk * 512 + hx * 128 + kch; vsrc = P.KVM + (size_t)kk * 512 + hx * 128 + 64 + vch; kpitch = 512;
                     rsrc = P.Z + (size_t)(16 * (wid & 3) + (lane >> 2)) * ZW + MKR + (((lane & 3) ^ ((lane >> 4) & 3)) * 8); }
      else { const int ko = (BR == 0 ? NAK : BR == 1 ? GK : SK) + hx * 64, vo = (BR == 0 ? NAV : BR == 1 ? GV : SV) + hx * 64;
             ksrc = P.Z + (size_t)kk * ZW + ko + kch; vsrc = P.Z + (size_t)kk * ZW + vo + vch; kpitch = ZW; } }
#define A_TROW(t) ((t) < 4 ? ctx0 + (size_t)(t) * 64 : lat0 + (size_t)klo + (size_t)((t) - 4) * 64)
#define A_DMA(t, slot) do { const size_t tr_ = A_TROW(t); const ldsp sb_ = lds + (slot) * SLOT; \
        GLDS16(ksrc + tr_ * kpitch, sb_ + wid * 1152); GLDS16(vsrc + tr_ * kpitch, sb_ + KB + wid * 1024); \
        if (BR == 3) { if (wid < 4) GLDS16(rsrc + tr_ * ZW, sb_ + 9216 + wid * 1024); } } while (0)
#define A_WAITBAR(n) do { if (BR == 3 && wid < 4) asm volatile("s_waitcnt vmcnt(%0) lgkmcnt(0)\n\ts_barrier" :: "n"(3 * (n)) : "memory"); \
                          else asm volatile("s_waitcnt vmcnt(%0) lgkmcnt(0)\n\ts_barrier" :: "n"(2 * (n)) : "memory"); } while (0)
    LAS float* btab = (LAS float*)(lds + BT0);
    if (BR == 0) { if (tid < 465) btab[tid] = P.rpb[hx * 465 + tid] * 1.4426950408889634f; }
    const int qr = (q0 >> 6) + (wid >> 1), qc = (wid & 1) * 32 + r32;
    const int krow0 = min(max(qr - 4, 0), GROWS - 8), kcol0 = min(max(qc - 8, 0), GW - 16);
    float mref = 0.f, lsum = 0.f;
    f32x16 o0, o1, negm;
#pragma unroll
    for (int r = 0; r < 16; ++r) { o0[r] = 0.f; o1[r] = 0.f; negm[r] = 0.f; }
    const unsigned kfo = (r32 >> 3) * 1152 + (r32 & 7) * 128 + ((hi ^ (r32 & 7)) * 16);
    const unsigned rfo = 9216 + r32 * 64 + ((hi ^ ((r32 >> 2) & 3)) * 16);
    const unsigned vfo = KB + (4 * hi + ((lane & 15) >> 2)) * 128 + ((lane >> 3) & 1) * 64 + ((lane >> 4) & 1) * 32 + (lane & 3) * 8;
#define A_ACTIVE(t) (!(BR == 0 && (t) >= 4) || (((klo >> 6) + ((t) - 4)) >= krow0 && ((klo >> 6) + ((t) - 4)) < krow0 + 8))
#define A_QK(p0, p1, slot) do { const ldsp kb_ = lds + (slot) * SLOT; bf16x8 kaf[NKS], kbf[NKS], qkf[NKS]; \
        _Pragma("unroll") for (int ks = 0; ks < NKS; ++ks) { \
            if (ks < 4) { const ldsp a_ = kb_ + (kfo ^ (unsigned)(ks * 32)); kaf[ks] = *(const LAS bf16x8*)(a_); kbf[ks] = *(const LAS bf16x8*)(a_ + 4608); } \
            else { const ldsp a_ = kb_ + (rfo ^ (unsigned)((ks - 4) * 32)); kaf[ks] = *(const LAS bf16x8*)(a_); kbf[ks] = *(const LAS bf16x8*)(a_ + 2048); } \
            qkf[ks] = *(const LAS bf16x8*)(qlds + ks * 1024); } \
        p0 = __builtin_amdgcn_mfma_f32_32x32x16_bf16(kaf[0], qkf[0], negm, 0, 0, 0); p1 = __builtin_amdgcn_mfma_f32_32x32x16_bf16(kbf[0], qkf[0], negm, 0, 0, 0); \
        _Pragma("unroll") for (int ks = 1; ks < NKS; ++ks) { \
          p0 = __builtin_amdgcn_mfma_f32_32x32x16_bf16(kaf[ks], qkf[ks], p0, 0, 0, 0); p1 = __builtin_amdgcn_mfma_f32_32x32x16_bf16(kbf[ks], qkf[ks], p1, 0, 0, 0); } } while (0)
    asm volatile("s_waitcnt lgkmcnt(0)" ::: "memory");
#pragma unroll
    for (int j = 0; j < PF; ++j) { if (j < nt) A_DMA(j, j); }
    if (nt >= PF) A_WAITBAR(PF - 2); else A_WAITBAR(0);
    f32x16 sA0, sA1, sB0, sB1;
    A_QK(sA0, sA1, 0);
    bool act_cur = true;
    int sl = 0;
#define A_STEP(t, pc0, pc1, pn0, pn1) do { \
        const int s1 = (sl + 1 == R) ? 0 : sl + 1, sm = (sl == 0) ? R - 1 : sl - 1; \
        if ((t) + PF < nt) A_DMA((t) + PF, sm);                   \
        const bool act_next = ((t) + 1 < nt) && A_ACTIVE((t) + 1); \
        if (act_next) A_QK(pn0, pn1, s1); \
        if (act_cur) { \
            if (BR == 0) { if ((t) >= 4) { const int dr = (klo >> 6) + ((t) - 4) - qr + 7; \
                    _Pragma("unroll") for (int r = 0; r < 16; ++r) { const int kc0 = crow(r, hi), kc1 = 32 + kc0; \
                        const bool v0 = (unsigned)(kc0 - kcol0) < 16u, v1 = (unsigned)(kc1 - kcol0) < 16u; \
                        const float b0 = btab[dr * 31 + min(max(kc0 - qc + 15, 0), 30)], b1 = btab[dr * 31 + min(max(kc1 - qc + 15, 0), 30)]; \
                        pc0[r] = v0 ? pc0[r] + b0 : NEG; pc1[r] = v1 ? pc1[r] + b1 : NEG; } } } \
            if (BR == 2) { if ((t) >= 4) { const int kb0 = klo + ((t) - 4) * 64 - tokq + 128; \
                    _Pragma("unroll") for (int r = 0; r < 16; ++r) { const int d0 = kb0 + crow(r, hi); \
                        if ((unsigned)d0 > 256u) pc0[r] = NEG; if ((unsigned)(d0 + 32) > 256u) pc1[r] = NEG; } } } \
            float rm; \
            { const float a0 = max3f(pc0[0], pc0[1], pc0[2]), a1 = max3f(pc0[3], pc0[4], pc0[5]), a2 = max3f(pc0[6], pc0[7], pc0[8]), a3 = max3f(pc0[9], pc0[10], pc0[11]), \
                          a4 = max3f(pc0[12], pc0[13], pc0[14]), a5 = max3f(pc0[15], pc1[0], pc1[1]), a6 = max3f(pc1[2], pc1[3], pc1[4]), a7 = max3f(pc1[5], pc1[6], pc1[7]), \
                          a8 = max3f(pc1[8], pc1[9], pc1[10]), a9 = max3f(pc1[11], pc1[12], pc1[13]), a10 = fmaxf(pc1[14], pc1[15]); \
              const float b0 = max3f(a0, a1, a2), b1 = max3f(a3, a4, a5), b2 = max3f(a6, a7, a8), b3 = fmaxf(a9, a10); \
              rm = xhalf_max(fmaxf(fmaxf(b0, b1), fmaxf(b2, b3))); } \
            if ((t) == 0 || __any(rm > THR)) { \
                const float dl = ((t) == 0) ? rm : fmaxf(rm, 0.f); const float f = __builtin_amdgcn_exp2f(-dl); \
                mref += dl; lsum *= f; \
                _Pragma("unroll") for (int r = 0; r < 16; ++r) { pc0[r] -= dl; pc1[r] -= dl; negm[r] -= dl; o0[r] *= f; o1[r] *= f; } \
                if (act_next) { _Pragma("unroll") for (int r = 0; r < 16; ++r) { pn0[r] -= dl; pn1[r] -= dl; } } } \
            _Pragma("unroll") for (int r = 0; r < 16; ++r) { pc0[r] = __builtin_amdgcn_exp2f(pc0[r]); pc1[r] = __builtin_amdgcn_exp2f(pc1[r]); } \
            { float s8[8]; _Pragma("unroll") for (int r = 0; r < 8; ++r) s8[r] = (pc0[r] + pc0[r + 8]) + (pc1[r] + pc1[r + 8]); \
              lsum += ((s8[0] + s8[1]) + (s8[2] + s8[3])) + ((s8[4] + s8[5]) + (s8[6] + s8[7])); } \
            const ldsp vb = lds + sl * SLOT + vfo, vb1 = lds + sl * SLOT + (vfo ^ 64u); \
            bf16x8 pf[4]; \
            _Pragma("unroll") for (int s = 0; s < 4; ++s) { const int rb = (s & 1) * 8; typedef unsigned u4 __attribute__((ext_vector_type(4))); u4 ww; \
                  if (s < 2) ww = (u4){cvtpk(pc0[rb], pc0[rb + 1]), cvtpk(pc0[rb + 2], pc0[rb + 3]), cvtpk(pc0[rb + 4], pc0[rb + 5]), cvtpk(pc0[rb + 6], pc0[rb + 7])}; \
                  else       ww = (u4){cvtpk(pc1[rb], pc1[rb + 1]), cvtpk(pc1[rb + 2], pc1[rb + 3]), cvtpk(pc1[rb + 4], pc1[rb + 5]), cvtpk(pc1[rb + 6], pc1[rb + 7])}; \
                  pf[s] = __builtin_bit_cast(bf16x8, ww); } \
            s16x4 vl0[4], vh0[4], vl1[4], vh1[4]; \
            _Pragma("unroll") for (int s = 0; s < 4; ++s) { vl0[s] = __builtin_bit_cast(s16x4, __builtin_amdgcn_ds_read_tr16_b64_v4i16((LAS v4i16_t*)(vb + s * 2048))); vh0[s] = __builtin_bit_cast(s16x4, __builtin_amdgcn_ds_read_tr16_b64_v4i16((LAS v4i16_t*)(vb + s * 2048 + 1024))); } \
            _Pragma("unroll") for (int s = 0; s < 4; ++s) { vl1[s] = __builtin_bit_cast(s16x4, __builtin_amdgcn_ds_read_tr16_b64_v4i16((LAS v4i16_t*)(vb1 + s * 2048))); vh1[s] = __builtin_bit_cast(s16x4, __builtin_amdgcn_ds_read_tr16_b64_v4i16((LAS v4i16_t*)(vb1 + s * 2048 + 1024))); } \
            _Pragma("unroll") for (int s = 0; s < 4; ++s) { const bf16x8 vf = (bf16x8){vl0[s][0], vl0[s][1], vl0[s][2], vl0[s][3], vh0[s][0], vh0[s][1], vh0[s][2], vh0[s][3]}; o0 = __builtin_amdgcn_mfma_f32_32x32x16_bf16(vf, pf[s], o0, 0, 0, 0); } \
            _Pragma("unroll") for (int s = 0; s < 4; ++s) { const bf16x8 vf = (bf16x8){vl1[s][0], vl1[s][1], vl1[s][2], vl1[s][3], vh1[s][0], vh1[s][1], vh1[s][2], vh1[s][3]}; o1 = __builtin_amdgcn_mfma_f32_32x32x16_bf16(vf, pf[s], o1, 0, 0, 0); } \
        } \
          \
        if ((t) + PF < nt) A_WAITBAR(PF - 2); else A_WAITBAR(0); \
        act_cur = act_next; sl = s1; \
    } while (0)
    { int t = 0;
      for (; t + 1 < nt; t += 2) { A_STEP(t, sA0, sA1, sB0, sB1); A_STEP(t + 1, sB0, sB1, sA0, sA1); }
      if (t < nt) A_STEP(t, sA0, sA1, sB0, sB1); }
    float ltot = xhalf_sum(lsum);
    if (BR == 2) ltot += __builtin_amdgcn_exp2f(P.sink[head] * 1.4426950408889634f - mref);
    const float inv = 1.f / ltot;
#ifdef PROBE_ATTN
    if (P.o32 && b == 1 && (ctxq || tokq < 1024 || tokq >= 7168)) {
        const int sub = ctxq ? 2048 + tokq : (tokq < 1024 ? tokq : 1024 + tokq - 7168);
        float* fp = P.o32 + (size_t)sub * D + BR * 256 + head * 64 + 4 * hi;
#pragma unroll
        for (int g = 0; g < 4; ++g)
#pragma unroll
            for (int j = 0; j < 4; ++j) { fp[8 * g + j] = o0[4 * g + j] * inv; fp[32 + 8 * g + j] = o1[4 * g + j] * inv; }
    }
#endif
    T* op = P.O + qrow * D + BR * 256 + head * 64 + 4 * hi;
#pragma unroll
    for (int g = 0; g < 4; ++g) {
        *(uint2*)(op + 8 * g) = pk4(o0[4 * g] * inv, o0[4 * g + 1] * inv, o0[4 * g + 2] * inv, o0[4 * g + 3] * inv);
        *(uint2*)(op + 32 + 8 * g) = pk4(o1[4 * g] * inv, o1[4 * g + 1] * inv, o1[4 * g + 2] * inv, o1[4 * g + 3] * inv);
    }
#undef A_TROW
#undef A_DMA
#undef A_WAITBAR
#undef A_ACTIVE
#undef A_QK
#undef A_STEP
}


template <int BR>
__device__ __forceinline__ void attn_unit(ldsp lds, const AttnP& P, int b, int hx, int q0, bool ctxq) {
    constexpr int DQK = (BR == 3) ? 96 : 64, NKS = DQK / 16, KB = (BR == 3) ? 9216 + 4096 : 9216, SLOT = KB + 8192;
    constexpr int R = (BR == 3) ? 7 : 9, PF = R - 3;
    constexpr int BT0 = 156672;
    static_assert(R * SLOT <= BT0, "ring");
    constexpr bool PACK2 = (BR == 1 || BR == 2);
    constexpr float SCALE = (BR == 3) ? 0.10206207261596575f : 0.125f;
    constexpr float CL2 = SCALE * 1.4426950408889634f;
    constexpr float NEG = -1e30f, THR = 8.f;
    const int tid = otid(), lane = tid & 63, wid = __builtin_amdgcn_readfirstlane(tid >> 6), r32 = lane & 31, hi = lane >> 5;
    const int tokq = q0 + (PACK2 ? (wid & 3) : wid) * 32 + r32;
    const int head = PACK2 ? hx * 2 + (wid >> 2) : hx;
    const size_t lat0 = (size_t)b * SEQ, ctx0 = (size_t)P.nlat + (size_t)b * CTX;
    const size_t qrow = ctxq ? ctx0 + tokq : lat0 + tokq;
    bf16x8 qf[NKS];
    { const T* qp = (BR == 3) ? P.QM + qrow * 384 + head * 96 + hi * 8 : P.Z + qrow * ZW + (BR == 0 ? NAQ : BR == 1 ? GQ : SQ) + head * 64 + hi * 8;
#pragma unroll
      for (int ks = 0; ks < NKS; ++ks) {
          const uint4 raw = *(const uint4*)(qp + ks * 16);
          typedef unsigned u4 __attribute__((ext_vector_type(4)));
          const u4 w = {cvtpk(__uint_as_float(raw.x << 16) * CL2, __uint_as_float(raw.x & 0xffff0000u) * CL2), cvtpk(__uint_as_float(raw.y << 16) * CL2, __uint_as_float(raw.y & 0xffff0000u) * CL2),
                        cvtpk(__uint_as_float(raw.z << 16) * CL2, __uint_as_float(raw.z & 0xffff0000u) * CL2), cvtpk(__uint_as_float(raw.w << 16) * CL2, __uint_as_float(raw.w & 0xffff0000u) * CL2)};
          qf[ks] = __builtin_bit_cast(bf16x8, w); } }
    int klo = 0, nlt = 0;
    if (!ctxq) {
        if (BR == 0) { const int r0 = q0 >> 6; const int lo = min(max(r0 - 4, 0), GROWS - 8), hi2 = min(max(r0 - 1, 0), GROWS - 8) + 8; klo = lo * 64; nlt = hi2 - lo; }
        else if (BR == 2) { klo = max(q0 - 128, 0); nlt = (min(q0 + 256, SEQ) - klo) >> 6; }
        else { klo = 0; nlt = SEQ / 64; }
    }
    const int nt = 4 + nlt;
    const T* ksrc; const T* vsrc; const T* rsrc = nullptr; size_t kpitch;
    { const int kk = 8 * wid + (lane >> 3), kch = ((lane & 7) ^ (lane >> 3)) * 8, vch = ((((lane >> 2) ^ (lane >> 4)) & 1) * 32) + (lane & 3) * 8;
      if (BR == 3) { ksrc = P.KVM + (size_t)kk * 512 + hx * 128 + kch; vsrc = P.KVM + (size_t)kk * 512 + hx * 128 + 64 + vch; kpitch = 512;
                     rsrc = P.Z + (size_t)(16 * (wid & 3) + (lane >> 2)) * ZW + MKR + (((lane & 3) ^ ((lane >> 4) & 3)) * 8); }
      else { const int ko = (BR == 0 ? NAK : BR == 1 ? GK : SK) + hx * 64, vo = (BR == 0 ? NAV : BR == 1 ? GV : SV) + hx * 64;
             ksrc = P.Z + (size_t)kk * ZW + ko + kch; vsrc = P.Z + (size_t)kk * ZW + vo + vch; kpitch = ZW; } }
#define A_TROW(t) ((t) < 4 ? ctx0 + (size_t)(t) * 64 : lat0 + (size_t)klo + (size_t)((t) - 4) * 64)
#define A_DMA(t, slot) do { if (wid < 4) { const size_t tr_ = A_TROW(t); const ldsp sb_ = lds + (slot) * SLOT; \
        GLDS16(ksrc + tr_ * kpitch, sb_ + wid * 1152); GLDS16(ksrc + (tr_ + 32) * kpitch, sb_ + (wid + 4) * 1152); \
        GLDS16(vsrc + tr_ * kpitch, sb_ + KB + wid * 1024); GLDS16(vsrc + (tr_ + 32) * kpitch, sb_ + KB + (wid + 4) * 1024); \
        if (BR == 3) GLDS16(rsrc + tr_ * ZW, sb_ + 9216 + wid * 1024); } } while (0)
#define A_WAITBAR(n) do { if (wid < 4) { if (BR == 3) asm volatile("s_waitcnt vmcnt(%0) lgkmcnt(0)\n\ts_barrier" :: "n"(5 * (n)) : "memory"); \
                                         else asm volatile("s_waitcnt vmcnt(%0) lgkmcnt(0)\n\ts_barrier" :: "n"(4 * (n)) : "memory"); } \
                          else asm volatile("s_waitcnt lgkmcnt(0)\n\ts_barrier" ::: "memory"); } while (0)
    LAS float* btab = (LAS float*)(lds + BT0);
    if (BR == 0) { if (tid < 465) btab[tid] = P.rpb[hx * 465 + tid] * 1.4426950408889634f; }
    const int qr = (q0 >> 6) + (wid >> 1), qc = (wid & 1) * 32 + r32;
    const int krow0 = min(max(qr - 4, 0), GROWS - 8), kcol0 = min(max(qc - 8, 0), GW - 16);
    float mref = 0.f, lsum = 0.f;
    f32x16 o0, o1, negm;
#pragma unroll
    for (int r = 0; r < 16; ++r) { o0[r] = 0.f; o1[r] = 0.f; negm[r] = 0.f; }
    const unsigned kfo = (r32 >> 3) * 1152 + (r32 & 7) * 128 + ((hi ^ (r32 & 7)) * 16);
    const unsigned rfo = 9216 + r32 * 64 + ((hi ^ ((r32 >> 2) & 3)) * 16);
    const unsigned vfo = KB + (4 * hi + ((lane & 15) >> 2)) * 128 + ((lane >> 3) & 1) * 64 + ((lane >> 4) & 1) * 32 + (lane & 3) * 8;
    constexpr int NG = 8 + 2 * NKS, AHEAD = 4, NGT = NG;
    if (wid < 4) { const size_t tr_ = A_TROW(0); GLDS16(vsrc + tr_ * kpitch, lds + (R - 1) * SLOT + KB + wid * 1024); GLDS16(vsrc + (tr_ + 32) * kpitch, lds + (R - 1) * SLOT + KB + (wid + 4) * 1024); }
#pragma unroll
    for (int j = 0; j < PF; ++j) { if (j < nt) A_DMA(j, j); }
    if (nt >= PF) A_WAITBAR(PF - 3); else A_WAITBAR(0);
    f32x16 sA0, sA1, sB0, sB1;
    { const ldsp kb_ = lds;
#pragma unroll
      for (int r = 0; r < 16; ++r) { sA0[r] = 0.f; sA1[r] = 0.f; }
#pragma unroll
      for (int ks = 0; ks < NKS; ++ks) { const ldsp a_ = kb_ + ((ks < 4) ? (kfo ^ (unsigned)(ks * 32)) : (rfo ^ (unsigned)((ks - 4) * 32)));
          const bf16x8 ka = *(const LAS bf16x8*)(a_), kb = *(const LAS bf16x8*)(a_ + ((ks < 4) ? 4608 : 2048));
          sA0 = __builtin_amdgcn_mfma_f32_32x32x16_bf16(ka, qf[ks], sA0, 0, 0, 0); sA1 = __builtin_amdgcn_mfma_f32_32x32x16_bf16(kb, qf[ks], sA1, 0, 0, 0); } }
    unsigned pwA[16], pwB[16];
#pragma unroll
    for (int i = 0; i < 16; ++i) { pwA[i] = 0u; pwB[i] = 0u; }
    int sl = 0;
#ifdef PROBE_T
    unsigned long long pt_acc = 0ull, pt_a = 0ull, pt_b = 0ull; const unsigned long long pt_t0 = __builtin_amdgcn_s_memtime(), pt_r0 = __builtin_amdgcn_s_memrealtime();
#define PT_A(k) do { if (PROBE_T == (k)) pt_a = __builtin_amdgcn_s_memtime(); } while (0)
#define PT_B(k) do { if (PROBE_T == (k)) { pt_b = __builtin_amdgcn_s_memtime(); pt_acc += pt_b - pt_a; } } while (0)
#else
#define PT_A(k) do { } while (0)
#define PT_B(k) do { } while (0)
#endif
#define S_EL(c0, c1, i) ((i) < 16 ? c0[(i) & 15] : c1[(i) & 15])
#define SB0() __builtin_amdgcn_sched_barrier(0)
    const unsigned lds0 = (unsigned)(size_t)lds;
#define DSR128(dst, addr, OFF) asm volatile("ds_read_b128 %0, %1 offset:" #OFF : "=v"(dst) : "v"(addr))
#define DSRTR(dst, addr, OFF) asm volatile("ds_read_b64_tr_b16 %0, %1 offset:" #OFF : "=v"(dst) : "v"(addr))
#define A_RD(m) do { switch (m) { \
        case 0: DSRTR(vL[0], vb_, 0); DSRTR(vH[0], vb_, 1024); break; case 1: DSRTR(vL[1], vc_, 0); DSRTR(vH[1], vc_, 1024); break; \
        case 2: DSRTR(vL[2], vb_, 2048); DSRTR(vH[2], vb_, 3072); break; case 3: DSRTR(vL[3], vc_, 2048); DSRTR(vH[3], vc_, 3072); break; \
        case 4: DSRTR(vL[4], vb_, 4096); DSRTR(vH[4], vb_, 5120); break; case 5: DSRTR(vL[5], vc_, 4096); DSRTR(vH[5], vc_, 5120); break; \
        case 6: DSRTR(vL[6], vb_, 6144); DSRTR(vH[6], vb_, 7168); break; case 7: DSRTR(vL[7], vc_, 6144); DSRTR(vH[7], vc_, 7168); break; \
        default: { const int q_ = (m) - 8, ks_ = q_ >> 1; \
                   if (ks_ < 4) { const unsigned a_ = kb_ + (kfo ^ (unsigned)(ks_ * 32)); if (q_ & 1) DSR128(kF[q_], a_, 4608); else DSR128(kF[q_], a_, 0); } \
                   else { const unsigned a_ = kb_ + (rfo ^ (unsigned)((ks_ - 4) * 32)); if (q_ & 1) DSR128(kF[q_], a_, 2048); else DSR128(kF[q_], a_, 0); } } break; } } while (0)
#define NRD(m) ((m) < 8 ? 2 : 1)
#define A_WT(g, n) do { if ((g) < 8) { if ((n) == 0) asm volatile("s_waitcnt lgkmcnt(0)" : "+v"(vL[g]), "+v"(vH[g])); else if ((n) == 1) asm volatile("s_waitcnt lgkmcnt(1)" : "+v"(vL[g]), "+v"(vH[g])); \
            else if ((n) == 2) asm volatile("s_waitcnt lgkmcnt(2)" : "+v"(vL[g]), "+v"(vH[g])); else if ((n) == 3) asm volatile("s_waitcnt lgkmcnt(3)" : "+v"(vL[g]), "+v"(vH[g])); \
            else if ((n) == 4) asm volatile("s_waitcnt lgkmcnt(4)" : "+v"(vL[g]), "+v"(vH[g])); else if ((n) == 5) asm volatile("s_waitcnt lgkmcnt(5)" : "+v"(vL[g]), "+v"(vH[g])); \
            else if ((n) == 6) asm volatile("s_waitcnt lgkmcnt(6)" : "+v"(vL[g]), "+v"(vH[g])); else if ((n) == 7) asm volatile("s_waitcnt lgkmcnt(7)" : "+v"(vL[g]), "+v"(vH[g])); \
            else asm volatile("s_waitcnt lgkmcnt(8)" : "+v"(vL[g]), "+v"(vH[g])); } \
        else { if ((n) == 0) asm volatile("s_waitcnt lgkmcnt(0)" : "+v"(kF[(g) - 8])); else if ((n) == 1) asm volatile("s_waitcnt lgkmcnt(1)" : "+v"(kF[(g) - 8])); \
            else if ((n) == 2) asm volatile("s_waitcnt lgkmcnt(2)" : "+v"(kF[(g) - 8])); else if ((n) == 3) asm volatile("s_waitcnt lgkmcnt(3)" : "+v"(kF[(g) - 8])); \
            else asm volatile("s_waitcnt lgkmcnt(4)" : "+v"(kF[(g) - 8])); } } while (0)
#define A_ITER(t, c0, c1, n0, n1, pwO, pwN, EVEN) do { \
        const int s1 = (sl + 1 == R) ? 0 : sl + 1, sm1 = (sl == 0) ? R - 1 : sl - 1, sm2 = (sm1 == 0) ? R - 1 : sm1 - 1; \
        const bool feed = (t) + PF < nt; PT_A(4); \
        if (BR == 2) { if ((t) >= 4) { const int kb0 = klo + ((t) - 4) * 64 - tokq + 128; \
                _Pragma("unroll") for (int r = 0; r < 16; ++r) { const int d0 = kb0 + crow(r, hi); \
                    if ((unsigned)d0 > 256u) c0[r] = NEG; if ((unsigned)(d0 + 32) > 256u) c1[r] = NEG; } } } \
          \
        const unsigned vb_ = lds0 + sm1 * SLOT + vfo, vc_ = lds0 + sm1 * SLOT + (vfo ^ 64u); const unsigned kb_ = lds0 + s1 * SLOT; \
        s16x4 vL[8], vH[8]; bf16x8 kF[2 * NKS]; \
        _Pragma("unroll") for (int m = 0; m < AHEAD; ++m) A_RD(m); \
        float rm; \
        { const float a0 = max3f(c0[0], c0[1], c0[2]), a1 = max3f(c0[3], c0[4], c0[5]), a2 = max3f(c0[6], c0[7], c0[8]), a3 = max3f(c0[9], c0[10], c0[11]), \
                      a4 = max3f(c0[12], c0[13], c0[14]), a5 = max3f(c0[15], c1[0], c1[1]), a6 = max3f(c1[2], c1[3], c1[4]), a7 = max3f(c1[5], c1[6], c1[7]), \
                      a8 = max3f(c1[8], c1[9], c1[10]), a9 = max3f(c1[11], c1[12], c1[13]), a10 = fmaxf(c1[14], c1[15]); \
          const float b0 = max3f(a0, a1, a2), b1 = max3f(a3, a4, a5), b2 = max3f(a6, a7, a8), b3 = fmaxf(a9, a10); \
          rm = xhalf_max(fmaxf(fmaxf(b0, b1), fmaxf(b2, b3))); } \
        if ((t) == 0 || __any(rm > THR)) {                   \
            const float dl = ((t) == 0) ? rm : fmaxf(rm, 0.f); const float f = __builtin_amdgcn_exp2f(-dl); \
            mref += dl; lsum *= f; \
            _Pragma("unroll") for (int r = 0; r < 16; ++r) { c0[r] -= dl; c1[r] -= dl; o0[r] *= f; o1[r] *= f; negm[r] -= dl; } \
            _Pragma("unroll") for (int i = 0; i < 16; ++i) pwO[i] = cvtpk(__uint_as_float(pwO[i] << 16) * f, __uint_as_float(pwO[i] & 0xffff0000u) * f); } \
        float acs0 = 0.f, acs1 = 0.f; SB0(); PT_B(4); PT_A(5); \
        _Pragma("unroll") for (int g = 0; g < NGT; ++g) { \
              \
            if (g + AHEAD < NG) A_RD(g + AHEAD); \
              \
            if (g < NG) { int n_ = 0; _Pragma("unroll") for (int m = g + 1; m <= g + AHEAD; ++m) if (m < NG) n_ += NRD(m); A_WT(g, n_); } \
              \
            if (g < 8) { typedef unsigned u4 __attribute__((ext_vector_type(4))); const int s = g >> 1; \
                const u4 pw4 = {pwO[4 * s], pwO[4 * s + 1], pwO[4 * s + 2], pwO[4 * s + 3]}; const bf16x8 pfr = __builtin_bit_cast(bf16x8, pw4); \
                const bf16x8 vf = (bf16x8){vL[g][0], vL[g][1], vL[g][2], vL[g][3], vH[g][0], vH[g][1], vH[g][2], vH[g][3]}; \
                if ((g & 1) == 0) o0 = __builtin_amdgcn_mfma_f32_32x32x16_bf16(vf, pfr, o0, 0, 0, 0); else o1 = __builtin_amdgcn_mfma_f32_32x32x16_bf16(vf, pfr, o1, 0, 0, 0); } \
            else if (g < NG) { const int q_ = g - 8, ks = q_ >> 1; \
                if ((q_ & 1) == 0) n0 = __builtin_amdgcn_mfma_f32_32x32x16_bf16(kF[q_], qf[ks], ks == 0 ? negm : n0, 0, 0, 0); \
                else               n1 = __builtin_amdgcn_mfma_f32_32x32x16_bf16(kF[q_], qf[ks], ks == 0 ? negm : n1, 0, 0, 0); } \
              \
              \
            { const int sx = (NG == 20) ? ((g % 5 == 4) ? -1 : g - g / 5) : (g < 16 ? g : -1); \
            if (sx >= 0) { const float e0 = __builtin_amdgcn_exp2f(S_EL(c0, c1, 2 * sx)), e1 = __builtin_amdgcn_exp2f(S_EL(c0, c1, 2 * sx + 1)); \
                pwN[sx] = cvtpk(e0, e1); \
                  \
                { float t_ = e0 + e1; asm volatile("" : "+v"(t_)); if ((sx & 1) == 0) { acs0 += t_; asm volatile("" : "+v"(acs0)); } else { acs1 += t_; asm volatile("" : "+v"(acs1)); } } } } \
            SB0(); \
        } \
        lsum += acs0 + acs1; PT_B(5); PT_A(3); \
          \
          \
        if (EVEN) { const int sp0 = (sl + PF >= R) ? sl + PF - R : sl + PF, sp1 = (sp0 + 1 == R) ? 0 : sp0 + 1; \
                    if (feed) A_DMA((t) + PF, sp0); if ((t) + PF + 1 < nt) A_DMA((t) + PF + 1, sp1); \
                    if ((t) + 1 >= nt) A_WAITBAR(0); } \
        else { if ((t) + PF < nt) A_WAITBAR(PF - 3); else A_WAITBAR(0); } PT_B(3); \
        sl = s1; \
    } while (0)
    { int t = 0;
      for (; t + 1 < nt; t += 2) { A_ITER(t, sA0, sA1, sB0, sB1, pwA, pwB, 1); A_ITER(t + 1, sB0, sB1, sA0, sA1, pwB, pwA, 0); }
      if (t < nt) { A_ITER(t, sA0, sA1, sB0, sB1, pwA, pwB, 1);
#pragma unroll
          for (int i = 0; i < 16; ++i) pwA[i] = pwB[i]; } }
    { const int sm1 = (sl == 0) ? R - 1 : sl - 1; const ldsp vb_ = lds + sm1 * SLOT + vfo, vc_ = lds + sm1 * SLOT + (vfo ^ 64u);
#pragma unroll
      for (int s = 0; s < 4; ++s) {
          typedef unsigned u4 __attribute__((ext_vector_type(4))); const u4 pw4 = {pwA[4 * s], pwA[4 * s + 1], pwA[4 * s + 2], pwA[4 * s + 3]}; const bf16x8 pfr = __builtin_bit_cast(bf16x8, pw4);
#pragma unroll
          for (int d0 = 0; d0 < 2; ++d0) { const ldsp vp = (d0 ? vc_ : vb_) + s * 2048;
              const s16x4 lo = __builtin_bit_cast(s16x4, __builtin_amdgcn_ds_read_tr16_b64_v4i16((LAS v4i16_t*)vp)), hi4 = __builtin_bit_cast(s16x4, __builtin_amdgcn_ds_read_tr16_b64_v4i16((LAS v4i16_t*)(vp + 1024)));
              const bf16x8 vf = (bf16x8){lo[0], lo[1], lo[2], lo[3], hi4[0], hi4[1], hi4[2], hi4[3]};
              if (d0 == 0) o0 = __builtin_amdgcn_mfma_f32_32x32x16_bf16(vf, pfr, o0, 0, 0, 0); else o1 = __builtin_amdgcn_mfma_f32_32x32x16_bf16(vf, pfr, o1, 0, 0, 0); }
          } }
    asm volatile("s_waitcnt lgkmcnt(0)\n\ts_barrier" ::: "memory");
#ifdef PROBE_T
    if (BR == PROBE_BR && P.o32 && blockIdx.x == 0 && wid == PROBE_W && lane == 0) {
        const unsigned long long t1 = __builtin_amdgcn_s_memtime(), r1 = __builtin_amdgcn_s_memrealtime();
        float c;
        if (PROBE_T == 1) c = 1e-5f * (float)(t1 - pt_t0) / (float)nt;
        else if (PROBE_T == 2) c = 1e-3f * (float)(t1 - pt_t0) / (float)(r1 - pt_r0);
        else c = 1e-5f * (float)pt_acc / (float)nt;
        P.o32[0] = 1.f + c;
    }
#endif
#undef S_EL
#undef SB0
#undef A_ITER
#undef A_RD
#undef NRD
#undef A_WT
#undef DSR128
#undef DSRTR
    float ltot = xhalf_sum(lsum);
    if (BR == 2) ltot += __builtin_amdgcn_exp2f(P.sink[head] * 1.4426950408889634f - mref);
    const float inv = 1.f / ltot;
#ifdef PROBE_ATTN
    if (P.o32 && b == 1 && (ctxq || tokq < 1024 || tokq >= 7168)) {
        const int sub = ctxq ? 2048 + tokq : (tokq < 1024 ? tokq : 1024 + tokq - 7168);
        float* fp = P.o32 + (size_t)sub * D + BR * 256 + head * 64 + 4 * hi;
#pragma unroll
        for (int g = 0; g < 4; ++g)
#pragma unroll
            for (int j = 0; j < 4; ++j) { fp[8 * g + j] = o0[4 * g + j] * inv; fp[32 + 8 * g + j] = o1[4 * g + j] * inv; }
    }
#endif
    T* op = P.O + qrow * D + BR * 256 + head * 64 + 4 * hi;
#pragma unroll
    for (int g = 0; g < 4; ++g) {
        *(uint2*)(op + 8 * g) = pk4(o0[4 * g] * inv, o0[4 * g + 1] * inv, o0[4 * g + 2] * inv, o0[4 * g + 3] * inv);
        *(uint2*)(op + 32 + 8 * g) = pk4(o1[4 * g] * inv, o1[4 * g + 1] * inv, o1[4 * g + 2] * inv, o1[4 * g + 3] * inv);
    }
#undef A_TROW
#undef A_DMA
#undef A_WAITBAR
#undef A_ACTIVE
#undef A_QK
#undef A_STEP
}

__device__ __forceinline__ void attn_phase(ldsp lds, const AttnP& P, int bid, int nblk) {
    for (int u = bid; u < 512; u += nblk) attn_unit<3>(lds, P, u >> 7, (u >> 5) & 3, (u & 31) * 256, false);
    for (int u = bid; u < 512; u += nblk) attn_unit<1>(lds, P, u >> 7, (u >> 6) & 1, (u & 63) * 128, false);
    for (int u = bid; u < 512; u += nblk) attn_unit_l<0>(lds, P, u >> 7, (u >> 5) & 3, (u & 31) * 256, false);
    for (int u = bid; u < 512; u += nblk) attn_unit<2>(lds, P, u >> 7, (u >> 6) & 1, (u & 63) * 128, false);
    if (P.need_ctx) {
        for (int u = bid; u < 64; u += nblk) {
            const int br = u >> 4, bb = (u >> 2) & 3, x = u & 3;
            if (br == 0) attn_unit_l<0>(lds, P, bb, x, 0, true);
            else if (br == 1) attn_unit<1>(lds, P, bb, x >> 1, (x & 1) * 128, true);
            else if (br == 2) attn_unit<2>(lds, P, bb, x >> 1, (x & 1) * 128, true);
            else attn_unit<3>(lds, P, bb, x, 0, true);
        }
    }
}

constexpr size_t al256(size_t b) { return (b + 255) & ~(size_t)255; }
constexpr size_t NSLOT_ = (size_t)NB * NE * (CAP + CAPC);
constexpr size_t OFF_BAR = 0, OFF_MODV = OFF_BAR + al256(3456 * 4), OFF_TAB64 = OFF_MODV + al256((size_t)NL * 5 * MODW * 4), OFF_TAB32 = OFF_TAB64 + al256(128 * 16 * 8),
    OFF_RA = OFF_TAB32 + al256(128 * 8 * 8), OFF_RC = OFF_RA + al256((size_t)NROW * D * 2), OFF_XCA = OFF_RC + al256((size_t)NROW * D * 2), OFF_XCB = OFF_XCA + al256((size_t)NCTX * D * 4),
    OFF_AFF = OFF_XCB + al256((size_t)NCTX * D * 4), OFF_IDX = OFF_AFF + al256((size_t)NROW * NE * 4), OFF_GATEV = OFF_IDX + al256(NSLOT_ * 4), OFF_INV = OFF_GATEV + al256(NSLOT_ * 4),
    OFF_Z = OFF_INV + al256((size_t)NROW * NE * 4), OFF_WINT = OFF_Z + al256((size_t)NROW * ZW * 2), OFF_WQT = OFF_WINT + al256((size_t)NL * 6400 * D * 2), OFF_WKVT = OFF_WQT + al256((size_t)NL * 384 * 192 * 2),
    OFF_SS = OFF_WKVT + al256((size_t)NL * 512 * 128 * 2), OFF_WBT = OFF_SS + al256((size_t)NROW * 8 * 4), OFF_WOUTT = OFF_WBT + al256((size_t)NL * 4 * 1024 * 256 * 2), OFF_END = OFF_WOUTT + al256((size_t)NL * D * D * 2);
struct MP {
    const float *x_, *c_, *ctx_, *c_ctx_, *w_mod_, *b_mod_, *w_in_, *na_rpb_, *gqn_, *gkn_, *swa_sink_, *mqn_, *mkvn_, *w_qb_, *w_kvb_, *w_branch_, *w_out_,
                *ln1g_, *ln1b_, *ln2g_, *ln2b_, *w_router_, *w_gate_, *w_up_, *w_down_;
    float* out_; char* ws_;
    float* o32_; const float* pscale_;
    int ph_lo_, ph_hi_;
    __device__ __forceinline__ const float* x() const { return x_; }
    __device__ __forceinline__ const float* c() const { return c_; }
    __device__ __forceinline__ const float* ctx() const { return ctx_; }
    __device__ __forceinline__ const float* c_ctx() const { return c_ctx_; }
    __device__ __forceinline__ const float* w_mod() const { return w_mod_; }
    __device__ __forceinline__ const float* b_mod() const { return b_mod_; }
    __device__ __forceinline__ const float* w_in() const { return w_in_; }
    __device__ __forceinline__ const float* na_rpb() const { return na_rpb_; }
    __device__ __forceinline__ const float* gqn() const { return gqn_; }
    __device__ __forceinline__ const float* gkn() const { return gkn_; }
    __device__ __forceinline__ const float* swa_sink() const { return swa_sink_; }
    __device__ __forceinline__ const float* mqn() const { return mqn_; }
    __device__ __forceinline__ const float* mkvn() const { return mkvn_; }
    __device__ __forceinline__ const float* w_qb() const { return w_qb_; }
    __device__ __forceinline__ const float* w_kvb() const { return w_kvb_; }
    __device__ __forceinline__ const float* w_branch() const { return w_branch_; }
    __device__ __forceinline__ const float* w_out() const { return w_out_; }
    __device__ __forceinline__ const float* ln1g() const { return ln1g_; }
    __device__ __forceinline__ const float* ln1b() const { return ln1b_; }
    __device__ __forceinline__ const float* ln2g() const { return ln2g_; }
    __device__ __forceinline__ const float* ln2b() const { return ln2b_; }
    __device__ __forceinline__ const float* w_router() const { return w_router_; }
    __device__ __forceinline__ const float* w_gate() const { return w_gate_; }
    __device__ __forceinline__ const float* w_up() const { return w_up_; }
    __device__ __forceinline__ const float* w_down() const { return w_down_; }
    __device__ __forceinline__ float* out() const { return out_; }
    __device__ __forceinline__ char* ws() const { return ws_; }
    __device__ __forceinline__ float* o32() const { return o32_; }
    __device__ __forceinline__ const float* pscale() const { return pscale_; }
    __device__ __forceinline__ int ph_lo() const { return ph_lo_; }
    __device__ __forceinline__ int ph_hi() const { return ph_hi_; }
    __device__ __forceinline__ unsigned* bar() const { return (unsigned*)(ws() + OFF_BAR); }
    __device__ __forceinline__ float* modv() const { return (float*)(ws() + OFF_MODV); }
    __device__ __forceinline__ float2* tab64() const { return (float2*)(ws() + OFF_TAB64); }
    __device__ __forceinline__ float2* tab32() const { return (float2*)(ws() + OFF_TAB32); }
    __device__ __forceinline__ T* RA() const { return (T*)(ws() + OFF_RA); }
    __device__ __forceinline__ T* RC() const { return (T*)(ws() + OFF_RC); }
    __device__ __forceinline__ float* XCa() const { return (float*)(ws() + OFF_XCA); }
    __device__ __forceinline__ float* XCb() const { return (float*)(ws() + OFF_XCB); }
    __device__ __forceinline__ float* AFF() const { return (float*)(ws() + OFF_AFF); }
    __device__ __forceinline__ int* IDX() const { return (int*)(ws() + OFF_IDX); }
    __device__ __forceinline__ float* GATEV() const { return (float*)(ws() + OFF_GATEV); }
    __device__ __forceinline__ int* INV() const { return (int*)(ws() + OFF_INV); }
    __device__ __forceinline__ T* Z() const { return (T*)(ws() + OFF_Z); }
    __device__ __forceinline__ T* WinT() const { return (T*)(ws() + OFF_WINT); }
    __device__ __forceinline__ T* WqT() const { return (T*)(ws() + OFF_WQT); }
    __device__ __forceinline__ T* WkvT() const { return (T*)(ws() + OFF_WKVT); }
    __device__ __forceinline__ float* SS() const { return (float*)(ws() + OFF_SS); }
    __device__ __forceinline__ T* WbT() const { return (T*)(ws() + OFF_WBT); }
    __device__ __forceinline__ T* WoutT() const { return (T*)(ws() + OFF_WOUTT); }
};

__device__ __forceinline__ void ph_mod(ldsp lds, const MP& p, int bid, int nblk) {
    LAS float* sc = (LAS float*)lds;
    LAS float* red = (LAS float*)(lds + 5 * 1024 * 4);
    const int tid = otid(), lane = tid & 63, kg = tid >> 6;
    for (int i = tid; i < 5 * 1024; i += 512) { const int s = i >> 10, k = i & 1023; const float v = s < 4 ? p.c()[s * 1024 + k] : p.c_ctx()[k]; sc[i] = v / (1.f + expf(-v)); }
    __syncthreads();
    for (int u = bid; u < NL * (MODW / 64); u += nblk) {
        const int l = u / (MODW / 64), j = (u % (MODW / 64)) * 64 + lane;
        float acc[5] = {0.f, 0.f, 0.f, 0.f, 0.f};
        const float* w = p.w_mod() + (size_t)l * D * MODW + j;
        for (int k = kg * 128; k < kg * 128 + 128; ++k) { const float wv = w[(size_t)k * MODW];
#pragma unroll
            for (int s = 0; s < 5; ++s) acc[s] += sc[s * 1024 + k] * wv; }
#pragma unroll
        for (int s = 0; s < 5; ++s) red[(kg * 5 + s) * 64 + lane] = acc[s];
        __syncthreads();
        if (kg < 5) { const int s = kg; float v = p.b_mod()[l * MODW + j];
#pragma unroll
            for (int g = 0; g < 8; ++g) v += red[(g * 5 + s) * 64 + lane];
            p.modv()[((size_t)l * 5 + s) * MODW + j] = v; }
        __syncthreads();
    }
}
__device__ __forceinline__ void ph_ropetab(const MP& p, int bid, int nblk) {
    for (int t = bid * 512 + otid(); t < 128 * 16; t += nblk * 512) {
        { const int pos = t / 16, i = t % 16; const float a = (float)pos * powf(10000.f, -(float)i / 16.f); p.tab64()[t] = make_float2(cosf(a), sinf(a)); }
        if (t < 128 * 8) { const int pos = t / 8, i = t % 8; const float a = (float)pos * powf(10000.f, -(float)i / 8.f); p.tab32()[t] = make_float2(cosf(a), sinf(a)); }
    }
}
struct PrepJob { const float* src; const float* src2; const float* kscale; T* dst; int K, Nsrc, Ndst, mode, nz, perm; long long src_zs, dst_zs, ks_zs; };
__device__ __forceinline__ void ph_wprep(ldsp lds, const PrepJob& a, int bid, int nblk) {
    constexpr int NT = 4;
    LAS float* tile = (LAS float*)lds;
    const int tid_ = otid();
    const int kr = tid_ >> 4, c4 = tid_ & 15;
    const int kq = tid_ & 7, nr = tid_ >> 3;
    const int nx = a.Ndst / 64, ny = a.K / 64, ntile = nx * ny * a.nz;
    float4 v0[NT], v1[NT];
#define WP_LOAD(i, u) do { const int z_ = (u) / (nx * ny), rem_ = (u) % (nx * ny), n0_ = (rem_ % nx) * 64, k0_ = (rem_ / nx) * 64; \
        const float* src_ = a.src + (size_t)z_ * a.src_zs; const float* ksc_ = a.kscale ? a.kscale + (size_t)z_ * a.ks_zs : nullptr; \
        int n_ = n0_ + 4 * c4; if (a.perm) { const int p_ = n_ & 255; n_ = (n_ & ~255) + 64 * ((p_ >> 5) & 3) + 32 * (p_ >> 7) + (p_ & 31); } bool valid_ = true; int col_ = n_; const float* sp_ = src_; \
        if (a.mode == 0) { valid_ = n_ < a.Nsrc; } \
        else if (a.mode == 1) { if (n_ < 2144) col_ = n_; else if (n_ < 2304) valid_ = false; else col_ = n_ - 160; } \
        else { const int j_ = n_ >> 6, w_ = n_ & 63; if (w_ >= 32) sp_ = a.src2 + (size_t)z_ * a.src_zs; col_ = 32 * j_ + (w_ & 31); } \
        v0[i] = make_float4(0.f, 0.f, 0.f, 0.f); v1[i] = v0[i]; \
        if (valid_) { v0[i] = *(const float4*)(sp_ + (size_t)(k0_ + kr) * a.Nsrc + col_); v1[i] = *(const float4*)(sp_ + (size_t)(k0_ + kr + 32) * a.Nsrc + col_); \
            if (ksc_) { const float s0_ = ksc_[k0_ + kr], s1_ = ksc_[k0_ + kr + 32]; v0[i].x *= s0_; v0[i].y *= s0_; v0[i].z *= s0_; v0[i].w *= s0_; v1[i].x *= s1_; v1[i].y *= s1_; v1[i].z *= s1_; v1[i].w *= s1_; } } } while (0)
    int u = bid, buf = 0;
#pragma unroll
    for (int i = 0; i < NT; ++i) { if (u + i * nblk < ntile) WP_LOAD(i, u + i * nblk); }
    for (; u < ntile; u += NT * nblk) {
        LAS float* tb = tile + buf * (NT * 64 * 65);
#pragma unroll
        for (int i = 0; i < NT; ++i) { if (u + i * nblk < ntile) { LAS float* w0 = tb + i * (64 * 65) + kr * 65 + 4 * c4; LAS float* w1 = w0 + 32 * 65;
            w0[0] = v0[i].x; w0[1] = v0[i].y; w0[2] = v0[i].z; w0[3] = v0[i].w; w1[0] = v1[i].x; w1[1] = v1[i].y; w1[2] = v1[i].z; w1[3] = v1[i].w; } }
        __syncthreads();
#pragma unroll
        for (int i = 0; i < NT; ++i) { const int un = u + (NT + i) * nblk; if (un < ntile) WP_LOAD(i, un); }
#pragma unroll
        for (int i = 0; i < NT; ++i) { const int ui = u + i * nblk; if (ui < ntile) {
            const int z = ui / (nx * ny), rem = ui % (nx * ny), n0 = (rem % nx) * 64, k0 = (rem / nx) * 64;
            T* dst = a.dst + (size_t)z * a.dst_zs;
            const LAS float* rp = tb + i * (64 * 65) + (kq * 8) * 65 + nr;
            *(uint4*)(dst + (size_t)(n0 + nr) * a.K + k0 + kq * 8) = make_uint4(pk2(rp[0], rp[65]), pk2(rp[130], rp[195]), pk2(rp[260], rp[325]), pk2(rp[390], rp[455])); } }
        buf ^= 1;
    }
#undef WP_LOAD
    __syncthreads();
}
__device__ __forceinline__ void lnmod_row(const float* src, const float* mv, int sh_off, int sc_off, T* dst, int lane) {
    float4 v[4]; float sum = 0.f;
#pragma unroll
    for (int i = 0; i < 4; ++i) { v[i] = *(const float4*)(src + i * 256 + lane * 4); sum += v[i].x + v[i].y + v[i].z + v[i].w; }
    const float mean = wave_sum(sum) * (1.f / D);
    float sq = 0.f;
#pragma unroll
    for (int i = 0; i < 4; ++i) { float a = v[i].x - mean, b = v[i].y - mean, c = v[i].z - mean, d = v[i].w - mean; sq += a * a + b * b + c * c + d * d; }
    const float rstd = 1.f / sqrtf(wave_sum(sq) * (1.f / D) + EPS);
#pragma unroll
    for (int i = 0; i < 4; ++i) {
        const int col = i * 256 + lane * 4;
        const float4 sh = *(const float4*)(mv + sh_off + col), sc = *(const float4*)(mv + sc_off + col);
        st4(dst + col, make_float4((v[i].x - mean) * rstd * (1.f + sc.x) + sh.x, (v[i].y - mean) * rstd * (1.f + sc.y) + sh.y,
                                   (v[i].z - mean) * rstd * (1.f + sc.z) + sh.z, (v[i].w - mean) * rstd * (1.f + sc.w) + sh.w));
    }
}
__device__ __forceinline__ void ph_lnmod0(const MP& p, int bid, int nblk) {
    const int tid_ = otid(); const int lane = tid_ & 63, wid = tid_ >> 6;
    for (int row = bid * 8 + wid; row < NROW; row += nblk * 8) {
        const bool lat = row < NLAT;
        const float* src = lat ? p.x() + (size_t)row * D : p.ctx() + (size_t)(row - NLAT) * D;
        const int s = lat ? row / SEQ : 4;
        lnmod_row(src, p.modv() + (size_t)s * MODW, 0, D, p.RA() + (size_t)row * D, lane);
    }
}
__device__ __forceinline__ void ph_lnres(ldsp lds, const MP& p, int l, int nrows, int bid, int nblk) {
    const int tid_ = otid(); const int lane = tid_ & 63, wid = tid_ >> 6;
    const float* modl = p.modv() + (size_t)l * 5 * MODW;
    const float* lgp = p.ln1g() + l * D; const float* lbp = p.ln1b() + l * D; const float* wr = p.w_router() + (size_t)l * D * NE;
    LAS float* WT = (LAS float*)lds;
    for (int i = tid_; i < NE * D; i += 512) { const int e = i >> 10, col = i & 1023; WT[i] = wr[col * NE + e]; }
    __syncthreads();
    const bool b5 = lane & 32, b4 = lane & 16, b3 = lane & 8, b2 = lane & 4;
    const int stride = nblk * 8;
    const float* xlat = l == 0 ? p.x() : p.out(); const float* xctx = l == 0 ? p.ctx() : p.XCb();
    float4 lgv[4], lbv[4], gv[4], shv[4], scv[4];
#pragma unroll
    for (int i = 0; i < 4; ++i) { lgv[i] = *(const float4*)(lgp + i * 256 + lane * 4); lbv[i] = *(const float4*)(lbp + i * 256 + lane * 4); }
    int cur_s = -1;
    int row = bid * 8 + wid;
    float4 xn[4]; uint2 yn[4];
#define LR_LOAD(r) do { const float* xs_ = (r) < NLAT ? xlat + (size_t)(r) * D : xctx + (size_t)((r) - NLAT) * D; const T* yp_ = p.RA() + (size_t)(r) * D; \
        _Pragma("unroll") for (int i = 0; i < 4; ++i) { xn[i] = *(const float4*)(xs_ + i * 256 + lane * 4); yn[i] = *(const uint2*)(yp_ + i * 256 + lane * 4); } } while (0)
    if (row < nrows) LR_LOAD(row);
    for (; row < nrows; row += stride) {
        float4 xc[4]; uint2 yc[4];
#pragma unroll
        for (int i = 0; i < 4; ++i) { xc[i] = xn[i]; yc[i] = yn[i]; }
        if (row + stride < nrows) LR_LOAD(row + stride);
        const bool lat = row < NLAT;
        float* xo = lat ? p.out() + (size_t)row * D : p.XCa() + (size_t)(row - NLAT) * D;
        const int s = lat ? row / SEQ : 4;
        if (s != cur_s) { cur_s = s; const float* mv = modl + (size_t)s * MODW;
#pragma unroll
            for (int i = 0; i < 4; ++i) { gv[i] = *(const float4*)(mv + 2 * D + i * 256 + lane * 4); shv[i] = *(const float4*)(mv + 3 * D + i * 256 + lane * 4); scv[i] = *(const float4*)(mv + 4 * D + i * 256 + lane * 4); } }
        float v[16]; float sum = 0.f;
#pragma unroll
        for (int i = 0; i < 4; ++i) {
            const float y0 = __uint_as_float(yc[i].x << 16), y1 = __uint_as_float(yc[i].x & 0xffff0000u), y2 = __uint_as_float(yc[i].y << 16), y3 = __uint_as_float(yc[i].y & 0xffff0000u);
            v[i * 4 + 0] = ALPHA * xc[i].x + gv[i].x * y0; v[i * 4 + 1] = ALPHA * xc[i].y + gv[i].y * y1; v[i * 4 + 2] = ALPHA * xc[i].z + gv[i].z * y2; v[i * 4 + 3] = ALPHA * xc[i].w + gv[i].w * y3;
            sum += v[i * 4] + v[i * 4 + 1] + v[i * 4 + 2] + v[i * 4 + 3];
        }
        const float mean = wave_sum(sum) * (1.f / D);
        float sq = 0.f;
#pragma unroll
        for (int i = 0; i < 16; ++i) { const float d = v[i] - mean; sq += d * d; }
        const float rstd = 1.f / sqrtf(wave_sum(sq) * (1.f / D) + EPS);
        float s2 = 0.f;
#pragma unroll
        for (int i = 0; i < 4; ++i) {
            v[i * 4 + 0] = (v[i * 4 + 0] - mean) * rstd * lgv[i].x + lbv[i].x; v[i * 4 + 1] = (v[i * 4 + 1] - mean) * rstd * lgv[i].y + lbv[i].y;
            v[i * 4 + 2] = (v[i * 4 + 2] - mean) * rstd * lgv[i].z + lbv[i].z; v[i * 4 + 3] = (v[i * 4 + 3] - mean) * rstd * lgv[i].w + lbv[i].w;
            *(float4*)(xo + i * 256 + lane * 4) = make_float4(v[i * 4], v[i * 4 + 1], v[i * 4 + 2], v[i * 4 + 3]);
            s2 += v[i * 4] + v[i * 4 + 1] + v[i * 4 + 2] + v[i * 4 + 3];
        }
        const float mean2 = wave_sum(s2) * (1.f / D);
        float sq2 = 0.f;
#pragma unroll
        for (int i = 0; i < 16; ++i) { const float d = v[i] - mean2; sq2 += d * d; }
        const float rstd2 = 1.f / sqrtf(wave_sum(sq2) * (1.f / D) + EPS);
        float h2[16];
#pragma unroll
        for (int i = 0; i < 4; ++i) {
            h2[i * 4 + 0] = (v[i * 4 + 0] - mean2) * rstd2 * (1.f + scv[i].x) + shv[i].x; h2[i * 4 + 1] = (v[i * 4 + 1] - mean2) * rstd2 * (1.f + scv[i].y) + shv[i].y;
            h2[i * 4 + 2] = (v[i * 4 + 2] - mean2) * rstd2 * (1.f + scv[i].z) + shv[i].z; h2[i * 4 + 3] = (v[i * 4 + 3] - mean2) * rstd2 * (1.f + scv[i].w) + shv[i].w;
            st4(p.RC() + (size_t)row * D + i * 256 + lane * 4, make_float4(h2[i * 4], h2[i * 4 + 1], h2[i * 4 + 2], h2[i * 4 + 3]));
        }
        float lg[16];
#pragma unroll
        for (int e = 0; e < 16; ++e) {
            float a = 0.f;
#pragma unroll
            for (int i = 0; i < 4; ++i) { const f32x4 w = *(const LAS f32x4*)(WT + e * D + i * 256 + lane * 4); a += h2[i * 4] * w.x + h2[i * 4 + 1] * w.y + h2[i * 4 + 2] * w.z + h2[i * 4 + 3] * w.w; }
            lg[e] = a;
            if (e & 1) __builtin_amdgcn_sched_barrier(0);
        }
        float a8[8], a4[4], a2[2];
#pragma unroll
        for (int k = 0; k < 8; ++k) {
            auto rr = __builtin_amdgcn_permlane32_swap(__float_as_uint(lg[k]), __float_as_uint(lg[8 + k]), false, false);
            a8[k] = __uint_as_float(rr[0]) + __uint_as_float(rr[1]); }
#pragma unroll
        for (int k = 0; k < 4; ++k) { const float mine = b4 ? a8[4 + k] : a8[k], oth = b4 ? a8[k] : a8[4 + k]; a4[k] = mine + __shfl_xor(oth, 16); }
#pragma unroll
        for (int k = 0; k < 2; ++k) { const float mine = b3 ? a4[2 + k] : a4[k], oth = b3 ? a4[k] : a4[2 + k]; a2[k] = mine + __shfl_xor(oth, 8); }
        float lgt = (b2 ? a2[1] : a2[0]) + __shfl_xor(b2 ? a2[0] : a2[1], 4);
        lgt = DPP_ADD(lgt, 0xB1); lgt = DPP_ADD(lgt, 0x4E);
        float mx = lgt;
        mx = fmaxf(mx, __shfl_xor(mx, 4)); mx = fmaxf(mx, __shfl_xor(mx, 8)); mx = fmaxf(mx, __shfl_xor(mx, 16)); mx = fmaxf(mx, __shfl_xor(mx, 32));
        const float ex = expf(lgt - mx);
        float den = ex;
        den += __shfl_xor(den, 4); den += __shfl_xor(den, 8); den += __shfl_xor(den, 16); den += __shfl_xor(den, 32);
        if ((lane & 3) == 0) p.AFF()[(size_t)row * NE + (lane >> 2)] = ex / den;
    }
#undef LR_LOAD
    __syncthreads();
}
__device__ __forceinline__ void ph_topk(ldsp lds, const MP& p, int nkinds, int bid, int nblk) {
    LAS unsigned* keys = (LAS unsigned*)lds;
    LAS unsigned* hist = (LAS unsigned*)(lds + 32768);
    LAS unsigned* part = (LAS unsigned*)(lds + 32768 + 8192);
    LAS unsigned* shv = (LAS unsigned*)(lds + 32768 + 8192 + 1024);
    const int tid = otid(), lane = tid & 63, wv = tid >> 6;
    for (int u = bid; u < NE * NB * nkinds; u += nblk) {
        const int e = u % NE, bl = (u / NE) % NB, kind = u / (NE * NB);
        const int n = kind ? CTX : SEQ, kk = kind ? CAPC : CAP;
        const size_t row0 = kind ? (size_t)NLAT + (size_t)bl * CTX : (size_t)bl * SEQ;
        const size_t grp = kind ? (size_t)NB * NE * CAP + ((size_t)e * NB + bl) * CAPC : ((size_t)bl * NE + e) * CAP;
        for (int i = tid; i < n; i += 512) keys[i] = __float_as_uint(p.AFF()[(row0 + i) * NE + e]);
        __syncthreads();
        unsigned prefix = 0, rem = kk;
        for (int pass = 0; pass < 3; ++pass) {
            const int shift = pass == 0 ? 21 : pass == 1 ? 10 : 0;
            const int nbm = pass == 2 ? 1023 : 2047;
            const int hshift = pass == 1 ? 21 : 10;
            for (int i = tid; i < 2048; i += 512) hist[i] = 0;
            __syncthreads();
            for (int i = tid; i < n; i += 512) { const unsigned k = keys[i]; const bool match = (pass == 0) || ((k >> hshift) == prefix); if (match) atomicAdd((unsigned*)&hist[(k >> shift) & nbm], 1u); }
            __syncthreads();
            unsigned loc = 0;
            if (tid < 256) { for (int j = 0; j < 8; ++j) loc += hist[tid * 8 + j]; part[tid] = loc; }
            __syncthreads();
            if (tid < 256) {
                unsigned above = 0;
                for (int j = tid + 1; j < 256; ++j) above += part[j];
                if (above < rem && above + loc >= rem) {
                    unsigned cum = above; int bsel = tid * 8 + 7;
                    for (; bsel >= tid * 8; --bsel) { const unsigned hc = hist[bsel]; if (cum + hc >= rem) break; cum += hc; }
                    shv[0] = (unsigned)bsel; shv[1] = rem - cum;
                }
            }
            __syncthreads();
            prefix = (pass == 0) ? shv[0] : ((prefix << (pass == 1 ? 11 : 10)) | shv[0]);
            rem = shv[1];
            __syncthreads();
        }
        const unsigned Tkey = prefix;
        unsigned base_gt = 0, base_eq = 0;
        for (int c0 = 0; c0 < n; c0 += 512) {
            const int i = c0 + tid; const bool inr = i < n;
            const unsigned k = inr ? keys[i] : 0u;
            const bool gt = inr && k > Tkey, eq = inr && k == Tkey;
            const unsigned long long mg = __ballot(gt), me = __ballot(eq);
            const unsigned long long lt = (1ull << lane) - 1ull;
            if (lane == 0) { shv[8 + wv] = __popcll(mg); shv[16 + wv] = __popcll(me); }
            __syncthreads();
            unsigned pg = base_gt + __popcll(mg & lt), pe = base_eq + __popcll(me & lt), tg = 0, te = 0;
            for (int w = 0; w < 8; ++w) { const unsigned a = shv[8 + w], b = shv[16 + w]; if (w < wv) { pg += a; pe += b; } tg += a; te += b; }
            const bool sel = gt || (eq && pe < rem);
            const unsigned slot = pg + min(pe, rem);
            if (inr) { if (sel) { p.IDX()[grp + slot] = (int)(row0 + i); p.GATEV()[grp + slot] = __uint_as_float(k); }
                       p.INV()[(row0 + i) * NE + e] = sel ? (int)slot : -1; }
            base_gt += tg; base_eq += te;
            __syncthreads();
        }
    }
}
__device__ __forceinline__ void ph_combine(const MP& p, int l, int nrows, const T* OUT, int bid, int nblk) {
    const int tid_ = otid(); const int lane = tid_ & 63, wid = tid_ >> 6;
    const float* modl = p.modv() + (size_t)l * 5 * MODW;
    const float* lgp = p.ln2g() + l * D; const float* lbp = p.ln2b() + l * D;
    const bool next = l + 1 < NL;
    const int stride = nblk * 8;
    float4 lgv[4], lbv[4], gv[4];
#pragma unroll
    for (int i = 0; i < 4; ++i) { lgv[i] = *(const float4*)(lgp + i * 256 + lane * 4); lbv[i] = *(const float4*)(lbp + i * 256 + lane * 4); }
    int cur_s = -1;
    int row = bid * 8 + wid;
    int sl_next = -1; float4 xn[4];
#define CB_LOAD(r) do { const float* xs_ = (r) < NLAT ? p.out() + (size_t)(r) * D : p.XCa() + (size_t)((r) - NLAT) * D; \
        _Pragma("unroll") for (int i = 0; i < 4; ++i) xn[i] = *(const float4*)(xs_ + i * 256 + lane * 4); \
        sl_next = lane < NE ? p.INV()[(size_t)(r) * NE + lane] : -1; } while (0)
    if (row < nrows) CB_LOAD(row);
    for (; row < nrows; row += stride) {
        float4 xc[4];
#pragma unroll
        for (int i = 0; i < 4; ++i) xc[i] = xn[i];
        const int slv = sl_next;
        if (row + stride < nrows) CB_LOAD(row + stride);
        const bool lat = row < NLAT;
        float* xo = lat ? p.out() + (size_t)row * D : p.XCb() + (size_t)(row - NLAT) * D;
        const int bl = lat ? row / SEQ : (row - NLAT) / CTX;
        const int s = lat ? bl : 4;
        if (s != cur_s) { cur_s = s; const float* mv = modl + (size_t)s * MODW;
#pragma unroll
            for (int i = 0; i < 4; ++i) gv[i] = *(const float4*)(mv + 5 * D + i * 256 + lane * 4); }
        unsigned long long mask = __ballot(slv >= 0) & 0xffffull;
        uint2 ob[4][4]; bool ok[4];
#pragma unroll
        for (int j = 0; j < 4; ++j) {
            ok[j] = mask != 0ull;
            if (ok[j]) {
                const int e = __builtin_ctzll(mask); mask &= mask - 1;
                const int sl = __builtin_amdgcn_readlane(slv, e);
                const size_t orow = lat ? ((size_t)bl * NE + e) * CAP + sl : (size_t)NB * NE * CAP + ((size_t)e * NB + bl) * CAPC + sl;
                const T* op = OUT + orow * D;
#pragma unroll
                for (int i = 0; i < 4; ++i) ob[j][i] = *(const uint2*)(op + i * 256 + lane * 4);
            } else {
#pragma unroll
                for (int i = 0; i < 4; ++i) ob[j][i] = make_uint2(0u, 0u);
            }
        }
        float y[16];
#pragma unroll
        for (int i = 0; i < 16; ++i) y[i] = 0.f;
#pragma unroll
        for (int j = 0; j < 4; ++j)
#pragma unroll
            for (int i = 0; i < 4; ++i) { y[i * 4] += __uint_as_float(ob[j][i].x << 16); y[i * 4 + 1] += __uint_as_float(ob[j][i].x & 0xffff0000u); y[i * 4 + 2] += __uint_as_float(ob[j][i].y << 16); y[i * 4 + 3] += __uint_as_float(ob[j][i].y & 0xffff0000u); }
        while (mask) {
            const int e = __builtin_ctzll(mask); mask &= mask - 1;
            const int sl = __builtin_amdgcn_readlane(slv, e);
            const size_t orow = lat ? ((size_t)bl * NE + e) * CAP + sl : (size_t)NB * NE * CAP + ((size_t)e * NB + bl) * CAPC + sl;
            const T* op = OUT + orow * D;
#pragma unroll
            for (int i = 0; i < 4; ++i) { const float4 o4 = ld4(op + i * 256 + lane * 4); y[i * 4] += o4.x; y[i * 4 + 1] += o4.y; y[i * 4 + 2] += o4.z; y[i * 4 + 3] += o4.w; }
        }
        float v[16]; float sum = 0.f;
#pragma unroll
        for (int i = 0; i < 4; ++i) {
            v[i * 4 + 0] = ALPHA * xc[i].x + gv[i].x * y[i * 4 + 0]; v[i * 4 + 1] = ALPHA * xc[i].y + gv[i].y * y[i * 4 + 1]; v[i * 4 + 2] = ALPHA * xc[i].z + gv[i].z * y[i * 4 + 2]; v[i * 4 + 3] = ALPHA * xc[i].w + gv[i].w * y[i * 4 + 3];
            sum += v[i * 4] + v[i * 4 + 1] + v[i * 4 + 2] + v[i * 4 + 3];
        }
        const float mean = wave_sum(sum) * (1.f / D);
        float sq = 0.f;
#pragma unroll
        for (int i = 0; i < 16; ++i) { const float d = v[i] - mean; sq += d * d; }
        const float rstd = 1.f / sqrtf(wave_sum(sq) * (1.f / D) + EPS);
        float s2 = 0.f;
#pragma unroll
        for (int i = 0; i < 4; ++i) {
            v[i * 4 + 0] = (v[i * 4 + 0] - mean) * rstd * lgv[i].x + lbv[i].x; v[i * 4 + 1] = (v[i * 4 + 1] - mean) * rstd * lgv[i].y + lbv[i].y;
            v[i * 4 + 2] = (v[i * 4 + 2] - mean) * rstd * lgv[i].z + lbv[i].z; v[i * 4 + 3] = (v[i * 4 + 3] - mean) * rstd * lgv[i].w + lbv[i].w;
            { const float ps_ = (!next && p.pscale()) ? p.pscale()[0] : 1.f;
              *(float4*)(xo + i * 256 + lane * 4) = make_float4(v[i * 4] * ps_, v[i * 4 + 1] * ps_, v[i * 4 + 2] * ps_, v[i * 4 + 3] * ps_); }
            s2 += v[i * 4] + v[i * 4 + 1] + v[i * 4 + 2] + v[i * 4 + 3];
        }
        if (next) {
            const float* mvn = p.modv() + ((size_t)(l + 1) * 5 + s) * MODW;
            const float mean2 = wave_sum(s2) * (1.f / D);
            float sq2 = 0.f;
#pragma unroll
            for (int i = 0; i < 16; ++i) { const float d = v[i] - mean2; sq2 += d * d; }
            const float rstd2 = 1.f / sqrtf(wave_sum(sq2) * (1.f / D) + EPS);
#pragma unroll
            for (int i = 0; i < 4; ++i) {
                const int col = i * 256 + lane * 4;
                const float4 sh = *(const float4*)(mvn + col), sc = *(const float4*)(mvn + D + col);
                st4(p.RA() + (size_t)row * D + col, make_float4((v[i * 4 + 0] - mean2) * rstd2 * (1.f + sc.x) + sh.x, (v[i * 4 + 1] - mean2) * rstd2 * (1.f + sc.y) + sh.y,
                                                             (v[i * 4 + 2] - mean2) * rstd2 * (1.f + sc.z) + sh.z, (v[i * 4 + 3] - mean2) * rstd2 * (1.f + sc.w) + sh.w));
            }
        }
    }
#undef CB_LOAD
}


#define XB_TMO      128
#define XB_XCNT(j)  (256  + 64 * (j))
#define XB_XSUB(j)  (1280 + 64 * (j))
#define XB_XGEN(j)  (2304 + 64 * (j))
#define XB_TOP      3328
#define XB_TOPGEN   3392
#define XCD_BAR_WORDS 3456
#define XB_SPIN_CAP (1u << 18)
__device__ __forceinline__ unsigned xb_ld(unsigned* p)              { return __hip_atomic_load(p, __ATOMIC_RELAXED, __HIP_MEMORY_SCOPE_AGENT); }
__device__ __forceinline__ unsigned xb_add(unsigned* p, unsigned v) { return __hip_atomic_fetch_add(p, v, __ATOMIC_RELAXED, __HIP_MEMORY_SCOPE_AGENT); }
__device__ __forceinline__ unsigned xb_xcc_id() { return (unsigned)__builtin_amdgcn_s_getreg((3 << 11) | 20) & 0xFu; }
#define XB_SPIN(cond, bar) do { unsigned _sp = 0; while (cond) { __builtin_amdgcn_s_sleep(1); \
    if ((++_sp & 255u) == 0u) { if (xb_ld(&(bar)[XB_TMO])) break; if (_sp > XB_SPIN_CAP) { atomicAdd(&(bar)[XB_TMO], 1u); break; } } } } while (0)
struct XcdBarrier { unsigned* bar; unsigned x; volatile LAS unsigned* st; };
__device__ __forceinline__ XcdBarrier xcd_barrier_post(unsigned* bar, volatile LAS unsigned* st) {
    XcdBarrier b; b.bar = bar; b.x = xb_xcc_id(); b.st = st;
    if (threadIdx.x == 0) (void)xb_add(&bar[XB_XCNT(b.x)], 1u);
    return b;
}
__device__ __forceinline__ void xcd_barrier_complete(unsigned* bar, unsigned x, unsigned& nloc, unsigned& nx) {
    const unsigned G = gridDim.x * gridDim.y * gridDim.z;
    unsigned sum, cnt, mine, sp = 0u;
    for (;;) {
        sum = 0u; cnt = 0u; mine = 0u;
#pragma unroll
        for (unsigned j = 0; j < 16; ++j) { const unsigned c = xb_ld(&bar[XB_XCNT(j)]); sum += c; cnt += (c > 0u) ? 1u : 0u; mine = (j == x) ? c : mine; }
        if (sum == G) break;
        __builtin_amdgcn_s_sleep(1);
        if ((++sp & 255u) == 0u) { if (xb_ld(&bar[XB_TMO])) break; if (sp > XB_SPIN_CAP) { atomicAdd(&bar[XB_TMO], 1u); break; } }
    }
    nloc = mine > 0u ? mine : 1u; nx = cnt > 0u ? cnt : 1u;
}
__device__ __forceinline__ void xcd_barrier(const XcdBarrier& b) {
    asm volatile("s_waitcnt vmcnt(0)" ::: "memory");
    __syncthreads();
    if (threadIdx.x == 0) {
        unsigned* bar = b.bar;
        __builtin_amdgcn_s_waitcnt(0);
        unsigned nloc = b.st[0], nx = b.st[1];
        if (nloc == 0u) { xcd_barrier_complete(bar, b.x, nloc, nx); b.st[0] = nloc; b.st[1] = nx; }
        const unsigned old = xb_add(&bar[XB_XSUB(b.x)], 1u);
        const unsigned gen = old / nloc;
        if (old + 1u == (gen + 1u) * nloc) {
            __builtin_amdgcn_fence(__ATOMIC_RELEASE, "agent");
            asm volatile("s_waitcnt vmcnt(0)" ::: "memory");
            const unsigned og = xb_add(&bar[XB_TOP], 1u);
            const unsigned tg = og / nx;
            if (og + 1u == (tg + 1u) * nx) xb_add(&bar[XB_TOPGEN], 1u);
            else XB_SPIN(xb_ld(&bar[XB_TOPGEN]) == tg, bar);
            __builtin_amdgcn_fence(__ATOMIC_ACQUIRE, "agent");
            xb_add(&bar[XB_XGEN(b.x)], 1u);
            asm volatile("s_waitcnt vmcnt(0)" ::: "memory");
        } else {
            XB_SPIN(xb_ld(&bar[XB_XGEN(b.x)]) == gen, bar);
            __builtin_amdgcn_fence(__ATOMIC_ACQUIRE, "agent");
            asm volatile("s_waitcnt vmcnt(0)" ::: "memory");
        }
    }
    __syncthreads();
}

#ifdef PROBE_L0
__global__ void __launch_bounds__(256) k_cmp2(const float* a, const float* b, size_t n, float* acc, int slot) {
    float num = 0.f, den = 0.f;
    for (size_t i = (size_t)blockIdx.x * 256 + threadIdx.x; i < n; i += (size_t)gridDim.x * 256) { const float x = a[i], y = b[i]; num += (x - y) * (x - y); den += y * y; }
    __shared__ float sn[256], sd[256]; sn[threadIdx.x] = num; sd[threadIdx.x] = den; __syncthreads();
    for (int s = 128; s > 0; s >>= 1) { if (threadIdx.x < s) { sn[threadIdx.x] += sn[threadIdx.x + s]; sd[threadIdx.x] += sd[threadIdx.x + s]; } __syncthreads(); }
    if (threadIdx.x == 0) { atomicAdd(&acc[slot], sn[0]); atomicAdd(&acc[4 + slot], sd[0]); }
}
__global__ void k_fin2(const float* acc, float* scale, int which) { float e = acc[which] / acc[4 + which]; if (!(e == e)) e = 1.f; scale[0] = 1.f + sqrtf(e) * 100.f; }
#endif
constexpr int LDS_TOTAL = 159744 + 64 + 256;
static_assert(ATT_LDS <= 159744, "attention LDS");
constexpr size_t NSLOT = (size_t)NB * NE * (CAP + CAPC);
constexpr int NPHASE = 2 + 11 * NL;
__global__ void __launch_bounds__(512, 2) k_mega(MP p) {
    extern __shared__ __attribute__((aligned(16))) unsigned char dynlds[];
    const ldsp lds = (ldsp)dynlds;
    const int bid0 = blockIdx.x, nblk0 = gridDim.x;

    volatile LAS unsigned* xbw = (volatile LAS unsigned*)(lds + 159744);
    if (threadIdx.x == 0) { xbw[0] = 0u; xbw[1] = 0u; xbw[2] = 0u; xbw[3] = 0u; }
    __syncthreads();
    const XcdBarrier bar = xcd_barrier_post(p.bar(), xbw);
    int g = 0;
#ifndef REP_MASK
#define REP_MASK 0
#endif
#define PH(kind, ...) if (g >= p.ph_lo() && g < p.ph_hi()) { int bid = bid0, nblk = nblk0; asm volatile("" : "+s"(bid), "+s"(nblk));     \
    __VA_ARGS__ if (((REP_MASK >> (kind)) & 1) && ((kind) != 5 || g < 13)) { xcd_barrier(bar); __VA_ARGS__ } if (g + 1 < p.ph_hi()) xcd_barrier(bar); } ++g;
#define bH (p.RA())
#define bO (p.RA())
#define bY (p.RA())
#define bQM (p.RC())
#define bKVM (p.RC() + (size_t)NROW * 384)
#define bMERGED (p.RC())
#define bH2 (p.RC())
#define bACT (p.Z())
#define bOUT (p.Z() + NSLOT * FF)
#define bXG (p.Z() + NSLOT * FF)
#define bWguT (p.Z() + 2 * NSLOT * FF)
#define bWdT (p.Z() + 2 * NSLOT * FF + (size_t)NE * 2048 * 1024)
    if ((REP_MASK >> 14) & 1) { for (int i = 0; i < 20; ++i) xcd_barrier(bar); }
    PH(12,
        ph_mod(lds, p, bid, nblk);
        ph_ropetab(p, bid, nblk);
        { PrepJob j{}; j.src = p.w_in(); j.dst = p.WinT(); j.K = D; j.Nsrc = INW; j.Ndst = ZWP; j.mode = 1; j.perm = 1; j.nz = NL; j.src_zs = (long long)D * INW; j.dst_zs = (long long)ZWP * D; ph_wprep(lds, j, bid, nblk); }
        { PrepJob j{}; j.src = p.w_qb(); j.kscale = p.mqn(); j.dst = p.WqT(); j.K = 192; j.Nsrc = 384; j.Ndst = 384; j.mode = 0; j.nz = NL; j.src_zs = 192 * 384; j.dst_zs = 384 * 192; j.ks_zs = 192; ph_wprep(lds, j, bid, nblk); }
        { PrepJob j{}; j.src = p.w_kvb(); j.kscale = p.mkvn(); j.dst = p.WkvT(); j.K = 128; j.Nsrc = 512; j.Ndst = 512; j.mode = 0; j.nz = NL; j.src_zs = 128 * 512; j.dst_zs = 512 * 128; j.ks_zs = 128; ph_wprep(lds, j, bid, nblk); }
        { PrepJob j{}; j.src = p.w_branch(); j.dst = p.WbT(); j.K = 256; j.Nsrc = 1024; j.Ndst = 1024; j.mode = 0; j.nz = NL * 4; j.src_zs = 256 * 1024; j.dst_zs = 1024 * 256; ph_wprep(lds, j, bid, nblk); }
        { PrepJob j{}; j.src = p.w_out(); j.dst = p.WoutT(); j.K = 1024; j.Nsrc = 1024; j.Ndst = 1024; j.mode = 0; j.perm = 1; j.nz = NL; j.src_zs = 1024 * 1024; j.dst_zs = 1024 * 1024; ph_wprep(lds, j, bid, nblk); }
    )
    PH(13, ph_lnmod0(p, bid, nblk);)
    for (int l = 0; l < NL; ++l) {
        const bool need_ctx = l + 1 < NL; const int mrows = need_ctx ? NROW : NLAT;
        PH(0, { InProj8S sc{}; sc.H = bH; sc.Wt = p.WinT() + (size_t)l * ZWP * D; sc.npm = NROW / 256; sc.bid = bid; sc.nblk = nblk; sc.nun = need_ctx ? 3300 : 3200 + 36;
                InProj8E ep{}; ep.Z = p.Z(); ep.SS = p.SS(); ep.gqn = p.gqn() + l * 64; ep.gkn = p.gkn() + l * 64; ep.tab64 = p.tab64(); ep.tab32 = p.tab32();
                pg8::gemm_phase<InProj8E, InProj8S, true, true>(lds, D, sc, ep); } )
        PH(1, { MlaProj pb{}; pb.Z = p.Z(); pb.WqT = p.WqT() + (size_t)l * 384 * 192; pb.WkvT = p.WkvT() + (size_t)l * 512 * 128; pb.QM = bQM; pb.KVM = bKVM; pb.SS = p.SS(); pb.tab32 = p.tab32(); pb.nlat = NLAT; pb.npm = NROW / 256;
                   gemm_run<128, false>(lds, pb, bid, nblk); } )
        PH(2, { AttnP ap{}; ap.Z = p.Z(); ap.QM = bQM; ap.KVM = bKVM; ap.O = bO; ap.rpb = p.na_rpb() + (size_t)l * 4 * 15 * 31; ap.sink = p.swa_sink() + l * 4; ap.nlat = NLAT; ap.need_ctx = need_ctx ? 1 : 0; ap.o32 = (l == 0) ? p.o32() : nullptr; ap.fake = 0;
#ifdef PROBE_F
                   if (l == 0) { ap.fake = PROBE_F; attn_phase(lds, ap, bid, nblk); ap.fake = 0; ap.o32 = nullptr; }
#endif
                   attn_phase(lds, ap, bid, nblk); } )
        PH(3, { MergeProb pb{}; pb.O = bO; pb.WbT = p.WbT() + (size_t)l * 4 * 1024 * 256; pb.Z = p.Z(); pb.MERGED = bMERGED; pb.npm = mrows / 256; gemm_run<128, true>(lds, pb, bid, nblk); } )
        PH(4, { Plain8S sc{}; sc.A = bMERGED; sc.Bt = p.WoutT() + (size_t)l * D * D; sc.npm = mrows / 256; sc.npn = 4; sc.K = D; sc.bid = bid; sc.nblk = nblk; Plain8E ep{}; ep.C = bY; ep.ldc = D;
                pg8::gemm_phase<Plain8E, Plain8S, true, true>(lds, D, sc, ep); } )
        PH(5, ph_lnres(lds, p, l, mrows, bid, nblk); )
        PH(6,
            ph_topk(lds, p, need_ctx ? 2 : 1, bid, nblk);
            { const bool split = nblk > 2 * NE * NB; const int pb_ = split ? bid - NE * NB : bid, pn_ = split ? nblk - NE * NB : nblk;
              if (pb_ >= 0) {
            { PrepJob j{}; j.src = p.w_gate() + (size_t)l * NE * D * FF; j.src2 = p.w_up() + (size_t)l * NE * D * FF; j.dst = bWguT; j.K = 1024; j.Nsrc = 1024; j.Ndst = 2048; j.mode = 2; j.perm = 1; j.nz = NE; j.src_zs = (long long)D * FF; j.dst_zs = (long long)2048 * 1024; ph_wprep(lds, j, pb_, pn_); }
            { PrepJob j{}; j.src = p.w_down() + (size_t)l * NE * FF * D; j.dst = bWdT; j.K = 1024; j.Nsrc = 1024; j.Ndst = 1024; j.mode = 0; j.perm = 1; j.nz = NE; j.src_zs = (long long)FF * D; j.dst_zs = (long long)1024 * 1024; ph_wprep(lds, j, pb_, pn_); }
              } }
        )
        PH(10, ph_gather(bH2, p.IDX(), bXG, need_ctx ? (int)NSLOT : CTXB, bid, nblk); )
        PH(7, { FfnUp8S sc{}; sc.XG = bXG; sc.WguT = bWguT; sc.nun = 2048 + (need_ctx ? 128 : 0); sc.bid = bid; sc.nblk = nblk; FfnUp8E ep{}; ep.ACT = bACT;
                pg8::gemm_phase<FfnUp8E, FfnUp8S, true, true>(lds, D, sc, ep); } )
        PH(8, { FfnDown8S sc{}; sc.ACT = bACT; sc.WdT = bWdT; sc.nun = 1024 + (need_ctx ? 64 : 0); sc.bid = bid; sc.nblk = nblk; FfnDown8E ep{}; ep.GATEV = p.GATEV(); ep.OUT = bOUT;
                pg8::gemm_phase<FfnDown8E, FfnDown8S, true, true>(lds, FF, sc, ep); } )
        PH(9, ph_combine(p, l, mrows, bOUT, bid, nblk); )
    }
#undef PH
#undef bH
#undef bO
#undef bY
#undef bQM
#undef bKVM
#undef bMERGED
#undef bH2
#undef bACT
#undef bOUT
#undef bXG
#undef bWguT
#undef bWdT
}
}

extern "C" void kernel_launch(void* const* d_in, const int* in_sizes, int n_in, void* d_out, int out_size, void* d_ws, size_t ws_size, hipStream_t stream) {
    MP p; memset(&p, 0, sizeof(p));
    p.x_ = (const float*)d_in[0]; p.c_ = (const float*)d_in[1]; p.ctx_ = (const float*)d_in[2]; p.c_ctx_ = (const float*)d_in[3];
    p.w_mod_ = (const float*)d_in[4]; p.b_mod_ = (const float*)d_in[5]; p.w_in_ = (const float*)d_in[6]; p.na_rpb_ = (const float*)d_in[7];
    p.gqn_ = (const float*)d_in[8]; p.gkn_ = (const float*)d_in[9]; p.swa_sink_ = (const float*)d_in[10];
    p.mqn_ = (const float*)d_in[11]; p.mkvn_ = (const float*)d_in[12]; p.w_qb_ = (const float*)d_in[13]; p.w_kvb_ = (const float*)d_in[14];
    p.w_branch_ = (const float*)d_in[15]; p.w_out_ = (const float*)d_in[16];
    p.ln1g_ = (const float*)d_in[17]; p.ln1b_ = (const float*)d_in[18]; p.ln2g_ = (const float*)d_in[19]; p.ln2b_ = (const float*)d_in[20];
    p.w_router_ = (const float*)d_in[21]; p.w_gate_ = (const float*)d_in[22]; p.w_up_ = (const float*)d_in[23]; p.w_down_ = (const float*)d_in[24];
    p.out_ = (float*)d_out;
    char* ws = (char*)d_ws; size_t off = OFF_END;
    auto carve = [&](size_t bytes) { void* q = ws + off; off += (bytes + 255) & ~(size_t)255; return q; }; (void)carve;
    p.ws_ = ws;
    if (off > ws_size || 2 * NSLOT * FF + (size_t)NE * 3072 * 1024 > (size_t)NROW * ZW) { fprintf(stderr, "workspace too small: need %zu have %zu\n", off, ws_size); return; }
    static int grid = 0;
    if (!grid) {
        int dev = 0, cus = 0, per_cu = 0;
        (void)hipGetDevice(&dev);
        (void)hipDeviceGetAttribute(&cus, hipDeviceAttributeMultiprocessorCount, dev);
        (void)hipFuncSetAttribute((const void*)k_mega, hipFuncAttributeMaxDynamicSharedMemorySize, LDS_TOTAL);
        (void)hipOccupancyMaxActiveBlocksPerMultiprocessor(&per_cu, (const void*)k_mega, 512, LDS_TOTAL);
        grid = per_cu >= 1 ? cus : 0;
        if (grid > 256) grid = 256;
    }
    if (!grid) { fprintf(stderr, "k_mega cannot be resident\n"); return; }
    (void)hipMemsetAsync(ws + OFF_BAR, 0, XCD_BAR_WORDS * 4, stream);
#ifdef PROBE_L0
    {
        float* save_xc = (float*)carve((size_t)NCTX * D * 4); float* save_x = (float*)carve((size_t)2048 * D * 4); float* pacc = (float*)carve(256); float* pscl = (float*)carve(256);
        if (off > ws_size) { fprintf(stderr, "probe workspace\n"); return; }
        nv::nv_layer0(d_in, d_out, d_ws, ws_size, stream, save_xc, save_x);
        (void)hipMemsetAsync(ws + OFF_BAR, 0, XCD_BAR_WORDS * 4, stream);
        (void)hipMemsetAsync(pacc, 0, 256, stream);
        p.pscale_ = pscl;
        p.ph_lo_ = 0; p.ph_hi_ = 2 + (NPHASE - 2) / NL;
        hipLaunchKernelGGL(k_mega, dim3(grid), dim3(512), LDS_TOTAL, stream, p);
        hipLaunchKernelGGL(k_cmp2, dim3(256), dim3(256), 0, stream, (const float*)(ws + OFF_XCB), (const float*)save_xc, (size_t)NCTX * D, pacc, 0);
        for (int b = 0; b < NB; ++b) hipLaunchKernelGGL(k_cmp2, dim3(256), dim3(256), 0, stream, (const float*)d_out + (size_t)b * SEQ * D, (const float*)save_x + (size_t)b * 512 * D, (size_t)512 * D, pacc, 1);
        hipLaunchKernelGGL(k_fin2, dim3(1), dim3(1), 0, stream, pacc, pscl, (int)PROBE_L0);
        (void)hipMemsetAsync(ws + OFF_BAR, 0, XCD_BAR_WORDS * 4, stream);
        p.ph_lo_ = 2 + (NPHASE - 2) / NL; p.ph_hi_ = NPHASE;
        hipLaunchKernelGGL(k_mega, dim3(grid), dim3(512), LDS_TOTAL, stream, p);
    }
#elif defined(PROBE_ATTN)
    {
        float* O32 = (float*)carve((size_t)2304 * D * 4); float* O2 = (float*)carve((size_t)2304 * D * 4); float* pacc = (float*)carve(256); float* pscl = (float*)carve(256);
        if (off > ws_size) { fprintf(stderr, "probe workspace\n"); return; }
        p.o32_ = O32; p.pscale_ = pscl;
        (void)hipMemsetAsync(pacc, 0, 256, stream);
        p.ph_lo_ = 0; p.ph_hi_ = 5;
        hipLaunchKernelGGL(k_mega, dim3(grid), dim3(512), LDS_TOTAL, stream, p);
        AttnArgs a{}; a.Z = (const T*)(ws + OFF_Z); a.QM = (const T*)(ws + OFF_RC); a.KVM = (const T*)(ws + OFF_RC) + (size_t)NROW * 384; a.O2 = O2; a.rpb = p.na_rpb_; a.sink = p.swa_sink_; a.P.nbp = NB; a.P.b0 = 0; a.P.nlat = NLAT; a.P.nctx = NCTX; a.P.nrow = NROW; a.bl0 = 1;
        a.ctxq = 0; { dim3 g(8, 4, 1); hipLaunchKernelGGL(k_attn_naive<0>, g, dim3(256), 0, stream, a); hipLaunchKernelGGL(k_attn_naive<1>, g, dim3(256), 0, stream, a);
                      hipLaunchKernelGGL(k_attn_naive<2>, g, dim3(256), 0, stream, a); hipLaunchKernelGGL(k_attn_naive<3>, g, dim3(256), 0, stream, a); }
        a.ctxq = 1; { dim3 g(1, 4, 1); hipLaunchKernelGGL(k_attn_naive<0>, g, dim3(256), 0, stream, a); hipLaunchKernelGGL(k_attn_naive<1>, g, dim3(256), 0, stream, a);
                      hipLaunchKernelGGL(k_attn_naive<2>, g, dim3(256), 0, stream, a); hipLaunchKernelGGL(k_attn_naive<3>, g, dim3(256), 0, stream, a); }
        hipLaunchKernelGGL(k_probe_cmp, dim3(64, 4), dim3(256), 0, stream, O32, O2, pacc, 2304);
        hipLaunchKernelGGL(k_probe_fin, dim3(1), dim3(1), 0, stream, pacc, pscl, (int)PROBE_ATTN);
        (void)hipMemsetAsync(ws + OFF_BAR, 0, XCD_BAR_WORDS * 4, stream);
        p.ph_lo_ = 5; p.ph_hi_ = NPHASE;
        hipLaunchKernelGGL(k_mega, dim3(grid), dim3(512), LDS_TOTAL, stream, p);
    }
#elif defined(PROBE_T)
    {
        float* pscl = (float*)carve(256);
        if (off > ws_size) { fprintf(stderr, "probe workspace\n"); return; }
        p.o32_ = pscl; p.pscale_ = pscl;
        p.ph_lo_ = 0; p.ph_hi_ = NPHASE;
        hipLaunchKernelGGL(k_mega, dim3(grid), dim3(512), LDS_TOTAL, stream, p);
    }
#elif !defined(MK_SPLIT)
    p.ph_lo_ = 0; p.ph_hi_ = NPHASE;
    hipLaunchKernelGGL(k_mega, dim3(grid), dim3(512), LDS_TOTAL, stream, p);
#else
    for (int g = 0; g < NPHASE; ++g) { p.ph_lo_ = g; p.ph_hi_ = g + 1; hipLaunchKernelGGL(k_mega, dim3(grid), dim3(512), LDS_TOTAL, stream, p); }
#endif
}
```

```cpp
#include <hip/hip_runtime.h>
#include <hip/hip_bf16.h>
#include <stdint.h>
#include <stdio.h>
#include <string.h>

namespace {
constexpr int D = 1024, SEQ = 8192, CTX = 256, NB = 4, NL = 2, HD = 64;
constexpr int GW = 64, GROWS = 128;
constexpr int INW = 6240;
constexpr int ZW = 6240;
constexpr int NAQ = 0, NAK = 256, NAV = 512, GQ = 768, GK = 1024, GV = 1152, SQ = 1280, SK = 1536, SV = 1664,
              MCQ = 1792, MCKV = 1984, MKR = 2112, GATE = 2144;
constexpr int NE = 16, FF = 1024, CAP = 1024, CAPC = 32;
constexpr int MODW = 6 * D;
constexpr float EPS = 1e-6f;
constexpr float ALPHA = 1.4142135623730951f;
constexpr int NLAT = NB * SEQ, NCTX = NB * CTX, NROW = NLAT + NCTX;

struct T {
    unsigned short u;
    __device__ __forceinline__ operator float() const { return __uint_as_float((unsigned)u << 16); }
    __device__ __forceinline__ T& operator=(float f) { unsigned b = __float_as_uint(f); b += 0x7fffu + ((b >> 16) & 1u); u = (unsigned short)(b >> 16); return *this; }
};
__device__ __forceinline__ float4 ld4(const float* p) { return *(const float4*)p; }
__device__ __forceinline__ float4 ld4(const T* p) { uint2 r = *(const uint2*)p; return make_float4(__uint_as_float(r.x << 16), __uint_as_float(r.x & 0xffff0000u), __uint_as_float(r.y << 16), __uint_as_float(r.y & 0xffff0000u)); }
__device__ __forceinline__ unsigned pk2(float lo, float hi) { T a, b; a = lo; b = hi; return (unsigned)a.u | ((unsigned)b.u << 16); }
__device__ __forceinline__ void st4(float* p, float4 v) { *(float4*)p = v; }
__device__ __forceinline__ void st4(T* p, float4 v) { *(uint2*)p = make_uint2(pk2(v.x, v.y), pk2(v.z, v.w)); }

__device__ __forceinline__ int otid() { int t = threadIdx.x; asm volatile("" : "+v"(t)); return t; }
__device__ __forceinline__ int xswz(int u, int n) { const int c = u & 7, s = u >> 3, q = n >> 3, rr = n & 7; return (c < rr ? c * (q + 1) : rr * (q + 1) + (c - rr) * q) + s; }
#define DPP_ADD(v, ctrl) ((v) + __builtin_bit_cast(float, __builtin_amdgcn_update_dpp(0, __builtin_bit_cast(int, (v)), (ctrl), 0xf, 0xf, true)))
__device__ __forceinline__ float wave_sum(float v) {
    v = DPP_ADD(v, 0xB1);
    v = DPP_ADD(v, 0x4E);
    v = DPP_ADD(v, 0x141);
    v = DPP_ADD(v, 0x140);
    const int iv = __builtin_bit_cast(int, v);
    const float r0 = __builtin_bit_cast(float, __builtin_amdgcn_readlane(iv, 0)), r1 = __builtin_bit_cast(float, __builtin_amdgcn_readlane(iv, 16)),
                r2 = __builtin_bit_cast(float, __builtin_amdgcn_readlane(iv, 32)), r3 = __builtin_bit_cast(float, __builtin_amdgcn_readlane(iv, 48));
    return (r0 + r1) + (r2 + r3);
}

typedef short bf16x8 __attribute__((ext_vector_type(8)));
typedef float f32x4 __attribute__((ext_vector_type(4)));
#define LAS __attribute__((address_space(3)))
typedef LAS unsigned char* ldsp;
constexpr int ZWP = 6400;

__device__ __forceinline__ float fast_rsqrt(float x) { return __builtin_amdgcn_rsqf(x); }
__device__ __forceinline__ float fast_sigmoid(float x) { return __builtin_amdgcn_rcpf(1.f + __builtin_amdgcn_exp2f(-1.4426950408889634f * x)); }
__device__ __forceinline__ float fast_silu(float x) { return x * fast_sigmoid(x); }
__device__ __forceinline__ uint2 pk4(float a, float b, float c, float d) { return make_uint2(pk2(a, b), pk2(c, d)); }

#define GLDS16(gp, lp) __builtin_amdgcn_global_load_lds((const unsigned*)(gp), (LAS unsigned*)(lp), 16, 0, 0)
template <int BN, bool HAS_SUM, class Prob>
__device__ __forceinline__ void gemm_run(ldsp lds, const Prob& pb, int bid, int nblk) {
    constexpr int NF = BN / 64, GLB = BN / 64, A_BYTES = 32768, B_BYTES = BN * 128, STAGE = A_BYTES + B_BYTES, NSTG = (BN == 128) ? 3 : 2, NGL = 4 + GLB;
    const int tid = otid(), wid = __builtin_amdgcn_readfirstlane(tid >> 6), lane = tid & 63, wr = wid >> 2, wc = wid & 3, fr = lane & 15, fq = lane >> 4;
    const int NU = pb.nunits();
    if (bid >= NU) return;
    const int sb = lane * 16, swz = sb ^ (((sb >> 9) & 1) << 5);
    const int sR0 = (wid >> 1) * 16 + (swz >> 6), sC = (wid & 1) * 32 + ((swz & 63) >> 1);
    const int ob = fr * 64 + fq * 16, lane_off = ob ^ (((ob >> 9) & 1) << 5);
    const unsigned ldsw = (unsigned)wid * 1024u;
    unsigned aoff[4], boff[GLB];
    int su = bid, st = 0, snt = pb.ntiles(su), sbuf = 0, inflight = 0;
#define G_LOAD_OFFS() do { _Pragma("unroll") for (int i = 0; i < 4; ++i) aoff[i] = pb.a_off(su, sR0 + 64 * i) + sC; \
                           _Pragma("unroll") for (int i = 0; i < GLB; ++i) boff[i] = pb.b_off(su, sR0 + 64 * i) + sC; } while (0)
#define G_STAGE() do { if (su < NU) { const T* Ab = pb.a_base(su, st); const T* Bb = pb.b_base(su, st); ldsp sbase = lds + sbuf * STAGE + ldsw; \
        _Pragma("unroll") for (int i = 0; i < 4; ++i) GLDS16(Ab + aoff[i], sbase + i * 8192); \
        _Pragma("unroll") for (int i = 0; i < GLB; ++i) GLDS16(Bb + boff[i], sbase + A_BYTES + i * 8192); \
        ++inflight; sbuf = (sbuf + 1 == NSTG) ? 0 : sbuf + 1; \
        if (++st == snt) { su += nblk; st = 0; if (su < NU) { snt = pb.ntiles(su); G_LOAD_OFFS(); } } } } while (0)
    G_LOAD_OFFS();
    G_STAGE();
    if (NSTG == 3) G_STAGE();
    int buf = 0;
    for (int cu = bid; cu < NU; cu += nblk) {
        f32x4 acc[8][NF]; f32x4 sum[HAS_SUM ? 8 : 1][HAS_SUM ? NF : 1]; uint2 gpre[HAS_SUM ? 8 : 1][HAS_SUM ? NF : 1];
#pragma unroll
        for (int m = 0; m < 8; ++m)
#pragma unroll
            for (int n = 0; n < NF; ++n) { acc[m][n] = (f32x4){0.f, 0.f, 0.f, 0.f}; if (HAS_SUM) sum[m][n] = (f32x4){0.f, 0.f, 0.f, 0.f}; }
        const int nt = pb.ntiles(cu);
        for (int t = 0; t < nt; ++t) {
            if (NSTG == 3) {
                if constexpr (HAS_SUM) { if (inflight >= 2) { if (pb.extra_inflight(t)) asm volatile("s_waitcnt vmcnt(%0)" :: "n"(NGL + 16) : "memory"); else asm volatile("s_waitcnt vmcnt(%0)" :: "n"(NGL) : "memory"); }
                                         else asm volatile("s_waitcnt vmcnt(0)" ::: "memory"); }
                else { if (inflight >= 2) asm volatile("s_waitcnt vmcnt(%0)" :: "n"(NGL) : "memory"); else asm volatile("s_waitcnt vmcnt(0)" ::: "memory"); }
                asm volatile("s_waitcnt lgkmcnt(0)\n\ts_barrier" ::: "memory");
            } else {
                asm volatile("s_waitcnt vmcnt(0)" ::: "memory");
                __syncthreads();
            }
            if constexpr (!(NF == 2 && HAS_SUM)) G_STAGE();
            if constexpr (HAS_SUM) pb.tile_begin(cu, t, gpre, wr, wc, fr, fq);
            const ldsp ta = lds + buf * STAGE + wr * 16384 + lane_off, tb = lds + buf * STAGE + A_BYTES + wc * (NF * 2048) + lane_off;
            if constexpr (NF == 2 && HAS_SUM) {
                const unsigned ta_ = (unsigned)(size_t)ta, tb_ = (unsigned)(size_t)tb;
                bf16x8 a0, a1, a2, a3, a4, a5, a6, a7, b0, b1;
#define G_RD(dst, addr, OFF) asm volatile("ds_read_b128 %0, %1 offset:" #OFF : "=v"(dst) : "v"(addr))
#define G_MM(m, av) do { acc[m][0] = __builtin_amdgcn_mfma_f32_16x16x32_bf16(b0, av, acc[m][0], 0, 0, 0); acc[m][1] = __builtin_amdgcn_mfma_f32_16x16x32_bf16(b1, av, acc[m][1], 0, 0, 0); } while (0)
                const bool g_on = su < NU; const T* gAb = pb.a_base(g_on ? su : cu, st); const T* gBb = pb.b_base(g_on ? su : cu, st); const ldsp gsb = lds + sbuf * STAGE + ldsw;
                G_RD(a0, ta_, 0); G_RD(a1, ta_, 2048); G_RD(a2, ta_, 4096); G_RD(a3, ta_, 6144); G_RD(b0, tb_, 0); G_RD(b1, tb_, 2048);
                if (g_on) { GLDS16(gAb + aoff[0], gsb); GLDS16(gAb + aoff[1], gsb + 8192); }
                asm volatile("s_waitcnt lgkmcnt(0)" : "+v"(a0), "+v"(a1), "+v"(a2), "+v"(a3), "+v"(b0), "+v"(b1));
                __builtin_amdgcn_sched_barrier(0);
                G_RD(a4, ta_, 8192); G_RD(a5, ta_, 10240); G_RD(a6, ta_, 12288); G_RD(a7, ta_, 14336);
                G_MM(0, a0); G_MM(1, a1); G_MM(2, a2); G_MM(3, a3);
                __builtin_amdgcn_sched_barrier(0);
                if (g_on) { GLDS16(gAb + aoff[2], gsb + 2 * 8192); GLDS16(gAb + aoff[3], gsb + 3 * 8192); }
                asm volatile("s_waitcnt lgkmcnt(0)" : "+v"(a4), "+v"(a5), "+v"(a6), "+v"(a7));
                __builtin_amdgcn_sched_barrier(0);
                bf16x8 c0, c1, c2, c3, d0, d1;
                G_RD(c0, ta_, 1024); G_RD(c1, ta_, 3072); G_RD(c2, ta_, 5120); G_RD(c3, ta_, 7168); G_RD(d0, tb_, 1024); G_RD(d1, tb_, 3072);
                G_MM(4, a4); G_MM(5, a5); G_MM(6, a6); G_MM(7, a7);
                __builtin_amdgcn_sched_barrier(0);
                if (g_on) { GLDS16(gBb + boff[0], gsb + A_BYTES); GLDS16(gBb + boff[1], gsb + A_BYTES + 8192);
                            ++inflight; sbuf = (sbuf + 1 == NSTG) ? 0 : sbuf + 1;
                            if (++st == snt) { su += nblk; st = 0; if (su < NU) { snt = pb.ntiles(su); G_LOAD_OFFS(); } } }
                asm volatile("s_waitcnt lgkmcnt(0)" : "+v"(c0), "+v"(c1), "+v"(c2), "+v"(c3), "+v"(d0), "+v"(d1));
                __builtin_amdgcn_sched_barrier(0);
                b0 = d0; b1 = d1;
                G_RD(a4, ta_, 9216); G_RD(a5, ta_, 11264); G_RD(a6, ta_, 13312); G_RD(a7, ta_, 15360);
                G_MM(0, c0); G_MM(1, c1); G_MM(2, c2); G_MM(3, c3);
                __builtin_amdgcn_sched_barrier(0);
                asm volatile("s_waitcnt lgkmcnt(0)" : "+v"(a4), "+v"(a5), "+v"(a6), "+v"(a7));
                __builtin_amdgcn_sched_barrier(0);
                G_MM(4, a4); G_MM(5, a5); G_MM(6, a6); G_MM(7, a7);
                __builtin_amdgcn_sched_barrier(0);
#undef G_RD
#undef G_MM
            } else {
#pragma unroll
            for (int ks = 0; ks < 2; ++ks) {
                bf16x8 At[8], Bf[NF];
#pragma unroll
                for (int m = 0; m < 8; ++m) At[m] = *(const LAS bf16x8*)(ta + m * 2048 + ks * 1024);
#pragma unroll
                for (int n = 0; n < NF; ++n) Bf[n] = *(const LAS bf16x8*)(tb + n * 2048 + ks * 1024);
#pragma unroll
                for (int m = 0; m < 8; ++m)
#pragma unroll
                    for (int n = 0; n < NF; ++n) acc[m][n] = __builtin_amdgcn_mfma_f32_16x16x32_bf16(Bf[n], At[m], acc[m][n], 0, 0, 0);
            }
            }
            if constexpr (HAS_SUM) pb.tile_done(cu, t, acc, sum, gpre, wr, wc, fr, fq);
            --inflight; buf = (buf + 1 == NSTG) ? 0 : buf + 1;
        }
        if constexpr (HAS_SUM) pb.epilogue(cu, sum, wr, wc, fr, fq); else pb.epilogue(cu, acc, wr, wc, fr, fq);
    }
    asm volatile("s_waitcnt vmcnt(0) lgkmcnt(0)\n\ts_barrier" ::: "memory");
#undef G_LOAD_OFFS
#undef G_STAGE
}

struct InProj {
    const T* H; const T* Wt; T* Z; float* SS; const float* gqn; const float* gkn; const float2* tab64; const float2* tab32; int nlat, npm;
    __device__ __forceinline__ int nunits() const { return npm * 25; }
    __device__ __forceinline__ int ntiles(int) const { return 16; }
    __device__ __forceinline__ unsigned a_off(int u, int R) const { return (unsigned)((u / 25) * 256 + R) * 1024u; }
    __device__ __forceinline__ unsigned b_off(int u, int R) const { return (unsigned)((u % 25) * 256 + R) * 1024u; }
    __device__ __forceinline__ const T* a_base(int, int t) const { return H + t * 64; }
    __device__ __forceinline__ const T* b_base(int, int t) const { return Wt + t * 64; }
    __device__ __forceinline__ void epilogue(int u, f32x4 (&acc)[8][4], int wr, int wc, int fr, int fq) const {
        const int pm = u / 25, pn = u % 25, cg = pn * 4 + wc;
        if (cg == 34 || cg == 35) return;
        const int row0 = pm * 256 + wr * 128 + fr;
        const bool lat = pm * 256 < nlat;
        const int zcol = (cg < 36 ? cg * 64 : 2144 + (cg - 36) * 64) + fq * 4;
        const bool t_rms = (cg >= 12 && cg < 18), t_rope = t_rms || (cg >= 20 && cg < 26), t_ssq = (cg >= 28 && cg < 33), t_kr = cg == 33, t_sig = cg >= 36;
        float4 gv[4];
        if (t_rms) { const float* g = cg < 16 ? gqn : gkn;
#pragma unroll
            for (int n = 0; n < 4; ++n) gv[n] = *(const float4*)(g + n * 16 + fq * 4); }
#pragma unroll
        for (int m = 0; m < 8; ++m) {
            const int row = row0 + m * 16;
            const int t = row & (SEQ - 1), gr = t >> 6, gc = t & 63;
            float v[4][4];
#pragma unroll
            for (int n = 0; n < 4; ++n)
#pragma unroll
                for (int j = 0; j < 4; ++j) v[n][j] = acc[m][n][j];
            T* zp = Z + (size_t)row * ZW + zcol;
            if (t_rms || t_ssq) {
                float ss = 0.f;
#pragma unroll
                for (int n = 0; n < 4; ++n)
#pragma unroll
                    for (int j = 0; j < 4; ++j) ss += v[n][j] * v[n][j];
                ss += __shfl_xor(ss, 16); ss += __shfl_xor(ss, 32);
                if (t_ssq) { if (fq == 0) SS[(size_t)row * 8 + (cg - 28)] = ss; }
                else { const float rstd = 1.f / sqrtf(ss * (1.f / 64.f) + EPS);
#pragma unroll
                    for (int n = 0; n < 4; ++n) { v[n][0] *= rstd * gv[n].x; v[n][1] *= rstd * gv[n].y; v[n][2] *= rstd * gv[n].z; v[n][3] *= rstd * gv[n].w; } }
            }
            if (t_rope && lat) {
                const float4* tr = (const float4*)(tab64 + gr * 16 + fq * 4); const float4* tc = (const float4*)(tab64 + gc * 16 + fq * 4);
                const float4 r0 = tr[0], r1 = tr[1], c0 = tc[0], c1 = tc[1];
                const float rc[4] = {r0.x, r0.z, r1.x, r1.z}, rs[4] = {r0.y, r0.w, r1.y, r1.w}, cc[4] = {c0.x, c0.z, c1.x, c1.z}, cs[4] = {c0.y, c0.w, c1.y, c1.w};
#pragma unroll
                for (int j = 0; j < 4; ++j) {
                    const float a0 = v[0][j], a1 = v[1][j], b0 = v[2][j], b1 = v[3][j];
                    v[0][j] = a0 * rc[j] - a1 * rs[j]; v[1][j] = a0 * rs[j] + a1 * rc[j];
                    v[2][j] = b0 * cc[j] - b1 * cs[j]; v[3][j] = b0 * cs[j] + b1 * cc[j];
                }
            }
            if (t_kr) {
#pragma unroll
                for (int n = 0; n < 2; ++n) {
                    const float4* tp = (const float4*)(tab32 + (n == 0 ? gr : gc) * 8 + (fq & 1) * 4);
                    const float4 q0 = tp[0], q1 = tp[1];
                    const float kc[4] = {q0.x, q0.z, q1.x, q1.z}, ks[4] = {q0.y, q0.w, q1.y, q1.w};
#pragma unroll
                    for (int j = 0; j < 4; ++j) { const float x = v[n][j], px = __shfl_xor(x, 32); if (lat) v[n][j] = (fq < 2) ? (x * kc[j] - px * ks[j]) : (px * ks[j] + x * kc[j]); }
                    *(uint2*)(zp + n * 16) = pk4(v[n][0], v[n][1], v[n][2], v[n][3]);
                }
                continue;
            }
            if (t_sig) {
#pragma unroll
                for (int n = 0; n < 4; ++n)
#pragma unroll
                    for (int j = 0; j < 4; ++j) v[n][j] = fast_sigmoid(v[n][j]);
            }
#pragma unroll
            for (int n = 0; n < 4; ++n) *(uint2*)(zp + n * 16) = pk4(v[n][0], v[n][1], v[n][2], v[n][3]);
        }
    }
};

struct MlaProj {
    const T* Z; const T* WqT; const T* WkvT; T* QM; T* KVM; const float* SS; const float2* tab32; int nlat, npm;
    __device__ __forceinline__ int nunits() const { return npm * 7; }
    __device__ __forceinline__ int ntiles(int u) const { return u < npm * 3 ? 3 : 2; }
    __device__ __forceinline__ unsigned a_off(int u, int R) const { const int pm = u < npm * 3 ? u / 3 : (u - npm * 3) / 4; return (unsigned)(pm * 256 + R) * (unsigned)ZW; }
    __device__ __forceinline__ unsigned b_off(int u, int R) const { return u < npm * 3 ? (unsigned)((u % 3) * 128 + R) * 192u : (unsigned)(((u - npm * 3) % 4) * 128 + R) * 128u; }
    __device__ __forceinline__ const T* a_base(int u, int t) const { return Z + (u < npm * 3 ? MCQ : MCKV) + t * 64; }
    __device__ __forceinline__ const T* b_base(int u, int t) const { return (u < npm * 3 ? WqT : WkvT) + t * 64; }
    __device__ __forceinline__ void epilogue(int u, f32x4 (&acc)[8][2], int wr, int wc, int fr, int fq) const {
        const bool isq = u < npm * 3;
        const int pm = isq ? u / 3 : (u - npm * 3) / 4, pn = isq ? u % 3 : (u - npm * 3) % 4;
        const int row0 = pm * 256 + wr * 128 + fr;
        const bool lat = pm * 256 < nlat;
#pragma unroll
        for (int m = 0; m < 8; ++m) {
            const int row = row0 + m * 16;
            const float* ss = SS + (size_t)row * 8;
            const float rstd = isq ? 1.f / sqrtf((ss[0] + ss[1] + ss[2]) * (1.f / 192.f) + EPS) : 1.f / sqrtf((ss[3] + ss[4]) * (1.f / 128.f) + EPS);
            const int t = row & (SEQ - 1), gr = t >> 6, gc = t & 63;
#pragma unroll
            for (int n = 0; n < 2; ++n) {
                float v[4];
#pragma unroll
                for (int j = 0; j < 4; ++j) v[j] = acc[m][n][j] * rstd;
                const int f = pn * 8 + wc * 2 + n;
                if (isq) {
                    const int part = f % 6;
                    if (part >= 4) {
                        const float4* tp = (const float4*)(tab32 + (part == 4 ? gr : gc) * 8 + (fq & 1) * 4);
                        const float4 q0 = tp[0], q1 = tp[1];
                        const float kc[4] = {q0.x, q0.z, q1.x, q1.z}, ks[4] = {q0.y, q0.w, q1.y, q1.w};
#pragma unroll
                        for (int j = 0; j < 4; ++j) { const float x = v[j], px = __shfl_xor(x, 32); if (lat) v[j] = (fq < 2) ? (x * kc[j] - px * ks[j]) : (px * ks[j] + x * kc[j]); }
                    }
                    *(uint2*)(QM + (size_t)row * 384 + f * 16 + fq * 4) = pk4(v[0], v[1], v[2], v[3]);
                } else {
                    *(uint2*)(KVM + (size_t)row * 512 + f * 16 + fq * 4) = pk4(v[0], v[1], v[2], v[3]);
                }
            }
        }
    }
};

struct MergeProb {
    const T* O; const T* WbT; const T* Z; T* MERGED; int npm;
    __device__ __forceinline__ int nunits() const { return npm * 8; }
    __device__ __forceinline__ int ntiles(int) const { return 16; }
    __device__ __forceinline__ unsigned a_off(int u0, int R) const { const int u = xswz(u0, npm * 8); return (unsigned)((u >> 3) * 256 + R) * 1024u; }
    __device__ __forceinline__ unsigned b_off(int u0, int R) const { const int u = xswz(u0, npm * 8); return (unsigned)((u & 7) * 128 + R) * 256u; }
    __device__ __forceinline__ const T* a_base(int, int t) const { return O + (t >> 2) * 256 + (t & 3) * 64; }
    __device__ __forceinline__ const T* b_base(int, int t) const { return WbT + (size_t)(t >> 2) * 1024 * 256 + (t & 3) * 64; }
    __device__ __forceinline__ void tile_begin(int u0, int t, uint2 (&gpre)[8][2], int wr, int wc, int fr, int fq) const {
        if ((t & 3) != 0) return;
        const int u = xswz(u0, npm * 8); const int i = t >> 2, pm = u >> 3, pn = u & 7;
        const T* gp = Z + (size_t)(pm * 256 + wr * 128 + fr) * ZW + GATE + i * 1024 + pn * 128 + wc * 32 + fq * 4;
#pragma unroll
        for (int m = 0; m < 8; ++m)
#pragma unroll
            for (int n = 0; n < 2; ++n) { const T* q_ = gp + (size_t)m * 16 * ZW + n * 16; asm volatile("global_load_dwordx2 %0, %1, off" : "=v"(gpre[m][n]) : "v"(q_)); }
    }
    __device__ __forceinline__ int extra_inflight(int t) const { return ((t & 3) == 1) ? 16 : 0; }
    __device__ __forceinline__ void tile_done(int u, int t, f32x4 (&acc)[8][2], f32x4 (&sum)[8][2], uint2 (&gpre)[8][2], int wr, int wc, int fr, int fq) const {
        if ((t & 3) != 3) return;
#pragma unroll
        for (int m = 0; m < 8; ++m)
#pragma unroll
            for (int n = 0; n < 2; ++n) {
                const uint2 r = gpre[m][n];
                { float s0 = __builtin_fmaf(__uint_as_float(r.x << 16), acc[m][n][0], sum[m][n][0]); asm volatile("" : "+v"(s0));
                  float s1 = __builtin_fmaf(__uint_as_float(r.x & 0xffff0000u), acc[m][n][1], sum[m][n][1]); asm volatile("" : "+v"(s1));
                  float s2 = __builtin_fmaf(__uint_as_float(r.y << 16), acc[m][n][2], sum[m][n][2]); asm volatile("" : "+v"(s2));
                  float s3 = __builtin_fmaf(__uint_as_float(r.y & 0xffff0000u), acc[m][n][3], sum[m][n][3]); asm volatile("" : "+v"(s3));
                  sum[m][n] = (f32x4){s0, s1, s2, s3}; }
                acc[m][n] = (f32x4){0.f, 0.f, 0.f, 0.f};
            }
    }
    __device__ __forceinline__ void epilogue(int u0, f32x4 (&sum)[8][2], int wr, int wc, int fr, int fq) const {
        const int u = xswz(u0, npm * 8); const int pm = u >> 3, pn = u & 7;
        T* op = MERGED + (size_t)(pm * 256 + wr * 128 + fr) * 1024 + pn * 128 + wc * 32 + fq * 4;
#pragma unroll
        for (int m = 0; m < 8; ++m)
#pragma unroll
            for (int n = 0; n < 2; ++n) *(uint2*)(op + (size_t)m * 16 * 1024 + n * 16) = pk4(sum[m][n][0], sum[m][n][1], sum[m][n][2], sum[m][n][3]);
    }
};

struct PlainProb {
    const T* A; const T* Bt; T* C; int npm, npn, K, lda, ldc;
    __device__ __forceinline__ int nunits() const { return npm * npn; }
    __device__ __forceinline__ int ntiles(int) const { return K / 64; }
    __device__ __forceinline__ unsigned a_off(int u0, int R) const { const int u = xswz(u0, npm * npn); return (unsigned)((u / npn) * 256 + R) * (unsigned)lda; }
    __device__ __forceinline__ unsigned b_off(int u0, int R) const { const int u = xswz(u0, npm * npn); return (unsigned)((u % npn) * 128 + R) * (unsigned)K; }
    __device__ __forceinline__ const T* a_base(int, int t) const { return A + t * 64; }
    __device__ __forceinline__ const T* b_base(int, int t) const { return Bt + t * 64; }
    __device__ __forceinline__ void epilogue(int u0, f32x4 (&acc)[8][2], int wr, int wc, int fr, int fq) const {
        const int u = xswz(u0, npm * npn); const int pm = u / npn, pn = u % npn;
        T* op = C + (size_t)(pm * 256 + wr * 128 + fr) * ldc + pn * 128 + wc * 32 + fq * 4;
#pragma unroll
        for (int m = 0; m < 8; ++m)
#pragma unroll
            for (int n = 0; n < 2; ++n) *(uint2*)(op + (size_t)m * 16 * ldc + n * 16) = pk4(acc[m][n][0], acc[m][n][1], acc[m][n][2], acc[m][n][3]);
    }
};

constexpr int CTXB = NB * NE * CAP;
struct FfnUp {
    const T* H2; const T* WguT; const int* IDX; T* ACT; int nun;
    __device__ __forceinline__ int nunits() const { return nun; }
    __device__ __forceinline__ int ntiles(int) const { return 16; }
    __device__ __forceinline__ void decode(int u, int& e, int& pn, int& sbase, bool& isctx) const {
        if (u < 2048) { e = u >> 7; const int rem = u & 127; pn = rem & 7; sbase = ((rem >> 5) * NE + e) * CAP + ((rem >> 3) & 3) * 256; isctx = false; }
        else { const int uc = u - 2048; e = uc >> 3; pn = uc & 7; sbase = CTXB + e * CAPC; isctx = true; }
    }
    __device__ __forceinline__ int slot_of(int sbase, bool isctx, int R) const { return isctx ? (R < 128 ? sbase + (R >> 5) * (NE * CAPC) + (R & 31) : -1) : sbase + R; }
    __device__ __forceinline__ unsigned a_off(int u, int R) const { int e, pn, sb; bool ic; decode(u, e, pn, sb, ic); const int s = slot_of(sb, ic, R); return s < 0 ? 0u : (unsigned)IDX[s] * 1024u; }
    __device__ __forceinline__ unsigned b_off(int u, int R) const { int e, pn, sb; bool ic; decode(u, e, pn, sb, ic); return (unsigned)(e * 2048 + pn * 256 + R) * 1024u; }
    __device__ __forceinline__ const T* a_base(int, int t) const { return H2 + t * 64; }
    __device__ __forceinline__ const T* b_base(int, int t) const { return WguT + t * 64; }
    __device__ __forceinline__ void epilogue(int u, f32x4 (&acc)[8][4], int wr, int wc, int fr, int fq) const {
        int e, pn, sb; bool ic; decode(u, e, pn, sb, ic);
        const int col = (pn * 4 + wc) * 32 + fq * 4;
#pragma unroll
        for (int m = 0; m < 8; ++m) {
            const int s = slot_of(sb, ic, wr * 128 + m * 16 + fr);
            if (s < 0) continue;
            T* op = ACT + (size_t)s * FF + col;
#pragma unroll
            for (int n = 0; n < 2; ++n)
                *(uint2*)(op + n * 16) = pk4(fast_silu(acc[m][n][0]) * acc[m][n + 2][0], fast_silu(acc[m][n][1]) * acc[m][n + 2][1],
                                             fast_silu(acc[m][n][2]) * acc[m][n + 2][2], fast_silu(acc[m][n][3]) * acc[m][n + 2][3]);
        }
    }
};
struct FfnDown {
    const T* ACT; const T* WdT; const float* GATEV; T* OUT; int nun;
    __device__ __forceinline__ int nunits() const { return nun; }
    __device__ __forceinline__ int ntiles(int) const { return 16; }
    __device__ __forceinline__ void decode(int u, int& e, int& pn, int& sbase, bool& isctx) const {
        if (u < 1024) { e = u >> 6; const int rem = u & 63; pn = rem & 3; sbase = ((rem >> 4) * NE + e) * CAP + ((rem >> 2) & 3) * 256; isctx = false; }
        else { const int uc = u - 1024; e = uc >> 2; pn = uc & 3; sbase = CTXB + e * CAPC; isctx = true; }
    }
    __device__ __forceinline__ int slot_of(int sbase, bool isctx, int R) const { return isctx ? (R < 128 ? sbase + (R >> 5) * (NE * CAPC) + (R & 31) : -1) : sbase + R; }
    __device__ __forceinline__ unsigned a_off(int u, int R) const { int e, pn, sb; bool ic; decode(u, e, pn, sb, ic); const int s = slot_of(sb, ic, R); return s < 0 ? 0u : (unsigned)s * 1024u; }
    __device__ __forceinline__ unsigned b_off(int u, int R) const { int e, pn, sb; bool ic; decode(u, e, pn, sb, ic); return (unsigned)(e * 1024 + pn * 256 + R) * 1024u; }
    __device__ __forceinline__ const T* a_base(int, int t) const { return ACT + t * 64; }
    __device__ __forceinline__ const T* b_base(int, int t) const { return WdT + t * 64; }
    __device__ __forceinline__ void epilogue(int u, f32x4 (&acc)[8][4], int wr, int wc, int fr, int fq) const {
        int e, pn, sb; bool ic; decode(u, e, pn, sb, ic);
        const int col = pn * 256 + wc * 64 + fq * 4;
#pragma unroll
        for (int m = 0; m < 8; ++m) {
            const int s = slot_of(sb, ic, wr * 128 + m * 16 + fr);
            if (s < 0) continue;
            const float g = GATEV[s];
            T* op = OUT + (size_t)s * D + col;
#pragma unroll
            for (int n = 0; n < 4; ++n) *(uint2*)(op + n * 16) = pk4(acc[m][n][0] * g, acc[m][n][1] * g, acc[m][n][2] * g, acc[m][n][3] * g);
        }
    }
};

namespace pg8 {
#define PG8_LAS __attribute__((address_space(3)))
constexpr int BM = 256, BK = 64, HALF = 128, HTB = HALF * BK * 2, STAGE_BYTES = 8 * HTB;
__host__ __device__ __forceinline__ int lds_byte(int r, int c) { const int st = (r >> 4) * 2 + (c >> 5), rr = r & 15, cc = c & 31, ob = rr * 64 + cc * 2; return st * 1024 + (ob ^ (((ob >> 9) & 1) << 5)); }
__host__ __device__ __forceinline__ void stage_rc(int b, int& R, int& C) { const int st = b / 1024, sb = b % 1024, swz = sb ^ (((sb >> 9) & 1) << 5); R = (st >> 1) * 16 + swz / 64; C = (st & 1) * 32 + (swz % 64) / 2; }
__host__ __device__ __forceinline__ int perm32(int rho) { const int n = rho >> 4, i = rho & 15; return 8 * (i >> 2) + 4 * n + (i & 3); }
struct Unit { int pm, pn; const char* a; const char* b; int x0, x1; };
template <class Epi, class Sched, bool ALIGN_EPI = false, bool SP2 = false>
__device__ __forceinline__ void gemm_phase(PG8_LAS unsigned char* lds, const int K, const Sched& S, const Epi& E) {
    const int tid = otid(), wid = __builtin_amdgcn_readfirstlane(tid >> 6), lane = tid & 63, wr = wid >> 2, wc = wid & 3, fr = lane & 15, fq = lane >> 4;
    const int nt = K / BK;
    unsigned voffA[2], voffB[2];
#pragma unroll
    for (int i = 0; i < 2; ++i) { int R, C; stage_rc(tid * 16 + i * 8192, R, C); const int Rb = Epi::PERM ? ((R & ~31) + perm32(R & 31)) : R;
        voffA[i] = (unsigned)(R * K + C) * 2u; voffB[i] = (unsigned)(Rb * K + C) * 2u; }
    const size_t kstep = (size_t)(BK * 2);
    const size_t hstep = (size_t)HALF * K * 2;
    const unsigned ldsw = (unsigned)wid * 1024u;
    const int aoff = lds_byte(wr * 64 + fr, fq * 8), boff = lds_byte(wc * 32 + fr, fq * 8);
#define PG8_SA(b, h) (((b) * 2 + (h)) * HTB)
#define PG8_SB(b, h) ((4 + (b) * 2 + (h)) * HTB)
#define PG8_STAGE(bufoff, gbase, voff) do { _Pragma("unroll") for (int _i = 0; _i < 2; ++_i) \
        __builtin_amdgcn_global_load_lds((const unsigned*)((const char*)(gbase) + (voff)[_i]), (PG8_LAS unsigned*)(lds + (bufoff) + ldsw + _i * 8192), 16, 0, 0); } while (0)
#define PG8_LDA(dst, b, h) do { _Pragma("unroll") for (int m = 0; m < 4; ++m) _Pragma("unroll") for (int k = 0; k < 2; ++k) dst[m][k] = *(const PG8_LAS bf16x8*)(lds + PG8_SA(b, h) + aoff + m * 2048 + k * 1024); } while (0)
#define PG8_LDB(dst, b, h) do { _Pragma("unroll") for (int n = 0; n < 2; ++n) _Pragma("unroll") for (int k = 0; k < 2; ++k) dst[n][k] = *(const PG8_LAS bf16x8*)(lds + PG8_SB(b, h) + boff + n * 2048 + k * 1024); } while (0)
#define PG8_MMA(ai, bj, At, Bt) do { __builtin_amdgcn_s_setprio(1); _Pragma("unroll") for (int m = 0; m < 4; ++m) _Pragma("unroll") for (int n = 0; n < 2; ++n) _Pragma("unroll") for (int k = 0; k < 2; ++k) \
        acc[ai][bj][m][n] = __builtin_amdgcn_mfma_f32_16x16x32_bf16(Bt[n][k], At[m][k], acc[ai][bj][m][n], 0, 0, 0); __builtin_amdgcn_s_setprio(0); } while (0)
#define PG8_WAIT_V(n) asm volatile("s_waitcnt vmcnt(" #n ")" ::: "memory")
#define PG8_WAIT_L(n) asm volatile("s_waitcnt lgkmcnt(" #n ")" ::: "memory")
#define PG8_BAR __builtin_amdgcn_s_barrier()
#define PG8_SCHED __builtin_amdgcn_sched_barrier(0)
    Unit cur, nxt; int ui = 0;
    if (!S.next(0, cur)) return;
    f32x4 acc[2][2][4][2];
#pragma unroll
    for (int a = 0; a < 2; ++a)
#pragma unroll
        for (int b = 0; b < 2; ++b)
#pragma unroll
            for (int m = 0; m < 4; ++m)
#pragma unroll
                for (int n = 0; n < 2; ++n) acc[a][b][m][n] = (f32x4){0.f, 0.f, 0.f, 0.f};
    bf16x8 At[4][2], B0[2][2], B1[2][2];
    const char* cA = cur.a; const char* cB = cur.b;
    S.a_ready(cur);
    if constexpr (SP2) {
        PG8_STAGE(PG8_SB(0, 0), cB, voffB); PG8_STAGE(PG8_SB(0, 1), cB + hstep, voffB); PG8_STAGE(PG8_SA(0, 0), cA, voffA); PG8_STAGE(PG8_SA(0, 1), cA + hstep, voffA);
        if (wr == 1) PG8_BAR;
        PG8_WAIT_V(2); PG8_BAR;
        PG8_STAGE(PG8_SB(1, 0), cB + kstep, voffB); PG8_STAGE(PG8_SA(1, 0), cA + kstep, voffA); PG8_STAGE(PG8_SB(1, 1), cB + hstep + kstep, voffB);
        PG8_WAIT_V(6); PG8_BAR;
    } else {
        PG8_STAGE(PG8_SB(0, 0), cB, voffB); PG8_STAGE(PG8_SA(0, 0), cA, voffA); PG8_STAGE(PG8_SB(0, 1), cB + hstep, voffB); PG8_STAGE(PG8_SA(0, 1), cA + hstep, voffA);
        if (wr == 1) PG8_BAR;
        PG8_WAIT_V(4); PG8_BAR;
        PG8_STAGE(PG8_SB(1, 0), cB + kstep, voffB); PG8_STAGE(PG8_SA(1, 0), cA + kstep, voffA); PG8_STAGE(PG8_SB(1, 1), cB + hstep + kstep, voffB);
        PG8_WAIT_V(6); PG8_BAR;
    }
    for (;;) {
        const bool has_next = S.next(ui + 1, nxt);
        const char* nA = has_next ? nxt.a : cA; const char* nB = has_next ? nxt.b : cB;
        for (int t = 0; t < nt; t += 2) {
            const bool last = (t == nt - 2);
            const char* a1 = cA + (size_t)(t + 1) * kstep;
            const char* a2 = last ? nA : cA + (size_t)(t + 2) * kstep; const char* b2 = last ? nB : cB + (size_t)(t + 2) * kstep;
            const char* a3 = a2 + kstep; const char* b3 = b2 + kstep;
            if (last && has_next) S.a_ready(nxt);
            if constexpr (SP2) {
            PG8_LDB(B0, 0, 0); PG8_LDB(B1, 0, 1); PG8_SCHED; PG8_LDA(At, 0, 0); PG8_STAGE(PG8_SA(1, 1), a1 + hstep, voffA);
            PG8_WAIT_V(8); PG8_WAIT_L(0); PG8_BAR; PG8_MMA(0, 0, At, B0); PG8_MMA(0, 1, At, B1); PG8_BAR; PG8_SCHED;
            PG8_LDA(At, 0, 1); PG8_STAGE(PG8_SB(0, 0), b2, voffB); PG8_STAGE(PG8_SB(0, 1), b2 + hstep, voffB); PG8_STAGE(PG8_SA(0, 0), a2, voffA);
            PG8_WAIT_V(8); PG8_WAIT_L(0); PG8_BAR; PG8_MMA(1, 0, At, B0); PG8_MMA(1, 1, At, B1); PG8_BAR; PG8_SCHED;
            PG8_LDB(B0, 1, 0); PG8_LDB(B1, 1, 1); PG8_SCHED; PG8_LDA(At, 1, 0); PG8_STAGE(PG8_SA(0, 1), a2 + hstep, voffA);
            PG8_WAIT_V(8); PG8_WAIT_L(0); PG8_BAR; PG8_MMA(0, 0, At, B0); PG8_MMA(0, 1, At, B1); PG8_BAR; PG8_SCHED;
            PG8_LDA(At, 1, 1); PG8_STAGE(PG8_SB(1, 0), b3, voffB); PG8_STAGE(PG8_SB(1, 1), b3 + hstep, voffB); PG8_STAGE(PG8_SA(1, 0), a3, voffA);
            PG8_WAIT_V(8); PG8_WAIT_L(0); PG8_BAR; PG8_MMA(1, 0, At, B0); PG8_MMA(1, 1, At, B1); PG8_BAR; PG8_SCHED;
            } else {
            PG8_LDB(B0, 0, 0); PG8_SCHED; PG8_LDA(At, 0, 0); PG8_STAGE(PG8_SA(1, 1), a1 + hstep, voffA);
            PG8_WAIT_L(8); PG8_BAR; PG8_WAIT_L(0); PG8_MMA(0, 0, At, B0); PG8_BAR; PG8_SCHED;
            PG8_LDB(B1, 0, 1); PG8_STAGE(PG8_SB(0, 0), b2, voffB);
            PG8_BAR; PG8_WAIT_L(0); PG8_MMA(0, 1, At, B1); PG8_BAR;
            PG8_LDA(At, 0, 1); PG8_STAGE(PG8_SA(0, 0), a2, voffA);
            PG8_BAR; PG8_WAIT_L(0); PG8_MMA(1, 0, At, B0); PG8_BAR; PG8_SCHED;
            PG8_STAGE(PG8_SB(0, 1), b2 + hstep, voffB);
            PG8_WAIT_V(6); PG8_BAR; PG8_MMA(1, 1, At, B1); PG8_BAR;
            PG8_LDB(B0, 1, 0); PG8_SCHED; PG8_LDA(At, 1, 0); PG8_STAGE(PG8_SA(0, 1), a2 + hstep, voffA);
            PG8_WAIT_L(8); PG8_BAR; PG8_WAIT_L(0); PG8_MMA(0, 0, At, B0); PG8_BAR; PG8_SCHED;
            PG8_LDB(B1, 1, 1); PG8_STAGE(PG8_SB(1, 0), b3, voffB);
            PG8_BAR; PG8_WAIT_L(0); PG8_MMA(0, 1, At, B1); PG8_BAR;
            PG8_LDA(At, 1, 1); PG8_STAGE(PG8_SA(1, 0), a3, voffA);
            PG8_BAR; PG8_WAIT_L(0); PG8_MMA(1, 0, At, B0); PG8_BAR; PG8_SCHED;
            PG8_STAGE(PG8_SB(1, 1), b3 + hstep, voffB);
            PG8_WAIT_V(6); PG8_BAR; PG8_MMA(1, 1, At, B1); PG8_BAR;
            }
        }
        if constexpr (ALIGN_EPI) { if (wr == 0) PG8_BAR; }
        if constexpr (!Epi::AFTER_DRAIN) { E(acc, cur, wr, wc, fr, fq); S.done(cur); }
        if (!has_next) break;
#pragma unroll
        for (int a = 0; a < 2; ++a)
#pragma unroll
            for (int b = 0; b < 2; ++b)
#pragma unroll
                for (int m = 0; m < 4; ++m)
#pragma unroll
                    for (int n = 0; n < 2; ++n) acc[a][b][m][n] = (f32x4){0.f, 0.f, 0.f, 0.f};
        cur = nxt; cA = nA; cB = nB; ++ui;
        if constexpr (ALIGN_EPI) { if (wr == 1) PG8_BAR; }
    }
    PG8_WAIT_V(0);
    if constexpr (!ALIGN_EPI) { if (wr == 0) PG8_BAR; }
    PG8_BAR;
    if constexpr (Epi::AFTER_DRAIN) { E.fused(acc, cur, wr, wc, fr, fq, lds, wid, lane); S.done(cur); }
#undef PG8_SA
#undef PG8_SB
#undef PG8_STAGE
#undef PG8_LDA
#undef PG8_LDB
#undef PG8_MMA
#undef PG8_WAIT_V
#undef PG8_WAIT_L
#undef PG8_BAR
#undef PG8_SCHED
}
}

struct SchedBase { __device__ __forceinline__ void a_ready(const pg8::Unit&) const {} __device__ __forceinline__ void done(const pg8::Unit&) const {} };
#define ACC8(mm, nn) acc[(mm) >> 2][(nn) >> 1][(mm) & 3][(nn) & 1]
#define ROW8(mm) (((mm) >> 2) * 128 + wr * 64 + ((mm) & 3) * 16 + fr)

struct InProj8S : SchedBase { const T* H; const T* Wt; int npm, bid, nblk, nun;
    __device__ __forceinline__ bool next(int i, pg8::Unit& u) const { const int x0 = bid + i * nblk; if (x0 >= nun) return false; const int x = xswz(x0, nun);
        if (x < 3200 || nun == 3300) { u.pm = x / 25; u.pn = x % 25; } else { const int y = x - 3200; u.pm = 128 + y / 9; u.pn = y % 9; }
        u.a = (const char*)(H + (size_t)u.pm * 256 * D); u.b = (const char*)(Wt + (size_t)u.pn * 256 * D); return true; } };
struct InProj8E {
    static constexpr bool PERM = false, AFTER_DRAIN = false;
    T* Z; float* SS; const float* gqn; const float* gkn; const float2* tab64; const float2* tab32;
    __device__ __forceinline__ void operator()(const f32x4 (&acc)[2][2][4][2], const pg8::Unit& u, int wr, int wc, int fr, int fq) const {
        const int pm = u.pm, cg = u.pn * 4 + wc;
        if (cg == 34 || cg == 35) return;
        const bool lat = pm * 256 < NLAT;
        const int zcol = (cg < 36 ? cg * 64 : 2144 + (cg - 36) * 64) + fq * 4;
        const bool t_rms = (cg >= 12 && cg < 18), t_rope = t_rms || (cg >= 20 && cg < 26), t_ssq = (cg >= 28 && cg < 33), t_kr = cg == 33, t_sig = cg >= 36;
        float4 gv[4];
        if (t_rms) { const float* g = cg < 16 ? gqn : gkn;
#pragma unroll
            for (int n = 0; n < 4; ++n) gv[n] = *(const float4*)(g + n * 16 + fq * 4); }
#pragma unroll
        for (int m = 0; m < 8; ++m) {
            const int row = pm * 256 + ROW8(m);
            const int t = row & (SEQ - 1), gr = t >> 6, gc = t & 63;
            float v[4][4];
#pragma unroll
            for (int n = 0; n < 4; ++n)
#pragma unroll
                for (int j = 0; j < 4; ++j) v[n][j] = ACC8(m, n)[j];
            T* zp = Z + (size_t)row * ZW + zcol;
            if (t_rms || t_ssq) {
                float ss = 0.f;
#pragma unroll
                for (int n = 0; n < 4; ++n)
#pragma unroll
                    for (int j = 0; j < 4; ++j) ss += v[n][j] * v[n][j];
                ss += __shfl_xor(ss, 16); ss += __shfl_xor(ss, 32);
                if (t_ssq) { if (fq == 0) SS[(size_t)row * 8 + (cg - 28)] = ss; }
                else { const float rstd = 1.f / sqrtf(ss * (1.f / 64.f) + EPS);
#pragma unroll
                    for (int n = 0; n < 4; ++n) { v[n][0] *= rstd * gv[n].x; v[n][1] *= rstd * gv[n].y; v[n][2] *= rstd * gv[n].z; v[n][3] *= rstd * gv[n].w; } }
            }
            if (t_rope && lat) {
                const float4* tr = (const float4*)(tab64 + gr * 16 + fq * 4); const float4* tc = (const float4*)(tab64 + gc * 16 + fq * 4);
                const float4 r0 = tr[0], r1 = tr[1], c0 = tc[0], c1 = tc[1];
                const float rc[4] = {r0.x, r0.z, r1.x, r1.z}, rs[4] = {r0.y, r0.w, r1.y, r1.w}, cc[4] = {c0.x, c0.z, c1.x, c1.z}, cs[4] = {c0.y, c0.w, c1.y, c1.w};
#pragma unroll
                for (int j = 0; j < 4; ++j) {
                    const float a0 = v[0][j], a1 = v[1][j], b0 = v[2][j], b1 = v[3][j];
                    v[0][j] = a0 * rc[j] - a1 * rs[j]; v[1][j] = a0 * rs[j] + a1 * rc[j];
                    v[2][j] = b0 * cc[j] - b1 * cs[j]; v[3][j] = b0 * cs[j] + b1 * cc[j];
                }
            }
            if (t_kr) {
#pragma unroll
                for (int n = 0; n < 2; ++n) {
                    const float4* tp = (const float4*)(tab32 + (n == 0 ? gr : gc) * 8 + (fq & 1) * 4);
                    const float4 q0 = tp[0], q1 = tp[1];
                    const float kc[4] = {q0.x, q0.z, q1.x, q1.z}, ks[4] = {q0.y, q0.w, q1.y, q1.w};
#pragma unroll
                    for (int j = 0; j < 4; ++j) { const float x = v[n][j], px = __shfl_xor(x, 32); if (lat) v[n][j] = (fq < 2) ? (x * kc[j] - px * ks[j]) : (px * ks[j] + x * kc[j]); }
                    *(uint2*)(zp + n * 16) = pk4(v[n][0], v[n][1], v[n][2], v[n][3]);
                }
                continue;
            }
            if (t_sig) {
#pragma unroll
                for (int n = 0; n < 4; ++n)
#pragma unroll
                    for (int j = 0; j < 4; ++j) v[n][j] = fast_sigmoid(v[n][j]);
            }
#pragma unroll
            for (int n = 0; n < 4; ++n) *(uint2*)(zp + n * 16) = pk4(v[n][0], v[n][1], v[n][2], v[n][3]);
        }
    }
};

struct FfnUp8S : SchedBase { const T* XG; const T* WguT; int nun, bid, nblk;
    __device__ __forceinline__ bool next(int i, pg8::Unit& u) const { const int x0 = bid + i * nblk; if (x0 >= nun) return false; const int x = xswz(x0, nun); int e, sb;
        if (x < 2048) { e = x >> 7; const int rem = x & 127; u.pn = rem & 7; sb = ((rem >> 5) * NE + e) * CAP + ((rem >> 3) & 3) * 256; u.x1 = 256; }
        else { const int uc = x - 2048; e = uc >> 3; u.pn = uc & 7; sb = CTXB + e * (NB * CAPC); u.x1 = NB * CAPC; }
        u.pm = 0; u.x0 = sb; u.a = (const char*)(XG + (size_t)sb * D); u.b = (const char*)(WguT + ((size_t)e * 2048 + u.pn * 256) * D); return true; } };
struct FfnUp8E {
    static constexpr bool PERM = false, AFTER_DRAIN = false;
    T* ACT;
    __device__ __forceinline__ void operator()(const f32x4 (&acc)[2][2][4][2], const pg8::Unit& u, int wr, int wc, int fr, int fq) const {
        const int col = (u.pn * 4 + wc) * 32 + fq * 4;
#pragma unroll
        for (int m = 0; m < 8; ++m) {
            const int R = ROW8(m);
            if (R >= u.x1) continue;
            T* op = ACT + (size_t)(u.x0 + R) * FF + col;
#pragma unroll
            for (int n = 0; n < 2; ++n) { const f32x4 g = ACC8(m, n), w = ACC8(m, n + 2);
                *(uint2*)(op + n * 16) = pk4(fast_silu(g[0]) * w[0], fast_silu(g[1]) * w[1], fast_silu(g[2]) * w[2], fast_silu(g[3]) * w[3]); }
        }
    }
};
struct FfnDown8S : SchedBase { const T* ACT; const T* WdT; int nun, bid, nblk;
    __device__ __forceinline__ bool next(int i, pg8::Unit& u) const { const int x0 = bid + i * nblk; if (x0 >= nun) return false; const int x = xswz(x0, nun); int e, sb;
        if (x < 1024) { e = x >> 6; const int rem = x & 63; u.pn = rem & 3; sb = ((rem >> 4) * NE + e) * CAP + ((rem >> 2) & 3) * 256; u.x1 = 256; }
        else { const int uc = x - 1024; e = uc >> 2; u.pn = uc & 3; sb = CTXB + e * (NB * CAPC); u.x1 = NB * CAPC; }
        u.pm = 0; u.x0 = sb; u.a = (const char*)(ACT + (size_t)sb * FF); u.b = (const char*)(WdT + ((size_t)e * 1024 + u.pn * 256) * FF); return true; } };
struct FfnDown8E {
    static constexpr bool PERM = false, AFTER_DRAIN = false;
    const float* GATEV; T* OUT;
    __device__ __forceinline__ void operator()(const f32x4 (&acc)[2][2][4][2], const pg8::Unit& u, int wr, int wc, int fr, int fq) const {
        const int col = u.pn * 256 + wc * 64 + fq * 4;
#pragma unroll
        for (int m = 0; m < 8; ++m) {
            const int R = ROW8(m);
            if (R >= u.x1) continue;
            const int s = u.x0 + R; const float g = GATEV[s];
            T* op = OUT + (size_t)s * D + col;
#pragma unroll
            for (int n = 0; n < 4; ++n) { const f32x4 a = ACC8(m, n); *(uint2*)(op + n * 16) = pk4(a[0] * g, a[1] * g, a[2] * g, a[3] * g); }
        }
    }
};
struct Plain8S : SchedBase { const T* A; const T* Bt; int npm, npn, K, bid, nblk;
    __device__ __forceinline__ bool next(int i, pg8::Unit& u) const { const int x0 = bid + i * nblk; if (x0 >= npm * npn) return false; const int x = xswz(x0, npm * npn); u.pm = x / npn; u.pn = x % npn;
        u.a = (const char*)(A + (size_t)u.pm * 256 * K); u.b = (const char*)(Bt + (size_t)u.pn * 256 * K); return true; } };
struct Plain8E {
    static constexpr bool PERM = false, AFTER_DRAIN = false;
    T* C; int ldc;
    __device__ __forceinline__ void operator()(const f32x4 (&acc)[2][2][4][2], const pg8::Unit& u, int wr, int wc, int fr, int fq) const {
        const int col = u.pn * 256 + wc * 64 + fq * 4;
#pragma unroll
        for (int m = 0; m < 8; ++m) {
            T* op = C + (size_t)(u.pm * 256 + ROW8(m)) * ldc + col;
#pragma unroll
            for (int n = 0; n < 4; ++n) { const f32x4 a = ACC8(m, n); *(uint2*)(op + n * 16) = pk4(a[0], a[1], a[2], a[3]); }
        }
    }
};
__device__ __forceinline__ void ph_gather(const T* H2, const int* IDX, T* XG, int nslot, int bid, int nblk) {
    const int tid_ = otid(); const int lane = tid_ & 63, wid = tid_ >> 6;
    for (int s0 = (bid * 8 + wid) * 2; s0 < nslot; s0 += nblk * 16) {
        const int i0 = IDX[s0], i1 = IDX[s0 + 1];
        const uint4 a0 = *(const uint4*)(H2 + (size_t)i0 * D + lane * 8), a1 = *(const uint4*)(H2 + (size_t)i0 * D + 512 + lane * 8);
        const uint4 b0 = *(const uint4*)(H2 + (size_t)i1 * D + lane * 8), b1 = *(const uint4*)(H2 + (size_t)i1 * D + 512 + lane * 8);
        *(uint4*)(XG + (size_t)s0 * D + lane * 8) = a0; *(uint4*)(XG + (size_t)s0 * D + 512 + lane * 8) = a1;
        *(uint4*)(XG + (size_t)(s0 + 1) * D + lane * 8) = b0; *(uint4*)(XG + (size_t)(s0 + 1) * D + 512 + lane * 8) = b1;
    }
}

typedef float f32x16 __attribute__((ext_vector_type(16)));
typedef short s16x4 __attribute__((ext_vector_type(4)));
typedef short v4i16_t __attribute__((ext_vector_type(4)));
struct AttnP { const T* Z; const T* QM; const T* KVM; T* O; const float* rpb; const float* sink; int nlat; int need_ctx; float* o32; int fake; };
constexpr int ATT_LDS = 156672 + 2048;
__device__ __forceinline__ int crow(int r, int hi) { return (r & 3) + 8 * (r >> 2) + 4 * hi; }
__device__ __forceinline__ float xhalf_max(float v) { auto rr = __builtin_amdgcn_permlane32_swap(__float_as_uint(v), __float_as_uint(v), false, false); return fmaxf(__uint_as_float(rr[0]), __uint_as_float(rr[1])); }
__device__ __forceinline__ float xhalf_sum(float v) { auto rr = __builtin_amdgcn_permlane32_swap(__float_as_uint(v), __float_as_uint(v), false, false); return __uint_as_float(rr[0]) + __uint_as_float(rr[1]); }
__device__ __forceinline__ unsigned cvtpk(float lo, float hi) { typedef float f2 __attribute__((ext_vector_type(2))); typedef __bf16 b2 __attribute__((ext_vector_type(2))); f2 v = {lo, hi}; b2 b = __builtin_convertvector(v, b2); return __builtin_bit_cast(unsigned, b); }

__device__ __forceinline__ float max3f(float a, float b, float c) { float r; asm("v_max3_f32 %0, %1, %2, %3" : "=v"(r) : "v"(a), "v"(b), "v"(c)); return r; }
template <int BR>
__device__ __forceinline__ void attn_unit_l(ldsp lds, const AttnP& P, int b, int hx, int q0, bool ctxq) {
    constexpr int DQK = (BR == 3) ? 96 : 64, NKS = DQK / 16, KB = (BR == 3) ? 9216 + 4096 : 9216, SLOT = KB + 8192;
    constexpr int R = (BR == 3) ? 5 : 6, PF = R - 1;
    constexpr int BT0 = 107520, QF0 = BT0 + 2048;
    static_assert(R * SLOT <= BT0, "ring");
    constexpr bool PACK2 = (BR == 1 || BR == 2);
    constexpr float SCALE = (BR == 3) ? 0.10206207261596575f : 0.125f;
    constexpr float CL2 = SCALE * 1.4426950408889634f;
    constexpr float NEG = -1e30f, THR = 8.f;
    const int tid = otid(), lane = tid & 63, wid = __builtin_amdgcn_readfirstlane(tid >> 6), r32 = lane & 31, hi = lane >> 5;
    const int tokq = q0 + (PACK2 ? (wid & 3) : wid) * 32 + r32;
    const int head = PACK2 ? hx * 2 + (wid >> 2) : hx;
    const size_t lat0 = (size_t)b * SEQ, ctx0 = (size_t)P.nlat + (size_t)b * CTX;
    const size_t qrow = ctxq ? ctx0 + tokq : lat0 + tokq;
    const ldsp qlds = lds + QF0 + wid * 6144 + lane * 16;
    { const T* qp = (BR == 3) ? P.QM + qrow * 384 + head * 96 + hi * 8 : P.Z + qrow * ZW + (BR == 0 ? NAQ : BR == 1 ? GQ : SQ) + head * 64 + hi * 8;
#pragma unroll
      for (int ks = 0; ks < NKS; ++ks) {
          const uint4 raw = *(const uint4*)(qp + ks * 16);
          typedef unsigned u4 __attribute__((ext_vector_type(4)));
          const u4 w = {cvtpk(__uint_as_float(raw.x << 16) * CL2, __uint_as_float(raw.x & 0xffff0000u) * CL2), cvtpk(__uint_as_float(raw.y << 16) * CL2, __uint_as_float(raw.y & 0xffff0000u) * CL2),
                        cvtpk(__uint_as_float(raw.z << 16) * CL2, __uint_as_float(raw.z & 0xffff0000u) * CL2), cvtpk(__uint_as_float(raw.w << 16) * CL2, __uint_as_float(raw.w & 0xffff0000u) * CL2)};
          *(LAS u4*)(qlds + ks * 1024) = w; } }
    int klo = 0, nlt = 0;
    if (!ctxq) {
        if (BR == 0) { const int r0 = q0 >> 6; const int lo = min(max(r0 - 4, 0), GROWS - 8), hi2 = min(max(r0 - 1, 0), GROWS - 8) + 8; klo = lo * 64; nlt = hi2 - lo; }
        else if (BR == 2) { klo = max(q0 - 128, 0); nlt = (min(q0 + 256, SEQ) - klo) >> 6; }
        else { klo = 0; nlt = SEQ / 64; }
    }
    const int nt = 4 + nlt;
    const T* ksrc; const T* vsrc; const T* rsrc = nullptr; size_t kpitch;
    { const int kk = 8 * wid + (lane >> 3), kch = ((lane & 7) ^ (lane >> 3)) * 8, vch = ((((lane >> 2) ^ (lane >> 4)) & 1) * 32) + (lane & 3) * 8;
      if (BR == 3) { ksrc = P.KVM + (size_t)kk * 512 + hx * 128 + kch; vsrc = P.KVM + (size_t)kk * 512 + hx * 128 + 64 + vch; kpitch = 512;
                     rsrc = P.Z + (size_t)(16 * (wid & 3) + (lane >> 2)) * ZW + MKR + (((lane & 3) ^ ((lane >> 4) & 3)) * 8); }
      else { const int ko = (BR == 0 ? NAK : BR == 1 ? GK : SK) + hx * 64, vo = (BR == 0 ? NAV : BR == 1 ? GV : SV) + hx * 64;
             ksrc = P.Z + (size_t)kk * ZW + ko + kch; vsrc = P.Z + (size_t)kk * ZW + vo + vch; kpitch = ZW; } }
#define A_TROW(t) ((t) < 4 ? ctx0 + (size_t)(t) * 64 : lat0 + (size_t)klo + (size_t)((t) - 4) * 64)
#define A_DMA(t, slot) do { const size_t tr_ = A_TROW(t); const ldsp sb_ = lds + (slot) * SLOT; \
        GLDS16(ksrc + tr_ * kpitch, sb_ + wid * 1152); GLDS16(vsrc + tr_ * kpitch, sb_ + KB + wid * 1024); \
        if (BR == 3) { if (wid < 4) GLDS16(rsrc + tr_ * ZW, sb_ + 9216 + wid * 1024); } } while (0)
#define A_WAITBAR(n) do { if (BR == 3 && wid < 4) asm volatile("s_waitcnt vmcnt(%0) lgkmcnt(0)\n\ts_barrier" :: "n"(3 * (n)) : "memory"); \
                          else asm volatile("s_waitcnt vmcnt(%0) lgkmcnt(0)\n\ts_barrier" :: "n"(2 * (n)) : "memory"); } while (0)
    LAS float* btab = (LAS float*)(lds + BT0);
    if (BR == 0) { if (tid < 465) btab[tid] = P.rpb[hx * 465 + tid] * 1.4426950408889634f; }
    const int qr = (q0 >> 6) + (wid >> 1), qc = (wid & 1) * 32 + r32;
    const int krow0 = min(max(qr - 4, 0), GROWS - 8), kcol0 = min(max(qc - 8, 0), GW - 16);
    float mref = 0.f, lsum = 0.f;
    f32x16 o0, o1, negm;
#pragma unroll
    for (int r = 0; r < 16; ++r) { o0[r] = 0.f; o1[r] = 0.f; negm[r] = 0.f; }
    const unsigned kfo = (r32 >> 3) * 1152 + (r32 & 7) * 128 + ((hi ^ (r32 & 7)) * 16);
    const unsigned rfo = 9216 + r32 * 64 + ((hi ^ ((r32 >> 2) & 3)) * 16);
    const unsigned vfo = KB + (4 * hi + ((lane & 15) >> 2)) * 128 + ((lane >> 3) & 1) * 64 + ((lane >> 4) & 1) * 32 + (lane & 3) * 8;
#define A_ACTIVE(t) (!(BR == 0 && (t) >= 4) || (((klo >> 6) + ((t) - 4)) >= krow0 && ((klo >> 6) + ((t) - 4)) < krow0 + 8))
#define A_QK(p0, p1, slot) do { const ldsp kb_ = lds + (slot) * SLOT; bf16x8 kaf[NKS], kbf[NKS], qkf[NKS]; \
        _Pragma("unroll") for (int ks = 0; ks < NKS; ++ks) { \
            if (ks < 4) { const ldsp a_ = kb_ + (kfo ^ (unsigned)(ks * 32)); kaf[ks] = *(const LAS bf16x8*)(a_); kbf[ks] = *(const LAS bf16x8*)(a_ + 4608); } \
            else { const ldsp a_ = kb_ + (rfo ^ (unsigned)((ks - 4) * 32)); kaf[ks] = *(const LAS bf16x8*)(a_); kbf[ks] = *(const LAS bf16x8*)(a_ + 2048); } \
            qkf[ks] = *(const LAS bf16x8*)(qlds + ks * 1024); } \
        p0 = __builtin_amdgcn_mfma_f32_32x32x16_bf16(kaf[0], qkf[0], negm, 0, 0, 0); p1 = __builtin_amdgcn_mfma_f32_32x32x16_bf16(kbf[0], qkf[0], negm, 0, 0, 0); \
        _Pragma("unroll") for (int ks = 1; ks < NKS; ++ks) { \
          p0 = __builtin_amdgcn_mfma_f32_32x32x16_bf16(kaf[ks], qkf[ks], p0, 0, 0, 0); p1 = __builtin_amdgcn_mfma_f32_32x32x16_bf16(kbf[ks], qkf[ks], p1, 0, 0, 0); } } while (0)
    asm volatile("s_waitcnt lgkmcnt(0)" ::: "memory");
#pragma unroll
    for (int j = 0; j < PF; ++j) { if (j < nt) A_DMA(j, j); }
    if (nt >= PF) A_WAITBAR(PF - 2); else A_WAITBAR(0);
    f32x16 sA0, sA1, sB0, sB1;
    A_QK(sA0, sA1, 0);
    bool act_cur = true;
    int sl = 0;
#define A_STEP(t, pc0, pc1, pn0, pn1) do { \
        const int s1 = (sl + 1 == R) ? 0 : sl + 1, sm = (sl == 0) ? R - 1 : sl - 1; \
        if ((t) + PF < nt) A_DMA((t) + PF, sm);                   \
        const bool act_next = ((t) + 1 < nt) && A_ACTIVE((t) + 1); \
        if (act_next) A_QK(pn0, pn1, s1); \
        if (act_cur) { \
            if (BR == 0) { if ((t) >= 4) { const int dr = (klo >> 6) + ((t) - 4) - qr + 7; \
                    _Pragma("unroll") for (int r = 0; r < 16; ++r) { const int kc0 = crow(r, hi), kc1 = 32 + kc0; \
                        const bool v0 = (unsigned)(kc0 - kcol0) < 16u, v1 = (unsigned)(kc1 - kcol0) < 16u; \
                        const float b0 = btab[dr * 31 + min(max(kc0 - qc + 15, 0), 30)], b1 = btab[dr * 31 + min(max(kc1 - qc + 15, 0), 30)]; \
                        pc0[r] = v0 ? pc0[r] + b0 : NEG; pc1[r] = v1 ? pc1[r] + b1 : NEG; } } } \
            if (BR == 2) { if ((t) >= 4) { const int kb0 = klo + ((t) - 4) * 64 - tokq + 128; \
                    _Pragma("unroll") for (int r = 0; r < 16; ++r) { const int d0 = kb0 + crow(r, hi); \
                        if ((unsigned)d0 > 256u) pc0[r] = NEG; if ((unsigned)(d0 + 32) > 256u) pc1[r] = NEG; } } } \
            float rm; \
            { const float a0 = max3f(pc0[0], pc0[1], pc0[2]), a1 = max3f(pc0[3], pc0[4], pc0[5]), a2 = max3f(pc0[6], pc0[7], pc0[8]), a3 = max3f(pc0[9], pc0[10], pc0[11]), \
                          a4 = max3f(pc0[12], pc0[13], pc0[14]), a5 = max3f(pc0[15], pc1[0], pc1[1]), a6 = max3f(pc1[2], pc1[3], pc1[4]), a7 = max3f(pc1[5], pc1[6], pc1[7]), \
                          a8 = max3f(pc1[8], pc1[9], pc1[10]), a9 = max3f(pc1[11], pc1[12], pc1[13]), a10 = fmaxf(pc1[14], pc1[15]); \
              const float b0 = max3f(a0, a1, a2), b1 = max3f(a3, a4, a5), b2 = max3f(a6, a7, a8), b3 = fmaxf(a9, a10); \
              rm = xhalf_max(fmaxf(fmaxf(b0, b1), fmaxf(b2, b3))); } \
            if ((t) == 0 || __any(rm > THR)) { \
                const float dl = ((t) == 0) ? rm : fmaxf(rm, 0.f); const float f = __builtin_amdgcn_exp2f(-dl); \
                mref += dl; lsum *= f; \
                _Pragma("unroll") for (int r = 0; r < 16; ++r) { pc0[r] -= dl; pc1[r] -= dl; negm[r] -= dl; o0[r] *= f; o1[r] *= f; } \
                if (act_next) { _Pragma("unroll") for (int r = 0; r < 16; ++r) { pn0[r] -= dl; pn1[r] -= dl; } } } \
            _Pragma("unroll") for (int r = 0; r < 16; ++r) { pc0[r] = __builtin_amdgcn_exp2f(pc0[r]); pc1[r] = __builtin_amdgcn_exp2f(pc1[r]); } \
            { float s8[8]; _Pragma("unroll") for (int r = 0; r < 8; ++r) s8[r] = (pc0[r] + pc0[r + 8]) + (pc1[r] + pc1[r + 8]); \
              lsum += ((s8[0] + s8[1]) + (s8[2] + s8[3])) + ((s8[4] + s8[5]) + (s8[6] + s8[7])); } \
            const ldsp vb = lds + sl * SLOT + vfo, vb1 = lds + sl * SLOT + (vfo ^ 64u); \
            bf16x8 pf[4]; \
            _Pragma("unroll") for (int s = 0; s < 4; ++s) { const int rb = (s & 1) * 8; typedef unsigned u4 __attribute__((ext_vector_type(4))); u4 ww; \
                  if (s < 2) ww = (u4){cvtpk(pc0[rb], pc0[rb + 1]), cvtpk(pc0[rb + 2], pc0[rb + 3]), cvtpk(pc0[rb + 4], pc0[rb + 5]), cvtpk(pc0[rb + 6], pc0[rb + 7])}; \
                  else       ww = (u4){cvtpk(pc1[rb], pc1[rb + 1]), cvtpk(pc1[rb + 2], pc1[rb + 3]), cvtpk(pc1[rb + 4], pc1[rb + 5]), cvtpk(pc1[rb + 6], pc1[rb + 7])}; \
                  pf[s] = __builtin_bit_cast(bf16x8, ww); } \
            s16x4 vl0[4], vh0[4], vl1[4], vh1[4]; \
            _Pragma("unroll") for (int s = 0; s < 4; ++s) { vl0[s] = __builtin_bit_cast(s16x4, __builtin_amdgcn_ds_read_tr16_b64_v4i16((LAS v4i16_t*)(vb + s * 2048))); vh0[s] = __builtin_bit_cast(s16x4, __builtin_amdgcn_ds_read_tr16_b64_v4i16((LAS v4i16_t*)(vb + s * 2048 + 1024))); } \
            _Pragma("unroll") for (int s = 0; s < 4; ++s) { vl1[s] = __builtin_bit_cast(s16x4, __builtin_amdgcn_ds_read_tr16_b64_v4i16((LAS v4i16_t*)(vb1 + s * 2048))); vh1[s] = __builtin_bit_cast(s16x4, __builtin_amdgcn_ds_read_tr16_b64_v4i16((LAS v4i16_t*)(vb1 + s * 2048 + 1024))); } \
            _Pragma("unroll") for (int s = 0; s < 4; ++s) { const bf16x8 vf = (bf16x8){vl0[s][0], vl0[s][1], vl0[s][2], vl0[s][3], vh0[s][0], vh0[s][1], vh0[s][2], vh0[s][3]}; o0 = __builtin_amdgcn_mfma_f32_32x32x16_bf16(vf, pf[s], o0, 0, 0, 0); } \
            _Pragma("unroll") for (int s = 0; s < 4; ++s) { const bf16x8 vf = (bf16x8){vl1[s][0], vl1[s][1], vl1[s][2], vl1[s][3], vh1[s][0], vh1[s][1], vh1[s][2], vh1[s][3]}; o1 = __builtin_amdgcn_mfma_f32_32x32x16_bf16(vf, pf[s], o1, 0, 0, 0); } \
        } \
          \
        if ((t) + PF < nt) A_WAITBAR(PF - 2); else A_WAITBAR(0); \
        act_cur = act_next; sl = s1; \
    } while (0)
    { int t = 0;
      for (; t + 1 < nt; t += 2) { A_STEP(t, sA0, sA1, sB0, sB1); A_STEP(t + 1, sB0, sB1, sA0, sA1); }
      if (t < nt) A_STEP(t, sA0, sA1, sB0, sB1); }
    float ltot = xhalf_sum(lsum);
    if (BR == 2) ltot += __builtin_amdgcn_exp2f(P.sink[head] * 1.4426950408889634f - mref);
    const float inv = 1.f / ltot;
#ifdef PROBE_ATTN
    if (P.o32 && b == 1 && (ctxq || tokq < 1024 || tokq >= 7168)) {
        const int sub = ctxq ? 2048 + tokq : (tokq < 1024 ? tokq : 1024 + tokq - 7168);
        float* fp = P.o32 + (size_t)sub * D + BR * 256 + head * 64 + 4 * hi;
#pragma unroll
        for (int g = 0; g < 4; ++g)
#pragma unroll
            for (int j = 0; j < 4; ++j) { fp[8 * g + j] = o0[4 * g + j] * inv; fp[32 + 8 * g + j] = o1[4 * g + j] * inv; }
    }
#endif
    T* op = P.O + qrow * D + BR * 256 + head * 64 + 4 * hi;
#pragma unroll
    for (int g = 0; g < 4; ++g) {
        *(uint2*)(op + 8 * g) = pk4(o0[4 * g] * inv, o0[4 * g + 1] * inv, o0[4 * g + 2] * inv, o0[4 * g + 3] * inv);
        *(uint2*)(op + 32 + 8 * g) = pk4(o1[4 * g] * inv, o1[4 * g + 1] * inv, o1[4 * g + 2] * inv, o1[4 * g + 3] * inv);
    }
#undef A_TROW
#undef A_DMA
#undef A_WAITBAR
#undef A_ACTIVE
#undef A_QK
#undef A_STEP
}


template <int BR>
__device__ __forceinline__ void attn_unit(ldsp lds, const AttnP& P, int b, int hx, int q0, bool ctxq) {
    constexpr int DQK = (BR == 3) ? 96 : 64, NKS = DQK / 16, KB = (BR == 3) ? 9216 + 4096 : 9216, SLOT = KB + 8192;
    constexpr int R = (BR == 3) ? 7 : 9, PF = R - 3;
    constexpr int BT0 = 156672;
    static_assert(R * SLOT <= BT0, "ring");
    constexpr bool PACK2 = (BR == 1 || BR == 2);
    constexpr float SCALE = (BR == 3) ? 0.10206207261596575f : 0.125f;
    constexpr float CL2 = SCALE * 1.4426950408889634f;
    constexpr float NEG = -1e30f, THR = 8.f;
    const int tid = otid(), lane = tid & 63, wid = __builtin_amdgcn_readfirstlane(tid >> 6), r32 = lane & 31, hi = lane >> 5;
    const int tokq = q0 + (PACK2 ? (wid & 3) : wid) * 32 + r32;
    const int head = PACK2 ? hx * 2 + (wid >> 2) : hx;
    const size_t lat0 = (size_t)b * SEQ, ctx0 = (size_t)P.nlat + (size_t)b * CTX;
    const size_t qrow = ctxq ? ctx0 + tokq : lat0 + tokq;
    bf16x8 qf[NKS];
    { const T* qp = (BR == 3) ? P.QM + qrow * 384 + head * 96 + hi * 8 : P.Z + qrow * ZW + (BR == 0 ? NAQ : BR == 1 ? GQ : SQ) + head * 64 + hi * 8;
#pragma unroll
      for (int ks = 0; ks < NKS; ++ks) {
          const uint4 raw = *(const uint4*)(qp + ks * 16);
          typedef unsigned u4 __attribute__((ext_vector_type(4)));
          const u4 w = {cvtpk(__uint_as_float(raw.x << 16) * CL2, __uint_as_float(raw.x & 0xffff0000u) * CL2), cvtpk(__uint_as_float(raw.y << 16) * CL2, __uint_as_float(raw.y & 0xffff0000u) * CL2),
                        cvtpk(__uint_as_float(raw.z << 16) * CL2, __uint_as_float(raw.z & 0xffff0000u) * CL2), cvtpk(__uint_as_float(raw.w << 16) * CL2, __uint_as_float(raw.w & 0xffff0000u) * CL2)};
          qf[ks] = __builtin_bit_cast(bf16x8, w); } }
    int klo = 0, nlt = 0;
    if (!ctxq) {
        if (BR == 0) { const int r0 = q0 >> 6; const int lo = min(max(r0 - 4, 0), GROWS - 8), hi2 = min(max(r0 - 1, 0), GROWS - 8) + 8; klo = lo * 64; nlt = hi2 - lo; }
        else if (BR == 2) { klo = max(q0 - 128, 0); nlt = (min(q0 + 256, SEQ) - klo) >> 6; }
        else { klo = 0; nlt = SEQ / 64; }
    }
    const int nt = 4 + nlt;
    const T* ksrc; const T* vsrc; const T* rsrc = nullptr; size_t kpitch;
    { const int kk = 8 * wid + (lane >> 3), kch = ((lane & 7) ^ (lane >> 3)) * 8, vch = ((((lane >> 2) ^ (lane >> 4)) & 1) * 32) + (lane & 3) * 8;
      if (BR == 3) { ksrc = P.KVM + (size_t)kk * 512 + hx * 128 + kch; vsrc = P.KVM + (size_t)kk * 512 + hx * 128 + 64 + vch; kpitch = 512;
                     rsrc = P.Z + (size_t)(16 * (wid & 3) + (lane >> 2)) * ZW + MKR + (((lane & 3) ^ ((lane >> 4) & 3)) * 8); }
      else { const int ko = (BR == 0 ? NAK : BR == 1 ? GK : SK) + hx * 64, vo = (BR == 0 ? NAV : BR == 1 ? GV : SV) + hx * 64;
             ksrc = P.Z + (size_t)kk * ZW + ko + kch; vsrc = P.Z + (size_t)kk * ZW + vo + vch; kpitch = ZW; } }
#define A_TROW(t) ((t) < 4 ? ctx0 + (size_t)(t) * 64 : lat0 + (size_t)klo + (size_t)((t) - 4) * 64)
#define A_DMA(t, slot) do { if (wid < 4) { const size_t tr_ = A_TROW(t); const ldsp sb_ = lds + (slot) * SLOT; \
        GLDS16(ksrc + tr_ * kpitch, sb_ + wid * 1152); GLDS16(ksrc + (tr_ + 32) * kpitch, sb_ + (wid + 4) * 1152); \
        GLDS16(vsrc + tr_ * kpitch, sb_ + KB + wid * 1024); GLDS16(vsrc + (tr_ + 32) * kpitch, sb_ + KB + (wid + 4) * 1024); \
        if (BR == 3) GLDS16(rsrc + tr_ * ZW, sb_ + 9216 + wid * 1024); } } while (0)
#define A_WAITBAR(n) do { if (wid < 4) { if (BR == 3) asm volatile("s_waitcnt vmcnt(%0) lgkmcnt(0)\n\ts_barrier" :: "n"(5 * (n)) : "memory"); \
                                         else asm volatile("s_waitcnt vmcnt(%0) lgkmcnt(0)\n\ts_barrier" :: "n"(4 * (n)) : "memory"); } \
                          else asm volatile("s_waitcnt lgkmcnt(0)\n\ts_barrier" ::: "memory"); } while (0)
    LAS float* btab = (LAS float*)(lds + BT0);
    if (BR == 0) { if (tid < 465) btab[tid] = P.rpb[hx * 465 + tid] * 1.4426950408889634f; }
    const int qr = (q0 >> 6) + (wid >> 1), qc = (wid & 1) * 32 + r32;
    const int krow0 = min(max(qr - 4, 0), GROWS - 8), kcol0 = min(max(qc - 8, 0), GW - 16);
    float mref = 0.f, lsum = 0.f;
    f32x16 o0, o1, negm;
#pragma unroll
    for (int r = 0; r < 16; ++r) { o0[r] = 0.f; o1[r] = 0.f; negm[r] = 0.f; }
    const unsigned kfo = (r32 >> 3) * 1152 + (r32 & 7) * 128 + ((hi ^ (r32 & 7)) * 16);
    const unsigned rfo = 9216 + r32 * 64 + ((hi ^ ((r32 >> 2) & 3)) * 16);
    const unsigned vfo = KB + (4 * hi + ((lane & 15) >> 2)) * 128 + ((lane >> 3) & 1) * 64 + ((lane >> 4) & 1) * 32 + (lane & 3) * 8;
    constexpr int NG = 8 + 2 * NKS, AHEAD = 4, NGT = NG;
    if (wid < 4) { const size_t tr_ = A_TROW(0); GLDS16(vsrc + tr_ * kpitch, lds + (R - 1) * SLOT + KB + wid * 1024); GLDS16(vsrc + (tr_ + 32) * kpitch, lds + (R - 1) * SLOT + KB + (wid + 4) * 1024); }
#pragma unroll
    for (int j = 0; j < PF; ++j) { if (j < nt) A_DMA(j, j); }
    if (nt >= PF) A_WAITBAR(PF - 3); else A_WAITBAR(0);
    f32x16 sA0, sA1, sB0, sB1;
    { const ldsp kb_ = lds;
#pragma unroll
      for (int r = 0; r < 16; ++r) { sA0[r] = 0.f; sA1[r] = 0.f; }
#pragma unroll
      for (int ks = 0; ks < NKS; ++ks) { const ldsp a_ = kb_ + ((ks < 4) ? (kfo ^ (unsigned)(ks * 32)) : (rfo ^ (unsigned)((ks - 4) * 32)));
          const bf16x8 ka = *(const LAS bf16x8*)(a_), kb = *(const LAS bf16x8*)(a_ + ((ks < 4) ? 4608 : 2048));
          sA0 = __builtin_amdgcn_mfma_f32_32x32x16_bf16(ka, qf[ks], sA0, 0, 0, 0); sA1 = __builtin_amdgcn_mfma_f32_32x32x16_bf16(kb, qf[ks], sA1, 0, 0, 0); } }
    unsigned pwA[16], pwB[16];
#pragma unroll
    for (int i = 0; i < 16; ++i) { pwA[i] = 0u; pwB[i] = 0u; }
    int sl = 0;
#ifdef PROBE_T
    unsigned long long pt_acc = 0ull, pt_a = 0ull, pt_b = 0ull; const unsigned long long pt_t0 = __builtin_amdgcn_s_memtime(), pt_r0 = __builtin_amdgcn_s_memrealtime();
#define PT_A(k) do { if (PROBE_T == (k)) pt_a = __builtin_amdgcn_s_memtime(); } while (0)
#define PT_B(k) do { if (PROBE_T == (k)) { pt_b = __builtin_amdgcn_s_memtime(); pt_acc += pt_b - pt_a; } } while (0)
#else
#define PT_A(k) do { } while (0)
#define PT_B(k) do { } while (0)
#endif
#define S_EL(c0, c1, i) ((i) < 16 ? c0[(i) & 15] : c1[(i) & 15])
#define SB0() __builtin_amdgcn_sched_barrier(0)
    const unsigned lds0 = (unsigned)(size_t)lds;
#define DSR128(dst, addr, OFF) asm volatile("ds_read_b128 %0, %1 offset:" #OFF : "=v"(dst) : "v"(addr))
#define DSRTR(dst, addr, OFF) asm volatile("ds_read_b64_tr_b16 %0, %1 offset:" #OFF : "=v"(dst) : "v"(addr))
#define A_RD(m) do { switch (m) { \
        case 0: DSRTR(vL[0], vb_, 0); DSRTR(vH[0], vb_, 1024); break; case 1: DSRTR(vL[1], vc_, 0); DSRTR(vH[1], vc_, 1024); break; \
        case 2: DSRTR(vL[2], vb_, 2048); DSRTR(vH[2], vb_, 3072); break; case 3: DSRTR(vL[3], vc_, 2048); DSRTR(vH[3], vc_, 3072); break; \
        case 4: DSRTR(vL[4], vb_, 4096); DSRTR(vH[4], vb_, 5120); break; case 5: DSRTR(vL[5], vc_, 4096); DSRTR(vH[5], vc_, 5120); break; \
        case 6: DSRTR(vL[6], vb_, 6144); DSRTR(vH[6], vb_, 7168); break; case 7: DSRTR(vL[7], vc_, 6144); DSRTR(vH[7], vc_, 7168); break; \
        default: { const int q_ = (m) - 8, ks_ = q_ >> 1; \
                   if (ks_ < 4) { const unsigned a_ = kb_ + (kfo ^ (unsigned)(ks_ * 32)); if (q_ & 1) DSR128(kF[q_], a_, 4608); else DSR128(kF[q_], a_, 0); } \
                   else { const unsigned a_ = kb_ + (rfo ^ (unsigned)((ks_ - 4) * 32)); if (q_ & 1) DSR128(kF[q_], a_, 2048); else DSR128(kF[q_], a_, 0); } } break; } } while (0)
#define NRD(m) ((m) < 8 ? 2 : 1)
#define A_WT(g, n) do { if ((g) < 8) { if ((n) == 0) asm volatile("s_waitcnt lgkmcnt(0)" : "+v"(vL[g]), "+v"(vH[g])); else if ((n) == 1) asm volatile("s_waitcnt lgkmcnt(1)" : "+v"(vL[g]), "+v"(vH[g])); \
            else if ((n) == 2) asm volatile("s_waitcnt lgkmcnt(2)" : "+v"(vL[g]), "+v"(vH[g])); else if ((n) == 3) asm volatile("s_waitcnt lgkmcnt(3)" : "+v"(vL[g]), "+v"(vH[g])); \
            else if ((n) == 4) asm volatile("s_waitcnt lgkmcnt(4)" : "+v"(vL[g]), "+v"(vH[g])); else if ((n) == 5) asm volatile("s_waitcnt lgkmcnt(5)" : "+v"(vL[g]), "+v"(vH[g])); \
            else if ((n) == 6) asm volatile("s_waitcnt lgkmcnt(6)" : "+v"(vL[g]), "+v"(vH[g])); else if ((n) == 7) asm volatile("s_waitcnt lgkmcnt(7)" : "+v"(vL[g]), "+v"(vH[g])); \
            else asm volatile("s_waitcnt lgkmcnt(8)" : "+v"(vL[g]), "+v"(vH[g])); } \
        else { if ((n) == 0) asm volatile("s_waitcnt lgkmcnt(0)" : "+v"(kF[(g) - 8])); else if ((n) == 1) asm volatile("s_waitcnt lgkmcnt(1)" : "+v"(kF[(g) - 8])); \
            else if ((n) == 2) asm volatile("s_waitcnt lgkmcnt(2)" : "+v"(kF[(g) - 8])); else if ((n) == 3) asm volatile("s_waitcnt lgkmcnt(3)" : "+v"(kF[(g) - 8])); \
            else asm volatile("s_waitcnt lgkmcnt(4)" : "+v"(kF[(g) - 8])); } } while (0)
#define A_ITER(t, c0, c1, n0, n1, pwO, pwN, EVEN) do { \
        const int s1 = (sl + 1 == R) ? 0 : sl + 1, sm1 = (sl == 0) ? R - 1 : sl - 1, sm2 = (sm1 == 0) ? R - 1 : sm1 - 1; \
        const bool feed = (t) + PF < nt; PT_A(4); \
        if (BR == 2) { if ((t) >= 4) { const int kb0 = klo + ((t) - 4) * 64 - tokq + 128; \
                _Pragma("unroll") for (int r = 0; r < 16; ++r) { const int d0 = kb0 + crow(r, hi); \
                    if ((unsigned)d0 > 256u) c0[r] = NEG; if ((unsigned)(d0 + 32) > 256u) c1[r] = NEG; } } } \
          \
        const unsigned vb_ = lds0 + sm1 * SLOT + vfo, vc_ = lds0 + sm1 * SLOT + (vfo ^ 64u); const unsigned kb_ = lds0 + s1 * SLOT; \
        s16x4 vL[8], vH[8]; bf16x8 kF[2 * NKS]; \
        _Pragma("unroll") for (int m = 0; m < AHEAD; ++m) A_RD(m); \
        float acs0 = 0.f, acs1 = 0.f; SB0(); PT_B(4); PT_A(5); \
        _Pragma("unroll") for (int g = 0; g < NGT; ++g) { \
              \
            if (g + AHEAD < NG) A_RD(g + AHEAD); \
              \
            if (g < NG) { int n_ = 0; _Pragma("unroll") for (int m = g + 1; m <= g + AHEAD; ++m) if (m < NG) n_ += NRD(m); A_WT(g, n_); } \
              \
            if (g < 8) { typedef unsigned u4 __attribute__((ext_vector_type(4))); const int s = g >> 1; \
                const u4 pw4 = {pwO[4 * s], pwO[4 * s + 1], pwO[4 * s + 2], pwO[4 * s + 3]}; const bf16x8 pfr = __builtin_bit_cast(bf16x8, pw4); \
                const bf16x8 vf = (bf16x8){vL[g][0], vL[g][1], vL[g][2], vL[g][3], vH[g][0], vH[g][1], vH[g][2], vH[g][3]}; \
                if ((g & 1) == 0) o0 = __builtin_amdgcn_mfma_f32_32x32x16_bf16(vf, pfr, o0, 0, 0, 0); else o1 = __builtin_amdgcn_mfma_f32_32x32x16_bf16(vf, pfr, o1, 0, 0, 0); } \
            else if (g < NG) { const int q_ = g - 8, ks = q_ >> 1; \
                if ((q_ & 1) == 0) n0 = __builtin_amdgcn_mfma_f32_32x32x16_bf16(kF[q_], qf[ks], ks == 0 ? negm : n0, 0, 0, 0); \
                else               n1 = __builtin_amdgcn_mfma_f32_32x32x16_bf16(kF[q_], qf[ks], ks == 0 ? negm : n1, 0, 0, 0); } \
              \
              \
            { const int sx = (NG == 20) ? ((g % 5 == 4) ? -1 : g - g / 5) : (g < 16 ? g : -1); \
            if (sx >= 0) { const float e0 = __builtin_amdgcn_exp2f(S_EL(c0, c1, 2 * sx)), e1 = __builtin_amdgcn_exp2f(S_EL(c0, c1, 2 * sx + 1)); \
                pwN[sx] = cvtpk(e0, e1); \
                  \
                { float t_ = e0 + e1; asm volatile("" : "+v"(t_)); if ((sx & 1) == 0) { acs0 += t_; asm volatile("" : "+v"(acs0)); } else { acs1 += t_; asm volatile("" : "+v"(acs1)); } } } } \
            SB0(); \
        } \
          \
          \
          \
        float ts_ = acs0 + acs1; \
        if ((t) == 0 || __any(!(ts_ <= 256.f))) { \
            float rm; \
            { const float a0 = max3f(c0[0], c0[1], c0[2]), a1 = max3f(c0[3], c0[4], c0[5]), a2 = max3f(c0[6], c0[7], c0[8]), a3 = max3f(c0[9], c0[10], c0[11]), \
                          a4 = max3f(c0[12], c0[13], c0[14]), a5 = max3f(c0[15], c1[0], c1[1]), a6 = max3f(c1[2], c1[3], c1[4]), a7 = max3f(c1[5], c1[6], c1[7]), \
                          a8 = max3f(c1[8], c1[9], c1[10]), a9 = max3f(c1[11], c1[12], c1[13]), a10 = fmaxf(c1[14], c1[15]); \
              const float b0 = max3f(a0, a1, a2), b1 = max3f(a3, a4, a5), b2 = max3f(a6, a7, a8), b3 = fmaxf(a9, a10); \
              rm = xhalf_max(fmaxf(fmaxf(b0, b1), fmaxf(b2, b3))); } \
            const float dl = ((t) == 0) ? rm : fmaxf(rm, 0.f); const float f = __builtin_amdgcn_exp2f(-dl); \
            mref += dl; lsum *= f; \
            _Pragma("unroll") for (int r = 0; r < 16; ++r) { o0[r] *= f; o1[r] *= f; negm[r] -= dl; n0[r] -= dl; n1[r] -= dl; } \
            float r0_ = 0.f, r1_ = 0.f; \
            _Pragma("unroll") for (int i = 0; i < 16; ++i) { const float e0 = __builtin_amdgcn_exp2f(S_EL(c0, c1, 2 * i) - dl), e1 = __builtin_amdgcn_exp2f(S_EL(c0, c1, 2 * i + 1) - dl); \
                pwN[i] = cvtpk(e0, e1); if (i & 1) r1_ += e0 + e1; else r0_ += e0 + e1; } \
            ts_ = r0_ + r1_; } \
        lsum += ts_; PT_B(5); PT_A(3); \
          \
          \
        if (EVEN) { const int sp0 = (sl + PF >= R) ? sl + PF - R : sl + PF, sp1 = (sp0 + 1 == R) ? 0 : sp0 + 1; \
                    if (feed) A_DMA((t) + PF, sp0); if ((t) + PF + 1 < nt) A_DMA((t) + PF + 1, sp1); \
                    if ((t) + 1 >= nt) A_WAITBAR(0); } \
        else { if ((t) + PF < nt) A_WAITBAR(PF - 3); else A_WAITBAR(0); } PT_B(3); \
        sl = s1; \
    } while (0)
    { int t = 0;
      for (; t + 1 < nt; t += 2) { A_ITER(t, sA0, sA1, sB0, sB1, pwA, pwB, 1); A_ITER(t + 1, sB0, sB1, sA0, sA1, pwB, pwA, 0); }
      if (t < nt) { A_ITER(t, sA0, sA1, sB0, sB1, pwA, pwB, 1);
#pragma unroll
          for (int i = 0; i < 16; ++i) pwA[i] = pwB[i]; } }
    { const int sm1 = (sl == 0) ? R - 1 : sl - 1; const ldsp vb_ = lds + sm1 * SLOT + vfo, vc_ = lds + sm1 * SLOT + (vfo ^ 64u);
#pragma unroll
      for (int s = 0; s < 4; ++s) {
          typedef unsigned u4 __attribute__((ext_vector_type(4))); const u4 pw4 = {pwA[4 * s], pwA[4 * s + 1], pwA[4 * s + 2], pwA[4 * s + 3]}; const bf16x8 pfr = __builtin_bit_cast(bf16x8, pw4);
#pragma unroll
          for (int d0 = 0; d0 < 2; ++d0) { const ldsp vp = (d0 ? vc_ : vb_) + s * 2048;
              const s16x4 lo = __builtin_bit_cast(s16x4, __builtin_amdgcn_ds_read_tr16_b64_v4i16((LAS v4i16_t*)vp)), hi4 = __builtin_bit_cast(s16x4, __builtin_amdgcn_ds_read_tr16_b64_v4i16((LAS v4i16_t*)(vp + 1024)));
              const bf16x8 vf = (bf16x8){lo[0], lo[1], lo[2], lo[3], hi4[0], hi4[1], hi4[2], hi4[3]};
              if (d0 == 0) o0 = __builtin_amdgcn_mfma_f32_32x32x16_bf16(vf, pfr, o0, 0, 0, 0); else o1 = __builtin_amdgcn_mfma_f32_32x32x16_bf16(vf, pfr, o1, 0, 0, 0); }
          } }
    asm volatile("s_waitcnt lgkmcnt(0)\n\ts_barrier" ::: "memory");
#ifdef PROBE_T
    if (BR == PROBE_BR && P.o32 && blockIdx.x == 0 && wid == PROBE_W && lane == 0) {
        const unsigned long long t1 = __builtin_amdgcn_s_memtime(), r1 = __builtin_amdgcn_s_memrealtime();
        float c;
        if (PROBE_T == 1) c = 1e-5f * (float)(t1 - pt_t0) / (float)nt;
        else if (PROBE_T == 2) c = 1e-3f * (float)(t1 - pt_t0) / (float)(r1 - pt_r0);
        else c = 1e-5f * (float)pt_acc / (float)nt;
        P.o32[0] = 1.f + c;
    }
#endif
#undef S_EL
#undef SB0
#undef A_ITER
#undef A_RD
#undef NRD
#undef A_WT
#undef DSR128
#undef DSRTR
    float ltot = xhalf_sum(lsum);
    if (BR == 2) ltot += __builtin_amdgcn_exp2f(P.sink[head] * 1.4426950408889634f - mref);
    const float inv = 1.f / ltot;
#ifdef PROBE_ATTN
    if (P.o32 && b == 1 && (ctxq || tokq < 1024 || tokq >= 7168)) {
        const int sub = ctxq ? 2048 + tokq : (tokq < 1024 ? tokq : 1024 + tokq - 7168);
        float* fp = P.o32 + (size_t)sub * D + BR * 256 + head * 64 + 4 * hi;
#pragma unroll
        for (int g = 0; g < 4; ++g)
#pragma unroll
            for (int j = 0; j < 4; ++j) { fp[8 * g + j] = o0[4 * g + j] * inv; fp[32 + 8 * g + j] = o1[4 * g + j] * inv; }
    }
#endif
    T* op = P.O + qrow * D + BR * 256 + head * 64 + 4 * hi;
#pragma unroll
    for (int g = 0; g < 4; ++g) {
        *(uint2*)(op + 8 * g) = pk4(o0[4 * g] * inv, o0[4 * g + 1] * inv, o0[4 * g + 2] * inv, o0[4 * g + 3] * inv);
        *(uint2*)(op + 32 + 8 * g) = pk4(o1[4 * g] * inv, o1[4 * g + 1] * inv, o1[4 * g + 2] * inv, o1[4 * g + 3] * inv);
    }
#undef A_TROW
#undef A_DMA
#undef A_WAITBAR
#undef A_ACTIVE
#undef A_QK
#undef A_STEP
}

__device__ __forceinline__ void attn_phase(ldsp lds, const AttnP& P, int bid, int nblk) {
    for (int u = bid; u < 512; u += nblk) attn_unit<3>(lds, P, u >> 7, (u >> 5) & 3, (u & 31) * 256, false);
    for (int u = bid; u < 512; u += nblk) attn_unit<1>(lds, P, u >> 7, (u >> 6) & 1, (u & 63) * 128, false);
    for (int u = bid; u < 512; u += nblk) attn_unit_l<0>(lds, P, u >> 7, (u >> 5) & 3, (u & 31) * 256, false);
    for (int u = bid; u < 512; u += nblk) attn_unit<2>(lds, P, u >> 7, (u >> 6) & 1, (u & 63) * 128, false);
    if (P.need_ctx) {
        for (int u = bid; u < 64; u += nblk) {
            const int br = u >> 4, bb = (u >> 2) & 3, x = u & 3;
            if (br == 0) attn_unit_l<0>(lds, P, bb, x, 0, true);
            else if (br == 1) attn_unit<1>(lds, P, bb, x >> 1, (x & 1) * 128, true);
            else if (br == 2) attn_unit<2>(lds, P, bb, x >> 1, (x & 1) * 128, true);
            else attn_unit<3>(lds, P, bb, x, 0, true);
        }
    }
}

constexpr size_t al256(size_t b) { return (b + 255) & ~(size_t)255; }
constexpr size_t NSLOT_ = (size_t)NB * NE * (CAP + CAPC);
constexpr size_t OFF_BAR = 0, OFF_MODV = OFF_BAR + al256(3456 * 4), OFF_TAB64 = OFF_MODV + al256((size_t)NL * 5 * MODW * 4), OFF_TAB32 = OFF_TAB64 + al256(128 * 16 * 8),
    OFF_RA = OFF_TAB32 + al256(128 * 8 * 8), OFF_RC = OFF_RA + al256((size_t)NROW * D * 2), OFF_XCA = OFF_RC + al256((size_t)NROW * D * 2), OFF_XCB = OFF_XCA + al256((size_t)NCTX * D * 4),
    OFF_AFF = OFF_XCB + al256((size_t)NCTX * D * 4), OFF_IDX = OFF_AFF + al256((size_t)NROW * NE * 4), OFF_GATEV = OFF_IDX + al256(NSLOT_ * 4), OFF_INV = OFF_GATEV + al256(NSLOT_ * 4),
    OFF_Z = OFF_INV + al256((size_t)NROW * NE * 4), OFF_WINT = OFF_Z + al256((size_t)NROW * ZW * 2), OFF_WQT = OFF_WINT + al256((size_t)NL * 6400 * D * 2), OFF_WKVT = OFF_WQT + al256((size_t)NL * 384 * 192 * 2),
    OFF_SS = OFF_WKVT + al256((size_t)NL * 512 * 128 * 2), OFF_WBT = OFF_SS + al256((size_t)NROW * 8 * 4), OFF_WOUTT = OFF_WBT + al256((size_t)NL * 4 * 1024 * 256 * 2), OFF_END = OFF_WOUTT + al256((size_t)NL * D * D * 2);
struct MP {
    const float *x_, *c_, *ctx_, *c_ctx_, *w_mod_, *b_mod_, *w_in_, *na_rpb_, *gqn_, *gkn_, *swa_sink_, *mqn_, *mkvn_, *w_qb_, *w_kvb_, *w_branch_, *w_out_,
                *ln1g_, *ln1b_, *ln2g_, *ln2b_, *w_router_, *w_gate_, *w_up_, *w_down_;
    float* out_; char* ws_;
    float* o32_; const float* pscale_;
    int ph_lo_, ph_hi_;
    __device__ __forceinline__ const float* x() const { return x_; }
    __device__ __forceinline__ const float* c() const { return c_; }
    __device__ __forceinline__ const float* ctx() const { return ctx_; }
    __device__ __forceinline__ const float* c_ctx() const { return c_ctx_; }
    __device__ __forceinline__ const float* w_mod() const { return w_mod_; }
    __device__ __forceinline__ const float* b_mod() const { return b_mod_; }
    __device__ __forceinline__ const float* w_in() const { return w_in_; }
    __device__ __forceinline__ const float* na_rpb() const { return na_rpb_; }
    __device__ __forceinline__ const float* gqn() const { return gqn_; }
    __device__ __forceinline__ const float* gkn() const { return gkn_; }
    __device__ __forceinline__ const float* swa_sink() const { return swa_sink_; }
    __device__ __forceinline__ const float* mqn() const { return mqn_; }
    __device__ __forceinline__ const float* mkvn() const { return mkvn_; }
    __device__ __forceinline__ const float* w_qb() const { return w_qb_; }
    __device__ __forceinline__ const float* w_kvb() const { return w_kvb_; }
    __device__ __forceinline__ const float* w_branch() const { return w_branch_; }
    __device__ __forceinline__ const float* w_out() const { return w_out_; }
    __device__ __forceinline__ const float* ln1g() const { return ln1g_; }
    __device__ __forceinline__ const float* ln1b() const { return ln1b_; }
    __device__ __forceinline__ const float* ln2g() const { return ln2g_; }
    __device__ __forceinline__ const float* ln2b() const { return ln2b_; }
    __device__ __forceinline__ const float* w_router() const { return w_router_; }
    __device__ __forceinline__ const float* w_gate() const { return w_gate_; }
    __device__ __forceinline__ const float* w_up() const { return w_up_; }
    __device__ __forceinline__ const float* w_down() const { return w_down_; }
    __device__ __forceinline__ float* out() const { return out_; }
    __device__ __forceinline__ char* ws() const { return ws_; }
    __device__ __forceinline__ float* o32() const { return o32_; }
    __device__ __forceinline__ const float* pscale() const { return pscale_; }
    __device__ __forceinline__ int ph_lo() const { return ph_lo_; }
    __device__ __forceinline__ int ph_hi() const { return ph_hi_; }
    __device__ __forceinline__ unsigned* bar() const { return (unsigned*)(ws() + OFF_BAR); }
    __device__ __forceinline__ float* modv() const { return (float*)(ws() + OFF_MODV); }
    __device__ __forceinline__ float2* tab64() const { return (float2*)(ws() + OFF_TAB64); }
    __device__ __forceinline__ float2* tab32() const { return (float2*)(ws() + OFF_TAB32); }
    __device__ __forceinline__ T* RA() const { return (T*)(ws() + OFF_RA); }
    __device__ __forceinline__ T* RC() const { return (T*)(ws() + OFF_RC); }
    __device__ __forceinline__ float* XCa() const { return (float*)(ws() + OFF_XCA); }
    __device__ __forceinline__ float* XCb() const { return (float*)(ws() + OFF_XCB); }
    __device__ __forceinline__ float* AFF() const { return (float*)(ws() + OFF_AFF); }
    __device__ __forceinline__ int* IDX() const { return (int*)(ws() + OFF_IDX); }
    __device__ __forceinline__ float* GATEV() const { return (float*)(ws() + OFF_GATEV); }
    __device__ __forceinline__ int* INV() const { return (int*)(ws() + OFF_INV); }
    __device__ __forceinline__ T* Z() const { return (T*)(ws() + OFF_Z); }
    __device__ __forceinline__ T* WinT() const { return (T*)(ws() + OFF_WINT); }
    __device__ __forceinline__ T* WqT() const { return (T*)(ws() + OFF_WQT); }
    __device__ __forceinline__ T* WkvT() const { return (T*)(ws() + OFF_WKVT); }
    __device__ __forceinline__ float* SS() const { return (float*)(ws() + OFF_SS); }
    __device__ __forceinline__ T* WbT() const { return (T*)(ws() + OFF_WBT); }
    __device__ __forceinline__ T* WoutT() const { return (T*)(ws() + OFF_WOUTT); }
};

__device__ __forceinline__ void ph_mod(ldsp lds, const MP& p, int bid, int nblk) {
    LAS float* sc = (LAS float*)lds;
    LAS float* red = (LAS float*)(lds + 5 * 1024 * 4);
    const int tid = otid(), lane = tid & 63, kg = tid >> 6;
    for (int i = tid; i < 5 * 1024; i += 512) { const int s = i >> 10, k = i & 1023; const float v = s < 4 ? p.c()[s * 1024 + k] : p.c_ctx()[k]; sc[i] = v / (1.f + expf(-v)); }
    __syncthreads();
    for (int u = bid; u < NL * (MODW / 64); u += nblk) {
        const int l = u / (MODW / 64), j = (u % (MODW / 64)) * 64 + lane;
        float acc[5] = {0.f, 0.f, 0.f, 0.f, 0.f};
        const float* w = p.w_mod() + (size_t)l * D * MODW + j;
        for (int k = kg * 128; k < kg * 128 + 128; ++k) { const float wv = w[(size_t)k * MODW];
#pragma unroll
            for (int s = 0; s < 5; ++s) acc[s] += sc[s * 1024 + k] * wv; }
#pragma unroll
        for (int s = 0; s < 5; ++s) red[(kg * 5 + s) * 64 + lane] = acc[s];
        __syncthreads();
        if (kg < 5) { const int s = kg; float v = p.b_mod()[l * MODW + j];
#pragma unroll
            for (int g = 0; g < 8; ++g) v += red[(g * 5 + s) * 64 + lane];
            p.modv()[((size_t)l * 5 + s) * MODW + j] = v; }
        __syncthreads();
    }
}
__device__ __forceinline__ void ph_ropetab(const MP& p, int bid, int nblk) {
    for (int t = bid * 512 + otid(); t < 128 * 16; t += nblk * 512) {
        { const int pos = t / 16, i = t % 16; const float a = (float)pos * powf(10000.f, -(float)i / 16.f); p.tab64()[t] = make_float2(cosf(a), sinf(a)); }
        if (t < 128 * 8) { const int pos = t / 8, i = t % 8; const float a = (float)pos * powf(10000.f, -(float)i / 8.f); p.tab32()[t] = make_float2(cosf(a), sinf(a)); }
    }
}
struct PrepJob { const float* src; const float* src2; const float* kscale; T* dst; int K, Nsrc, Ndst, mode, nz, perm; long long src_zs, dst_zs, ks_zs; };
__device__ __forceinline__ void ph_wprep(ldsp lds, const PrepJob& a, int bid, int nblk) {
    constexpr int NT = 4;
    LAS float* tile = (LAS float*)lds;
    const int tid_ = otid();
    const int kr = tid_ >> 4, c4 = tid_ & 15;
    const int kq = tid_ & 7, nr = tid_ >> 3;
    const int nx = a.Ndst / 64, ny = a.K / 64, ntile = nx * ny * a.nz;
    float4 v0[NT], v1[NT];
#define WP_LOAD(i, u) do { const int z_ = (u) / (nx * ny), rem_ = (u) % (nx * ny), n0_ = (rem_ % nx) * 64, k0_ = (rem_ / nx) * 64; \
        const float* src_ = a.src + (size_t)z_ * a.src_zs; const float* ksc_ = a.kscale ? a.kscale + (size_t)z_ * a.ks_zs : nullptr; \
        int n_ = n0_ + 4 * c4; if (a.perm) { const int p_ = n_ & 255; n_ = (n_ & ~255) + 64 * ((p_ >> 5) & 3) + 32 * (p_ >> 7) + (p_ & 31); } bool valid_ = true; int col_ = n_; const float* sp_ = src_; \
        if (a.mode == 0) { valid_ = n_ < a.Nsrc; } \
        else if (a.mode == 1) { if (n_ < 2144) col_ = n_; else if (n_ < 2304) valid_ = false; else col_ = n_ - 160; } \
        else { const int j_ = n_ >> 6, w_ = n_ & 63; if (w_ >= 32) sp_ = a.src2 + (size_t)z_ * a.src_zs; col_ = 32 * j_ + (w_ & 31); } \
        v0[i] = make_float4(0.f, 0.f, 0.f, 0.f); v1[i] = v0[i]; \
        if (valid_) { v0[i] = *(const float4*)(sp_ + (size_t)(k0_ + kr) * a.Nsrc + col_); v1[i] = *(const float4*)(sp_ + (size_t)(k0_ + kr + 32) * a.Nsrc + col_); \
            if (ksc_) { const float s0_ = ksc_[k0_ + kr], s1_ = ksc_[k0_ + kr + 32]; v0[i].x *= s0_; v0[i].y *= s0_; v0[i].z *= s0_; v0[i].w *= s0_; v1[i].x *= s1_; v1[i].y *= s1_; v1[i].z *= s1_; v1[i].w *= s1_; } } } while (0)
    int u = bid, buf = 0;
#pragma unroll
    for (int i = 0; i < NT; ++i) { if (u + i * nblk < ntile) WP_LOAD(i, u + i * nblk); }
    for (; u < ntile; u += NT * nblk) {
        LAS float* tb = tile + buf * (NT * 64 * 65);
#pragma unroll
        for (int i = 0; i < NT; ++i) { if (u + i * nblk < ntile) { LAS float* w0 = tb + i * (64 * 65) + kr * 65 + 4 * c4; LAS float* w1 = w0 + 32 * 65;
            w0[0] = v0[i].x; w0[1] = v0[i].y; w0[2] = v0[i].z; w0[3] = v0[i].w; w1[0] = v1[i].x; w1[1] = v1[i].y; w1[2] = v1[i].z; w1[3] = v1[i].w; } }
        __syncthreads();
#pragma unroll
        for (int i = 0; i < NT; ++i) { const int un = u + (NT + i) * nblk; if (un < ntile) WP_LOAD(i, un); }
#pragma unroll
        for (int i = 0; i < NT; ++i) { const int ui = u + i * nblk; if (ui < ntile) {
            const int z = ui / (nx * ny), rem = ui % (nx * ny), n0 = (rem % nx) * 64, k0 = (rem / nx) * 64;
            T* dst = a.dst + (size_t)z * a.dst_zs;
            const LAS float* rp = tb + i * (64 * 65) + (kq * 8) * 65 + nr;
            *(uint4*)(dst + (size_t)(n0 + nr) * a.K + k0 + kq * 8) = make_uint4(pk2(rp[0], rp[65]), pk2(rp[130], rp[195]), pk2(rp[260], rp[325]), pk2(rp[390], rp[455])); } }
        buf ^= 1;
    }
#undef WP_LOAD
    __syncthreads();
}
__device__ __forceinline__ void lnmod_row(const float* src, const float* mv, int sh_off, int sc_off, T* dst, int lane) {
    float4 v[4]; float sum = 0.f;
#pragma unroll
    for (int i = 0; i < 4; ++i) { v[i] = *(const float4*)(src + i * 256 + lane * 4); sum += v[i].x + v[i].y + v[i].z + v[i].w; }
    const float mean = wave_sum(sum) * (1.f / D);
    float sq = 0.f;
#pragma unroll
    for (int i = 0; i < 4; ++i) { float a = v[i].x - mean, b = v[i].y - mean, c = v[i].z - mean, d = v[i].w - mean; sq += a * a + b * b + c * c + d * d; }
    const float rstd = 1.f / sqrtf(wave_sum(sq) * (1.f / D) + EPS);
#pragma unroll
    for (int i = 0; i < 4; ++i) {
        const int col = i * 256 + lane * 4;
        const float4 sh = *(const float4*)(mv + sh_off + col), sc = *(const float4*)(mv + sc_off + col);
        st4(dst + col, make_float4((v[i].x - mean) * rstd * (1.f + sc.x) + sh.x, (v[i].y - mean) * rstd * (1.f + sc.y) + sh.y,
                                   (v[i].z - mean) * rstd * (1.f + sc.z) + sh.z, (v[i].w - mean) * rstd * (1.f + sc.w) + sh.w));
    }
}
__device__ __forceinline__ void ph_lnmod0(const MP& p, int bid, int nblk) {
    const int tid_ = otid(); const int lane = tid_ & 63, wid = tid_ >> 6;
    for (int row = bid * 8 + wid; row < NROW; row += nblk * 8) {
        const bool lat = row < NLAT;
        const float* src = lat ? p.x() + (size_t)row * D : p.ctx() + (size_t)(row - NLAT) * D;
        const int s = lat ? row / SEQ : 4;
        lnmod_row(src, p.modv() + (size_t)s * MODW, 0, D, p.RA() + (size_t)row * D, lane);
    }
}
__device__ __forceinline__ void ph_lnres(ldsp lds, const MP& p, int l, int nrows, int bid, int nblk) {
    const int tid_ = otid(); const int lane = tid_ & 63, wid = tid_ >> 6;
    const float* modl = p.modv() + (size_t)l * 5 * MODW;
    const float* lgp = p.ln1g() + l * D; const float* lbp = p.ln1b() + l * D; const float* wr = p.w_router() + (size_t)l * D * NE;
    LAS float* WT = (LAS float*)lds;
    for (int i = tid_; i < NE * D; i += 512) { const int e = i >> 10, col = i & 1023; WT[i] = wr[col * NE + e]; }
    __syncthreads();
    const bool b5 = lane & 32, b4 = lane & 16, b3 = lane & 8, b2 = lane & 4;
    const int stride = nblk * 8;
    const float* xlat = l == 0 ? p.x() : p.out(); const float* xctx = l == 0 ? p.ctx() : p.XCb();
    float4 lgv[4], lbv[4], gv[4], shv[4], scv[4];
#pragma unroll
    for (int i = 0; i < 4; ++i) { lgv[i] = *(const float4*)(lgp + i * 256 + lane * 4); lbv[i] = *(const float4*)(lbp + i * 256 + lane * 4); }
    int cur_s = -1;
    int row = bid * 8 + wid;
    float4 xn[4]; uint2 yn[4];
#define LR_LOAD(r) do { const float* xs_ = (r) < NLAT ? xlat + (size_t)(r) * D : xctx + (size_t)((r) - NLAT) * D; const T* yp_ = p.RA() + (size_t)(r) * D; \
        _Pragma("unroll") for (int i = 0; i < 4; ++i) { xn[i] = *(const float4*)(xs_ + i * 256 + lane * 4); yn[i] = *(const uint2*)(yp_ + i * 256 + lane * 4); } } while (0)
    if (row < nrows) LR_LOAD(row);
    for (; row < nrows; row += stride) {
        float4 xc[4]; uint2 yc[4];
#pragma unroll
        for (int i = 0; i < 4; ++i) { xc[i] = xn[i]; yc[i] = yn[i]; }
        if (row + stride < nrows) LR_LOAD(row + stride);
        const bool lat = row < NLAT;
        float* xo = lat ? p.out() + (size_t)row * D : p.XCa() + (size_t)(row - NLAT) * D;
        const int s = lat ? row / SEQ : 4;
        if (s != cur_s) { cur_s = s; const float* mv = modl + (size_t)s * MODW;
#pragma unroll
            for (int i = 0; i < 4; ++i) { gv[i] = *(const float4*)(mv + 2 * D + i * 256 + lane * 4); shv[i] = *(const float4*)(mv + 3 * D + i * 256 + lane * 4); scv[i] = *(const float4*)(mv + 4 * D + i * 256 + lane * 4); } }
        float v[16]; float sum = 0.f;
#pragma unroll
        for (int i = 0; i < 4; ++i) {
            const float y0 = __uint_as_float(yc[i].x << 16), y1 = __uint_as_float(yc[i].x & 0xffff0000u), y2 = __uint_as_float(yc[i].y << 16), y3 = __uint_as_float(yc[i].y & 0xffff0000u);
            v[i * 4 + 0] = ALPHA * xc[i].x + gv[i].x * y0; v[i * 4 + 1] = ALPHA * xc[i].y + gv[i].y * y1; v[i * 4 + 2] = ALPHA * xc[i].z + gv[i].z * y2; v[i * 4 + 3] = ALPHA * xc[i].w + gv[i].w * y3;
            sum += v[i * 4] + v[i * 4 + 1] + v[i * 4 + 2] + v[i * 4 + 3];
        }
        const float mean = wave_sum(sum) * (1.f / D);
        float sq = 0.f;
#pragma unroll
        for (int i = 0; i < 16; ++i) { const float d = v[i] - mean; sq += d * d; }
        const float rstd = 1.f / sqrtf(wave_sum(sq) * (1.f / D) + EPS);
        float s2 = 0.f;
#pragma unroll
        for (int i = 0; i < 4; ++i) {
            v[i * 4 + 0] = (v[i * 4 + 0] - mean) * rstd * lgv[i].x + lbv[i].x; v[i * 4 + 1] = (v[i * 4 + 1] - mean) * rstd * lgv[i].y + lbv[i].y;
            v[i * 4 + 2] = (v[i * 4 + 2] - mean) * rstd * lgv[i].z + lbv[i].z; v[i * 4 + 3] = (v[i * 4 + 3] - mean) * rstd * lgv[i].w + lbv[i].w;
            *(float4*)(xo + i * 256 + lane * 4) = make_float4(v[i * 4], v[i * 4 + 1], v[i * 4 + 2], v[i * 4 + 3]);
            s2 += v[i * 4] + v[i * 4 + 1] + v[i * 4 + 2] + v[i * 4 + 3];
        }
        const float mean2 = wave_sum(s2) * (1.f / D);
        float sq2 = 0.f;
#pragma unroll
        for (int i = 0; i < 16; ++i) { const float d = v[i] - mean2; sq2 += d * d; }
        const float rstd2 = 1.f / sqrtf(wave_sum(sq2) * (1.f / D) + EPS);
        float h2[16];
#pragma unroll
        for (int i = 0; i < 4; ++i) {
            h2[i * 4 + 0] = (v[i * 4 + 0] - mean2) * rstd2 * (1.f + scv[i].x) + shv[i].x; h2[i * 4 + 1] = (v[i * 4 + 1] - mean2) * rstd2 * (1.f + scv[i].y) + shv[i].y;
            h2[i * 4 + 2] = (v[i * 4 + 2] - mean2) * rstd2 * (1.f + scv[i].z) + shv[i].z; h2[i * 4 + 3] = (v[i * 4 + 3] - mean2) * rstd2 * (1.f + scv[i].w) + shv[i].w;
            st4(p.RC() + (size_t)row * D + i * 256 + lane * 4, make_float4(h2[i * 4], h2[i * 4 + 1], h2[i * 4 + 2], h2[i * 4 + 3]));
        }
        float lg[16];
#pragma unroll
        for (int e = 0; e < 16; ++e) {
            float a = 0.f;
#pragma unroll
            for (int i = 0; i < 4; ++i) { const f32x4 w = *(const LAS f32x4*)(WT + e * D + i * 256 + lane * 4); a += h2[i * 4] * w.x + h2[i * 4 + 1] * w.y + h2[i * 4 + 2] * w.z + h2[i * 4 + 3] * w.w; }
            lg[e] = a;
            if (e & 1) __builtin_amdgcn_sched_barrier(0);
        }
        float a8[8], a4[4], a2[2];
#pragma unroll
        for (int k = 0; k < 8; ++k) {
            auto rr = __builtin_amdgcn_permlane32_swap(__float_as_uint(lg[k]), __float_as_uint(lg[8 + k]), false, false);
            a8[k] = __uint_as_float(rr[0]) + __uint_as_float(rr[1]); }
#pragma unroll
        for (int k = 0; k < 4; ++k) { const float mine = b4 ? a8[4 + k] : a8[k], oth = b4 ? a8[k] : a8[4 + k]; a4[k] = mine + __shfl_xor(oth, 16); }
#pragma unroll
        for (int k = 0; k < 2; ++k) { const float mine = b3 ? a4[2 + k] : a4[k], oth = b3 ? a4[k] : a4[2 + k]; a2[k] = mine + __shfl_xor(oth, 8); }
        float lgt = (b2 ? a2[1] : a2[0]) + __shfl_xor(b2 ? a2[0] : a2[1], 4);
        lgt = DPP_ADD(lgt, 0xB1); lgt = DPP_ADD(lgt, 0x4E);
        float mx = lgt;
        mx = fmaxf(mx, __shfl_xor(mx, 4)); mx = fmaxf(mx, __shfl_xor(mx, 8)); mx = fmaxf(mx, __shfl_xor(mx, 16)); mx = fmaxf(mx, __shfl_xor(mx, 32));
        const float ex = expf(lgt - mx);
        float den = ex;
        den += __shfl_xor(den, 4); den += __shfl_xor(den, 8); den += __shfl_xor(den, 16); den += __shfl_xor(den, 32);
        if ((lane & 3) == 0) p.AFF()[(size_t)row * NE + (lane >> 2)] = ex / den;
    }
#undef LR_LOAD
    __syncthreads();
}
__device__ __forceinline__ void ph_topk(ldsp lds, const MP& p, int nkinds, int bid, int nblk) {
    LAS unsigned* keys = (LAS unsigned*)lds;
    LAS unsigned* hist = (LAS unsigned*)(lds + 32768);
    LAS unsigned* part = (LAS unsigned*)(lds + 32768 + 8192);
    LAS unsigned* shv = (LAS unsigned*)(lds + 32768 + 8192 + 1024);
    const int tid = otid(), lane = tid & 63, wv = tid >> 6;
    for (int u = bid; u < NE * NB * nkinds; u += nblk) {
        const int e = u % NE, bl = (u / NE) % NB, kind = u / (NE * NB);
        const int n = kind ? CTX : SEQ, kk = kind ? CAPC : CAP;
        const size_t row0 = kind ? (size_t)NLAT + (size_t)bl * CTX : (size_t)bl * SEQ;
        const size_t grp = kind ? (size_t)NB * NE * CAP + ((size_t)e * NB + bl) * CAPC : ((size_t)bl * NE + e) * CAP;
        for (int i = tid; i < n; i += 512) keys[i] = __float_as_uint(p.AFF()[(row0 + i) * NE + e]);
        __syncthreads();
        unsigned prefix = 0, rem = kk;
        for (int pass = 0; pass < 3; ++pass) {
            const int shift = pass == 0 ? 21 : pass == 1 ? 10 : 0;
            const int nbm = pass == 2 ? 1023 : 2047;
            const int hshift = pass == 1 ? 21 : 10;
            for (int i = tid; i < 2048; i += 512) hist[i] = 0;
            __syncthreads();
            for (int i = tid; i < n; i += 512) { const unsigned k = keys[i]; const bool match = (pass == 0) || ((k >> hshift) == prefix); if (match) atomicAdd((unsigned*)&hist[(k >> shift) & nbm], 1u); }
            __syncthreads();
            unsigned loc = 0;
            if (tid < 256) { for (int j = 0; j < 8; ++j) loc += hist[tid * 8 + j]; part[tid] = loc; }
            __syncthreads();
            if (tid < 256) {
                unsigned above = 0;
                for (int j = tid + 1; j < 256; ++j) above += part[j];
                if (above < rem && above + loc >= rem) {
                    unsigned cum = above; int bsel = tid * 8 + 7;
                    for (; bsel >= tid * 8; --bsel) { const unsigned hc = hist[bsel]; if (cum + hc >= rem) break; cum += hc; }
                    shv[0] = (unsigned)bsel; shv[1] = rem - cum;
                }
            }
            __syncthreads();
            prefix = (pass == 0) ? shv[0] : ((prefix << (pass == 1 ? 11 : 10)) | shv[0]);
            rem = shv[1];
            __syncthreads();
        }
        const unsigned Tkey = prefix;
        unsigned base_gt = 0, base_eq = 0;
        for (int c0 = 0; c0 < n; c0 += 512) {
            const int i = c0 + tid; const bool inr = i < n;
            const unsigned k = inr ? keys[i] : 0u;
            const bool gt = inr && k > Tkey, eq = inr && k == Tkey;
            const unsigned long long mg = __ballot(gt), me = __ballot(eq);
            const unsigned long long lt = (1ull << lane) - 1ull;
            if (lane == 0) { shv[8 + wv] = __popcll(mg); shv[16 + wv] = __popcll(me); }
            __syncthreads();
            unsigned pg = base_gt + __popcll(mg & lt), pe = base_eq + __popcll(me & lt), tg = 0, te = 0;
            for (int w = 0; w < 8; ++w) { const unsigned a = shv[8 + w], b = shv[16 + w]; if (w < wv) { pg += a; pe += b; } tg += a; te += b; }
            const bool sel = gt || (eq && pe < rem);
            const unsigned slot = pg + min(pe, rem);
            if (inr) { if (sel) { p.IDX()[grp + slot] = (int)(row0 + i); p.GATEV()[grp + slot] = __uint_as_float(k); }
                       p.INV()[(row0 + i) * NE + e] = sel ? (int)slot : -1; }
            base_gt += tg; base_eq += te;
            __syncthreads();
        }
    }
}
__device__ __forceinline__ void ph_combine(const MP& p, int l, int nrows, const T* OUT, int bid, int nblk) {
    const int tid_ = otid(); const int lane = tid_ & 63, wid = tid_ >> 6;
    const float* modl = p.modv() + (size_t)l * 5 * MODW;
    const float* lgp = p.ln2g() + l * D; const float* lbp = p.ln2b() + l * D;
    const bool next = l + 1 < NL;
    const int stride = nblk * 8;
    float4 lgv[4], lbv[4], gv[4];
#pragma unroll
    for (int i = 0; i < 4; ++i) { lgv[i] = *(const float4*)(lgp + i * 256 + lane * 4); lbv[i] = *(const float4*)(lbp + i * 256 + lane * 4); }
    int cur_s = -1;
    int row = bid * 8 + wid;
    int sl_next = -1; float4 xn[4];
#define CB_LOAD(r) do { const float* xs_ = (r) < NLAT ? p.out() + (size_t)(r) * D : p.XCa() + (size_t)((r) - NLAT) * D; \
        _Pragma("unroll") for (int i = 0; i < 4; ++i) xn[i] = *(const float4*)(xs_ + i * 256 + lane * 4); \
        sl_next = lane < NE ? p.INV()[(size_t)(r) * NE + lane] : -1; } while (0)
    if (row < nrows) CB_LOAD(row);
    for (; row < nrows; row += stride) {
        float4 xc[4];
#pragma unroll
        for (int i = 0; i < 4; ++i) xc[i] = xn[i];
        const int slv = sl_next;
        if (row + stride < nrows) CB_LOAD(row + stride);
        const bool lat = row < NLAT;
        float* xo = lat ? p.out() + (size_t)row * D : p.XCb() + (size_t)(row - NLAT) * D;
        const int bl = lat ? row / SEQ : (row - NLAT) / CTX;
        const int s = lat ? bl : 4;
        if (s != cur_s) { cur_s = s; const float* mv = modl + (size_t)s * MODW;
#pragma unroll
            for (int i = 0; i < 4; ++i) gv[i] = *(const float4*)(mv + 5 * D + i * 256 + lane * 4); }
        unsigned long long mask = __ballot(slv >= 0) & 0xffffull;
        uint2 ob[4][4]; bool ok[4];
#pragma unroll
        for (int j = 0; j < 4; ++j) {
            ok[j] = mask != 0ull;
            if (ok[j]) {
                const int e = __builtin_ctzll(mask); mask &= mask - 1;
                const int sl = __builtin_amdgcn_readlane(slv, e);
                const size_t orow = lat ? ((size_t)bl * NE + e) * CAP + sl : (size_t)NB * NE * CAP + ((size_t)e * NB + bl) * CAPC + sl;
                const T* op = OUT + orow * D;
#pragma unroll
                for (int i = 0; i < 4; ++i) ob[j][i] = *(const uint2*)(op + i * 256 + lane * 4);
            } else {
#pragma unroll
                for (int i = 0; i < 4; ++i) ob[j][i] = make_uint2(0u, 0u);
            }
        }
        float y[16];
#pragma unroll
        for (int i = 0; i < 16; ++i) y[i] = 0.f;
#pragma unroll
        for (int j = 0; j < 4; ++j)
#pragma unroll
            for (int i = 0; i < 4; ++i) { y[i * 4] += __uint_as_float(ob[j][i].x << 16); y[i * 4 + 1] += __uint_as_float(ob[j][i].x & 0xffff0000u); y[i * 4 + 2] += __uint_as_float(ob[j][i].y << 16); y[i * 4 + 3] += __uint_as_float(ob[j][i].y & 0xffff0000u); }
        while (mask) {
            const int e = __builtin_ctzll(mask); mask &= mask - 1;
            const int sl = __builtin_amdgcn_readlane(slv, e);
            const size_t orow = lat ? ((size_t)bl * NE + e) * CAP + sl : (size_t)NB * NE * CAP + ((size_t)e * NB + bl) * CAPC + sl;
            const T* op = OUT + orow * D;
#pragma unroll
            for (int i = 0; i < 4; ++i) { const float4 o4 = ld4(op + i * 256 + lane * 4); y[i * 4] += o4.x; y[i * 4 + 1] += o4.y; y[i * 4 + 2] += o4.z; y[i * 4 + 3] += o4.w; }
        }
        float v[16]; float sum = 0.f;
#pragma unroll
        for (int i = 0; i < 4; ++i) {
            v[i * 4 + 0] = ALPHA * xc[i].x + gv[i].x * y[i * 4 + 0]; v[i * 4 + 1] = ALPHA * xc[i].y + gv[i].y * y[i * 4 + 1]; v[i * 4 + 2] = ALPHA * xc[i].z + gv[i].z * y[i * 4 + 2]; v[i * 4 + 3] = ALPHA * xc[i].w + gv[i].w * y[i * 4 + 3];
            sum += v[i * 4] + v[i * 4 + 1] + v[i * 4 + 2] + v[i * 4 + 3];
        }
        const float mean = wave_sum(sum) * (1.f / D);
        float sq = 0.f;
#pragma unroll
        for (int i = 0; i < 16; ++i) { const float d = v[i] - mean; sq += d * d; }
        const float rstd = 1.f / sqrtf(wave_sum(sq) * (1.f / D) + EPS);
        float s2 = 0.f;
#pragma unroll
        for (int i = 0; i < 4; ++i) {
            v[i * 4 + 0] = (v[i * 4 + 0] - mean) * rstd * lgv[i].x + lbv[i].x; v[i * 4 + 1] = (v[i * 4 + 1] - mean) * rstd * lgv[i].y + lbv[i].y;
            v[i * 4 + 2] = (v[i * 4 + 2] - mean) * rstd * lgv[i].z + lbv[i].z; v[i * 4 + 3] = (v[i * 4 + 3] - mean) * rstd * lgv[i].w + lbv[i].w;
            { const float ps_ = (!next && p.pscale()) ? p.pscale()[0] : 1.f;
              *(float4*)(xo + i * 256 + lane * 4) = make_float4(v[i * 4] * ps_, v[i * 4 + 1] * ps_, v[i * 4 + 2] * ps_, v[i * 4 + 3] * ps_); }
            s2 += v[i * 4] + v[i * 4 + 1] + v[i * 4 + 2] + v[i * 4 + 3];
        }
        if (next) {
            const float* mvn = p.modv() + ((size_t)(l + 1) * 5 + s) * MODW;
            const float mean2 = wave_sum(s2) * (1.f / D);
            float sq2 = 0.f;
#pragma unroll
            for (int i = 0; i < 16; ++i) { const float d = v[i] - mean2; sq2 += d * d; }
            const float rstd2 = 1.f / sqrtf(wave_sum(sq2) * (1.f / D) + EPS);
#pragma unroll
            for (int i = 0; i < 4; ++i) {
                const int col = i * 256 + lane * 4;
                const float4 sh = *(const float4*)(mvn + col), sc = *(const float4*)(mvn + D + col);
                st4(p.RA() + (size_t)row * D + col, make_float4((v[i * 4 + 0] - mean2) * rstd2 * (1.f + sc.x) + sh.x, (v[i * 4 + 1] - mean2) * rstd2 * (1.f + sc.y) + sh.y,
                                                             (v[i * 4 + 2] - mean2) * rstd2 * (1.f + sc.z) + sh.z, (v[i * 4 + 3] - mean2) * rstd2 * (1.f + sc.w) + sh.w));
            }
        }
    }
#undef CB_LOAD
}


#define XB_TMO      128
#define XB_XCNT(j)  (256  + 64 * (j))
#define XB_XSUB(j)  (1280 + 64 * (j))
#define XB_XGEN(j)  (2304 + 64 * (j))
#define XB_TOP      3328
#define XB_TOPGEN   3392
#define XCD_BAR_WORDS 3456
#define XB_SPIN_CAP (1u << 18)
__device__ __forceinline__ unsigned xb_ld(unsigned* p)              { return __hip_atomic_load(p, __ATOMIC_RELAXED, __HIP_MEMORY_SCOPE_AGENT); }
__device__ __forceinline__ unsigned xb_add(unsigned* p, unsigned v) { return __hip_atomic_fetch_add(p, v, __ATOMIC_RELAXED, __HIP_MEMORY_SCOPE_AGENT); }
__device__ __forceinline__ unsigned xb_xcc_id() { return (unsigned)__builtin_amdgcn_s_getreg((3 << 11) | 20) & 0xFu; }
#define XB_SPIN(cond, bar) do { unsigned _sp = 0; while (cond) { __builtin_amdgcn_s_sleep(1); \
    if ((++_sp & 255u) == 0u) { if (xb_ld(&(bar)[XB_TMO])) break; if (_sp > XB_SPIN_CAP) { atomicAdd(&(bar)[XB_TMO], 1u); break; } } } } while (0)
struct XcdBarrier { unsigned* bar; unsigned x; volatile LAS unsigned* st; };
__device__ __forceinline__ XcdBarrier xcd_barrier_post(unsigned* bar, volatile LAS unsigned* st) {
    XcdBarrier b; b.bar = bar; b.x = xb_xcc_id(); b.st = st;
    if (threadIdx.x == 0) (void)xb_add(&bar[XB_XCNT(b.x)], 1u);
    return b;
}
__device__ __forceinline__ void xcd_barrier_complete(unsigned* bar, unsigned x, unsigned& nloc, unsigned& nx) {
    const unsigned G = gridDim.x * gridDim.y * gridDim.z;
    unsigned sum, cnt, mine, sp = 0u;
    for (;;) {
        sum = 0u; cnt = 0u; mine = 0u;
#pragma unroll
        for (unsigned j = 0; j < 16; ++j) { const unsigned c = xb_ld(&bar[XB_XCNT(j)]); sum += c; cnt += (c > 0u) ? 1u : 0u; mine = (j == x) ? c : mine; }
        if (sum == G) break;
        __builtin_amdgcn_s_sleep(1);
        if ((++sp & 255u) == 0u) { if (xb_ld(&bar[XB_TMO])) break; if (sp > XB_SPIN_CAP) { atomicAdd(&bar[XB_TMO], 1u); break; } }
    }
    nloc = mine > 0u ? mine : 1u; nx = cnt > 0u ? cnt : 1u;
}
__device__ __forceinline__ void xcd_barrier(const XcdBarrier& b) {
    asm volatile("s_waitcnt vmcnt(0)" ::: "memory");
    __syncthreads();
    if (threadIdx.x == 0) {
        unsigned* bar = b.bar;
        __builtin_amdgcn_s_waitcnt(0);
        unsigned nloc = b.st[0], nx = b.st[1];
        if (nloc == 0u) { xcd_barrier_complete(bar, b.x, nloc, nx); b.st[0] = nloc; b.st[1] = nx; }
        const unsigned old = xb_add(&bar[XB_XSUB(b.x)], 1u);
        const unsigned gen = old / nloc;
        if (old + 1u == (gen + 1u) * nloc) {
            __builtin_amdgcn_fence(__ATOMIC_RELEASE, "agent");
            asm volatile("s_waitcnt vmcnt(0)" ::: "memory");
            const unsigned og = xb_add(&bar[XB_TOP], 1u);
            const unsigned tg = og / nx;
            if (og + 1u == (tg + 1u) * nx) xb_add(&bar[XB_TOPGEN], 1u);
            else XB_SPIN(xb_ld(&bar[XB_TOPGEN]) == tg, bar);
            __builtin_amdgcn_fence(__ATOMIC_ACQUIRE, "agent");
            xb_add(&bar[XB_XGEN(b.x)], 1u);
            asm volatile("s_waitcnt vmcnt(0)" ::: "memory");
        } else {
            XB_SPIN(xb_ld(&bar[XB_XGEN(b.x)]) == gen, bar);
            __builtin_amdgcn_fence(__ATOMIC_ACQUIRE, "agent");
            asm volatile("s_waitcnt vmcnt(0)" ::: "memory");
        }
    }
    __syncthreads();
}

#ifdef PROBE_L0
__global__ void __launch_bounds__(256) k_cmp2(const float* a, const float* b, size_t n, float* acc, int slot) {
    float num = 0.f, den = 0.f;
    for (size_t i = (size_t)blockIdx.x * 256 + threadIdx.x; i < n; i += (size_t)gridDim.x * 256) { const float x = a[i], y = b[i]; num += (x - y) * (x - y); den += y * y; }
    __shared__ float sn[256], sd[256]; sn[threadIdx.x] = num; sd[threadIdx.x] = den; __syncthreads();
    for (int s = 128; s > 0; s >>= 1) { if (threadIdx.x < s) { sn[threadIdx.x] += sn[threadIdx.x + s]; sd[threadIdx.x] += sd[threadIdx.x + s]; } __syncthreads(); }
    if (threadIdx.x == 0) { atomicAdd(&acc[slot], sn[0]); atomicAdd(&acc[4 + slot], sd[0]); }
}
__global__ void k_fin2(const float* acc, float* scale, int which) { float e = acc[which] / acc[4 + which]; if (!(e == e)) e = 1.f; scale[0] = 1.f + sqrtf(e) * 100.f; }
#endif
constexpr int LDS_TOTAL = 159744 + 64 + 256;
static_assert(ATT_LDS <= 159744, "attention LDS");
constexpr size_t NSLOT = (size_t)NB * NE * (CAP + CAPC);
constexpr int NPHASE = 2 + 11 * NL;
__global__ void __launch_bounds__(512, 2) k_mega(MP p) {
    extern __shared__ __attribute__((aligned(16))) unsigned char dynlds[];
    const ldsp lds = (ldsp)dynlds;
    const int bid0 = blockIdx.x, nblk0 = gridDim.x;

    volatile LAS unsigned* xbw = (volatile LAS unsigned*)(lds + 159744);
    if (threadIdx.x == 0) { xbw[0] = 0u; xbw[1] = 0u; xbw[2] = 0u; xbw[3] = 0u; }
    __syncthreads();
    const XcdBarrier bar = xcd_barrier_post(p.bar(), xbw);
    int g = 0;
#ifndef REP_MASK
#define REP_MASK 0
#endif
#define PH(kind, ...) if (g >= p.ph_lo() && g < p.ph_hi()) { int bid = bid0, nblk = nblk0; asm volatile("" : "+s"(bid), "+s"(nblk));     \
    __VA_ARGS__ if (((REP_MASK >> (kind)) & 1) && ((kind) != 5 || g < 13)) { xcd_barrier(bar); __VA_ARGS__ } if (g + 1 < p.ph_hi()) xcd_barrier(bar); } ++g;
#define bH (p.RA())
#define bO (p.RA())
#define bY (p.RA())
#define bQM (p.RC())
#define bKVM (p.RC() + (size_t)NROW * 384)
#define bMERGED (p.RC())
#define bH2 (p.RC())
#define bACT (p.Z())
#define bOUT (p.Z() + NSLOT * FF)
#define bXG (p.Z() + NSLOT * FF)
#define bWguT (p.Z() + 2 * NSLOT * FF)
#define bWdT (p.Z() + 2 * NSLOT * FF + (size_t)NE * 2048 * 1024)
    if ((REP_MASK >> 14) & 1) { for (int i = 0; i < 20; ++i) xcd_barrier(bar); }
    PH(12,
        ph_mod(lds, p, bid, nblk);
        ph_ropetab(p, bid, nblk);
        { PrepJob j{}; j.src = p.w_in(); j.dst = p.WinT(); j.K = D; j.Nsrc = INW; j.Ndst = ZWP; j.mode = 1; j.perm = 1; j.nz = NL; j.src_zs = (long long)D * INW; j.dst_zs = (long long)ZWP * D; ph_wprep(lds, j, bid, nblk); }
        { PrepJob j{}; j.src = p.w_qb(); j.kscale = p.mqn(); j.dst = p.WqT(); j.K = 192; j.Nsrc = 384; j.Ndst = 384; j.mode = 0; j.nz = NL; j.src_zs = 192 * 384; j.dst_zs = 384 * 192; j.ks_zs = 192; ph_wprep(lds, j, bid, nblk); }
        { PrepJob j{}; j.src = p.w_kvb(); j.kscale = p.mkvn(); j.dst = p.WkvT(); j.K = 128; j.Nsrc = 512; j.Ndst = 512; j.mode = 0; j.nz = NL; j.src_zs = 128 * 512; j.dst_zs = 512 * 128; j.ks_zs = 128; ph_wprep(lds, j, bid, nblk); }
        { PrepJob j{}; j.src = p.w_branch(); j.dst = p.WbT(); j.K = 256; j.Nsrc = 1024; j.Ndst = 1024; j.mode = 0; j.nz = NL * 4; j.src_zs = 256 * 1024; j.dst_zs = 1024 * 256; ph_wprep(lds, j, bid, nblk); }
        { PrepJob j{}; j.src = p.w_out(); j.dst = p.WoutT(); j.K = 1024; j.Nsrc = 1024; j.Ndst = 1024; j.mode = 0; j.perm = 1; j.nz = NL; j.src_zs = 1024 * 1024; j.dst_zs = 1024 * 1024; ph_wprep(lds, j, bid, nblk); }
    )
    PH(13, ph_lnmod0(p, bid, nblk);)
    for (int l = 0; l < NL; ++l) {
        const bool need_ctx = l + 1 < NL; const int mrows = need_ctx ? NROW : NLAT;
        PH(0, { InProj8S sc{}; sc.H = bH; sc.Wt = p.WinT() + (size_t)l * ZWP * D; sc.npm = NROW / 256; sc.bid = bid; sc.nblk = nblk; sc.nun = need_ctx ? 3300 : 3200 + 36;
                InProj8E ep{}; ep.Z = p.Z(); ep.SS = p.SS(); ep.gqn = p.gqn() + l * 64; ep.gkn = p.gkn() + l * 64; ep.tab64 = p.tab64(); ep.tab32 = p.tab32();
                pg8::gemm_phase<InProj8E, InProj8S, true, true>(lds, D, sc, ep); } )
        PH(1, { MlaProj pb{}; pb.Z = p.Z(); pb.WqT = p.WqT() + (size_t)l * 384 * 192; pb.WkvT = p.WkvT() + (size_t)l * 512 * 128; pb.QM = bQM; pb.KVM = bKVM; pb.SS = p.SS(); pb.tab32 = p.tab32(); pb.nlat = NLAT; pb.npm = NROW / 256;
                   gemm_run<128, false>(lds, pb, bid, nblk); } )
        PH(2, { AttnP ap{}; ap.Z = p.Z(); ap.QM = bQM; ap.KVM = bKVM; ap.O = bO; ap.rpb = p.na_rpb() + (size_t)l * 4 * 15 * 31; ap.sink = p.swa_sink() + l * 4; ap.nlat = NLAT; ap.need_ctx = need_ctx ? 1 : 0; ap.o32 = (l == 0) ? p.o32() : nullptr; ap.fake = 0;
#ifdef PROBE_F
                   if (l == 0) { ap.fake = PROBE_F; attn_phase(lds, ap, bid, nblk); ap.fake = 0; ap.o32 = nullptr; }
#endif
                   attn_phase(lds, ap, bid, nblk); } )
        PH(3, { MergeProb pb{}; pb.O = bO; pb.WbT = p.WbT() + (size_t)l * 4 * 1024 * 256; pb.Z = p.Z(); pb.MERGED = bMERGED; pb.npm = mrows / 256; gemm_run<128, true>(lds, pb, bid, nblk); } )
        PH(4, { Plain8S sc{}; sc.A = bMERGED; sc.Bt = p.WoutT() + (size_t)l * D * D; sc.npm = mrows / 256; sc.npn = 4; sc.K = D; sc.bid = bid; sc.nblk = nblk; Plain8E ep{}; ep.C = bY; ep.ldc = D;
                pg8::gemm_phase<Plain8E, Plain8S, true, true>(lds, D, sc, ep); } )
        PH(5, ph_lnres(lds, p, l, mrows, bid, nblk); )
        PH(6,
            ph_topk(lds, p, need_ctx ? 2 : 1, bid, nblk);
            { const bool split = nblk > 2 * NE * NB; const int pb_ = split ? bid - NE * NB : bid, pn_ = split ? nblk - NE * NB : nblk;
              if (pb_ >= 0) {
            { PrepJob j{}; j.src = p.w_gate() + (size_t)l * NE * D * FF; j.src2 = p.w_up() + (size_t)l * NE * D * FF; j.dst = bWguT; j.K = 1024; j.Nsrc = 1024; j.Ndst = 2048; j.mode = 2; j.perm = 1; j.nz = NE; j.src_zs = (long long)D * FF; j.dst_zs = (long long)2048 * 1024; ph_wprep(lds, j, pb_, pn_); }
            { PrepJob j{}; j.src = p.w_down() + (size_t)l * NE * FF * D; j.dst = bWdT; j.K = 1024; j.Nsrc = 1024; j.Ndst = 1024; j.mode = 0; j.perm = 1; j.nz = NE; j.src_zs = (long long)FF * D; j.dst_zs = (long long)1024 * 1024; ph_wprep(lds, j, pb_, pn_); }
              } }
        )
        PH(10, ph_gather(bH2, p.IDX(), bXG, need_ctx ? (int)NSLOT : CTXB, bid, nblk); )
        PH(7, { FfnUp8S sc{}; sc.XG = bXG; sc.WguT = bWguT; sc.nun = 2048 + (need_ctx ? 128 : 0); sc.bid = bid; sc.nblk = nblk; FfnUp8E ep{}; ep.ACT = bACT;
                pg8::gemm_phase<FfnUp8E, FfnUp8S, true, true>(lds, D, sc, ep); } )
        PH(8, { FfnDown8S sc{}; sc.ACT = bACT; sc.WdT = bWdT; sc.nun = 1024 + (need_ctx ? 64 : 0); sc.bid = bid; sc.nblk = nblk; FfnDown8E ep{}; ep.GATEV = p.GATEV(); ep.OUT = bOUT;
                pg8::gemm_phase<FfnDown8E, FfnDown8S, true, true>(lds, FF, sc, ep); } )
        PH(9, ph_combine(p, l, mrows, bOUT, bid, nblk); )
    }
#undef PH
#undef bH
#undef bO
#undef bY
#undef bQM
#undef bKVM
#undef bMERGED
#undef bH2
#undef bACT
#undef bOUT
#undef bXG
#undef bWguT
#undef bWdT
}
}

extern "C" void kernel_launch(void* const* d_in, const int* in_sizes, int n_in, void* d_out, int out_size, void* d_ws, size_t ws_size, hipStream_t stream) {
    MP p; memset(&p, 0, sizeof(p));
    p.x_ = (const float*)d_in[0]; p.c_ = (const float*)d_in[1]; p.ctx_ = (const float*)d_in[2]; p.c_ctx_ = (const float*)d_in[3];
    p.w_mod_ = (const float*)d_in[4]; p.b_mod_ = (const float*)d_in[5]; p.w_in_ = (const float*)d_in[6]; p.na_rpb_ = (const float*)d_in[7];
    p.gqn_ = (const float*)d_in[8]; p.gkn_ = (const float*)d_in[9]; p.swa_sink_ = (const float*)d_in[10];
    p.mqn_ = (const float*)d_in[11]; p.mkvn_ = (const float*)d_in[12]; p.w_qb_ = (const float*)d_in[13]; p.w_kvb_ = (const float*)d_in[14];
    p.w_branch_ = (const float*)d_in[15]; p.w_out_ = (const float*)d_in[16];
    p.ln1g_ = (const float*)d_in[17]; p.ln1b_ = (const float*)d_in[18]; p.ln2g_ = (const float*)d_in[19]; p.ln2b_ = (const float*)d_in[20];
    p.w_router_ = (const float*)d_in[21]; p.w_gate_ = (const float*)d_in[22]; p.w_up_ = (const float*)d_in[23]; p.w_down_ = (const float*)d_in[24];
    p.out_ = (float*)d_out;
    char* ws = (char*)d_ws; size_t off = OFF_END;
    auto carve = [&](size_t bytes) { void* q = ws + off; off += (bytes + 255) & ~(size_t)255; return q; }; (void)carve;
    p.ws_ = ws;
    if (off > ws_size || 2 * NSLOT * FF + (size_t)NE * 3072 * 1024 > (size_t)NROW * ZW) { fprintf(stderr, "workspace too small: need %zu have %zu\n", off, ws_size); return; }
    static int grid = 0;
    if (!grid) {
        int dev = 0, cus = 0, per_cu = 0;
        (void)hipGetDevice(&dev);
        (void)hipDeviceGetAttribute(&cus, hipDeviceAttributeMultiprocessorCount, dev);
        (void)hipFuncSetAttribute((const void*)k_mega, hipFuncAttributeMaxDynamicSharedMemorySize, LDS_TOTAL);
        (void)hipOccupancyMaxActiveBlocksPerMultiprocessor(&per_cu, (const void*)k_mega, 512, LDS_TOTAL);
        grid = per_cu >= 1 ? cus : 0;
        if (grid > 256) grid = 256;
    }
    if (!grid) { fprintf(stderr, "k_mega cannot be resident\n"); return; }
    (void)hipMemsetAsync(ws + OFF_BAR, 0, XCD_BAR_WORDS * 4, stream);
#ifdef PROBE_L0
    {
        float* save_xc = (float*)carve((size_t)NCTX * D * 4); float* save_x = (float*)carve((size_t)2048 * D * 4); float* pacc = (float*)carve(256); float* pscl = (float*)carve(256);
        if (off > ws_size) { fprintf(stderr, "probe workspace\n"); return; }
        nv::nv_layer0(d_in, d_out, d_ws, ws_size, stream, save_xc, save_x);
        (void)hipMemsetAsync(ws + OFF_BAR, 0, XCD_BAR_WORDS * 4, stream);
        (void)hipMemsetAsync(pacc, 0, 256, stream);
        p.pscale_ = pscl;
        p.ph_lo_ = 0; p.ph_hi_ = 2 + (NPHASE - 2) / NL;
        hipLaunchKernelGGL(k_mega, dim3(grid), dim3(512), LDS_TOTAL, stream, p);
        hipLaunchKernelGGL(k_cmp2, dim3(256), dim3(256), 0, stream, (const float*)(ws + OFF_XCB), (const float*)save_xc, (size_t)NCTX * D, pacc, 0);
        for (int b = 0; b < NB; ++b) hipLaunchKernelGGL(k_cmp2, dim3(256), dim3(256), 0, stream, (const float*)d_out + (size_t)b * SEQ * D, (const float*)save_x + (size_t)b * 512 * D, (size_t)512 * D, pacc, 1);
        hipLaunchKernelGGL(k_fin2, dim3(1), dim3(1), 0, stream, pacc, pscl, (int)PROBE_L0);
        (void)hipMemsetAsync(ws + OFF_BAR, 0, XCD_BAR_WORDS * 4, stream);
        p.ph_lo_ = 2 + (NPHASE - 2) / NL; p.ph_hi_ = NPHASE;
        hipLaunchKernelGGL(k_mega, dim3(grid), dim3(512), LDS_TOTAL, stream, p);
    }
#elif defined(PROBE_ATTN)
    {
        float* O32 = (float*)carve((size_t)2304 * D * 4); float* O2 = (float*)carve((size_t)2304 * D * 4); float* pacc = (float*)carve(256); float* pscl = (float*)carve(256);
        if (off > ws_size) { fprintf(stderr, "probe workspace\n"); return; }
        p.o32_ = O32; p.pscale_ = pscl;
        (void)hipMemsetAsync(pacc, 0, 256, stream);
        p.ph_lo_ = 0; p.ph_hi_ = 5;
        hipLaunchKernelGGL(k_mega, dim3(grid), dim3(512), LDS_TOTAL, stream, p);
        AttnArgs a{}; a.Z = (const T*)(ws + OFF_Z); a.QM = (const T*)(ws + OFF_RC); a.KVM = (const T*)(ws + OFF_RC) + (size_t)NROW * 384; a.O2 = O2; a.rpb = p.na_rpb_; a.sink = p.swa_sink_; a.P.nbp = NB; a.P.b0 = 0; a.P.nlat = NLAT; a.P.nctx = NCTX; a.P.nrow = NROW; a.bl0 = 1;
        a.ctxq = 0; { dim3 g(8, 4, 1); hipLaunchKernelGGL(k_attn_naive<0>, g, dim3(256), 0, stream, a); hipLaunchKernelGGL(k_attn_naive<1>, g, dim3(256), 0, stream, a);
                      hipLaunchKernelGGL(k_attn_naive<2>, g, dim3(256), 0, stream, a); hipLaunchKernelGGL(k_attn_naive<3>, g, dim3(256), 0, stream, a); }
        a.ctxq = 1; { dim3 g(1, 4, 1); hipLaunchKernelGGL(k_attn_naive<0>, g, dim3(256), 0, stream, a); hipLaunchKernelGGL(k_attn_naive<1>, g, dim3(256), 0, stream, a);
                      hipLaunchKernelGGL(k_attn_naive<2>, g, dim3(256), 0, stream, a); hipLaunchKernelGGL(k_attn_naive<3>, g, dim3(256), 0, stream, a); }
        hipLaunchKernelGGL(k_probe_cmp, dim3(64, 4), dim3(256), 0, stream, O32, O2, pacc, 2304);
        hipLaunchKernelGGL(k_probe_fin, dim3(1), dim3(1), 0, stream, pacc, pscl, (int)PROBE_ATTN);
        (void)hipMemsetAsync(ws + OFF_BAR, 0, XCD_BAR_WORDS * 4, stream);
        p.ph_lo_ = 5; p.ph_hi_ = NPHASE;
        hipLaunchKernelGGL(k_mega, dim3(grid), dim3(512), LDS_TOTAL, stream, p);
    }
#elif defined(PROBE_T)
    {
        float* pscl = (float*)carve(256);
        if (off > ws_size) { fprintf(stderr, "probe workspace\n"); return; }
        p.o32_ = pscl; p.pscale_ = pscl;
        p.ph_lo_ = 0; p.ph_hi_ = NPHASE;
        hipLaunchKernelGGL(k_mega, dim3(grid), dim3(512), LDS_TOTAL, stream, p);
    }
#elif !defined(MK_SPLIT)
    p.ph_lo_ = 0; p.ph_hi_ = NPHASE;
    hipLaunchKernelGGL(k_mega, dim3(grid), dim3(512), LDS_TOTAL, stream, p);
#else
    for (int g = 0; g < NPHASE; ++g) { p.ph_lo_ = g; p.ph_hi_ = g + 1; hipLaunchKernelGGL(k_mega, dim3(grid), dim3(512), LDS_TOTAL, stream, p); }
#endif
}
```
